# Optimizing an MI355X kernel written in HIP

```python
import jax, jax.numpy as jnp
from jax import lax
import numpy as np

D_MODEL = 2048
BATCH = 4
SEQ = 2048
DEPTH = 1
DEC_BATCH = 8
DEC_SEQ = 4
PAST_LEN = 16384
PAGE_SIZE = 128

D_MIX = D_MODEL
D_ATTN = D_MIX // 2
D_CONV = D_MIX - D_ATTN
HEAD_DIM = 128
N_HEADS = D_ATTN // HEAD_DIM
N_KV_HEADS = 2
GROUP = N_HEADS // N_KV_HEADS
ROPE_DIM = HEAD_DIM // 4
ROPE_THETA = 500000.0
N_IDX_HEADS = 16
IDX_DIM = 64
IDX_ROPE_DIM = IDX_DIM // 4
TOPK_MAX = 256
CONV_W = 3
N_CONV_GROUPS = 8
Q_BLOCK = 128
EPS = 1e-6

SPLITS = (
    ("q", N_HEADS * HEAD_DIM),
    ("k", N_KV_HEADS * HEAD_DIM),
    ("v", N_KV_HEADS * HEAD_DIM),
    ("z_attn", D_ATTN),
    ("q_idx", N_IDX_HEADS * IDX_DIM),
    ("k_idx", IDX_DIM),
    ("w_idx", N_IDX_HEADS),
    ("h", D_CONV),
    ("b", D_CONV),
    ("c", D_CONV),
    ("z_conv", D_CONV),
)
D_IN = sum(n for _, n in SPLITS)

kernel_name = "hymba_dsa_shortconv_step"


def rmsnorm(x, g):
    xf = x.astype(jnp.float32)
    y = xf * lax.rsqrt(jnp.mean(xf * xf, axis=-1, keepdims=True) + EPS)
    return (y * g.astype(jnp.float32)).astype(x.dtype)


def partial_rope(x, pos, rot_dim):
    half = rot_dim // 2
    inv = ROPE_THETA ** (-jnp.arange(half, dtype=jnp.float32) / half)
    ang = pos.astype(jnp.float32)[:, None] * inv[None, :]
    cos = jnp.cos(ang)[:, None, :]
    sin = jnp.sin(ang)[:, None, :]
    xr = x[..., :rot_dim].astype(jnp.float32)
    x1, x2 = xr[..., :half], xr[..., half:]
    rot = jnp.concatenate([x1 * cos - x2 * sin, x2 * cos + x1 * sin], axis=-1)
    return jnp.concatenate([rot.astype(x.dtype), x[..., rot_dim:]], axis=-1)


def split_proj(p):
    offs = [0] + [int(v) for v in np.cumsum([n for _, n in SPLITS])]
    return {name: p[..., offs[i]:offs[i + 1]] for i, (name, _) in enumerate(SPLITS)}


take_rows = jax.vmap(lambda a, i: a[i])


def index_scores(qi, wi, ki, q_pos, k_pos):
    dots = jnp.einsum("bthd,bld->bthl", qi.astype(jnp.float32), ki.astype(jnp.float32))
    s = jnp.einsum("bth,bthl->btl", wi.astype(jnp.float32), jax.nn.relu(dots))
    return jnp.where(k_pos[None, None, :] <= q_pos[None, :, None], s, -jnp.inf)


def sparse_attend(q, k_sel, v_sel, valid):
    Bn, T = q.shape[:2]
    qg = q.reshape(Bn, T, N_KV_HEADS, GROUP, HEAD_DIM)
    logits = jnp.einsum("btkgd,btnkd->btkgn", qg, k_sel,
                        preferred_element_type=jnp.float32) * (HEAD_DIM ** -0.5)
    logits = jnp.where(valid[:, :, None, None, :], logits, -jnp.inf)
    probs = jax.nn.softmax(logits, axis=-1).astype(v_sel.dtype)
    o = jnp.einsum("btkgn,btnkd->btkgd", probs, v_sel)
    return o.reshape(Bn, T, N_HEADS * HEAD_DIM)


def prompt_sparse_attention(q, k, v, qi, ki, wi):
    Bn, S = q.shape[:2]
    topk = min(TOPK_MAX, S // 4)
    nb = S // Q_BLOCK
    k_pos = jnp.arange(S)

    def blk(args):
        qb, qib, wib, tb = args
        sc = index_scores(qib, wib, ki, tb, k_pos)
        _, idx = lax.top_k(sc, topk)
        valid = idx <= tb[None, :, None]
        return sparse_attend(qb, take_rows(k, idx), take_rows(v, idx), valid)

    def to_blocks(a):
        return a.reshape(Bn, nb, Q_BLOCK, *a.shape[2:]).swapaxes(0, 1)

    out = lax.map(blk, (to_blocks(q), to_blocks(qi), to_blocks(wi), k_pos.reshape(nb, Q_BLOCK)))
    return out.swapaxes(0, 1).reshape(Bn, S, D_ATTN)


def sample_sparse_attention(q, k_new, v_new, qi, ki_new, wi, cache_k, cache_v, cache_kidx, page_table):
    Bd, T = q.shape[:2]
    past = page_table.shape[1] * PAGE_SIZE
    L = past + T
    topk = min(TOPK_MAX, L // 4)
    ki_past = cache_kidx[page_table].reshape(Bd, past, IDX_DIM)
    ki_all = jnp.concatenate([ki_past, ki_new], axis=1)
    q_pos = past + jnp.arange(T)
    sc = index_scores(qi, wi, ki_all, q_pos, jnp.arange(L))
    _, idx = lax.top_k(sc, topk)
    valid = idx <= q_pos[None, :, None]
    in_past = idx < past
    pidx = jnp.minimum(idx, past - 1)
    phys = jax.vmap(lambda pt, i: pt[i])(page_table, pidx // PAGE_SIZE)
    off = pidx % PAGE_SIZE
    nidx = jnp.clip(idx - past, 0, T - 1)

    def sel(pool, new):
        return jnp.where(in_past[..., None, None], pool[phys, off], take_rows(new, nidx))

    return sparse_attend(q, sel(cache_k, k_new), sel(cache_v, v_new), valid)


def short_conv(u, buf, w_conv):
    T = u.shape[1]
    padded = jnp.concatenate([buf, u], axis=1)
    y = padded[:, 0:T] * w_conv[0]
    for j in range(1, CONV_W):
        y = y + padded[:, j:j + T] * w_conv[j]
    return y, padded[:, -(CONV_W - 1):]


def mixer_layer(x, pos, conv_buf, attn_fn, norm_in, w_in, g_q, g_k, g_kidx, w_conv, w_out):
    Bn, T, _ = x.shape
    p = split_proj(rmsnorm(x, norm_in) @ w_in)
    q = partial_rope(rmsnorm(p["q"].reshape(Bn, T, N_HEADS, HEAD_DIM), g_q), pos, ROPE_DIM)
    k = partial_rope(rmsnorm(p["k"].reshape(Bn, T, N_KV_HEADS, HEAD_DIM), g_k), pos, ROPE_DIM)
    v = p["v"].reshape(Bn, T, N_KV_HEADS, HEAD_DIM)
    qi = partial_rope(p["q_idx"].reshape(Bn, T, N_IDX_HEADS, IDX_DIM), pos, IDX_ROPE_DIM)
    ki = partial_rope(rmsnorm(p["k_idx"], g_kidx)[:, :, None, :], pos, IDX_ROPE_DIM)[:, :, 0]
    wi = p["w_idx"] * ((N_IDX_HEADS ** -0.5) * (IDX_DIM ** -0.5))
    attn = attn_fn(q, k, v, qi, ki, wi)
    conv, new_buf = short_conv(p["c"] * p["h"], conv_buf, w_conv)
    mix = jnp.concatenate([attn * jax.nn.silu(p["z_attn"]),
                           p["b"] * conv * jax.nn.silu(p["z_conv"])], axis=-1)
    return x + mix @ w_out, k, v, ki, new_buf


def setup_inputs(seed: int = 0) -> dict:
    key = jax.random.key(seed)
    ks = jax.random.split(key, 16)
    f32 = jnp.float32
    n_pages = PAST_LEN // PAGE_SIZE
    n_used = DEC_BATCH * n_pages
    n_pool = n_used + max(1, n_used // 4)

    def nrm(k, shape, s):
        return jax.random.normal(k, shape, f32) * s

    page_table = jax.random.permutation(ks[6], n_pool)[:n_used].reshape(DEC_BATCH, n_pages).astype(jnp.int32)
    return {
        "x_prompt": nrm(ks[0], (BATCH, SEQ, D_MODEL), 1.0),
        "x_sample": nrm(ks[1], (DEC_BATCH, DEC_SEQ, D_MODEL), 1.0),
        "cache_k": nrm(ks[2], (DEPTH, n_pool, PAGE_SIZE, N_KV_HEADS, HEAD_DIM), 1.0),
        "cache_v": nrm(ks[3], (DEPTH, n_pool, PAGE_SIZE, N_KV_HEADS, HEAD_DIM), 1.0),
        "cache_kidx": nrm(ks[4], (DEPTH, n_pool, PAGE_SIZE, IDX_DIM), 1.0),
        "state_conv": nrm(ks[5], (DEPTH, DEC_BATCH, CONV_W - 1, D_CONV), 1.0),
        "page_table": page_table,
        "norm_in": 1.0 + nrm(ks[7], (DEPTH, D_MODEL), 0.02),
        "w_in": nrm(ks[8], (DEPTH, D_MODEL, D_IN), D_MODEL ** -0.5),
        "g_q": 1.0 + nrm(ks[9], (DEPTH, HEAD_DIM), 0.02),
        "g_k": 1.0 + nrm(ks[10], (DEPTH, HEAD_DIM), 0.02),
        "g_kidx": 1.0 + nrm(ks[11], (DEPTH, IDX_DIM), 0.02),
        "w_conv": nrm(ks[12], (DEPTH, CONV_W, D_CONV), CONV_W ** -0.5),
        "w_out": nrm(ks[13], (DEPTH, D_MIX, D_MODEL), D_MIX ** -0.5),
    }


def reference(x_prompt, x_sample, cache_k, cache_v, cache_kidx, state_conv, page_table,
              norm_in, w_in, g_q, g_k, g_kidx, w_conv, w_out):
    Bp, S, _ = x_prompt.shape
    Bd, T, _ = x_sample.shape
    past = page_table.shape[1] * PAGE_SIZE
    pos_p = jnp.arange(S)
    pos_s = past + jnp.arange(T)
    hp, hs = x_prompt, x_sample
    kp, vp, kip, cp, ks_, vs, kis, cs = [], [], [], [], [], [], [], []
    for l in range(DEPTH):
        lw = (norm_in[l], w_in[l], g_q[l], g_k[l], g_kidx[l], w_conv[l], w_out[l])
        zero_buf = jnp.zeros((Bp, CONV_W - 1, D_CONV), x_prompt.dtype)
        hp, k1, v1, ki1, c1 = mixer_layer(hp, pos_p, zero_buf, prompt_sparse_attention, *lw)
        ck, cv, cki = cache_k[l], cache_v[l], cache_kidx[l]

        def attn_s(q, k, v, qi, ki, wi, ck=ck, cv=cv, cki=cki):
            return sample_sparse_attention(q, k, v, qi, ki, wi, ck, cv, cki, page_table)

        hs, k2, v2, ki2, c2 = mixer_layer(hs, pos_s, state_conv[l], attn_s, *lw)
        kp.append(k1); vp.append(v1); kip.append(ki1); cp.append(c1)
        ks_.append(k2); vs.append(v2); kis.append(ki2); cs.append(c2)
    return (hp, hs,
            jnp.stack(kp), jnp.stack(vp), jnp.stack(kip), jnp.stack(cp),
            jnp.stack(ks_), jnp.stack(vs), jnp.stack(kis), jnp.stack(cs))
```

```cpp
#include <hip/hip_runtime.h>
#include <cstdio>
#include <cstdint>
#include <cmath>

typedef _Float16 f16;
typedef unsigned short bf16_t;

constexpr int DM = 2048, NB = 4, S = 2048, NSB = 8, NST = 4, PAST = 16384, PAGE = 128, NPAGES = PAST / PAGE;
constexpr int MP = NB * S;
constexpr int MS = NSB * NST;
constexpr int MT = MP + MS;
constexpr int DIN = 7760;
constexpr int OQ = 0, OKK = 1024, OV = 1280, OZ = 1536, OQI = 2560, OKI = 3584, OWI = 3648, OH = 3664, OBB = 4688, OC = 5712, OZC = 6736;
constexpr int NH = 8, NKV = 2, HD = 128, NIH = 16, ID = 64, TOPK = 256, DC = 1024;
constexpr float EPS = 1e-6f;
constexpr size_t O_YP = 0, O_YS = 16777216, O_KP = 16842752, O_VP = 18939904, O_KIP = 21037056, O_CVP = 21561344,
                 O_KS = 21569536, O_VS = 21577728, O_KIS = 21585920, O_CVS = 21587968, O_END = 21604352;
constexpr size_t MiB = 1u << 20;
constexpr size_t WS_ROPE = 1 * MiB;
constexpr size_t WS_ROPE_I = WS_ROPE + 2052 * 32 * 4;
constexpr size_t WS_QB = 2 * MiB;
constexpr size_t WS_KB = 18 * MiB;
constexpr size_t WS_VB = 22 * MiB;
constexpr size_t WS_SZ = 26 * MiB;
constexpr size_t WS_QI = 43 * MiB;
constexpr size_t WS_KI = 60 * MiB;
constexpr size_t WS_WI = 61 * MiB;
constexpr size_t WS_U = 62 * MiB;
constexpr size_t WS_G = 79 * MiB;
constexpr size_t WS_MIX = 96 * MiB;
constexpr size_t WS_MASK = 130 * MiB;
constexpr size_t WS_SSC = 132 * MiB;
constexpr size_t WS_QS = 134 * MiB;
constexpr size_t WS_XN = 136 * MiB;
constexpr size_t WS_P = 202 * MiB;
constexpr size_t WS_NEED = 448 * MiB;

__device__ __forceinline__ bf16_t f2bf(float f) { unsigned u = __builtin_bit_cast(unsigned, f); return (bf16_t)((u + 0x7fffu + ((u >> 16) & 1u)) >> 16); }
__device__ __forceinline__ float bf2f(bf16_t h) { return __builtin_bit_cast(float, (unsigned)h << 16); }
__device__ __forceinline__ float silu(float z) { return z / (1.f + __expf(-z)); }
__device__ __forceinline__ unsigned fkey(float f) { unsigned u = __builtin_bit_cast(unsigned, f); return (u & 0x80000000u) ? ~u : (u | 0x80000000u); }

#define LAS __attribute__((address_space(3)))
#define GAS __attribute__((address_space(1)))
typedef _Float16 f16x8 __attribute__((ext_vector_type(8)));
typedef _Float16 f16x4 __attribute__((ext_vector_type(4)));
typedef _Float16 f16x2 __attribute__((ext_vector_type(2)));
typedef float f32x4 __attribute__((ext_vector_type(4)));
typedef float f32x2 __attribute__((ext_vector_type(2)));
typedef unsigned u32x4 __attribute__((ext_vector_type(4)));
typedef unsigned u32x2 __attribute__((ext_vector_type(2)));
typedef __bf16 bf16x2_t __attribute__((ext_vector_type(2)));
namespace pg8 {
constexpr int BM = 256, BK = 64, HALF = 128, HTB = HALF * BK * 2, STAGE_BYTES = 8 * HTB, NXCD = 8, WGM = 8;
__host__ __device__ __forceinline__ int lds_byte(int r, int c) { const int st = (r >> 4) * 2 + (c >> 5), rr = r & 15, cc = c & 31, ob = rr * 64 + cc * 2; return st * 1024 + (ob ^ (((ob >> 9) & 1) << 5)); }
__host__ __device__ __forceinline__ void stage_rc(int b, int& R, int& C) { const int st = b / 1024, sb = b % 1024, swz = sb ^ (((sb >> 9) & 1) << 5); R = (st >> 1) * 16 + swz / 64; C = (st & 1) * 32 + (swz % 64) / 2; }
struct Unit { int pm, pn; };
struct Gemm { const f16* A; const f16* Bt; int K; };
struct StaticOrder {
    int nM, nN, nwg, G, c;
    __device__ void init(int nM_, int nN_, int G_, int c_) { nM = nM_; nN = nN_; nwg = nM * nN; G = G_; c = c_; }
    __device__ bool next(int i, Unit& u) const {
        const long L = (long)i * G + c; if (L >= nwg) return false;
        int wgid = (int)L; { const int q = nwg / NXCD, r = nwg % NXCD, xcd = wgid % NXCD, off = wgid / NXCD; wgid = (xcd < r ? xcd * (q + 1) : r * (q + 1) + (xcd - r) * q) + off; }
        const int nig = WGM * nN, gid = wgid / nig, fm = gid * WGM, gsz = (nM - fm) < WGM ? (nM - fm) : WGM;
        u.pm = fm + ((wgid % nig) % gsz); u.pn = (wgid % nig) / gsz; return true;
    }
};
template <class Epi, class Sched>
__device__ __forceinline__ void gemm_phase(LAS unsigned char* lds, const Gemm g, const Sched& S, const Epi& E) {
    const int tid = threadIdx.x, wid = __builtin_amdgcn_readfirstlane(tid >> 6), lane = tid & 63, wr = wid >> 2, wc = wid & 3, fr = lane & 15, fq = lane >> 4;
    const int K = g.K, nt = K / BK;
    unsigned voffA[2];
#pragma unroll
    for (int i = 0; i < 2; ++i) { int R, C; stage_rc(tid * 16 + i * 8192, R, C); voffA[i] = (unsigned)(R * K + C) * 2u; }
    const size_t kstep = (size_t)(BK * 2);
    const size_t hstep = (size_t)HALF * K * 2;
    const size_t tstep = 2 * hstep;
    const unsigned ldsw = (unsigned)wid * 1024u;
    const int aoff = lds_byte(wr * 64 + fr, fq * 8), boff = lds_byte(wc * 32 + fr, fq * 8);
#define PG8_SA(b, h) (((b) * 2 + (h)) * HTB)
#define PG8_SB(b, h) ((4 + (b) * 2 + (h)) * HTB)
#define PG8_STAGE(bufoff, gbase) do { _Pragma("unroll") for (int _i = 0; _i < 2; ++_i) \
        __builtin_amdgcn_global_load_lds((const unsigned*)((const char*)(gbase) + voffA[_i]), (LAS unsigned*)(lds + (bufoff) + ldsw + _i * 8192), 16, 0, 0); } while (0)
#define PG8_LDA(dst, b, h) do { _Pragma("unroll") for (int m = 0; m < 4; ++m) _Pragma("unroll") for (int k = 0; k < 2; ++k) dst[m][k] = *(const LAS f16x8*)(lds + PG8_SA(b, h) + aoff + m * 2048 + k * 1024); } while (0)
#define PG8_LDB(dst, b, h) do { _Pragma("unroll") for (int n = 0; n < 2; ++n) _Pragma("unroll") for (int k = 0; k < 2; ++k) dst[n][k] = *(const LAS f16x8*)(lds + PG8_SB(b, h) + boff + n * 2048 + k * 1024); } while (0)
#define PG8_MMA(ai, bj, At, Bt) do { __builtin_amdgcn_s_setprio(1); _Pragma("unroll") for (int m = 0; m < 4; ++m) _Pragma("unroll") for (int n = 0; n < 2; ++n) _Pragma("unroll") for (int k = 0; k < 2; ++k) \
        acc[ai][bj][m][n] = __builtin_amdgcn_mfma_f32_16x16x32_f16(Bt[n][k], At[m][k], acc[ai][bj][m][n], 0, 0, 0); __builtin_amdgcn_s_setprio(0); } while (0)
#define PG8_WAIT_V(n) asm volatile("s_waitcnt vmcnt(" #n ")" ::: "memory")
#define PG8_WAIT_L(n) asm volatile("s_waitcnt lgkmcnt(" #n ")" ::: "memory")
#define PG8_BAR __builtin_amdgcn_s_barrier()
#define PG8_SCHED __builtin_amdgcn_sched_barrier(0)
    Unit cur, nxt; int ui = 0;
    if (!S.next(0, cur)) return;
    f32x4 acc[2][2][4][2];
#pragma unroll
    for (int a = 0; a < 2; ++a)
#pragma unroll
        for (int b = 0; b < 2; ++b)
#pragma unroll
            for (int m = 0; m < 4; ++m)
#pragma unroll
                for (int n = 0; n < 2; ++n) acc[a][b][m][n] = (f32x4){0.f, 0.f, 0.f, 0.f};
    f16x8 At[4][2], B0[2][2], B1[2][2];
    const char* cA = (const char*)g.A + (size_t)cur.pm * tstep; const char* cB = (const char*)g.Bt + (size_t)cur.pn * tstep;
    PG8_STAGE(PG8_SB(0, 0), cB); PG8_STAGE(PG8_SB(0, 1), cB + hstep); PG8_STAGE(PG8_SA(0, 0), cA); PG8_STAGE(PG8_SA(0, 1), cA + hstep);
    if (wr == 1) PG8_BAR;
    PG8_WAIT_V(2); PG8_BAR;
    PG8_STAGE(PG8_SB(1, 0), cB + kstep); PG8_STAGE(PG8_SA(1, 0), cA + kstep); PG8_STAGE(PG8_SB(1, 1), cB + hstep + kstep);
    PG8_WAIT_V(6); PG8_BAR;
    for (;;) {
        const bool has_next = S.next(ui + 1, nxt);
        const char* nA = has_next ? (const char*)g.A + (size_t)nxt.pm * tstep : cA; const char* nB = has_next ? (const char*)g.Bt + (size_t)nxt.pn * tstep : cB;
        for (int t = 0; t < nt; t += 2) {
            const bool last = (t == nt - 2);
            const char* a1 = cA + (size_t)(t + 1) * kstep;
            const char* a2 = last ? nA : cA + (size_t)(t + 2) * kstep; const char* b2 = last ? nB : cB + (size_t)(t + 2) * kstep;
            const char* a3 = a2 + kstep; const char* b3 = b2 + kstep;
            PG8_LDB(B0, 0, 0); PG8_LDB(B1, 0, 1); PG8_SCHED; PG8_LDA(At, 0, 0); PG8_STAGE(PG8_SA(1, 1), a1 + hstep);
            PG8_WAIT_V(8); PG8_WAIT_L(0); PG8_BAR; PG8_MMA(0, 0, At, B0); PG8_MMA(0, 1, At, B1); PG8_BAR; PG8_SCHED;
            PG8_LDA(At, 0, 1); PG8_STAGE(PG8_SB(0, 0), b2); PG8_STAGE(PG8_SB(0, 1), b2 + hstep); PG8_STAGE(PG8_SA(0, 0), a2);
            PG8_WAIT_V(8); PG8_WAIT_L(0); PG8_BAR; PG8_MMA(1, 0, At, B0); PG8_MMA(1, 1, At, B1); PG8_BAR; PG8_SCHED;
            PG8_LDB(B0, 1, 0); PG8_LDB(B1, 1, 1); PG8_SCHED; PG8_LDA(At, 1, 0); PG8_STAGE(PG8_SA(0, 1), a2 + hstep);
            PG8_WAIT_V(8); PG8_WAIT_L(0); PG8_BAR; PG8_MMA(0, 0, At, B0); PG8_MMA(0, 1, At, B1); PG8_BAR; PG8_SCHED;
            PG8_LDA(At, 1, 1); PG8_STAGE(PG8_SB(1, 0), b3); PG8_STAGE(PG8_SB(1, 1), b3 + hstep); PG8_STAGE(PG8_SA(1, 0), a3);
            PG8_WAIT_V(8); PG8_WAIT_L(0); PG8_BAR; PG8_MMA(1, 0, At, B0); PG8_MMA(1, 1, At, B1); PG8_BAR; PG8_SCHED;
        }
        if (wr == 0) PG8_BAR;
        E(acc, cur, wr, wc, fr, fq);
        if (!has_next) break;
#pragma unroll
        for (int a = 0; a < 2; ++a)
#pragma unroll
            for (int b = 0; b < 2; ++b)
#pragma unroll
                for (int m = 0; m < 4; ++m)
#pragma unroll
                    for (int n = 0; n < 2; ++n) acc[a][b][m][n] = (f32x4){0.f, 0.f, 0.f, 0.f};
        cur = nxt; cA = nA; cB = nB; ++ui;
        if (wr == 1) PG8_BAR;
    }
    PG8_WAIT_V(0);
    PG8_BAR;
#undef PG8_SA
#undef PG8_SB
#undef PG8_STAGE
#undef PG8_LDA
#undef PG8_LDB
#undef PG8_MMA
#undef PG8_WAIT_V
#undef PG8_WAIT_L
#undef PG8_BAR
#undef PG8_SCHED
}
}
constexpr int NWAVES = 8;
constexpr int MPAD = 8448, NPAD = 7936;
constexpr size_t WS_XNH = 450 * MiB;
constexpr size_t WS_WINT = 484 * MiB;
constexpr size_t WS_WOUTT = 516 * MiB;
constexpr size_t WS_NEED2 = 524 * MiB;
constexpr int RING_BYTES = 131072, SCR_OFF = RING_BYTES, SCR_BYTES = 8192, MISC_OFF = 145408, LDS_BYTES = 147456;

__device__ __forceinline__ unsigned pk_bf16(float lo, float hi) { f32x2 v = {lo, hi}; bf16x2_t b = __builtin_convertvector(v, bf16x2_t); return __builtin_bit_cast(unsigned, b); }
__device__ __forceinline__ unsigned pk_f16(float lo, float hi) { f32x2 v = {lo, hi}; f16x2 b = __builtin_convertvector(v, f16x2); return __builtin_bit_cast(unsigned, b); }

struct Args { const float* in[14]; float* out; unsigned char* ws; int ph_lo, ph_hi; };

__device__ __forceinline__ int win_src(int np) {
    const int pn = np >> 8, c = np & 255;
    if (pn < 14) return np;
    if (pn == 14) return c < 80 ? np : -1;
    const int T = pn - 15, bj = c >> 7, wc = (c >> 5) & 3, n = (c >> 4) & 1, fqi = c & 15;
    const int base = bj == 0 ? (n == 0 ? OH : OBB) : (n == 0 ? OC : OZC);
    return base + 64 * T + 16 * wc + fqi;
}
template <bool MAP>
__device__ __forceinline__ void p0_transpose_item(const float* W, int N, f16* WT, LAS float* scr, int item, int nblk, int lane) {
    const int kb = item / nblk, nb = item % nblk, k0 = 64 * kb, n0 = 32 * nb;
    const int src = MAP ? win_src(n0 + (lane & 31)) : n0 + (lane & 31);
#pragma unroll 8
    for (int i = 0; i < 32; ++i) { const int kk = 2 * i + (lane >> 5); scr[kk * 33 + (lane & 31)] = src >= 0 ? W[(size_t)(k0 + kk) * N + src] : 0.f; }
    asm volatile("s_waitcnt lgkmcnt(0)" ::: "memory");
    const int c = lane & 7;
#pragma unroll
    for (int j = 0; j < 4; ++j) { const int n = (lane >> 3) + 8 * j; const LAS float* s = scr + (8 * c) * 33 + n;
        u32x4 o; o.x = pk_f16(s[0 * 33], s[1 * 33]); o.y = pk_f16(s[2 * 33], s[3 * 33]); o.z = pk_f16(s[4 * 33], s[5 * 33]); o.w = pk_f16(s[6 * 33], s[7 * 33]);
        *(u32x4*)(WT + (size_t)(n0 + n) * 2048 + k0 + 8 * c) = o; }
    asm volatile("s_waitcnt lgkmcnt(0)" ::: "memory");
}
__device__ __forceinline__ float wave_sum(float v) {
#pragma unroll
    for (int o = 1; o < 64; o <<= 1) v += __shfl_xor(v, o);
    return v;
}
__device__ __forceinline__ void p0_prologue(const Args& a, LAS unsigned char* lds, int vcu, int G, int wave, int lane) {
    LAS float* scr = (LAS float*)(lds + wave * 16384);
    const int gw = vcu * NWAVES + wave, NGW = G * NWAVES;
    const float* win = a.in[8]; const float* wout = a.in[13];
    f16* WinT = (f16*)(a.ws + WS_WINT); f16* WoutT = (f16*)(a.ws + WS_WOUTT); f16* XN = (f16*)(a.ws + WS_XNH);
    constexpr int I_IN = 32 * (NPAD / 32), I_OUT = 32 * (DM / 32);
    for (int it = gw; it < I_IN + I_OUT; it += NGW) {
        if (it < I_IN) p0_transpose_item<true>(win, DIN, WinT, scr, it, NPAD / 32, lane);
        else p0_transpose_item<false>(wout, DM, WoutT, scr, it - I_IN, DM / 32, lane);
    }
    const float* gin = a.in[7];
    for (int m = gw; m < MT; m += NGW) {
        const float* xrow = m < MP ? a.in[0] + (size_t)m * DM : a.in[1] + (size_t)(m - MP) * DM;
        const f32x4* xr = (const f32x4*)xrow + lane; f32x4 v[8]; float s = 0.f;
#pragma unroll
        for (int j = 0; j < 8; ++j) { v[j] = xr[64 * j]; s += (v[j].x * v[j].x + v[j].y * v[j].y) + (v[j].z * v[j].z + v[j].w * v[j].w); }
        const float rs = rsqrtf(wave_sum(s) * (1.f / DM) + EPS);
        u32x2* o8 = (u32x2*)(XN + (size_t)m * DM) + lane;
#pragma unroll
        for (int j = 0; j < 8; ++j) { const f32x4 gv = ((const f32x4*)gin)[lane + 64 * j]; u32x2 w; w.x = pk_f16(v[j].x * rs * gv.x, v[j].y * rs * gv.y); w.y = pk_f16(v[j].z * rs * gv.z, v[j].w * rs * gv.w); o8[64 * j] = w; }
    }
    float* rqk = (float*)(a.ws + WS_ROPE); float* ri = (float*)(a.ws + WS_ROPE_I);
    for (int i = gw * 64 + lane; i < 2052 * 16; i += NGW * 64) {
        { int slot = i / 16, j = i % 16; int pos = slot < 2048 ? slot : PAST + (slot - 2048);
          float inv = (float)pow(500000.0, -(double)j / 16.0); float ang = (float)pos * inv;
          rqk[(slot * 16 + j) * 2] = (float)cos((double)ang); rqk[(slot * 16 + j) * 2 + 1] = (float)sin((double)ang); }
        if (i < 2052 * 8) { int slot = i / 8, j = i % 8; int pos = slot < 2048 ? slot : PAST + (slot - 2048);
          float inv = (float)pow(500000.0, -(double)j / 8.0); float ang = (float)pos * inv;
          ri[(slot * 8 + j) * 2] = (float)cos((double)ang); ri[(slot * 8 + j) * 2 + 1] = (float)sin((double)ang); }
    }
}

struct EpiIn {
    float* out; unsigned char* ws; const float* gq; const float* gk; const float* gki; LAS float* scr;
    __device__ __forceinline__ void operator()(f32x4 (&acc)[2][2][4][2], const pg8::Unit& u, int wr, int wc, int fr_, int fq_) const {
        int fr = fr_, fq = fq_; asm volatile("" : "+v"(fr), "+v"(fq));
        GAS unsigned char* ws = (GAS unsigned char*)this->ws; GAS float* out = (GAS float*)this->out; asm volatile("" : "+s"(ws), "+s"(out));
        const int pn = u.pn, pm = u.pm; const bool smp = pm == 32;
        const int rbase = 64 * wr + fr;
        const int bb = pm >> 3, t0 = (pm & 7) << 8;
        const GAS float* rqk = (const GAS float*)(ws + WS_ROPE); const GAS float* ri = (const GAS float*)(ws + WS_ROPE_I);
#define ROWLOOP _Pragma("unroll") for (int ai = 0; ai < 2; ++ai) _Pragma("unroll") for (int m = 0; m < 4; ++m)
#define ROWVARS const int r = rbase + 128 * ai + 16 * m; const bool valid = !smp || r < MS; const int grow = smp ? MP + r : pm * 256 + r; const int tt = smp ? (r & 3) : t0 + r; const int slot = smp ? 2048 + (r & 3) : tt; (void)grow; (void)tt; (void)slot; (void)valid;
        if (pn <= 4 || pn == 14) {
            const bool isk = pn == 14;
            ROWLOOP { asm volatile("" ::: "memory"); const int r = rbase + 128 * ai + 16 * m;
#pragma unroll
                for (int bj = 0; bj < 2; ++bj) { float s = 0.f;
#pragma unroll
                    for (int n = 0; n < 2; ++n) { const f32x4 x = acc[ai][bj][m][n]; s += (x[0] * x[0] + x[1] * x[1]) + (x[2] * x[2] + x[3] * x[3]); }
                    if (isk && (wc >= 2 || bj == 1)) s = 0.f;
                    s += __shfl_xor(s, 16); s += __shfl_xor(s, 32);
                    if (fq == 0) scr[(r * 2 + bj) * 4 + wc] = s; } }
            asm volatile("s_waitcnt lgkmcnt(0)" ::: "memory"); __builtin_amdgcn_s_barrier(); asm volatile("" ::: "memory");
            if (!isk) {
                const GAS float* g = (const GAS float*)(pn < 4 ? gq : gk); const int dl = 32 * wc + 4 * fq;
                const f32x4 g0 = *(const GAS f32x4*)(g + dl), g1 = *(const GAS f32x4*)(g + dl + 16);
                GAS bf16_t* Qb = (GAS bf16_t*)(ws + WS_QB); GAS bf16_t* Kb = (GAS bf16_t*)(ws + WS_KB); GAS float* QS = (GAS float*)(ws + WS_QS);
                ROWLOOP { asm volatile("" ::: "memory"); ROWVARS
                    f32x4 cs0 = {1.f, 0.f, 1.f, 0.f}, cs1 = {1.f, 0.f, 1.f, 0.f};
                    if (wc == 0) { const GAS f32x4* cp = (const GAS f32x4*)(rqk + (slot * 16 + 4 * fq) * 2); cs0 = cp[0]; cs1 = cp[1]; }
#pragma unroll
                    for (int bj = 0; bj < 2; ++bj) {
                        const f32x4 p = *(const LAS f32x4*)(scr + (r * 2 + bj) * 4);
                        const float rs = rsqrtf(((p[0] + p[1]) + (p[2] + p[3])) * (1.f / 128.f) + EPS);
                        f32x4 x0 = acc[ai][bj][m][0] * rs * g0, x1 = acc[ai][bj][m][1] * rs * g1;
                        if (wc == 0) { const f32x4 c = {cs0[0], cs0[2], cs1[0], cs1[2]}, s = {cs0[1], cs0[3], cs1[1], cs1[3]};
                            const f32x4 y0 = x0 * c - x1 * s, y1 = x1 * c + x0 * s; x0 = y0; x1 = y1; }
                        const int hh = 2 * pn + bj;
                        if (pn < 4) {
                            if (smp) { if (valid) { GAS float* q = QS + (size_t)r * 1024 + hh * 128 + dl; *(GAS f32x4*)q = x0; *(GAS f32x4*)(q + 16) = x1; } }
                            else { GAS bf16_t* q = Qb + (((size_t)bb * NH + hh) * S + tt) * HD + dl;
                                u32x2 w0 = {pk_bf16(x0[0], x0[1]), pk_bf16(x0[2], x0[3])}, w1 = {pk_bf16(x1[0], x1[1]), pk_bf16(x1[2], x1[3])};
                                *(GAS u32x2*)q = w0; *(GAS u32x2*)(q + 16) = w1; }
                        } else {
                            if (smp) { if (valid) { GAS float* k = out + O_KS + (size_t)r * 256 + bj * 128 + dl; *(GAS f32x4*)k = x0; *(GAS f32x4*)(k + 16) = x1; } }
                            else { GAS float* k = out + O_KP + (size_t)grow * 256 + bj * 128 + dl; *(GAS f32x4*)k = x0; *(GAS f32x4*)(k + 16) = x1;
                                GAS bf16_t* kb = Kb + (((size_t)bb * NKV + bj) * S + tt) * HD + dl;
                                u32x2 w0 = {pk_bf16(x0[0], x0[1]), pk_bf16(x0[2], x0[3])}, w1 = {pk_bf16(x1[0], x1[1]), pk_bf16(x1[2], x1[3])};
                                *(GAS u32x2*)kb = w0; *(GAS u32x2*)(kb + 16) = w1; }
                        } } }
            } else {
                const int dl = 32 * (wc & 1) + 4 * fq;
                const f32x4 g0 = *(const GAS f32x4*)((const GAS float*)gki + dl), g1 = *(const GAS f32x4*)((const GAS float*)gki + dl + 16);
                GAS f16* KI = (GAS f16*)(ws + WS_KI); GAS float* WI = (GAS float*)(ws + WS_WI);
                ROWLOOP { asm volatile("" ::: "memory"); ROWVARS
                    const f32x4 p = *(const LAS f32x4*)(scr + (r * 2) * 4);
                    const float rs = rsqrtf((p[0] + p[1]) * (1.f / 64.f) + EPS);
                    f32x4 x0 = acc[ai][0][m][0] * rs * g0, x1 = acc[ai][0][m][1] * rs * g1;
                    f32x4 xo; xo[0] = __shfl_xor(x0[0], 32); xo[1] = __shfl_xor(x0[1], 32); xo[2] = __shfl_xor(x0[2], 32); xo[3] = __shfl_xor(x0[3], 32);
                    if (wc == 0) { const GAS f32x4* cp = (const GAS f32x4*)(ri + (slot * 8 + 4 * (fq & 1)) * 2); const f32x4 cs0 = cp[0], cs1 = cp[1];
                        const f32x4 c = {cs0[0], cs0[2], cs1[0], cs1[2]}, s = {cs0[1], cs0[3], cs1[1], cs1[3]};
                        x0 = fq < 2 ? x0 * c - xo * s : x0 * c + xo * s; }
                    if (wc < 2 && valid) {
                        GAS float* ko = smp ? out + O_KIS + (size_t)r * 64 + dl : out + O_KIP + (size_t)grow * 64 + dl;
                        *(GAS f32x4*)ko = x0; *(GAS f32x4*)(ko + 16) = x1;
                        if (!smp) { GAS f16* kh = KI + (size_t)grow * 64 + dl; u32x2 w0 = {pk_f16(x0[0], x0[1]), pk_f16(x0[2], x0[3])}, w1 = {pk_f16(x1[0], x1[1]), pk_f16(x1[2], x1[3])};
                            *(GAS u32x2*)kh = w0; *(GAS u32x2*)(kh + 16) = w1; } }
                    if (wc == 2 && valid) *(GAS f32x4*)(WI + (size_t)grow * 16 + 4 * fq) = acc[ai][0][m][0] * (1.f / 32.f);
                }
            }
        } else if (pn == 5) {
            GAS bf16_t* Vb = (GAS bf16_t*)(ws + WS_VB); const int dl = 32 * wc + 4 * fq;
            ROWLOOP { asm volatile("" ::: "memory"); ROWVARS
#pragma unroll
                for (int bj = 0; bj < 2; ++bj) { const f32x4 x0 = acc[ai][bj][m][0], x1 = acc[ai][bj][m][1];
                    if (smp) { if (valid) { GAS float* v = out + O_VS + (size_t)r * 256 + bj * 128 + dl; *(GAS f32x4*)v = x0; *(GAS f32x4*)(v + 16) = x1; } }
                    else { GAS float* v = out + O_VP + (size_t)grow * 256 + bj * 128 + dl; *(GAS f32x4*)v = x0; *(GAS f32x4*)(v + 16) = x1;
                        GAS bf16_t* vb = Vb + (((size_t)bb * NKV + bj) * S + tt) * HD + dl;
                        u32x2 w0 = {pk_bf16(x0[0], x0[1]), pk_bf16(x0[2], x0[3])}, w1 = {pk_bf16(x1[0], x1[1]), pk_bf16(x1[2], x1[3])};
                        *(GAS u32x2*)vb = w0; *(GAS u32x2*)(vb + 16) = w1; } } }
        } else if (pn <= 9) {
            GAS f16* SZ = (GAS f16*)(ws + WS_SZ); const int c0 = 256 * (pn - 6) + 32 * wc + 4 * fq;
            ROWLOOP { asm volatile("" ::: "memory"); ROWVARS
                if (valid) {
#pragma unroll
                    for (int bj = 0; bj < 2; ++bj)
#pragma unroll
                        for (int n = 0; n < 2; ++n) { const f32x4 x = acc[ai][bj][m][n]; u32x2 w = {pk_f16(silu(x[0]), silu(x[1])), pk_f16(silu(x[2]), silu(x[3]))};
                            *(GAS u32x2*)(SZ + (size_t)grow * 1024 + c0 + 128 * bj + 16 * n) = w; } } }
        } else if (pn <= 13) {
            GAS f16* QI = (GAS f16*)(ws + WS_QI); const int c0 = 256 * (pn - 10) + 32 * wc + 4 * fq;
            ROWLOOP { asm volatile("" ::: "memory"); ROWVARS
                f32x4 c = {1.f, 1.f, 1.f, 1.f}, s = {0.f, 0.f, 0.f, 0.f};
                if ((wc & 1) == 0) { const GAS f32x4* cp = (const GAS f32x4*)(ri + (slot * 8 + 4 * (fq & 1)) * 2); const f32x4 cs0 = cp[0], cs1 = cp[1];
                    c = (f32x4){cs0[0], cs0[2], cs1[0], cs1[2]}; s = (f32x4){cs0[1], cs0[3], cs1[1], cs1[3]}; }
#pragma unroll
                for (int bj = 0; bj < 2; ++bj) { f32x4 x0 = acc[ai][bj][m][0]; const f32x4 x1 = acc[ai][bj][m][1];
                    f32x4 xo; xo[0] = __shfl_xor(x0[0], 32); xo[1] = __shfl_xor(x0[1], 32); xo[2] = __shfl_xor(x0[2], 32); xo[3] = __shfl_xor(x0[3], 32);
                    if ((wc & 1) == 0) x0 = fq < 2 ? x0 * c - xo * s : x0 * c + xo * s;
                    if (valid) { GAS f16* q = QI + (size_t)grow * 1024 + c0 + 128 * bj;
                        u32x2 w0 = {pk_f16(x0[0], x0[1]), pk_f16(x0[2], x0[3])}, w1 = {pk_f16(x1[0], x1[1]), pk_f16(x1[2], x1[3])};
                        *(GAS u32x2*)q = w0; *(GAS u32x2*)(q + 16) = w1; } } }
        } else {
            GAS f16* U = (GAS f16*)(ws + WS_U); GAS f16* G = (GAS f16*)(ws + WS_G); const int ch = 64 * (pn - 15) + 16 * wc + 4 * fq;
            ROWLOOP { asm volatile("" ::: "memory"); ROWVARS
                const f32x4 h = acc[ai][0][m][0], b = acc[ai][0][m][1], c = acc[ai][1][m][0], z = acc[ai][1][m][1];
                const f32x4 uu = c * h; f32x4 gg; gg[0] = b[0] * silu(z[0]); gg[1] = b[1] * silu(z[1]); gg[2] = b[2] * silu(z[2]); gg[3] = b[3] * silu(z[3]);
                if (valid) { u32x2 wu = {pk_f16(uu[0], uu[1]), pk_f16(uu[2], uu[3])}, wg = {pk_f16(gg[0], gg[1]), pk_f16(gg[2], gg[3])};
                    *(GAS u32x2*)(U + (size_t)grow * 1024 + ch) = wu; *(GAS u32x2*)(G + (size_t)grow * 1024 + ch) = wg;
                    if (!smp && tt >= S - 2) *(GAS f32x4*)(out + O_CVP + ((size_t)bb * 2 + (tt - (S - 2))) * 1024 + ch) = uu;
                    if (smp && tt >= 2) *(GAS f32x4*)(out + O_CVS + ((size_t)(r >> 2) * 2 + (tt - 2)) * 1024 + ch) = uu; } }
        }
#undef ROWLOOP
#undef ROWVARS
    }
};


struct EpiOut {
    float* out; const float* xp;
    __device__ __forceinline__ void operator()(f32x4 (&acc)[2][2][4][2], const pg8::Unit& u, int wr, int wc, int fr_, int fq_) const {
        int fr = fr_, fq = fq_; asm volatile("" : "+v"(fr), "+v"(fq));
        GAS float* out = (GAS float*)this->out; const GAS float* xp = (const GAS float*)this->xp; asm volatile("" : "+s"(out), "+s"(xp));
        const size_t base = (size_t)(u.pm * 256 + 64 * wr + fr) * DM + u.pn * 256 + 32 * wc + 4 * fq;
#pragma unroll
        for (int ai = 0; ai < 2; ++ai)
#pragma unroll
            for (int m = 0; m < 4; ++m) { asm volatile("" ::: "memory"); const size_t off = base + (size_t)(128 * ai + 16 * m) * DM;
#pragma unroll
                for (int bj = 0; bj < 2; ++bj)
#pragma unroll
                    for (int n = 0; n < 2; ++n) { const f32x4 xv = *(const GAS f32x4*)(xp + off + 128 * bj + 16 * n); *(GAS f32x4*)(out + off + 128 * bj + 16 * n) = xv + acc[ai][bj][m][n]; } }
    }
};
__device__ __forceinline__ void p4_sample(const Args& a, LAS unsigned char* lds, int bx, int G, int tid) {
    const f16* MIX = (const f16*)(a.ws + WS_MIX) + (size_t)MP * DM; const f16* WT = (const f16*)(a.ws + WS_WOUTT);
    LAS float* part = (LAS float*)lds;
    const int r = tid & 31, cn = (tid >> 5) & 7, ks = tid >> 8;
    for (int cg = bx; cg < DM / 8; cg += G) {
        const int col = cg * 8 + cn;
        const f16x8* mp = (const f16x8*)(MIX + (size_t)r * DM + ks * 1024); const f16x8* wp = (const f16x8*)(WT + (size_t)col * DM + ks * 1024);
        float s0 = 0.f, s1 = 0.f;
#pragma unroll 4
        for (int k = 0; k < 128; ++k) { const f16x8 mv = mp[k], wv = wp[k];
            s0 = __builtin_amdgcn_fdot2((f16x2){mv[0], mv[1]}, (f16x2){wv[0], wv[1]}, s0, false); s1 = __builtin_amdgcn_fdot2((f16x2){mv[2], mv[3]}, (f16x2){wv[2], wv[3]}, s1, false);
            s0 = __builtin_amdgcn_fdot2((f16x2){mv[4], mv[5]}, (f16x2){wv[4], wv[5]}, s0, false); s1 = __builtin_amdgcn_fdot2((f16x2){mv[6], mv[7]}, (f16x2){wv[6], wv[7]}, s1, false); }
        part[(ks * 32 + r) * 8 + cn] = s0 + s1;
        __syncthreads();
        if (tid < 256) { const int rr = tid >> 3, cc = tid & 7; a.out[O_YS + (size_t)rr * DM + cg * 8 + cc] = a.in[1][(size_t)rr * DM + cg * 8 + cc] + part[rr * 8 + cc] + part[(32 + rr) * 8 + cc]; }
        __syncthreads();
    }
}

constexpr int SC_STRIDE = 2052;
constexpr int SC_BYTES = 16 * SC_STRIDE * 4;
constexpr int WSCR_OFF = 131584, WSCR_BYTES = 1536;
__device__ __forceinline__ f16x8 cvt8(f32x4 a, f32x4 b) { u32x4 w = {pk_f16(a[0], a[1]), pk_f16(a[2], a[3]), pk_f16(b[0], b[1]), pk_f16(b[2], b[3])}; return __builtin_bit_cast(f16x8, w); }

__device__ __forceinline__ void p2_convmix(const Args& a, int gw, int NGW, int lane) {
    const GAS f16* U = (const GAS f16*)(a.ws + WS_U); const GAS f16* Gm = (const GAS f16*)(a.ws + WS_G); GAS f16* MIX = (GAS f16*)(a.ws + WS_MIX);
    const GAS float* wconv = (const GAS float*)a.in[12]; const GAS float* state = (const GAS float*)a.in[5];
    for (int ch = gw; ch < MT / 4; ch += NGW) {
        const int row0 = 4 * ch; const bool smp = row0 >= MP; const int t0 = smp ? 0 : (row0 & (S - 1)); const int seq = (row0 - MP) >> 2;
#pragma unroll
        for (int half = 0; half < 2; ++half) { const int cb = half * 512 + 8 * lane;
            float um2[8], um1[8], w0[8], w1[8], w2[8];
#pragma unroll
            for (int e = 0; e < 8; e += 4) { const f32x4 a0 = *(const GAS f32x4*)(wconv + cb + e), a1 = *(const GAS f32x4*)(wconv + 1024 + cb + e), a2 = *(const GAS f32x4*)(wconv + 2048 + cb + e);
#pragma unroll
                for (int i = 0; i < 4; ++i) { w0[e + i] = a0[i]; w1[e + i] = a1[i]; w2[e + i] = a2[i]; } }
            if (t0 == 0) {
                if (smp) {
#pragma unroll
                    for (int e = 0; e < 8; e += 4) { const f32x4 s0 = *(const GAS f32x4*)(state + ((size_t)seq * 2) * 1024 + cb + e), s1 = *(const GAS f32x4*)(state + ((size_t)seq * 2 + 1) * 1024 + cb + e);
#pragma unroll
                        for (int i = 0; i < 4; ++i) { um2[e + i] = s0[i]; um1[e + i] = s1[i]; } }
                } else {
#pragma unroll
                    for (int e = 0; e < 8; ++e) { um2[e] = 0.f; um1[e] = 0.f; } }
            } else { const f16x8 p2 = *(const GAS f16x8*)(U + (size_t)(row0 - 2) * 1024 + cb), p1 = *(const GAS f16x8*)(U + (size_t)(row0 - 1) * 1024 + cb);
#pragma unroll
                for (int e = 0; e < 8; ++e) { um2[e] = (float)p2[e]; um1[e] = (float)p1[e]; } }
#pragma unroll
            for (int i = 0; i < 4; ++i) { const size_t row = row0 + i;
                const f16x8 uv = *(const GAS f16x8*)(U + row * 1024 + cb), gv = *(const GAS f16x8*)(Gm + row * 1024 + cb); float o[8];
#pragma unroll
                for (int e = 0; e < 8; ++e) { const float u = (float)uv[e]; const float cv = w0[e] * um2[e] + w1[e] * um1[e] + w2[e] * u; o[e] = (float)gv[e] * cv; um2[e] = um1[e]; um1[e] = u; }
                u32x4 w = {pk_f16(o[0], o[1]), pk_f16(o[2], o[3]), pk_f16(o[4], o[5]), pk_f16(o[6], o[7])};
                *(GAS u32x4*)(MIX + row * 2048 + 1024 + cb) = w; }
        }
    }
}

__device__ __forceinline__ void p2_sscore(const Args& a, int gw, int NGW, int lane) {
    const GAS float* cki = (const GAS float*)a.in[4]; const GAS int* ptab = (const GAS int*)a.in[6];
    const GAS f16* QI = (const GAS f16*)(a.ws + WS_QI); const GAS float* WI = (const GAS float*)(a.ws + WS_WI); GAS float* SSC = (GAS float*)(a.ws + WS_SSC);
    const int fr = lane & 15, fq = lane >> 4;
    for (int it = gw; it < NSB * 256; it += NGW) {
        const int sb = it >> 8, hp = it & 255, pg = hp >> 1, k0 = (hp & 1) * 64; const int phys = ptab[sb * NPAGES + pg];
        const GAS float* kbase = cki + ((size_t)phys * PAGE + k0) * 64;
        f16x8 qf[4][2]; f32x4 wv[4];
#pragma unroll
        for (int t = 0; t < 4; ++t) { const size_t row = MP + 4 * sb + t;
            qf[t][0] = *(const GAS f16x8*)(QI + row * 1024 + fr * 64 + 8 * fq); qf[t][1] = *(const GAS f16x8*)(QI + row * 1024 + fr * 64 + 32 + 8 * fq);
            wv[t] = *(const GAS f32x4*)(WI + row * 16 + 4 * fq); }
#pragma unroll
        for (int tile = 0; tile < 4; ++tile) {
            const GAS float* kr = kbase + (size_t)(16 * tile + fr) * 64 + 8 * fq;
            const f16x8 kf0 = cvt8(*(const GAS f32x4*)kr, *(const GAS f32x4*)(kr + 4)), kf1 = cvt8(*(const GAS f32x4*)(kr + 32), *(const GAS f32x4*)(kr + 36));
            float mine = 0.f;
#pragma unroll
            for (int t = 0; t < 4; ++t) { f32x4 c = {0.f, 0.f, 0.f, 0.f};
                c = __builtin_amdgcn_mfma_f32_16x16x32_f16(qf[t][0], kf0, c, 0, 0, 0); c = __builtin_amdgcn_mfma_f32_16x16x32_f16(qf[t][1], kf1, c, 0, 0, 0);
                float s = wv[t][0] * fmaxf(c[0], 0.f) + wv[t][1] * fmaxf(c[1], 0.f) + wv[t][2] * fmaxf(c[2], 0.f) + wv[t][3] * fmaxf(c[3], 0.f);
                s += __shfl_xor(s, 16); s += __shfl_xor(s, 32);
                mine = fq == t ? s : mine; }
            SSC[(size_t)(4 * sb + fq) * PAST + pg * PAGE + k0 + 16 * tile + fr] = mine;
        }
    }
}

__device__ __forceinline__ void wave_topk_mask(const LAS float* row, int t, GAS unsigned long long* mrow, int lane) {
    unsigned k[32];
#pragma unroll
    for (int j = 0; j < 32; ++j) { const int s = 64 * j + lane; const float v = row[s]; k[j] = s <= t ? fkey(v) : 0u; }
    unsigned tau = 0u;
    for (int bit = 31; bit >= 0; --bit) { const unsigned cand = tau | (1u << bit); int cnt = 0;
#pragma unroll
        for (int j = 0; j < 32; ++j) cnt += __builtin_popcountll(__ballot(k[j] >= cand));
        if (cnt >= TOPK) tau = cand; }
    unsigned wlo = 0u, whi = 0u;
#pragma unroll
    for (int j = 0; j < 32; ++j) { const unsigned long long m = __ballot(k[j] >= tau); if (lane == j) { wlo = (unsigned)m; whi = (unsigned)(m >> 32); } }
    if (lane < 32) mrow[lane] = ((unsigned long long)whi << 32) | wlo;
}

#define RELU_FMA(acc_, c_, w_) do { const float r_ = fmaxf((c_), 0.f); asm("v_fmac_f32_e32 %0, %1, %2" : "+v"(acc_) : "v"(r_), "v"(w_)); } while (0)
__device__ __forceinline__ void p2_index_tile(const Args& a, LAS unsigned char* lds, int b, int t0, int wave, int lane) {
    const GAS f16* QI = (const GAS f16*)(a.ws + WS_QI); const GAS float* WI = (const GAS float*)(a.ws + WS_WI); const GAS f16* KI = (const GAS f16*)(a.ws + WS_KI);
    GAS unsigned long long* MASK = (GAS unsigned long long*)(a.ws + WS_MASK);
    LAS float* sc = (LAS float*)lds;
    const int fr = lane & 15, fq = lane >> 4; const size_t rowq = (size_t)b * S + t0 + fr;
    f16x8 qf[16][2]; float w[16];
#pragma unroll
    for (int h = 0; h < 16; ++h) { qf[h][0] = *(const GAS f16x8*)(QI + rowq * 1024 + h * 64 + 8 * fq); qf[h][1] = *(const GAS f16x8*)(QI + rowq * 1024 + h * 64 + 32 + 8 * fq); }
#pragma unroll
    for (int h = 0; h < 16; h += 4) { const f32x4 x = *(const GAS f32x4*)(WI + rowq * 16 + h); w[h] = x[0]; w[h + 1] = x[1]; w[h + 2] = x[2]; w[h + 3] = x[3]; }
    const int nkt = (t0 + 16) >> 4;
    const GAS f16* kp = KI + ((size_t)b * S + fr) * 64 + 8 * fq;
    for (int kt = wave; kt < nkt; kt += NWAVES) {
        const f16x8 kf0 = *(const GAS f16x8*)(kp + (size_t)kt * 1024), kf1 = *(const GAS f16x8*)(kp + (size_t)kt * 1024 + 32);
        float a0 = 0.f, a1 = 0.f, a2 = 0.f, a3 = 0.f;
#pragma unroll
        for (int h = 0; h < 16; ++h) { f32x4 c = {0.f, 0.f, 0.f, 0.f};
            c = __builtin_amdgcn_mfma_f32_16x16x32_f16(kf0, qf[h][0], c, 0, 0, 0); c = __builtin_amdgcn_mfma_f32_16x16x32_f16(kf1, qf[h][1], c, 0, 0, 0);
            RELU_FMA(a0, c[0], w[h]); RELU_FMA(a1, c[1], w[h]); RELU_FMA(a2, c[2], w[h]); RELU_FMA(a3, c[3], w[h]); }
        *(LAS f32x4*)(sc + fr * SC_STRIDE + 16 * kt + 4 * fq) = (f32x4){a0, a1, a2, a3};
    }
    __syncthreads();
#pragma unroll 1
    for (int qq = 0; qq < 2; ++qq) { const int q = 2 * wave + qq; const int t = t0 + q;
        wave_topk_mask(sc + q * SC_STRIDE, t, MASK + ((size_t)b * S + t) * 32, lane); }
    __syncthreads();
}

__device__ __forceinline__ void p2_phase(const Args& a, LAS unsigned char* lds, int vcu, int G, int wave, int lane) {
    const int gw = vcu * NWAVES + wave, NGW = G * NWAVES;
    p2_sscore(a, gw, NGW, lane);
    p2_convmix(a, gw, NGW, lane);
    { GAS unsigned long long* MASK = (GAS unsigned long long*)(a.ws + WS_MASK);
      for (int i = gw * 64 + lane; i < NB * TOPK * 32; i += NGW * 64) { const int wd = i & 31, t = (i >> 5) & (TOPK - 1), b = i >> 13; const int lo = 64 * wd;
          const unsigned long long m = lo + 63 <= t ? ~0ull : (lo > t ? 0ull : ((1ull << (t - lo + 1)) - 1ull));
          MASK[((size_t)b * S + t) * 32 + wd] = m; } }
    constexpr int NT = NB * (S - TOPK) / 16;
    for (int r = 0; r * G < NT; ++r) { const int k = (r & 1) ? (r + 1) * G - 1 - vcu : r * G + vcu;
        if (k < NT) { const int j = (NT / NB - 1) - (k >> 2), b = k & 3; p2_index_tile(a, lds, b, TOPK + 16 * j, wave, lane); } }
}

namespace att {
typedef short bf16x8 __attribute__((ext_vector_type(8)));
typedef short s16x4 __attribute__((ext_vector_type(4)));
typedef float f32x16 __attribute__((ext_vector_type(16)));
constexpr int QBLK = 32, KVBLK = 64, D = 128;
constexpr int SHM_V = KVBLK * D * 2, SHM_K = KVBLK * D * 2;
constexpr int WS_OFF = 2 * SHM_V + 2 * SHM_K;
constexpr float SCALE = 0.08838834764831845f;
#define KSWZ(row, colB) ((row) * 256 + ((colB) ^ (((row) & 7) << 4)))
#define SBAR() __builtin_amdgcn_sched_barrier(0)
__device__ __forceinline__ int v_st(int k, int c) { const int kk = (k & ~0xC) | ((k & 4) << 1) | ((k & 8) >> 1); return ((kk >> 3) * 4 + (c >> 5)) * 512 + ((kk & 7) * 32 + (c & 31)) * 2; }
__device__ __forceinline__ int v_rd_base(int lane) { return ((lane & 3) << 3) | (((lane >> 2) & 3) << 6) | (((lane >> 4) & 1) << 5) | (((lane >> 5) & 1) << 8); }
constexpr int v_rd_off(int d0, int ks, int half) { return d0 * 512 + ks * 4096 + half * 2048; }
__device__ __forceinline__ int crow(int r, int hi) { return (r & 3) + 8 * (r >> 2) + 4 * hi; }
__device__ __forceinline__ unsigned cvtpk(float lo, float hi) { return pk_bf16(lo, hi); }

template <int KB>
__device__ __forceinline__ void qkt(f32x16& p0, f32x16& p1, const LAS unsigned char* K_lds, int r32, int hi, const LAS unsigned char* qp) {
    p0 = f32x16{}; p1 = f32x16{};
    const LAS unsigned char* kb[4];
#pragma unroll
    for (int dd = 0; dd < 4; ++dd) kb[dd] = K_lds + KB * SHM_K + KSWZ(r32, (dd * 16 + hi * 8) * 2);
#pragma unroll
    for (int d0 = 0; d0 < 8; ++d0) { const LAS unsigned char* a = kb[d0 & 3] + (d0 >> 2) * 128;
        const bf16x8 b0 = *(const LAS bf16x8*)a;
        const bf16x8 b1 = *(const LAS bf16x8*)(a + 32 * 256);
        const bf16x8 qv = *(const LAS bf16x8*)(qp + d0 * 1024);
        p0 = __builtin_amdgcn_mfma_f32_32x32x16_bf16(b0, qv, p0, 0, 0, 0);
        p1 = __builtin_amdgcn_mfma_f32_32x32x16_bf16(b1, qv, p1, 0, 0, 0); }
}
template <int VB>
__device__ __forceinline__ void pv_tile(f32x16* o, int vb0, bf16x8 pa0, bf16x8 pa1, bf16x8 pa2, bf16x8 pa3) {
#define TRRD(dst, off) asm volatile("ds_read_b64_tr_b16 %0, %1 offset:%2" : "=&v"(dst) : "v"(vb0), "i"(off) : "memory")
#define PV_D0(d0) do { s16x4 l0, l1, l2, l3, h0, h1, h2, h3; constexpr int b_ = VB * SHM_V + v_rd_off(d0, 0, 0); \
        TRRD(l0, b_); TRRD(h0, b_ + 2048); TRRD(l1, b_ + 4096); TRRD(h1, b_ + 6144); TRRD(l2, b_ + 8192); TRRD(h2, b_ + 10240); TRRD(l3, b_ + 12288); TRRD(h3, b_ + 14336); \
        asm volatile("s_waitcnt lgkmcnt(0)" ::: "memory"); SBAR(); \
        o[d0] = __builtin_amdgcn_mfma_f32_32x32x16_bf16(pa0, (bf16x8){l0[0], l0[1], l0[2], l0[3], h0[0], h0[1], h0[2], h0[3]}, o[d0], 0, 0, 0); \
        o[d0] = __builtin_amdgcn_mfma_f32_32x32x16_bf16(pa1, (bf16x8){l1[0], l1[1], l1[2], l1[3], h1[0], h1[1], h1[2], h1[3]}, o[d0], 0, 0, 0); \
        o[d0] = __builtin_amdgcn_mfma_f32_32x32x16_bf16(pa2, (bf16x8){l2[0], l2[1], l2[2], l2[3], h2[0], h2[1], h2[2], h2[3]}, o[d0], 0, 0, 0); \
        o[d0] = __builtin_amdgcn_mfma_f32_32x32x16_bf16(pa3, (bf16x8){l3[0], l3[1], l3[2], l3[3], h3[0], h3[1], h3[2], h3[3]}, o[d0], 0, 0, 0); } while (0)
    PV_D0(0); PV_D0(1); PV_D0(2); PV_D0(3);
#undef PV_D0
#undef TRRD
}
__device__ __forceinline__ void partialSM(f32x16& p0, f32x16& p1, unsigned wl, unsigned wh, float sh2) {
    const float NEG = -__builtin_inff(); constexpr float C2 = 1.4426950408889634f * SCALE;
#pragma unroll
    for (int r = 0; r < 16; ++r) { const unsigned bit = 1u << ((r & 3) + 8 * (r >> 2));
        p0[r] = (wl & bit) ? fmaf(p0[r], C2, -sh2) : NEG; p1[r] = (wh & bit) ? fmaf(p1[r], C2, -sh2) : NEG; }
#pragma unroll
    for (int r = 0; r < 16; ++r) p0[r] = __builtin_amdgcn_exp2f(p0[r]);
}
__device__ __forceinline__ void finishSM(f32x16& p0, f32x16& p1, float& l_reg, bf16x8& pa0, bf16x8& pa1, bf16x8& pa2, bf16x8& pa3) {
#pragma unroll
    for (int r = 0; r < 16; ++r) p1[r] = __builtin_amdgcn_exp2f(p1[r]);
    float ps = 0;
#pragma unroll
    for (int r = 0; r < 16; ++r) ps += p0[r];
#pragma unroll
    for (int r = 0; r < 16; ++r) ps += p1[r];
    l_reg += ps;
#define PK4(P, B_, OUT) do { unsigned a0 = cvtpk(P[B_+0], P[B_+1]), a1 = cvtpk(P[B_+2], P[B_+3]); \
        unsigned b0 = cvtpk(P[B_+4], P[B_+5]), b1 = cvtpk(P[B_+6], P[B_+7]); \
        auto r0 = __builtin_amdgcn_permlane32_swap(a0, b0, false, false); auto r1 = __builtin_amdgcn_permlane32_swap(a1, b1, false, false); \
        u32x4 w = {r0[0], r1[0], r0[1], r1[1]}; OUT = __builtin_bit_cast(bf16x8, w); } while (0)
    PK4(p0, 0, pa0); PK4(p0, 8, pa1); PK4(p1, 0, pa2); PK4(p1, 8, pa3);
#undef PK4
}

__device__ __forceinline__ __amdgpu_buffer_rsrc_t mk_rsrc(const GAS void* p, unsigned bytes) {
    const unsigned long long u = (unsigned long long)p; const unsigned lo = __builtin_amdgcn_readfirstlane((unsigned)u), hi = __builtin_amdgcn_readfirstlane((unsigned)(u >> 32));
    return __builtin_amdgcn_make_buffer_rsrc((void*)(((unsigned long long)hi << 32) | lo), (short)0, (int)bytes, 0x00020000);
}
__device__ __forceinline__ void attn_block(const Args& a, LAS unsigned char* lds, int b, int kvh, int q0, float sh2) {
    const int tid = threadIdx.x, wid = __builtin_amdgcn_readfirstlane(tid >> 6), lane = tid & 63, r32 = lane & 31, hi = lane >> 5;
    const int head = 4 * kvh + (wid >> 1), qw = q0 + 32 * (wid & 1);
    const GAS bf16_t* Qw = (const GAS bf16_t*)(a.ws + WS_QB) + (((size_t)b * NH + head) * S + qw) * D;
    const GAS bf16_t* Kh = (const GAS bf16_t*)(a.ws + WS_KB) + ((size_t)b * NKV + kvh) * S * D;
    const GAS bf16_t* Vh = (const GAS bf16_t*)(a.ws + WS_VB) + ((size_t)b * NKV + kvh) * S * D;
    const __amdgpu_buffer_rsrc_t rK = mk_rsrc(Kh, S * D * 2), rV = mk_rsrc(Vh, S * D * 2), rM = mk_rsrc((const GAS unsigned long long*)(a.ws + WS_MASK) + ((size_t)b * S + qw) * 32, 32 * 256);
    const unsigned moff = (unsigned)r32 * 256u;
    const int NT = q0 / KVBLK + 1;
    LAS unsigned char* V_lds = lds; LAS unsigned char* K_lds = lds + 2 * SHM_V;
    const int sr = tid >> 4, sc = (tid & 15) * 8, vst0 = v_st(sr, sc), vst1 = v_st(32 + sr, sc), kws = KSWZ(sr, sc * 2);
    const int vb0 = (int)(unsigned)(size_t)V_lds + v_rd_base(lane); const unsigned kvoff = (unsigned)(sr * D + sc) * 2u;
    bf16x8 st_v0, st_v1, st_k0, st_k1;
    LAS unsigned char* qp = lds + WS_OFF + 2048 + wid * 8192 + lane * 16;
#define VMW() asm volatile("s_waitcnt vmcnt(0)" ::: "memory")
#define BL128(r_, so_) __builtin_bit_cast(bf16x8, __builtin_amdgcn_raw_buffer_load_b128(r_, kvoff, (so_), 0))
#define SLOAD_H(k0) do { const int so_ = (k0) * 256; st_v0 = BL128(rV, so_); st_v1 = BL128(rV, so_ + 8192); st_k0 = BL128(rK, so_); st_k1 = BL128(rK, so_ + 8192); } while (0)
#define SWRITE_HK(bf) do { *(LAS bf16x8*)(K_lds + (bf) * SHM_K + kws) = st_k0; *(LAS bf16x8*)(K_lds + (bf) * SHM_K + kws + 32 * 256) = st_k1; } while (0)
#define SWRITE_HV(bf) do { *(LAS bf16x8*)(V_lds + (bf) * SHM_V + vst0) = st_v0; *(LAS bf16x8*)(V_lds + (bf) * SHM_V + vst1) = st_v1; } while (0)
#define SWRITE_H(bf) do { SWRITE_HV(bf); SWRITE_HK(bf); } while (0)
#define MLOAD(t) __builtin_bit_cast(unsigned long long, __builtin_amdgcn_raw_buffer_load_b64(rM, moff, (t) * 8, 0))
#define MSPLIT(mw, wl, wh) do { wl = (unsigned)(mw) >> (4 * hi); wh = (unsigned)((mw) >> 32) >> (4 * hi); } while (0)
    { bf16x8 qt[8];
#pragma unroll
      for (int d0 = 0; d0 < 8; ++d0) qt[d0] = *(const GAS bf16x8*)(Qw + (unsigned)(r32 * D + d0 * 16 + hi * 8));
#pragma unroll
      for (int d0 = 0; d0 < 8; ++d0) *(LAS bf16x8*)(qp + d0 * 1024) = qt[d0]; }
    SLOAD_H(0); unsigned long long mwA = MLOAD(0), mwB = 0ull; VMW(); SWRITE_H(0);
    if (NT > 1) { SLOAD_H(KVBLK); mwB = MLOAD(1); }
    __syncthreads();
    float l_reg = 0.f; f32x16 o[4] = {};
    f32x16 p0, p1; bf16x8 pa0, pa1, pa2, pa3; unsigned wl, wh;
    SBAR(); qkt<0>(p0, p1, K_lds, r32, hi, qp);
    MSPLIT(mwA, wl, wh); partialSM(p0, p1, wl, wh, sh2);
    if (NT > 1) { VMW(); SWRITE_H(1); }
    __syncthreads();
#define STEP(t, KB, VB) do { \
        finishSM(p0, p1, l_reg, pa0, pa1, pa2, pa3); SBAR(); \
        if ((t) + 1 < NT) { SLOAD_H(((t) + 1) * KVBLK); mwA = MLOAD((t) + 1); SBAR(); } \
        pv_tile<VB>(o, vb0, pa0, pa1, pa2, pa3); SBAR(); \
        qkt<KB>(p0, p1, K_lds, r32, hi, qp); \
        MSPLIT(mwB, wl, wh); partialSM(p0, p1, wl, wh, sh2); mwB = mwA; \
        __syncthreads(); \
        if ((t) + 1 < NT) { VMW(); SWRITE_H(VB); } \
        __syncthreads(); } while (0)
    int t = 1;
    for (; t + 1 < NT; t += 2) { STEP(t, 1, 0); STEP(t + 1, 0, 1); }
    if (t < NT) { STEP(t, 1, 0); }
    finishSM(p0, p1, l_reg, pa0, pa1, pa2, pa3); SBAR();
    if ((NT - 1) & 1) pv_tile<1>(o, vb0, pa0, pa1, pa2, pa3); else pv_tile<0>(o, vb0, pa0, pa1, pa2, pa3);
    { auto rr = __builtin_amdgcn_permlane32_swap(__float_as_uint(l_reg), __float_as_uint(l_reg), false, false); l_reg = __uint_as_float(rr[0]) + __uint_as_float(rr[1]); }
    { int te = threadIdx.x; asm volatile("" : "+v"(te));
      const int le = te & 63, r32e = le & 31, hie = le >> 5;
      LAS float* wse = (LAS float*)(lds + WS_OFF) + wid * 64;
      if (hie == 0) wse[r32e] = l_reg;
      asm volatile("s_waitcnt lgkmcnt(0)" ::: "memory");
      __syncthreads();
      LAS f16* stg = (LAS f16*)(lds + wid * 8192);
#pragma unroll
      for (int r = 0; r < 16; ++r) { const int orow = crow(r, hie); const float rl = __builtin_amdgcn_rcpf(wse[orow]);
#pragma unroll
          for (int d0 = 0; d0 < 4; ++d0) stg[orow * 128 + d0 * 32 + r32e] = (f16)(o[d0][r] * rl); }
      asm volatile("s_waitcnt lgkmcnt(0)" ::: "memory");
      const GAS f16* SZ = (const GAS f16*)(a.ws + WS_SZ) + ((size_t)b * S + qw) * 1024 + head * 128; GAS f16* MIX = (GAS f16*)(a.ws + WS_MIX) + ((size_t)b * S + qw) * 2048 + head * 128;
#pragma unroll
      for (int i = 0; i < 8; ++i) { const int c = le + 64 * i, row = c >> 4, ch = c & 15;
          const f16x8 ov = *(const LAS f16x8*)(stg + row * 128 + ch * 8); const f16x8 zv = *(const GAS f16x8*)(SZ + (unsigned)(row * 1024 + ch * 8));
          *(GAS f16x8*)(MIX + (unsigned)(row * 2048 + ch * 8)) = ov * zv; } }
    asm volatile("s_waitcnt lgkmcnt(0)" ::: "memory");
    __syncthreads();
#undef BL128
#undef VMW
#undef SLOAD_H
#undef SWRITE_HK
#undef SWRITE_HV
#undef SWRITE_H
#undef MLOAD
#undef MSPLIT
#undef STEP
}
#undef KSWZ
#undef SBAR
}

__device__ __forceinline__ void p3_sample_item(const Args& a, LAS unsigned char* lds, int qi, int tid) {
    const int sb = qi / NST, tl = qi % NST; constexpr int L = PAST + NST, PER = 33;
    const GAS float* ck = (const GAS float*)a.in[2]; const GAS float* cv = (const GAS float*)a.in[3]; const GAS int* ptab = (const GAS int*)a.in[6]; const GAS float* out_ro = (const GAS float*)a.out;
    LAS float* q = (LAS float*)lds; LAS float* w = q + 1024; LAS float* newsc = w + 16; LAS float* pr = newsc + 16; LAS float* red = pr + 512; LAS float* qh = red + 512;
    LAS int* list = (LAS int*)(qh + 128); LAS unsigned* cnt = (LAS unsigned*)(list + 512); LAS int* nsel = (LAS int*)(cnt + 4);
    const GAS f16* QI = (const GAS f16*)(a.ws + WS_QI) + (size_t)(MP + qi) * 1024;
    for (int i = tid; i < 1024; i += 512) q[i] = (float)QI[i];
    if (tid < 16) w[tid] = ((const GAS float*)(a.ws + WS_WI))[(size_t)(MP + qi) * 16 + tid];
    if (tid == 0) *nsel = 0;
    __syncthreads();
    if (tid < NST) { const GAS float* kr = out_ro + O_KIS + (size_t)(sb * NST + tid) * 64; float sc = 0.f;
#pragma unroll 1
        for (int h = 0; h < 16; ++h) { float dsum = 0.f;
#pragma unroll 8
            for (int d = 0; d < 64; ++d) dsum += q[h * 64 + d] * kr[d];
            sc += w[h] * fmaxf(dsum, 0.f); }
        newsc[tid] = sc; }
    __syncthreads();
    const GAS float* ssc = (const GAS float*)(a.ws + WS_SSC) + (size_t)qi * PAST;
    unsigned keys[PER];
#pragma unroll
    for (int j = 0; j < PER; ++j) { const int s = j * 512 + tid; unsigned key = 0u;
        if (s < PAST) key = fkey(ssc[s]); else if (s < L && (s - PAST) <= tl) key = fkey(newsc[s - PAST]);
        keys[j] = key; }
    unsigned tau = 0u;
    for (int bit = 31; bit >= 0; --bit) { const unsigned cand = tau | (1u << bit); if (tid == 0) *cnt = 0; __syncthreads();
        unsigned c = 0;
#pragma unroll
        for (int j = 0; j < PER; ++j) c += keys[j] >= cand;
        c = (unsigned)wave_sum((float)c);
        if ((tid & 63) == 0) __hip_atomic_fetch_add(cnt, c, __ATOMIC_RELAXED, __HIP_MEMORY_SCOPE_WORKGROUP);
        __syncthreads();
        if (*cnt >= TOPK) tau = cand; __syncthreads(); }
#pragma unroll
    for (int j = 0; j < PER; ++j) { const int s = j * 512 + tid; if (keys[j] >= tau && keys[j] != 0u) { const int p = __hip_atomic_fetch_add(nsel, 1, __ATOMIC_RELAXED, __HIP_MEMORY_SCOPE_WORKGROUP); if (p < 512) list[p] = s; } }
    __syncthreads();
    const int n = *nsel < 512 ? *nsel : 512; const GAS float* QS = (const GAS float*)(a.ws + WS_QS) + (size_t)qi * 1024;
    const GAS f16* SZ = (const GAS f16*)(a.ws + WS_SZ); GAS f16* MIX = (GAS f16*)(a.ws + WS_MIX); const int row = MP + qi;
#pragma unroll 1
    for (int h = 0; h < NH; ++h) { const int kh = h / 4;
        if (tid < 128) qh[tid] = QS[h * 128 + tid];
        __syncthreads();
        float mx = -1e30f;
        if (tid < n) { const int s = list[tid]; const GAS float* kr;
            if (s < PAST) { const int phys = ptab[sb * NPAGES + s / PAGE]; kr = ck + (((size_t)phys * PAGE + s % PAGE) * NKV + kh) * HD; }
            else kr = out_ro + O_KS + ((size_t)(sb * NST + (s - PAST)) * NKV + kh) * HD;
            float d = 0.f;
#pragma unroll 8
            for (int e = 0; e < 128; e += 4) { const f32x4 kv = *(const GAS f32x4*)(kr + e); d += qh[e] * kv[0] + qh[e + 1] * kv[1] + qh[e + 2] * kv[2] + qh[e + 3] * kv[3]; }
            d *= 0.08838834764831845f; pr[tid] = d; mx = d; }
        red[tid] = mx; __syncthreads();
        for (int o = 256; o > 0; o >>= 1) { if (tid < o) red[tid] = fmaxf(red[tid], red[tid + o]); __syncthreads(); }
        mx = red[0]; __syncthreads();
        float sm = 0.f; if (tid < n) { const float e = __expf(pr[tid] - mx); pr[tid] = e; sm = e; }
        red[tid] = sm; __syncthreads();
        for (int o = 256; o > 0; o >>= 1) { if (tid < o) red[tid] += red[tid + o]; __syncthreads(); }
        sm = red[0]; __syncthreads();
        { const int part = tid >> 7, d = tid & 127; float o = 0.f;
          for (int j = part; j < n; j += 4) { const int s = list[j]; const GAS float* vr;
              if (s < PAST) { const int phys = ptab[sb * NPAGES + s / PAGE]; vr = cv + (((size_t)phys * PAGE + s % PAGE) * NKV + kh) * HD; }
              else vr = out_ro + O_VS + ((size_t)(sb * NST + (s - PAST)) * NKV + kh) * HD;
              o += pr[j] * vr[d]; }
          red[tid] = o; __syncthreads();
          if (tid < 128) { const float ov = (red[tid] + red[128 + tid] + red[256 + tid] + red[384 + tid]) / sm;
              MIX[(size_t)row * 2048 + h * 128 + tid] = (f16)(ov * (float)SZ[(size_t)row * 1024 + h * 128 + tid]); } }
        __syncthreads(); }
}

__device__ __forceinline__ void p3_phase(const Args& a, LAS unsigned char* lds, int vcu, int G, int tid) {
    float gm = 0.f, km = 0.f;
    for (int i = 0; i < HD; ++i) { gm = fmaxf(gm, fabsf(a.in[9][i])); km = fmaxf(km, fabsf(a.in[10][i])); }
    const float sh2 = fmaxf(0.f, 11.313708498984761f * gm * km - 20.f) * 1.4426950408889634f;
    for (int sidx = G - 1 - vcu; sidx < MS; sidx += G) p3_sample_item(a, lds, sidx, tid);
    for (int k = vcu; k < 256; k += G) { const int i = 31 - (k >> 3), bk = k & 7;
        att::attn_block(a, lds, bk >> 1, bk & 1, 64 * i, sh2); }
}

typedef GAS unsigned gu32;
#define XB_TMO      128
#define XB_XCNT(j)  (256  + 64 * (j))
#define XB_XSUB(j)  (1280 + 64 * (j))
#define XB_XGEN(j)  (2304 + 64 * (j))
#define XB_TOP      3328
#define XB_TOPGEN   3392
#define XCD_BAR_WORDS 3456
#define XB_SPIN_CAP (1u << 18)
__device__ __forceinline__ unsigned xb_ld(unsigned* p)              { return __hip_atomic_load(p, __ATOMIC_RELAXED, __HIP_MEMORY_SCOPE_AGENT); }
__device__ __forceinline__ unsigned xb_add(unsigned* p, unsigned v) { return __hip_atomic_fetch_add(p, v, __ATOMIC_RELAXED, __HIP_MEMORY_SCOPE_AGENT); }
__device__ __forceinline__ unsigned xb_xcc_id() { return (unsigned)__builtin_amdgcn_s_getreg((3 << 11) | 20) & 0xFu; }
#define XB_SPIN(cond, bar) do { unsigned _sp = 0; while (cond) { __builtin_amdgcn_s_sleep(1); \
    if ((++_sp & 255u) == 0u) { if (xb_ld(&(bar)[XB_TMO])) break; if (_sp > XB_SPIN_CAP) { atomicAdd(&(bar)[XB_TMO], 1u); break; } } } } while (0)
struct XcdBarrier { unsigned* bar; unsigned x; volatile LAS unsigned* st; };
__device__ __forceinline__ XcdBarrier xcd_barrier_post(unsigned* bar, volatile LAS unsigned* st) {
    XcdBarrier b; b.bar = bar; b.x = xb_xcc_id(); b.st = st;
    if (threadIdx.x == 0) (void)xb_add(&bar[XB_XCNT(b.x)], 1u);
    return b;
}
__device__ __forceinline__ void xcd_barrier_complete(unsigned* bar, unsigned x, unsigned& nloc, unsigned& nx) {
    const unsigned G = gridDim.x * gridDim.y * gridDim.z;
    unsigned sum, cnt, mine, sp = 0u;
    for (;;) {
        sum = 0u; cnt = 0u; mine = 0u;
#pragma unroll
        for (unsigned j = 0; j < 16; ++j) { const unsigned c = xb_ld(&bar[XB_XCNT(j)]); sum += c; cnt += (c > 0u) ? 1u : 0u; mine = (j == x) ? c : mine; }
        if (sum == G) break;
        __builtin_amdgcn_s_sleep(1);
        if ((++sp & 255u) == 0u) { if (xb_ld(&bar[XB_TMO])) break; if (sp > XB_SPIN_CAP) { atomicAdd(&bar[XB_TMO], 1u); break; } }
    }
    nloc = mine > 0u ? mine : 1u; nx = cnt > 0u ? cnt : 1u;
}
__device__ __forceinline__ void xcd_barrier(const XcdBarrier& b) {
    asm volatile("s_waitcnt vmcnt(0)" ::: "memory");
    __syncthreads();
    if (threadIdx.x == 0) {
        unsigned* bar = b.bar;
        __builtin_amdgcn_s_waitcnt(0);
        unsigned nloc = b.st[0], nx = b.st[1];
        if (nloc == 0u) { xcd_barrier_complete(bar, b.x, nloc, nx); b.st[0] = nloc; b.st[1] = nx; }
        const unsigned old = xb_add(&bar[XB_XSUB(b.x)], 1u);
        const unsigned gen = old / nloc;
        if (old + 1u == (gen + 1u) * nloc) {
            __builtin_amdgcn_fence(__ATOMIC_RELEASE, "agent");
            asm volatile("s_waitcnt vmcnt(0)" ::: "memory");
            const unsigned og = xb_add(&bar[XB_TOP], 1u);
            const unsigned tg = og / nx;
            if (og + 1u == (tg + 1u) * nx) xb_add(&bar[XB_TOPGEN], 1u);
            else XB_SPIN(xb_ld(&bar[XB_TOPGEN]) == tg, bar);
            __builtin_amdgcn_fence(__ATOMIC_ACQUIRE, "agent");
            xb_add(&bar[XB_XGEN(b.x)], 1u);
            asm volatile("s_waitcnt vmcnt(0)" ::: "memory");
        } else {
            XB_SPIN(xb_ld(&bar[XB_XGEN(b.x)]) == gen, bar);
            __builtin_amdgcn_fence(__ATOMIC_ACQUIRE, "agent");
            asm volatile("s_waitcnt vmcnt(0)" ::: "memory");
        }
    }
    __syncthreads();
}

__global__ void __launch_bounds__(NWAVES * 64, 2) mk_fwd(Args a) {
    extern __shared__ __attribute__((aligned(16))) unsigned char lds_raw[];
    LAS unsigned char* lds = (LAS unsigned char*)lds_raw;
    const int tid = threadIdx.x, lane = tid & 63, wave = __builtin_amdgcn_readfirstlane(tid >> 6);
    const int G = gridDim.x; const int bx = blockIdx.x; const int vcu = (G % 8 == 0) ? (bx % 8) * (G / 8) + bx / 8 : bx;
    const int lo = a.ph_lo, hi = a.ph_hi;
#define IN(k) (lo <= (k) && (k) < hi)
#define BOTH(k) (IN(k) && IN((k) + 1))
    volatile LAS unsigned* MISC = (volatile LAS unsigned*)(lds + MISC_OFF);
    if (tid < 64) MISC[tid] = 0u;
    __syncthreads();
    XcdBarrier bar; bar.bar = (unsigned*)a.ws; bar.x = 0; bar.st = nullptr;
    if (hi - lo > 1) bar = xcd_barrier_post((unsigned*)a.ws, MISC + 8);
    if (IN(0)) { p0_prologue(a, lds, vcu, G, wave, lane); if (BOTH(0)) xcd_barrier(bar); }
    if (IN(1)) {
        pg8::Gemm g{(const f16*)(a.ws + WS_XNH), (const f16*)(a.ws + WS_WINT), DM};
        pg8::StaticOrder S; S.init(MPAD / 256, NPAD / 256, G, bx);
        EpiIn E{a.out, a.ws, a.in[9], a.in[10], a.in[11], (LAS float*)(lds + SCR_OFF)};
        pg8::gemm_phase<EpiIn, pg8::StaticOrder>(lds, g, S, E);
        if (BOTH(1)) xcd_barrier(bar);
    }
    if (IN(2)) { p2_phase(a, lds, vcu, G, wave, lane); if (BOTH(2)) xcd_barrier(bar); }
    if (IN(3)) { p3_phase(a, lds, vcu, G, tid); if (BOTH(3)) xcd_barrier(bar); }
    if (IN(4)) {
        pg8::Gemm g{(const f16*)(a.ws + WS_MIX), (const f16*)(a.ws + WS_WOUTT), DM};
        pg8::StaticOrder S; S.init(MP / 256, DM / 256, G, bx);
        EpiOut E{a.out, a.in[0]};
        pg8::gemm_phase<EpiOut, pg8::StaticOrder>(lds, g, S, E);
        p4_sample(a, lds, bx, G, tid);
    }
#undef BOTH
#undef IN
}

extern "C" void kernel_launch(void* const* d_in, const int* in_sizes, int n_in, void* d_out, int out_size, void* d_ws, size_t ws_size, hipStream_t stream) {
    static int grid = 0;
    if (grid == 0) {
        if (ws_size < WS_NEED2 || out_size != (int)O_END || n_in != 14) { fprintf(stderr, "kernel_launch: ws %zu (need %zu) out %d (want %zu) n_in %d\n", ws_size, (size_t)WS_NEED2, out_size, (size_t)O_END, n_in); grid = -1; return; }
        int dev = 0, cus = 0; hipGetDevice(&dev); hipDeviceGetAttribute(&cus, hipDeviceAttributeMultiprocessorCount, dev);
        if (hipFuncSetAttribute((const void*)mk_fwd, hipFuncAttributeMaxDynamicSharedMemorySize, LDS_BYTES) != hipSuccess) { fprintf(stderr, "kernel_launch: hipFuncSetAttribute failed\n"); grid = -1; return; }
        int per_cu = 0; hipOccupancyMaxActiveBlocksPerMultiprocessor(&per_cu, (const void*)mk_fwd, NWAVES * 64, LDS_BYTES); (void)hipGetLastError();
        if (per_cu < 1) fprintf(stderr, "kernel_launch: occupancy query says %d blocks per CU\n", per_cu);
        grid = cus > 0 ? cus : 256;
    }
    if (grid < 0) return;
    float* out = (float*)d_out; unsigned char* ws = (unsigned char*)d_ws;
    Args a{};
    for (int i = 0; i < 14; ++i) a.in[i] = (const float*)d_in[i];
    a.out = out; a.ws = ws;
    if (hipMemsetAsync(ws, 0, 65536, stream) != hipSuccess) { fprintf(stderr, "kernel_launch: memset of the control words failed\n"); return; }
    a.ph_lo = 0; a.ph_hi = 5; hipLaunchKernelGGL(mk_fwd, dim3(grid), dim3(NWAVES * 64), LDS_BYTES, stream, a);
}
```

```cpp
#include <hip/hip_runtime.h>
#include <cstdio>
#include <cstdint>
#include <cmath>

typedef _Float16 f16;
typedef unsigned short bf16_t;

constexpr int DM = 2048, NB = 4, S = 2048, NSB = 8, NST = 4, PAST = 16384, PAGE = 128, NPAGES = PAST / PAGE;
constexpr int MP = NB * S;
constexpr int MS = NSB * NST;
constexpr int MT = MP + MS;
constexpr int DIN = 7760;
constexpr int OQ = 0, OKK = 1024, OV = 1280, OZ = 1536, OQI = 2560, OKI = 3584, OWI = 3648, OH = 3664, OBB = 4688, OC = 5712, OZC = 6736;
constexpr int NH = 8, NKV = 2, HD = 128, NIH = 16, ID = 64, TOPK = 256, DC = 1024;
constexpr float EPS = 1e-6f;
constexpr size_t O_YP = 0, O_YS = 16777216, O_KP = 16842752, O_VP = 18939904, O_KIP = 21037056, O_CVP = 21561344,
                 O_KS = 21569536, O_VS = 21577728, O_KIS = 21585920, O_CVS = 21587968, O_END = 21604352;
constexpr size_t MiB = 1u << 20;
constexpr size_t WS_ROPE = 1 * MiB;
constexpr size_t WS_ROPE_I = WS_ROPE + 2052 * 32 * 4;
constexpr size_t WS_QB = 2 * MiB;
constexpr size_t WS_KB = 18 * MiB;
constexpr size_t WS_VB = 22 * MiB;
constexpr size_t WS_SZ = 26 * MiB;
constexpr size_t WS_QI = 43 * MiB;
constexpr size_t WS_KI = 60 * MiB;
constexpr size_t WS_WI = 61 * MiB;
constexpr size_t WS_U = 62 * MiB;
constexpr size_t WS_G = 79 * MiB;
constexpr size_t WS_MIX = 96 * MiB;
constexpr size_t WS_MASK = 130 * MiB;
constexpr size_t WS_SSC = 132 * MiB;
constexpr size_t WS_QS = 134 * MiB;
constexpr size_t WS_XN = 136 * MiB;
constexpr size_t WS_P = 202 * MiB;
constexpr size_t WS_NEED = 448 * MiB;

__device__ __forceinline__ bf16_t f2bf(float f) { unsigned u = __builtin_bit_cast(unsigned, f); return (bf16_t)((u + 0x7fffu + ((u >> 16) & 1u)) >> 16); }
__device__ __forceinline__ float bf2f(bf16_t h) { return __builtin_bit_cast(float, (unsigned)h << 16); }
__device__ __forceinline__ float silu(float z) { return z / (1.f + __expf(-z)); }
__device__ __forceinline__ unsigned fkey(float f) { unsigned u = __builtin_bit_cast(unsigned, f); return (u & 0x80000000u) ? ~u : (u | 0x80000000u); }

#define LAS __attribute__((address_space(3)))
#define GAS __attribute__((address_space(1)))
typedef _Float16 f16x8 __attribute__((ext_vector_type(8)));
typedef _Float16 f16x4 __attribute__((ext_vector_type(4)));
typedef _Float16 f16x2 __attribute__((ext_vector_type(2)));
typedef float f32x4 __attribute__((ext_vector_type(4)));
typedef float f32x2 __attribute__((ext_vector_type(2)));
typedef unsigned u32x4 __attribute__((ext_vector_type(4)));
typedef unsigned u32x2 __attribute__((ext_vector_type(2)));
typedef __bf16 bf16x2_t __attribute__((ext_vector_type(2)));
namespace pg8 {
constexpr int BM = 256, BK = 64, HALF = 128, HTB = HALF * BK * 2, STAGE_BYTES = 8 * HTB, NXCD = 8, WGM = 8;
__host__ __device__ __forceinline__ int lds_byte(int r, int c) { const int st = (r >> 4) * 2 + (c >> 5), rr = r & 15, cc = c & 31, ob = rr * 64 + cc * 2; return st * 1024 + (ob ^ (((ob >> 9) & 1) << 5)); }
__host__ __device__ __forceinline__ void stage_rc(int b, int& R, int& C) { const int st = b / 1024, sb = b % 1024, swz = sb ^ (((sb >> 9) & 1) << 5); R = (st >> 1) * 16 + swz / 64; C = (st & 1) * 32 + (swz % 64) / 2; }
struct Unit { int pm, pn; };
struct Gemm { const f16* A; const f16* Bt; int K; };
struct StaticOrder {
    int nM, nN, nwg, G, c;
    __device__ void init(int nM_, int nN_, int G_, int c_) { nM = nM_; nN = nN_; nwg = nM * nN; G = G_; c = c_; }
    __device__ bool next(int i, Unit& u) const {
        const long L = (long)i * G + c; if (L >= nwg) return false;
        int wgid = (int)L; { const int q = nwg / NXCD, r = nwg % NXCD, xcd = wgid % NXCD, off = wgid / NXCD; wgid = (xcd < r ? xcd * (q + 1) : r * (q + 1) + (xcd - r) * q) + off; }
        const int nig = WGM * nN, gid = wgid / nig, fm = gid * WGM, gsz = (nM - fm) < WGM ? (nM - fm) : WGM;
        u.pm = fm + ((wgid % nig) % gsz); u.pn = (wgid % nig) / gsz; return true;
    }
};
template <class Epi, class Sched>
__device__ __forceinline__ void gemm_phase(LAS unsigned char* lds, const Gemm g, const Sched& S, const Epi& E) {
    int tid_ = threadIdx.x; asm volatile("" : "+v"(tid_));
    const int tid = tid_, wid = __builtin_amdgcn_readfirstlane(tid >> 6), lane = tid & 63, wr = wid >> 2, wc = wid & 3, fr = lane & 15, fq = lane >> 4;
    const int K = g.K, nt = K / BK;
    unsigned voffA[2];
#pragma unroll
    for (int i = 0; i < 2; ++i) { int R, C; stage_rc(tid * 16 + i * 8192, R, C); voffA[i] = (unsigned)(R * K + C) * 2u; }
    const size_t kstep = (size_t)(BK * 2);
    const size_t hstep = (size_t)HALF * K * 2;
    const size_t tstep = 2 * hstep;
    const unsigned ldsw = (unsigned)wid * 1024u;
    const int aoff = lds_byte(wr * 64 + fr, fq * 8), boff = lds_byte(wc * 32 + fr, fq * 8);
#define PG8_SA(b, h) (((b) * 2 + (h)) * HTB)
#define PG8_SB(b, h) ((4 + (b) * 2 + (h)) * HTB)
#define PG8_STAGE(bufoff, gbase) do { _Pragma("unroll") for (int _i = 0; _i < 2; ++_i) \
        __builtin_amdgcn_global_load_lds((const unsigned*)((const char*)(gbase) + voffA[_i]), (LAS unsigned*)(lds + (bufoff) + ldsw + _i * 8192), 16, 0, 0); } while (0)
#define PG8_LDA(dst, b, h) do { _Pragma("unroll") for (int m = 0; m < 4; ++m) _Pragma("unroll") for (int k = 0; k < 2; ++k) dst[m][k] = *(const LAS f16x8*)(lds + PG8_SA(b, h) + aoff + m * 2048 + k * 1024); } while (0)
#define PG8_LDB(dst, b, h) do { _Pragma("unroll") for (int n = 0; n < 2; ++n) _Pragma("unroll") for (int k = 0; k < 2; ++k) dst[n][k] = *(const LAS f16x8*)(lds + PG8_SB(b, h) + boff + n * 2048 + k * 1024); } while (0)
#define PG8_MMA(ai, bj, At, Bt) do { __builtin_amdgcn_s_setprio(1); _Pragma("unroll") for (int m = 0; m < 4; ++m) _Pragma("unroll") for (int n = 0; n < 2; ++n) _Pragma("unroll") for (int k = 0; k < 2; ++k) \
        acc[ai][bj][m][n] = __builtin_amdgcn_mfma_f32_16x16x32_f16(Bt[n][k], At[m][k], acc[ai][bj][m][n], 0, 0, 0); __builtin_amdgcn_s_setprio(0); } while (0)
#define PG8_WAIT_V(n) asm volatile("s_waitcnt vmcnt(" #n ")" ::: "memory")
#define PG8_WAIT_L(n) asm volatile("s_waitcnt lgkmcnt(" #n ")" ::: "memory")
#define PG8_BAR __builtin_amdgcn_s_barrier()
#define PG8_SCHED __builtin_amdgcn_sched_barrier(0)
    Unit cur, nxt; int ui = 0;
    if (!S.next(0, cur)) return;
    f32x4 acc[2][2][4][2];
#pragma unroll
    for (int a = 0; a < 2; ++a)
#pragma unroll
        for (int b = 0; b < 2; ++b)
#pragma unroll
            for (int m = 0; m < 4; ++m)
#pragma unroll
                for (int n = 0; n < 2; ++n) acc[a][b][m][n] = (f32x4){0.f, 0.f, 0.f, 0.f};
    f16x8 At[4][2], B0[2][2], B1[2][2];
    const char* cA = (const char*)g.A + (size_t)cur.pm * tstep; const char* cB = (const char*)g.Bt + (size_t)cur.pn * tstep;
    PG8_STAGE(PG8_SB(0, 0), cB); PG8_STAGE(PG8_SB(0, 1), cB + hstep); PG8_STAGE(PG8_SA(0, 0), cA); PG8_STAGE(PG8_SA(0, 1), cA + hstep);
    if (wr == 1) PG8_BAR;
    PG8_WAIT_V(2); PG8_BAR;
    PG8_STAGE(PG8_SB(1, 0), cB + kstep); PG8_STAGE(PG8_SA(1, 0), cA + kstep); PG8_STAGE(PG8_SB(1, 1), cB + hstep + kstep);
    PG8_WAIT_V(6); PG8_BAR;
    for (;;) {
        const bool has_next = S.next(ui + 1, nxt);
        const char* nA = has_next ? (const char*)g.A + (size_t)nxt.pm * tstep : cA; const char* nB = has_next ? (const char*)g.Bt + (size_t)nxt.pn * tstep : cB;
        for (int t = 0; t < nt; t += 2) {
            const bool last = (t == nt - 2);
            const char* a1 = cA + (size_t)(t + 1) * kstep;
            const char* a2 = last ? nA : cA + (size_t)(t + 2) * kstep; const char* b2 = last ? nB : cB + (size_t)(t + 2) * kstep;
            const char* a3 = a2 + kstep; const char* b3 = b2 + kstep;
            PG8_LDB(B0, 0, 0); PG8_LDB(B1, 0, 1); PG8_SCHED; PG8_LDA(At, 0, 0); PG8_STAGE(PG8_SA(1, 1), a1 + hstep);
            PG8_WAIT_V(8); PG8_WAIT_L(0); PG8_BAR; PG8_MMA(0, 0, At, B0); PG8_MMA(0, 1, At, B1); PG8_BAR; PG8_SCHED;
            PG8_LDA(At, 0, 1); PG8_STAGE(PG8_SB(0, 0), b2); PG8_STAGE(PG8_SB(0, 1), b2 + hstep); PG8_STAGE(PG8_SA(0, 0), a2);
            PG8_WAIT_V(8); PG8_WAIT_L(0); PG8_BAR; PG8_MMA(1, 0, At, B0); PG8_MMA(1, 1, At, B1); PG8_BAR; PG8_SCHED;
            PG8_LDB(B0, 1, 0); PG8_LDB(B1, 1, 1); PG8_SCHED; PG8_LDA(At, 1, 0); PG8_STAGE(PG8_SA(0, 1), a2 + hstep);
            PG8_WAIT_V(8); PG8_WAIT_L(0); PG8_BAR; PG8_MMA(0, 0, At, B0); PG8_MMA(0, 1, At, B1); PG8_BAR; PG8_SCHED;
            PG8_LDA(At, 1, 1); PG8_STAGE(PG8_SB(1, 0), b3); PG8_STAGE(PG8_SB(1, 1), b3 + hstep); PG8_STAGE(PG8_SA(1, 0), a3);
            PG8_WAIT_V(8); PG8_WAIT_L(0); PG8_BAR; PG8_MMA(1, 0, At, B0); PG8_MMA(1, 1, At, B1); PG8_BAR; PG8_SCHED;
        }
        if (wr == 0) PG8_BAR;
        E(acc, cur, wr, wc, fr, fq);
        if (!has_next) break;
#pragma unroll
        for (int a = 0; a < 2; ++a)
#pragma unroll
            for (int b = 0; b < 2; ++b)
#pragma unroll
                for (int m = 0; m < 4; ++m)
#pragma unroll
                    for (int n = 0; n < 2; ++n) acc[a][b][m][n] = (f32x4){0.f, 0.f, 0.f, 0.f};
        cur = nxt; cA = nA; cB = nB; ++ui;
        if (wr == 1) PG8_BAR;
    }
    PG8_WAIT_V(0);
    PG8_BAR;
#undef PG8_SA
#undef PG8_SB
#undef PG8_STAGE
#undef PG8_LDA
#undef PG8_LDB
#undef PG8_MMA
#undef PG8_WAIT_V
#undef PG8_WAIT_L
#undef PG8_BAR
#undef PG8_SCHED
}
}
constexpr int NWAVES = 8;
constexpr int MPAD = 8448, NPAD = 7936;
constexpr size_t WS_XNH = 450 * MiB;
constexpr size_t WS_WINT = 484 * MiB;
constexpr size_t WS_WOUTT = 516 * MiB;
constexpr size_t WS_NEED2 = 524 * MiB;
constexpr int RING_BYTES = 131072, SCR_OFF = RING_BYTES, SCR_BYTES = 8192, MISC_OFF = 145408, LDS_BYTES = 147456;

__device__ __forceinline__ unsigned pk_bf16(float lo, float hi) { f32x2 v = {lo, hi}; bf16x2_t b = __builtin_convertvector(v, bf16x2_t); return __builtin_bit_cast(unsigned, b); }
__device__ __forceinline__ unsigned pk_f16(float lo, float hi) { f32x2 v = {lo, hi}; f16x2 b = __builtin_convertvector(v, f16x2); return __builtin_bit_cast(unsigned, b); }

struct Args { const float* in[14]; float* out; unsigned char* ws; int ph_lo, ph_hi; };

__device__ __forceinline__ int win_src(int np) {
    const int pn = np >> 8, c = np & 255;
    if (pn < 14) return np;
    if (pn == 14) return c < 80 ? np : -1;
    const int T = pn - 15, bj = c >> 7, wc = (c >> 5) & 3, n = (c >> 4) & 1, fqi = c & 15;
    const int base = bj == 0 ? (n == 0 ? OH : OBB) : (n == 0 ? OC : OZC);
    return base + 64 * T + 16 * wc + fqi;
}
template <bool MAP>
__device__ __forceinline__ void p0_transpose_item(const float* W, int N, f16* WT, LAS float* scr, int item, int nblk, int lane) {
    const int kb = item / nblk, nb = item % nblk, k0 = 64 * kb, n0 = 32 * nb;
    const int src = MAP ? win_src(n0 + (lane & 31)) : n0 + (lane & 31);
#pragma unroll 8
    for (int i = 0; i < 32; ++i) { const int kk = 2 * i + (lane >> 5); scr[kk * 33 + (lane & 31)] = src >= 0 ? W[(size_t)(k0 + kk) * N + src] : 0.f; }
    asm volatile("s_waitcnt lgkmcnt(0)" ::: "memory");
    const int c = lane & 7;
#pragma unroll
    for (int j = 0; j < 4; ++j) { const int n = (lane >> 3) + 8 * j; const LAS float* s = scr + (8 * c) * 33 + n;
        u32x4 o; o.x = pk_f16(s[0 * 33], s[1 * 33]); o.y = pk_f16(s[2 * 33], s[3 * 33]); o.z = pk_f16(s[4 * 33], s[5 * 33]); o.w = pk_f16(s[6 * 33], s[7 * 33]);
        *(u32x4*)(WT + (size_t)(n0 + n) * 2048 + k0 + 8 * c) = o; }
    asm volatile("s_waitcnt lgkmcnt(0)" ::: "memory");
}
__device__ __forceinline__ float wave_sum(float v) {
#pragma unroll
    for (int o = 1; o < 64; o <<= 1) v += __shfl_xor(v, o);
    return v;
}
__device__ __forceinline__ void p0_prologue(const Args& a, LAS unsigned char* lds, int vcu, int G, int wave, int lane) {
    LAS float* scr = (LAS float*)(lds + wave * 16384);
    const int gw = vcu * NWAVES + wave, NGW = G * NWAVES;
    const float* win = a.in[8]; const float* wout = a.in[13];
    f16* WinT = (f16*)(a.ws + WS_WINT); f16* WoutT = (f16*)(a.ws + WS_WOUTT); f16* XN = (f16*)(a.ws + WS_XNH);
    constexpr int I_IN = 32 * (NPAD / 32), I_OUT = 32 * (DM / 32);
    for (int it = gw; it < I_IN + I_OUT; it += NGW) {
        if (it < I_IN) p0_transpose_item<true>(win, DIN, WinT, scr, it, NPAD / 32, lane);
        else p0_transpose_item<false>(wout, DM, WoutT, scr, it - I_IN, DM / 32, lane);
    }
    const float* gin = a.in[7];
    for (int m = gw; m < MT; m += NGW) {
        const float* xrow = m < MP ? a.in[0] + (size_t)m * DM : a.in[1] + (size_t)(m - MP) * DM;
        const f32x4* xr = (const f32x4*)xrow + lane; f32x4 v[8]; float s = 0.f;
#pragma unroll
        for (int j = 0; j < 8; ++j) { v[j] = xr[64 * j]; s += (v[j].x * v[j].x + v[j].y * v[j].y) + (v[j].z * v[j].z + v[j].w * v[j].w); }
        const float rs = rsqrtf(wave_sum(s) * (1.f / DM) + EPS);
        u32x2* o8 = (u32x2*)(XN + (size_t)m * DM) + lane;
#pragma unroll
        for (int j = 0; j < 8; ++j) { const f32x4 gv = ((const f32x4*)gin)[lane + 64 * j]; u32x2 w; w.x = pk_f16(v[j].x * rs * gv.x, v[j].y * rs * gv.y); w.y = pk_f16(v[j].z * rs * gv.z, v[j].w * rs * gv.w); o8[64 * j] = w; }
    }
    float* rqk = (float*)(a.ws + WS_ROPE); float* ri = (float*)(a.ws + WS_ROPE_I);
    for (int i = gw * 64 + lane; i < 2052 * 16; i += NGW * 64) {
        { int slot = i / 16, j = i % 16; int pos = slot < 2048 ? slot : PAST + (slot - 2048);
          float inv = (float)pow(500000.0, -(double)j / 16.0); float ang = (float)pos * inv;
          rqk[(slot * 16 + j) * 2] = (float)cos((double)ang); rqk[(slot * 16 + j) * 2 + 1] = (float)sin((double)ang); }
        if (i < 2052 * 8) { int slot = i / 8, j = i % 8; int pos = slot < 2048 ? slot : PAST + (slot - 2048);
          float inv = (float)pow(500000.0, -(double)j / 8.0); float ang = (float)pos * inv;
          ri[(slot * 8 + j) * 2] = (float)cos((double)ang); ri[(slot * 8 + j) * 2 + 1] = (float)sin((double)ang); }
    }
}

struct EpiIn {
    float* out; unsigned char* ws; const float* gq; const float* gk; const float* gki; LAS float* scr;
    __device__ __forceinline__ void operator()(f32x4 (&acc)[2][2][4][2], const pg8::Unit& u, int wr, int wc, int fr_, int fq_) const {
        int fr = fr_, fq = fq_; asm volatile("" : "+v"(fr), "+v"(fq));
        GAS unsigned char* ws = (GAS unsigned char*)this->ws; GAS float* out = (GAS float*)this->out; asm volatile("" : "+s"(ws), "+s"(out));
        const int pn = u.pn, pm = u.pm; const bool smp = pm == 32;
        const int rbase = 64 * wr + fr;
        const int bb = pm >> 3, t0 = (pm & 7) << 8;
        const GAS float* rqk = (const GAS float*)(ws + WS_ROPE); const GAS float* ri = (const GAS float*)(ws + WS_ROPE_I);
#define ROWLOOP _Pragma("unroll") for (int ai = 0; ai < 2; ++ai) _Pragma("unroll") for (int m = 0; m < 4; ++m)
#define ROWVARS const int r = rbase + 128 * ai + 16 * m; const bool valid = !smp || r < MS; const int grow = smp ? MP + r : pm * 256 + r; const int tt = smp ? (r & 3) : t0 + r; const int slot = smp ? 2048 + (r & 3) : tt; (void)grow; (void)tt; (void)slot; (void)valid;
        if (pn <= 4 || pn == 14) {
            const bool isk = pn == 14;
            ROWLOOP { asm volatile("" ::: "memory"); const int r = rbase + 128 * ai + 16 * m;
#pragma unroll
                for (int bj = 0; bj < 2; ++bj) { float s = 0.f;
#pragma unroll
                    for (int n = 0; n < 2; ++n) { const f32x4 x = acc[ai][bj][m][n]; s += (x[0] * x[0] + x[1] * x[1]) + (x[2] * x[2] + x[3] * x[3]); }
                    if (isk && (wc >= 2 || bj == 1)) s = 0.f;
                    s += __shfl_xor(s, 16); s += __shfl_xor(s, 32);
                    if (fq == 0) scr[(r * 2 + bj) * 4 + wc] = s; } }
            asm volatile("s_waitcnt lgkmcnt(0)" ::: "memory"); __builtin_amdgcn_s_barrier(); asm volatile("" ::: "memory");
            if (!isk) {
                const GAS float* g = (const GAS float*)(pn < 4 ? gq : gk); const int dl = 32 * wc + 4 * fq;
                const f32x4 g0 = *(const GAS f32x4*)(g + dl), g1 = *(const GAS f32x4*)(g + dl + 16);
                GAS bf16_t* Qb = (GAS bf16_t*)(ws + WS_QB); GAS bf16_t* Kb = (GAS bf16_t*)(ws + WS_KB); GAS float* QS = (GAS float*)(ws + WS_QS);
                ROWLOOP { asm volatile("" ::: "memory"); ROWVARS
                    f32x4 cs0 = {1.f, 0.f, 1.f, 0.f}, cs1 = {1.f, 0.f, 1.f, 0.f};
                    if (wc == 0) { const GAS f32x4* cp = (const GAS f32x4*)(rqk + (slot * 16 + 4 * fq) * 2); cs0 = cp[0]; cs1 = cp[1]; }
#pragma unroll
                    for (int bj = 0; bj < 2; ++bj) {
                        const f32x4 p = *(const LAS f32x4*)(scr + (r * 2 + bj) * 4);
                        const float rs = rsqrtf(((p[0] + p[1]) + (p[2] + p[3])) * (1.f / 128.f) + EPS);
                        f32x4 x0 = acc[ai][bj][m][0] * rs * g0, x1 = acc[ai][bj][m][1] * rs * g1;
                        if (wc == 0) { const f32x4 c = {cs0[0], cs0[2], cs1[0], cs1[2]}, s = {cs0[1], cs0[3], cs1[1], cs1[3]};
                            const f32x4 y0 = x0 * c - x1 * s, y1 = x1 * c + x0 * s; x0 = y0; x1 = y1; }
                        const int hh = 2 * pn + bj;
                        if (pn < 4) {
                            if (smp) { if (valid) { GAS float* q = QS + (size_t)r * 1024 + hh * 128 + dl; *(GAS f32x4*)q = x0; *(GAS f32x4*)(q + 16) = x1; } }
                            else { GAS bf16_t* q = Qb + (((size_t)bb * NH + hh) * S + tt) * HD + dl;
                                u32x2 w0 = {pk_bf16(x0[0], x0[1]), pk_bf16(x0[2], x0[3])}, w1 = {pk_bf16(x1[0], x1[1]), pk_bf16(x1[2], x1[3])};
                                *(GAS u32x2*)q = w0; *(GAS u32x2*)(q + 16) = w1; }
                        } else {
                            if (smp) { if (valid) { GAS float* k = out + O_KS + (size_t)r * 256 + bj * 128 + dl; *(GAS f32x4*)k = x0; *(GAS f32x4*)(k + 16) = x1; } }
                            else { GAS float* k = out + O_KP + (size_t)grow * 256 + bj * 128 + dl; *(GAS f32x4*)k = x0; *(GAS f32x4*)(k + 16) = x1;
                                GAS bf16_t* kb = Kb + (((size_t)bb * NKV + bj) * S + tt) * HD + dl;
                                u32x2 w0 = {pk_bf16(x0[0], x0[1]), pk_bf16(x0[2], x0[3])}, w1 = {pk_bf16(x1[0], x1[1]), pk_bf16(x1[2], x1[3])};
                                *(GAS u32x2*)kb = w0; *(GAS u32x2*)(kb + 16) = w1; }
                        } } }
            } else {
                const int dl = 32 * (wc & 1) + 4 * fq;
                const f32x4 g0 = *(const GAS f32x4*)((const GAS float*)gki + dl), g1 = *(const GAS f32x4*)((const GAS float*)gki + dl + 16);
                GAS f16* KI = (GAS f16*)(ws + WS_KI); GAS float* WI = (GAS float*)(ws + WS_WI);
                ROWLOOP { asm volatile("" ::: "memory"); ROWVARS
                    const f32x4 p = *(const LAS f32x4*)(scr + (r * 2) * 4);
                    const float rs = rsqrtf((p[0] + p[1]) * (1.f / 64.f) + EPS);
                    f32x4 x0 = acc[ai][0][m][0] * rs * g0, x1 = acc[ai][0][m][1] * rs * g1;
                    f32x4 xo; xo[0] = __shfl_xor(x0[0], 32); xo[1] = __shfl_xor(x0[1], 32); xo[2] = __shfl_xor(x0[2], 32); xo[3] = __shfl_xor(x0[3], 32);
                    if (wc == 0) { const GAS f32x4* cp = (const GAS f32x4*)(ri + (slot * 8 + 4 * (fq & 1)) * 2); const f32x4 cs0 = cp[0], cs1 = cp[1];
                        const f32x4 c = {cs0[0], cs0[2], cs1[0], cs1[2]}, s = {cs0[1], cs0[3], cs1[1], cs1[3]};
                        x0 = fq < 2 ? x0 * c - xo * s : x0 * c + xo * s; }
                    if (wc < 2 && valid) {
                        GAS float* ko = smp ? out + O_KIS + (size_t)r * 64 + dl : out + O_KIP + (size_t)grow * 64 + dl;
                        *(GAS f32x4*)ko = x0; *(GAS f32x4*)(ko + 16) = x1;
                        if (!smp) { GAS f16* kh = KI + (size_t)grow * 64 + dl; u32x2 w0 = {pk_f16(x0[0], x0[1]), pk_f16(x0[2], x0[3])}, w1 = {pk_f16(x1[0], x1[1]), pk_f16(x1[2], x1[3])};
                            *(GAS u32x2*)kh = w0; *(GAS u32x2*)(kh + 16) = w1; } }
                    if (wc == 2 && valid) *(GAS f32x4*)(WI + (size_t)grow * 16 + 4 * fq) = acc[ai][0][m][0] * (1.f / 32.f);
                }
            }
        } else if (pn == 5) {
            GAS bf16_t* Vb = (GAS bf16_t*)(ws + WS_VB); const int dl = 32 * wc + 4 * fq;
            ROWLOOP { asm volatile("" ::: "memory"); ROWVARS
#pragma unroll
                for (int bj = 0; bj < 2; ++bj) { const f32x4 x0 = acc[ai][bj][m][0], x1 = acc[ai][bj][m][1];
                    if (smp) { if (valid) { GAS float* v = out + O_VS + (size_t)r * 256 + bj * 128 + dl; *(GAS f32x4*)v = x0; *(GAS f32x4*)(v + 16) = x1; } }
                    else { GAS float* v = out + O_VP + (size_t)grow * 256 + bj * 128 + dl; *(GAS f32x4*)v = x0; *(GAS f32x4*)(v + 16) = x1;
                        GAS bf16_t* vb = Vb + (((size_t)bb * NKV + bj) * S + tt) * HD + dl;
                        u32x2 w0 = {pk_bf16(x0[0], x0[1]), pk_bf16(x0[2], x0[3])}, w1 = {pk_bf16(x1[0], x1[1]), pk_bf16(x1[2], x1[3])};
                        *(GAS u32x2*)vb = w0; *(GAS u32x2*)(vb + 16) = w1; } } }
        } else if (pn <= 9) {
            GAS f16* SZ = (GAS f16*)(ws + WS_SZ); const int c0 = 256 * (pn - 6) + 32 * wc + 4 * fq;
            ROWLOOP { asm volatile("" ::: "memory"); ROWVARS
                if (valid) {
#pragma unroll
                    for (int bj = 0; bj < 2; ++bj)
#pragma unroll
                        for (int n = 0; n < 2; ++n) { const f32x4 x = acc[ai][bj][m][n]; u32x2 w = {pk_f16(silu(x[0]), silu(x[1])), pk_f16(silu(x[2]), silu(x[3]))};
                            *(GAS u32x2*)(SZ + (size_t)grow * 1024 + c0 + 128 * bj + 16 * n) = w; } } }
        } else if (pn <= 13) {
            GAS f16* QI = (GAS f16*)(ws + WS_QI); const int c0 = 256 * (pn - 10) + 32 * wc + 4 * fq;
            ROWLOOP { asm volatile("" ::: "memory"); ROWVARS
                f32x4 c = {1.f, 1.f, 1.f, 1.f}, s = {0.f, 0.f, 0.f, 0.f};
                if ((wc & 1) == 0) { const GAS f32x4* cp = (const GAS f32x4*)(ri + (slot * 8 + 4 * (fq & 1)) * 2); const f32x4 cs0 = cp[0], cs1 = cp[1];
                    c = (f32x4){cs0[0], cs0[2], cs1[0], cs1[2]}; s = (f32x4){cs0[1], cs0[3], cs1[1], cs1[3]}; }
#pragma unroll
                for (int bj = 0; bj < 2; ++bj) { f32x4 x0 = acc[ai][bj][m][0]; const f32x4 x1 = acc[ai][bj][m][1];
                    f32x4 xo; xo[0] = __shfl_xor(x0[0], 32); xo[1] = __shfl_xor(x0[1], 32); xo[2] = __shfl_xor(x0[2], 32); xo[3] = __shfl_xor(x0[3], 32);
                    if ((wc & 1) == 0) x0 = fq < 2 ? x0 * c - xo * s : x0 * c + xo * s;
                    if (valid) { GAS f16* q = QI + (size_t)grow * 1024 + c0 + 128 * bj;
                        u32x2 w0 = {pk_f16(x0[0], x0[1]), pk_f16(x0[2], x0[3])}, w1 = {pk_f16(x1[0], x1[1]), pk_f16(x1[2], x1[3])};
                        *(GAS u32x2*)q = w0; *(GAS u32x2*)(q + 16) = w1; } } }
        } else {
            GAS f16* U = (GAS f16*)(ws + WS_U); GAS f16* G = (GAS f16*)(ws + WS_G); const int ch = 64 * (pn - 15) + 16 * wc + 4 * fq;
            ROWLOOP { asm volatile("" ::: "memory"); ROWVARS
                const f32x4 h = acc[ai][0][m][0], b = acc[ai][0][m][1], c = acc[ai][1][m][0], z = acc[ai][1][m][1];
                const f32x4 uu = c * h; f32x4 gg; gg[0] = b[0] * silu(z[0]); gg[1] = b[1] * silu(z[1]); gg[2] = b[2] * silu(z[2]); gg[3] = b[3] * silu(z[3]);
                if (valid) { u32x2 wu = {pk_f16(uu[0], uu[1]), pk_f16(uu[2], uu[3])}, wg = {pk_f16(gg[0], gg[1]), pk_f16(gg[2], gg[3])};
                    *(GAS u32x2*)(U + (size_t)grow * 1024 + ch) = wu; *(GAS u32x2*)(G + (size_t)grow * 1024 + ch) = wg;
                    if (!smp && tt >= S - 2) *(GAS f32x4*)(out + O_CVP + ((size_t)bb * 2 + (tt - (S - 2))) * 1024 + ch) = uu;
                    if (smp && tt >= 2) *(GAS f32x4*)(out + O_CVS + ((size_t)(r >> 2) * 2 + (tt - 2)) * 1024 + ch) = uu; } }
        }
#undef ROWLOOP
#undef ROWVARS
    }
};


struct EpiOut {
    float* out; const float* xp;
    __device__ __forceinline__ void operator()(f32x4 (&acc)[2][2][4][2], const pg8::Unit& u, int wr, int wc, int fr_, int fq_) const {
        int fr = fr_, fq = fq_; asm volatile("" : "+v"(fr), "+v"(fq));
        GAS float* out = (GAS float*)this->out; const GAS float* xp = (const GAS float*)this->xp; asm volatile("" : "+s"(out), "+s"(xp));
        const size_t base = (size_t)(u.pm * 256 + 64 * wr + fr) * DM + u.pn * 256 + 32 * wc + 4 * fq;
#pragma unroll
        for (int ai = 0; ai < 2; ++ai)
#pragma unroll
            for (int m = 0; m < 4; ++m) { asm volatile("" ::: "memory"); const size_t off = base + (size_t)(128 * ai + 16 * m) * DM;
#pragma unroll
                for (int bj = 0; bj < 2; ++bj)
#pragma unroll
                    for (int n = 0; n < 2; ++n) { const f32x4 xv = *(const GAS f32x4*)(xp + off + 128 * bj + 16 * n); *(GAS f32x4*)(out + off + 128 * bj + 16 * n) = xv + acc[ai][bj][m][n]; } }
    }
};
__device__ __forceinline__ void p4_sample(const Args& a, LAS unsigned char* lds, int bx, int G, int tid) {
    const f16* MIX = (const f16*)(a.ws + WS_MIX) + (size_t)MP * DM; const f16* WT = (const f16*)(a.ws + WS_WOUTT);
    LAS float* part = (LAS float*)lds;
    const int r = tid & 31, cn = (tid >> 5) & 7, ks = tid >> 8;
    for (int cg = bx; cg < DM / 8; cg += G) {
        const int col = cg * 8 + cn;
        const f16x8* mp = (const f16x8*)(MIX + (size_t)r * DM + ks * 1024); const f16x8* wp = (const f16x8*)(WT + (size_t)col * DM + ks * 1024);
        float s0 = 0.f, s1 = 0.f;
#pragma unroll 4
        for (int k = 0; k < 128; ++k) { const f16x8 mv = mp[k], wv = wp[k];
            s0 = __builtin_amdgcn_fdot2((f16x2){mv[0], mv[1]}, (f16x2){wv[0], wv[1]}, s0, false); s1 = __builtin_amdgcn_fdot2((f16x2){mv[2], mv[3]}, (f16x2){wv[2], wv[3]}, s1, false);
            s0 = __builtin_amdgcn_fdot2((f16x2){mv[4], mv[5]}, (f16x2){wv[4], wv[5]}, s0, false); s1 = __builtin_amdgcn_fdot2((f16x2){mv[6], mv[7]}, (f16x2){wv[6], wv[7]}, s1, false); }
        part[(ks * 32 + r) * 8 + cn] = s0 + s1;
        __syncthreads();
        if (tid < 256) { const int rr = tid >> 3, cc = tid & 7; a.out[O_YS + (size_t)rr * DM + cg * 8 + cc] = a.in[1][(size_t)rr * DM + cg * 8 + cc] + part[rr * 8 + cc] + part[(32 + rr) * 8 + cc]; }
        __syncthreads();
    }
}

constexpr int SC_STRIDE = 2052;
constexpr int SC_BYTES = 16 * SC_STRIDE * 4;
constexpr int WSCR_OFF = 131584, WSCR_BYTES = 1536;
__device__ __forceinline__ f16x8 cvt8(f32x4 a, f32x4 b) { u32x4 w = {pk_f16(a[0], a[1]), pk_f16(a[2], a[3]), pk_f16(b[0], b[1]), pk_f16(b[2], b[3])}; return __builtin_bit_cast(f16x8, w); }

__device__ __forceinline__ void p2_convmix(const Args& a, int gw, int NGW, int lane) {
    const GAS f16* U = (const GAS f16*)(a.ws + WS_U); const GAS f16* Gm = (const GAS f16*)(a.ws + WS_G); GAS f16* MIX = (GAS f16*)(a.ws + WS_MIX);
    const GAS float* wconv = (const GAS float*)a.in[12]; const GAS float* state = (const GAS float*)a.in[5];
    for (int ch = gw; ch < MT / 4; ch += NGW) {
        const int row0 = 4 * ch; const bool smp = row0 >= MP; const int t0 = smp ? 0 : (row0 & (S - 1)); const int seq = (row0 - MP) >> 2;
#pragma unroll
        for (int half = 0; half < 2; ++half) { const int cb = half * 512 + 8 * lane;
            float um2[8], um1[8], w0[8], w1[8], w2[8];
#pragma unroll
            for (int e = 0; e < 8; e += 4) { const f32x4 a0 = *(const GAS f32x4*)(wconv + cb + e), a1 = *(const GAS f32x4*)(wconv + 1024 + cb + e), a2 = *(const GAS f32x4*)(wconv + 2048 + cb + e);
#pragma unroll
                for (int i = 0; i < 4; ++i) { w0[e + i] = a0[i]; w1[e + i] = a1[i]; w2[e + i] = a2[i]; } }
            if (t0 == 0) {
                if (smp) {
#pragma unroll
                    for (int e = 0; e < 8; e += 4) { const f32x4 s0 = *(const GAS f32x4*)(state + ((size_t)seq * 2) * 1024 + cb + e), s1 = *(const GAS f32x4*)(state + ((size_t)seq * 2 + 1) * 1024 + cb + e);
#pragma unroll
                        for (int i = 0; i < 4; ++i) { um2[e + i] = s0[i]; um1[e + i] = s1[i]; } }
                } else {
#pragma unroll
                    for (int e = 0; e < 8; ++e) { um2[e] = 0.f; um1[e] = 0.f; } }
            } else { const f16x8 p2 = *(const GAS f16x8*)(U + (size_t)(row0 - 2) * 1024 + cb), p1 = *(const GAS f16x8*)(U + (size_t)(row0 - 1) * 1024 + cb);
#pragma unroll
                for (int e = 0; e < 8; ++e) { um2[e] = (float)p2[e]; um1[e] = (float)p1[e]; } }
#pragma unroll
            for (int i = 0; i < 4; ++i) { const size_t row = row0 + i;
                const f16x8 uv = *(const GAS f16x8*)(U + row * 1024 + cb), gv = *(const GAS f16x8*)(Gm + row * 1024 + cb); float o[8];
#pragma unroll
                for (int e = 0; e < 8; ++e) { const float u = (float)uv[e]; const float cv = w0[e] * um2[e] + w1[e] * um1[e] + w2[e] * u; o[e] = (float)gv[e] * cv; um2[e] = um1[e]; um1[e] = u; }
                u32x4 w = {pk_f16(o[0], o[1]), pk_f16(o[2], o[3]), pk_f16(o[4], o[5]), pk_f16(o[6], o[7])};
                *(GAS u32x4*)(MIX + row * 2048 + 1024 + cb) = w; }
        }
    }
}

__device__ __forceinline__ void p2_sscore(const Args& a, int gw, int NGW, int lane) {
    const GAS float* cki = (const GAS float*)a.in[4]; const GAS int* ptab = (const GAS int*)a.in[6];
    const GAS f16* QI = (const GAS f16*)(a.ws + WS_QI); const GAS float* WI = (const GAS float*)(a.ws + WS_WI); GAS float* SSC = (GAS float*)(a.ws + WS_SSC);
    const int fr = lane & 15, fq = lane >> 4;
    for (int it = gw; it < NSB * 256; it += NGW) {
        const int sb = it >> 8, hp = it & 255, pg = hp >> 1, k0 = (hp & 1) * 64; const int phys = ptab[sb * NPAGES + pg];
        const GAS float* kbase = cki + ((size_t)phys * PAGE + k0) * 64;
        f16x8 qf[4][2]; f32x4 wv[4];
#pragma unroll
        for (int t = 0; t < 4; ++t) { const size_t row = MP + 4 * sb + t;
            qf[t][0] = *(const GAS f16x8*)(QI + row * 1024 + fr * 64 + 8 * fq); qf[t][1] = *(const GAS f16x8*)(QI + row * 1024 + fr * 64 + 32 + 8 * fq);
            wv[t] = *(const GAS f32x4*)(WI + row * 16 + 4 * fq); }
#pragma unroll
        for (int tile = 0; tile < 4; ++tile) {
            const GAS float* kr = kbase + (size_t)(16 * tile + fr) * 64 + 8 * fq;
            const f16x8 kf0 = cvt8(*(const GAS f32x4*)kr, *(const GAS f32x4*)(kr + 4)), kf1 = cvt8(*(const GAS f32x4*)(kr + 32), *(const GAS f32x4*)(kr + 36));
            float mine = 0.f;
#pragma unroll
            for (int t = 0; t < 4; ++t) { f32x4 c = {0.f, 0.f, 0.f, 0.f};
                c = __builtin_amdgcn_mfma_f32_16x16x32_f16(qf[t][0], kf0, c, 0, 0, 0); c = __builtin_amdgcn_mfma_f32_16x16x32_f16(qf[t][1], kf1, c, 0, 0, 0);
                float s = wv[t][0] * fmaxf(c[0], 0.f) + wv[t][1] * fmaxf(c[1], 0.f) + wv[t][2] * fmaxf(c[2], 0.f) + wv[t][3] * fmaxf(c[3], 0.f);
                s += __shfl_xor(s, 16); s += __shfl_xor(s, 32);
                mine = fq == t ? s : mine; }
            SSC[(size_t)(4 * sb + fq) * PAST + pg * PAGE + k0 + 16 * tile + fr] = mine;
        }
    }
}

__device__ __forceinline__ void wave_topk_mask(const LAS float* row, int t, GAS unsigned long long* mrow, int lane) {
    unsigned k[32];
#pragma unroll
    for (int j = 0; j < 32; ++j) { const int s = 64 * j + lane; const float v = row[s]; k[j] = s <= t ? fkey(v) : 0u; }
    unsigned tau = 0u;
    for (int bit = 31; bit >= 0; --bit) { const unsigned cand = tau | (1u << bit); int cnt = 0;
#pragma unroll
        for (int j = 0; j < 32; ++j) cnt += __builtin_popcountll(__ballot(k[j] >= cand));
        if (cnt >= TOPK) tau = cand; }
    unsigned wlo = 0u, whi = 0u;
#pragma unroll
    for (int j = 0; j < 32; ++j) { const unsigned long long m = __ballot(k[j] >= tau); if (lane == j) { wlo = (unsigned)m; whi = (unsigned)(m >> 32); } }
    if (lane < 32) mrow[lane] = ((unsigned long long)whi << 32) | wlo;
}

#define RELU_FMA(acc_, c_, w_) do { const float r_ = fmaxf((c_), 0.f); asm("v_fmac_f32_e32 %0, %1, %2" : "+v"(acc_) : "v"(r_), "v"(w_)); } while (0)
__device__ __forceinline__ void p2_index_tile(const Args& a, LAS unsigned char* lds, int b, int t0, int wave, int lane) {
    const GAS f16* QI = (const GAS f16*)(a.ws + WS_QI); const GAS float* WI = (const GAS float*)(a.ws + WS_WI); const GAS f16* KI = (const GAS f16*)(a.ws + WS_KI);
    GAS unsigned long long* MASK = (GAS unsigned long long*)(a.ws + WS_MASK);
    LAS float* sc = (LAS float*)lds;
    const int fr = lane & 15, fq = lane >> 4; const size_t rowq = (size_t)b * S + t0 + fr;
    f16x8 qf[16][2]; float w[16];
#pragma unroll
    for (int h = 0; h < 16; ++h) { qf[h][0] = *(const GAS f16x8*)(QI + rowq * 1024 + h * 64 + 8 * fq); qf[h][1] = *(const GAS f16x8*)(QI + rowq * 1024 + h * 64 + 32 + 8 * fq); }
#pragma unroll
    for (int h = 0; h < 16; h += 4) { const f32x4 x = *(const GAS f32x4*)(WI + rowq * 16 + h); w[h] = x[0]; w[h + 1] = x[1]; w[h + 2] = x[2]; w[h + 3] = x[3]; }
    const int nkt = (t0 + 16) >> 4;
    const GAS f16* kp = KI + ((size_t)b * S + fr) * 64 + 8 * fq;
    for (int kt = wave; kt < nkt; kt += NWAVES) {
        const f16x8 kf0 = *(const GAS f16x8*)(kp + (size_t)kt * 1024), kf1 = *(const GAS f16x8*)(kp + (size_t)kt * 1024 + 32);
        float a0 = 0.f, a1 = 0.f, a2 = 0.f, a3 = 0.f;
#pragma unroll
        for (int h = 0; h < 16; ++h) { f32x4 c = {0.f, 0.f, 0.f, 0.f};
            c = __builtin_amdgcn_mfma_f32_16x16x32_f16(kf0, qf[h][0], c, 0, 0, 0); c = __builtin_amdgcn_mfma_f32_16x16x32_f16(kf1, qf[h][1], c, 0, 0, 0);
            RELU_FMA(a0, c[0], w[h]); RELU_FMA(a1, c[1], w[h]); RELU_FMA(a2, c[2], w[h]); RELU_FMA(a3, c[3], w[h]); }
        *(LAS f32x4*)(sc + fr * SC_STRIDE + 16 * kt + 4 * fq) = (f32x4){a0, a1, a2, a3};
    }
    __syncthreads();
#pragma unroll 1
    for (int qq = 0; qq < 2; ++qq) { const int q = 2 * wave + qq; const int t = t0 + q;
        wave_topk_mask(sc + q * SC_STRIDE, t, MASK + ((size_t)b * S + t) * 32, lane); }
    __syncthreads();
}

__device__ __forceinline__ void p2_phase(const Args& a, LAS unsigned char* lds, int vcu, int G, int wave, int lane) {
    const int gw = vcu * NWAVES + wave, NGW = G * NWAVES;
    p2_sscore(a, gw, NGW, lane);
    p2_convmix(a, gw, NGW, lane);
    { GAS unsigned long long* MASK = (GAS unsigned long long*)(a.ws + WS_MASK);
      for (int i = gw * 64 + lane; i < NB * TOPK * 32; i += NGW * 64) { const int wd = i & 31, t = (i >> 5) & (TOPK - 1), b = i >> 13; const int lo = 64 * wd;
          const unsigned long long m = lo + 63 <= t ? ~0ull : (lo > t ? 0ull : ((1ull << (t - lo + 1)) - 1ull));
          MASK[((size_t)b * S + t) * 32 + wd] = m; } }
    constexpr int NT = NB * (S - TOPK) / 16;
    for (int r = 0; r * G < NT; ++r) { const int k = (r & 1) ? (r + 1) * G - 1 - vcu : r * G + vcu;
        if (k < NT) { const int j = (NT / NB - 1) - (k >> 2), b = k & 3; p2_index_tile(a, lds, b, TOPK + 16 * j, wave, lane); } }
}

namespace att {
typedef short bf16x8 __attribute__((ext_vector_type(8)));
typedef short s16x4 __attribute__((ext_vector_type(4)));
typedef float f32x16 __attribute__((ext_vector_type(16)));
constexpr int QBLK = 32, KVBLK = 64, D = 128;
constexpr int SHM_V = KVBLK * D * 2, SHM_K = KVBLK * D * 2;
constexpr int WS_OFF = 2 * SHM_V + 2 * SHM_K;
constexpr float SCALE = 0.08838834764831845f;
#define KSWZ(row, colB) ((row) * 256 + ((colB) ^ (((row) & 7) << 4)))
#define SBAR() __builtin_amdgcn_sched_barrier(0)
__device__ __forceinline__ int v_st(int k, int c) { const int kk = (k & ~0xC) | ((k & 4) << 1) | ((k & 8) >> 1); return ((kk >> 3) * 4 + (c >> 5)) * 512 + ((kk & 7) * 32 + (c & 31)) * 2; }
__device__ __forceinline__ int v_rd_base(int lane) { return ((lane & 3) << 3) | (((lane >> 2) & 3) << 6) | (((lane >> 4) & 1) << 5) | (((lane >> 5) & 1) << 8); }
constexpr int v_rd_off(int d0, int ks, int half) { return d0 * 512 + ks * 4096 + half * 2048; }
__device__ __forceinline__ int crow(int r, int hi) { return (r & 3) + 8 * (r >> 2) + 4 * hi; }
__device__ __forceinline__ unsigned cvtpk(float lo, float hi) { return pk_bf16(lo, hi); }

template <int KB>
__device__ __forceinline__ void qkt(f32x16& p0, f32x16& p1, const LAS unsigned char* K_lds, int r32, int hi, const LAS unsigned char* qp) {
    p0 = f32x16{}; p1 = f32x16{};
    const LAS unsigned char* kb[4];
#pragma unroll
    for (int dd = 0; dd < 4; ++dd) kb[dd] = K_lds + KB * SHM_K + KSWZ(r32, (dd * 16 + hi * 8) * 2);
#pragma unroll
    for (int d0 = 0; d0 < 8; ++d0) { const LAS unsigned char* a = kb[d0 & 3] + (d0 >> 2) * 128;
        const bf16x8 b0 = *(const LAS bf16x8*)a;
        const bf16x8 b1 = *(const LAS bf16x8*)(a + 32 * 256);
        const bf16x8 qv = *(const LAS bf16x8*)(qp + d0 * 1024);
        p0 = __builtin_amdgcn_mfma_f32_32x32x16_bf16(b0, qv, p0, 0, 0, 0);
        p1 = __builtin_amdgcn_mfma_f32_32x32x16_bf16(b1, qv, p1, 0, 0, 0); }
}
template <int VB>
__device__ __forceinline__ void pv_tile(f32x16* o, int vb0, bf16x8 pa0, bf16x8 pa1, bf16x8 pa2, bf16x8 pa3) {
#define TRRD(dst, off) asm volatile("ds_read_b64_tr_b16 %0, %1 offset:%2" : "=&v"(dst) : "v"(vb0), "i"(off) : "memory")
#define PV_D0(d0) do { s16x4 l0, l1, l2, l3, h0, h1, h2, h3; constexpr int b_ = VB * SHM_V + v_rd_off(d0, 0, 0); \
        TRRD(l0, b_); TRRD(h0, b_ + 2048); TRRD(l1, b_ + 4096); TRRD(h1, b_ + 6144); TRRD(l2, b_ + 8192); TRRD(h2, b_ + 10240); TRRD(l3, b_ + 12288); TRRD(h3, b_ + 14336); \
        asm volatile("s_waitcnt lgkmcnt(0)" ::: "memory"); SBAR(); \
        o[d0] = __builtin_amdgcn_mfma_f32_32x32x16_bf16(pa0, (bf16x8){l0[0], l0[1], l0[2], l0[3], h0[0], h0[1], h0[2], h0[3]}, o[d0], 0, 0, 0); \
        o[d0] = __builtin_amdgcn_mfma_f32_32x32x16_bf16(pa1, (bf16x8){l1[0], l1[1], l1[2], l1[3], h1[0], h1[1], h1[2], h1[3]}, o[d0], 0, 0, 0); \
        o[d0] = __builtin_amdgcn_mfma_f32_32x32x16_bf16(pa2, (bf16x8){l2[0], l2[1], l2[2], l2[3], h2[0], h2[1], h2[2], h2[3]}, o[d0], 0, 0, 0); \
        o[d0] = __builtin_amdgcn_mfma_f32_32x32x16_bf16(pa3, (bf16x8){l3[0], l3[1], l3[2], l3[3], h3[0], h3[1], h3[2], h3[3]}, o[d0], 0, 0, 0); } while (0)
    PV_D0(0); PV_D0(1); PV_D0(2); PV_D0(3);
#undef PV_D0
#undef TRRD
}
__device__ __forceinline__ void partialSM(f32x16& p0, f32x16& p1, unsigned wl, unsigned wh, float sh2) {
    const float NEG = -__builtin_inff(); constexpr float C2 = 1.4426950408889634f * SCALE;
#pragma unroll
    for (int r = 0; r < 16; ++r) { const unsigned bit = 1u << ((r & 3) + 8 * (r >> 2));
        p0[r] = (wl & bit) ? fmaf(p0[r], C2, -sh2) : NEG; p1[r] = (wh & bit) ? fmaf(p1[r], C2, -sh2) : NEG; }
#pragma unroll
    for (int r = 0; r < 16; ++r) p0[r] = __builtin_amdgcn_exp2f(p0[r]);
}
__device__ __forceinline__ void finishSM(f32x16& p0, f32x16& p1, float& l_reg, bf16x8& pa0, bf16x8& pa1, bf16x8& pa2, bf16x8& pa3) {
#pragma unroll
    for (int r = 0; r < 16; ++r) p1[r] = __builtin_amdgcn_exp2f(p1[r]);
    float ps = 0;
#pragma unroll
    for (int r = 0; r < 16; ++r) ps += p0[r];
#pragma unroll
    for (int r = 0; r < 16; ++r) ps += p1[r];
    l_reg += ps;
#define PK4(P, B_, OUT) do { unsigned a0 = cvtpk(P[B_+0], P[B_+1]), a1 = cvtpk(P[B_+2], P[B_+3]); \
        unsigned b0 = cvtpk(P[B_+4], P[B_+5]), b1 = cvtpk(P[B_+6], P[B_+7]); \
        auto r0 = __builtin_amdgcn_permlane32_swap(a0, b0, false, false); auto r1 = __builtin_amdgcn_permlane32_swap(a1, b1, false, false); \
        u32x4 w = {r0[0], r1[0], r0[1], r1[1]}; OUT = __builtin_bit_cast(bf16x8, w); } while (0)
    PK4(p0, 0, pa0); PK4(p0, 8, pa1); PK4(p1, 0, pa2); PK4(p1, 8, pa3);
#undef PK4
}

__device__ __forceinline__ __amdgpu_buffer_rsrc_t mk_rsrc(const GAS void* p, unsigned bytes) {
    const unsigned long long u = (unsigned long long)p; const unsigned lo = __builtin_amdgcn_readfirstlane((unsigned)u), hi = __builtin_amdgcn_readfirstlane((unsigned)(u >> 32));
    return __builtin_amdgcn_make_buffer_rsrc((void*)(((unsigned long long)hi << 32) | lo), (short)0, (int)bytes, 0x00020000);
}
__device__ __forceinline__ void attn_block(const Args& a, LAS unsigned char* lds, int b, int kvh, int q0, float sh2) {
    int tid_ = threadIdx.x; asm volatile("" : "+v"(tid_));
    const int tid = tid_, wid = __builtin_amdgcn_readfirstlane(tid >> 6), lane = tid & 63, r32 = lane & 31, hi = lane >> 5;
    const int head = 4 * kvh + (wid >> 1), qw = q0 + 32 * (wid & 1);
    const GAS bf16_t* Qw = (const GAS bf16_t*)(a.ws + WS_QB) + (((size_t)b * NH + head) * S + qw) * D;
    const GAS bf16_t* Kh = (const GAS bf16_t*)(a.ws + WS_KB) + ((size_t)b * NKV + kvh) * S * D;
    const GAS bf16_t* Vh = (const GAS bf16_t*)(a.ws + WS_VB) + ((size_t)b * NKV + kvh) * S * D;
    const __amdgpu_buffer_rsrc_t rK = mk_rsrc(Kh, S * D * 2), rV = mk_rsrc(Vh, S * D * 2), rM = mk_rsrc((const GAS unsigned long long*)(a.ws + WS_MASK) + ((size_t)b * S + qw) * 32, 32 * 256);
    const unsigned moff = (unsigned)r32 * 256u;
    const int NT = q0 / KVBLK + 1;
    LAS unsigned char* V_lds = lds; LAS unsigned char* K_lds = lds + 2 * SHM_V;
    const int sr = tid >> 4, sc = (tid & 15) * 8, vst0 = v_st(sr, sc), vst1 = v_st(32 + sr, sc), kws = KSWZ(sr, sc * 2);
    const int vb0 = (int)(unsigned)(size_t)V_lds + v_rd_base(lane); const unsigned kvoff = (unsigned)(sr * D + sc) * 2u;
    bf16x8 st_v0, st_v1, st_k0, st_k1;
    LAS unsigned char* qp = lds + WS_OFF + 2048 + wid * 8192 + lane * 16;
#define VMW() asm volatile("s_waitcnt vmcnt(0)" ::: "memory")
#define BL128(r_, so_) __builtin_bit_cast(bf16x8, __builtin_amdgcn_raw_buffer_load_b128(r_, kvoff, (so_), 0))
#define SLOAD_H(k0) do { const int so_ = (k0) * 256; st_v0 = BL128(rV, so_); st_v1 = BL128(rV, so_ + 8192); st_k0 = BL128(rK, so_); st_k1 = BL128(rK, so_ + 8192); } while (0)
#define SWRITE_HK(bf) do { *(LAS bf16x8*)(K_lds + (bf) * SHM_K + kws) = st_k0; *(LAS bf16x8*)(K_lds + (bf) * SHM_K + kws + 32 * 256) = st_k1; } while (0)
#define SWRITE_HV(bf) do { *(LAS bf16x8*)(V_lds + (bf) * SHM_V + vst0) = st_v0; *(LAS bf16x8*)(V_lds + (bf) * SHM_V + vst1) = st_v1; } while (0)
#define SWRITE_H(bf) do { SWRITE_HV(bf); SWRITE_HK(bf); } while (0)
#define MLOAD(t) __builtin_bit_cast(unsigned long long, __builtin_amdgcn_raw_buffer_load_b64(rM, moff, (t) * 8, 0))
#define MSPLIT(mw, wl, wh) do { wl = (unsigned)(mw) >> (4 * hi); wh = (unsigned)((mw) >> 32) >> (4 * hi); } while (0)
    { bf16x8 qt[8];
#pragma unroll
      for (int d0 = 0; d0 < 8; ++d0) qt[d0] = *(const GAS bf16x8*)(Qw + (unsigned)(r32 * D + d0 * 16 + hi * 8));
#pragma unroll
      for (int d0 = 0; d0 < 8; ++d0) *(LAS bf16x8*)(qp + d0 * 1024) = qt[d0]; }
    SLOAD_H(0); unsigned long long mwA = MLOAD(0), mwB = 0ull; VMW(); SWRITE_H(0);
    if (NT > 1) { SLOAD_H(KVBLK); mwB = MLOAD(1); }
    __syncthreads();
    float l_reg = 0.f; f32x16 o[4] = {};
    f32x16 p0, p1; bf16x8 pa0, pa1, pa2, pa3; unsigned wl, wh;
    SBAR(); qkt<0>(p0, p1, K_lds, r32, hi, qp);
    MSPLIT(mwA, wl, wh); partialSM(p0, p1, wl, wh, sh2);
    if (NT > 1) { VMW(); SWRITE_H(1); }
    __syncthreads();
#define STEP(t, KB, VB) do { \
        finishSM(p0, p1, l_reg, pa0, pa1, pa2, pa3); SBAR(); \
        if ((t) + 1 < NT) { SLOAD_H(((t) + 1) * KVBLK); mwA = MLOAD((t) + 1); SBAR(); } \
        pv_tile<VB>(o, vb0, pa0, pa1, pa2, pa3); SBAR(); \
        qkt<KB>(p0, p1, K_lds, r32, hi, qp); \
        MSPLIT(mwB, wl, wh); partialSM(p0, p1, wl, wh, sh2); mwB = mwA; \
        __syncthreads(); \
        if ((t) + 1 < NT) { VMW(); SWRITE_H(VB); } \
        __syncthreads(); } while (0)
    int t = 1;
    for (; t + 1 < NT; t += 2) { STEP(t, 1, 0); STEP(t + 1, 0, 1); }
    if (t < NT) { STEP(t, 1, 0); }
    finishSM(p0, p1, l_reg, pa0, pa1, pa2, pa3); SBAR();
    if ((NT - 1) & 1) pv_tile<1>(o, vb0, pa0, pa1, pa2, pa3); else pv_tile<0>(o, vb0, pa0, pa1, pa2, pa3);
    { auto rr = __builtin_amdgcn_permlane32_swap(__float_as_uint(l_reg), __float_as_uint(l_reg), false, false); l_reg = __uint_as_float(rr[0]) + __uint_as_float(rr[1]); }
    { int te = threadIdx.x; asm volatile("" : "+v"(te));
      const int le = te & 63, r32e = le & 31, hie = le >> 5;
      LAS float* wse = (LAS float*)(lds + WS_OFF) + wid * 64;
      if (hie == 0) wse[r32e] = l_reg;
      asm volatile("s_waitcnt lgkmcnt(0)" ::: "memory");
      __syncthreads();
      LAS f16* stg = (LAS f16*)(lds + wid * 8192);
#pragma unroll
      for (int r = 0; r < 16; ++r) { const int orow = crow(r, hie); const float rl = __builtin_amdgcn_rcpf(wse[orow]);
#pragma unroll
          for (int d0 = 0; d0 < 4; ++d0) stg[orow * 128 + d0 * 32 + r32e] = (f16)(o[d0][r] * rl); }
      asm volatile("s_waitcnt lgkmcnt(0)" ::: "memory");
      const GAS f16* SZ = (const GAS f16*)(a.ws + WS_SZ) + ((size_t)b * S + qw) * 1024 + head * 128; GAS f16* MIX = (GAS f16*)(a.ws + WS_MIX) + ((size_t)b * S + qw) * 2048 + head * 128;
#pragma unroll
      for (int i = 0; i < 8; ++i) { const int c = le + 64 * i, row = c >> 4, ch = c & 15;
          const f16x8 ov = *(const LAS f16x8*)(stg + row * 128 + ch * 8); const f16x8 zv = *(const GAS f16x8*)(SZ + (unsigned)(row * 1024 + ch * 8));
          *(GAS f16x8*)(MIX + (unsigned)(row * 2048 + ch * 8)) = ov * zv; } }
    asm volatile("s_waitcnt lgkmcnt(0)" ::: "memory");
    __syncthreads();
#undef BL128
#undef VMW
#undef SLOAD_H
#undef SWRITE_HK
#undef SWRITE_HV
#undef SWRITE_H
#undef MLOAD
#undef MSPLIT
#undef STEP
}
#undef KSWZ
#undef SBAR
}

__device__ __forceinline__ void p3_sample_item(const Args& a, LAS unsigned char* lds, int qi, int tid) {
    const int sb = qi / NST, tl = qi % NST; constexpr int L = PAST + NST, PER = 33;
    const int lane = tid & 63, wave = __builtin_amdgcn_readfirstlane(tid >> 6);
    const GAS float* ck = (const GAS float*)a.in[2]; const GAS float* cv = (const GAS float*)a.in[3]; const GAS int* ptab = (const GAS int*)a.in[6]; const GAS float* out_ro = (const GAS float*)a.out;
    LAS float* q = (LAS float*)lds; LAS float* w = q + 1024; LAS float* newsc = w + 16; LAS unsigned* cnt = (LAS unsigned*)(newsc + 4); LAS int* nsel = (LAS int*)(cnt + 32);
    LAS unsigned* rid = (LAS unsigned*)(nsel + 4); LAS float* qa = (LAS float*)(rid + 512); LAS float* sc = qa + 1024; LAS float* inv = sc + 8 * 512; LAS float* part = inv + 8;
    const GAS f16* QI = (const GAS f16*)(a.ws + WS_QI) + (size_t)(MP + qi) * 1024; const GAS float* QS = (const GAS float*)(a.ws + WS_QS) + (size_t)qi * 1024;
    for (int i = tid; i < 1024; i += 512) { q[i] = (float)QI[i]; qa[i] = QS[i]; }
    if (tid < 16) w[tid] = ((const GAS float*)(a.ws + WS_WI))[(size_t)(MP + qi) * 16 + tid];
    if (tid < 32) cnt[tid] = 0u;
    if (tid == 0) *nsel = 0;
    __syncthreads();
    if (tid < NST) { const GAS float* kr = out_ro + O_KIS + (size_t)(sb * NST + tid) * 64; float s = 0.f;
#pragma unroll 1
        for (int h = 0; h < 16; ++h) { float dsum = 0.f;
#pragma unroll 8
            for (int d = 0; d < 64; ++d) dsum += q[h * 64 + d] * kr[d];
            s += w[h] * fmaxf(dsum, 0.f); }
        newsc[tid] = s; }
    const GAS float* ssc = (const GAS float*)(a.ws + WS_SSC) + (size_t)qi * PAST;
    unsigned keys[PER];
#pragma unroll
    for (int j = 0; j < PER - 1; ++j) keys[j] = fkey(ssc[j * 512 + tid]);
    __syncthreads();
    { const int s = (PER - 1) * 512 + tid; keys[PER - 1] = (s < L && (s - PAST) <= tl) ? fkey(newsc[s - PAST]) : 0u; }
    unsigned tau = 0u;
    for (int bit = 31; bit >= 0; --bit) { const unsigned cand = tau | (1u << bit); int c = 0;
#pragma unroll
        for (int j = 0; j < PER; ++j) c += __builtin_popcountll(__ballot(keys[j] >= cand));
        if (lane == 0) __hip_atomic_fetch_add(cnt + bit, (unsigned)c, __ATOMIC_RELAXED, __HIP_MEMORY_SCOPE_WORKGROUP);
        __syncthreads();
        if (cnt[bit] >= TOPK) tau = cand; }
#pragma unroll
    for (int j = 0; j < PER; ++j) { if (keys[j] >= tau && keys[j] != 0u) { const int s = j * 512 + tid; const int p = __hip_atomic_fetch_add(nsel, 1, __ATOMIC_RELAXED, __HIP_MEMORY_SCOPE_WORKGROUP);
        if (p < 512) rid[p] = s < PAST ? (unsigned)(ptab[sb * NPAGES + (s >> 7)] * PAGE + (s & (PAGE - 1))) : (0x80000000u | (unsigned)(s - PAST)); } }
    __syncthreads();
    const int n = *nsel < 512 ? *nsel : 512;
    const int kvh = wave & 1, prt = wave >> 1, half = lane >> 5, l32 = lane & 31;
    { f32x4 qv[4];
#pragma unroll
      for (int h = 0; h < 4; ++h) qv[h] = *(const LAS f32x4*)(qa + (4 * kvh + h) * 128 + 4 * l32);
      for (int j0 = 2 * prt; j0 < n; j0 += 32) { f32x4 kv[4]; int jj[4];
#pragma unroll
          for (int u = 0; u < 4; ++u) { jj[u] = j0 + 8 * u + half; const unsigned r = rid[jj[u] < n ? jj[u] : 0];
              const GAS float* kr = (r & 0x80000000u) ? out_ro + O_KS + ((size_t)(sb * NST + (r & 3u)) * NKV + kvh) * HD : ck + ((size_t)r * NKV + kvh) * HD;
              kv[u] = *(const GAS f32x4*)(kr + 4 * l32); }
#pragma unroll
          for (int u = 0; u < 4; ++u) { float d[4];
#pragma unroll
              for (int h = 0; h < 4; ++h) { d[h] = (kv[u][0] * qv[h][0] + kv[u][1] * qv[h][1]) + (kv[u][2] * qv[h][2] + kv[u][3] * qv[h][3]);
                  d[h] += __shfl_xor(d[h], 1); d[h] += __shfl_xor(d[h], 2); d[h] += __shfl_xor(d[h], 4); d[h] += __shfl_xor(d[h], 8); d[h] += __shfl_xor(d[h], 16); }
              if (jj[u] < n && l32 < 4) sc[(4 * kvh + l32) * 512 + jj[u]] = (l32 == 0 ? d[0] : l32 == 1 ? d[1] : l32 == 2 ? d[2] : d[3]) * 0.08838834764831845f; } } }
    __syncthreads();
    { LAS float* row = sc + wave * 512; float mx = -1e30f;
      for (int j = lane; j < n; j += 64) mx = fmaxf(mx, row[j]);
#pragma unroll
      for (int o = 1; o < 64; o <<= 1) mx = fmaxf(mx, __shfl_xor(mx, o));
      float sm = 0.f;
      for (int j = lane; j < n; j += 64) { const float e = __expf(row[j] - mx); row[j] = e; sm += e; }
      sm = wave_sum(sm); if (lane == 0) inv[wave] = 1.f / sm; }
    __syncthreads();
    { f32x4 acc[4] = {};
      for (int j0 = 2 * prt; j0 < n; j0 += 32) { f32x4 vv[4]; int jj[4];
#pragma unroll
          for (int u = 0; u < 4; ++u) { jj[u] = j0 + 8 * u + half; const unsigned r = rid[jj[u] < n ? jj[u] : 0];
              const GAS float* vr = (r & 0x80000000u) ? out_ro + O_VS + ((size_t)(sb * NST + (r & 3u)) * NKV + kvh) * HD : cv + ((size_t)r * NKV + kvh) * HD;
              vv[u] = *(const GAS f32x4*)(vr + 4 * l32); }
#pragma unroll
          for (int u = 0; u < 4; ++u)
#pragma unroll
              for (int h = 0; h < 4; ++h) { const float p = jj[u] < n ? sc[(4 * kvh + h) * 512 + jj[u]] : 0.f; acc[h] += vv[u] * p; } }
#pragma unroll
      for (int h = 0; h < 4; ++h) {
#pragma unroll
          for (int e = 0; e < 4; ++e) acc[h][e] += __shfl_xor(acc[h][e], 32);
          if (half == 0) *(LAS f32x4*)(part + (wave * 4 + h) * 128 + 4 * l32) = acc[h]; } }
    __syncthreads();
    { const GAS f16* SZ = (const GAS f16*)(a.ws + WS_SZ) + (size_t)(MP + qi) * 1024; GAS f16* MIX = (GAS f16*)(a.ws + WS_MIX) + (size_t)(MP + qi) * 2048;
      for (int i = tid; i < 1024; i += 512) { const int h = i >> 7, d = i & 127, kh = h >> 2, hl = h & 3; float o = 0.f;
#pragma unroll
          for (int p = 0; p < 4; ++p) o += part[((2 * p + kh) * 4 + hl) * 128 + d];
          MIX[i] = (f16)(o * inv[h] * (float)SZ[i]); } }
    __syncthreads();
}

__device__ __forceinline__ void p3_phase(const Args& a, LAS unsigned char* lds, int vcu, int G, int tid) {
    float gm = 0.f, km = 0.f;
    for (int i = 0; i < HD; ++i) { gm = fmaxf(gm, fabsf(a.in[9][i])); km = fmaxf(km, fabsf(a.in[10][i])); }
    const float sh2 = fmaxf(0.f, 11.313708498984761f * gm * km - 20.f) * 1.4426950408889634f;
    for (int sidx = G - 1 - vcu; sidx < MS; sidx += G) p3_sample_item(a, lds, sidx, tid);
    for (int k = vcu; k < 256; k += G) { const int i = 31 - (k >> 3), bk = k & 7;
        att::attn_block(a, lds, bk >> 1, bk & 1, 64 * i, sh2); }
}

typedef GAS unsigned gu32;
#define XB_TMO      128
#define XB_XCNT(j)  (256  + 64 * (j))
#define XB_XSUB(j)  (1280 + 64 * (j))
#define XB_XGEN(j)  (2304 + 64 * (j))
#define XB_TOP      3328
#define XB_TOPGEN   3392
#define XCD_BAR_WORDS 3456
#define XB_SPIN_CAP (1u << 18)
__device__ __forceinline__ unsigned xb_ld(unsigned* p)              { return __hip_atomic_load(p, __ATOMIC_RELAXED, __HIP_MEMORY_SCOPE_AGENT); }
__device__ __forceinline__ unsigned xb_add(unsigned* p, unsigned v) { return __hip_atomic_fetch_add(p, v, __ATOMIC_RELAXED, __HIP_MEMORY_SCOPE_AGENT); }
__device__ __forceinline__ unsigned xb_xcc_id() { return (unsigned)__builtin_amdgcn_s_getreg((3 << 11) | 20) & 0xFu; }
#define XB_SPIN(cond, bar) do { unsigned _sp = 0; while (cond) { __builtin_amdgcn_s_sleep(1); \
    if ((++_sp & 255u) == 0u) { if (xb_ld(&(bar)[XB_TMO])) break; if (_sp > XB_SPIN_CAP) { atomicAdd(&(bar)[XB_TMO], 1u); break; } } } } while (0)
struct XcdBarrier { unsigned* bar; unsigned x; volatile LAS unsigned* st; };
__device__ __forceinline__ XcdBarrier xcd_barrier_post(unsigned* bar, volatile LAS unsigned* st) {
    XcdBarrier b; b.bar = bar; b.x = xb_xcc_id(); b.st = st;
    if (threadIdx.x == 0) (void)xb_add(&bar[XB_XCNT(b.x)], 1u);
    return b;
}
__device__ __forceinline__ void xcd_barrier_complete(unsigned* bar, unsigned x, unsigned& nloc, unsigned& nx) {
    const unsigned G = gridDim.x * gridDim.y * gridDim.z;
    unsigned sum, cnt, mine, sp = 0u;
    for (;;) {
        sum = 0u; cnt = 0u; mine = 0u;
#pragma unroll
        for (unsigned j = 0; j < 16; ++j) { const unsigned c = xb_ld(&bar[XB_XCNT(j)]); sum += c; cnt += (c > 0u) ? 1u : 0u; mine = (j == x) ? c : mine; }
        if (sum == G) break;
        __builtin_amdgcn_s_sleep(1);
        if ((++sp & 255u) == 0u) { if (xb_ld(&bar[XB_TMO])) break; if (sp > XB_SPIN_CAP) { atomicAdd(&bar[XB_TMO], 1u); break; } }
    }
    nloc = mine > 0u ? mine : 1u; nx = cnt > 0u ? cnt : 1u;
}
__device__ __forceinline__ void xcd_barrier(const XcdBarrier& b) {
    asm volatile("s_waitcnt vmcnt(0)" ::: "memory");
    __syncthreads();
    if (threadIdx.x == 0) {
        unsigned* bar = b.bar;
        __builtin_amdgcn_s_waitcnt(0);
        unsigned nloc = b.st[0], nx = b.st[1];
        if (nloc == 0u) { xcd_barrier_complete(bar, b.x, nloc, nx); b.st[0] = nloc; b.st[1] = nx; }
        const unsigned old = xb_add(&bar[XB_XSUB(b.x)], 1u);
        const unsigned gen = old / nloc;
        if (old + 1u == (gen + 1u) * nloc) {
            __builtin_amdgcn_fence(__ATOMIC_RELEASE, "agent");
            asm volatile("s_waitcnt vmcnt(0)" ::: "memory");
            const unsigned og = xb_add(&bar[XB_TOP], 1u);
            const unsigned tg = og / nx;
            if (og + 1u == (tg + 1u) * nx) xb_add(&bar[XB_TOPGEN], 1u);
            else XB_SPIN(xb_ld(&bar[XB_TOPGEN]) == tg, bar);
            __builtin_amdgcn_fence(__ATOMIC_ACQUIRE, "agent");
            xb_add(&bar[XB_XGEN(b.x)], 1u);
            asm volatile("s_waitcnt vmcnt(0)" ::: "memory");
        } else {
            XB_SPIN(xb_ld(&bar[XB_XGEN(b.x)]) == gen, bar);
            __builtin_amdgcn_fence(__ATOMIC_ACQUIRE, "agent");
            asm volatile("s_waitcnt vmcnt(0)" ::: "memory");
        }
    }
    __syncthreads();
}

__global__ void __launch_bounds__(NWAVES * 64, 2) mk_fwd(Args a) {
    extern __shared__ __attribute__((aligned(16))) unsigned char lds_raw[];
    LAS unsigned char* lds = (LAS unsigned char*)lds_raw;
    const int tid = threadIdx.x, lane = tid & 63, wave = __builtin_amdgcn_readfirstlane(tid >> 6);
    const int G = gridDim.x; const int bx = blockIdx.x; const int vcu = (G % 8 == 0) ? (bx % 8) * (G / 8) + bx / 8 : bx;
    volatile LAS unsigned* MISC = (volatile LAS unsigned*)(lds + MISC_OFF);
    if (tid < 64) MISC[tid] = 0u;
    __syncthreads();
    XcdBarrier bar = xcd_barrier_post((unsigned*)a.ws, MISC + 8);
    { int t_ = threadIdx.x; asm volatile("" : "+v"(t_)); const int lane = t_ & 63, wave = __builtin_amdgcn_readfirstlane(t_ >> 6); p0_prologue(a, lds, vcu, G, wave, lane); }
    xcd_barrier(bar);
    { pg8::Gemm g{(const f16*)(a.ws + WS_XNH), (const f16*)(a.ws + WS_WINT), DM};
      pg8::StaticOrder S; S.init(MPAD / 256, NPAD / 256, G, bx);
      EpiIn E{a.out, a.ws, a.in[9], a.in[10], a.in[11], (LAS float*)(lds + SCR_OFF)};
      pg8::gemm_phase<EpiIn, pg8::StaticOrder>(lds, g, S, E); }
    xcd_barrier(bar);
    { int t_ = threadIdx.x; asm volatile("" : "+v"(t_)); const int lane = t_ & 63, wave = __builtin_amdgcn_readfirstlane(t_ >> 6); p2_phase(a, lds, vcu, G, wave, lane); }
    xcd_barrier(bar);
    { int t_ = threadIdx.x; asm volatile("" : "+v"(t_)); p3_phase(a, lds, vcu, G, t_); }
    xcd_barrier(bar);
    { pg8::Gemm g{(const f16*)(a.ws + WS_MIX), (const f16*)(a.ws + WS_WOUTT), DM};
      pg8::StaticOrder S; S.init(MP / 256, DM / 256, G, bx);
      EpiOut E{a.out, a.in[0]};
      pg8::gemm_phase<EpiOut, pg8::StaticOrder>(lds, g, S, E);
      int t_ = threadIdx.x; asm volatile("" : "+v"(t_)); p4_sample(a, lds, bx, G, t_); }
}

#ifndef PROG
#define PROG 0x11111u
#endif
extern "C" void kernel_launch(void* const* d_in, const int* in_sizes, int n_in, void* d_out, int out_size, void* d_ws, size_t ws_size, hipStream_t stream) {
    static int grid = 0;
    if (grid == 0) {
        if (ws_size < WS_NEED2 || out_size != (int)O_END || n_in != 14) { fprintf(stderr, "kernel_launch: ws %zu (need %zu) out %d (want %zu) n_in %d\n", ws_size, (size_t)WS_NEED2, out_size, (size_t)O_END, n_in); grid = -1; return; }
        int dev = 0, cus = 0; hipGetDevice(&dev); hipDeviceGetAttribute(&cus, hipDeviceAttributeMultiprocessorCount, dev);
        if (hipFuncSetAttribute((const void*)mk_fwd, hipFuncAttributeMaxDynamicSharedMemorySize, LDS_BYTES) != hipSuccess) { fprintf(stderr, "kernel_launch: hipFuncSetAttribute failed\n"); grid = -1; return; }
        int per_cu = 0; hipOccupancyMaxActiveBlocksPerMultiprocessor(&per_cu, (const void*)mk_fwd, NWAVES * 64, LDS_BYTES); (void)hipGetLastError();
        if (per_cu < 1) fprintf(stderr, "kernel_launch: occupancy query says %d blocks per CU\n", per_cu);
        grid = cus > 0 ? cus : 256;
    }
    if (grid < 0) return;
    float* out = (float*)d_out; unsigned char* ws = (unsigned char*)d_ws;
    Args a{};
    for (int i = 0; i < 14; ++i) a.in[i] = (const float*)d_in[i];
    a.out = out; a.ws = ws;
    if (hipMemsetAsync(ws, 0, 65536, stream) != hipSuccess) { fprintf(stderr, "kernel_launch: memset of the control words failed\n"); return; }
    a.ph_lo = (int)PROG; a.ph_hi = 0; hipLaunchKernelGGL(mk_fwd, dim3(grid), dim3(NWAVES * 64), LDS_BYTES, stream, a);
}
```

```cpp
#include <hip/hip_runtime.h>
#include <cstdio>
#include <cstdint>
#include <cmath>

typedef _Float16 f16;
typedef unsigned short bf16_t;

constexpr int DM = 2048, NB = 4, S = 2048, NSB = 8, NST = 4, PAST = 16384, PAGE = 128, NPAGES = PAST / PAGE;
constexpr int MP = NB * S;
constexpr int MS = NSB * NST;
constexpr int MT = MP + MS;
constexpr int DIN = 7760;
constexpr int OQ = 0, OKK = 1024, OV = 1280, OZ = 1536, OQI = 2560, OKI = 3584, OWI = 3648, OH = 3664, OBB = 4688, OC = 5712, OZC = 6736;
constexpr int NH = 8, NKV = 2, HD = 128, NIH = 16, ID = 64, TOPK = 256, DC = 1024;
constexpr float EPS = 1e-6f;
constexpr size_t O_YP = 0, O_YS = 16777216, O_KP = 16842752, O_VP = 18939904, O_KIP = 21037056, O_CVP = 21561344,
                 O_KS = 21569536, O_VS = 21577728, O_KIS = 21585920, O_CVS = 21587968, O_END = 21604352;
constexpr size_t MiB = 1u << 20;
constexpr size_t WS_ROPE = 1 * MiB;
constexpr size_t WS_ROPE_I = WS_ROPE + 2052 * 32 * 4;
constexpr size_t WS_QB = 2 * MiB;
constexpr size_t WS_KB = 18 * MiB;
constexpr size_t WS_VB = 22 * MiB;
constexpr size_t WS_SZ = 26 * MiB;
constexpr size_t WS_QI = 43 * MiB;
constexpr size_t WS_KI = 60 * MiB;
constexpr size_t WS_WI = 61 * MiB;
constexpr size_t WS_U = 62 * MiB;
constexpr size_t WS_G = 79 * MiB;
constexpr size_t WS_MIX = 96 * MiB;
constexpr size_t WS_MASK = 130 * MiB;
constexpr size_t WS_SSC = 132 * MiB;
constexpr size_t WS_QS = 134 * MiB;
constexpr size_t WS_XN = 136 * MiB;
constexpr size_t WS_P = 202 * MiB;
constexpr size_t WS_NEED = 448 * MiB;

__device__ __forceinline__ bf16_t f2bf(float f) { unsigned u = __builtin_bit_cast(unsigned, f); return (bf16_t)((u + 0x7fffu + ((u >> 16) & 1u)) >> 16); }
__device__ __forceinline__ float bf2f(bf16_t h) { return __builtin_bit_cast(float, (unsigned)h << 16); }
__device__ __forceinline__ float silu(float z) { return z / (1.f + __expf(-z)); }
__device__ __forceinline__ unsigned fkey(float f) { unsigned u = __builtin_bit_cast(unsigned, f); return (u & 0x80000000u) ? ~u : (u | 0x80000000u); }

#define LAS __attribute__((address_space(3)))
#define GAS __attribute__((address_space(1)))
typedef _Float16 f16x8 __attribute__((ext_vector_type(8)));
typedef _Float16 f16x4 __attribute__((ext_vector_type(4)));
typedef _Float16 f16x2 __attribute__((ext_vector_type(2)));
typedef float f32x4 __attribute__((ext_vector_type(4)));
typedef float f32x2 __attribute__((ext_vector_type(2)));
typedef unsigned u32x4 __attribute__((ext_vector_type(4)));
typedef unsigned u32x2 __attribute__((ext_vector_type(2)));
typedef __bf16 bf16x2_t __attribute__((ext_vector_type(2)));
namespace pg8 {
constexpr int BM = 256, BK = 64, HALF = 128, HTB = HALF * BK * 2, STAGE_BYTES = 8 * HTB, NXCD = 8, WGM = 8;
__host__ __device__ __forceinline__ int lds_byte(int r, int c) { const int st = (r >> 4) * 2 + (c >> 5), rr = r & 15, cc = c & 31, ob = rr * 64 + cc * 2; return st * 1024 + (ob ^ (((ob >> 9) & 1) << 5)); }
__host__ __device__ __forceinline__ void stage_rc(int b, int& R, int& C) { const int st = b / 1024, sb = b % 1024, swz = sb ^ (((sb >> 9) & 1) << 5); R = (st >> 1) * 16 + swz / 64; C = (st & 1) * 32 + (swz % 64) / 2; }
struct Unit { int pm, pn; };
struct Gemm { const f16* A; const f16* Bt; int K; };
struct StaticOrder {
    int nM, nN, nwg, G, c;
    __device__ void init(int nM_, int nN_, int G_, int c_) { nM = nM_; nN = nN_; nwg = nM * nN; G = G_; c = c_; }
    __device__ bool next(int i, Unit& u) const {
        const long L = (long)i * G + c; if (L >= nwg) return false;
        int wgid = (int)L; { const int q = nwg / NXCD, r = nwg % NXCD, xcd = wgid % NXCD, off = wgid / NXCD; wgid = (xcd < r ? xcd * (q + 1) : r * (q + 1) + (xcd - r) * q) + off; }
        const int nig = WGM * nN, gid = wgid / nig, fm = gid * WGM, gsz = (nM - fm) < WGM ? (nM - fm) : WGM;
        u.pm = fm + ((wgid % nig) % gsz); u.pn = (wgid % nig) / gsz; return true;
    }
};
template <class Epi, class Sched>
__device__ __forceinline__ void gemm_phase(LAS unsigned char* lds, const Gemm g, const Sched& S, const Epi& E) {
    int tid_ = threadIdx.x; asm volatile("" : "+v"(tid_));
    const int tid = tid_, wid = __builtin_amdgcn_readfirstlane(tid >> 6), lane = tid & 63, wr = wid >> 2, wc = wid & 3, fr = lane & 15, fq = lane >> 4;
    const int K = g.K, nt = K / BK;
    unsigned voffA[2];
#pragma unroll
    for (int i = 0; i < 2; ++i) { int R, C; stage_rc(tid * 16 + i * 8192, R, C); voffA[i] = (unsigned)(R * K + C) * 2u; }
    const size_t kstep = (size_t)(BK * 2);
    const size_t hstep = (size_t)HALF * K * 2;
    const size_t tstep = 2 * hstep;
    const unsigned ldsw = (unsigned)wid * 1024u;
    const int aoff = lds_byte(wr * 64 + fr, fq * 8), boff = lds_byte(wc * 32 + fr, fq * 8);
#define PG8_SA(b, h) (((b) * 2 + (h)) * HTB)
#define PG8_SB(b, h) ((4 + (b) * 2 + (h)) * HTB)
#define PG8_STAGE(bufoff, gbase) do { _Pragma("unroll") for (int _i = 0; _i < 2; ++_i) \
        __builtin_amdgcn_global_load_lds((const unsigned*)((const char*)(gbase) + voffA[_i]), (LAS unsigned*)(lds + (bufoff) + ldsw + _i * 8192), 16, 0, 0); } while (0)
#define PG8_LDA(dst, b, h) do { _Pragma("unroll") for (int m = 0; m < 4; ++m) _Pragma("unroll") for (int k = 0; k < 2; ++k) dst[m][k] = *(const LAS f16x8*)(lds + PG8_SA(b, h) + aoff + m * 2048 + k * 1024); } while (0)
#define PG8_LDB(dst, b, h) do { _Pragma("unroll") for (int n = 0; n < 2; ++n) _Pragma("unroll") for (int k = 0; k < 2; ++k) dst[n][k] = *(const LAS f16x8*)(lds + PG8_SB(b, h) + boff + n * 2048 + k * 1024); } while (0)
#define PG8_MMA(ai, bj, At, Bt) do { __builtin_amdgcn_s_setprio(1); _Pragma("unroll") for (int m = 0; m < 4; ++m) _Pragma("unroll") for (int n = 0; n < 2; ++n) _Pragma("unroll") for (int k = 0; k < 2; ++k) \
        acc[ai][bj][m][n] = __builtin_amdgcn_mfma_f32_16x16x32_f16(Bt[n][k], At[m][k], acc[ai][bj][m][n], 0, 0, 0); __builtin_amdgcn_s_setprio(0); } while (0)
#define PG8_WAIT_V(n) asm volatile("s_waitcnt vmcnt(" #n ")" ::: "memory")
#define PG8_WAIT_L(n) asm volatile("s_waitcnt lgkmcnt(" #n ")" ::: "memory")
#define PG8_BAR __builtin_amdgcn_s_barrier()
#define PG8_SCHED __builtin_amdgcn_sched_barrier(0)
    Unit cur, nxt; int ui = 0;
    if (!S.next(0, cur)) return;
    f32x4 acc[2][2][4][2];
#pragma unroll
    for (int a = 0; a < 2; ++a)
#pragma unroll
        for (int b = 0; b < 2; ++b)
#pragma unroll
            for (int m = 0; m < 4; ++m)
#pragma unroll
                for (int n = 0; n < 2; ++n) acc[a][b][m][n] = (f32x4){0.f, 0.f, 0.f, 0.f};
    f16x8 At[4][2], B0[2][2], B1[2][2];
    const char* cA = (const char*)g.A + (size_t)cur.pm * tstep; const char* cB = (const char*)g.Bt + (size_t)cur.pn * tstep;
    PG8_STAGE(PG8_SB(0, 0), cB); PG8_STAGE(PG8_SB(0, 1), cB + hstep); PG8_STAGE(PG8_SA(0, 0), cA); PG8_STAGE(PG8_SA(0, 1), cA + hstep);
    if (wr == 1) PG8_BAR;
    PG8_WAIT_V(2); PG8_BAR;
    PG8_STAGE(PG8_SB(1, 0), cB + kstep); PG8_STAGE(PG8_SA(1, 0), cA + kstep); PG8_STAGE(PG8_SB(1, 1), cB + hstep + kstep);
    PG8_WAIT_V(6); PG8_BAR;
    for (;;) {
        const bool has_next = S.next(ui + 1, nxt);
        const char* nA = has_next ? (const char*)g.A + (size_t)nxt.pm * tstep : cA; const char* nB = has_next ? (const char*)g.Bt + (size_t)nxt.pn * tstep : cB;
        for (int t = 0; t < nt; t += 2) {
            const bool last = (t == nt - 2);
            const char* a1 = cA + (size_t)(t + 1) * kstep;
            const char* a2 = last ? nA : cA + (size_t)(t + 2) * kstep; const char* b2 = last ? nB : cB + (size_t)(t + 2) * kstep;
            const char* a3 = a2 + kstep; const char* b3 = b2 + kstep;
            PG8_LDB(B0, 0, 0); PG8_LDB(B1, 0, 1); PG8_SCHED; PG8_LDA(At, 0, 0); PG8_STAGE(PG8_SA(1, 1), a1 + hstep);
            PG8_WAIT_V(8); PG8_WAIT_L(0); PG8_BAR; PG8_MMA(0, 0, At, B0); PG8_MMA(0, 1, At, B1); PG8_BAR; PG8_SCHED;
            PG8_LDA(At, 0, 1); PG8_STAGE(PG8_SB(0, 0), b2); PG8_STAGE(PG8_SB(0, 1), b2 + hstep); PG8_STAGE(PG8_SA(0, 0), a2);
            PG8_WAIT_V(8); PG8_WAIT_L(0); PG8_BAR; PG8_MMA(1, 0, At, B0); PG8_MMA(1, 1, At, B1); PG8_BAR; PG8_SCHED;
            PG8_LDB(B0, 1, 0); PG8_LDB(B1, 1, 1); PG8_SCHED; PG8_LDA(At, 1, 0); PG8_STAGE(PG8_SA(0, 1), a2 + hstep);
            PG8_WAIT_V(8); PG8_WAIT_L(0); PG8_BAR; PG8_MMA(0, 0, At, B0); PG8_MMA(0, 1, At, B1); PG8_BAR; PG8_SCHED;
            PG8_LDA(At, 1, 1); PG8_STAGE(PG8_SB(1, 0), b3); PG8_STAGE(PG8_SB(1, 1), b3 + hstep); PG8_STAGE(PG8_SA(1, 0), a3);
            PG8_WAIT_V(8); PG8_WAIT_L(0); PG8_BAR; PG8_MMA(1, 0, At, B0); PG8_MMA(1, 1, At, B1); PG8_BAR; PG8_SCHED;
        }
        if (wr == 0) PG8_BAR;
        E(acc, cur, wr, wc, fr, fq);
        if (!has_next) break;
#pragma unroll
        for (int a = 0; a < 2; ++a)
#pragma unroll
            for (int b = 0; b < 2; ++b)
#pragma unroll
                for (int m = 0; m < 4; ++m)
#pragma unroll
                    for (int n = 0; n < 2; ++n) acc[a][b][m][n] = (f32x4){0.f, 0.f, 0.f, 0.f};
        cur = nxt; cA = nA; cB = nB; ++ui;
        if (wr == 1) PG8_BAR;
    }
    PG8_WAIT_V(0);
    PG8_BAR;
#undef PG8_SA
#undef PG8_SB
#undef PG8_STAGE
#undef PG8_LDA
#undef PG8_LDB
#undef PG8_MMA
#undef PG8_WAIT_V
#undef PG8_WAIT_L
#undef PG8_BAR
#undef PG8_SCHED
}
}
constexpr int NWAVES = 8;
constexpr int MPAD = 8448, NPAD = 7936;
constexpr size_t WS_XNH = 450 * MiB;
constexpr size_t WS_WINT = 484 * MiB;
constexpr size_t WS_WOUTT = 516 * MiB;
constexpr size_t WS_NEED2 = 524 * MiB;
constexpr int RING_BYTES = 131072, SCR_OFF = RING_BYTES, SCR_BYTES = 8192, MISC_OFF = 145408, LDS_BYTES = 147456;

__device__ __forceinline__ unsigned pk_bf16(float lo, float hi) { f32x2 v = {lo, hi}; bf16x2_t b = __builtin_convertvector(v, bf16x2_t); return __builtin_bit_cast(unsigned, b); }
__device__ __forceinline__ unsigned pk_f16(float lo, float hi) { f32x2 v = {lo, hi}; f16x2 b = __builtin_convertvector(v, f16x2); return __builtin_bit_cast(unsigned, b); }

struct Args { const float* in[14]; float* out; unsigned char* ws; int ph_lo, ph_hi; };

__device__ __forceinline__ int win_src(int np) {
    const int pn = np >> 8, c = np & 255;
    if (pn < 14) return np;
    if (pn == 14) return c < 80 ? np : -1;
    const int T = pn - 15, bj = c >> 7, wc = (c >> 5) & 3, n = (c >> 4) & 1, fqi = c & 15;
    const int base = bj == 0 ? (n == 0 ? OH : OBB) : (n == 0 ? OC : OZC);
    return base + 64 * T + 16 * wc + fqi;
}
template <bool MAP>
__device__ __forceinline__ void p0_transpose_item(const float* W, int N, f16* WT, LAS float* scr, int item, int nblk, int lane) {
    const int kb = item / nblk, nb = item % nblk, k0 = 64 * kb, n0 = 32 * nb;
    const int src = MAP ? win_src(n0 + (lane & 31)) : n0 + (lane & 31);
#pragma unroll 8
    for (int i = 0; i < 32; ++i) { const int kk = 2 * i + (lane >> 5); scr[kk * 33 + (lane & 31)] = src >= 0 ? W[(size_t)(k0 + kk) * N + src] : 0.f; }
    asm volatile("s_waitcnt lgkmcnt(0)" ::: "memory");
    const int c = lane & 7;
#pragma unroll
    for (int j = 0; j < 4; ++j) { const int n = (lane >> 3) + 8 * j; const LAS float* s = scr + (8 * c) * 33 + n;
        u32x4 o; o.x = pk_f16(s[0 * 33], s[1 * 33]); o.y = pk_f16(s[2 * 33], s[3 * 33]); o.z = pk_f16(s[4 * 33], s[5 * 33]); o.w = pk_f16(s[6 * 33], s[7 * 33]);
        *(u32x4*)(WT + (size_t)(n0 + n) * 2048 + k0 + 8 * c) = o; }
    asm volatile("s_waitcnt lgkmcnt(0)" ::: "memory");
}
__device__ __forceinline__ float wave_sum(float v) {
#pragma unroll
    for (int o = 1; o < 64; o <<= 1) v += __shfl_xor(v, o);
    return v;
}
__device__ __forceinline__ void p0_prologue(const Args& a, LAS unsigned char* lds, int vcu, int G, int wave, int lane) {
    LAS float* scr = (LAS float*)(lds + wave * 16384);
    const int gw = vcu * NWAVES + wave, NGW = G * NWAVES;
    const float* win = a.in[8]; const float* wout = a.in[13];
    f16* WinT = (f16*)(a.ws + WS_WINT); f16* WoutT = (f16*)(a.ws + WS_WOUTT); f16* XN = (f16*)(a.ws + WS_XNH);
    constexpr int I_IN = 32 * (NPAD / 32), I_OUT = 32 * (DM / 32);
    for (int it = gw; it < I_IN + I_OUT; it += NGW) {
        if (it < I_IN) p0_transpose_item<true>(win, DIN, WinT, scr, it, NPAD / 32, lane);
        else p0_transpose_item<false>(wout, DM, WoutT, scr, it - I_IN, DM / 32, lane);
    }
    const float* gin = a.in[7];
    for (int m = gw; m < MT; m += NGW) {
        const float* xrow = m < MP ? a.in[0] + (size_t)m * DM : a.in[1] + (size_t)(m - MP) * DM;
        const f32x4* xr = (const f32x4*)xrow + lane; f32x4 v[8]; float s = 0.f;
#pragma unroll
        for (int j = 0; j < 8; ++j) { v[j] = xr[64 * j]; s += (v[j].x * v[j].x + v[j].y * v[j].y) + (v[j].z * v[j].z + v[j].w * v[j].w); }
        const float rs = rsqrtf(wave_sum(s) * (1.f / DM) + EPS);
        u32x2* o8 = (u32x2*)(XN + (size_t)m * DM) + lane;
#pragma unroll
        for (int j = 0; j < 8; ++j) { const f32x4 gv = ((const f32x4*)gin)[lane + 64 * j]; u32x2 w; w.x = pk_f16(v[j].x * rs * gv.x, v[j].y * rs * gv.y); w.y = pk_f16(v[j].z * rs * gv.z, v[j].w * rs * gv.w); o8[64 * j] = w; }
    }
    float* rqk = (float*)(a.ws + WS_ROPE); float* ri = (float*)(a.ws + WS_ROPE_I);
    for (int i = gw * 64 + lane; i < 2052 * 16; i += NGW * 64) {
        { int slot = i / 16, j = i % 16; int pos = slot < 2048 ? slot : PAST + (slot - 2048);
          float inv = (float)pow(500000.0, -(double)j / 16.0); float ang = (float)pos * inv;
          rqk[(slot * 16 + j) * 2] = (float)cos((double)ang); rqk[(slot * 16 + j) * 2 + 1] = (float)sin((double)ang); }
        if (i < 2052 * 8) { int slot = i / 8, j = i % 8; int pos = slot < 2048 ? slot : PAST + (slot - 2048);
          float inv = (float)pow(500000.0, -(double)j / 8.0); float ang = (float)pos * inv;
          ri[(slot * 8 + j) * 2] = (float)cos((double)ang); ri[(slot * 8 + j) * 2 + 1] = (float)sin((double)ang); }
    }
}

struct EpiIn {
    float* out; unsigned char* ws; const float* gq; const float* gk; const float* gki; LAS float* scr;
    __device__ __forceinline__ void operator()(f32x4 (&acc)[2][2][4][2], const pg8::Unit& u, int wr, int wc, int fr_, int fq_) const {
        int fr = fr_, fq = fq_; asm volatile("" : "+v"(fr), "+v"(fq));
        GAS unsigned char* ws = (GAS unsigned char*)this->ws; GAS float* out = (GAS float*)this->out; asm volatile("" : "+s"(ws), "+s"(out));
        const int pn = u.pn, pm = u.pm; const bool smp = pm == 32;
        const int rbase = 64 * wr + fr;
        const int bb = pm >> 3, t0 = (pm & 7) << 8;
        const GAS float* rqk = (const GAS float*)(ws + WS_ROPE); const GAS float* ri = (const GAS float*)(ws + WS_ROPE_I);
#define ROWLOOP _Pragma("unroll") for (int ai = 0; ai < 2; ++ai) _Pragma("unroll") for (int m = 0; m < 4; ++m)
#define ROWVARS const int r = rbase + 128 * ai + 16 * m; const bool valid = !smp || r < MS; const int grow = smp ? MP + r : pm * 256 + r; const int tt = smp ? (r & 3) : t0 + r; const int slot = smp ? 2048 + (r & 3) : tt; (void)grow; (void)tt; (void)slot; (void)valid;
        if (pn <= 4 || pn == 14) {
            const bool isk = pn == 14;
            ROWLOOP { asm volatile("" ::: "memory"); const int r = rbase + 128 * ai + 16 * m;
#pragma unroll
                for (int bj = 0; bj < 2; ++bj) { float s = 0.f;
#pragma unroll
                    for (int n = 0; n < 2; ++n) { const f32x4 x = acc[ai][bj][m][n]; s += (x[0] * x[0] + x[1] * x[1]) + (x[2] * x[2] + x[3] * x[3]); }
                    if (isk && (wc >= 2 || bj == 1)) s = 0.f;
                    s += __shfl_xor(s, 16); s += __shfl_xor(s, 32);
                    if (fq == 0) scr[(r * 2 + bj) * 4 + wc] = s; } }
            asm volatile("s_waitcnt lgkmcnt(0)" ::: "memory"); __builtin_amdgcn_s_barrier(); asm volatile("" ::: "memory");
            if (!isk) {
                const GAS float* g = (const GAS float*)(pn < 4 ? gq : gk); const int dl = 32 * wc + 4 * fq;
                const f32x4 g0 = *(const GAS f32x4*)(g + dl), g1 = *(const GAS f32x4*)(g + dl + 16);
                GAS bf16_t* Qb = (GAS bf16_t*)(ws + WS_QB); GAS bf16_t* Kb = (GAS bf16_t*)(ws + WS_KB); GAS float* QS = (GAS float*)(ws + WS_QS);
                ROWLOOP { asm volatile("" ::: "memory"); ROWVARS
                    f32x4 cs0 = {1.f, 0.f, 1.f, 0.f}, cs1 = {1.f, 0.f, 1.f, 0.f};
                    if (wc == 0) { const GAS f32x4* cp = (const GAS f32x4*)(rqk + (slot * 16 + 4 * fq) * 2); cs0 = cp[0]; cs1 = cp[1]; }
#pragma unroll
                    for (int bj = 0; bj < 2; ++bj) {
                        const f32x4 p = *(const LAS f32x4*)(scr + (r * 2 + bj) * 4);
                        const float rs = rsqrtf(((p[0] + p[1]) + (p[2] + p[3])) * (1.f / 128.f) + EPS);
                        f32x4 x0 = acc[ai][bj][m][0] * rs * g0, x1 = acc[ai][bj][m][1] * rs * g1;
                        if (wc == 0) { const f32x4 c = {cs0[0], cs0[2], cs1[0], cs1[2]}, s = {cs0[1], cs0[3], cs1[1], cs1[3]};
                            const f32x4 y0 = x0 * c - x1 * s, y1 = x1 * c + x0 * s; x0 = y0; x1 = y1; }
                        const int hh = 2 * pn + bj;
                        if (pn < 4) {
                            if (smp) { if (valid) { GAS float* q = QS + (size_t)r * 1024 + hh * 128 + dl; *(GAS f32x4*)q = x0; *(GAS f32x4*)(q + 16) = x1; } }
                            else { GAS bf16_t* q = Qb + (((size_t)bb * NH + hh) * S + tt) * HD + dl;
                                u32x2 w0 = {pk_bf16(x0[0], x0[1]), pk_bf16(x0[2], x0[3])}, w1 = {pk_bf16(x1[0], x1[1]), pk_bf16(x1[2], x1[3])};
                                *(GAS u32x2*)q = w0; *(GAS u32x2*)(q + 16) = w1; }
                        } else {
                            if (smp) { if (valid) { GAS float* k = out + O_KS + (size_t)r * 256 + bj * 128 + dl; *(GAS f32x4*)k = x0; *(GAS f32x4*)(k + 16) = x1; } }
                            else { GAS float* k = out + O_KP + (size_t)grow * 256 + bj * 128 + dl; *(GAS f32x4*)k = x0; *(GAS f32x4*)(k + 16) = x1;
                                GAS bf16_t* kb = Kb + (((size_t)bb * NKV + bj) * S + tt) * HD + dl;
                                u32x2 w0 = {pk_bf16(x0[0], x0[1]), pk_bf16(x0[2], x0[3])}, w1 = {pk_bf16(x1[0], x1[1]), pk_bf16(x1[2], x1[3])};
                                *(GAS u32x2*)kb = w0; *(GAS u32x2*)(kb + 16) = w1; }
                        } } }
            } else {
                const int dl = 32 * (wc & 1) + 4 * fq;
                const f32x4 g0 = *(const GAS f32x4*)((const GAS float*)gki + dl), g1 = *(const GAS f32x4*)((const GAS float*)gki + dl + 16);
                GAS f16* KI = (GAS f16*)(ws + WS_KI); GAS float* WI = (GAS float*)(ws + WS_WI);
                ROWLOOP { asm volatile("" ::: "memory"); ROWVARS
                    const f32x4 p = *(const LAS f32x4*)(scr + (r * 2) * 4);
                    const float rs = rsqrtf((p[0] + p[1]) * (1.f / 64.f) + EPS);
                    f32x4 x0 = acc[ai][0][m][0] * rs * g0, x1 = acc[ai][0][m][1] * rs * g1;
                    f32x4 xo; xo[0] = __shfl_xor(x0[0], 32); xo[1] = __shfl_xor(x0[1], 32); xo[2] = __shfl_xor(x0[2], 32); xo[3] = __shfl_xor(x0[3], 32);
                    if (wc == 0) { const GAS f32x4* cp = (const GAS f32x4*)(ri + (slot * 8 + 4 * (fq & 1)) * 2); const f32x4 cs0 = cp[0], cs1 = cp[1];
                        const f32x4 c = {cs0[0], cs0[2], cs1[0], cs1[2]}, s = {cs0[1], cs0[3], cs1[1], cs1[3]};
                        x0 = fq < 2 ? x0 * c - xo * s : x0 * c + xo * s; }
                    if (wc < 2 && valid) {
                        GAS float* ko = smp ? out + O_KIS + (size_t)r * 64 + dl : out + O_KIP + (size_t)grow * 64 + dl;
                        *(GAS f32x4*)ko = x0; *(GAS f32x4*)(ko + 16) = x1;
                        if (!smp) { GAS f16* kh = KI + (size_t)grow * 64 + dl; u32x2 w0 = {pk_f16(x0[0], x0[1]), pk_f16(x0[2], x0[3])}, w1 = {pk_f16(x1[0], x1[1]), pk_f16(x1[2], x1[3])};
                            *(GAS u32x2*)kh = w0; *(GAS u32x2*)(kh + 16) = w1; } }
                    if (wc == 2 && valid) *(GAS f32x4*)(WI + (size_t)grow * 16 + 4 * fq) = acc[ai][0][m][0] * (1.f / 32.f);
                }
            }
        } else if (pn == 5) {
            GAS bf16_t* Vb = (GAS bf16_t*)(ws + WS_VB); const int dl = 32 * wc + 4 * fq;
            ROWLOOP { asm volatile("" ::: "memory"); ROWVARS
#pragma unroll
                for (int bj = 0; bj < 2; ++bj) { const f32x4 x0 = acc[ai][bj][m][0], x1 = acc[ai][bj][m][1];
                    if (smp) { if (valid) { GAS float* v = out + O_VS + (size_t)r * 256 + bj * 128 + dl; *(GAS f32x4*)v = x0; *(GAS f32x4*)(v + 16) = x1; } }
                    else { GAS float* v = out + O_VP + (size_t)grow * 256 + bj * 128 + dl; *(GAS f32x4*)v = x0; *(GAS f32x4*)(v + 16) = x1;
                        GAS bf16_t* vb = Vb + (((size_t)bb * NKV + bj) * S + tt) * HD + dl;
                        u32x2 w0 = {pk_bf16(x0[0], x0[1]), pk_bf16(x0[2], x0[3])}, w1 = {pk_bf16(x1[0], x1[1]), pk_bf16(x1[2], x1[3])};
                        *(GAS u32x2*)vb = w0; *(GAS u32x2*)(vb + 16) = w1; } } }
        } else if (pn <= 9) {
            GAS f16* SZ = (GAS f16*)(ws + WS_SZ); const int c0 = 256 * (pn - 6) + 32 * wc + 4 * fq;
            ROWLOOP { asm volatile("" ::: "memory"); ROWVARS
                if (valid) {
#pragma unroll
                    for (int bj = 0; bj < 2; ++bj)
#pragma unroll
                        for (int n = 0; n < 2; ++n) { const f32x4 x = acc[ai][bj][m][n]; u32x2 w = {pk_f16(silu(x[0]), silu(x[1])), pk_f16(silu(x[2]), silu(x[3]))};
                            *(GAS u32x2*)(SZ + (size_t)grow * 1024 + c0 + 128 * bj + 16 * n) = w; } } }
        } else if (pn <= 13) {
            GAS f16* QI = (GAS f16*)(ws + WS_QI); const int c0 = 256 * (pn - 10) + 32 * wc + 4 * fq;
            ROWLOOP { asm volatile("" ::: "memory"); ROWVARS
                f32x4 c = {1.f, 1.f, 1.f, 1.f}, s = {0.f, 0.f, 0.f, 0.f};
                if ((wc & 1) == 0) { const GAS f32x4* cp = (const GAS f32x4*)(ri + (slot * 8 + 4 * (fq & 1)) * 2); const f32x4 cs0 = cp[0], cs1 = cp[1];
                    c = (f32x4){cs0[0], cs0[2], cs1[0], cs1[2]}; s = (f32x4){cs0[1], cs0[3], cs1[1], cs1[3]}; }
#pragma unroll
                for (int bj = 0; bj < 2; ++bj) { f32x4 x0 = acc[ai][bj][m][0]; const f32x4 x1 = acc[ai][bj][m][1];
                    f32x4 xo; xo[0] = __shfl_xor(x0[0], 32); xo[1] = __shfl_xor(x0[1], 32); xo[2] = __shfl_xor(x0[2], 32); xo[3] = __shfl_xor(x0[3], 32);
                    if ((wc & 1) == 0) x0 = fq < 2 ? x0 * c - xo * s : x0 * c + xo * s;
                    if (valid) { GAS f16* q = QI + (size_t)grow * 1024 + c0 + 128 * bj;
                        u32x2 w0 = {pk_f16(x0[0], x0[1]), pk_f16(x0[2], x0[3])}, w1 = {pk_f16(x1[0], x1[1]), pk_f16(x1[2], x1[3])};
                        *(GAS u32x2*)q = w0; *(GAS u32x2*)(q + 16) = w1; } } }
        } else {
            GAS f16* U = (GAS f16*)(ws + WS_U); GAS f16* G = (GAS f16*)(ws + WS_G); const int ch = 64 * (pn - 15) + 16 * wc + 4 * fq;
            ROWLOOP { asm volatile("" ::: "memory"); ROWVARS
                const f32x4 h = acc[ai][0][m][0], b = acc[ai][0][m][1], c = acc[ai][1][m][0], z = acc[ai][1][m][1];
                const f32x4 uu = c * h; f32x4 gg; gg[0] = b[0] * silu(z[0]); gg[1] = b[1] * silu(z[1]); gg[2] = b[2] * silu(z[2]); gg[3] = b[3] * silu(z[3]);
                if (valid) { u32x2 wu = {pk_f16(uu[0], uu[1]), pk_f16(uu[2], uu[3])}, wg = {pk_f16(gg[0], gg[1]), pk_f16(gg[2], gg[3])};
                    *(GAS u32x2*)(U + (size_t)grow * 1024 + ch) = wu; *(GAS u32x2*)(G + (size_t)grow * 1024 + ch) = wg;
                    if (!smp && tt >= S - 2) *(GAS f32x4*)(out + O_CVP + ((size_t)bb * 2 + (tt - (S - 2))) * 1024 + ch) = uu;
                    if (smp && tt >= 2) *(GAS f32x4*)(out + O_CVS + ((size_t)(r >> 2) * 2 + (tt - 2)) * 1024 + ch) = uu; } }
        }
#undef ROWLOOP
#undef ROWVARS
    }
};


struct EpiOut {
    float* out; const float* xp;
    __device__ __forceinline__ void operator()(f32x4 (&acc)[2][2][4][2], const pg8::Unit& u, int wr, int wc, int fr_, int fq_) const {
        int fr = fr_, fq = fq_; asm volatile("" : "+v"(fr), "+v"(fq));
        GAS float* out = (GAS float*)this->out; const GAS float* xp = (const GAS float*)this->xp; asm volatile("" : "+s"(out), "+s"(xp));
        const size_t base = (size_t)(u.pm * 256 + 64 * wr + fr) * DM + u.pn * 256 + 32 * wc + 4 * fq;
#pragma unroll
        for (int ai = 0; ai < 2; ++ai)
#pragma unroll
            for (int m = 0; m < 4; ++m) { asm volatile("" ::: "memory"); const size_t off = base + (size_t)(128 * ai + 16 * m) * DM;
#pragma unroll
                for (int bj = 0; bj < 2; ++bj)
#pragma unroll
                    for (int n = 0; n < 2; ++n) { const f32x4 xv = *(const GAS f32x4*)(xp + off + 128 * bj + 16 * n); *(GAS f32x4*)(out + off + 128 * bj + 16 * n) = xv + acc[ai][bj][m][n]; } }
    }
};
__device__ __forceinline__ void p4_sample(const Args& a, LAS unsigned char* lds, int bx, int G, int tid) {
    const f16* MIX = (const f16*)(a.ws + WS_MIX) + (size_t)MP * DM; const f16* WT = (const f16*)(a.ws + WS_WOUTT);
    LAS float* part = (LAS float*)lds;
    const int r = tid & 31, cn = (tid >> 5) & 7, ks = tid >> 8;
    for (int cg = bx; cg < DM / 8; cg += G) {
        const int col = cg * 8 + cn;
        const f16x8* mp = (const f16x8*)(MIX + (size_t)r * DM + ks * 1024); const f16x8* wp = (const f16x8*)(WT + (size_t)col * DM + ks * 1024);
        float s0 = 0.f, s1 = 0.f;
#pragma unroll 4
        for (int k = 0; k < 128; ++k) { const f16x8 mv = mp[k], wv = wp[k];
            s0 = __builtin_amdgcn_fdot2((f16x2){mv[0], mv[1]}, (f16x2){wv[0], wv[1]}, s0, false); s1 = __builtin_amdgcn_fdot2((f16x2){mv[2], mv[3]}, (f16x2){wv[2], wv[3]}, s1, false);
            s0 = __builtin_amdgcn_fdot2((f16x2){mv[4], mv[5]}, (f16x2){wv[4], wv[5]}, s0, false); s1 = __builtin_amdgcn_fdot2((f16x2){mv[6], mv[7]}, (f16x2){wv[6], wv[7]}, s1, false); }
        part[(ks * 32 + r) * 8 + cn] = s0 + s1;
        __syncthreads();
        if (tid < 256) { const int rr = tid >> 3, cc = tid & 7; a.out[O_YS + (size_t)rr * DM + cg * 8 + cc] = a.in[1][(size_t)rr * DM + cg * 8 + cc] + part[rr * 8 + cc] + part[(32 + rr) * 8 + cc]; }
        __syncthreads();
    }
}

constexpr int SC_STRIDE = 2052;
constexpr int SC_BYTES = 16 * SC_STRIDE * 4;
constexpr int WSCR_OFF = 131584, WSCR_BYTES = 1536;
__device__ __forceinline__ f16x8 cvt8(f32x4 a, f32x4 b) { u32x4 w = {pk_f16(a[0], a[1]), pk_f16(a[2], a[3]), pk_f16(b[0], b[1]), pk_f16(b[2], b[3])}; return __builtin_bit_cast(f16x8, w); }

__device__ __forceinline__ void p2_convmix(const Args& a, int gw, int NGW, int lane) {
    const GAS f16* U = (const GAS f16*)(a.ws + WS_U); const GAS f16* Gm = (const GAS f16*)(a.ws + WS_G); GAS f16* MIX = (GAS f16*)(a.ws + WS_MIX);
    const GAS float* wconv = (const GAS float*)a.in[12]; const GAS float* state = (const GAS float*)a.in[5];
    for (int ch = gw; ch < MT / 4; ch += NGW) {
        const int row0 = 4 * ch; const bool smp = row0 >= MP; const int t0 = smp ? 0 : (row0 & (S - 1)); const int seq = (row0 - MP) >> 2;
#pragma unroll
        for (int half = 0; half < 2; ++half) { const int cb = half * 512 + 8 * lane;
            float um2[8], um1[8], w0[8], w1[8], w2[8];
#pragma unroll
            for (int e = 0; e < 8; e += 4) { const f32x4 a0 = *(const GAS f32x4*)(wconv + cb + e), a1 = *(const GAS f32x4*)(wconv + 1024 + cb + e), a2 = *(const GAS f32x4*)(wconv + 2048 + cb + e);
#pragma unroll
                for (int i = 0; i < 4; ++i) { w0[e + i] = a0[i]; w1[e + i] = a1[i]; w2[e + i] = a2[i]; } }
            if (t0 == 0) {
                if (smp) {
#pragma unroll
                    for (int e = 0; e < 8; e += 4) { const f32x4 s0 = *(const GAS f32x4*)(state + ((size_t)seq * 2) * 1024 + cb + e), s1 = *(const GAS f32x4*)(state + ((size_t)seq * 2 + 1) * 1024 + cb + e);
#pragma unroll
                        for (int i = 0; i < 4; ++i) { um2[e + i] = s0[i]; um1[e + i] = s1[i]; } }
                } else {
#pragma unroll
                    for (int e = 0; e < 8; ++e) { um2[e] = 0.f; um1[e] = 0.f; } }
            } else { const f16x8 p2 = *(const GAS f16x8*)(U + (size_t)(row0 - 2) * 1024 + cb), p1 = *(const GAS f16x8*)(U + (size_t)(row0 - 1) * 1024 + cb);
#pragma unroll
                for (int e = 0; e < 8; ++e) { um2[e] = (float)p2[e]; um1[e] = (float)p1[e]; } }
#pragma unroll
            for (int i = 0; i < 4; ++i) { const size_t row = row0 + i;
                const f16x8 uv = *(const GAS f16x8*)(U + row * 1024 + cb), gv = *(const GAS f16x8*)(Gm + row * 1024 + cb); float o[8];
#pragma unroll
                for (int e = 0; e < 8; ++e) { const float u = (float)uv[e]; const float cv = w0[e] * um2[e] + w1[e] * um1[e] + w2[e] * u; o[e] = (float)gv[e] * cv; um2[e] = um1[e]; um1[e] = u; }
                u32x4 w = {pk_f16(o[0], o[1]), pk_f16(o[2], o[3]), pk_f16(o[4], o[5]), pk_f16(o[6], o[7])};
                *(GAS u32x4*)(MIX + row * 2048 + 1024 + cb) = w; }
        }
    }
}

__device__ __forceinline__ void p2_sscore(const Args& a, int gw, int NGW, int lane) {
    const GAS float* cki = (const GAS float*)a.in[4]; const GAS int* ptab = (const GAS int*)a.in[6];
    const GAS f16* QI = (const GAS f16*)(a.ws + WS_QI); const GAS float* WI = (const GAS float*)(a.ws + WS_WI); GAS float* SSC = (GAS float*)(a.ws + WS_SSC);
    const int fr = lane & 15, fq = lane >> 4;
    for (int it = gw; it < NSB * 256; it += NGW) {
        const int sb = it >> 8, hp = it & 255, pg = hp >> 1, k0 = (hp & 1) * 64; const int phys = ptab[sb * NPAGES + pg];
        const GAS float* kbase = cki + ((size_t)phys * PAGE + k0) * 64;
        f16x8 qf[4][2]; f32x4 wv[4];
#pragma unroll
        for (int t = 0; t < 4; ++t) { const size_t row = MP + 4 * sb + t;
            qf[t][0] = *(const GAS f16x8*)(QI + row * 1024 + fr * 64 + 8 * fq); qf[t][1] = *(const GAS f16x8*)(QI + row * 1024 + fr * 64 + 32 + 8 * fq);
            wv[t] = *(const GAS f32x4*)(WI + row * 16 + 4 * fq); }
#pragma unroll
        for (int tile = 0; tile < 4; ++tile) {
            const GAS float* kr = kbase + (size_t)(16 * tile + fr) * 64 + 8 * fq;
            const f16x8 kf0 = cvt8(*(const GAS f32x4*)kr, *(const GAS f32x4*)(kr + 4)), kf1 = cvt8(*(const GAS f32x4*)(kr + 32), *(const GAS f32x4*)(kr + 36));
            float mine = 0.f;
#pragma unroll
            for (int t = 0; t < 4; ++t) { f32x4 c = {0.f, 0.f, 0.f, 0.f};
                c = __builtin_amdgcn_mfma_f32_16x16x32_f16(qf[t][0], kf0, c, 0, 0, 0); c = __builtin_amdgcn_mfma_f32_16x16x32_f16(qf[t][1], kf1, c, 0, 0, 0);
                float s = wv[t][0] * fmaxf(c[0], 0.f) + wv[t][1] * fmaxf(c[1], 0.f) + wv[t][2] * fmaxf(c[2], 0.f) + wv[t][3] * fmaxf(c[3], 0.f);
                s += __shfl_xor(s, 16); s += __shfl_xor(s, 32);
                mine = fq == t ? s : mine; }
            SSC[(size_t)(4 * sb + fq) * PAST + pg * PAGE + k0 + 16 * tile + fr] = mine;
        }
    }
}

__device__ __forceinline__ void wave_topk_mask(const LAS float* row, int t, GAS unsigned long long* mrow, int lane, LAS unsigned* hist, LAS float* cand) {
    const float NINF = -__builtin_inff(), PINF = __builtin_inff();
    float v[32]; float mx = NINF, mn = PINF;
#pragma unroll
    for (int j = 0; j < 32; ++j) { const int s = 64 * j + lane; const float x = row[s]; const bool ok = s <= t; v[j] = ok ? x : NINF; mx = fmaxf(mx, v[j]); mn = fminf(mn, ok ? x : PINF); }
#pragma unroll
    for (int o = 1; o < 64; o <<= 1) { mx = fmaxf(mx, __shfl_xor(mx, o)); mn = fminf(mn, __shfl_xor(mn, o)); }
    *(LAS u32x4*)(hist + 4 * lane) = (u32x4){0u, 0u, 0u, 0u};
    const float scale = 255.5f / (mx - mn);
    float tau = 0.f; bool have = false;
    if (mx > mn) {
        asm volatile("s_waitcnt lgkmcnt(0)" ::: "memory");
#pragma unroll
        for (int j = 0; j < 32; ++j) { if (64 * j + lane <= t) { int b = (int)((v[j] - mn) * scale); b = b > 255 ? 255 : b; __hip_atomic_fetch_add(hist + b, 1u, __ATOMIC_RELAXED, __HIP_MEMORY_SCOPE_WORKGROUP); } }
        asm volatile("s_waitcnt lgkmcnt(0)" ::: "memory");
        const u32x4 h = *(const LAS u32x4*)(hist + 4 * lane);
        const unsigned sl = h[0] + h[1] + h[2] + h[3]; unsigned pre = sl;
#pragma unroll
        for (int o = 1; o < 64; o <<= 1) { const unsigned y = __shfl_up(pre, o); if (lane >= o) pre += y; }
        const unsigned tot = __builtin_amdgcn_readlane(pre, 63); const unsigned suf = tot - pre + sl;
        const unsigned long long bm = __ballot(suf >= TOPK);
        const int Ls = 63 - __builtin_clzll(bm);
        unsigned c = __builtin_amdgcn_readlane(suf, Ls) - __builtin_amdgcn_readlane(sl, Ls);
        const unsigned h3 = __builtin_amdgcn_readlane(h[3], Ls), h2 = __builtin_amdgcn_readlane(h[2], Ls), h1 = __builtin_amdgcn_readlane(h[1], Ls);
        int Bs;
        if (c + h3 >= TOPK) Bs = 4 * Ls + 3; else { c += h3; if (c + h2 >= TOPK) Bs = 4 * Ls + 2; else { c += h2; if (c + h1 >= TOPK) Bs = 4 * Ls + 1; else { c += h1; Bs = 4 * Ls; } } }
        const int need = TOPK - (int)c;
        int base = 0;
#pragma unroll
        for (int j = 0; j < 32; ++j) { int b = (int)((v[j] - mn) * scale); b = b > 255 ? 255 : b; const bool isc = (64 * j + lane <= t) && b == Bs;
            const unsigned long long m = __ballot(isc);
            if (m) { const int pos = base + (int)__builtin_amdgcn_mbcnt_hi((unsigned)(m >> 32), __builtin_amdgcn_mbcnt_lo((unsigned)m, 0u)); if (isc && pos < 64) cand[pos] = v[j]; base += __builtin_popcountll(m); } }
        if (base <= 64) {
            asm volatile("s_waitcnt lgkmcnt(0)" ::: "memory");
            const float x = lane < base ? cand[lane] : NINF; int rank = 0;
            for (int m = 0; m < base; ++m) { const float y = __builtin_bit_cast(float, __builtin_amdgcn_readlane(__builtin_bit_cast(int, x), m)); rank += y > x ? 1 : 0; }
            float tc = (lane < base && rank <= need - 1) ? x : PINF;
#pragma unroll
            for (int o = 1; o < 64; o <<= 1) tc = fminf(tc, __shfl_xor(tc, o));
            tau = tc; have = true;
        }
    }
    if (!have) {
        unsigned tk = 0u;
        for (int bit = 31; bit >= 0; --bit) { const unsigned cd = tk | (1u << bit); int cnt = 0;
#pragma unroll
            for (int j = 0; j < 32; ++j) cnt += __builtin_popcountll(__ballot((64 * j + lane <= t) && fkey(v[j]) >= cd));
            if (cnt >= TOPK) tk = cd; }
        tau = __builtin_bit_cast(float, (tk & 0x80000000u) ? (tk ^ 0x80000000u) : ~tk);
    }
    unsigned wlo = 0u, whi = 0u;
#pragma unroll
    for (int j = 0; j < 32; ++j) { const unsigned long long m = __ballot((64 * j + lane <= t) && v[j] >= tau); if (lane == j) { wlo = (unsigned)m; whi = (unsigned)(m >> 32); } }
    if (lane < 32) mrow[lane] = ((unsigned long long)whi << 32) | wlo;
}

#define RELU_FMA(acc_, c_, w_) do { const float r_ = fmaxf((c_), 0.f); asm("v_fmac_f32_e32 %0, %1, %2" : "+v"(acc_) : "v"(r_), "v"(w_)); } while (0)
__device__ __forceinline__ void p2_index_tile(const Args& a, LAS unsigned char* lds, int b, int t0, int wave, int lane) {
    const GAS f16* QI = (const GAS f16*)(a.ws + WS_QI); const GAS float* WI = (const GAS float*)(a.ws + WS_WI); const GAS f16* KI = (const GAS f16*)(a.ws + WS_KI);
    GAS unsigned long long* MASK = (GAS unsigned long long*)(a.ws + WS_MASK);
    LAS float* sc = (LAS float*)lds;
    const int fr = lane & 15, fq = lane >> 4; const size_t rowq = (size_t)b * S + t0 + fr;
    f16x8 qf[16][2]; float w[16];
#pragma unroll
    for (int h = 0; h < 16; ++h) { qf[h][0] = *(const GAS f16x8*)(QI + rowq * 1024 + h * 64 + 8 * fq); qf[h][1] = *(const GAS f16x8*)(QI + rowq * 1024 + h * 64 + 32 + 8 * fq); }
#pragma unroll
    for (int h = 0; h < 16; h += 4) { const f32x4 x = *(const GAS f32x4*)(WI + rowq * 16 + h); w[h] = x[0]; w[h + 1] = x[1]; w[h + 2] = x[2]; w[h + 3] = x[3]; }
    const int nkt = (t0 + 16) >> 4;
    const GAS f16* kp = KI + ((size_t)b * S + fr) * 64 + 8 * fq;
    for (int kt = wave; kt < nkt; kt += NWAVES) {
        const f16x8 kf0 = *(const GAS f16x8*)(kp + (size_t)kt * 1024), kf1 = *(const GAS f16x8*)(kp + (size_t)kt * 1024 + 32);
        float a0 = 0.f, a1 = 0.f, a2 = 0.f, a3 = 0.f;
#pragma unroll
        for (int h = 0; h < 16; ++h) { f32x4 c = {0.f, 0.f, 0.f, 0.f};
            c = __builtin_amdgcn_mfma_f32_16x16x32_f16(kf0, qf[h][0], c, 0, 0, 0); c = __builtin_amdgcn_mfma_f32_16x16x32_f16(kf1, qf[h][1], c, 0, 0, 0);
            RELU_FMA(a0, c[0], w[h]); RELU_FMA(a1, c[1], w[h]); RELU_FMA(a2, c[2], w[h]); RELU_FMA(a3, c[3], w[h]); }
        *(LAS f32x4*)(sc + fr * SC_STRIDE + 16 * kt + 4 * fq) = (f32x4){a0, a1, a2, a3};
    }
    __syncthreads();
#pragma unroll 1
    for (int qq = 0; qq < 2; ++qq) { const int q = 2 * wave + qq; const int t = t0 + q;
        wave_topk_mask(sc + q * SC_STRIDE, t, MASK + ((size_t)b * S + t) * 32, lane, (LAS unsigned*)(lds + WSCR_OFF + wave * WSCR_BYTES), (LAS float*)(lds + WSCR_OFF + wave * WSCR_BYTES + 1024)); }
    __syncthreads();
}

__device__ __forceinline__ void p2_phase(const Args& a, LAS unsigned char* lds, int vcu, int G, int wave, int lane) {
    const int gw = vcu * NWAVES + wave, NGW = G * NWAVES;
    p2_sscore(a, gw, NGW, lane);
    p2_convmix(a, gw, NGW, lane);
    { GAS unsigned long long* MASK = (GAS unsigned long long*)(a.ws + WS_MASK);
      for (int i = gw * 64 + lane; i < NB * TOPK * 32; i += NGW * 64) { const int wd = i & 31, t = (i >> 5) & (TOPK - 1), b = i >> 13; const int lo = 64 * wd;
          const unsigned long long m = lo + 63 <= t ? ~0ull : (lo > t ? 0ull : ((1ull << (t - lo + 1)) - 1ull));
          MASK[((size_t)b * S + t) * 32 + wd] = m; } }
    constexpr int NT = NB * (S - TOPK) / 16;
    for (int r = 0; r * G < NT; ++r) { const int k = (r & 1) ? (r + 1) * G - 1 - vcu : r * G + vcu;
        if (k < NT) { const int j = (NT / NB - 1) - (k >> 2), b = k & 3; p2_index_tile(a, lds, b, TOPK + 16 * j, wave, lane); } }
}

namespace att {
typedef short bf16x8 __attribute__((ext_vector_type(8)));
typedef short s16x4 __attribute__((ext_vector_type(4)));
typedef float f32x16 __attribute__((ext_vector_type(16)));
constexpr int QBLK = 32, KVBLK = 64, D = 128;
constexpr int SHM_V = KVBLK * D * 2, SHM_K = KVBLK * D * 2;
constexpr int WS_OFF = 2 * SHM_V + 2 * SHM_K;
constexpr float SCALE = 0.08838834764831845f;
#define KSWZ(row, colB) ((row) * 256 + ((colB) ^ (((row) & 7) << 4)))
#define SBAR() __builtin_amdgcn_sched_barrier(0)
__device__ __forceinline__ int v_st(int k, int c) { const int kk = (k & ~0xC) | ((k & 4) << 1) | ((k & 8) >> 1); return ((kk >> 3) * 4 + (c >> 5)) * 512 + ((kk & 7) * 32 + (c & 31)) * 2; }
__device__ __forceinline__ int v_rd_base(int lane) { return ((lane & 3) << 3) | (((lane >> 2) & 3) << 6) | (((lane >> 4) & 1) << 5) | (((lane >> 5) & 1) << 8); }
constexpr int v_rd_off(int d0, int ks, int half) { return d0 * 512 + ks * 4096 + half * 2048; }
__device__ __forceinline__ int crow(int r, int hi) { return (r & 3) + 8 * (r >> 2) + 4 * hi; }
__device__ __forceinline__ unsigned cvtpk(float lo, float hi) { return pk_bf16(lo, hi); }

template <int KB>
__device__ __forceinline__ void qkt(f32x16& p0, f32x16& p1, const LAS unsigned char* K_lds, int r32, int hi, const LAS unsigned char* qp) {
    p0 = f32x16{}; p1 = f32x16{};
    const LAS unsigned char* kb[4];
#pragma unroll
    for (int dd = 0; dd < 4; ++dd) kb[dd] = K_lds + KB * SHM_K + KSWZ(r32, (dd * 16 + hi * 8) * 2);
#pragma unroll
    for (int d0 = 0; d0 < 8; ++d0) { const LAS unsigned char* a = kb[d0 & 3] + (d0 >> 2) * 128;
        const bf16x8 b0 = *(const LAS bf16x8*)a;
        const bf16x8 b1 = *(const LAS bf16x8*)(a + 32 * 256);
        const bf16x8 qv = *(const LAS bf16x8*)(qp + d0 * 1024);
        p0 = __builtin_amdgcn_mfma_f32_32x32x16_bf16(b0, qv, p0, 0, 0, 0);
        p1 = __builtin_amdgcn_mfma_f32_32x32x16_bf16(b1, qv, p1, 0, 0, 0); }
}
template <int VB>
__device__ __forceinline__ void pv_tile(f32x16* o, int vb0, bf16x8 pa0, bf16x8 pa1, bf16x8 pa2, bf16x8 pa3) {
#define TRRD(dst, off) asm volatile("ds_read_b64_tr_b16 %0, %1 offset:%2" : "=&v"(dst) : "v"(vb0), "i"(off) : "memory")
#define PV_D0(d0) do { s16x4 l0, l1, l2, l3, h0, h1, h2, h3; constexpr int b_ = VB * SHM_V + v_rd_off(d0, 0, 0); \
        TRRD(l0, b_); TRRD(h0, b_ + 2048); TRRD(l1, b_ + 4096); TRRD(h1, b_ + 6144); TRRD(l2, b_ + 8192); TRRD(h2, b_ + 10240); TRRD(l3, b_ + 12288); TRRD(h3, b_ + 14336); \
        asm volatile("s_waitcnt lgkmcnt(0)" ::: "memory"); SBAR(); \
        o[d0] = __builtin_amdgcn_mfma_f32_32x32x16_bf16(pa0, (bf16x8){l0[0], l0[1], l0[2], l0[3], h0[0], h0[1], h0[2], h0[3]}, o[d0], 0, 0, 0); \
        o[d0] = __builtin_amdgcn_mfma_f32_32x32x16_bf16(pa1, (bf16x8){l1[0], l1[1], l1[2], l1[3], h1[0], h1[1], h1[2], h1[3]}, o[d0], 0, 0, 0); \
        o[d0] = __builtin_amdgcn_mfma_f32_32x32x16_bf16(pa2, (bf16x8){l2[0], l2[1], l2[2], l2[3], h2[0], h2[1], h2[2], h2[3]}, o[d0], 0, 0, 0); \
        o[d0] = __builtin_amdgcn_mfma_f32_32x32x16_bf16(pa3, (bf16x8){l3[0], l3[1], l3[2], l3[3], h3[0], h3[1], h3[2], h3[3]}, o[d0], 0, 0, 0); } while (0)
    PV_D0(0); PV_D0(1); PV_D0(2); PV_D0(3);
#undef PV_D0
#undef TRRD
}
__device__ __forceinline__ void partialSM(f32x16& p0, f32x16& p1, unsigned wl, unsigned wh, float sh2) {
    const float NEG = -__builtin_inff(); constexpr float C2 = 1.4426950408889634f * SCALE;
#pragma unroll
    for (int r = 0; r < 16; ++r) { const unsigned bit = 1u << ((r & 3) + 8 * (r >> 2));
        p0[r] = (wl & bit) ? fmaf(p0[r], C2, -sh2) : NEG; p1[r] = (wh & bit) ? fmaf(p1[r], C2, -sh2) : NEG; }
#pragma unroll
    for (int r = 0; r < 16; ++r) p0[r] = __builtin_amdgcn_exp2f(p0[r]);
}
__device__ __forceinline__ void finishSM(f32x16& p0, f32x16& p1, float& l_reg, bf16x8& pa0, bf16x8& pa1, bf16x8& pa2, bf16x8& pa3) {
#pragma unroll
    for (int r = 0; r < 16; ++r) p1[r] = __builtin_amdgcn_exp2f(p1[r]);
    float ps = 0;
#pragma unroll
    for (int r = 0; r < 16; ++r) ps += p0[r];
#pragma unroll
    for (int r = 0; r < 16; ++r) ps += p1[r];
    l_reg += ps;
#define PK4(P, B_, OUT) do { unsigned a0 = cvtpk(P[B_+0], P[B_+1]), a1 = cvtpk(P[B_+2], P[B_+3]); \
        unsigned b0 = cvtpk(P[B_+4], P[B_+5]), b1 = cvtpk(P[B_+6], P[B_+7]); \
        auto r0 = __builtin_amdgcn_permlane32_swap(a0, b0, false, false); auto r1 = __builtin_amdgcn_permlane32_swap(a1, b1, false, false); \
        u32x4 w = {r0[0], r1[0], r0[1], r1[1]}; OUT = __builtin_bit_cast(bf16x8, w); } while (0)
    PK4(p0, 0, pa0); PK4(p0, 8, pa1); PK4(p1, 0, pa2); PK4(p1, 8, pa3);
#undef PK4
}

__device__ __forceinline__ __amdgpu_buffer_rsrc_t mk_rsrc(const GAS void* p, unsigned bytes) {
    const unsigned long long u = (unsigned long long)p; const unsigned lo = __builtin_amdgcn_readfirstlane((unsigned)u), hi = __builtin_amdgcn_readfirstlane((unsigned)(u >> 32));
    return __builtin_amdgcn_make_buffer_rsrc((void*)(((unsigned long long)hi << 32) | lo), (short)0, (int)bytes, 0x00020000);
}
__device__ __forceinline__ void attn_block(const Args& a, LAS unsigned char* lds, int b, int kvh, int q0, float sh2) {
    int tid_ = threadIdx.x; asm volatile("" : "+v"(tid_));
    const int tid = tid_, wid = __builtin_amdgcn_readfirstlane(tid >> 6), lane = tid & 63, r32 = lane & 31, hi = lane >> 5;
    const int head = 4 * kvh + (wid >> 1), qw = q0 + 32 * (wid & 1);
    const GAS bf16_t* Qw = (const GAS bf16_t*)(a.ws + WS_QB) + (((size_t)b * NH + head) * S + qw) * D;
    const GAS bf16_t* Kh = (const GAS bf16_t*)(a.ws + WS_KB) + ((size_t)b * NKV + kvh) * S * D;
    const GAS bf16_t* Vh = (const GAS bf16_t*)(a.ws + WS_VB) + ((size_t)b * NKV + kvh) * S * D;
    const __amdgpu_buffer_rsrc_t rK = mk_rsrc(Kh, S * D * 2), rV = mk_rsrc(Vh, S * D * 2), rM = mk_rsrc((const GAS unsigned long long*)(a.ws + WS_MASK) + ((size_t)b * S + qw) * 32, 32 * 256);
    const unsigned moff = (unsigned)r32 * 256u;
    const int NT = q0 / KVBLK + 1;
    LAS unsigned char* V_lds = lds; LAS unsigned char* K_lds = lds + 2 * SHM_V;
    const int sr = tid >> 4, sc = (tid & 15) * 8, vst0 = v_st(sr, sc), vst1 = v_st(32 + sr, sc), kws = KSWZ(sr, sc * 2);
    const int vb0 = (int)(unsigned)(size_t)V_lds + v_rd_base(lane); const unsigned kvoff = (unsigned)(sr * D + sc) * 2u;
    bf16x8 st_v0, st_v1, st_k0, st_k1;
    LAS unsigned char* qp = lds + WS_OFF + 2048 + wid * 8192 + lane * 16;
#define VMW() asm volatile("s_waitcnt vmcnt(0)" ::: "memory")
#define BL128(r_, so_) __builtin_bit_cast(bf16x8, __builtin_amdgcn_raw_buffer_load_b128(r_, kvoff, (so_), 0))
#define SLOAD_H(k0) do { const int so_ = (k0) * 256; st_v0 = BL128(rV, so_); st_v1 = BL128(rV, so_ + 8192); st_k0 = BL128(rK, so_); st_k1 = BL128(rK, so_ + 8192); } while (0)
#define SWRITE_HK(bf) do { *(LAS bf16x8*)(K_lds + (bf) * SHM_K + kws) = st_k0; *(LAS bf16x8*)(K_lds + (bf) * SHM_K + kws + 32 * 256) = st_k1; } while (0)
#define SWRITE_HV(bf) do { *(LAS bf16x8*)(V_lds + (bf) * SHM_V + vst0) = st_v0; *(LAS bf16x8*)(V_lds + (bf) * SHM_V + vst1) = st_v1; } while (0)
#define SWRITE_H(bf) do { SWRITE_HV(bf); SWRITE_HK(bf); } while (0)
#define MLOAD(t) __builtin_bit_cast(unsigned long long, __builtin_amdgcn_raw_buffer_load_b64(rM, moff, (t) * 8, 0))
#define MSPLIT(mw, wl, wh) do { wl = (unsigned)(mw) >> (4 * hi); wh = (unsigned)((mw) >> 32) >> (4 * hi); } while (0)
    { bf16x8 qt[8];
#pragma unroll
      for (int d0 = 0; d0 < 8; ++d0) qt[d0] = *(const GAS bf16x8*)(Qw + (unsigned)(r32 * D + d0 * 16 + hi * 8));
#pragma unroll
      for (int d0 = 0; d0 < 8; ++d0) *(LAS bf16x8*)(qp + d0 * 1024) = qt[d0]; }
    SLOAD_H(0); unsigned long long mwA = MLOAD(0), mwB = 0ull; VMW(); SWRITE_H(0);
    if (NT > 1) { SLOAD_H(KVBLK); mwB = MLOAD(1); }
    __syncthreads();
    float l_reg = 0.f; f32x16 o[4] = {};
    f32x16 p0, p1; bf16x8 pa0, pa1, pa2, pa3; unsigned wl, wh;
    SBAR(); qkt<0>(p0, p1, K_lds, r32, hi, qp);
    MSPLIT(mwA, wl, wh); partialSM(p0, p1, wl, wh, sh2);
    if (NT > 1) { VMW(); SWRITE_H(1); }
    __syncthreads();
#define STEP(t, KB, VB) do { \
        finishSM(p0, p1, l_reg, pa0, pa1, pa2, pa3); SBAR(); \
        if ((t) + 1 < NT) { SLOAD_H(((t) + 1) * KVBLK); mwA = MLOAD((t) + 1); SBAR(); } \
        pv_tile<VB>(o, vb0, pa0, pa1, pa2, pa3); SBAR(); \
        qkt<KB>(p0, p1, K_lds, r32, hi, qp); \
        MSPLIT(mwB, wl, wh); partialSM(p0, p1, wl, wh, sh2); mwB = mwA; \
        __syncthreads(); \
        if ((t) + 1 < NT) { VMW(); SWRITE_H(VB); } \
        __syncthreads(); } while (0)
    int t = 1;
    for (; t + 1 < NT; t += 2) { STEP(t, 1, 0); STEP(t + 1, 0, 1); }
    if (t < NT) { STEP(t, 1, 0); }
    finishSM(p0, p1, l_reg, pa0, pa1, pa2, pa3); SBAR();
    if ((NT - 1) & 1) pv_tile<1>(o, vb0, pa0, pa1, pa2, pa3); else pv_tile<0>(o, vb0, pa0, pa1, pa2, pa3);
    { auto rr = __builtin_amdgcn_permlane32_swap(__float_as_uint(l_reg), __float_as_uint(l_reg), false, false); l_reg = __uint_as_float(rr[0]) + __uint_as_float(rr[1]); }
    { int te = threadIdx.x; asm volatile("" : "+v"(te));
      const int le = te & 63, r32e = le & 31, hie = le >> 5;
      LAS float* wse = (LAS float*)(lds + WS_OFF) + wid * 64;
      if (hie == 0) wse[r32e] = l_reg;
      asm volatile("s_waitcnt lgkmcnt(0)" ::: "memory");
      __syncthreads();
      LAS f16* stg = (LAS f16*)(lds + wid * 8192);
#pragma unroll
      for (int r = 0; r < 16; ++r) { const int orow = crow(r, hie); const float rl = __builtin_amdgcn_rcpf(wse[orow]);
#pragma unroll
          for (int d0 = 0; d0 < 4; ++d0) stg[orow * 128 + d0 * 32 + r32e] = (f16)(o[d0][r] * rl); }
      asm volatile("s_waitcnt lgkmcnt(0)" ::: "memory");
      const GAS f16* SZ = (const GAS f16*)(a.ws + WS_SZ) + ((size_t)b * S + qw) * 1024 + head * 128; GAS f16* MIX = (GAS f16*)(a.ws + WS_MIX) + ((size_t)b * S + qw) * 2048 + head * 128;
#pragma unroll
      for (int i = 0; i < 8; ++i) { const int c = le + 64 * i, row = c >> 4, ch = c & 15;
          const f16x8 ov = *(const LAS f16x8*)(stg + row * 128 + ch * 8); const f16x8 zv = *(const GAS f16x8*)(SZ + (unsigned)(row * 1024 + ch * 8));
          *(GAS f16x8*)(MIX + (unsigned)(row * 2048 + ch * 8)) = ov * zv; } }
    asm volatile("s_waitcnt lgkmcnt(0)" ::: "memory");
    __syncthreads();
#undef BL128
#undef VMW
#undef SLOAD_H
#undef SWRITE_HK
#undef SWRITE_HV
#undef SWRITE_H
#undef MLOAD
#undef MSPLIT
#undef STEP
}
#undef KSWZ
#undef SBAR
}

__device__ __forceinline__ void p3_sample_item(const Args& a, LAS unsigned char* lds, int qi, int tid) {
    const int sb = qi / NST, tl = qi % NST; constexpr int L = PAST + NST, PER = 33;
    const int lane = tid & 63, wave = __builtin_amdgcn_readfirstlane(tid >> 6);
    const GAS float* ck = (const GAS float*)a.in[2]; const GAS float* cv = (const GAS float*)a.in[3]; const GAS int* ptab = (const GAS int*)a.in[6]; const GAS float* out_ro = (const GAS float*)a.out;
    LAS float* q = (LAS float*)lds; LAS float* w = q + 1024; LAS float* newsc = w + 16; LAS unsigned* cnt = (LAS unsigned*)(newsc + 4); LAS int* nsel = (LAS int*)(cnt + 32);
    LAS unsigned* rid = (LAS unsigned*)(nsel + 4); LAS float* qa = (LAS float*)(rid + 512); LAS float* sc = qa + 1024; LAS float* inv = sc + 8 * 512; LAS float* part = inv + 8;
    const GAS f16* QI = (const GAS f16*)(a.ws + WS_QI) + (size_t)(MP + qi) * 1024; const GAS float* QS = (const GAS float*)(a.ws + WS_QS) + (size_t)qi * 1024;
    for (int i = tid; i < 1024; i += 512) { q[i] = (float)QI[i]; qa[i] = QS[i]; }
    if (tid < 16) w[tid] = ((const GAS float*)(a.ws + WS_WI))[(size_t)(MP + qi) * 16 + tid];
    if (tid < 32) cnt[tid] = 0u;
    if (tid == 0) *nsel = 0;
    __syncthreads();
    if (tid < NST) { const GAS float* kr = out_ro + O_KIS + (size_t)(sb * NST + tid) * 64; float s = 0.f;
#pragma unroll 1
        for (int h = 0; h < 16; ++h) { float dsum = 0.f;
#pragma unroll 8
            for (int d = 0; d < 64; ++d) dsum += q[h * 64 + d] * kr[d];
            s += w[h] * fmaxf(dsum, 0.f); }
        newsc[tid] = s; }
    const GAS float* ssc = (const GAS float*)(a.ws + WS_SSC) + (size_t)qi * PAST;
    unsigned keys[PER];
#pragma unroll
    for (int j = 0; j < PER - 1; ++j) keys[j] = fkey(ssc[j * 512 + tid]);
    __syncthreads();
    { const int s = (PER - 1) * 512 + tid; keys[PER - 1] = (s < L && (s - PAST) <= tl) ? fkey(newsc[s - PAST]) : 0u; }
    unsigned tau = 0u;
    for (int bit = 31; bit >= 0; --bit) { const unsigned cand = tau | (1u << bit); int c = 0;
#pragma unroll
        for (int j = 0; j < PER; ++j) c += __builtin_popcountll(__ballot(keys[j] >= cand));
        if (lane == 0) __hip_atomic_fetch_add(cnt + bit, (unsigned)c, __ATOMIC_RELAXED, __HIP_MEMORY_SCOPE_WORKGROUP);
        __syncthreads();
        if (cnt[bit] >= TOPK) tau = cand; }
#pragma unroll
    for (int j = 0; j < PER; ++j) { if (keys[j] >= tau && keys[j] != 0u) { const int s = j * 512 + tid; const int p = __hip_atomic_fetch_add(nsel, 1, __ATOMIC_RELAXED, __HIP_MEMORY_SCOPE_WORKGROUP);
        if (p < 512) rid[p] = s < PAST ? (unsigned)(ptab[sb * NPAGES + (s >> 7)] * PAGE + (s & (PAGE - 1))) : (0x80000000u | (unsigned)(s - PAST)); } }
    __syncthreads();
    const int n = *nsel < 512 ? *nsel : 512;
    const int kvh = wave & 1, prt = wave >> 1, half = lane >> 5, l32 = lane & 31;
    { f32x4 qv[4];
#pragma unroll
      for (int h = 0; h < 4; ++h) qv[h] = *(const LAS f32x4*)(qa + (4 * kvh + h) * 128 + 4 * l32);
      for (int j0 = 2 * prt; j0 < n; j0 += 32) { f32x4 kv[4]; int jj[4];
#pragma unroll
          for (int u = 0; u < 4; ++u) { jj[u] = j0 + 8 * u + half; const unsigned r = rid[jj[u] < n ? jj[u] : 0];
              const GAS float* kr = (r & 0x80000000u) ? out_ro + O_KS + ((size_t)(sb * NST + (r & 3u)) * NKV + kvh) * HD : ck + ((size_t)r * NKV + kvh) * HD;
              kv[u] = *(const GAS f32x4*)(kr + 4 * l32); }
#pragma unroll
          for (int u = 0; u < 4; ++u) { float d[4];
#pragma unroll
              for (int h = 0; h < 4; ++h) { d[h] = (kv[u][0] * qv[h][0] + kv[u][1] * qv[h][1]) + (kv[u][2] * qv[h][2] + kv[u][3] * qv[h][3]);
                  d[h] += __shfl_xor(d[h], 1); d[h] += __shfl_xor(d[h], 2); d[h] += __shfl_xor(d[h], 4); d[h] += __shfl_xor(d[h], 8); d[h] += __shfl_xor(d[h], 16); }
              if (jj[u] < n && l32 < 4) sc[(4 * kvh + l32) * 512 + jj[u]] = (l32 == 0 ? d[0] : l32 == 1 ? d[1] : l32 == 2 ? d[2] : d[3]) * 0.08838834764831845f; } } }
    __syncthreads();
    { LAS float* row = sc + wave * 512; float mx = -1e30f;
      for (int j = lane; j < n; j += 64) mx = fmaxf(mx, row[j]);
#pragma unroll
      for (int o = 1; o < 64; o <<= 1) mx = fmaxf(mx, __shfl_xor(mx, o));
      float sm = 0.f;
      for (int j = lane; j < n; j += 64) { const float e = __expf(row[j] - mx); row[j] = e; sm += e; }
      sm = wave_sum(sm); if (lane == 0) inv[wave] = 1.f / sm; }
    __syncthreads();
    { f32x4 acc[4] = {};
      for (int j0 = 2 * prt; j0 < n; j0 += 32) { f32x4 vv[4]; int jj[4];
#pragma unroll
          for (int u = 0; u < 4; ++u) { jj[u] = j0 + 8 * u + half; const unsigned r = rid[jj[u] < n ? jj[u] : 0];
              const GAS float* vr = (r & 0x80000000u) ? out_ro + O_VS + ((size_t)(sb * NST + (r & 3u)) * NKV + kvh) * HD : cv + ((size_t)r * NKV + kvh) * HD;
              vv[u] = *(const GAS f32x4*)(vr + 4 * l32); }
#pragma unroll
          for (int u = 0; u < 4; ++u)
#pragma unroll
              for (int h = 0; h < 4; ++h) { const float p = jj[u] < n ? sc[(4 * kvh + h) * 512 + jj[u]] : 0.f; acc[h] += vv[u] * p; } }
#pragma unroll
      for (int h = 0; h < 4; ++h) {
#pragma unroll
          for (int e = 0; e < 4; ++e) acc[h][e] += __shfl_xor(acc[h][e], 32);
          if (half == 0) *(LAS f32x4*)(part + (wave * 4 + h) * 128 + 4 * l32) = acc[h]; } }
    __syncthreads();
    { const GAS f16* SZ = (const GAS f16*)(a.ws + WS_SZ) + (size_t)(MP + qi) * 1024; GAS f16* MIX = (GAS f16*)(a.ws + WS_MIX) + (size_t)(MP + qi) * 2048;
      for (int i = tid; i < 1024; i += 512) { const int h = i >> 7, d = i & 127, kh = h >> 2, hl = h & 3; float o = 0.f;
#pragma unroll
          for (int p = 0; p < 4; ++p) o += part[((2 * p + kh) * 4 + hl) * 128 + d];
          MIX[i] = (f16)(o * inv[h] * (float)SZ[i]); } }
    __syncthreads();
}

__device__ __forceinline__ void p3_phase(const Args& a, LAS unsigned char* lds, int vcu, int G, int tid) {
    float gm = 0.f, km = 0.f;
    for (int i = 0; i < HD; ++i) { gm = fmaxf(gm, fabsf(a.in[9][i])); km = fmaxf(km, fabsf(a.in[10][i])); }
    const float sh2 = fmaxf(0.f, 11.313708498984761f * gm * km - 20.f) * 1.4426950408889634f;
    for (int sidx = G - 1 - vcu; sidx < MS; sidx += G) p3_sample_item(a, lds, sidx, tid);
    for (int k = vcu; k < 256; k += G) { const int i = 31 - (k >> 3), bk = k & 7;
        att::attn_block(a, lds, bk >> 1, bk & 1, 64 * i, sh2); }
}

typedef GAS unsigned gu32;
#define XB_TMO      128
#define XB_XCNT(j)  (256  + 64 * (j))
#define XB_XSUB(j)  (1280 + 64 * (j))
#define XB_XGEN(j)  (2304 + 64 * (j))
#define XB_TOP      3328
#define XB_TOPGEN   3392
#define XCD_BAR_WORDS 3456
#define XB_SPIN_CAP (1u << 18)
__device__ __forceinline__ unsigned xb_ld(unsigned* p)              { return __hip_atomic_load(p, __ATOMIC_RELAXED, __HIP_MEMORY_SCOPE_AGENT); }
__device__ __forceinline__ unsigned xb_add(unsigned* p, unsigned v) { return __hip_atomic_fetch_add(p, v, __ATOMIC_RELAXED, __HIP_MEMORY_SCOPE_AGENT); }
__device__ __forceinline__ unsigned xb_xcc_id() { return (unsigned)__builtin_amdgcn_s_getreg((3 << 11) | 20) & 0xFu; }
#define XB_SPIN(cond, bar) do { unsigned _sp = 0; while (cond) { __builtin_amdgcn_s_sleep(1); \
    if ((++_sp & 255u) == 0u) { if (xb_ld(&(bar)[XB_TMO])) break; if (_sp > XB_SPIN_CAP) { atomicAdd(&(bar)[XB_TMO], 1u); break; } } } } while (0)
struct XcdBarrier { unsigned* bar; unsigned x; volatile LAS unsigned* st; };
__device__ __forceinline__ XcdBarrier xcd_barrier_post(unsigned* bar, volatile LAS unsigned* st) {
    XcdBarrier b; b.bar = bar; b.x = xb_xcc_id(); b.st = st;
    if (threadIdx.x == 0) (void)xb_add(&bar[XB_XCNT(b.x)], 1u);
    return b;
}
__device__ __forceinline__ void xcd_barrier_complete(unsigned* bar, unsigned x, unsigned& nloc, unsigned& nx) {
    const unsigned G = gridDim.x * gridDim.y * gridDim.z;
    unsigned sum, cnt, mine, sp = 0u;
    for (;;) {
        sum = 0u; cnt = 0u; mine = 0u;
#pragma unroll
        for (unsigned j = 0; j < 16; ++j) { const unsigned c = xb_ld(&bar[XB_XCNT(j)]); sum += c; cnt += (c > 0u) ? 1u : 0u; mine = (j == x) ? c : mine; }
        if (sum == G) break;
        __builtin_amdgcn_s_sleep(1);
        if ((++sp & 255u) == 0u) { if (xb_ld(&bar[XB_TMO])) break; if (sp > XB_SPIN_CAP) { atomicAdd(&bar[XB_TMO], 1u); break; } }
    }
    nloc = mine > 0u ? mine : 1u; nx = cnt > 0u ? cnt : 1u;
}
__device__ __forceinline__ void xcd_barrier(const XcdBarrier& b) {
    asm volatile("s_waitcnt vmcnt(0)" ::: "memory");
    __syncthreads();
    if (threadIdx.x == 0) {
        unsigned* bar = b.bar;
        __builtin_amdgcn_s_waitcnt(0);
        unsigned nloc = b.st[0], nx = b.st[1];
        if (nloc == 0u) { xcd_barrier_complete(bar, b.x, nloc, nx); b.st[0] = nloc; b.st[1] = nx; }
        const unsigned old = xb_add(&bar[XB_XSUB(b.x)], 1u);
        const unsigned gen = old / nloc;
        if (old + 1u == (gen + 1u) * nloc) {
            __builtin_amdgcn_fence(__ATOMIC_RELEASE, "agent");
            asm volatile("s_waitcnt vmcnt(0)" ::: "memory");
            const unsigned og = xb_add(&bar[XB_TOP], 1u);
            const unsigned tg = og / nx;
            if (og + 1u == (tg + 1u) * nx) xb_add(&bar[XB_TOPGEN], 1u);
            else XB_SPIN(xb_ld(&bar[XB_TOPGEN]) == tg, bar);
            __builtin_amdgcn_fence(__ATOMIC_ACQUIRE, "agent");
            xb_add(&bar[XB_XGEN(b.x)], 1u);
            asm volatile("s_waitcnt vmcnt(0)" ::: "memory");
        } else {
            XB_SPIN(xb_ld(&bar[XB_XGEN(b.x)]) == gen, bar);
            __builtin_amdgcn_fence(__ATOMIC_ACQUIRE, "agent");
            asm volatile("s_waitcnt vmcnt(0)" ::: "memory");
        }
    }
    __syncthreads();
}

__global__ void __launch_bounds__(NWAVES * 64, 2) mk_fwd(Args a) {
    extern __shared__ __attribute__((aligned(16))) unsigned char lds_raw[];
    LAS unsigned char* lds = (LAS unsigned char*)lds_raw;
    const int tid = threadIdx.x, lane = tid & 63, wave = __builtin_amdgcn_readfirstlane(tid >> 6);
    const int G = gridDim.x; const int bx = blockIdx.x; const int vcu = (G % 8 == 0) ? (bx % 8) * (G / 8) + bx / 8 : bx;
    volatile LAS unsigned* MISC = (volatile LAS unsigned*)(lds + MISC_OFF);
    if (tid < 64) MISC[tid] = 0u;
    __syncthreads();
    XcdBarrier bar = xcd_barrier_post((unsigned*)a.ws, MISC + 8);
    { int t_ = threadIdx.x; asm volatile("" : "+v"(t_)); const int lane = t_ & 63, wave = __builtin_amdgcn_readfirstlane(t_ >> 6); p0_prologue(a, lds, vcu, G, wave, lane); }
    xcd_barrier(bar);
    { pg8::Gemm g{(const f16*)(a.ws + WS_XNH), (const f16*)(a.ws + WS_WINT), DM};
      pg8::StaticOrder S; S.init(MPAD / 256, NPAD / 256, G, bx);
      EpiIn E{a.out, a.ws, a.in[9], a.in[10], a.in[11], (LAS float*)(lds + SCR_OFF)};
      pg8::gemm_phase<EpiIn, pg8::StaticOrder>(lds, g, S, E); }
    xcd_barrier(bar);
    { int t_ = threadIdx.x; asm volatile("" : "+v"(t_)); const int lane = t_ & 63, wave = __builtin_amdgcn_readfirstlane(t_ >> 6); p2_phase(a, lds, vcu, G, wave, lane); }
    xcd_barrier(bar);
    { int t_ = threadIdx.x; asm volatile("" : "+v"(t_)); p3_phase(a, lds, vcu, G, t_); }
    xcd_barrier(bar);
    { pg8::Gemm g{(const f16*)(a.ws + WS_MIX), (const f16*)(a.ws + WS_WOUTT), DM};
      pg8::StaticOrder S; S.init(MP / 256, DM / 256, G, bx);
      EpiOut E{a.out, a.in[0]};
      pg8::gemm_phase<EpiOut, pg8::StaticOrder>(lds, g, S, E);
      int t_ = threadIdx.x; asm volatile("" : "+v"(t_)); p4_sample(a, lds, bx, G, t_); }
}

#ifndef PROG
#define PROG 0x11111u
#endif
extern "C" void kernel_launch(void* const* d_in, const int* in_sizes, int n_in, void* d_out, int out_size, void* d_ws, size_t ws_size, hipStream_t stream) {
    static int grid = 0;
    if (grid == 0) {
        if (ws_size < WS_NEED2 || out_size != (int)O_END || n_in != 14) { fprintf(stderr, "kernel_launch: ws %zu (need %zu) out %d (want %zu) n_in %d\n", ws_size, (size_t)WS_NEED2, out_size, (size_t)O_END, n_in); grid = -1; return; }
        int dev = 0, cus = 0; hipGetDevice(&dev); hipDeviceGetAttribute(&cus, hipDeviceAttributeMultiprocessorCount, dev);
        if (hipFuncSetAttribute((const void*)mk_fwd, hipFuncAttributeMaxDynamicSharedMemorySize, LDS_BYTES) != hipSuccess) { fprintf(stderr, "kernel_launch: hipFuncSetAttribute failed\n"); grid = -1; return; }
        int per_cu = 0; hipOccupancyMaxActiveBlocksPerMultiprocessor(&per_cu, (const void*)mk_fwd, NWAVES * 64, LDS_BYTES); (void)hipGetLastError();
        if (per_cu < 1) fprintf(stderr, "kernel_launch: occupancy query says %d blocks per CU\n", per_cu);
        grid = cus > 0 ? cus : 256;
    }
    if (grid < 0) return;
    float* out = (float*)d_out; unsigned char* ws = (unsigned char*)d_ws;
    Args a{};
    for (int i = 0; i < 14; ++i) a.in[i] = (const float*)d_in[i];
    a.out = out; a.ws = ws;
    if (hipMemsetAsync(ws, 0, 65536, stream) != hipSuccess) { fprintf(stderr, "kernel_launch: memset of the control words failed\n"); return; }
    a.ph_lo = (int)PROG; a.ph_hi = 0; hipLaunchKernelGGL(mk_fwd, dim3(grid), dim3(NWAVES * 64), LDS_BYTES, stream, a);
}
```

```cpp
#include <hip/hip_runtime.h>
#include <cstdio>
#include <cstdint>
#include <cmath>

typedef _Float16 f16;
typedef unsigned short bf16_t;

constexpr int DM = 2048, NB = 4, S = 2048, NSB = 8, NST = 4, PAST = 16384, PAGE = 128, NPAGES = PAST / PAGE;
constexpr int MP = NB * S;
constexpr int MS = NSB * NST;
constexpr int MT = MP + MS;
constexpr int DIN = 7760;
constexpr int OQ = 0, OKK = 1024, OV = 1280, OZ = 1536, OQI = 2560, OKI = 3584, OWI = 3648, OH = 3664, OBB = 4688, OC = 5712, OZC = 6736;
constexpr int NH = 8, NKV = 2, HD = 128, NIH = 16, ID = 64, TOPK = 256, DC = 1024;
constexpr float EPS = 1e-6f;
constexpr size_t O_YP = 0, O_YS = 16777216, O_KP = 16842752, O_VP = 18939904, O_KIP = 21037056, O_CVP = 21561344,
                 O_KS = 21569536, O_VS = 21577728, O_KIS = 21585920, O_CVS = 21587968, O_END = 21604352;
constexpr size_t MiB = 1u << 20;
constexpr size_t WS_ROPE = 1 * MiB;
constexpr size_t WS_ROPE_I = WS_ROPE + 2052 * 32 * 4;
constexpr size_t WS_QB = 2 * MiB;
constexpr size_t WS_KB = 18 * MiB;
constexpr size_t WS_VB = 22 * MiB;
constexpr size_t WS_SZ = 26 * MiB;
constexpr size_t WS_QI = 43 * MiB;
constexpr size_t WS_KI = 60 * MiB;
constexpr size_t WS_WI = 61 * MiB;
constexpr size_t WS_U = 62 * MiB;
constexpr size_t WS_G = 79 * MiB;
constexpr size_t WS_MIX = 96 * MiB;
constexpr size_t WS_MASK = 130 * MiB;
constexpr size_t WS_SSC = 132 * MiB;
constexpr size_t WS_QS = 134 * MiB;
constexpr size_t WS_XN = 136 * MiB;
constexpr size_t WS_P = 202 * MiB;
constexpr size_t WS_NEED = 448 * MiB;

__device__ __forceinline__ bf16_t f2bf(float f) { unsigned u = __builtin_bit_cast(unsigned, f); return (bf16_t)((u + 0x7fffu + ((u >> 16) & 1u)) >> 16); }
__device__ __forceinline__ float bf2f(bf16_t h) { return __builtin_bit_cast(float, (unsigned)h << 16); }
__device__ __forceinline__ float silu(float z) { return z / (1.f + __expf(-z)); }
__device__ __forceinline__ unsigned fkey(float f) { unsigned u = __builtin_bit_cast(unsigned, f); return (u & 0x80000000u) ? ~u : (u | 0x80000000u); }

#define LAS __attribute__((address_space(3)))
#define GAS __attribute__((address_space(1)))
typedef _Float16 f16x8 __attribute__((ext_vector_type(8)));
typedef _Float16 f16x4 __attribute__((ext_vector_type(4)));
typedef _Float16 f16x2 __attribute__((ext_vector_type(2)));
typedef float f32x4 __attribute__((ext_vector_type(4)));
typedef float f32x2 __attribute__((ext_vector_type(2)));
typedef unsigned u32x4 __attribute__((ext_vector_type(4)));
typedef unsigned u32x2 __attribute__((ext_vector_type(2)));
typedef __bf16 bf16x2_t __attribute__((ext_vector_type(2)));
namespace pg8 {
constexpr int BM = 256, BK = 64, HALF = 128, HTB = HALF * BK * 2, STAGE_BYTES = 8 * HTB, NXCD = 8, WGM = 8;
__host__ __device__ __forceinline__ int lds_byte(int r, int c) { const int st = (r >> 4) * 2 + (c >> 5), rr = r & 15, cc = c & 31, ob = rr * 64 + cc * 2; return st * 1024 + (ob ^ (((ob >> 9) & 1) << 5)); }
__host__ __device__ __forceinline__ void stage_rc(int b, int& R, int& C) { const int st = b / 1024, sb = b % 1024, swz = sb ^ (((sb >> 9) & 1) << 5); R = (st >> 1) * 16 + swz / 64; C = (st & 1) * 32 + (swz % 64) / 2; }
struct Unit { int pm, pn; };
struct Gemm { const f16* A; const f16* Bt; int K; };
struct StaticOrder {
    int nM, nN, nwg, G, c;
    __device__ void init(int nM_, int nN_, int G_, int c_) { nM = nM_; nN = nN_; nwg = nM * nN; G = G_; c = c_; }
    __device__ bool next(int i, Unit& u) const {
        const long L = (long)i * G + c; if (L >= nwg) return false;
        int wgid = (int)L; { const int q = nwg / NXCD, r = nwg % NXCD, xcd = wgid % NXCD, off = wgid / NXCD; wgid = (xcd < r ? xcd * (q + 1) : r * (q + 1) + (xcd - r) * q) + off; }
        const int nig = WGM * nN, gid = wgid / nig, fm = gid * WGM, gsz = (nM - fm) < WGM ? (nM - fm) : WGM;
        u.pm = fm + ((wgid % nig) % gsz); u.pn = (wgid % nig) / gsz; return true;
    }
};
template <class Epi, class Sched>
__device__ __forceinline__ void gemm_phase(LAS unsigned char* lds, const Gemm g, const Sched& S, const Epi& E) {
    int tid_ = threadIdx.x; asm volatile("" : "+v"(tid_));
    const int tid = tid_, wid = __builtin_amdgcn_readfirstlane(tid >> 6), lane = tid & 63, wr = wid >> 2, wc = wid & 3, fr = lane & 15, fq = lane >> 4;
    const int K = g.K, nt = K / BK;
    unsigned voffA[2];
#pragma unroll
    for (int i = 0; i < 2; ++i) { int R, C; stage_rc(tid * 16 + i * 8192, R, C); voffA[i] = (unsigned)(R * K + C) * 2u; }
    const size_t kstep = (size_t)(BK * 2);
    const size_t hstep = (size_t)HALF * K * 2;
    const size_t tstep = 2 * hstep;
    const unsigned ldsw = (unsigned)wid * 1024u;
    const int aoff = lds_byte(wr * 64 + fr, fq * 8), boff = lds_byte(wc * 32 + fr, fq * 8);
#define PG8_SA(b, h) (((b) * 2 + (h)) * HTB)
#define PG8_SB(b, h) ((4 + (b) * 2 + (h)) * HTB)
#define PG8_STAGE(bufoff, gbase) do { _Pragma("unroll") for (int _i = 0; _i < 2; ++_i) \
        __builtin_amdgcn_global_load_lds((const unsigned*)((const char*)(gbase) + voffA[_i]), (LAS unsigned*)(lds + (bufoff) + ldsw + _i * 8192), 16, 0, 0); } while (0)
#define PG8_LDA(dst, b, h) do { _Pragma("unroll") for (int m = 0; m < 4; ++m) _Pragma("unroll") for (int k = 0; k < 2; ++k) dst[m][k] = *(const LAS f16x8*)(lds + PG8_SA(b, h) + aoff + m * 2048 + k * 1024); } while (0)
#define PG8_LDB(dst, b, h) do { _Pragma("unroll") for (int n = 0; n < 2; ++n) _Pragma("unroll") for (int k = 0; k < 2; ++k) dst[n][k] = *(const LAS f16x8*)(lds + PG8_SB(b, h) + boff + n * 2048 + k * 1024); } while (0)
#define PG8_MMA(ai, bj, At, Bt) do { __builtin_amdgcn_s_setprio(1); _Pragma("unroll") for (int m = 0; m < 4; ++m) _Pragma("unroll") for (int n = 0; n < 2; ++n) _Pragma("unroll") for (int k = 0; k < 2; ++k) \
        acc[ai][bj][m][n] = __builtin_amdgcn_mfma_f32_16x16x32_f16(Bt[n][k], At[m][k], acc[ai][bj][m][n], 0, 0, 0); __builtin_amdgcn_s_setprio(0); } while (0)
#define PG8_WAIT_V(n) asm volatile("s_waitcnt vmcnt(" #n ")" ::: "memory")
#define PG8_WAIT_L(n) asm volatile("s_waitcnt lgkmcnt(" #n ")" ::: "memory")
#define PG8_BAR __builtin_amdgcn_s_barrier()
#define PG8_SCHED __builtin_amdgcn_sched_barrier(0)
    Unit cur, nxt; int ui = 0;
    if (!S.next(0, cur)) return;
    f32x4 acc[2][2][4][2];
    E.init(acc, cur, wr, wc, fr, fq);
    f16x8 At[4][2], B0[2][2], B1[2][2];
    const char* cA = (const char*)g.A + (size_t)cur.pm * tstep; const char* cB = (const char*)g.Bt + (size_t)cur.pn * tstep;
    PG8_STAGE(PG8_SB(0, 0), cB); PG8_STAGE(PG8_SB(0, 1), cB + hstep); PG8_STAGE(PG8_SA(0, 0), cA); PG8_STAGE(PG8_SA(0, 1), cA + hstep);
    if (wr == 1) PG8_BAR;
    PG8_WAIT_V(2); PG8_BAR;
    PG8_STAGE(PG8_SB(1, 0), cB + kstep); PG8_STAGE(PG8_SA(1, 0), cA + kstep); PG8_STAGE(PG8_SB(1, 1), cB + hstep + kstep);
    PG8_WAIT_V(6); PG8_BAR;
    for (;;) {
        const bool has_next = S.next(ui + 1, nxt);
        const char* nA = has_next ? (const char*)g.A + (size_t)nxt.pm * tstep : cA; const char* nB = has_next ? (const char*)g.Bt + (size_t)nxt.pn * tstep : cB;
        for (int t = 0; t < nt; t += 2) {
            const bool last = (t == nt - 2);
            const char* a1 = cA + (size_t)(t + 1) * kstep;
            const char* a2 = last ? nA : cA + (size_t)(t + 2) * kstep; const char* b2 = last ? nB : cB + (size_t)(t + 2) * kstep;
            const char* a3 = a2 + kstep; const char* b3 = b2 + kstep;
            PG8_LDB(B0, 0, 0); PG8_LDB(B1, 0, 1); PG8_SCHED; PG8_LDA(At, 0, 0); PG8_STAGE(PG8_SA(1, 1), a1 + hstep);
            PG8_WAIT_V(8); PG8_WAIT_L(0); PG8_BAR; PG8_MMA(0, 0, At, B0); PG8_MMA(0, 1, At, B1); PG8_BAR; PG8_SCHED;
            PG8_LDA(At, 0, 1); PG8_STAGE(PG8_SB(0, 0), b2); PG8_STAGE(PG8_SB(0, 1), b2 + hstep); PG8_STAGE(PG8_SA(0, 0), a2);
            PG8_WAIT_V(8); PG8_WAIT_L(0); PG8_BAR; PG8_MMA(1, 0, At, B0); PG8_MMA(1, 1, At, B1); PG8_BAR; PG8_SCHED;
            PG8_LDB(B0, 1, 0); PG8_LDB(B1, 1, 1); PG8_SCHED; PG8_LDA(At, 1, 0); PG8_STAGE(PG8_SA(0, 1), a2 + hstep);
            PG8_WAIT_V(8); PG8_WAIT_L(0); PG8_BAR; PG8_MMA(0, 0, At, B0); PG8_MMA(0, 1, At, B1); PG8_BAR; PG8_SCHED;
            PG8_LDA(At, 1, 1); PG8_STAGE(PG8_SB(1, 0), b3); PG8_STAGE(PG8_SB(1, 1), b3 + hstep); PG8_STAGE(PG8_SA(1, 0), a3);
            PG8_WAIT_V(8); PG8_WAIT_L(0); PG8_BAR; PG8_MMA(1, 0, At, B0); PG8_MMA(1, 1, At, B1); PG8_BAR; PG8_SCHED;
        }
        if (wr == 0) PG8_BAR;
        E(acc, cur, wr, wc, fr, fq);
        if (!has_next) break;
        cur = nxt; cA = nA; cB = nB; ++ui;
        E.init(acc, cur, wr, wc, fr, fq);
        if (wr == 1) PG8_BAR;
    }
    PG8_WAIT_V(0);
    PG8_BAR;
#undef PG8_SA
#undef PG8_SB
#undef PG8_STAGE
#undef PG8_LDA
#undef PG8_LDB
#undef PG8_MMA
#undef PG8_WAIT_V
#undef PG8_WAIT_L
#undef PG8_BAR
#undef PG8_SCHED
}
}
constexpr int NWAVES = 8;
constexpr int MPAD = 8448, NPAD = 7936;
constexpr size_t WS_XNH = 450 * MiB;
constexpr size_t WS_WINT = 484 * MiB;
constexpr size_t WS_WOUTT = 516 * MiB;
constexpr size_t WS_NEED2 = 524 * MiB;
constexpr int RING_BYTES = 131072, SCR_OFF = RING_BYTES, SCR_BYTES = 8192, MISC_OFF = 145408, LDS_BYTES = 147456;

__device__ __forceinline__ unsigned pk_bf16(float lo, float hi) { f32x2 v = {lo, hi}; bf16x2_t b = __builtin_convertvector(v, bf16x2_t); return __builtin_bit_cast(unsigned, b); }
__device__ __forceinline__ unsigned pk_f16(float lo, float hi) { f32x2 v = {lo, hi}; f16x2 b = __builtin_convertvector(v, f16x2); return __builtin_bit_cast(unsigned, b); }

struct Args { const float* in[14]; float* out; unsigned char* ws; int ph_lo, ph_hi; };

__device__ __forceinline__ int win_src(int np) {
    const int pn = np >> 8, c = np & 255;
    if (pn < 14) return np;
    if (pn == 14) return c < 80 ? np : -1;
    const int T = pn - 15, bj = c >> 7, wc = (c >> 5) & 3, n = (c >> 4) & 1, fqi = c & 15;
    const int base = bj == 0 ? (n == 0 ? OH : OBB) : (n == 0 ? OC : OZC);
    return base + 64 * T + 16 * wc + fqi;
}
template <bool MAP>
__device__ __forceinline__ void p0_transpose_item(const float* W, int N, f16* WT, LAS float* scr, int item, int nblk, int lane) {
    const int kb = item / nblk, nb = item % nblk, k0 = 64 * kb, n0 = 32 * nb;
    const int src = MAP ? win_src(n0 + (lane & 31)) : n0 + (lane & 31);
#pragma unroll 8
    for (int i = 0; i < 32; ++i) { const int kk = 2 * i + (lane >> 5); scr[kk * 33 + (lane & 31)] = src >= 0 ? W[(size_t)(k0 + kk) * N + src] : 0.f; }
    asm volatile("s_waitcnt lgkmcnt(0)" ::: "memory");
    const int c = lane & 7;
#pragma unroll
    for (int j = 0; j < 4; ++j) { const int n = (lane >> 3) + 8 * j; const LAS float* s = scr + (8 * c) * 33 + n;
        u32x4 o; o.x = pk_f16(s[0 * 33], s[1 * 33]); o.y = pk_f16(s[2 * 33], s[3 * 33]); o.z = pk_f16(s[4 * 33], s[5 * 33]); o.w = pk_f16(s[6 * 33], s[7 * 33]);
        *(u32x4*)(WT + (size_t)(n0 + n) * 2048 + k0 + 8 * c) = o; }
    asm volatile("s_waitcnt lgkmcnt(0)" ::: "memory");
}
__device__ __forceinline__ float wave_sum(float v) {
#pragma unroll
    for (int o = 1; o < 64; o <<= 1) v += __shfl_xor(v, o);
    return v;
}
__device__ __forceinline__ void p0_prologue(const Args& a, LAS unsigned char* lds, int vcu, int G, int wave, int lane) {
    LAS float* scr = (LAS float*)(lds + wave * 16384);
    const int gw = vcu * NWAVES + wave, NGW = G * NWAVES;
    const float* win = a.in[8]; const float* wout = a.in[13];
    f16* WinT = (f16*)(a.ws + WS_WINT); f16* WoutT = (f16*)(a.ws + WS_WOUTT); f16* XN = (f16*)(a.ws + WS_XNH);
    constexpr int I_IN = 32 * (NPAD / 32), I_OUT = 32 * (DM / 32);
    for (int it = gw; it < I_IN + I_OUT; it += NGW) {
        if (it < I_IN) p0_transpose_item<true>(win, DIN, WinT, scr, it, NPAD / 32, lane);
        else p0_transpose_item<false>(wout, DM, WoutT, scr, it - I_IN, DM / 32, lane);
    }
    const float* gin = a.in[7];
    for (int m = gw; m < MT; m += NGW) {
        const float* xrow = m < MP ? a.in[0] + (size_t)m * DM : a.in[1] + (size_t)(m - MP) * DM;
        const f32x4* xr = (const f32x4*)xrow + lane; f32x4 v[8]; float s = 0.f;
#pragma unroll
        for (int j = 0; j < 8; ++j) { v[j] = xr[64 * j]; s += (v[j].x * v[j].x + v[j].y * v[j].y) + (v[j].z * v[j].z + v[j].w * v[j].w); }
        const float rs = rsqrtf(wave_sum(s) * (1.f / DM) + EPS);
        u32x2* o8 = (u32x2*)(XN + (size_t)m * DM) + lane;
#pragma unroll
        for (int j = 0; j < 8; ++j) { const f32x4 gv = ((const f32x4*)gin)[lane + 64 * j]; u32x2 w; w.x = pk_f16(v[j].x * rs * gv.x, v[j].y * rs * gv.y); w.y = pk_f16(v[j].z * rs * gv.z, v[j].w * rs * gv.w); o8[64 * j] = w; }
    }
    float* rqk = (float*)(a.ws + WS_ROPE); float* ri = (float*)(a.ws + WS_ROPE_I);
    for (int i = gw * 64 + lane; i < 2052 * 16; i += NGW * 64) {
        { int slot = i / 16, j = i % 16; int pos = slot < 2048 ? slot : PAST + (slot - 2048);
          float inv = (float)pow(500000.0, -(double)j / 16.0); float ang = (float)pos * inv;
          rqk[(slot * 16 + j) * 2] = (float)cos((double)ang); rqk[(slot * 16 + j) * 2 + 1] = (float)sin((double)ang); }
        if (i < 2052 * 8) { int slot = i / 8, j = i % 8; int pos = slot < 2048 ? slot : PAST + (slot - 2048);
          float inv = (float)pow(500000.0, -(double)j / 8.0); float ang = (float)pos * inv;
          ri[(slot * 8 + j) * 2] = (float)cos((double)ang); ri[(slot * 8 + j) * 2 + 1] = (float)sin((double)ang); }
    }
}

struct EpiIn {
    float* out; unsigned char* ws; const float* gq; const float* gk; const float* gki; LAS float* scr;
    __device__ __forceinline__ void init(f32x4 (&acc)[2][2][4][2], const pg8::Unit&, int, int, int, int) const {
#pragma unroll
        for (int a = 0; a < 2; ++a)
#pragma unroll
            for (int b = 0; b < 2; ++b)
#pragma unroll
                for (int m = 0; m < 4; ++m)
#pragma unroll
                    for (int n = 0; n < 2; ++n) acc[a][b][m][n] = (f32x4){0.f, 0.f, 0.f, 0.f};
    }
    __device__ __forceinline__ void operator()(f32x4 (&acc)[2][2][4][2], const pg8::Unit& u, int wr, int wc, int fr_, int fq_) const {
        int fr = fr_, fq = fq_; asm volatile("" : "+v"(fr), "+v"(fq));
        GAS unsigned char* ws = (GAS unsigned char*)this->ws; GAS float* out = (GAS float*)this->out; asm volatile("" : "+s"(ws), "+s"(out));
        const int pn = u.pn, pm = u.pm; const bool smp = pm == 32;
        const int rbase = 64 * wr + fr;
        const int bb = pm >> 3, t0 = (pm & 7) << 8;
        const GAS float* rqk = (const GAS float*)(ws + WS_ROPE); const GAS float* ri = (const GAS float*)(ws + WS_ROPE_I);
#define ROWLOOP _Pragma("unroll") for (int ai = 0; ai < 2; ++ai) _Pragma("unroll") for (int m = 0; m < 4; ++m)
#define ROWVARS const int r = rbase + 128 * ai + 16 * m; const bool valid = !smp || r < MS; const int grow = smp ? MP + r : pm * 256 + r; const int tt = smp ? (r & 3) : t0 + r; const int slot = smp ? 2048 + (r & 3) : tt; (void)grow; (void)tt; (void)slot; (void)valid;
        if (pn <= 4 || pn == 14) {
            const bool isk = pn == 14;
            ROWLOOP { asm volatile("" ::: "memory"); const int r = rbase + 128 * ai + 16 * m;
#pragma unroll
                for (int bj = 0; bj < 2; ++bj) { float s = 0.f;
#pragma unroll
                    for (int n = 0; n < 2; ++n) { const f32x4 x = acc[ai][bj][m][n]; s += (x[0] * x[0] + x[1] * x[1]) + (x[2] * x[2] + x[3] * x[3]); }
                    if (isk && (wc >= 2 || bj == 1)) s = 0.f;
                    s += __shfl_xor(s, 16); s += __shfl_xor(s, 32);
                    if (fq == 0) scr[(r * 2 + bj) * 4 + wc] = s; } }
            asm volatile("s_waitcnt lgkmcnt(0)" ::: "memory"); __builtin_amdgcn_s_barrier(); asm volatile("" ::: "memory");
            if (!isk) {
                const GAS float* g = (const GAS float*)(pn < 4 ? gq : gk); const int dl = 32 * wc + 4 * fq;
                const f32x4 g0 = *(const GAS f32x4*)(g + dl), g1 = *(const GAS f32x4*)(g + dl + 16);
                GAS bf16_t* Qb = (GAS bf16_t*)(ws + WS_QB); GAS bf16_t* Kb = (GAS bf16_t*)(ws + WS_KB); GAS float* QS = (GAS float*)(ws + WS_QS);
                ROWLOOP { asm volatile("" ::: "memory"); ROWVARS
                    f32x4 cs0 = {1.f, 0.f, 1.f, 0.f}, cs1 = {1.f, 0.f, 1.f, 0.f};
                    if (wc == 0) { const GAS f32x4* cp = (const GAS f32x4*)(rqk + (slot * 16 + 4 * fq) * 2); cs0 = cp[0]; cs1 = cp[1]; }
#pragma unroll
                    for (int bj = 0; bj < 2; ++bj) {
                        const f32x4 p = *(const LAS f32x4*)(scr + (r * 2 + bj) * 4);
                        const float rs = rsqrtf(((p[0] + p[1]) + (p[2] + p[3])) * (1.f / 128.f) + EPS);
                        f32x4 x0 = acc[ai][bj][m][0] * rs * g0, x1 = acc[ai][bj][m][1] * rs * g1;
                        if (wc == 0) { const f32x4 c = {cs0[0], cs0[2], cs1[0], cs1[2]}, s = {cs0[1], cs0[3], cs1[1], cs1[3]};
                            const f32x4 y0 = x0 * c - x1 * s, y1 = x1 * c + x0 * s; x0 = y0; x1 = y1; }
                        const int hh = 2 * pn + bj;
                        if (pn < 4) {
                            if (smp) { if (valid) { GAS float* q = QS + (size_t)r * 1024 + hh * 128 + dl; *(GAS f32x4*)q = x0; *(GAS f32x4*)(q + 16) = x1; } }
                            else { GAS bf16_t* q = Qb + (((size_t)bb * NH + hh) * S + tt) * HD + dl;
                                u32x2 w0 = {pk_bf16(x0[0], x0[1]), pk_bf16(x0[2], x0[3])}, w1 = {pk_bf16(x1[0], x1[1]), pk_bf16(x1[2], x1[3])};
                                *(GAS u32x2*)q = w0; *(GAS u32x2*)(q + 16) = w1; }
                        } else {
                            if (smp) { if (valid) { GAS float* k = out + O_KS + (size_t)r * 256 + bj * 128 + dl; *(GAS f32x4*)k = x0; *(GAS f32x4*)(k + 16) = x1; } }
                            else { GAS float* k = out + O_KP + (size_t)grow * 256 + bj * 128 + dl; *(GAS f32x4*)k = x0; *(GAS f32x4*)(k + 16) = x1;
                                GAS bf16_t* kb = Kb + (((size_t)bb * NKV + bj) * S + tt) * HD + dl;
                                u32x2 w0 = {pk_bf16(x0[0], x0[1]), pk_bf16(x0[2], x0[3])}, w1 = {pk_bf16(x1[0], x1[1]), pk_bf16(x1[2], x1[3])};
                                *(GAS u32x2*)kb = w0; *(GAS u32x2*)(kb + 16) = w1; }
                        } } }
            } else {
                const int dl = 32 * (wc & 1) + 4 * fq;
                const f32x4 g0 = *(const GAS f32x4*)((const GAS float*)gki + dl), g1 = *(const GAS f32x4*)((const GAS float*)gki + dl + 16);
                GAS f16* KI = (GAS f16*)(ws + WS_KI); GAS float* WI = (GAS float*)(ws + WS_WI);
                ROWLOOP { asm volatile("" ::: "memory"); ROWVARS
                    const f32x4 p = *(const LAS f32x4*)(scr + (r * 2) * 4);
                    const float rs = rsqrtf((p[0] + p[1]) * (1.f / 64.f) + EPS);
                    f32x4 x0 = acc[ai][0][m][0] * rs * g0, x1 = acc[ai][0][m][1] * rs * g1;
                    f32x4 xo; xo[0] = __shfl_xor(x0[0], 32); xo[1] = __shfl_xor(x0[1], 32); xo[2] = __shfl_xor(x0[2], 32); xo[3] = __shfl_xor(x0[3], 32);
                    if (wc == 0) { const GAS f32x4* cp = (const GAS f32x4*)(ri + (slot * 8 + 4 * (fq & 1)) * 2); const f32x4 cs0 = cp[0], cs1 = cp[1];
                        const f32x4 c = {cs0[0], cs0[2], cs1[0], cs1[2]}, s = {cs0[1], cs0[3], cs1[1], cs1[3]};
                        x0 = fq < 2 ? x0 * c - xo * s : x0 * c + xo * s; }
                    if (wc < 2 && valid) {
                        GAS float* ko = smp ? out + O_KIS + (size_t)r * 64 + dl : out + O_KIP + (size_t)grow * 64 + dl;
                        *(GAS f32x4*)ko = x0; *(GAS f32x4*)(ko + 16) = x1;
                        if (!smp) { GAS f16* kh = KI + (size_t)grow * 64 + dl; u32x2 w0 = {pk_f16(x0[0], x0[1]), pk_f16(x0[2], x0[3])}, w1 = {pk_f16(x1[0], x1[1]), pk_f16(x1[2], x1[3])};
                            *(GAS u32x2*)kh = w0; *(GAS u32x2*)(kh + 16) = w1; } }
                    if (wc == 2 && valid) *(GAS f32x4*)(WI + (size_t)grow * 16 + 4 * fq) = acc[ai][0][m][0] * (1.f / 32.f);
                }
            }
        } else if (pn == 5) {
            GAS bf16_t* Vb = (GAS bf16_t*)(ws + WS_VB); const int dl = 32 * wc + 4 * fq;
            ROWLOOP { asm volatile("" ::: "memory"); ROWVARS
#pragma unroll
                for (int bj = 0; bj < 2; ++bj) { const f32x4 x0 = acc[ai][bj][m][0], x1 = acc[ai][bj][m][1];
                    if (smp) { if (valid) { GAS float* v = out + O_VS + (size_t)r * 256 + bj * 128 + dl; *(GAS f32x4*)v = x0; *(GAS f32x4*)(v + 16) = x1; } }
                    else { GAS float* v = out + O_VP + (size_t)grow * 256 + bj * 128 + dl; *(GAS f32x4*)v = x0; *(GAS f32x4*)(v + 16) = x1;
                        GAS bf16_t* vb = Vb + (((size_t)bb * NKV + bj) * S + tt) * HD + dl;
                        u32x2 w0 = {pk_bf16(x0[0], x0[1]), pk_bf16(x0[2], x0[3])}, w1 = {pk_bf16(x1[0], x1[1]), pk_bf16(x1[2], x1[3])};
                        *(GAS u32x2*)vb = w0; *(GAS u32x2*)(vb + 16) = w1; } } }
        } else if (pn <= 9) {
            GAS f16* SZ = (GAS f16*)(ws + WS_SZ); const int c0 = 256 * (pn - 6) + 32 * wc + 4 * fq;
            ROWLOOP { asm volatile("" ::: "memory"); ROWVARS
                if (valid) {
#pragma unroll
                    for (int bj = 0; bj < 2; ++bj)
#pragma unroll
                        for (int n = 0; n < 2; ++n) { const f32x4 x = acc[ai][bj][m][n]; u32x2 w = {pk_f16(silu(x[0]), silu(x[1])), pk_f16(silu(x[2]), silu(x[3]))};
                            *(GAS u32x2*)(SZ + (size_t)grow * 1024 + c0 + 128 * bj + 16 * n) = w; } } }
        } else if (pn <= 13) {
            GAS f16* QI = (GAS f16*)(ws + WS_QI); const int c0 = 256 * (pn - 10) + 32 * wc + 4 * fq;
            ROWLOOP { asm volatile("" ::: "memory"); ROWVARS
                f32x4 c = {1.f, 1.f, 1.f, 1.f}, s = {0.f, 0.f, 0.f, 0.f};
                if ((wc & 1) == 0) { const GAS f32x4* cp = (const GAS f32x4*)(ri + (slot * 8 + 4 * (fq & 1)) * 2); const f32x4 cs0 = cp[0], cs1 = cp[1];
                    c = (f32x4){cs0[0], cs0[2], cs1[0], cs1[2]}; s = (f32x4){cs0[1], cs0[3], cs1[1], cs1[3]}; }
#pragma unroll
                for (int bj = 0; bj < 2; ++bj) { f32x4 x0 = acc[ai][bj][m][0]; const f32x4 x1 = acc[ai][bj][m][1];
                    f32x4 xo; xo[0] = __shfl_xor(x0[0], 32); xo[1] = __shfl_xor(x0[1], 32); xo[2] = __shfl_xor(x0[2], 32); xo[3] = __shfl_xor(x0[3], 32);
                    if ((wc & 1) == 0) x0 = fq < 2 ? x0 * c - xo * s : x0 * c + xo * s;
                    if (valid) { GAS f16* q = QI + (size_t)grow * 1024 + c0 + 128 * bj;
                        u32x2 w0 = {pk_f16(x0[0], x0[1]), pk_f16(x0[2], x0[3])}, w1 = {pk_f16(x1[0], x1[1]), pk_f16(x1[2], x1[3])};
                        *(GAS u32x2*)q = w0; *(GAS u32x2*)(q + 16) = w1; } } }
        } else {
            GAS f16* U = (GAS f16*)(ws + WS_U); GAS f16* G = (GAS f16*)(ws + WS_G); const int ch = 64 * (pn - 15) + 16 * wc + 4 * fq;
            ROWLOOP { asm volatile("" ::: "memory"); ROWVARS
                const f32x4 h = acc[ai][0][m][0], b = acc[ai][0][m][1], c = acc[ai][1][m][0], z = acc[ai][1][m][1];
                const f32x4 uu = c * h; f32x4 gg; gg[0] = b[0] * silu(z[0]); gg[1] = b[1] * silu(z[1]); gg[2] = b[2] * silu(z[2]); gg[3] = b[3] * silu(z[3]);
                if (valid) { u32x2 wu = {pk_f16(uu[0], uu[1]), pk_f16(uu[2], uu[3])}, wg = {pk_f16(gg[0], gg[1]), pk_f16(gg[2], gg[3])};
                    *(GAS u32x2*)(U + (size_t)grow * 1024 + ch) = wu; *(GAS u32x2*)(G + (size_t)grow * 1024 + ch) = wg;
                    if (!smp && tt >= S - 2) *(GAS f32x4*)(out + O_CVP + ((size_t)bb * 2 + (tt - (S - 2))) * 1024 + ch) = uu;
                    if (smp && tt >= 2) *(GAS f32x4*)(out + O_CVS + ((size_t)(r >> 2) * 2 + (tt - 2)) * 1024 + ch) = uu; } }
        }
#undef ROWLOOP
#undef ROWVARS
    }
};


struct EpiOut {
    float* out; const float* xp;
    __device__ __forceinline__ void init(f32x4 (&acc)[2][2][4][2], const pg8::Unit& u, int wr, int wc, int fr, int fq) const {
        const GAS float* xp = (const GAS float*)this->xp;
        const size_t base = (size_t)(u.pm * 256 + 64 * wr + fr) * DM + u.pn * 256 + 32 * wc + 4 * fq;
#pragma unroll
        for (int ai = 0; ai < 2; ++ai)
#pragma unroll
            for (int m = 0; m < 4; ++m)
#pragma unroll
                for (int bj = 0; bj < 2; ++bj)
#pragma unroll
                    for (int n = 0; n < 2; ++n) acc[ai][bj][m][n] = *(const GAS f32x4*)(xp + base + (size_t)(128 * ai + 16 * m) * DM + 128 * bj + 16 * n);
    }
    __device__ __forceinline__ void operator()(f32x4 (&acc)[2][2][4][2], const pg8::Unit& u, int wr, int wc, int fr_, int fq_) const {
        int fr = fr_, fq = fq_; asm volatile("" : "+v"(fr), "+v"(fq));
        GAS float* out = (GAS float*)this->out; asm volatile("" : "+s"(out));
        const size_t base = (size_t)(u.pm * 256 + 64 * wr + fr) * DM + u.pn * 256 + 32 * wc + 4 * fq;
#pragma unroll
        for (int ai = 0; ai < 2; ++ai)
#pragma unroll
            for (int m = 0; m < 4; ++m) { const size_t off = base + (size_t)(128 * ai + 16 * m) * DM;
#pragma unroll
                for (int bj = 0; bj < 2; ++bj)
#pragma unroll
                    for (int n = 0; n < 2; ++n) *(GAS f32x4*)(out + off + 128 * bj + 16 * n) = acc[ai][bj][m][n]; }
    }
};
__device__ __forceinline__ void p4_sample(const Args& a, LAS unsigned char* lds, int bx, int G, int tid) {
    const GAS f16* MIX = (const GAS f16*)(a.ws + WS_MIX) + (size_t)MP * DM; const GAS f16* WT = (const GAS f16*)(a.ws + WS_WOUTT);
    LAS float* part = (LAS float*)lds;
    const int lane = tid & 63, wave = __builtin_amdgcn_readfirstlane(tid >> 6), fr = lane & 15, fq = lane >> 4;
    for (int cg = bx; cg < DM / 8; cg += G) {
        const GAS f16* wp = WT + (size_t)(cg * 8 + (fr & 7)) * DM + wave * 256 + 8 * fq; const GAS f16* mp = MIX + (size_t)fr * DM + wave * 256 + 8 * fq;
        f16x8 wf[8], m0[8], m1[8];
#pragma unroll
        for (int ks = 0; ks < 8; ++ks) { wf[ks] = *(const GAS f16x8*)(wp + 32 * ks); m0[ks] = *(const GAS f16x8*)(mp + 32 * ks); m1[ks] = *(const GAS f16x8*)(mp + (size_t)16 * DM + 32 * ks); }
        f32x4 c0 = {0.f, 0.f, 0.f, 0.f}, c1 = {0.f, 0.f, 0.f, 0.f};
#pragma unroll
        for (int ks = 0; ks < 8; ++ks) { c0 = __builtin_amdgcn_mfma_f32_16x16x32_f16(wf[ks], m0[ks], c0, 0, 0, 0); c1 = __builtin_amdgcn_mfma_f32_16x16x32_f16(wf[ks], m1[ks], c1, 0, 0, 0); }
        *(LAS f32x4*)(part + ((wave * 2 + 0) * 64 + lane) * 4) = c0; *(LAS f32x4*)(part + ((wave * 2 + 1) * 64 + lane) * 4) = c1;
        __syncthreads();
        if (tid < 256) { const int rr = tid >> 3, cc = tid & 7; const int ln = (rr & 15) + 16 * (cc >> 2), tl = rr >> 4; float s = a.in[1][(size_t)rr * DM + cg * 8 + cc];
#pragma unroll
            for (int w = 0; w < 8; ++w) s += part[((w * 2 + tl) * 64 + ln) * 4 + (cc & 3)];
            a.out[O_YS + (size_t)rr * DM + cg * 8 + cc] = s; }
        __syncthreads();
    }
}
constexpr int SC_STRIDE = 2052;
constexpr int SC_BYTES = 16 * SC_STRIDE * 4;
constexpr int WSCR_OFF = 131584, WSCR_BYTES = 1536;
__device__ __forceinline__ f16x8 cvt8(f32x4 a, f32x4 b) { u32x4 w = {pk_f16(a[0], a[1]), pk_f16(a[2], a[3]), pk_f16(b[0], b[1]), pk_f16(b[2], b[3])}; return __builtin_bit_cast(f16x8, w); }

__device__ __forceinline__ void p2_convmix(const Args& a, int gw, int NGW, int lane) {
    const GAS f16* U = (const GAS f16*)(a.ws + WS_U); const GAS f16* Gm = (const GAS f16*)(a.ws + WS_G); GAS f16* MIX = (GAS f16*)(a.ws + WS_MIX);
    const GAS float* wconv = (const GAS float*)a.in[12]; const GAS float* state = (const GAS float*)a.in[5];
    for (int ch = gw; ch < MT / 4; ch += NGW) {
        const int row0 = 4 * ch; const bool smp = row0 >= MP; const int t0 = smp ? 0 : (row0 & (S - 1)); const int seq = (row0 - MP) >> 2;
#pragma unroll
        for (int half = 0; half < 2; ++half) { const int cb = half * 512 + 8 * lane;
            float um2[8], um1[8], w0[8], w1[8], w2[8];
#pragma unroll
            for (int e = 0; e < 8; e += 4) { const f32x4 a0 = *(const GAS f32x4*)(wconv + cb + e), a1 = *(const GAS f32x4*)(wconv + 1024 + cb + e), a2 = *(const GAS f32x4*)(wconv + 2048 + cb + e);
#pragma unroll
                for (int i = 0; i < 4; ++i) { w0[e + i] = a0[i]; w1[e + i] = a1[i]; w2[e + i] = a2[i]; } }
            if (t0 == 0) {
                if (smp) {
#pragma unroll
                    for (int e = 0; e < 8; e += 4) { const f32x4 s0 = *(const GAS f32x4*)(state + ((size_t)seq * 2) * 1024 + cb + e), s1 = *(const GAS f32x4*)(state + ((size_t)seq * 2 + 1) * 1024 + cb + e);
#pragma unroll
                        for (int i = 0; i < 4; ++i) { um2[e + i] = s0[i]; um1[e + i] = s1[i]; } }
                } else {
#pragma unroll
                    for (int e = 0; e < 8; ++e) { um2[e] = 0.f; um1[e] = 0.f; } }
            } else { const f16x8 p2 = *(const GAS f16x8*)(U + (size_t)(row0 - 2) * 1024 + cb), p1 = *(const GAS f16x8*)(U + (size_t)(row0 - 1) * 1024 + cb);
#pragma unroll
                for (int e = 0; e < 8; ++e) { um2[e] = (float)p2[e]; um1[e] = (float)p1[e]; } }
#pragma unroll
            for (int i = 0; i < 4; ++i) { const size_t row = row0 + i;
                const f16x8 uv = *(const GAS f16x8*)(U + row * 1024 + cb), gv = *(const GAS f16x8*)(Gm + row * 1024 + cb); float o[8];
#pragma unroll
                for (int e = 0; e < 8; ++e) { const float u = (float)uv[e]; const float cv = w0[e] * um2[e] + w1[e] * um1[e] + w2[e] * u; o[e] = (float)gv[e] * cv; um2[e] = um1[e]; um1[e] = u; }
                u32x4 w = {pk_f16(o[0], o[1]), pk_f16(o[2], o[3]), pk_f16(o[4], o[5]), pk_f16(o[6], o[7])};
                *(GAS u32x4*)(MIX + row * 2048 + 1024 + cb) = w; }
        }
    }
}

__device__ __forceinline__ void p2_sscore(const Args& a, int gw, int NGW, int lane) {
    const GAS float* cki = (const GAS float*)a.in[4]; const GAS int* ptab = (const GAS int*)a.in[6];
    const GAS f16* QI = (const GAS f16*)(a.ws + WS_QI); const GAS float* WI = (const GAS float*)(a.ws + WS_WI); GAS float* SSC = (GAS float*)(a.ws + WS_SSC);
    const int fr = lane & 15, fq = lane >> 4;
    for (int it = gw; it < NSB * 256; it += NGW) {
        const int sb = it >> 8, hp = it & 255, pg = hp >> 1, k0 = (hp & 1) * 64; const int phys = ptab[sb * NPAGES + pg];
        const GAS float* kbase = cki + ((size_t)phys * PAGE + k0) * 64;
        f16x8 qf[4][2]; f32x4 wv[4];
#pragma unroll
        for (int t = 0; t < 4; ++t) { const size_t row = MP + 4 * sb + t;
            qf[t][0] = *(const GAS f16x8*)(QI + row * 1024 + fr * 64 + 8 * fq); qf[t][1] = *(const GAS f16x8*)(QI + row * 1024 + fr * 64 + 32 + 8 * fq);
            wv[t] = *(const GAS f32x4*)(WI + row * 16 + 4 * fq); }
#pragma unroll
        for (int tile = 0; tile < 4; ++tile) {
            const GAS float* kr = kbase + (size_t)(16 * tile + fr) * 64 + 8 * fq;
            const f16x8 kf0 = cvt8(*(const GAS f32x4*)kr, *(const GAS f32x4*)(kr + 4)), kf1 = cvt8(*(const GAS f32x4*)(kr + 32), *(const GAS f32x4*)(kr + 36));
            float mine = 0.f;
#pragma unroll
            for (int t = 0; t < 4; ++t) { f32x4 c = {0.f, 0.f, 0.f, 0.f};
                c = __builtin_amdgcn_mfma_f32_16x16x32_f16(qf[t][0], kf0, c, 0, 0, 0); c = __builtin_amdgcn_mfma_f32_16x16x32_f16(qf[t][1], kf1, c, 0, 0, 0);
                float s = wv[t][0] * fmaxf(c[0], 0.f) + wv[t][1] * fmaxf(c[1], 0.f) + wv[t][2] * fmaxf(c[2], 0.f) + wv[t][3] * fmaxf(c[3], 0.f);
                s += __shfl_xor(s, 16); s += __shfl_xor(s, 32);
                mine = fq == t ? s : mine; }
            SSC[(size_t)(4 * sb + fq) * PAST + pg * PAGE + k0 + 16 * tile + fr] = mine;
        }
    }
}

__device__ __forceinline__ void wave_topk_mask(const LAS float* row, int t, GAS unsigned long long* mrow, int lane, LAS unsigned* hist, LAS float* cand) {
    const float NINF = -__builtin_inff(), PINF = __builtin_inff();
    float v[32]; float mx = NINF, mn = PINF;
#pragma unroll
    for (int j = 0; j < 32; ++j) { const int s = 64 * j + lane; const float x = row[s]; const bool ok = s <= t; v[j] = ok ? x : NINF; mx = fmaxf(mx, v[j]); mn = fminf(mn, ok ? x : PINF); }
#pragma unroll
    for (int o = 1; o < 64; o <<= 1) { mx = fmaxf(mx, __shfl_xor(mx, o)); mn = fminf(mn, __shfl_xor(mn, o)); }
    *(LAS u32x4*)(hist + 4 * lane) = (u32x4){0u, 0u, 0u, 0u};
    const float scale = 255.5f / (mx - mn);
    float tau = 0.f; bool have = false;
    if (mx > mn) {
        asm volatile("s_waitcnt lgkmcnt(0)" ::: "memory");
#pragma unroll
        for (int j = 0; j < 32; ++j) { if (64 * j + lane <= t) { int b = (int)((v[j] - mn) * scale); b = b > 255 ? 255 : b; __hip_atomic_fetch_add(hist + b, 1u, __ATOMIC_RELAXED, __HIP_MEMORY_SCOPE_WORKGROUP); } }
        asm volatile("s_waitcnt lgkmcnt(0)" ::: "memory");
        const u32x4 h = *(const LAS u32x4*)(hist + 4 * lane);
        const unsigned sl = h[0] + h[1] + h[2] + h[3]; unsigned pre = sl;
#pragma unroll
        for (int o = 1; o < 64; o <<= 1) { const unsigned y = __shfl_up(pre, o); if (lane >= o) pre += y; }
        const unsigned tot = __builtin_amdgcn_readlane(pre, 63); const unsigned suf = tot - pre + sl;
        const unsigned long long bm = __ballot(suf >= TOPK);
        const int Ls = 63 - __builtin_clzll(bm);
        unsigned c = __builtin_amdgcn_readlane(suf, Ls) - __builtin_amdgcn_readlane(sl, Ls);
        const unsigned h3 = __builtin_amdgcn_readlane(h[3], Ls), h2 = __builtin_amdgcn_readlane(h[2], Ls), h1 = __builtin_amdgcn_readlane(h[1], Ls);
        int Bs;
        if (c + h3 >= TOPK) Bs = 4 * Ls + 3; else { c += h3; if (c + h2 >= TOPK) Bs = 4 * Ls + 2; else { c += h2; if (c + h1 >= TOPK) Bs = 4 * Ls + 1; else { c += h1; Bs = 4 * Ls; } } }
        const int need = TOPK - (int)c;
        int base = 0;
#pragma unroll
        for (int j = 0; j < 32; ++j) { int b = (int)((v[j] - mn) * scale); b = b > 255 ? 255 : b; const bool isc = (64 * j + lane <= t) && b == Bs;
            const unsigned long long m = __ballot(isc);
            if (m) { const int pos = base + (int)__builtin_amdgcn_mbcnt_hi((unsigned)(m >> 32), __builtin_amdgcn_mbcnt_lo((unsigned)m, 0u)); if (isc && pos < 64) cand[pos] = v[j]; base += __builtin_popcountll(m); } }
        if (base <= 64) {
            asm volatile("s_waitcnt lgkmcnt(0)" ::: "memory");
            const float x = lane < base ? cand[lane] : NINF; int rank = 0;
            for (int m = 0; m < base; ++m) { const float y = __builtin_bit_cast(float, __builtin_amdgcn_readlane(__builtin_bit_cast(int, x), m)); rank += y > x ? 1 : 0; }
            float tc = (lane < base && rank <= need - 1) ? x : PINF;
#pragma unroll
            for (int o = 1; o < 64; o <<= 1) tc = fminf(tc, __shfl_xor(tc, o));
            tau = tc; have = true;
        }
    }
    if (!have) {
        unsigned tk = 0u;
        for (int bit = 31; bit >= 0; --bit) { const unsigned cd = tk | (1u << bit); int cnt = 0;
#pragma unroll
            for (int j = 0; j < 32; ++j) cnt += __builtin_popcountll(__ballot((64 * j + lane <= t) && fkey(v[j]) >= cd));
            if (cnt >= TOPK) tk = cd; }
        tau = __builtin_bit_cast(float, (tk & 0x80000000u) ? (tk ^ 0x80000000u) : ~tk);
    }
    unsigned wlo = 0u, whi = 0u;
#pragma unroll
    for (int j = 0; j < 32; ++j) { const unsigned long long m = __ballot((64 * j + lane <= t) && v[j] >= tau); if (lane == j) { wlo = (unsigned)m; whi = (unsigned)(m >> 32); } }
    if (lane < 32) mrow[lane] = ((unsigned long long)whi << 32) | wlo;
}

#define RELU_FMA(acc_, c_, w_) do { const float r_ = fmaxf((c_), 0.f); asm("v_fmac_f32_e32 %0, %1, %2" : "+v"(acc_) : "v"(r_), "v"(w_)); } while (0)
__device__ __forceinline__ void p2_index_tile(const Args& a, LAS unsigned char* lds, int b, int t0, int wave, int lane) {
    const GAS f16* QI = (const GAS f16*)(a.ws + WS_QI); const GAS float* WI = (const GAS float*)(a.ws + WS_WI); const GAS f16* KI = (const GAS f16*)(a.ws + WS_KI);
    GAS unsigned long long* MASK = (GAS unsigned long long*)(a.ws + WS_MASK);
    LAS float* sc = (LAS float*)lds;
    const int fr = lane & 15, fq = lane >> 4; const size_t rowq = (size_t)b * S + t0 + fr;
    f16x8 qf[16][2]; float w[16];
#pragma unroll
    for (int h = 0; h < 16; ++h) { qf[h][0] = *(const GAS f16x8*)(QI + rowq * 1024 + h * 64 + 8 * fq); qf[h][1] = *(const GAS f16x8*)(QI + rowq * 1024 + h * 64 + 32 + 8 * fq); }
#pragma unroll
    for (int h = 0; h < 16; h += 4) { const f32x4 x = *(const GAS f32x4*)(WI + rowq * 16 + h); w[h] = x[0]; w[h + 1] = x[1]; w[h + 2] = x[2]; w[h + 3] = x[3]; }
    const int nkt = (t0 + 16) >> 4;
    const GAS f16* kp = KI + ((size_t)b * S + fr) * 64 + 8 * fq;
    for (int kt = wave; kt < nkt; kt += NWAVES) {
        const f16x8 kf0 = *(const GAS f16x8*)(kp + (size_t)kt * 1024), kf1 = *(const GAS f16x8*)(kp + (size_t)kt * 1024 + 32);
        float a0 = 0.f, a1 = 0.f, a2 = 0.f, a3 = 0.f;
#pragma unroll
        for (int h = 0; h < 16; ++h) { f32x4 c = {0.f, 0.f, 0.f, 0.f};
            c = __builtin_amdgcn_mfma_f32_16x16x32_f16(kf0, qf[h][0], c, 0, 0, 0); c = __builtin_amdgcn_mfma_f32_16x16x32_f16(kf1, qf[h][1], c, 0, 0, 0);
            RELU_FMA(a0, c[0], w[h]); RELU_FMA(a1, c[1], w[h]); RELU_FMA(a2, c[2], w[h]); RELU_FMA(a3, c[3], w[h]); }
        *(LAS f32x4*)(sc + fr * SC_STRIDE + 16 * kt + 4 * fq) = (f32x4){a0, a1, a2, a3};
    }
    __syncthreads();
#pragma unroll 1
    for (int qq = 0; qq < 2; ++qq) { const int q = 2 * wave + qq; const int t = t0 + q;
        wave_topk_mask(sc + q * SC_STRIDE, t, MASK + ((size_t)b * S + t) * 32, lane, (LAS unsigned*)(lds + WSCR_OFF + wave * WSCR_BYTES), (LAS float*)(lds + WSCR_OFF + wave * WSCR_BYTES + 1024)); }
    __syncthreads();
}

__device__ __forceinline__ void p2_phase(const Args& a, LAS unsigned char* lds, int vcu, int G, int wave, int lane) {
    const int gw = vcu * NWAVES + wave, NGW = G * NWAVES;
    p2_sscore(a, gw, NGW, lane);
    p2_convmix(a, gw, NGW, lane);
    { GAS unsigned long long* MASK = (GAS unsigned long long*)(a.ws + WS_MASK);
      for (int i = gw * 64 + lane; i < NB * TOPK * 32; i += NGW * 64) { const int wd = i & 31, t = (i >> 5) & (TOPK - 1), b = i >> 13; const int lo = 64 * wd;
          const unsigned long long m = lo + 63 <= t ? ~0ull : (lo > t ? 0ull : ((1ull << (t - lo + 1)) - 1ull));
          MASK[((size_t)b * S + t) * 32 + wd] = m; } }
    constexpr int NT = NB * (S - TOPK) / 16;
    for (int r = 0; r * G < NT; ++r) { const int k = (r & 1) ? (r + 1) * G - 1 - vcu : r * G + vcu;
        if (k < NT) { const int j = (NT / NB - 1) - (k >> 2), b = k & 3; p2_index_tile(a, lds, b, TOPK + 16 * j, wave, lane); } }
}

namespace att {
typedef short bf16x8 __attribute__((ext_vector_type(8)));
typedef short s16x4 __attribute__((ext_vector_type(4)));
typedef float f32x16 __attribute__((ext_vector_type(16)));
constexpr int QBLK = 32, KVBLK = 64, D = 128;
constexpr int SHM_V = KVBLK * D * 2, SHM_K = KVBLK * D * 2;
constexpr int WS_OFF = 2 * SHM_V + 2 * SHM_K;
constexpr float SCALE = 0.08838834764831845f;
#define KSWZ(row, colB) ((row) * 256 + ((colB) ^ (((row) & 7) << 4)))
#define SBAR() __builtin_amdgcn_sched_barrier(0)
__device__ __forceinline__ int v_st(int k, int c) { const int kk = (k & ~0xC) | ((k & 4) << 1) | ((k & 8) >> 1); return ((kk >> 3) * 4 + (c >> 5)) * 512 + ((kk & 7) * 32 + (c & 31)) * 2; }
__device__ __forceinline__ int v_rd_base(int lane) { return ((lane & 3) << 3) | (((lane >> 2) & 3) << 6) | (((lane >> 4) & 1) << 5) | (((lane >> 5) & 1) << 8); }
constexpr int v_rd_off(int d0, int ks, int half) { return d0 * 512 + ks * 4096 + half * 2048; }
__device__ __forceinline__ int crow(int r, int hi) { return (r & 3) + 8 * (r >> 2) + 4 * hi; }
__device__ __forceinline__ unsigned cvtpk(float lo, float hi) { return pk_bf16(lo, hi); }

template <int KB>
__device__ __forceinline__ void qkt(f32x16& p0, f32x16& p1, const LAS unsigned char* K_lds, int r32, int hi, const LAS unsigned char* qp) {
    p0 = f32x16{}; p1 = f32x16{};
    const LAS unsigned char* kb[4];
#pragma unroll
    for (int dd = 0; dd < 4; ++dd) kb[dd] = K_lds + KB * SHM_K + KSWZ(r32, (dd * 16 + hi * 8) * 2);
#pragma unroll
    for (int d0 = 0; d0 < 8; ++d0) { const LAS unsigned char* a = kb[d0 & 3] + (d0 >> 2) * 128;
        const bf16x8 b0 = *(const LAS bf16x8*)a;
        const bf16x8 b1 = *(const LAS bf16x8*)(a + 32 * 256);
        const bf16x8 qv = *(const LAS bf16x8*)(qp + d0 * 1024);
        p0 = __builtin_amdgcn_mfma_f32_32x32x16_bf16(b0, qv, p0, 0, 0, 0);
        p1 = __builtin_amdgcn_mfma_f32_32x32x16_bf16(b1, qv, p1, 0, 0, 0); }
}
template <int VB>
__device__ __forceinline__ void pv_tile(f32x16* o, int vb0, bf16x8 pa0, bf16x8 pa1, bf16x8 pa2, bf16x8 pa3) {
#define TRRD(dst, off) asm volatile("ds_read_b64_tr_b16 %0, %1 offset:%2" : "=&v"(dst) : "v"(vb0), "i"(off) : "memory")
#define PV_D0(d0) do { s16x4 l0, l1, l2, l3, h0, h1, h2, h3; constexpr int b_ = VB * SHM_V + v_rd_off(d0, 0, 0); \
        TRRD(l0, b_); TRRD(h0, b_ + 2048); TRRD(l1, b_ + 4096); TRRD(h1, b_ + 6144); TRRD(l2, b_ + 8192); TRRD(h2, b_ + 10240); TRRD(l3, b_ + 12288); TRRD(h3, b_ + 14336); \
        asm volatile("s_waitcnt lgkmcnt(0)" ::: "memory"); SBAR(); \
        o[d0] = __builtin_amdgcn_mfma_f32_32x32x16_bf16(pa0, (bf16x8){l0[0], l0[1], l0[2], l0[3], h0[0], h0[1], h0[2], h0[3]}, o[d0], 0, 0, 0); \
        o[d0] = __builtin_amdgcn_mfma_f32_32x32x16_bf16(pa1, (bf16x8){l1[0], l1[1], l1[2], l1[3], h1[0], h1[1], h1[2], h1[3]}, o[d0], 0, 0, 0); \
        o[d0] = __builtin_amdgcn_mfma_f32_32x32x16_bf16(pa2, (bf16x8){l2[0], l2[1], l2[2], l2[3], h2[0], h2[1], h2[2], h2[3]}, o[d0], 0, 0, 0); \
        o[d0] = __builtin_amdgcn_mfma_f32_32x32x16_bf16(pa3, (bf16x8){l3[0], l3[1], l3[2], l3[3], h3[0], h3[1], h3[2], h3[3]}, o[d0], 0, 0, 0); } while (0)
    PV_D0(0); PV_D0(1); PV_D0(2); PV_D0(3);
#undef PV_D0
#undef TRRD
}
__device__ __forceinline__ void partialSM(f32x16& p0, f32x16& p1, unsigned wl, unsigned wh, float sh2) {
    const float NEG = -__builtin_inff(); constexpr float C2 = 1.4426950408889634f * SCALE;
#pragma unroll
    for (int r = 0; r < 16; ++r) { const unsigned bit = 1u << ((r & 3) + 8 * (r >> 2));
        p0[r] = (wl & bit) ? fmaf(p0[r], C2, -sh2) : NEG; p1[r] = (wh & bit) ? fmaf(p1[r], C2, -sh2) : NEG; }
#pragma unroll
    for (int r = 0; r < 16; ++r) p0[r] = __builtin_amdgcn_exp2f(p0[r]);
}
__device__ __forceinline__ void finishSM(f32x16& p0, f32x16& p1, float& l_reg, bf16x8& pa0, bf16x8& pa1, bf16x8& pa2, bf16x8& pa3) {
#pragma unroll
    for (int r = 0; r < 16; ++r) p1[r] = __builtin_amdgcn_exp2f(p1[r]);
    float ps = 0;
#pragma unroll
    for (int r = 0; r < 16; ++r) ps += p0[r];
#pragma unroll
    for (int r = 0; r < 16; ++r) ps += p1[r];
    l_reg += ps;
#define PK4(P, B_, OUT) do { unsigned a0 = cvtpk(P[B_+0], P[B_+1]), a1 = cvtpk(P[B_+2], P[B_+3]); \
        unsigned b0 = cvtpk(P[B_+4], P[B_+5]), b1 = cvtpk(P[B_+6], P[B_+7]); \
        auto r0 = __builtin_amdgcn_permlane32_swap(a0, b0, false, false); auto r1 = __builtin_amdgcn_permlane32_swap(a1, b1, false, false); \
        u32x4 w = {r0[0], r1[0], r0[1], r1[1]}; OUT = __builtin_bit_cast(bf16x8, w); } while (0)
    PK4(p0, 0, pa0); PK4(p0, 8, pa1); PK4(p1, 0, pa2); PK4(p1, 8, pa3);
#undef PK4
}

__device__ __forceinline__ __amdgpu_buffer_rsrc_t mk_rsrc(const GAS void* p, unsigned bytes) {
    const unsigned long long u = (unsigned long long)p; const unsigned lo = __builtin_amdgcn_readfirstlane((unsigned)u), hi = __builtin_amdgcn_readfirstlane((unsigned)(u >> 32));
    return __builtin_amdgcn_make_buffer_rsrc((void*)(((unsigned long long)hi << 32) | lo), (short)0, (int)bytes, 0x00020000);
}
__device__ __forceinline__ void attn_block(const Args& a, LAS unsigned char* lds, int b, int kvh, int q0, float sh2) {
    int tid_ = threadIdx.x; asm volatile("" : "+v"(tid_));
    const int tid = tid_, wid = __builtin_amdgcn_readfirstlane(tid >> 6), lane = tid & 63, r32 = lane & 31, hi = lane >> 5;
    const int head = 4 * kvh + (wid >> 1), qw = q0 + 32 * (wid & 1);
    const GAS bf16_t* Qw = (const GAS bf16_t*)(a.ws + WS_QB) + (((size_t)b * NH + head) * S + qw) * D;
    const GAS bf16_t* Kh = (const GAS bf16_t*)(a.ws + WS_KB) + ((size_t)b * NKV + kvh) * S * D;
    const GAS bf16_t* Vh = (const GAS bf16_t*)(a.ws + WS_VB) + ((size_t)b * NKV + kvh) * S * D;
    const __amdgpu_buffer_rsrc_t rK = mk_rsrc(Kh, S * D * 2), rV = mk_rsrc(Vh, S * D * 2), rM = mk_rsrc((const GAS unsigned long long*)(a.ws + WS_MASK) + ((size_t)b * S + qw) * 32, 32 * 256);
    const unsigned moff = (unsigned)r32 * 256u;
    const int NT = q0 / KVBLK + 1;
    LAS unsigned char* V_lds = lds; LAS unsigned char* K_lds = lds + 2 * SHM_V;
    const int sr = tid >> 4, sc = (tid & 15) * 8, vst0 = v_st(sr, sc), vst1 = v_st(32 + sr, sc), kws = KSWZ(sr, sc * 2);
    const int vb0 = (int)(unsigned)(size_t)V_lds + v_rd_base(lane); const unsigned kvoff = (unsigned)(sr * D + sc) * 2u;
    bf16x8 st_v0, st_v1, st_k0, st_k1;
    LAS unsigned char* qp = lds + WS_OFF + 2048 + wid * 8192 + lane * 16;
#define VMW() asm volatile("s_waitcnt vmcnt(0)" ::: "memory")
#define BL128(r_, so_) __builtin_bit_cast(bf16x8, __builtin_amdgcn_raw_buffer_load_b128(r_, kvoff, (so_), 0))
#define SLOAD_H(k0) do { const int so_ = (k0) * 256; st_v0 = BL128(rV, so_); st_v1 = BL128(rV, so_ + 8192); st_k0 = BL128(rK, so_); st_k1 = BL128(rK, so_ + 8192); } while (0)
#define SWRITE_HK(bf) do { *(LAS bf16x8*)(K_lds + (bf) * SHM_K + kws) = st_k0; *(LAS bf16x8*)(K_lds + (bf) * SHM_K + kws + 32 * 256) = st_k1; } while (0)
#define SWRITE_HV(bf) do { *(LAS bf16x8*)(V_lds + (bf) * SHM_V + vst0) = st_v0; *(LAS bf16x8*)(V_lds + (bf) * SHM_V + vst1) = st_v1; } while (0)
#define SWRITE_H(bf) do { SWRITE_HV(bf); SWRITE_HK(bf); } while (0)
#define MLOAD(t) __builtin_bit_cast(unsigned long long, __builtin_amdgcn_raw_buffer_load_b64(rM, moff, (t) * 8, 0))
#define MSPLIT(mw, wl, wh) do { wl = (unsigned)(mw) >> (4 * hi); wh = (unsigned)((mw) >> 32) >> (4 * hi); } while (0)
    { bf16x8 qt[8];
#pragma unroll
      for (int d0 = 0; d0 < 8; ++d0) qt[d0] = *(const GAS bf16x8*)(Qw + (unsigned)(r32 * D + d0 * 16 + hi * 8));
#pragma unroll
      for (int d0 = 0; d0 < 8; ++d0) *(LAS bf16x8*)(qp + d0 * 1024) = qt[d0]; }
    SLOAD_H(0); unsigned long long mwA = MLOAD(0), mwB = 0ull; VMW(); SWRITE_H(0);
    if (NT > 1) { SLOAD_H(KVBLK); mwB = MLOAD(1); }
    __syncthreads();
    float l_reg = 0.f; f32x16 o[4] = {};
    f32x16 p0, p1; bf16x8 pa0, pa1, pa2, pa3; unsigned wl, wh;
    SBAR(); qkt<0>(p0, p1, K_lds, r32, hi, qp);
    MSPLIT(mwA, wl, wh); partialSM(p0, p1, wl, wh, sh2);
    if (NT > 1) { VMW(); SWRITE_H(1); }
    __syncthreads();
#define STEP(t, KB, VB) do { \
        finishSM(p0, p1, l_reg, pa0, pa1, pa2, pa3); SBAR(); \
        if ((t) + 1 < NT) { SLOAD_H(((t) + 1) * KVBLK); mwA = MLOAD((t) + 1); SBAR(); } \
        pv_tile<VB>(o, vb0, pa0, pa1, pa2, pa3); SBAR(); \
        qkt<KB>(p0, p1, K_lds, r32, hi, qp); \
        MSPLIT(mwB, wl, wh); partialSM(p0, p1, wl, wh, sh2); mwB = mwA; \
        __syncthreads(); \
        if ((t) + 1 < NT) { VMW(); SWRITE_H(VB); } \
        __syncthreads(); } while (0)
    int t = 1;
    for (; t + 1 < NT; t += 2) { STEP(t, 1, 0); STEP(t + 1, 0, 1); }
    if (t < NT) { STEP(t, 1, 0); }
    finishSM(p0, p1, l_reg, pa0, pa1, pa2, pa3); SBAR();
    if ((NT - 1) & 1) pv_tile<1>(o, vb0, pa0, pa1, pa2, pa3); else pv_tile<0>(o, vb0, pa0, pa1, pa2, pa3);
    { auto rr = __builtin_amdgcn_permlane32_swap(__float_as_uint(l_reg), __float_as_uint(l_reg), false, false); l_reg = __uint_as_float(rr[0]) + __uint_as_float(rr[1]); }
    { int te = threadIdx.x; asm volatile("" : "+v"(te));
      const int le = te & 63, r32e = le & 31, hie = le >> 5;
      LAS float* wse = (LAS float*)(lds + WS_OFF) + wid * 64;
      if (hie == 0) wse[r32e] = l_reg;
      asm volatile("s_waitcnt lgkmcnt(0)" ::: "memory");
      __syncthreads();
      LAS f16* stg = (LAS f16*)(lds + wid * 8192);
#pragma unroll
      for (int r = 0; r < 16; ++r) { const int orow = crow(r, hie); const float rl = __builtin_amdgcn_rcpf(wse[orow]);
#pragma unroll
          for (int d0 = 0; d0 < 4; ++d0) stg[orow * 128 + d0 * 32 + r32e] = (f16)(o[d0][r] * rl); }
      asm volatile("s_waitcnt lgkmcnt(0)" ::: "memory");
      const GAS f16* SZ = (const GAS f16*)(a.ws + WS_SZ) + ((size_t)b * S + qw) * 1024 + head * 128; GAS f16* MIX = (GAS f16*)(a.ws + WS_MIX) + ((size_t)b * S + qw) * 2048 + head * 128;
#pragma unroll
      for (int i = 0; i < 8; ++i) { const int c = le + 64 * i, row = c >> 4, ch = c & 15;
          const f16x8 ov = *(const LAS f16x8*)(stg + row * 128 + ch * 8); const f16x8 zv = *(const GAS f16x8*)(SZ + (unsigned)(row * 1024 + ch * 8));
          *(GAS f16x8*)(MIX + (unsigned)(row * 2048 + ch * 8)) = ov * zv; } }
    asm volatile("s_waitcnt lgkmcnt(0)" ::: "memory");
    __syncthreads();
#undef BL128
#undef VMW
#undef SLOAD_H
#undef SWRITE_HK
#undef SWRITE_HV
#undef SWRITE_H
#undef MLOAD
#undef MSPLIT
#undef STEP
}
#undef KSWZ
#undef SBAR
}

__device__ __forceinline__ void p3_sample_item(const Args& a, LAS unsigned char* lds, int qi, int tid) {
    const int sb = qi / NST, tl = qi % NST; constexpr int L = PAST + NST, PER = 33;
    const int lane = tid & 63, wave = __builtin_amdgcn_readfirstlane(tid >> 6);
    const GAS float* ck = (const GAS float*)a.in[2]; const GAS float* cv = (const GAS float*)a.in[3]; const GAS int* ptab = (const GAS int*)a.in[6]; const GAS float* out_ro = (const GAS float*)a.out;
    LAS float* q = (LAS float*)lds; LAS float* w = q + 1024; LAS float* newsc = w + 16; LAS unsigned* cnt = (LAS unsigned*)(newsc + 4); LAS int* nsel = (LAS int*)(cnt + 32);
    LAS unsigned* rid = (LAS unsigned*)(nsel + 4); LAS float* qa = (LAS float*)(rid + 512); LAS float* sc = qa + 1024; LAS float* inv = sc + 8 * 512; LAS float* part = inv + 8;
    const GAS f16* QI = (const GAS f16*)(a.ws + WS_QI) + (size_t)(MP + qi) * 1024; const GAS float* QS = (const GAS float*)(a.ws + WS_QS) + (size_t)qi * 1024;
    for (int i = tid; i < 1024; i += 512) { q[i] = (float)QI[i]; qa[i] = QS[i]; }
    if (tid < 16) w[tid] = ((const GAS float*)(a.ws + WS_WI))[(size_t)(MP + qi) * 16 + tid];
    if (tid < 32) cnt[tid] = 0u;
    if (tid == 0) *nsel = 0;
    __syncthreads();
    if (tid < NST) { const GAS float* kr = out_ro + O_KIS + (size_t)(sb * NST + tid) * 64; float s = 0.f;
#pragma unroll 1
        for (int h = 0; h < 16; ++h) { float dsum = 0.f;
#pragma unroll 8
            for (int d = 0; d < 64; ++d) dsum += q[h * 64 + d] * kr[d];
            s += w[h] * fmaxf(dsum, 0.f); }
        newsc[tid] = s; }
    const GAS float* ssc = (const GAS float*)(a.ws + WS_SSC) + (size_t)qi * PAST;
    unsigned keys[PER];
#pragma unroll
    for (int j = 0; j < PER - 1; ++j) keys[j] = fkey(ssc[j * 512 + tid]);
    __syncthreads();
    { const int s = (PER - 1) * 512 + tid; keys[PER - 1] = (s < L && (s - PAST) <= tl) ? fkey(newsc[s - PAST]) : 0u; }
    unsigned tau = 0u;
    for (int bit = 31; bit >= 0; --bit) { const unsigned cand = tau | (1u << bit); int c = 0;
#pragma unroll
        for (int j = 0; j < PER; ++j) c += __builtin_popcountll(__ballot(keys[j] >= cand));
        if (lane == 0) __hip_atomic_fetch_add(cnt + bit, (unsigned)c, __ATOMIC_RELAXED, __HIP_MEMORY_SCOPE_WORKGROUP);
        __syncthreads();
        if (cnt[bit] >= TOPK) tau = cand; }
#pragma unroll
    for (int j = 0; j < PER; ++j) { if (keys[j] >= tau && keys[j] != 0u) { const int s = j * 512 + tid; const int p = __hip_atomic_fetch_add(nsel, 1, __ATOMIC_RELAXED, __HIP_MEMORY_SCOPE_WORKGROUP);
        if (p < 512) rid[p] = s < PAST ? (unsigned)(ptab[sb * NPAGES + (s >> 7)] * PAGE + (s & (PAGE - 1))) : (0x80000000u | (unsigned)(s - PAST)); } }
    __syncthreads();
    const int n = *nsel < 512 ? *nsel : 512;
    const int kvh = wave & 1, prt = wave >> 1, half = lane >> 5, l32 = lane & 31;
    { f32x4 qv[4];
#pragma unroll
      for (int h = 0; h < 4; ++h) qv[h] = *(const LAS f32x4*)(qa + (4 * kvh + h) * 128 + 4 * l32);
      for (int j0 = 2 * prt; j0 < n; j0 += 32) { f32x4 kv[4]; int jj[4];
#pragma unroll
          for (int u = 0; u < 4; ++u) { jj[u] = j0 + 8 * u + half; const unsigned r = rid[jj[u] < n ? jj[u] : 0];
              const GAS float* kr = (r & 0x80000000u) ? out_ro + O_KS + ((size_t)(sb * NST + (r & 3u)) * NKV + kvh) * HD : ck + ((size_t)r * NKV + kvh) * HD;
              kv[u] = *(const GAS f32x4*)(kr + 4 * l32); }
#pragma unroll
          for (int u = 0; u < 4; ++u) { float d[4];
#pragma unroll
              for (int h = 0; h < 4; ++h) { d[h] = (kv[u][0] * qv[h][0] + kv[u][1] * qv[h][1]) + (kv[u][2] * qv[h][2] + kv[u][3] * qv[h][3]);
                  d[h] += __shfl_xor(d[h], 1); d[h] += __shfl_xor(d[h], 2); d[h] += __shfl_xor(d[h], 4); d[h] += __shfl_xor(d[h], 8); d[h] += __shfl_xor(d[h], 16); }
              if (jj[u] < n && l32 < 4) sc[(4 * kvh + l32) * 512 + jj[u]] = (l32 == 0 ? d[0] : l32 == 1 ? d[1] : l32 == 2 ? d[2] : d[3]) * 0.08838834764831845f; } } }
    __syncthreads();
    { LAS float* row = sc + wave * 512; float mx = -1e30f;
      for (int j = lane; j < n; j += 64) mx = fmaxf(mx, row[j]);
#pragma unroll
      for (int o = 1; o < 64; o <<= 1) mx = fmaxf(mx, __shfl_xor(mx, o));
      float sm = 0.f;
      for (int j = lane; j < n; j += 64) { const float e = __expf(row[j] - mx); row[j] = e; sm += e; }
      sm = wave_sum(sm); if (lane == 0) inv[wave] = 1.f / sm; }
    __syncthreads();
    { f32x4 acc[4] = {};
      for (int j0 = 2 * prt; j0 < n; j0 += 32) { f32x4 vv[4]; int jj[4];
#pragma unroll
          for (int u = 0; u < 4; ++u) { jj[u] = j0 + 8 * u + half; const unsigned r = rid[jj[u] < n ? jj[u] : 0];
              const GAS float* vr = (r & 0x80000000u) ? out_ro + O_VS + ((size_t)(sb * NST + (r & 3u)) * NKV + kvh) * HD : cv + ((size_t)r * NKV + kvh) * HD;
              vv[u] = *(const GAS f32x4*)(vr + 4 * l32); }
#pragma unroll
          for (int u = 0; u < 4; ++u)
#pragma unroll
              for (int h = 0; h < 4; ++h) { const float p = jj[u] < n ? sc[(4 * kvh + h) * 512 + jj[u]] : 0.f; acc[h] += vv[u] * p; } }
#pragma unroll
      for (int h = 0; h < 4; ++h) {
#pragma unroll
          for (int e = 0; e < 4; ++e) acc[h][e] += __shfl_xor(acc[h][e], 32);
          if (half == 0) *(LAS f32x4*)(part + (wave * 4 + h) * 128 + 4 * l32) = acc[h]; } }
    __syncthreads();
    { const GAS f16* SZ = (const GAS f16*)(a.ws + WS_SZ) + (size_t)(MP + qi) * 1024; GAS f16* MIX = (GAS f16*)(a.ws + WS_MIX) + (size_t)(MP + qi) * 2048;
      for (int i = tid; i < 1024; i += 512) { const int h = i >> 7, d = i & 127, kh = h >> 2, hl = h & 3; float o = 0.f;
#pragma unroll
          for (int p = 0; p < 4; ++p) o += part[((2 * p + kh) * 4 + hl) * 128 + d];
          MIX[i] = (f16)(o * inv[h] * (float)SZ[i]); } }
    __syncthreads();
}

__device__ __forceinline__ void p3_phase(const Args& a, LAS unsigned char* lds, int vcu, int G, int tid) {
    float gm = 0.f, km = 0.f;
    for (int i = 0; i < HD; ++i) { gm = fmaxf(gm, fabsf(a.in[9][i])); km = fmaxf(km, fabsf(a.in[10][i])); }
    const float sh2 = fmaxf(0.f, 11.313708498984761f * gm * km - 20.f) * 1.4426950408889634f;
    for (int sidx = G - 1 - vcu; sidx < MS; sidx += G) p3_sample_item(a, lds, sidx, tid);
    for (int k = vcu; k < 256; k += G) { const int i = 31 - (k >> 3), bk = k & 7;
        att::attn_block(a, lds, bk >> 1, bk & 1, 64 * i, sh2); }
}

typedef GAS unsigned gu32;
#define XB_TMO      128
#define XB_XCNT(j)  (256  + 64 * (j))
#define XB_XSUB(j)  (1280 + 64 * (j))
#define XB_XGEN(j)  (2304 + 64 * (j))
#define XB_TOP      3328
#define XB_TOPGEN   3392
#define XCD_BAR_WORDS 3456
#define XB_SPIN_CAP (1u << 18)
__device__ __forceinline__ unsigned xb_ld(unsigned* p)              { return __hip_atomic_load(p, __ATOMIC_RELAXED, __HIP_MEMORY_SCOPE_AGENT); }
__device__ __forceinline__ unsigned xb_add(unsigned* p, unsigned v) { return __hip_atomic_fetch_add(p, v, __ATOMIC_RELAXED, __HIP_MEMORY_SCOPE_AGENT); }
__device__ __forceinline__ unsigned xb_xcc_id() { return (unsigned)__builtin_amdgcn_s_getreg((3 << 11) | 20) & 0xFu; }
#define XB_SPIN(cond, bar) do { unsigned _sp = 0; while (cond) { __builtin_amdgcn_s_sleep(1); \
    if ((++_sp & 255u) == 0u) { if (xb_ld(&(bar)[XB_TMO])) break; if (_sp > XB_SPIN_CAP) { atomicAdd(&(bar)[XB_TMO], 1u); break; } } } } while (0)
struct XcdBarrier { unsigned* bar; unsigned x; volatile LAS unsigned* st; };
__device__ __forceinline__ XcdBarrier xcd_barrier_post(unsigned* bar, volatile LAS unsigned* st) {
    XcdBarrier b; b.bar = bar; b.x = xb_xcc_id(); b.st = st;
    if (threadIdx.x == 0) (void)xb_add(&bar[XB_XCNT(b.x)], 1u);
    return b;
}
__device__ __forceinline__ void xcd_barrier_complete(unsigned* bar, unsigned x, unsigned& nloc, unsigned& nx) {
    const unsigned G = gridDim.x * gridDim.y * gridDim.z;
    unsigned sum, cnt, mine, sp = 0u;
    for (;;) {
        sum = 0u; cnt = 0u; mine = 0u;
#pragma unroll
        for (unsigned j = 0; j < 16; ++j) { const unsigned c = xb_ld(&bar[XB_XCNT(j)]); sum += c; cnt += (c > 0u) ? 1u : 0u; mine = (j == x) ? c : mine; }
        if (sum == G) break;
        __builtin_amdgcn_s_sleep(1);
        if ((++sp & 255u) == 0u) { if (xb_ld(&bar[XB_TMO])) break; if (sp > XB_SPIN_CAP) { atomicAdd(&bar[XB_TMO], 1u); break; } }
    }
    nloc = mine > 0u ? mine : 1u; nx = cnt > 0u ? cnt : 1u;
}
__device__ __forceinline__ void xcd_barrier(const XcdBarrier& b) {
    asm volatile("s_waitcnt vmcnt(0)" ::: "memory");
    __syncthreads();
    if (threadIdx.x == 0) {
        unsigned* bar = b.bar;
        __builtin_amdgcn_s_waitcnt(0);
        unsigned nloc = b.st[0], nx = b.st[1];
        if (nloc == 0u) { xcd_barrier_complete(bar, b.x, nloc, nx); b.st[0] = nloc; b.st[1] = nx; }
        const unsigned old = xb_add(&bar[XB_XSUB(b.x)], 1u);
        const unsigned gen = old / nloc;
        if (old + 1u == (gen + 1u) * nloc) {
            __builtin_amdgcn_fence(__ATOMIC_RELEASE, "agent");
            asm volatile("s_waitcnt vmcnt(0)" ::: "memory");
            const unsigned og = xb_add(&bar[XB_TOP], 1u);
            const unsigned tg = og / nx;
            if (og + 1u == (tg + 1u) * nx) xb_add(&bar[XB_TOPGEN], 1u);
            else XB_SPIN(xb_ld(&bar[XB_TOPGEN]) == tg, bar);
            __builtin_amdgcn_fence(__ATOMIC_ACQUIRE, "agent");
            xb_add(&bar[XB_XGEN(b.x)], 1u);
            asm volatile("s_waitcnt vmcnt(0)" ::: "memory");
        } else {
            XB_SPIN(xb_ld(&bar[XB_XGEN(b.x)]) == gen, bar);
            __builtin_amdgcn_fence(__ATOMIC_ACQUIRE, "agent");
            asm volatile("s_waitcnt vmcnt(0)" ::: "memory");
        }
    }
    __syncthreads();
}

__global__ void __launch_bounds__(NWAVES * 64, 2) mk_fwd(Args a) {
    extern __shared__ __attribute__((aligned(16))) unsigned char lds_raw[];
    LAS unsigned char* lds = (LAS unsigned char*)lds_raw;
    const int tid = threadIdx.x, lane = tid & 63, wave = __builtin_amdgcn_readfirstlane(tid >> 6);
    const int G = gridDim.x; const int bx = blockIdx.x; const int vcu = (G % 8 == 0) ? (bx % 8) * (G / 8) + bx / 8 : bx;
    volatile LAS unsigned* MISC = (volatile LAS unsigned*)(lds + MISC_OFF);
    if (tid < 64) MISC[tid] = 0u;
    __syncthreads();
    XcdBarrier bar = xcd_barrier_post((unsigned*)a.ws, MISC + 8);
    { int t_ = threadIdx.x; asm volatile("" : "+v"(t_)); const int lane = t_ & 63, wave = __builtin_amdgcn_readfirstlane(t_ >> 6); p0_prologue(a, lds, vcu, G, wave, lane); }
    xcd_barrier(bar);
    { pg8::Gemm g{(const f16*)(a.ws + WS_XNH), (const f16*)(a.ws + WS_WINT), DM};
      pg8::StaticOrder S; S.init(MPAD / 256, NPAD / 256, G, bx);
      EpiIn E{a.out, a.ws, a.in[9], a.in[10], a.in[11], (LAS float*)(lds + SCR_OFF)};
      pg8::gemm_phase<EpiIn, pg8::StaticOrder>(lds, g, S, E); }
    xcd_barrier(bar);
    { int t_ = threadIdx.x; asm volatile("" : "+v"(t_)); const int lane = t_ & 63, wave = __builtin_amdgcn_readfirstlane(t_ >> 6); p2_phase(a, lds, vcu, G, wave, lane); }
    xcd_barrier(bar);
    { int t_ = threadIdx.x; asm volatile("" : "+v"(t_)); p3_phase(a, lds, vcu, G, t_); }
    xcd_barrier(bar);
    { pg8::Gemm g{(const f16*)(a.ws + WS_MIX), (const f16*)(a.ws + WS_WOUTT), DM};
      pg8::StaticOrder S; S.init(MP / 256, DM / 256, G, bx);
      EpiOut E{a.out, a.in[0]};
      pg8::gemm_phase<EpiOut, pg8::StaticOrder>(lds, g, S, E);
      int t_ = threadIdx.x; asm volatile("" : "+v"(t_)); p4_sample(a, lds, bx, G, t_); }
}

#ifndef PROG
#define PROG 0x11111u
#endif
extern "C" void kernel_launch(void* const* d_in, const int* in_sizes, int n_in, void* d_out, int out_size, void* d_ws, size_t ws_size, hipStream_t stream) {
    static int grid = 0;
    if (grid == 0) {
        if (ws_size < WS_NEED2 || out_size != (int)O_END || n_in != 14) { fprintf(stderr, "kernel_launch: ws %zu (need %zu) out %d (want %zu) n_in %d\n", ws_size, (size_t)WS_NEED2, out_size, (size_t)O_END, n_in); grid = -1; return; }
        int dev = 0, cus = 0; hipGetDevice(&dev); hipDeviceGetAttribute(&cus, hipDeviceAttributeMultiprocessorCount, dev);
        if (hipFuncSetAttribute((const void*)mk_fwd, hipFuncAttributeMaxDynamicSharedMemorySize, LDS_BYTES) != hipSuccess) { fprintf(stderr, "kernel_launch: hipFuncSetAttribute failed\n"); grid = -1; return; }
        int per_cu = 0; hipOccupancyMaxActiveBlocksPerMultiprocessor(&per_cu, (const void*)mk_fwd, NWAVES * 64, LDS_BYTES); (void)hipGetLastError();
        if (per_cu < 1) fprintf(stderr, "kernel_launch: occupancy query says %d blocks per CU\n", per_cu);
        grid = cus > 0 ? cus : 256;
    }
    if (grid < 0) return;
    float* out = (float*)d_out; unsigned char* ws = (unsigned char*)d_ws;
    Args a{};
    for (int i = 0; i < 14; ++i) a.in[i] = (const float*)d_in[i];
    a.out = out; a.ws = ws;
    if (hipMemsetAsync(ws, 0, 65536, stream) != hipSuccess) { fprintf(stderr, "kernel_launch: memset of the control words failed\n"); return; }
    a.ph_lo = (int)PROG; a.ph_hi = 0; hipLaunchKernelGGL(mk_fwd, dim3(grid), dim3(NWAVES * 64), LDS_BYTES, stream, a);
}
```

```cpp
#include <hip/hip_runtime.h>
#include <cstdio>
#include <cstdint>
#include <cmath>

typedef _Float16 f16;
typedef unsigned short bf16_t;

constexpr int DM = 2048, NB = 4, S = 2048, NSB = 8, NST = 4, PAST = 16384, PAGE = 128, NPAGES = PAST / PAGE;
constexpr int MP = NB * S;
constexpr int MS = NSB * NST;
constexpr int MT = MP + MS;
constexpr int DIN = 7760;
constexpr int OQ = 0, OKK = 1024, OV = 1280, OZ = 1536, OQI = 2560, OKI = 3584, OWI = 3648, OH = 3664, OBB = 4688, OC = 5712, OZC = 6736;
constexpr int NH = 8, NKV = 2, HD = 128, NIH = 16, ID = 64, TOPK = 256, DC = 1024;
constexpr float EPS = 1e-6f;
constexpr size_t O_YP = 0, O_YS = 16777216, O_KP = 16842752, O_VP = 18939904, O_KIP = 21037056, O_CVP = 21561344,
                 O_KS = 21569536, O_VS = 21577728, O_KIS = 21585920, O_CVS = 21587968, O_END = 21604352;
constexpr size_t MiB = 1u << 20;
constexpr size_t WS_ROPE = 1 * MiB;
constexpr size_t WS_ROPE_I = WS_ROPE + 2052 * 32 * 4;
constexpr size_t WS_QB = 2 * MiB;
constexpr size_t WS_KB = 18 * MiB;
constexpr size_t WS_VB = 22 * MiB;
constexpr size_t WS_SZ = 26 * MiB;
constexpr size_t WS_QI = 43 * MiB;
constexpr size_t WS_KI = 60 * MiB;
constexpr size_t WS_WI = 61 * MiB;
constexpr size_t WS_U = 62 * MiB;
constexpr size_t WS_G = 79 * MiB;
constexpr size_t WS_MIX = 96 * MiB;
constexpr size_t WS_MASK = 130 * MiB;
constexpr size_t WS_SSC = 132 * MiB;
constexpr size_t WS_QS = 134 * MiB;
constexpr size_t WS_XN = 136 * MiB;
constexpr size_t WS_P = 202 * MiB;
constexpr size_t WS_NEED = 448 * MiB;

__device__ __forceinline__ bf16_t f2bf(float f) { unsigned u = __builtin_bit_cast(unsigned, f); return (bf16_t)((u + 0x7fffu + ((u >> 16) & 1u)) >> 16); }
__device__ __forceinline__ float bf2f(bf16_t h) { return __builtin_bit_cast(float, (unsigned)h << 16); }
__device__ __forceinline__ float silu(float z) { return z / (1.f + __expf(-z)); }
__device__ __forceinline__ unsigned fkey(float f) { unsigned u = __builtin_bit_cast(unsigned, f); return (u & 0x80000000u) ? ~u : (u | 0x80000000u); }

#define P3_REP_S 1
#define P3_REP_A 1
#define P2_KT_REP 1
#define P2_SEL_REP 1
#define P2_REP_A 1
#define P2_REP_B 1
#define P2_REP_C 1
#define LAS __attribute__((address_space(3)))
#define GAS __attribute__((address_space(1)))
typedef _Float16 f16x8 __attribute__((ext_vector_type(8)));
typedef _Float16 f16x4 __attribute__((ext_vector_type(4)));
typedef _Float16 f16x2 __attribute__((ext_vector_type(2)));
typedef float f32x4 __attribute__((ext_vector_type(4)));
typedef float f32x2 __attribute__((ext_vector_type(2)));
typedef unsigned u32x4 __attribute__((ext_vector_type(4)));
typedef unsigned u32x2 __attribute__((ext_vector_type(2)));
typedef __bf16 bf16x2_t __attribute__((ext_vector_type(2)));
namespace pg8 {
constexpr int BM = 256, BK = 64, HALF = 128, HTB = HALF * BK * 2, STAGE_BYTES = 8 * HTB, NXCD = 8, WGM = 8;
__host__ __device__ __forceinline__ int lds_byte(int r, int c) { const int st = (r >> 4) * 2 + (c >> 5), rr = r & 15, cc = c & 31, ob = rr * 64 + cc * 2; return st * 1024 + (ob ^ (((ob >> 9) & 1) << 5)); }
__host__ __device__ __forceinline__ void stage_rc(int b, int& R, int& C) { const int st = b / 1024, sb = b % 1024, swz = sb ^ (((sb >> 9) & 1) << 5); R = (st >> 1) * 16 + swz / 64; C = (st & 1) * 32 + (swz % 64) / 2; }
struct Unit { int pm, pn; };
struct Gemm { const f16* A; const f16* Bt; int K; };
struct StaticOrder {
    int nM, nN, nwg, G, c;
    __device__ void init(int nM_, int nN_, int G_, int c_) { nM = nM_; nN = nN_; nwg = nM * nN; G = G_; c = c_; }
    __device__ bool next(int i, Unit& u) const {
        const long L = (long)i * G + c; if (L >= nwg) return false;
        int wgid = (int)L; { const int q = nwg / NXCD, r = nwg % NXCD, xcd = wgid % NXCD, off = wgid / NXCD; wgid = (xcd < r ? xcd * (q + 1) : r * (q + 1) + (xcd - r) * q) + off; }
        const int nig = WGM * nN, gid = wgid / nig, fm = gid * WGM, gsz = (nM - fm) < WGM ? (nM - fm) : WGM;
        u.pm = fm + ((wgid % nig) % gsz); u.pn = (wgid % nig) / gsz; return true;
    }
};
template <class Epi, class Sched>
__device__ __forceinline__ void gemm_phase(LAS unsigned char* lds, const Gemm g, const Sched& S, const Epi& E) {
    int tid_ = threadIdx.x; asm volatile("" : "+v"(tid_));
    const int tid = tid_, wid = __builtin_amdgcn_readfirstlane(tid >> 6), lane = tid & 63, wr = wid >> 2, wc = wid & 3, fr = lane & 15, fq = lane >> 4;
    const int K = g.K, nt = K / BK;
    unsigned voffA[2];
#pragma unroll
    for (int i = 0; i < 2; ++i) { int R, C; stage_rc(tid * 16 + i * 8192, R, C); voffA[i] = (unsigned)(R * K + C) * 2u; }
    const size_t kstep = (size_t)(BK * 2);
    const size_t hstep = (size_t)HALF * K * 2;
    const size_t tstep = 2 * hstep;
    const unsigned ldsw = (unsigned)wid * 1024u;
    const int aoff = lds_byte(wr * 64 + fr, fq * 8), boff = lds_byte(wc * 32 + fr, fq * 8);
#define PG8_SA(b, h) (((b) * 2 + (h)) * HTB)
#define PG8_SB(b, h) ((4 + (b) * 2 + (h)) * HTB)
#define PG8_STAGE(bufoff, gbase) do { _Pragma("unroll") for (int _i = 0; _i < 2; ++_i) \
        __builtin_amdgcn_global_load_lds((const unsigned*)((const char*)(gbase) + voffA[_i]), (LAS unsigned*)(lds + (bufoff) + ldsw + _i * 8192), 16, 0, 0); } while (0)
#define PG8_LDA(dst, b, h) do { _Pragma("unroll") for (int m = 0; m < 4; ++m) _Pragma("unroll") for (int k = 0; k < 2; ++k) dst[m][k] = *(const LAS f16x8*)(lds + PG8_SA(b, h) + aoff + m * 2048 + k * 1024); } while (0)
#define PG8_LDB(dst, b, h) do { _Pragma("unroll") for (int n = 0; n < 2; ++n) _Pragma("unroll") for (int k = 0; k < 2; ++k) dst[n][k] = *(const LAS f16x8*)(lds + PG8_SB(b, h) + boff + n * 2048 + k * 1024); } while (0)
#define PG8_MMA(ai, bj, At, Bt) do { __builtin_amdgcn_s_setprio(1); _Pragma("unroll") for (int m = 0; m < 4; ++m) _Pragma("unroll") for (int n = 0; n < 2; ++n) _Pragma("unroll") for (int k = 0; k < 2; ++k) \
        acc[ai][bj][m][n] = __builtin_amdgcn_mfma_f32_16x16x32_f16(Bt[n][k], At[m][k], acc[ai][bj][m][n], 0, 0, 0); __builtin_amdgcn_s_setprio(0); } while (0)
#define PG8_WAIT_V(n) asm volatile("s_waitcnt vmcnt(" #n ")" ::: "memory")
#define PG8_WAIT_L(n) asm volatile("s_waitcnt lgkmcnt(" #n ")" ::: "memory")
#define PG8_BAR __builtin_amdgcn_s_barrier()
#define PG8_SCHED __builtin_amdgcn_sched_barrier(0)
    Unit cur, nxt; int ui = 0;
    if (!S.next(0, cur)) return;
    f32x4 acc[2][2][4][2];
    E.init(acc, cur, wr, wc, fr, fq);
    f16x8 At[4][2], B0[2][2], B1[2][2];
    const char* cA = (const char*)g.A + (size_t)cur.pm * tstep; const char* cB = (const char*)g.Bt + (size_t)cur.pn * tstep;
    PG8_STAGE(PG8_SB(0, 0), cB); PG8_STAGE(PG8_SB(0, 1), cB + hstep); PG8_STAGE(PG8_SA(0, 0), cA); PG8_STAGE(PG8_SA(0, 1), cA + hstep);
    if (wr == 1) PG8_BAR;
    PG8_WAIT_V(2); PG8_BAR;
    PG8_STAGE(PG8_SB(1, 0), cB + kstep); PG8_STAGE(PG8_SA(1, 0), cA + kstep); PG8_STAGE(PG8_SB(1, 1), cB + hstep + kstep);
    PG8_WAIT_V(6); PG8_BAR;
    for (;;) {
        const bool has_next = S.next(ui + 1, nxt);
        const char* nA = has_next ? (const char*)g.A + (size_t)nxt.pm * tstep : cA; const char* nB = has_next ? (const char*)g.Bt + (size_t)nxt.pn * tstep : cB;
        for (int t = 0; t < nt; t += 2) {
            const bool last = (t == nt - 2);
            const char* a1 = cA + (size_t)(t + 1) * kstep;
            const char* a2 = last ? nA : cA + (size_t)(t + 2) * kstep; const char* b2 = last ? nB : cB + (size_t)(t + 2) * kstep;
            const char* a3 = a2 + kstep; const char* b3 = b2 + kstep;
            PG8_LDB(B0, 0, 0); PG8_LDB(B1, 0, 1); PG8_SCHED; PG8_LDA(At, 0, 0); PG8_STAGE(PG8_SA(1, 1), a1 + hstep);
            PG8_WAIT_V(8); PG8_WAIT_L(0); PG8_BAR; PG8_MMA(0, 0, At, B0); PG8_MMA(0, 1, At, B1); PG8_BAR; PG8_SCHED;
            PG8_LDA(At, 0, 1); PG8_STAGE(PG8_SB(0, 0), b2); PG8_STAGE(PG8_SB(0, 1), b2 + hstep); PG8_STAGE(PG8_SA(0, 0), a2);
            PG8_WAIT_V(8); PG8_WAIT_L(0); PG8_BAR; PG8_MMA(1, 0, At, B0); PG8_MMA(1, 1, At, B1); PG8_BAR; PG8_SCHED;
            PG8_LDB(B0, 1, 0); PG8_LDB(B1, 1, 1); PG8_SCHED; PG8_LDA(At, 1, 0); PG8_STAGE(PG8_SA(0, 1), a2 + hstep);
            PG8_WAIT_V(8); PG8_WAIT_L(0); PG8_BAR; PG8_MMA(0, 0, At, B0); PG8_MMA(0, 1, At, B1); PG8_BAR; PG8_SCHED;
            PG8_LDA(At, 1, 1); PG8_STAGE(PG8_SB(1, 0), b3); PG8_STAGE(PG8_SB(1, 1), b3 + hstep); PG8_STAGE(PG8_SA(1, 0), a3);
            PG8_WAIT_V(8); PG8_WAIT_L(0); PG8_BAR; PG8_MMA(1, 0, At, B0); PG8_MMA(1, 1, At, B1); PG8_BAR; PG8_SCHED;
        }
        if (wr == 0) PG8_BAR;
        E(acc, cur, wr, wc, fr, fq);
        if (!has_next) break;
        cur = nxt; cA = nA; cB = nB; ++ui;
        E.init(acc, cur, wr, wc, fr, fq);
        if (wr == 1) PG8_BAR;
    }
    PG8_WAIT_V(0);
    PG8_BAR;
#undef PG8_SA
#undef PG8_SB
#undef PG8_STAGE
#undef PG8_LDA
#undef PG8_LDB
#undef PG8_MMA
#undef PG8_WAIT_V
#undef PG8_WAIT_L
#undef PG8_BAR
#undef PG8_SCHED
}
}
constexpr int NWAVES = 8;
constexpr int MPAD = 8448, NPAD = 7936;
constexpr size_t WS_XNH = 450 * MiB;
constexpr size_t WS_WINT = 484 * MiB;
constexpr size_t WS_WOUTT = 516 * MiB;
constexpr size_t WS_NEED2 = 524 * MiB;
constexpr int RING_BYTES = 131072, SCR_OFF = RING_BYTES, SCR_BYTES = 8192, MISC_OFF = 145408, LDS_BYTES = 147456;

__device__ __forceinline__ unsigned pk_bf16(float lo, float hi) { f32x2 v = {lo, hi}; bf16x2_t b = __builtin_convertvector(v, bf16x2_t); return __builtin_bit_cast(unsigned, b); }
__device__ __forceinline__ unsigned pk_f16(float lo, float hi) { f32x2 v = {lo, hi}; f16x2 b = __builtin_convertvector(v, f16x2); return __builtin_bit_cast(unsigned, b); }

struct Args { const float* in[14]; float* out; unsigned char* ws; int ph_lo, ph_hi; };

__device__ __forceinline__ int win_src(int np) {
    const int pn = np >> 8, c = np & 255;
    if (pn < 14) return np;
    if (pn == 14) return c < 80 ? np : -1;
    const int T = pn - 15, bj = c >> 7, wc = (c >> 5) & 3, n = (c >> 4) & 1, fqi = c & 15;
    const int base = bj == 0 ? (n == 0 ? OH : OBB) : (n == 0 ? OC : OZC);
    return base + 64 * T + 16 * wc + fqi;
}
template <bool MAP>
__device__ __forceinline__ void p0_transpose_item(const float* W, int N, f16* WT, LAS float* scr, int item, int nblk, int lane) {
    const int kb = item / nblk, nb = item % nblk, k0 = 64 * kb, n0 = 32 * nb;
    const int src = MAP ? win_src(n0 + (lane & 31)) : n0 + (lane & 31);
#pragma unroll 8
    for (int i = 0; i < 32; ++i) { const int kk = 2 * i + (lane >> 5); scr[kk * 33 + (lane & 31)] = src >= 0 ? W[(size_t)(k0 + kk) * N + src] : 0.f; }
    asm volatile("s_waitcnt lgkmcnt(0)" ::: "memory");
    const int c = lane & 7;
#pragma unroll
    for (int j = 0; j < 4; ++j) { const int n = (lane >> 3) + 8 * j; const LAS float* s = scr + (8 * c) * 33 + n;
        u32x4 o; o.x = pk_f16(s[0 * 33], s[1 * 33]); o.y = pk_f16(s[2 * 33], s[3 * 33]); o.z = pk_f16(s[4 * 33], s[5 * 33]); o.w = pk_f16(s[6 * 33], s[7 * 33]);
        *(u32x4*)(WT + (size_t)(n0 + n) * 2048 + k0 + 8 * c) = o; }
    asm volatile("s_waitcnt lgkmcnt(0)" ::: "memory");
}
__device__ __forceinline__ float wave_sum(float v) {
#pragma unroll
    for (int o = 1; o < 64; o <<= 1) v += __shfl_xor(v, o);
    return v;
}
__device__ __forceinline__ void p0_prologue(const Args& a, LAS unsigned char* lds, int vcu, int G, int wave, int lane) {
    LAS float* scr = (LAS float*)(lds + wave * 16384);
    const int gw = vcu * NWAVES + wave, NGW = G * NWAVES;
    const float* win = a.in[8]; const float* wout = a.in[13];
    f16* WinT = (f16*)(a.ws + WS_WINT); f16* WoutT = (f16*)(a.ws + WS_WOUTT); f16* XN = (f16*)(a.ws + WS_XNH);
    constexpr int I_IN = 32 * (NPAD / 32), I_OUT = 32 * (DM / 32);
    for (int it = gw; it < I_IN + I_OUT; it += NGW) {
        if (it < I_IN) p0_transpose_item<true>(win, DIN, WinT, scr, it, NPAD / 32, lane);
        else p0_transpose_item<false>(wout, DM, WoutT, scr, it - I_IN, DM / 32, lane);
    }
    const float* gin = a.in[7];
    for (int m = gw; m < MT; m += NGW) {
        const float* xrow = m < MP ? a.in[0] + (size_t)m * DM : a.in[1] + (size_t)(m - MP) * DM;
        const f32x4* xr = (const f32x4*)xrow + lane; f32x4 v[8]; float s = 0.f;
#pragma unroll
        for (int j = 0; j < 8; ++j) { v[j] = xr[64 * j]; s += (v[j].x * v[j].x + v[j].y * v[j].y) + (v[j].z * v[j].z + v[j].w * v[j].w); }
        const float rs = rsqrtf(wave_sum(s) * (1.f / DM) + EPS);
        u32x2* o8 = (u32x2*)(XN + (size_t)m * DM) + lane;
#pragma unroll
        for (int j = 0; j < 8; ++j) { const f32x4 gv = ((const f32x4*)gin)[lane + 64 * j]; u32x2 w; w.x = pk_f16(v[j].x * rs * gv.x, v[j].y * rs * gv.y); w.y = pk_f16(v[j].z * rs * gv.z, v[j].w * rs * gv.w); o8[64 * j] = w; }
    }
    float* rqk = (float*)(a.ws + WS_ROPE); float* ri = (float*)(a.ws + WS_ROPE_I);
    for (int i = gw * 64 + lane; i < 2052 * 16; i += NGW * 64) {
        { int slot = i / 16, j = i % 16; int pos = slot < 2048 ? slot : PAST + (slot - 2048);
          float inv = (float)pow(500000.0, -(double)j / 16.0); float ang = (float)pos * inv;
          rqk[(slot * 16 + j) * 2] = (float)cos((double)ang); rqk[(slot * 16 + j) * 2 + 1] = (float)sin((double)ang); }
        if (i < 2052 * 8) { int slot = i / 8, j = i % 8; int pos = slot < 2048 ? slot : PAST + (slot - 2048);
          float inv = (float)pow(500000.0, -(double)j / 8.0); float ang = (float)pos * inv;
          ri[(slot * 8 + j) * 2] = (float)cos((double)ang); ri[(slot * 8 + j) * 2 + 1] = (float)sin((double)ang); }
    }
}

struct EpiIn {
    float* out; unsigned char* ws; const float* gq; const float* gk; const float* gki; LAS float* scr;
    __device__ __forceinline__ void init(f32x4 (&acc)[2][2][4][2], const pg8::Unit&, int, int, int, int) const {
#pragma unroll
        for (int a = 0; a < 2; ++a)
#pragma unroll
            for (int b = 0; b < 2; ++b)
#pragma unroll
                for (int m = 0; m < 4; ++m)
#pragma unroll
                    for (int n = 0; n < 2; ++n) acc[a][b][m][n] = (f32x4){0.f, 0.f, 0.f, 0.f};
    }
    __device__ __forceinline__ void operator()(f32x4 (&acc)[2][2][4][2], const pg8::Unit& u, int wr, int wc, int fr_, int fq_) const {
        int fr = fr_, fq = fq_; asm volatile("" : "+v"(fr), "+v"(fq));
        GAS unsigned char* ws = (GAS unsigned char*)this->ws; GAS float* out = (GAS float*)this->out; asm volatile("" : "+s"(ws), "+s"(out));
        const int pn = u.pn, pm = u.pm; const bool smp = pm == 32;
        const int rbase = 64 * wr + fr;
        const int bb = pm >> 3, t0 = (pm & 7) << 8;
        const GAS float* rqk = (const GAS float*)(ws + WS_ROPE); const GAS float* ri = (const GAS float*)(ws + WS_ROPE_I);
#define ROWLOOP _Pragma("unroll") for (int ai = 0; ai < 2; ++ai) _Pragma("unroll") for (int m = 0; m < 4; ++m)
#define ROWVARS const int r = rbase + 128 * ai + 16 * m; const bool valid = !smp || r < MS; const int grow = smp ? MP + r : pm * 256 + r; const int tt = smp ? (r & 3) : t0 + r; const int slot = smp ? 2048 + (r & 3) : tt; (void)grow; (void)tt; (void)slot; (void)valid;
        if (pn <= 4 || pn == 14) {
            const bool isk = pn == 14;
            ROWLOOP { asm volatile("" ::: "memory"); const int r = rbase + 128 * ai + 16 * m;
#pragma unroll
                for (int bj = 0; bj < 2; ++bj) { float s = 0.f;
#pragma unroll
                    for (int n = 0; n < 2; ++n) { const f32x4 x = acc[ai][bj][m][n]; s += (x[0] * x[0] + x[1] * x[1]) + (x[2] * x[2] + x[3] * x[3]); }
                    if (isk && (wc >= 2 || bj == 1)) s = 0.f;
                    s += __shfl_xor(s, 16); s += __shfl_xor(s, 32);
                    if (fq == 0) scr[(r * 2 + bj) * 4 + wc] = s; } }
            asm volatile("s_waitcnt lgkmcnt(0)" ::: "memory"); __builtin_amdgcn_s_barrier(); asm volatile("" ::: "memory");
            if (!isk) {
                const GAS float* g = (const GAS float*)(pn < 4 ? gq : gk); const int dl = 32 * wc + 4 * fq;
                const f32x4 g0 = *(const GAS f32x4*)(g + dl), g1 = *(const GAS f32x4*)(g + dl + 16);
                GAS bf16_t* Qb = (GAS bf16_t*)(ws + WS_QB); GAS bf16_t* Kb = (GAS bf16_t*)(ws + WS_KB); GAS float* QS = (GAS float*)(ws + WS_QS);
                ROWLOOP { asm volatile("" ::: "memory"); ROWVARS
                    f32x4 cs0 = {1.f, 0.f, 1.f, 0.f}, cs1 = {1.f, 0.f, 1.f, 0.f};
                    if (wc == 0) { const GAS f32x4* cp = (const GAS f32x4*)(rqk + (slot * 16 + 4 * fq) * 2); cs0 = cp[0]; cs1 = cp[1]; }
#pragma unroll
                    for (int bj = 0; bj < 2; ++bj) {
                        const f32x4 p = *(const LAS f32x4*)(scr + (r * 2 + bj) * 4);
                        const float rs = rsqrtf(((p[0] + p[1]) + (p[2] + p[3])) * (1.f / 128.f) + EPS);
                        f32x4 x0 = acc[ai][bj][m][0] * rs * g0, x1 = acc[ai][bj][m][1] * rs * g1;
                        if (wc == 0) { const f32x4 c = {cs0[0], cs0[2], cs1[0], cs1[2]}, s = {cs0[1], cs0[3], cs1[1], cs1[3]};
                            const f32x4 y0 = x0 * c - x1 * s, y1 = x1 * c + x0 * s; x0 = y0; x1 = y1; }
                        const int hh = 2 * pn + bj;
                        if (pn < 4) {
                            if (smp) { if (valid) { GAS float* q = QS + (size_t)r * 1024 + hh * 128 + dl; *(GAS f32x4*)q = x0; *(GAS f32x4*)(q + 16) = x1; } }
                            else { GAS bf16_t* q = Qb + (((size_t)bb * NH + hh) * S + tt) * HD + dl;
                                u32x2 w0 = {pk_bf16(x0[0], x0[1]), pk_bf16(x0[2], x0[3])}, w1 = {pk_bf16(x1[0], x1[1]), pk_bf16(x1[2], x1[3])};
                                *(GAS u32x2*)q = w0; *(GAS u32x2*)(q + 16) = w1; }
                        } else {
                            if (smp) { if (valid) { GAS float* k = out + O_KS + (size_t)r * 256 + bj * 128 + dl; *(GAS f32x4*)k = x0; *(GAS f32x4*)(k + 16) = x1; } }
                            else { GAS float* k = out + O_KP + (size_t)grow * 256 + bj * 128 + dl; *(GAS f32x4*)k = x0; *(GAS f32x4*)(k + 16) = x1;
                                GAS bf16_t* kb = Kb + (((size_t)bb * NKV + bj) * S + tt) * HD + dl;
                                u32x2 w0 = {pk_bf16(x0[0], x0[1]), pk_bf16(x0[2], x0[3])}, w1 = {pk_bf16(x1[0], x1[1]), pk_bf16(x1[2], x1[3])};
                                *(GAS u32x2*)kb = w0; *(GAS u32x2*)(kb + 16) = w1; }
                        } } }
            } else {
                const int dl = 32 * (wc & 1) + 4 * fq;
                const f32x4 g0 = *(const GAS f32x4*)((const GAS float*)gki + dl), g1 = *(const GAS f32x4*)((const GAS float*)gki + dl + 16);
                GAS f16* KI = (GAS f16*)(ws + WS_KI); GAS float* WI = (GAS float*)(ws + WS_WI);
                ROWLOOP { asm volatile("" ::: "memory"); ROWVARS
                    const f32x4 p = *(const LAS f32x4*)(scr + (r * 2) * 4);
                    const float rs = rsqrtf((p[0] + p[1]) * (1.f / 64.f) + EPS);
                    f32x4 x0 = acc[ai][0][m][0] * rs * g0, x1 = acc[ai][0][m][1] * rs * g1;
                    f32x4 xo; xo[0] = __shfl_xor(x0[0], 32); xo[1] = __shfl_xor(x0[1], 32); xo[2] = __shfl_xor(x0[2], 32); xo[3] = __shfl_xor(x0[3], 32);
                    if (wc == 0) { const GAS f32x4* cp = (const GAS f32x4*)(ri + (slot * 8 + 4 * (fq & 1)) * 2); const f32x4 cs0 = cp[0], cs1 = cp[1];
                        const f32x4 c = {cs0[0], cs0[2], cs1[0], cs1[2]}, s = {cs0[1], cs0[3], cs1[1], cs1[3]};
                        x0 = fq < 2 ? x0 * c - xo * s : x0 * c + xo * s; }
                    if (wc < 2 && valid) {
                        GAS float* ko = smp ? out + O_KIS + (size_t)r * 64 + dl : out + O_KIP + (size_t)grow * 64 + dl;
                        *(GAS f32x4*)ko = x0; *(GAS f32x4*)(ko + 16) = x1;
                        if (!smp) { GAS f16* kh = KI + (size_t)grow * 64 + dl; u32x2 w0 = {pk_f16(x0[0], x0[1]), pk_f16(x0[2], x0[3])}, w1 = {pk_f16(x1[0], x1[1]), pk_f16(x1[2], x1[3])};
                            *(GAS u32x2*)kh = w0; *(GAS u32x2*)(kh + 16) = w1; } }
                    if (wc == 2 && valid) *(GAS f32x4*)(WI + (size_t)grow * 16 + 4 * fq) = acc[ai][0][m][0] * (1.f / 32.f);
                }
            }
        } else if (pn == 5) {
            GAS bf16_t* Vb = (GAS bf16_t*)(ws + WS_VB); const int dl = 32 * wc + 4 * fq;
            ROWLOOP { asm volatile("" ::: "memory"); ROWVARS
#pragma unroll
                for (int bj = 0; bj < 2; ++bj) { const f32x4 x0 = acc[ai][bj][m][0], x1 = acc[ai][bj][m][1];
                    if (smp) { if (valid) { GAS float* v = out + O_VS + (size_t)r * 256 + bj * 128 + dl; *(GAS f32x4*)v = x0; *(GAS f32x4*)(v + 16) = x1; } }
                    else { GAS float* v = out + O_VP + (size_t)grow * 256 + bj * 128 + dl; *(GAS f32x4*)v = x0; *(GAS f32x4*)(v + 16) = x1;
                        GAS bf16_t* vb = Vb + (((size_t)bb * NKV + bj) * S + tt) * HD + dl;
                        u32x2 w0 = {pk_bf16(x0[0], x0[1]), pk_bf16(x0[2], x0[3])}, w1 = {pk_bf16(x1[0], x1[1]), pk_bf16(x1[2], x1[3])};
                        *(GAS u32x2*)vb = w0; *(GAS u32x2*)(vb + 16) = w1; } } }
        } else if (pn <= 9) {
            GAS f16* SZ = (GAS f16*)(ws + WS_SZ); const int c0 = 256 * (pn - 6) + 32 * wc + 4 * fq;
            ROWLOOP { asm volatile("" ::: "memory"); ROWVARS
                if (valid) {
#pragma unroll
                    for (int bj = 0; bj < 2; ++bj)
#pragma unroll
                        for (int n = 0; n < 2; ++n) { const f32x4 x = acc[ai][bj][m][n]; u32x2 w = {pk_f16(silu(x[0]), silu(x[1])), pk_f16(silu(x[2]), silu(x[3]))};
                            *(GAS u32x2*)(SZ + (size_t)grow * 1024 + c0 + 128 * bj + 16 * n) = w; } } }
        } else if (pn <= 13) {
            GAS f16* QI = (GAS f16*)(ws + WS_QI); const int c0 = 256 * (pn - 10) + 32 * wc + 4 * fq;
            ROWLOOP { asm volatile("" ::: "memory"); ROWVARS
                f32x4 c = {1.f, 1.f, 1.f, 1.f}, s = {0.f, 0.f, 0.f, 0.f};
                if ((wc & 1) == 0) { const GAS f32x4* cp = (const GAS f32x4*)(ri + (slot * 8 + 4 * (fq & 1)) * 2); const f32x4 cs0 = cp[0], cs1 = cp[1];
                    c = (f32x4){cs0[0], cs0[2], cs1[0], cs1[2]}; s = (f32x4){cs0[1], cs0[3], cs1[1], cs1[3]}; }
#pragma unroll
                for (int bj = 0; bj < 2; ++bj) { f32x4 x0 = acc[ai][bj][m][0]; const f32x4 x1 = acc[ai][bj][m][1];
                    f32x4 xo; xo[0] = __shfl_xor(x0[0], 32); xo[1] = __shfl_xor(x0[1], 32); xo[2] = __shfl_xor(x0[2], 32); xo[3] = __shfl_xor(x0[3], 32);
                    if ((wc & 1) == 0) x0 = fq < 2 ? x0 * c - xo * s : x0 * c + xo * s;
                    if (valid) { GAS f16* q = QI + (size_t)grow * 1024 + c0 + 128 * bj;
                        u32x2 w0 = {pk_f16(x0[0], x0[1]), pk_f16(x0[2], x0[3])}, w1 = {pk_f16(x1[0], x1[1]), pk_f16(x1[2], x1[3])};
                        *(GAS u32x2*)q = w0; *(GAS u32x2*)(q + 16) = w1; } } }
        } else {
            GAS f16* U = (GAS f16*)(ws + WS_U); GAS f16* G = (GAS f16*)(ws + WS_G); const int ch = 64 * (pn - 15) + 16 * wc + 4 * fq;
            ROWLOOP { asm volatile("" ::: "memory"); ROWVARS
                const f32x4 h = acc[ai][0][m][0], b = acc[ai][0][m][1], c = acc[ai][1][m][0], z = acc[ai][1][m][1];
                const f32x4 uu = c * h; f32x4 gg; gg[0] = b[0] * silu(z[0]); gg[1] = b[1] * silu(z[1]); gg[2] = b[2] * silu(z[2]); gg[3] = b[3] * silu(z[3]);
                if (valid) { u32x2 wu = {pk_f16(uu[0], uu[1]), pk_f16(uu[2], uu[3])}, wg = {pk_f16(gg[0], gg[1]), pk_f16(gg[2], gg[3])};
                    *(GAS u32x2*)(U + (size_t)grow * 1024 + ch) = wu; *(GAS u32x2*)(G + (size_t)grow * 1024 + ch) = wg;
                    if (!smp && tt >= S - 2) *(GAS f32x4*)(out + O_CVP + ((size_t)bb * 2 + (tt - (S - 2))) * 1024 + ch) = uu;
                    if (smp && tt >= 2) *(GAS f32x4*)(out + O_CVS + ((size_t)(r >> 2) * 2 + (tt - 2)) * 1024 + ch) = uu; } }
        }
#undef ROWLOOP
#undef ROWVARS
    }
};


struct EpiOut {
    float* out; const float* xp;
    __device__ __forceinline__ void init(f32x4 (&acc)[2][2][4][2], const pg8::Unit& u, int wr, int wc, int fr, int fq) const {
        const GAS float* xp = (const GAS float*)this->xp;
        const size_t base = (size_t)(u.pm * 256 + 64 * wr + fr) * DM + u.pn * 256 + 32 * wc + 4 * fq;
#pragma unroll
        for (int ai = 0; ai < 2; ++ai)
#pragma unroll
            for (int m = 0; m < 4; ++m)
#pragma unroll
                for (int bj = 0; bj < 2; ++bj)
#pragma unroll
                    for (int n = 0; n < 2; ++n) acc[ai][bj][m][n] = *(const GAS f32x4*)(xp + base + (size_t)(128 * ai + 16 * m) * DM + 128 * bj + 16 * n);
    }
    __device__ __forceinline__ void operator()(f32x4 (&acc)[2][2][4][2], const pg8::Unit& u, int wr, int wc, int fr_, int fq_) const {
        int fr = fr_, fq = fq_; asm volatile("" : "+v"(fr), "+v"(fq));
        GAS float* out = (GAS float*)this->out; asm volatile("" : "+s"(out));
        const size_t base = (size_t)(u.pm * 256 + 64 * wr + fr) * DM + u.pn * 256 + 32 * wc + 4 * fq;
#pragma unroll
        for (int ai = 0; ai < 2; ++ai)
#pragma unroll
            for (int m = 0; m < 4; ++m) { const size_t off = base + (size_t)(128 * ai + 16 * m) * DM;
#pragma unroll
                for (int bj = 0; bj < 2; ++bj)
#pragma unroll
                    for (int n = 0; n < 2; ++n) *(GAS f32x4*)(out + off + 128 * bj + 16 * n) = acc[ai][bj][m][n]; }
    }
};
__device__ __forceinline__ void p4_sample(const Args& a, LAS unsigned char* lds, int bx, int G, int tid) {
    const GAS f16* MIX = (const GAS f16*)(a.ws + WS_MIX) + (size_t)MP * DM; const GAS f16* WT = (const GAS f16*)(a.ws + WS_WOUTT);
    LAS float* part = (LAS float*)lds;
    const int lane = tid & 63, wave = __builtin_amdgcn_readfirstlane(tid >> 6), fr = lane & 15, fq = lane >> 4;
    for (int cg = bx; cg < DM / 8; cg += G) {
        const GAS f16* wp = WT + (size_t)(cg * 8 + (fr & 7)) * DM + wave * 256 + 8 * fq; const GAS f16* mp = MIX + (size_t)fr * DM + wave * 256 + 8 * fq;
        f16x8 wf[8], m0[8], m1[8];
#pragma unroll
        for (int ks = 0; ks < 8; ++ks) { wf[ks] = *(const GAS f16x8*)(wp + 32 * ks); m0[ks] = *(const GAS f16x8*)(mp + 32 * ks); m1[ks] = *(const GAS f16x8*)(mp + (size_t)16 * DM + 32 * ks); }
        f32x4 c0 = {0.f, 0.f, 0.f, 0.f}, c1 = {0.f, 0.f, 0.f, 0.f};
#pragma unroll
        for (int ks = 0; ks < 8; ++ks) { c0 = __builtin_amdgcn_mfma_f32_16x16x32_f16(wf[ks], m0[ks], c0, 0, 0, 0); c1 = __builtin_amdgcn_mfma_f32_16x16x32_f16(wf[ks], m1[ks], c1, 0, 0, 0); }
        *(LAS f32x4*)(part + ((wave * 2 + 0) * 64 + lane) * 4) = c0; *(LAS f32x4*)(part + ((wave * 2 + 1) * 64 + lane) * 4) = c1;
        __syncthreads();
        if (tid < 256) { const int rr = tid >> 3, cc = tid & 7; const int ln = (rr & 15) + 16 * (cc >> 2), tl = rr >> 4; float s = a.in[1][(size_t)rr * DM + cg * 8 + cc];
#pragma unroll
            for (int w = 0; w < 8; ++w) s += part[((w * 2 + tl) * 64 + ln) * 4 + (cc & 3)];
            a.out[O_YS + (size_t)rr * DM + cg * 8 + cc] = s; }
        __syncthreads();
    }
}
#ifndef P2_KT_REP
#define P2_KT_REP 1
#define P2_SEL_REP 1
#endif
#ifndef P2_REP_A
#define P2_REP_A 1
#define P2_REP_B 1
#define P2_REP_C 1
#endif
constexpr int SC_STRIDE = 2052;
constexpr int SC_BYTES = 16 * SC_STRIDE * 4;
constexpr int WSCR_OFF = 131584, WSCR_BYTES = 1536;
__device__ __forceinline__ f16x8 cvt8(f32x4 a, f32x4 b) { u32x4 w = {pk_f16(a[0], a[1]), pk_f16(a[2], a[3]), pk_f16(b[0], b[1]), pk_f16(b[2], b[3])}; return __builtin_bit_cast(f16x8, w); }

__device__ __forceinline__ void p2_convmix(const Args& a, int gw, int NGW, int lane) {
    const GAS f16* U = (const GAS f16*)(a.ws + WS_U); const GAS f16* Gm = (const GAS f16*)(a.ws + WS_G); GAS f16* MIX = (GAS f16*)(a.ws + WS_MIX);
    const GAS float* wconv = (const GAS float*)a.in[12]; const GAS float* state = (const GAS float*)a.in[5];
    for (int ch = gw; ch < MT / 4; ch += NGW) {
        const int row0 = 4 * ch; const bool smp = row0 >= MP; const int t0 = smp ? 0 : (row0 & (S - 1)); const int seq = (row0 - MP) >> 2;
#pragma unroll
        for (int half = 0; half < 2; ++half) { const int cb = half * 512 + 8 * lane;
            float um2[8], um1[8], w0[8], w1[8], w2[8];
#pragma unroll
            for (int e = 0; e < 8; e += 4) { const f32x4 a0 = *(const GAS f32x4*)(wconv + cb + e), a1 = *(const GAS f32x4*)(wconv + 1024 + cb + e), a2 = *(const GAS f32x4*)(wconv + 2048 + cb + e);
#pragma unroll
                for (int i = 0; i < 4; ++i) { w0[e + i] = a0[i]; w1[e + i] = a1[i]; w2[e + i] = a2[i]; } }
            if (t0 == 0) {
                if (smp) {
#pragma unroll
                    for (int e = 0; e < 8; e += 4) { const f32x4 s0 = *(const GAS f32x4*)(state + ((size_t)seq * 2) * 1024 + cb + e), s1 = *(const GAS f32x4*)(state + ((size_t)seq * 2 + 1) * 1024 + cb + e);
#pragma unroll
                        for (int i = 0; i < 4; ++i) { um2[e + i] = s0[i]; um1[e + i] = s1[i]; } }
                } else {
#pragma unroll
                    for (int e = 0; e < 8; ++e) { um2[e] = 0.f; um1[e] = 0.f; } }
            } else { const f16x8 p2 = *(const GAS f16x8*)(U + (size_t)(row0 - 2) * 1024 + cb), p1 = *(const GAS f16x8*)(U + (size_t)(row0 - 1) * 1024 + cb);
#pragma unroll
                for (int e = 0; e < 8; ++e) { um2[e] = (float)p2[e]; um1[e] = (float)p1[e]; } }
#pragma unroll
            for (int i = 0; i < 4; ++i) { const size_t row = row0 + i;
                const f16x8 uv = *(const GAS f16x8*)(U + row * 1024 + cb), gv = *(const GAS f16x8*)(Gm + row * 1024 + cb); float o[8];
#pragma unroll
                for (int e = 0; e < 8; ++e) { const float u = (float)uv[e]; const float cv = w0[e] * um2[e] + w1[e] * um1[e] + w2[e] * u; o[e] = (float)gv[e] * cv; um2[e] = um1[e]; um1[e] = u; }
                u32x4 w = {pk_f16(o[0], o[1]), pk_f16(o[2], o[3]), pk_f16(o[4], o[5]), pk_f16(o[6], o[7])};
                *(GAS u32x4*)(MIX + row * 2048 + 1024 + cb) = w; }
        }
    }
}

__device__ __forceinline__ void p2_sscore(const Args& a, int gw, int NGW, int lane) {
    const GAS float* cki = (const GAS float*)a.in[4]; const GAS int* ptab = (const GAS int*)a.in[6];
    const GAS f16* QI = (const GAS f16*)(a.ws + WS_QI); const GAS float* WI = (const GAS float*)(a.ws + WS_WI); GAS float* SSC = (GAS float*)(a.ws + WS_SSC);
    const int fr = lane & 15, fq = lane >> 4;
    for (int it = gw; it < NSB * 256; it += NGW) {
        const int sb = it >> 8, hp = it & 255, pg = hp >> 1, k0 = (hp & 1) * 64; const int phys = ptab[sb * NPAGES + pg];
        const GAS float* kbase = cki + ((size_t)phys * PAGE + k0) * 64;
        f16x8 qf[4][2]; f32x4 wv[4];
#pragma unroll
        for (int t = 0; t < 4; ++t) { const size_t row = MP + 4 * sb + t;
            qf[t][0] = *(const GAS f16x8*)(QI + row * 1024 + fr * 64 + 8 * fq); qf[t][1] = *(const GAS f16x8*)(QI + row * 1024 + fr * 64 + 32 + 8 * fq);
            wv[t] = *(const GAS f32x4*)(WI + row * 16 + 4 * fq); }
#pragma unroll
        for (int tile = 0; tile < 4; ++tile) {
            const GAS float* kr = kbase + (size_t)(16 * tile + fr) * 64 + 8 * fq;
            const f16x8 kf0 = cvt8(*(const GAS f32x4*)kr, *(const GAS f32x4*)(kr + 4)), kf1 = cvt8(*(const GAS f32x4*)(kr + 32), *(const GAS f32x4*)(kr + 36));
            float mine = 0.f;
#pragma unroll
            for (int t = 0; t < 4; ++t) { f32x4 c = {0.f, 0.f, 0.f, 0.f};
                c = __builtin_amdgcn_mfma_f32_16x16x32_f16(qf[t][0], kf0, c, 0, 0, 0); c = __builtin_amdgcn_mfma_f32_16x16x32_f16(qf[t][1], kf1, c, 0, 0, 0);
                float s = wv[t][0] * fmaxf(c[0], 0.f) + wv[t][1] * fmaxf(c[1], 0.f) + wv[t][2] * fmaxf(c[2], 0.f) + wv[t][3] * fmaxf(c[3], 0.f);
                s += __shfl_xor(s, 16); s += __shfl_xor(s, 32);
                mine = fq == t ? s : mine; }
            SSC[(size_t)(4 * sb + fq) * PAST + pg * PAGE + k0 + 16 * tile + fr] = mine;
        }
    }
}

__device__ __forceinline__ void wave_topk_mask(const LAS float* row, int t, GAS unsigned long long* mrow, int lane, LAS unsigned* hist, LAS float* cand) {
    const float NINF = -__builtin_inff(), PINF = __builtin_inff();
    const int jmax = t >> 6;
    float v[32]; float mx = NINF, mn = PINF;
#pragma unroll
    for (int j = 0; j < 32; ++j) { v[j] = NINF; if (j <= jmax) { const int s = 64 * j + lane; const float x = row[s]; const bool ok = s <= t; v[j] = ok ? x : NINF; mx = fmaxf(mx, v[j]); mn = fminf(mn, ok ? x : PINF); } }
#pragma unroll
    for (int o = 1; o < 64; o <<= 1) { mx = fmaxf(mx, __shfl_xor(mx, o)); mn = fminf(mn, __shfl_xor(mn, o)); }
    *(LAS u32x4*)(hist + 4 * lane) = (u32x4){0u, 0u, 0u, 0u};
    const float scale = 255.5f / (mx - mn);
    float tau = 0.f; bool have = false;
    if (mx > mn) {
        asm volatile("s_waitcnt lgkmcnt(0)" ::: "memory");
        unsigned bins[8];
#pragma unroll
        for (int j = 0; j < 8; ++j) bins[j] = 0u;
#pragma unroll
        for (int j = 0; j < 32; ++j) { if (j <= jmax) { int b = (int)((v[j] - mn) * scale); b = b > 255 ? 255 : (b < 0 ? 0 : b); bins[j >> 2] |= (unsigned)b << (8 * (j & 3));
            if (64 * j + lane <= t) __hip_atomic_fetch_add(hist + b, 1u, __ATOMIC_RELAXED, __HIP_MEMORY_SCOPE_WORKGROUP); } }
        asm volatile("s_waitcnt lgkmcnt(0)" ::: "memory");
        const u32x4 h = *(const LAS u32x4*)(hist + 4 * lane);
        const unsigned sl = h[0] + h[1] + h[2] + h[3]; unsigned pre = sl;
#pragma unroll
        for (int o = 1; o < 64; o <<= 1) { const unsigned y = __shfl_up(pre, o); if (lane >= o) pre += y; }
        const unsigned tot = __builtin_amdgcn_readlane(pre, 63); const unsigned suf = tot - pre + sl;
        const unsigned long long bm = __ballot(suf >= TOPK);
        const int Ls = 63 - __builtin_clzll(bm);
        unsigned c = __builtin_amdgcn_readlane(suf, Ls) - __builtin_amdgcn_readlane(sl, Ls);
        const unsigned h3 = __builtin_amdgcn_readlane(h[3], Ls), h2 = __builtin_amdgcn_readlane(h[2], Ls), h1 = __builtin_amdgcn_readlane(h[1], Ls);
        int Bs;
        if (c + h3 >= TOPK) Bs = 4 * Ls + 3; else { c += h3; if (c + h2 >= TOPK) Bs = 4 * Ls + 2; else { c += h2; if (c + h1 >= TOPK) Bs = 4 * Ls + 1; else { c += h1; Bs = 4 * Ls; } } }
        const int need = TOPK - (int)c;
        int base = 0;
#pragma unroll
        for (int j = 0; j < 32; ++j) { if (j <= jmax) { const int b = (int)((bins[j >> 2] >> (8 * (j & 3))) & 255u); const bool isc = (64 * j + lane <= t) && b == Bs;
            const unsigned long long m = __ballot(isc);
            if (m) { const int pos = base + (int)__builtin_amdgcn_mbcnt_hi((unsigned)(m >> 32), __builtin_amdgcn_mbcnt_lo((unsigned)m, 0u)); if (isc && pos < 64) cand[pos] = v[j]; base += __builtin_popcountll(m); } } }
        if (base <= 64) {
            asm volatile("s_waitcnt lgkmcnt(0)" ::: "memory");
            const float x = lane < base ? cand[lane] : NINF; int rank = 0;
            for (int m = 0; m < base; ++m) { const float y = __builtin_bit_cast(float, __builtin_amdgcn_readlane(__builtin_bit_cast(int, x), m)); rank += y > x ? 1 : 0; }
            float tc = (lane < base && rank <= need - 1) ? x : PINF;
#pragma unroll
            for (int o = 1; o < 64; o <<= 1) tc = fminf(tc, __shfl_xor(tc, o));
            tau = tc; have = true;
        }
    }
    if (!have) {
        unsigned tk = 0u;
        for (int bit = 31; bit >= 0; --bit) { const unsigned cd = tk | (1u << bit); int cnt = 0;
#pragma unroll
            for (int j = 0; j < 32; ++j) cnt += __builtin_popcountll(__ballot((64 * j + lane <= t) && fkey(v[j]) >= cd));
            if (cnt >= TOPK) tk = cd; }
        tau = __builtin_bit_cast(float, (tk & 0x80000000u) ? (tk ^ 0x80000000u) : ~tk);
    }
    unsigned wlo = 0u, whi = 0u;
#pragma unroll
    for (int j = 0; j < 32; ++j) { if (j <= jmax) { const unsigned long long m = __ballot(v[j] >= tau); if (lane == j) { wlo = (unsigned)m; whi = (unsigned)(m >> 32); } } }
    if (lane < 32) mrow[lane] = ((unsigned long long)whi << 32) | wlo;
}

#define RELU_FMA(acc_, c_, w_) do { const float f_ = (c_); const int i_ = __builtin_bit_cast(int, f_); const float r_ = __builtin_bit_cast(float, i_ > 0 ? i_ : 0); asm("v_fmac_f32_e32 %0, %1, %2" : "+v"(acc_) : "v"(r_), "v"(w_)); } while (0)
__device__ __forceinline__ void p2_index_tile(const Args& a, LAS unsigned char* lds, int b, int t0, int wave, int lane) {
    const GAS f16* QI = (const GAS f16*)(a.ws + WS_QI); const GAS float* WI = (const GAS float*)(a.ws + WS_WI); const GAS f16* KI = (const GAS f16*)(a.ws + WS_KI);
    GAS unsigned long long* MASK = (GAS unsigned long long*)(a.ws + WS_MASK);
    LAS float* sc = (LAS float*)lds;
    const int fr = lane & 15, fq = lane >> 4; const size_t rowq = (size_t)b * S + t0 + fr;
    f16x8 qf[16][2]; float w[16];
#pragma unroll
    for (int h = 0; h < 16; ++h) { qf[h][0] = *(const GAS f16x8*)(QI + rowq * 1024 + h * 64 + 8 * fq); qf[h][1] = *(const GAS f16x8*)(QI + rowq * 1024 + h * 64 + 32 + 8 * fq); }
#pragma unroll
    for (int h = 0; h < 16; h += 4) { const f32x4 x = *(const GAS f32x4*)(WI + rowq * 16 + h); w[h] = x[0]; w[h + 1] = x[1]; w[h + 2] = x[2]; w[h + 3] = x[3]; }
    const int nkt = (t0 + 16) >> 4;
    const GAS f16* kp = KI + ((size_t)b * S + fr) * 64 + 8 * fq;
#define KLOAD(d0_, d1_, kt_) do { const int k_ = (kt_) < nkt ? (kt_) : wave; d0_ = *(const GAS f16x8*)(kp + (size_t)k_ * 1024); d1_ = *(const GAS f16x8*)(kp + (size_t)k_ * 1024 + 32); } while (0)
    f16x8 ka0, ka1, kb0, kb1, kc0, kc1;
#define KCOMP(kf0, kf1, kt_) do { float a0 = 0.f, a1 = 0.f, a2 = 0.f, a3 = 0.f; const f32x4 z4 = {0.f, 0.f, 0.f, 0.f}; \
        f32x4 cc = __builtin_amdgcn_mfma_f32_16x16x32_f16(kf0, qf[0][0], z4, 0, 0, 0); cc = __builtin_amdgcn_mfma_f32_16x16x32_f16(kf1, qf[0][1], cc, 0, 0, 0); \
        _Pragma("unroll") for (int h = 0; h < 16; ++h) { f32x4 cn = z4;        \
            if (h < 15) { cn = __builtin_amdgcn_mfma_f32_16x16x32_f16(kf0, qf[h + 1][0], z4, 0, 0, 0); cn = __builtin_amdgcn_mfma_f32_16x16x32_f16(kf1, qf[h + 1][1], cn, 0, 0, 0); } \
            RELU_FMA(a0, cc[0], w[h]); RELU_FMA(a1, cc[1], w[h]); RELU_FMA(a2, cc[2], w[h]); RELU_FMA(a3, cc[3], w[h]); \
            cc = cn; __builtin_amdgcn_sched_barrier(0); } \
        *(LAS f32x4*)(sc + fr * SC_STRIDE + 16 * (kt_) + 4 * fq) = (f32x4){a0, a1, a2, a3}; } while (0)
    KLOAD(ka0, ka1, wave); KLOAD(kb0, kb1, wave + NWAVES);
    for (int rpk = 0; rpk < P2_KT_REP; ++rpk)
    for (int kt = wave; kt < nkt; kt += 3 * NWAVES) {
        KLOAD(kc0, kc1, kt + 2 * NWAVES); KCOMP(ka0, ka1, kt);
        if (kt + NWAVES < nkt) { KLOAD(ka0, ka1, kt + 3 * NWAVES); KCOMP(kb0, kb1, kt + NWAVES); }
        if (kt + 2 * NWAVES < nkt) { KLOAD(kb0, kb1, kt + 4 * NWAVES); KCOMP(kc0, kc1, kt + 2 * NWAVES); }
    }
#undef KCOMP
#undef KLOAD
    __syncthreads();
#pragma unroll 1
    for (int qq = 0; qq < 2 * P2_SEL_REP; ++qq) { const int q = 2 * wave + (qq & 1); const int t = t0 + q;
        wave_topk_mask(sc + q * SC_STRIDE, t, MASK + ((size_t)b * S + t) * 32, lane, (LAS unsigned*)(lds + WSCR_OFF + wave * WSCR_BYTES), (LAS float*)(lds + WSCR_OFF + wave * WSCR_BYTES + 1024)); }
    __syncthreads();
}

__device__ __forceinline__ void p2_phase(const Args& a, LAS unsigned char* lds, int vcu, int G, int wave, int lane) {
    const int gw = vcu * NWAVES + wave, NGW = G * NWAVES;
    for (int rp = 0; rp < P2_REP_A; ++rp) p2_sscore(a, gw, NGW, lane);
    for (int rp = 0; rp < P2_REP_B; ++rp) p2_convmix(a, gw, NGW, lane);
    { GAS unsigned long long* MASK = (GAS unsigned long long*)(a.ws + WS_MASK);
      for (int i = gw * 64 + lane; i < NB * TOPK * 32; i += NGW * 64) { const int wd = i & 31, t = (i >> 5) & (TOPK - 1), b = i >> 13; const int lo = 64 * wd;
          const unsigned long long m = lo + 63 <= t ? ~0ull : (lo > t ? 0ull : ((1ull << (t - lo + 1)) - 1ull));
          MASK[((size_t)b * S + t) * 32 + wd] = m; } }
    constexpr int NT = NB * (S - TOPK) / 16;
    for (int rp = 0; rp < P2_REP_C; ++rp)
    for (int r = 0; r * G < NT; ++r) { const int k = (r & 1) ? (r + 1) * G - 1 - vcu : r * G + vcu;
        if (k < NT) { const int j = (NT / NB - 1) - (k >> 2), b = k & 3; p2_index_tile(a, lds, b, TOPK + 16 * j, wave, lane); } }
}

#ifndef P3_REP_S
#define P3_REP_S 1
#define P3_REP_A 1
#endif
namespace att {
typedef short bf16x8 __attribute__((ext_vector_type(8)));
typedef short s16x4 __attribute__((ext_vector_type(4)));
typedef float f32x16 __attribute__((ext_vector_type(16)));
constexpr int QBLK = 32, KVBLK = 64, D = 128;
constexpr int SHM_V = KVBLK * D * 2, SHM_K = KVBLK * D * 2;
constexpr int WS_OFF = 2 * SHM_V + 2 * SHM_K;
constexpr float SCALE = 0.08838834764831845f;
#define KSWZ(row, colB) ((row) * 256 + ((colB) ^ (((row) & 7) << 4)))
#define SBAR() __builtin_amdgcn_sched_barrier(0)
__device__ __forceinline__ int v_st(int k, int c) { const int kk = (k & ~0xC) | ((k & 4) << 1) | ((k & 8) >> 1); return ((kk >> 3) * 4 + (c >> 5)) * 512 + ((kk & 7) * 32 + (c & 31)) * 2; }
__device__ __forceinline__ int v_rd_base(int lane) { return ((lane & 3) << 3) | (((lane >> 2) & 3) << 6) | (((lane >> 4) & 1) << 5) | (((lane >> 5) & 1) << 8); }
constexpr int v_rd_off(int d0, int ks, int half) { return d0 * 512 + ks * 4096 + half * 2048; }
__device__ __forceinline__ int crow(int r, int hi) { return (r & 3) + 8 * (r >> 2) + 4 * hi; }
__device__ __forceinline__ unsigned cvtpk(float lo, float hi) { return pk_bf16(lo, hi); }

template <int KB>
__device__ __forceinline__ void qkt(f32x16& p0, f32x16& p1, const LAS unsigned char* K_lds, int r32, int hi, const LAS unsigned char* qp) {
    p0 = f32x16{}; p1 = f32x16{};
    const LAS unsigned char* kb[4];
#pragma unroll
    for (int dd = 0; dd < 4; ++dd) kb[dd] = K_lds + KB * SHM_K + KSWZ(r32, (dd * 16 + hi * 8) * 2);
#pragma unroll
    for (int d0 = 0; d0 < 8; ++d0) { const LAS unsigned char* a = kb[d0 & 3] + (d0 >> 2) * 128;
        const bf16x8 b0 = *(const LAS bf16x8*)a;
        const bf16x8 b1 = *(const LAS bf16x8*)(a + 32 * 256);
        const bf16x8 qv = *(const LAS bf16x8*)(qp + d0 * 1024);
        p0 = __builtin_amdgcn_mfma_f32_32x32x16_bf16(b0, qv, p0, 0, 0, 0);
        p1 = __builtin_amdgcn_mfma_f32_32x32x16_bf16(b1, qv, p1, 0, 0, 0); }
}
template <int VB>
__device__ __forceinline__ void pv_tile(f32x16* o, int vb0, bf16x8 pa0, bf16x8 pa1, bf16x8 pa2, bf16x8 pa3) {
#define TRRD(dst, off) asm volatile("ds_read_b64_tr_b16 %0, %1 offset:%2" : "=&v"(dst) : "v"(vb0), "i"(off) : "memory")
#define PV_D0(d0) do { s16x4 l0, l1, l2, l3, h0, h1, h2, h3; constexpr int b_ = VB * SHM_V + v_rd_off(d0, 0, 0); \
        TRRD(l0, b_); TRRD(h0, b_ + 2048); TRRD(l1, b_ + 4096); TRRD(h1, b_ + 6144); TRRD(l2, b_ + 8192); TRRD(h2, b_ + 10240); TRRD(l3, b_ + 12288); TRRD(h3, b_ + 14336); \
        asm volatile("s_waitcnt lgkmcnt(0)" ::: "memory"); SBAR(); \
        o[d0] = __builtin_amdgcn_mfma_f32_32x32x16_bf16(pa0, (bf16x8){l0[0], l0[1], l0[2], l0[3], h0[0], h0[1], h0[2], h0[3]}, o[d0], 0, 0, 0); \
        o[d0] = __builtin_amdgcn_mfma_f32_32x32x16_bf16(pa1, (bf16x8){l1[0], l1[1], l1[2], l1[3], h1[0], h1[1], h1[2], h1[3]}, o[d0], 0, 0, 0); \
        o[d0] = __builtin_amdgcn_mfma_f32_32x32x16_bf16(pa2, (bf16x8){l2[0], l2[1], l2[2], l2[3], h2[0], h2[1], h2[2], h2[3]}, o[d0], 0, 0, 0); \
        o[d0] = __builtin_amdgcn_mfma_f32_32x32x16_bf16(pa3, (bf16x8){l3[0], l3[1], l3[2], l3[3], h3[0], h3[1], h3[2], h3[3]}, o[d0], 0, 0, 0); } while (0)
    PV_D0(0); PV_D0(1); PV_D0(2); PV_D0(3);
#undef PV_D0
#undef TRRD
}
__device__ __forceinline__ void partialSM(f32x16& p0, f32x16& p1, unsigned wl, unsigned wh, float sh2) {
    const float NEG = -__builtin_inff(); constexpr float C2 = 1.4426950408889634f * SCALE;
#pragma unroll
    for (int r = 0; r < 16; ++r) { const unsigned bit = 1u << ((r & 3) + 8 * (r >> 2));
        p0[r] = (wl & bit) ? fmaf(p0[r], C2, -sh2) : NEG; p1[r] = (wh & bit) ? fmaf(p1[r], C2, -sh2) : NEG; }
#pragma unroll
    for (int r = 0; r < 16; ++r) p0[r] = __builtin_amdgcn_exp2f(p0[r]);
}
__device__ __forceinline__ void finishSM(f32x16& p0, f32x16& p1, float& l_reg, bf16x8& pa0, bf16x8& pa1, bf16x8& pa2, bf16x8& pa3) {
#pragma unroll
    for (int r = 0; r < 16; ++r) p1[r] = __builtin_amdgcn_exp2f(p1[r]);
    float ps = 0;
#pragma unroll
    for (int r = 0; r < 16; ++r) ps += p0[r];
#pragma unroll
    for (int r = 0; r < 16; ++r) ps += p1[r];
    l_reg += ps;
#define PK4(P, B_, OUT) do { unsigned a0 = cvtpk(P[B_+0], P[B_+1]), a1 = cvtpk(P[B_+2], P[B_+3]); \
        unsigned b0 = cvtpk(P[B_+4], P[B_+5]), b1 = cvtpk(P[B_+6], P[B_+7]); \
        auto r0 = __builtin_amdgcn_permlane32_swap(a0, b0, false, false); auto r1 = __builtin_amdgcn_permlane32_swap(a1, b1, false, false); \
        u32x4 w = {r0[0], r1[0], r0[1], r1[1]}; OUT = __builtin_bit_cast(bf16x8, w); } while (0)
    PK4(p0, 0, pa0); PK4(p0, 8, pa1); PK4(p1, 0, pa2); PK4(p1, 8, pa3);
#undef PK4
}

__device__ __forceinline__ __amdgpu_buffer_rsrc_t mk_rsrc(const GAS void* p, unsigned bytes) {
    const unsigned long long u = (unsigned long long)p; const unsigned lo = __builtin_amdgcn_readfirstlane((unsigned)u), hi = __builtin_amdgcn_readfirstlane((unsigned)(u >> 32));
    return __builtin_amdgcn_make_buffer_rsrc((void*)(((unsigned long long)hi << 32) | lo), (short)0, (int)bytes, 0x00020000);
}
__device__ __forceinline__ void attn_block(const Args& a, LAS unsigned char* lds, int b, int kvh, int q0, float sh2) {
    int tid_ = threadIdx.x; asm volatile("" : "+v"(tid_));
    const int tid = tid_, wid = __builtin_amdgcn_readfirstlane(tid >> 6), lane = tid & 63, r32 = lane & 31, hi = lane >> 5;
    const int head = 4 * kvh + (wid >> 1), qw = q0 + 32 * (wid & 1);
    const GAS bf16_t* Qw = (const GAS bf16_t*)(a.ws + WS_QB) + (((size_t)b * NH + head) * S + qw) * D;
    const GAS bf16_t* Kh = (const GAS bf16_t*)(a.ws + WS_KB) + ((size_t)b * NKV + kvh) * S * D;
    const GAS bf16_t* Vh = (const GAS bf16_t*)(a.ws + WS_VB) + ((size_t)b * NKV + kvh) * S * D;
    const __amdgpu_buffer_rsrc_t rK = mk_rsrc(Kh, S * D * 2), rV = mk_rsrc(Vh, S * D * 2), rM = mk_rsrc((const GAS unsigned long long*)(a.ws + WS_MASK) + ((size_t)b * S + qw) * 32, 32 * 256);
    const unsigned moff = (unsigned)r32 * 256u;
    const int NT = q0 / KVBLK + 1;
    LAS unsigned char* V_lds = lds; LAS unsigned char* K_lds = lds + 2 * SHM_V;
    const int sr = tid >> 4, sc = (tid & 15) * 8, vst0 = v_st(sr, sc), vst1 = v_st(32 + sr, sc), kws = KSWZ(sr, sc * 2);
    const int vb0 = (int)(unsigned)(size_t)V_lds + v_rd_base(lane); const unsigned kvoff = (unsigned)(sr * D + sc) * 2u;
    bf16x8 st_v0, st_v1, st_k0, st_k1;
    LAS unsigned char* qp = lds + WS_OFF + 2048 + wid * 8192 + lane * 16;
#define VMW() asm volatile("s_waitcnt vmcnt(0)" ::: "memory")
#define BL128(r_, so_) __builtin_bit_cast(bf16x8, __builtin_amdgcn_raw_buffer_load_b128(r_, kvoff, (so_), 0))
#define SLOAD_H(k0) do { const int so_ = (k0) * 256; st_v0 = BL128(rV, so_); st_v1 = BL128(rV, so_ + 8192); st_k0 = BL128(rK, so_); st_k1 = BL128(rK, so_ + 8192); } while (0)
#define SWRITE_HK(bf) do { *(LAS bf16x8*)(K_lds + (bf) * SHM_K + kws) = st_k0; *(LAS bf16x8*)(K_lds + (bf) * SHM_K + kws + 32 * 256) = st_k1; } while (0)
#define SWRITE_HV(bf) do { *(LAS bf16x8*)(V_lds + (bf) * SHM_V + vst0) = st_v0; *(LAS bf16x8*)(V_lds + (bf) * SHM_V + vst1) = st_v1; } while (0)
#define SWRITE_H(bf) do { SWRITE_HV(bf); SWRITE_HK(bf); } while (0)
#define MLOAD(t) __builtin_bit_cast(unsigned long long, __builtin_amdgcn_raw_buffer_load_b64(rM, moff, (t) * 8, 0))
#define MSPLIT(mw, wl, wh) do { wl = (unsigned)(mw) >> (4 * hi); wh = (unsigned)((mw) >> 32) >> (4 * hi); } while (0)
    { bf16x8 qt[8];
#pragma unroll
      for (int d0 = 0; d0 < 8; ++d0) qt[d0] = *(const GAS bf16x8*)(Qw + (unsigned)(r32 * D + d0 * 16 + hi * 8));
#pragma unroll
      for (int d0 = 0; d0 < 8; ++d0) *(LAS bf16x8*)(qp + d0 * 1024) = qt[d0]; }
    SLOAD_H(0); unsigned long long mwA = MLOAD(0), mwB = 0ull; VMW(); SWRITE_H(0);
    if (NT > 1) { SLOAD_H(KVBLK); mwB = MLOAD(1); }
    __syncthreads();
    float l_reg = 0.f; f32x16 o[4] = {};
    f32x16 p0, p1; bf16x8 pa0, pa1, pa2, pa3; unsigned wl, wh;
    SBAR(); qkt<0>(p0, p1, K_lds, r32, hi, qp);
    MSPLIT(mwA, wl, wh); partialSM(p0, p1, wl, wh, sh2);
    if (NT > 1) { VMW(); SWRITE_H(1); }
    __syncthreads();
#define STEP(t, KB, VB) do { \
        finishSM(p0, p1, l_reg, pa0, pa1, pa2, pa3); SBAR(); \
        if ((t) + 1 < NT) { SLOAD_H(((t) + 1) * KVBLK); mwA = MLOAD((t) + 1); SBAR(); } \
        pv_tile<VB>(o, vb0, pa0, pa1, pa2, pa3); SBAR(); \
        qkt<KB>(p0, p1, K_lds, r32, hi, qp); \
        MSPLIT(mwB, wl, wh); partialSM(p0, p1, wl, wh, sh2); mwB = mwA; \
        __syncthreads(); \
        if ((t) + 1 < NT) { VMW(); SWRITE_H(VB); } \
        __syncthreads(); } while (0)
    int t = 1;
    for (; t + 1 < NT; t += 2) { STEP(t, 1, 0); STEP(t + 1, 0, 1); }
    if (t < NT) { STEP(t, 1, 0); }
    finishSM(p0, p1, l_reg, pa0, pa1, pa2, pa3); SBAR();
    if ((NT - 1) & 1) pv_tile<1>(o, vb0, pa0, pa1, pa2, pa3); else pv_tile<0>(o, vb0, pa0, pa1, pa2, pa3);
    { auto rr = __builtin_amdgcn_permlane32_swap(__float_as_uint(l_reg), __float_as_uint(l_reg), false, false); l_reg = __uint_as_float(rr[0]) + __uint_as_float(rr[1]); }
    { int te = threadIdx.x; asm volatile("" : "+v"(te));
      const int le = te & 63, r32e = le & 31, hie = le >> 5;
      LAS float* wse = (LAS float*)(lds + WS_OFF) + wid * 64;
      if (hie == 0) wse[r32e] = l_reg;
      asm volatile("s_waitcnt lgkmcnt(0)" ::: "memory");
      __syncthreads();
      LAS f16* stg = (LAS f16*)(lds + wid * 8192);
#pragma unroll
      for (int r = 0; r < 16; ++r) { const int orow = crow(r, hie); const float rl = __builtin_amdgcn_rcpf(wse[orow]);
#pragma unroll
          for (int d0 = 0; d0 < 4; ++d0) stg[orow * 128 + d0 * 32 + r32e] = (f16)(o[d0][r] * rl); }
      asm volatile("s_waitcnt lgkmcnt(0)" ::: "memory");
      const GAS f16* SZ = (const GAS f16*)(a.ws + WS_SZ) + ((size_t)b * S + qw) * 1024 + head * 128; GAS f16* MIX = (GAS f16*)(a.ws + WS_MIX) + ((size_t)b * S + qw) * 2048 + head * 128;
#pragma unroll
      for (int i = 0; i < 8; ++i) { const int c = le + 64 * i, row = c >> 4, ch = c & 15;
          const f16x8 ov = *(const LAS f16x8*)(stg + row * 128 + ch * 8); const f16x8 zv = *(const GAS f16x8*)(SZ + (unsigned)(row * 1024 + ch * 8));
          *(GAS f16x8*)(MIX + (unsigned)(row * 2048 + ch * 8)) = ov * zv; } }
    asm volatile("s_waitcnt lgkmcnt(0)" ::: "memory");
    __syncthreads();
#undef BL128
#undef VMW
#undef SLOAD_H
#undef SWRITE_HK
#undef SWRITE_HV
#undef SWRITE_H
#undef MLOAD
#undef MSPLIT
#undef STEP
}
#undef KSWZ
#undef SBAR
}

__device__ __forceinline__ void p3_sample_item(const Args& a, LAS unsigned char* lds, int item, int tid) {
    const int qi = item >> 1, kvh = item & 1, sb = qi / NST, tl = qi % NST; constexpr int L = PAST + NST, PER = 33;
    const int lane = tid & 63, wave = __builtin_amdgcn_readfirstlane(tid >> 6);
    const GAS float* ck = (const GAS float*)a.in[2]; const GAS float* cv = (const GAS float*)a.in[3]; const GAS int* ptab = (const GAS int*)a.in[6]; const GAS float* out_ro = (const GAS float*)a.out;
    LAS float* q = (LAS float*)lds; LAS float* w = q + 1024; LAS float* newsc = w + 16; LAS float* ctl = newsc + 4; LAS float* red = ctl + 16;
    LAS unsigned* hist = (LAS unsigned*)(red + 32); LAS float* cand = (LAS float*)(hist + 256); LAS unsigned* cnt = (LAS unsigned*)(cand + 64);
    LAS unsigned* rid = cnt + 32; LAS float* qa = (LAS float*)(rid + 512); LAS float* sc = qa + 512; LAS float* inv = sc + 4 * 512; LAS float* part = inv + 4;
    LAS int* nsel = (LAS int*)(ctl + 8); LAS int* ncand = (LAS int*)(ctl + 9);
    const GAS f16* QI = (const GAS f16*)(a.ws + WS_QI) + (size_t)(MP + qi) * 1024; const GAS float* QS = (const GAS float*)(a.ws + WS_QS) + (size_t)qi * 1024 + kvh * 512;
    for (int i = tid; i < 1024; i += 512) q[i] = (float)QI[i];
    qa[tid] = QS[tid];
    if (tid < 16) w[tid] = ((const GAS float*)(a.ws + WS_WI))[(size_t)(MP + qi) * 16 + tid];
    if (tid < 32) cnt[tid] = 0u;
    if (tid < 256) hist[tid] = 0u;
    if (tid == 0) { *nsel = 0; *ncand = 0; }
    const GAS float* ssc = (const GAS float*)(a.ws + WS_SSC) + (size_t)qi * PAST;
    float v[PER];
#pragma unroll
    for (int j = 0; j < PER - 1; ++j) v[j] = ssc[j * 512 + tid];
    __syncthreads();
    if (tid < NST) { const GAS float* kr = out_ro + O_KIS + (size_t)(sb * NST + tid) * 64; float s = 0.f;
#pragma unroll 1
        for (int h = 0; h < 16; ++h) { float dsum = 0.f;
#pragma unroll 8
            for (int d = 0; d < 64; ++d) dsum += q[h * 64 + d] * kr[d];
            s += w[h] * fmaxf(dsum, 0.f); }
        newsc[tid] = s; }
    __syncthreads();
    const float NINF = -__builtin_inff(), PINF = __builtin_inff();
    { const int s = (PER - 1) * 512 + tid; v[PER - 1] = (s < L && (s - PAST) <= tl) ? newsc[s - PAST] : NINF; }
    float mx = NINF, mn = PINF;
#pragma unroll
    for (int j = 0; j < PER; ++j) { mx = fmaxf(mx, v[j]); mn = fminf(mn, v[j] == NINF ? PINF : v[j]); }
#pragma unroll
    for (int o = 1; o < 64; o <<= 1) { mx = fmaxf(mx, __shfl_xor(mx, o)); mn = fminf(mn, __shfl_xor(mn, o)); }
    if (lane == 0) { red[wave] = mx; red[8 + wave] = mn; }
    __syncthreads();
#pragma unroll
    for (int i = 0; i < 8; ++i) { mx = fmaxf(mx, red[i]); mn = fminf(mn, red[8 + i]); }
    const float scale = 255.5f / (mx - mn);
    float tau = 0.f; bool have = false;
    if (mx > mn) {
#pragma unroll
        for (int j = 0; j < PER; ++j) if (v[j] != NINF) { int bn = (int)((v[j] - mn) * scale); bn = bn > 255 ? 255 : bn; __hip_atomic_fetch_add(hist + bn, 1u, __ATOMIC_RELAXED, __HIP_MEMORY_SCOPE_WORKGROUP); }
        __syncthreads();
        if (wave == 0) {
            const u32x4 h = *(const LAS u32x4*)(hist + 4 * lane);
            const unsigned sl = h[0] + h[1] + h[2] + h[3]; unsigned pre = sl;
#pragma unroll
            for (int o = 1; o < 64; o <<= 1) { const unsigned y = __shfl_up(pre, o); if (lane >= o) pre += y; }
            const unsigned tot = __builtin_amdgcn_readlane(pre, 63); const unsigned suf = tot - pre + sl;
            const unsigned long long bm = __ballot(suf >= TOPK);
            const int Ls = 63 - __builtin_clzll(bm);
            unsigned c = __builtin_amdgcn_readlane(suf, Ls) - __builtin_amdgcn_readlane(sl, Ls);
            const unsigned h3 = __builtin_amdgcn_readlane(h[3], Ls), h2 = __builtin_amdgcn_readlane(h[2], Ls), h1 = __builtin_amdgcn_readlane(h[1], Ls);
            int Bs;
            if (c + h3 >= TOPK) Bs = 4 * Ls + 3; else { c += h3; if (c + h2 >= TOPK) Bs = 4 * Ls + 2; else { c += h2; if (c + h1 >= TOPK) Bs = 4 * Ls + 1; else { c += h1; Bs = 4 * Ls; } } }
            if (lane == 0) { ((LAS int*)ctl)[0] = Bs; ((LAS int*)ctl)[1] = TOPK - (int)c; }
        }
        __syncthreads();
        const int Bs = ((LAS int*)ctl)[0], need = ((LAS int*)ctl)[1];
#pragma unroll
        for (int j = 0; j < PER; ++j) if (v[j] != NINF) { int bn = (int)((v[j] - mn) * scale); bn = bn > 255 ? 255 : bn;
            if (bn == Bs) { const int p = __hip_atomic_fetch_add(ncand, 1, __ATOMIC_RELAXED, __HIP_MEMORY_SCOPE_WORKGROUP); if (p < 64) cand[p] = v[j]; } }
        __syncthreads();
        const int base = *ncand;
        if (base <= 64) {
            if (wave == 0) { const float x = lane < base ? cand[lane] : NINF; int rank = 0;
                for (int m = 0; m < base; ++m) { const float y = __builtin_bit_cast(float, __builtin_amdgcn_readlane(__builtin_bit_cast(int, x), m)); rank += y > x ? 1 : 0; }
                float tc = (lane < base && rank <= need - 1) ? x : PINF;
#pragma unroll
                for (int o = 1; o < 64; o <<= 1) tc = fminf(tc, __shfl_xor(tc, o));
                if (lane == 0) ctl[2] = tc; }
            __syncthreads();
            tau = ctl[2]; have = true;
        }
    }
    if (!have) {
        unsigned tk = 0u;
        for (int bit = 31; bit >= 0; --bit) { const unsigned cd = tk | (1u << bit); int c = 0;
#pragma unroll
            for (int j = 0; j < PER; ++j) c += __builtin_popcountll(__ballot(v[j] != NINF && fkey(v[j]) >= cd));
            if (lane == 0) __hip_atomic_fetch_add(cnt + bit, (unsigned)c, __ATOMIC_RELAXED, __HIP_MEMORY_SCOPE_WORKGROUP);
            __syncthreads();
            if (cnt[bit] >= TOPK) tk = cd; }
        tau = __builtin_bit_cast(float, (tk & 0x80000000u) ? (tk ^ 0x80000000u) : ~tk);
    }
#pragma unroll
    for (int j = 0; j < PER; ++j) { if (v[j] >= tau) { const int s = j * 512 + tid; const int p = __hip_atomic_fetch_add(nsel, 1, __ATOMIC_RELAXED, __HIP_MEMORY_SCOPE_WORKGROUP);
        if (p < 512) rid[p] = s < PAST ? (unsigned)(ptab[sb * NPAGES + (s >> 7)] * PAGE + (s & (PAGE - 1))) : (0x80000000u | (unsigned)(s - PAST)); } }
    __syncthreads();
    const int n = *nsel < 512 ? *nsel : 512;
    const int half = lane >> 5, l32 = lane & 31;
    { f32x4 qv[4];
#pragma unroll
      for (int h = 0; h < 4; ++h) qv[h] = *(const LAS f32x4*)(qa + h * 128 + 4 * l32);
      for (int j0 = 2 * wave; j0 < n; j0 += 128) { f32x4 kv[8]; int jj[8];
#pragma unroll
          for (int u = 0; u < 8; ++u) { jj[u] = j0 + 16 * u + half; const unsigned r = rid[jj[u] < n ? jj[u] : 0];
              const GAS float* kr = (r & 0x80000000u) ? out_ro + O_KS + ((size_t)(sb * NST + (r & 3u)) * NKV + kvh) * HD : ck + ((size_t)r * NKV + kvh) * HD;
              kv[u] = *(const GAS f32x4*)(kr + 4 * l32); }
#pragma unroll
          for (int u = 0; u < 8; ++u) { float d[4];
#pragma unroll
              for (int h = 0; h < 4; ++h) { d[h] = (kv[u][0] * qv[h][0] + kv[u][1] * qv[h][1]) + (kv[u][2] * qv[h][2] + kv[u][3] * qv[h][3]);
                  d[h] += __shfl_xor(d[h], 1); d[h] += __shfl_xor(d[h], 2); d[h] += __shfl_xor(d[h], 4); d[h] += __shfl_xor(d[h], 8); d[h] += __shfl_xor(d[h], 16); }
              if (jj[u] < n && l32 < 4) sc[l32 * 512 + jj[u]] = (l32 == 0 ? d[0] : l32 == 1 ? d[1] : l32 == 2 ? d[2] : d[3]) * 0.08838834764831845f; } } }
    __syncthreads();
    if (wave < 4) { LAS float* row = sc + wave * 512; float m2 = -1e30f;
      for (int j = lane; j < n; j += 64) m2 = fmaxf(m2, row[j]);
#pragma unroll
      for (int o = 1; o < 64; o <<= 1) m2 = fmaxf(m2, __shfl_xor(m2, o));
      float sm = 0.f;
      for (int j = lane; j < n; j += 64) { const float e = __expf(row[j] - m2); row[j] = e; sm += e; }
      sm = wave_sum(sm); if (lane == 0) inv[wave] = 1.f / sm; }
    __syncthreads();
    { f32x4 acc[4] = {};
      for (int j0 = 2 * wave; j0 < n; j0 += 128) { f32x4 vv[8]; int jj[8];
#pragma unroll
          for (int u = 0; u < 8; ++u) { jj[u] = j0 + 16 * u + half; const unsigned r = rid[jj[u] < n ? jj[u] : 0];
              const GAS float* vr = (r & 0x80000000u) ? out_ro + O_VS + ((size_t)(sb * NST + (r & 3u)) * NKV + kvh) * HD : cv + ((size_t)r * NKV + kvh) * HD;
              vv[u] = *(const GAS f32x4*)(vr + 4 * l32); }
#pragma unroll
          for (int u = 0; u < 8; ++u)
#pragma unroll
              for (int h = 0; h < 4; ++h) { const float p = jj[u] < n ? sc[h * 512 + jj[u]] : 0.f; acc[h] += vv[u] * p; } }
#pragma unroll
      for (int h = 0; h < 4; ++h) {
#pragma unroll
          for (int e = 0; e < 4; ++e) acc[h][e] += __shfl_xor(acc[h][e], 32);
          if (half == 0) *(LAS f32x4*)(part + (wave * 4 + h) * 128 + 4 * l32) = acc[h]; } }
    __syncthreads();
    { const GAS f16* SZ = (const GAS f16*)(a.ws + WS_SZ) + (size_t)(MP + qi) * 1024 + kvh * 512; GAS f16* MIX = (GAS f16*)(a.ws + WS_MIX) + (size_t)(MP + qi) * 2048 + kvh * 512;
      const int h = tid >> 7, d = tid & 127; float o = 0.f;
#pragma unroll
      for (int p = 0; p < 8; ++p) o += part[(p * 4 + h) * 128 + d];
      MIX[tid] = (f16)(o * inv[h] * (float)SZ[tid]); }
    __syncthreads();
}

__device__ __forceinline__ void p3_phase(const Args& a, LAS unsigned char* lds, int vcu, int G, int tid) {
    float gm = 0.f, km = 0.f;
    for (int i = 0; i < HD; ++i) { gm = fmaxf(gm, fabsf(a.in[9][i])); km = fmaxf(km, fabsf(a.in[10][i])); }
    const float sh2 = fmaxf(0.f, 11.313708498984761f * gm * km - 20.f) * 1.4426950408889634f;
    for (int rp = 0; rp < P3_REP_S; ++rp)
    for (int sidx = G - 1 - vcu; sidx < 2 * MS; sidx += G) p3_sample_item(a, lds, sidx, tid);
    for (int rp = 0; rp < P3_REP_A; ++rp)
    for (int k = vcu; k < 256; k += G) { const int i = 31 - (k >> 3), bk = k & 7;
        att::attn_block(a, lds, bk >> 1, bk & 1, 64 * i, sh2); }
}

typedef GAS unsigned gu32;
#define XB_TMO      128
#define XB_XCNT(j)  (256  + 64 * (j))
#define XB_XSUB(j)  (1280 + 64 * (j))
#define XB_XGEN(j)  (2304 + 64 * (j))
#define XB_TOP      3328
#define XB_TOPGEN   3392
#define XCD_BAR_WORDS 3456
#define XB_SPIN_CAP (1u << 18)
__device__ __forceinline__ unsigned xb_ld(unsigned* p)              { return __hip_atomic_load(p, __ATOMIC_RELAXED, __HIP_MEMORY_SCOPE_AGENT); }
__device__ __forceinline__ unsigned xb_add(unsigned* p, unsigned v) { return __hip_atomic_fetch_add(p, v, __ATOMIC_RELAXED, __HIP_MEMORY_SCOPE_AGENT); }
__device__ __forceinline__ unsigned xb_xcc_id() { return (unsigned)__builtin_amdgcn_s_getreg((3 << 11) | 20) & 0xFu; }
#define XB_SPIN(cond, bar) do { unsigned _sp = 0; while (cond) { __builtin_amdgcn_s_sleep(1); \
    if ((++_sp & 255u) == 0u) { if (xb_ld(&(bar)[XB_TMO])) break; if (_sp > XB_SPIN_CAP) { atomicAdd(&(bar)[XB_TMO], 1u); break; } } } } while (0)
struct XcdBarrier { unsigned* bar; unsigned x; volatile LAS unsigned* st; };
__device__ __forceinline__ XcdBarrier xcd_barrier_post(unsigned* bar, volatile LAS unsigned* st) {
    XcdBarrier b; b.bar = bar; b.x = xb_xcc_id(); b.st = st;
    if (threadIdx.x == 0) (void)xb_add(&bar[XB_XCNT(b.x)], 1u);
    return b;
}
__device__ __forceinline__ void xcd_barrier_complete(unsigned* bar, unsigned x, unsigned& nloc, unsigned& nx) {
    const unsigned G = gridDim.x * gridDim.y * gridDim.z;
    unsigned sum, cnt, mine, sp = 0u;
    for (;;) {
        sum = 0u; cnt = 0u; mine = 0u;
#pragma unroll
        for (unsigned j = 0; j < 16; ++j) { const unsigned c = xb_ld(&bar[XB_XCNT(j)]); sum += c; cnt += (c > 0u) ? 1u : 0u; mine = (j == x) ? c : mine; }
        if (sum == G) break;
        __builtin_amdgcn_s_sleep(1);
        if ((++sp & 255u) == 0u) { if (xb_ld(&bar[XB_TMO])) break; if (sp > XB_SPIN_CAP) { atomicAdd(&bar[XB_TMO], 1u); break; } }
    }
    nloc = mine > 0u ? mine : 1u; nx = cnt > 0u ? cnt : 1u;
}
__device__ __forceinline__ void xcd_barrier(const XcdBarrier& b) {
    asm volatile("s_waitcnt vmcnt(0)" ::: "memory");
    __syncthreads();
    if (threadIdx.x == 0) {
        unsigned* bar = b.bar;
        __builtin_amdgcn_s_waitcnt(0);
        unsigned nloc = b.st[0], nx = b.st[1];
        if (nloc == 0u) { xcd_barrier_complete(bar, b.x, nloc, nx); b.st[0] = nloc; b.st[1] = nx; }
        const unsigned old = xb_add(&bar[XB_XSUB(b.x)], 1u);
        const unsigned gen = old / nloc;
        if (old + 1u == (gen + 1u) * nloc) {
            __builtin_amdgcn_fence(__ATOMIC_RELEASE, "agent");
            asm volatile("s_waitcnt vmcnt(0)" ::: "memory");
            const unsigned og = xb_add(&bar[XB_TOP], 1u);
            const unsigned tg = og / nx;
            if (og + 1u == (tg + 1u) * nx) xb_add(&bar[XB_TOPGEN], 1u);
            else XB_SPIN(xb_ld(&bar[XB_TOPGEN]) == tg, bar);
            __builtin_amdgcn_fence(__ATOMIC_ACQUIRE, "agent");
            xb_add(&bar[XB_XGEN(b.x)], 1u);
            asm volatile("s_waitcnt vmcnt(0)" ::: "memory");
        } else {
            XB_SPIN(xb_ld(&bar[XB_XGEN(b.x)]) == gen, bar);
            __builtin_amdgcn_fence(__ATOMIC_ACQUIRE, "agent");
            asm volatile("s_waitcnt vmcnt(0)" ::: "memory");
        }
    }
    __syncthreads();
}

__global__ void __launch_bounds__(NWAVES * 64, 2) mk_fwd(Args a) {
    extern __shared__ __attribute__((aligned(16))) unsigned char lds_raw[];
    LAS unsigned char* lds = (LAS unsigned char*)lds_raw;
    const int tid = threadIdx.x, lane = tid & 63, wave = __builtin_amdgcn_readfirstlane(tid >> 6);
    const int G = gridDim.x; const int bx = blockIdx.x; const int vcu = (G % 8 == 0) ? (bx % 8) * (G / 8) + bx / 8 : bx;
    volatile LAS unsigned* MISC = (volatile LAS unsigned*)(lds + MISC_OFF);
    if (tid < 64) MISC[tid] = 0u;
    __syncthreads();
    XcdBarrier bar = xcd_barrier_post((unsigned*)a.ws, MISC + 8);
    { int t_ = threadIdx.x; asm volatile("" : "+v"(t_)); const int lane = t_ & 63, wave = __builtin_amdgcn_readfirstlane(t_ >> 6); p0_prologue(a, lds, vcu, G, wave, lane); }
    xcd_barrier(bar);
    { pg8::Gemm g{(const f16*)(a.ws + WS_XNH), (const f16*)(a.ws + WS_WINT), DM};
      pg8::StaticOrder S; S.init(MPAD / 256, NPAD / 256, G, bx);
      EpiIn E{a.out, a.ws, a.in[9], a.in[10], a.in[11], (LAS float*)(lds + SCR_OFF)};
      pg8::gemm_phase<EpiIn, pg8::StaticOrder>(lds, g, S, E); }
    xcd_barrier(bar);
    { int t_ = threadIdx.x; asm volatile("" : "+v"(t_)); const int lane = t_ & 63, wave = __builtin_amdgcn_readfirstlane(t_ >> 6); p2_phase(a, lds, vcu, G, wave, lane); }
    xcd_barrier(bar);
    { int t_ = threadIdx.x; asm volatile("" : "+v"(t_)); p3_phase(a, lds, vcu, G, t_); }
    xcd_barrier(bar);
    { pg8::Gemm g{(const f16*)(a.ws + WS_MIX), (const f16*)(a.ws + WS_WOUTT), DM};
      pg8::StaticOrder S; S.init(MP / 256, DM / 256, G, bx);
      EpiOut E{a.out, a.in[0]};
      pg8::gemm_phase<EpiOut, pg8::StaticOrder>(lds, g, S, E);
      int t_ = threadIdx.x; asm volatile("" : "+v"(t_)); p4_sample(a, lds, bx, G, t_); }
}

#ifndef PROG
#define PROG 0x11111u
#endif
extern "C" void kernel_launch(void* const* d_in, const int* in_sizes, int n_in, void* d_out, int out_size, void* d_ws, size_t ws_size, hipStream_t stream) {
    static int grid = 0;
    if (grid == 0) {
        if (ws_size < WS_NEED2 || out_size != (int)O_END || n_in != 14) { fprintf(stderr, "kernel_launch: ws %zu (need %zu) out %d (want %zu) n_in %d\n", ws_size, (size_t)WS_NEED2, out_size, (size_t)O_END, n_in); grid = -1; return; }
        int dev = 0, cus = 0; hipGetDevice(&dev); hipDeviceGetAttribute(&cus, hipDeviceAttributeMultiprocessorCount, dev);
        if (hipFuncSetAttribute((const void*)mk_fwd, hipFuncAttributeMaxDynamicSharedMemorySize, LDS_BYTES) != hipSuccess) { fprintf(stderr, "kernel_launch: hipFuncSetAttribute failed\n"); grid = -1; return; }
        int per_cu = 0; hipOccupancyMaxActiveBlocksPerMultiprocessor(&per_cu, (const void*)mk_fwd, NWAVES * 64, LDS_BYTES); (void)hipGetLastError();
        if (per_cu < 1) fprintf(stderr, "kernel_launch: occupancy query says %d blocks per CU\n", per_cu);
        grid = cus > 0 ? cus : 256;
    }
    if (grid < 0) return;
    float* out = (float*)d_out; unsigned char* ws = (unsigned char*)d_ws;
    Args a{};
    for (int i = 0; i < 14; ++i) a.in[i] = (const float*)d_in[i];
    a.out = out; a.ws = ws;
    if (hipMemsetAsync(ws, 0, 65536, stream) != hipSuccess) { fprintf(stderr, "kernel_launch: memset of the control words failed\n"); return; }
    a.ph_lo = (int)PROG; a.ph_hi = 0; hipLaunchKernelGGL(mk_fwd, dim3(grid), dim3(NWAVES * 64), LDS_BYTES, stream, a);
}
```

```cpp
#include <hip/hip_runtime.h>
#include <cstdio>
#include <cstdint>
#include <cmath>

typedef _Float16 f16;
typedef unsigned short bf16_t;

constexpr int DM = 2048, NB = 4, S = 2048, NSB = 8, NST = 4, PAST = 16384, PAGE = 128, NPAGES = PAST / PAGE;
constexpr int MP = NB * S;
constexpr int MS = NSB * NST;
constexpr int MT = MP + MS;
constexpr int DIN = 7760;
constexpr int OQ = 0, OKK = 1024, OV = 1280, OZ = 1536, OQI = 2560, OKI = 3584, OWI = 3648, OH = 3664, OBB = 4688, OC = 5712, OZC = 6736;
constexpr int NH = 8, NKV = 2, HD = 128, NIH = 16, ID = 64, TOPK = 256, DC = 1024;
constexpr float EPS = 1e-6f;
constexpr size_t O_YP = 0, O_YS = 16777216, O_KP = 16842752, O_VP = 18939904, O_KIP = 21037056, O_CVP = 21561344,
                 O_KS = 21569536, O_VS = 21577728, O_KIS = 21585920, O_CVS = 21587968, O_END = 21604352;
constexpr size_t MiB = 1u << 20;
constexpr size_t WS_ROPE = 1 * MiB;
constexpr size_t WS_ROPE_I = WS_ROPE + 2052 * 32 * 4;
constexpr size_t WS_QB = 2 * MiB;
constexpr size_t WS_KB = 18 * MiB;
constexpr size_t WS_VB = 22 * MiB;
constexpr size_t WS_SZ = 26 * MiB;
constexpr size_t WS_QI = 43 * MiB;
constexpr size_t WS_KI = 60 * MiB;
constexpr size_t WS_WI = 61 * MiB;
constexpr size_t WS_U = 62 * MiB;
constexpr size_t WS_G = 79 * MiB;
constexpr size_t WS_MIX = 96 * MiB;
constexpr size_t WS_MASK = 130 * MiB;
constexpr size_t WS_SSC = 132 * MiB;
constexpr size_t WS_QS = 134 * MiB;
constexpr size_t WS_XN = 136 * MiB;
constexpr size_t WS_P = 202 * MiB;
constexpr size_t WS_NEED = 448 * MiB;

__device__ __forceinline__ bf16_t f2bf(float f) { unsigned u = __builtin_bit_cast(unsigned, f); return (bf16_t)((u + 0x7fffu + ((u >> 16) & 1u)) >> 16); }
__device__ __forceinline__ float bf2f(bf16_t h) { return __builtin_bit_cast(float, (unsigned)h << 16); }
__device__ __forceinline__ float silu(float z) { return z * __builtin_amdgcn_rcpf(1.f + __builtin_amdgcn_exp2f(-1.4426950408889634f * z)); }
__device__ __forceinline__ unsigned fkey(float f) { unsigned u = __builtin_bit_cast(unsigned, f); return (u & 0x80000000u) ? ~u : (u | 0x80000000u); }

#define P3_REP_S 1
#define P3_REP_A 1
#define P2_KT_REP 1
#define P2_SEL_REP 1
#define P2_REP_A 1
#define P2_REP_B 1
#define P2_REP_C 1
#define LAS __attribute__((address_space(3)))
#define GAS __attribute__((address_space(1)))
typedef _Float16 f16x8 __attribute__((ext_vector_type(8)));
typedef _Float16 f16x4 __attribute__((ext_vector_type(4)));
typedef _Float16 f16x2 __attribute__((ext_vector_type(2)));
typedef float f32x4 __attribute__((ext_vector_type(4)));
typedef float f32x2 __attribute__((ext_vector_type(2)));
typedef unsigned u32x4 __attribute__((ext_vector_type(4)));
typedef unsigned u32x2 __attribute__((ext_vector_type(2)));
typedef __bf16 bf16x2_t __attribute__((ext_vector_type(2)));
namespace pg8 {
constexpr int BM = 256, BK = 64, HALF = 128, HTB = HALF * BK * 2, STAGE_BYTES = 8 * HTB, NXCD = 8, WGM = 8;
__host__ __device__ __forceinline__ int lds_byte(int r, int c) { const int st = (r >> 4) * 2 + (c >> 5), rr = r & 15, cc = c & 31, ob = rr * 64 + cc * 2; return st * 1024 + (ob ^ (((ob >> 9) & 1) << 5)); }
__host__ __device__ __forceinline__ void stage_rc(int b, int& R, int& C) { const int st = b / 1024, sb = b % 1024, swz = sb ^ (((sb >> 9) & 1) << 5); R = (st >> 1) * 16 + swz / 64; C = (st & 1) * 32 + (swz % 64) / 2; }
struct Unit { int pm, pn; };
struct Gemm { const f16* A; const f16* Bt; int K; };
struct StaticOrder {
    int nM, nN, nwg, G, c;
    __device__ void init(int nM_, int nN_, int G_, int c_) { nM = nM_; nN = nN_; nwg = nM * nN; G = G_; c = c_; }
    __device__ bool next(int i, Unit& u) const {
        const long L = (long)i * G + c; if (L >= nwg) return false;
        int wgid = (int)L; { const int q = nwg / NXCD, r = nwg % NXCD, xcd = wgid % NXCD, off = wgid / NXCD; wgid = (xcd < r ? xcd * (q + 1) : r * (q + 1) + (xcd - r) * q) + off; }
        const int nig = WGM * nN, gid = wgid / nig, fm = gid * WGM, gsz = (nM - fm) < WGM ? (nM - fm) : WGM;
        u.pm = fm + ((wgid % nig) % gsz); u.pn = (wgid % nig) / gsz; return true;
    }
};
template <class Epi, class Sched>
__device__ __forceinline__ void gemm_phase(LAS unsigned char* lds, const Gemm g, const Sched& S, const Epi& E) {
    int tid_ = threadIdx.x; asm volatile("" : "+v"(tid_));
    const int tid = tid_, wid = __builtin_amdgcn_readfirstlane(tid >> 6), lane = tid & 63, wr = wid >> 2, wc = wid & 3, fr = lane & 15, fq = lane >> 4;
    const int K = g.K, nt = K / BK;
    unsigned voffA[2];
#pragma unroll
    for (int i = 0; i < 2; ++i) { int R, C; stage_rc(tid * 16 + i * 8192, R, C); voffA[i] = (unsigned)(R * K + C) * 2u; }
    const size_t kstep = (size_t)(BK * 2);
    const size_t hstep = (size_t)HALF * K * 2;
    const size_t tstep = 2 * hstep;
    const unsigned ldsw = (unsigned)wid * 1024u;
    const int aoff = lds_byte(wr * 64 + fr, fq * 8), boff = lds_byte(wc * 32 + fr, fq * 8);
#define PG8_SA(b, h) (((b) * 2 + (h)) * HTB)
#define PG8_SB(b, h) ((4 + (b) * 2 + (h)) * HTB)
#define PG8_STAGE(bufoff, gbase) do { _Pragma("unroll") for (int _i = 0; _i < 2; ++_i) \
        __builtin_amdgcn_global_load_lds((const unsigned*)((const char*)(gbase) + voffA[_i]), (LAS unsigned*)(lds + (bufoff) + ldsw + _i * 8192), 16, 0, 0); } while (0)
#define PG8_LDA(dst, b, h) do { _Pragma("unroll") for (int m = 0; m < 4; ++m) _Pragma("unroll") for (int k = 0; k < 2; ++k) dst[m][k] = *(const LAS f16x8*)(lds + PG8_SA(b, h) + aoff + m * 2048 + k * 1024); } while (0)
#define PG8_LDB(dst, b, h) do { _Pragma("unroll") for (int n = 0; n < 2; ++n) _Pragma("unroll") for (int k = 0; k < 2; ++k) dst[n][k] = *(const LAS f16x8*)(lds + PG8_SB(b, h) + boff + n * 2048 + k * 1024); } while (0)
#define PG8_MMA(ai, bj, At, Bt) do { __builtin_amdgcn_s_setprio(1); _Pragma("unroll") for (int m = 0; m < 4; ++m) _Pragma("unroll") for (int n = 0; n < 2; ++n) _Pragma("unroll") for (int k = 0; k < 2; ++k) \
        acc[ai][bj][m][n] = __builtin_amdgcn_mfma_f32_16x16x32_f16(Bt[n][k], At[m][k], acc[ai][bj][m][n], 0, 0, 0); __builtin_amdgcn_s_setprio(0); } while (0)
#define PG8_WAIT_V(n) asm volatile("s_waitcnt vmcnt(" #n ")" ::: "memory")
#define PG8_WAIT_L(n) asm volatile("s_waitcnt lgkmcnt(" #n ")" ::: "memory")
#define PG8_BAR __builtin_amdgcn_s_barrier()
#define PG8_SCHED __builtin_amdgcn_sched_barrier(0)
    Unit cur, nxt; int ui = 0;
    if (!S.next(0, cur)) return;
    f32x4 acc[2][2][4][2];
    E.init(acc, cur, wr, wc, fr, fq);
    f16x8 At[4][2], B0[2][2], B1[2][2];
    const char* cA = (const char*)g.A + (size_t)cur.pm * tstep; const char* cB = (const char*)g.Bt + (size_t)cur.pn * tstep;
    PG8_STAGE(PG8_SB(0, 0), cB); PG8_STAGE(PG8_SB(0, 1), cB + hstep); PG8_STAGE(PG8_SA(0, 0), cA); PG8_STAGE(PG8_SA(0, 1), cA + hstep);
    if (wr == 1) PG8_BAR;
    PG8_WAIT_V(2); PG8_BAR;
    PG8_STAGE(PG8_SB(1, 0), cB + kstep); PG8_STAGE(PG8_SA(1, 0), cA + kstep); PG8_STAGE(PG8_SB(1, 1), cB + hstep + kstep);
    PG8_WAIT_V(6); PG8_BAR;
    for (;;) {
        const bool has_next = S.next(ui + 1, nxt);
        const char* nA = has_next ? (const char*)g.A + (size_t)nxt.pm * tstep : cA; const char* nB = has_next ? (const char*)g.Bt + (size_t)nxt.pn * tstep : cB;
        for (int t = 0; t < nt; t += 2) {
            const bool last = (t == nt - 2);
            const char* a1 = cA + (size_t)(t + 1) * kstep;
            const char* a2 = last ? nA : cA + (size_t)(t + 2) * kstep; const char* b2 = last ? nB : cB + (size_t)(t + 2) * kstep;
            const char* a3 = a2 + kstep; const char* b3 = b2 + kstep;
            PG8_LDB(B0, 0, 0); PG8_LDB(B1, 0, 1); PG8_SCHED; PG8_LDA(At, 0, 0); PG8_STAGE(PG8_SA(1, 1), a1 + hstep);
            PG8_WAIT_V(8); PG8_WAIT_L(0); PG8_BAR; PG8_MMA(0, 0, At, B0); PG8_MMA(0, 1, At, B1); PG8_BAR; PG8_SCHED;
            PG8_LDA(At, 0, 1); PG8_STAGE(PG8_SB(0, 0), b2); PG8_STAGE(PG8_SB(0, 1), b2 + hstep); PG8_STAGE(PG8_SA(0, 0), a2);
            PG8_WAIT_V(8); PG8_WAIT_L(0); PG8_BAR; PG8_MMA(1, 0, At, B0); PG8_MMA(1, 1, At, B1); PG8_BAR; PG8_SCHED;
            PG8_LDB(B0, 1, 0); PG8_LDB(B1, 1, 1); PG8_SCHED; PG8_LDA(At, 1, 0); PG8_STAGE(PG8_SA(0, 1), a2 + hstep);
            PG8_WAIT_V(8); PG8_WAIT_L(0); PG8_BAR; PG8_MMA(0, 0, At, B0); PG8_MMA(0, 1, At, B1); PG8_BAR; PG8_SCHED;
            PG8_LDA(At, 1, 1); PG8_STAGE(PG8_SB(1, 0), b3); PG8_STAGE(PG8_SB(1, 1), b3 + hstep); PG8_STAGE(PG8_SA(1, 0), a3);
            PG8_WAIT_V(8); PG8_WAIT_L(0); PG8_BAR; PG8_MMA(1, 0, At, B0); PG8_MMA(1, 1, At, B1); PG8_BAR; PG8_SCHED;
        }
        const bool al = E.aligned(cur);
        if (al && wr == 0) PG8_BAR;
        E(acc, cur, wr, wc, fr, fq);
        if (!has_next) { if (!al && wr == 0) PG8_BAR; break; }
        cur = nxt; cA = nA; cB = nB; ++ui;
        E.init(acc, cur, wr, wc, fr, fq);
        if (al && wr == 1) PG8_BAR;
    }
    PG8_WAIT_V(0);
    PG8_BAR;
#undef PG8_SA
#undef PG8_SB
#undef PG8_STAGE
#undef PG8_LDA
#undef PG8_LDB
#undef PG8_MMA
#undef PG8_WAIT_V
#undef PG8_WAIT_L
#undef PG8_BAR
#undef PG8_SCHED
}
}
constexpr int NWAVES = 8;
constexpr int MPAD = 8448, NPAD = 7936;
constexpr size_t WS_XNH = 450 * MiB;
constexpr size_t WS_WINT = 484 * MiB;
constexpr size_t WS_WOUTT = 516 * MiB;
constexpr size_t WS_NEED2 = 524 * MiB;
constexpr int RING_BYTES = 131072, SCR_OFF = RING_BYTES, SCR_BYTES = 8192, MISC_OFF = 145408, LDS_BYTES = 147456;

__device__ __forceinline__ unsigned pk_bf16(float lo, float hi) { f32x2 v = {lo, hi}; bf16x2_t b = __builtin_convertvector(v, bf16x2_t); return __builtin_bit_cast(unsigned, b); }
__device__ __forceinline__ unsigned pk_f16(float lo, float hi) { f32x2 v = {lo, hi}; f16x2 b = __builtin_convertvector(v, f16x2); return __builtin_bit_cast(unsigned, b); }

struct Args { const float* in[14]; float* out; unsigned char* ws; int ph_lo, ph_hi; };

__device__ __forceinline__ int win_src(int np) {
    const int pn = np >> 8, c = np & 255;
    if (pn < 14) return np;
    if (pn == 14) return c < 80 ? np : -1;
    const int T = pn - 15, bj = c >> 7, wc = (c >> 5) & 3, n = (c >> 4) & 1, fqi = c & 15;
    const int base = bj == 0 ? (n == 0 ? OH : OBB) : (n == 0 ? OC : OZC);
    return base + 64 * T + 16 * wc + fqi;
}
template <bool MAP>
__device__ __forceinline__ void p0_transpose_item(const float* W, int N, f16* WT, LAS float* scr, int item, int nblk, int lane) {
    const int kb = item / nblk, nb = item % nblk, k0 = 64 * kb, n0 = 32 * nb;
    const int src = MAP ? win_src(n0 + (lane & 31)) : n0 + (lane & 31);
#pragma unroll 8
    for (int i = 0; i < 32; ++i) { const int kk = 2 * i + (lane >> 5); scr[kk * 33 + (lane & 31)] = src >= 0 ? W[(size_t)(k0 + kk) * N + src] : 0.f; }
    asm volatile("s_waitcnt lgkmcnt(0)" ::: "memory");
    const int c = lane & 7;
#pragma unroll
    for (int j = 0; j < 4; ++j) { const int n = (lane >> 3) + 8 * j; const LAS float* s = scr + (8 * c) * 33 + n;
        u32x4 o; o.x = pk_f16(s[0 * 33], s[1 * 33]); o.y = pk_f16(s[2 * 33], s[3 * 33]); o.z = pk_f16(s[4 * 33], s[5 * 33]); o.w = pk_f16(s[6 * 33], s[7 * 33]);
        *(u32x4*)(WT + (size_t)(n0 + n) * 2048 + k0 + 8 * c) = o; }
    asm volatile("s_waitcnt lgkmcnt(0)" ::: "memory");
}
__device__ __forceinline__ float wave_sum(float v) {
#pragma unroll
    for (int o = 1; o < 64; o <<= 1) v += __shfl_xor(v, o);
    return v;
}
__device__ __forceinline__ void p0_prologue(const Args& a, LAS unsigned char* lds, int vcu, int G, int wave, int lane) {
    LAS float* scr = (LAS float*)(lds + wave * 16384);
    const int gw = vcu * NWAVES + wave, NGW = G * NWAVES;
    const float* win = a.in[8]; const float* wout = a.in[13];
    f16* WinT = (f16*)(a.ws + WS_WINT); f16* WoutT = (f16*)(a.ws + WS_WOUTT); f16* XN = (f16*)(a.ws + WS_XNH);
    constexpr int I_IN = 32 * (NPAD / 32), I_OUT = 32 * (DM / 32);
    for (int it = gw; it < I_IN + I_OUT; it += NGW) {
        if (it < I_IN) p0_transpose_item<true>(win, DIN, WinT, scr, it, NPAD / 32, lane);
        else p0_transpose_item<false>(wout, DM, WoutT, scr, it - I_IN, DM / 32, lane);
    }
    const float* gin = a.in[7];
    for (int m = gw; m < MT; m += NGW) {
        const float* xrow = m < MP ? a.in[0] + (size_t)m * DM : a.in[1] + (size_t)(m - MP) * DM;
        const f32x4* xr = (const f32x4*)xrow + lane; f32x4 v[8]; float s = 0.f;
#pragma unroll
        for (int j = 0; j < 8; ++j) { v[j] = xr[64 * j]; s += (v[j].x * v[j].x + v[j].y * v[j].y) + (v[j].z * v[j].z + v[j].w * v[j].w); }
        const float rs = rsqrtf(wave_sum(s) * (1.f / DM) + EPS);
        u32x2* o8 = (u32x2*)(XN + (size_t)m * DM) + lane;
#pragma unroll
        for (int j = 0; j < 8; ++j) { const f32x4 gv = ((const f32x4*)gin)[lane + 64 * j]; u32x2 w; w.x = pk_f16(v[j].x * rs * gv.x, v[j].y * rs * gv.y); w.y = pk_f16(v[j].z * rs * gv.z, v[j].w * rs * gv.w); o8[64 * j] = w; }
    }
    float* rqk = (float*)(a.ws + WS_ROPE); float* ri = (float*)(a.ws + WS_ROPE_I);
    for (int i = gw * 64 + lane; i < 2052 * 16; i += NGW * 64) {
        { int slot = i / 16, j = i % 16; int pos = slot < 2048 ? slot : PAST + (slot - 2048);
          float inv = (float)pow(500000.0, -(double)j / 16.0); float ang = (float)pos * inv;
          rqk[(slot * 16 + j) * 2] = (float)cos((double)ang); rqk[(slot * 16 + j) * 2 + 1] = (float)sin((double)ang); }
        if (i < 2052 * 8) { int slot = i / 8, j = i % 8; int pos = slot < 2048 ? slot : PAST + (slot - 2048);
          float inv = (float)pow(500000.0, -(double)j / 8.0); float ang = (float)pos * inv;
          ri[(slot * 8 + j) * 2] = (float)cos((double)ang); ri[(slot * 8 + j) * 2 + 1] = (float)sin((double)ang); }
    }
}

struct EpiIn {
    float* out; unsigned char* ws; const float* gq; const float* gk; const float* gki; LAS float* scr;
    __device__ __forceinline__ bool aligned(const pg8::Unit& u) const { return u.pn <= 4 || u.pn == 14; }
    __device__ __forceinline__ void init(f32x4 (&acc)[2][2][4][2], const pg8::Unit&, int, int, int, int) const {
#pragma unroll
        for (int a = 0; a < 2; ++a)
#pragma unroll
            for (int b = 0; b < 2; ++b)
#pragma unroll
                for (int m = 0; m < 4; ++m)
#pragma unroll
                    for (int n = 0; n < 2; ++n) acc[a][b][m][n] = (f32x4){0.f, 0.f, 0.f, 0.f};
    }
    __device__ __forceinline__ void operator()(f32x4 (&acc)[2][2][4][2], const pg8::Unit& u, int wr, int wc, int fr_, int fq_) const {
        int fr = fr_, fq = fq_; asm volatile("" : "+v"(fr), "+v"(fq));
        GAS unsigned char* ws = (GAS unsigned char*)this->ws; GAS float* out = (GAS float*)this->out; asm volatile("" : "+s"(ws), "+s"(out));
        const int pn = u.pn, pm = u.pm; const bool smp = pm == 32;
        const int rbase = 64 * wr + fr;
        const int bb = pm >> 3, t0 = (pm & 7) << 8;
        const GAS float* rqk = (const GAS float*)(ws + WS_ROPE); const GAS float* ri = (const GAS float*)(ws + WS_ROPE_I);
#define ROWLOOP _Pragma("unroll") for (int ai = 0; ai < 2; ++ai) _Pragma("unroll") for (int m = 0; m < 4; ++m)
#define ROWVARS const int r = rbase + 128 * ai + 16 * m; const bool valid = !smp || r < MS; const int grow = smp ? MP + r : pm * 256 + r; const int tt = smp ? (r & 3) : t0 + r; const int slot = smp ? 2048 + (r & 3) : tt; (void)grow; (void)tt; (void)slot; (void)valid;
        if (pn <= 4 || pn == 14) {
            const bool isk = pn == 14;
            ROWLOOP { asm volatile("" ::: "memory"); const int r = rbase + 128 * ai + 16 * m;
#pragma unroll
                for (int bj = 0; bj < 2; ++bj) { float s = 0.f;
#pragma unroll
                    for (int n = 0; n < 2; ++n) { const f32x4 x = acc[ai][bj][m][n]; s += (x[0] * x[0] + x[1] * x[1]) + (x[2] * x[2] + x[3] * x[3]); }
                    if (isk && (wc >= 2 || bj == 1)) s = 0.f;
                    s += __shfl_xor(s, 16); s += __shfl_xor(s, 32);
                    if (fq == 0) scr[(r * 2 + bj) * 4 + wc] = s; } }
            asm volatile("s_waitcnt lgkmcnt(0)" ::: "memory"); __builtin_amdgcn_s_barrier(); asm volatile("" ::: "memory");
            if (!isk) {
                const GAS float* g = (const GAS float*)(pn < 4 ? gq : gk); const int dl = 32 * wc + 4 * fq;
                const f32x4 g0 = *(const GAS f32x4*)(g + dl), g1 = *(const GAS f32x4*)(g + dl + 16);
                GAS bf16_t* Qb = (GAS bf16_t*)(ws + WS_QB); GAS bf16_t* Kb = (GAS bf16_t*)(ws + WS_KB); GAS float* QS = (GAS float*)(ws + WS_QS);
                ROWLOOP { asm volatile("" ::: "memory"); ROWVARS
                    f32x4 cs0 = {1.f, 0.f, 1.f, 0.f}, cs1 = {1.f, 0.f, 1.f, 0.f};
                    if (wc == 0) { const GAS f32x4* cp = (const GAS f32x4*)(rqk + (slot * 16 + 4 * fq) * 2); cs0 = cp[0]; cs1 = cp[1]; }
#pragma unroll
                    for (int bj = 0; bj < 2; ++bj) {
                        const f32x4 p = *(const LAS f32x4*)(scr + (r * 2 + bj) * 4);
                        const float rs = rsqrtf(((p[0] + p[1]) + (p[2] + p[3])) * (1.f / 128.f) + EPS);
                        f32x4 x0 = acc[ai][bj][m][0] * rs * g0, x1 = acc[ai][bj][m][1] * rs * g1;
                        if (wc == 0) { const f32x4 c = {cs0[0], cs0[2], cs1[0], cs1[2]}, s = {cs0[1], cs0[3], cs1[1], cs1[3]};
                            const f32x4 y0 = x0 * c - x1 * s, y1 = x1 * c + x0 * s; x0 = y0; x1 = y1; }
                        const int hh = 2 * pn + bj;
                        if (pn < 4) {
                            if (smp) { if (valid) { GAS float* q = QS + (size_t)r * 1024 + hh * 128 + dl; *(GAS f32x4*)q = x0; *(GAS f32x4*)(q + 16) = x1; } }
                            else { GAS bf16_t* q = Qb + (((size_t)bb * NH + hh) * S + tt) * HD + dl;
                                u32x2 w0 = {pk_bf16(x0[0], x0[1]), pk_bf16(x0[2], x0[3])}, w1 = {pk_bf16(x1[0], x1[1]), pk_bf16(x1[2], x1[3])};
                                *(GAS u32x2*)q = w0; *(GAS u32x2*)(q + 16) = w1; }
                        } else {
                            if (smp) { if (valid) { GAS float* k = out + O_KS + (size_t)r * 256 + bj * 128 + dl; *(GAS f32x4*)k = x0; *(GAS f32x4*)(k + 16) = x1; } }
                            else { GAS float* k = out + O_KP + (size_t)grow * 256 + bj * 128 + dl; *(GAS f32x4*)k = x0; *(GAS f32x4*)(k + 16) = x1;
                                GAS bf16_t* kb = Kb + (((size_t)bb * NKV + bj) * S + tt) * HD + dl;
                                u32x2 w0 = {pk_bf16(x0[0], x0[1]), pk_bf16(x0[2], x0[3])}, w1 = {pk_bf16(x1[0], x1[1]), pk_bf16(x1[2], x1[3])};
                                *(GAS u32x2*)kb = w0; *(GAS u32x2*)(kb + 16) = w1; }
                        } } }
            } else {
                const int dl = 32 * (wc & 1) + 4 * fq;
                const f32x4 g0 = *(const GAS f32x4*)((const GAS float*)gki + dl), g1 = *(const GAS f32x4*)((const GAS float*)gki + dl + 16);
                GAS f16* KI = (GAS f16*)(ws + WS_KI); GAS float* WI = (GAS float*)(ws + WS_WI);
                ROWLOOP { asm volatile("" ::: "memory"); ROWVARS
                    const f32x4 p = *(const LAS f32x4*)(scr + (r * 2) * 4);
                    const float rs = rsqrtf((p[0] + p[1]) * (1.f / 64.f) + EPS);
                    f32x4 x0 = acc[ai][0][m][0] * rs * g0, x1 = acc[ai][0][m][1] * rs * g1;
                    f32x4 xo; xo[0] = __shfl_xor(x0[0], 32); xo[1] = __shfl_xor(x0[1], 32); xo[2] = __shfl_xor(x0[2], 32); xo[3] = __shfl_xor(x0[3], 32);
                    if (wc == 0) { const GAS f32x4* cp = (const GAS f32x4*)(ri + (slot * 8 + 4 * (fq & 1)) * 2); const f32x4 cs0 = cp[0], cs1 = cp[1];
                        const f32x4 c = {cs0[0], cs0[2], cs1[0], cs1[2]}, s = {cs0[1], cs0[3], cs1[1], cs1[3]};
                        x0 = fq < 2 ? x0 * c - xo * s : x0 * c + xo * s; }
                    if (wc < 2 && valid) {
                        GAS float* ko = smp ? out + O_KIS + (size_t)r * 64 + dl : out + O_KIP + (size_t)grow * 64 + dl;
                        *(GAS f32x4*)ko = x0; *(GAS f32x4*)(ko + 16) = x1;
                        if (!smp) { GAS f16* kh = KI + (size_t)grow * 64 + dl; u32x2 w0 = {pk_f16(x0[0], x0[1]), pk_f16(x0[2], x0[3])}, w1 = {pk_f16(x1[0], x1[1]), pk_f16(x1[2], x1[3])};
                            *(GAS u32x2*)kh = w0; *(GAS u32x2*)(kh + 16) = w1; } }
                    if (wc == 2 && valid) *(GAS f32x4*)(WI + (size_t)grow * 16 + 4 * fq) = acc[ai][0][m][0] * (1.f / 32.f);
                }
            }
        } else if (pn == 5) {
            GAS bf16_t* Vb = (GAS bf16_t*)(ws + WS_VB); const int dl = 32 * wc + 4 * fq;
            ROWLOOP { asm volatile("" ::: "memory"); ROWVARS
#pragma unroll
                for (int bj = 0; bj < 2; ++bj) { const f32x4 x0 = acc[ai][bj][m][0], x1 = acc[ai][bj][m][1];
                    if (smp) { if (valid) { GAS float* v = out + O_VS + (size_t)r * 256 + bj * 128 + dl; *(GAS f32x4*)v = x0; *(GAS f32x4*)(v + 16) = x1; } }
                    else { GAS float* v = out + O_VP + (size_t)grow * 256 + bj * 128 + dl; *(GAS f32x4*)v = x0; *(GAS f32x4*)(v + 16) = x1;
                        GAS bf16_t* vb = Vb + (((size_t)bb * NKV + bj) * S + tt) * HD + dl;
                        u32x2 w0 = {pk_bf16(x0[0], x0[1]), pk_bf16(x0[2], x0[3])}, w1 = {pk_bf16(x1[0], x1[1]), pk_bf16(x1[2], x1[3])};
                        *(GAS u32x2*)vb = w0; *(GAS u32x2*)(vb + 16) = w1; } } }
        } else if (pn <= 9) {
            GAS f16* SZ = (GAS f16*)(ws + WS_SZ); const int c0 = 256 * (pn - 6) + 32 * wc + 4 * fq;
            ROWLOOP { asm volatile("" ::: "memory"); ROWVARS
                if (valid) {
#pragma unroll
                    for (int bj = 0; bj < 2; ++bj)
#pragma unroll
                        for (int n = 0; n < 2; ++n) { const f32x4 x = acc[ai][bj][m][n]; u32x2 w = {pk_f16(silu(x[0]), silu(x[1])), pk_f16(silu(x[2]), silu(x[3]))};
                            *(GAS u32x2*)(SZ + (size_t)grow * 1024 + c0 + 128 * bj + 16 * n) = w; } } }
        } else if (pn <= 13) {
            GAS f16* QI = (GAS f16*)(ws + WS_QI); const int c0 = 256 * (pn - 10) + 32 * wc + 4 * fq;
            ROWLOOP { asm volatile("" ::: "memory"); ROWVARS
                f32x4 c = {1.f, 1.f, 1.f, 1.f}, s = {0.f, 0.f, 0.f, 0.f};
                if ((wc & 1) == 0) { const GAS f32x4* cp = (const GAS f32x4*)(ri + (slot * 8 + 4 * (fq & 1)) * 2); const f32x4 cs0 = cp[0], cs1 = cp[1];
                    c = (f32x4){cs0[0], cs0[2], cs1[0], cs1[2]}; s = (f32x4){cs0[1], cs0[3], cs1[1], cs1[3]}; }
#pragma unroll
                for (int bj = 0; bj < 2; ++bj) { f32x4 x0 = acc[ai][bj][m][0]; const f32x4 x1 = acc[ai][bj][m][1];
                    f32x4 xo; xo[0] = __shfl_xor(x0[0], 32); xo[1] = __shfl_xor(x0[1], 32); xo[2] = __shfl_xor(x0[2], 32); xo[3] = __shfl_xor(x0[3], 32);
                    if ((wc & 1) == 0) x0 = fq < 2 ? x0 * c - xo * s : x0 * c + xo * s;
                    if (valid) { GAS f16* q = QI + (size_t)grow * 1024 + c0 + 128 * bj;
                        u32x2 w0 = {pk_f16(x0[0], x0[1]), pk_f16(x0[2], x0[3])}, w1 = {pk_f16(x1[0], x1[1]), pk_f16(x1[2], x1[3])};
                        *(GAS u32x2*)q = w0; *(GAS u32x2*)(q + 16) = w1; } } }
        } else {
            GAS f16* U = (GAS f16*)(ws + WS_U); GAS f16* G = (GAS f16*)(ws + WS_G); const int ch = 64 * (pn - 15) + 16 * wc + 4 * fq;
            ROWLOOP { asm volatile("" ::: "memory"); ROWVARS
                const f32x4 h = acc[ai][0][m][0], b = acc[ai][0][m][1], c = acc[ai][1][m][0], z = acc[ai][1][m][1];
                const f32x4 uu = c * h; f32x4 gg; gg[0] = b[0] * silu(z[0]); gg[1] = b[1] * silu(z[1]); gg[2] = b[2] * silu(z[2]); gg[3] = b[3] * silu(z[3]);
                if (valid) { u32x2 wu = {pk_f16(uu[0], uu[1]), pk_f16(uu[2], uu[3])}, wg = {pk_f16(gg[0], gg[1]), pk_f16(gg[2], gg[3])};
                    *(GAS u32x2*)(U + (size_t)grow * 1024 + ch) = wu; *(GAS u32x2*)(G + (size_t)grow * 1024 + ch) = wg;
                    if (!smp && tt >= S - 2) *(GAS f32x4*)(out + O_CVP + ((size_t)bb * 2 + (tt - (S - 2))) * 1024 + ch) = uu;
                    if (smp && tt >= 2) *(GAS f32x4*)(out + O_CVS + ((size_t)(r >> 2) * 2 + (tt - 2)) * 1024 + ch) = uu; } }
        }
#undef ROWLOOP
#undef ROWVARS
    }
};


struct EpiOut {
    float* out; const float* xp;
    __device__ __forceinline__ bool aligned(const pg8::Unit&) const { return false; }
    __device__ __forceinline__ void init(f32x4 (&acc)[2][2][4][2], const pg8::Unit& u, int wr, int wc, int fr, int fq) const {
        const GAS float* xp = (const GAS float*)this->xp;
        const size_t base = (size_t)(u.pm * 256 + 64 * wr + fr) * DM + u.pn * 256 + 32 * wc + 4 * fq;
#pragma unroll
        for (int ai = 0; ai < 2; ++ai)
#pragma unroll
            for (int m = 0; m < 4; ++m)
#pragma unroll
                for (int bj = 0; bj < 2; ++bj)
#pragma unroll
                    for (int n = 0; n < 2; ++n) acc[ai][bj][m][n] = *(const GAS f32x4*)(xp + base + (size_t)(128 * ai + 16 * m) * DM + 128 * bj + 16 * n);
    }
    __device__ __forceinline__ void operator()(f32x4 (&acc)[2][2][4][2], const pg8::Unit& u, int wr, int wc, int fr_, int fq_) const {
        int fr = fr_, fq = fq_; asm volatile("" : "+v"(fr), "+v"(fq));
        GAS float* out = (GAS float*)this->out; asm volatile("" : "+s"(out));
        const size_t base = (size_t)(u.pm * 256 + 64 * wr + fr) * DM + u.pn * 256 + 32 * wc + 4 * fq;
#pragma unroll
        for (int ai = 0; ai < 2; ++ai)
#pragma unroll
            for (int m = 0; m < 4; ++m) { const size_t off = base + (size_t)(128 * ai + 16 * m) * DM;
#pragma unroll
                for (int bj = 0; bj < 2; ++bj)
#pragma unroll
                    for (int n = 0; n < 2; ++n) *(GAS f32x4*)(out + off + 128 * bj + 16 * n) = acc[ai][bj][m][n]; }
    }
};
__device__ __forceinline__ void p4_sample(const Args& a, LAS unsigned char* lds, int bx, int G, int tid) {
    const GAS f16* MIX = (const GAS f16*)(a.ws + WS_MIX) + (size_t)MP * DM; const GAS f16* WT = (const GAS f16*)(a.ws + WS_WOUTT);
    LAS float* part = (LAS float*)lds;
    const int lane = tid & 63, wave = __builtin_amdgcn_readfirstlane(tid >> 6), fr = lane & 15, fq = lane >> 4;
    for (int cg = bx; cg < DM / 8; cg += G) {
        const GAS f16* wp = WT + (size_t)(cg * 8 + (fr & 7)) * DM + wave * 256 + 8 * fq; const GAS f16* mp = MIX + (size_t)fr * DM + wave * 256 + 8 * fq;
        f16x8 wf[8], m0[8], m1[8];
#pragma unroll
        for (int ks = 0; ks < 8; ++ks) { wf[ks] = *(const GAS f16x8*)(wp + 32 * ks); m0[ks] = *(const GAS f16x8*)(mp + 32 * ks); m1[ks] = *(const GAS f16x8*)(mp + (size_t)16 * DM + 32 * ks); }
        f32x4 c0 = {0.f, 0.f, 0.f, 0.f}, c1 = {0.f, 0.f, 0.f, 0.f};
#pragma unroll
        for (int ks = 0; ks < 8; ++ks) { c0 = __builtin_amdgcn_mfma_f32_16x16x32_f16(wf[ks], m0[ks], c0, 0, 0, 0); c1 = __builtin_amdgcn_mfma_f32_16x16x32_f16(wf[ks], m1[ks], c1, 0, 0, 0); }
        *(LAS f32x4*)(part + ((wave * 2 + 0) * 64 + lane) * 4) = c0; *(LAS f32x4*)(part + ((wave * 2 + 1) * 64 + lane) * 4) = c1;
        __syncthreads();
        if (tid < 256) { const int rr = tid >> 3, cc = tid & 7; const int ln = (rr & 15) + 16 * (cc >> 2), tl = rr >> 4; float s = a.in[1][(size_t)rr * DM + cg * 8 + cc];
#pragma unroll
            for (int w = 0; w < 8; ++w) s += part[((w * 2 + tl) * 64 + ln) * 4 + (cc & 3)];
            a.out[O_YS + (size_t)rr * DM + cg * 8 + cc] = s; }
        __syncthreads();
    }
}
#ifndef P2_KT_REP
#define P2_KT_REP 1
#define P2_SEL_REP 1
#endif
#ifndef P2_REP_A
#define P2_REP_A 1
#define P2_REP_B 1
#define P2_REP_C 1
#endif
constexpr int SC_STRIDE = 2052;
constexpr int SC_BYTES = 16 * SC_STRIDE * 4;
constexpr int WSCR_OFF = 131584, WSCR_BYTES = 1536;
__device__ __forceinline__ f16x8 cvt8(f32x4 a, f32x4 b) { u32x4 w = {pk_f16(a[0], a[1]), pk_f16(a[2], a[3]), pk_f16(b[0], b[1]), pk_f16(b[2], b[3])}; return __builtin_bit_cast(f16x8, w); }

__device__ __forceinline__ void p2_convmix(const Args& a, int gw, int NGW, int lane) {
    const GAS f16* U = (const GAS f16*)(a.ws + WS_U); const GAS f16* Gm = (const GAS f16*)(a.ws + WS_G); GAS f16* MIX = (GAS f16*)(a.ws + WS_MIX);
    const GAS float* wconv = (const GAS float*)a.in[12]; const GAS float* state = (const GAS float*)a.in[5];
    for (int ch = gw; ch < MT / 4; ch += NGW) {
        const int row0 = 4 * ch; const bool smp = row0 >= MP; const int t0 = smp ? 0 : (row0 & (S - 1)); const int seq = (row0 - MP) >> 2;
#pragma unroll
        for (int half = 0; half < 2; ++half) { const int cb = half * 512 + 8 * lane;
            float um2[8], um1[8], w0[8], w1[8], w2[8];
#pragma unroll
            for (int e = 0; e < 8; e += 4) { const f32x4 a0 = *(const GAS f32x4*)(wconv + cb + e), a1 = *(const GAS f32x4*)(wconv + 1024 + cb + e), a2 = *(const GAS f32x4*)(wconv + 2048 + cb + e);
#pragma unroll
                for (int i = 0; i < 4; ++i) { w0[e + i] = a0[i]; w1[e + i] = a1[i]; w2[e + i] = a2[i]; } }
            if (t0 == 0) {
                if (smp) {
#pragma unroll
                    for (int e = 0; e < 8; e += 4) { const f32x4 s0 = *(const GAS f32x4*)(state + ((size_t)seq * 2) * 1024 + cb + e), s1 = *(const GAS f32x4*)(state + ((size_t)seq * 2 + 1) * 1024 + cb + e);
#pragma unroll
                        for (int i = 0; i < 4; ++i) { um2[e + i] = s0[i]; um1[e + i] = s1[i]; } }
                } else {
#pragma unroll
                    for (int e = 0; e < 8; ++e) { um2[e] = 0.f; um1[e] = 0.f; } }
            } else { const f16x8 p2 = *(const GAS f16x8*)(U + (size_t)(row0 - 2) * 1024 + cb), p1 = *(const GAS f16x8*)(U + (size_t)(row0 - 1) * 1024 + cb);
#pragma unroll
                for (int e = 0; e < 8; ++e) { um2[e] = (float)p2[e]; um1[e] = (float)p1[e]; } }
#pragma unroll
            for (int i = 0; i < 4; ++i) { const size_t row = row0 + i;
                const f16x8 uv = *(const GAS f16x8*)(U + row * 1024 + cb), gv = *(const GAS f16x8*)(Gm + row * 1024 + cb); float o[8];
#pragma unroll
                for (int e = 0; e < 8; ++e) { const float u = (float)uv[e]; const float cv = w0[e] * um2[e] + w1[e] * um1[e] + w2[e] * u; o[e] = (float)gv[e] * cv; um2[e] = um1[e]; um1[e] = u; }
                u32x4 w = {pk_f16(o[0], o[1]), pk_f16(o[2], o[3]), pk_f16(o[4], o[5]), pk_f16(o[6], o[7])};
                *(GAS u32x4*)(MIX + row * 2048 + 1024 + cb) = w; }
        }
    }
}

__device__ __forceinline__ void p2_sscore(const Args& a, int gw, int NGW, int lane) {
    const GAS float* cki = (const GAS float*)a.in[4]; const GAS int* ptab = (const GAS int*)a.in[6];
    const GAS f16* QI = (const GAS f16*)(a.ws + WS_QI); const GAS float* WI = (const GAS float*)(a.ws + WS_WI); GAS float* SSC = (GAS float*)(a.ws + WS_SSC);
    const int fr = lane & 15, fq = lane >> 4;
    for (int it = gw; it < NSB * 256; it += NGW) {
        const int sb = it >> 8, hp = it & 255, pg = hp >> 1, k0 = (hp & 1) * 64; const int phys = ptab[sb * NPAGES + pg];
        const GAS float* kbase = cki + ((size_t)phys * PAGE + k0) * 64;
        f16x8 qf[4][2]; f32x4 wv[4];
#pragma unroll
        for (int t = 0; t < 4; ++t) { const size_t row = MP + 4 * sb + t;
            qf[t][0] = *(const GAS f16x8*)(QI + row * 1024 + fr * 64 + 8 * fq); qf[t][1] = *(const GAS f16x8*)(QI + row * 1024 + fr * 64 + 32 + 8 * fq);
            wv[t] = *(const GAS f32x4*)(WI + row * 16 + 4 * fq); }
#pragma unroll
        for (int tile = 0; tile < 4; ++tile) {
            const GAS float* kr = kbase + (size_t)(16 * tile + fr) * 64 + 8 * fq;
            const f16x8 kf0 = cvt8(*(const GAS f32x4*)kr, *(const GAS f32x4*)(kr + 4)), kf1 = cvt8(*(const GAS f32x4*)(kr + 32), *(const GAS f32x4*)(kr + 36));
            float mine = 0.f;
#pragma unroll
            for (int t = 0; t < 4; ++t) { f32x4 c = {0.f, 0.f, 0.f, 0.f};
                c = __builtin_amdgcn_mfma_f32_16x16x32_f16(qf[t][0], kf0, c, 0, 0, 0); c = __builtin_amdgcn_mfma_f32_16x16x32_f16(qf[t][1], kf1, c, 0, 0, 0);
                float s = wv[t][0] * fmaxf(c[0], 0.f) + wv[t][1] * fmaxf(c[1], 0.f) + wv[t][2] * fmaxf(c[2], 0.f) + wv[t][3] * fmaxf(c[3], 0.f);
                s += __shfl_xor(s, 16); s += __shfl_xor(s, 32);
                mine = fq == t ? s : mine; }
            SSC[(size_t)(4 * sb + fq) * PAST + pg * PAGE + k0 + 16 * tile + fr] = mine;
        }
    }
}

__device__ __forceinline__ void wave_topk_mask(const LAS float* row, int t, GAS unsigned long long* mrow, int lane, LAS unsigned* hist, LAS float* cand) {
    const float NINF = -__builtin_inff(), PINF = __builtin_inff();
    const int jmax = t >> 6;
    float v[32]; float mx = NINF, mn = PINF;
#pragma unroll
    for (int j = 0; j < 32; ++j) { v[j] = NINF; if (j <= jmax) { const int s = 64 * j + lane; const float x = row[s]; const bool ok = s <= t; v[j] = ok ? x : NINF; mx = fmaxf(mx, v[j]); mn = fminf(mn, ok ? x : PINF); } }
#pragma unroll
    for (int o = 1; o < 64; o <<= 1) { mx = fmaxf(mx, __shfl_xor(mx, o)); mn = fminf(mn, __shfl_xor(mn, o)); }
    *(LAS u32x4*)(hist + 4 * lane) = (u32x4){0u, 0u, 0u, 0u};
    const float scale = 255.5f / (mx - mn);
    float tau = 0.f; bool have = false;
    if (mx > mn) {
        asm volatile("s_waitcnt lgkmcnt(0)" ::: "memory");
        unsigned bins[8];
#pragma unroll
        for (int j = 0; j < 8; ++j) bins[j] = 0u;
#pragma unroll
        for (int j = 0; j < 32; ++j) { if (j <= jmax) { int b = (int)((v[j] - mn) * scale); b = b > 255 ? 255 : (b < 0 ? 0 : b); bins[j >> 2] |= (unsigned)b << (8 * (j & 3));
            if (64 * j + lane <= t) __hip_atomic_fetch_add(hist + b, 1u, __ATOMIC_RELAXED, __HIP_MEMORY_SCOPE_WORKGROUP); } }
        asm volatile("s_waitcnt lgkmcnt(0)" ::: "memory");
        const u32x4 h = *(const LAS u32x4*)(hist + 4 * lane);
        const unsigned sl = h[0] + h[1] + h[2] + h[3]; unsigned pre = sl;
#pragma unroll
        for (int o = 1; o < 64; o <<= 1) { const unsigned y = __shfl_up(pre, o); if (lane >= o) pre += y; }
        const unsigned tot = __builtin_amdgcn_readlane(pre, 63); const unsigned suf = tot - pre + sl;
        const unsigned long long bm = __ballot(suf >= TOPK);
        const int Ls = 63 - __builtin_clzll(bm);
        unsigned c = __builtin_amdgcn_readlane(suf, Ls) - __builtin_amdgcn_readlane(sl, Ls);
        const unsigned h3 = __builtin_amdgcn_readlane(h[3], Ls), h2 = __builtin_amdgcn_readlane(h[2], Ls), h1 = __builtin_amdgcn_readlane(h[1], Ls);
        int Bs;
        if (c + h3 >= TOPK) Bs = 4 * Ls + 3; else { c += h3; if (c + h2 >= TOPK) Bs = 4 * Ls + 2; else { c += h2; if (c + h1 >= TOPK) Bs = 4 * Ls + 1; else { c += h1; Bs = 4 * Ls; } } }
        const int need = TOPK - (int)c;
        int base = 0;
#pragma unroll
        for (int j = 0; j < 32; ++j) { if (j <= jmax) { const int b = (int)((bins[j >> 2] >> (8 * (j & 3))) & 255u); const bool isc = (64 * j + lane <= t) && b == Bs;
            const unsigned long long m = __ballot(isc);
            if (m) { const int pos = base + (int)__builtin_amdgcn_mbcnt_hi((unsigned)(m >> 32), __builtin_amdgcn_mbcnt_lo((unsigned)m, 0u)); if (isc && pos < 64) cand[pos] = v[j]; base += __builtin_popcountll(m); } } }
        if (base <= 64) {
            asm volatile("s_waitcnt lgkmcnt(0)" ::: "memory");
            const float x = lane < base ? cand[lane] : NINF; int rank = 0;
            for (int m = 0; m < base; ++m) { const float y = __builtin_bit_cast(float, __builtin_amdgcn_readlane(__builtin_bit_cast(int, x), m)); rank += y > x ? 1 : 0; }
            float tc = (lane < base && rank <= need - 1) ? x : PINF;
#pragma unroll
            for (int o = 1; o < 64; o <<= 1) tc = fminf(tc, __shfl_xor(tc, o));
            tau = tc; have = true;
        }
    }
    if (!have) {
        unsigned tk = 0u;
        for (int bit = 31; bit >= 0; --bit) { const unsigned cd = tk | (1u << bit); int cnt = 0;
#pragma unroll
            for (int j = 0; j < 32; ++j) cnt += __builtin_popcountll(__ballot((64 * j + lane <= t) && fkey(v[j]) >= cd));
            if (cnt >= TOPK) tk = cd; }
        tau = __builtin_bit_cast(float, (tk & 0x80000000u) ? (tk ^ 0x80000000u) : ~tk);
    }
    unsigned wlo = 0u, whi = 0u;
#pragma unroll
    for (int j = 0; j < 32; ++j) { if (j <= jmax) { const unsigned long long m = __ballot(v[j] >= tau); if (lane == j) { wlo = (unsigned)m; whi = (unsigned)(m >> 32); } } }
    if (lane < 32) mrow[lane] = ((unsigned long long)whi << 32) | wlo;
}

#define RELU_FMA(acc_, c_, w_) do { const float f_ = (c_); const int i_ = __builtin_bit_cast(int, f_); const float r_ = __builtin_bit_cast(float, i_ > 0 ? i_ : 0); asm("v_fmac_f32_e32 %0, %1, %2" : "+v"(acc_) : "v"(r_), "v"(w_)); } while (0)
__device__ __forceinline__ void p2_index_tile(const Args& a, LAS unsigned char* lds, int b, int t0, int wave, int lane) {
    const GAS f16* QI = (const GAS f16*)(a.ws + WS_QI); const GAS float* WI = (const GAS float*)(a.ws + WS_WI); const GAS f16* KI = (const GAS f16*)(a.ws + WS_KI);
    GAS unsigned long long* MASK = (GAS unsigned long long*)(a.ws + WS_MASK);
    LAS float* sc = (LAS float*)lds;
    const int fr = lane & 15, fq = lane >> 4; const size_t rowq = (size_t)b * S + t0 + fr;
    f16x8 qf[16][2]; float w[16];
#pragma unroll
    for (int h = 0; h < 16; ++h) { qf[h][0] = *(const GAS f16x8*)(QI + rowq * 1024 + h * 64 + 8 * fq); qf[h][1] = *(const GAS f16x8*)(QI + rowq * 1024 + h * 64 + 32 + 8 * fq); }
#pragma unroll
    for (int h = 0; h < 16; h += 4) { const f32x4 x = *(const GAS f32x4*)(WI + rowq * 16 + h); w[h] = x[0]; w[h + 1] = x[1]; w[h + 2] = x[2]; w[h + 3] = x[3]; }
    const int nkt = (t0 + 16) >> 4;
    const GAS f16* kp = KI + ((size_t)b * S + fr) * 64 + 8 * fq;
#define KLOAD(d0_, d1_, kt_) do { const int k_ = (kt_) < nkt ? (kt_) : wave; d0_ = *(const GAS f16x8*)(kp + (size_t)k_ * 1024); d1_ = *(const GAS f16x8*)(kp + (size_t)k_ * 1024 + 32); } while (0)
    f16x8 ka0, ka1, kb0, kb1, kc0, kc1;
#define KCOMP(kf0, kf1, kt_) do { float a0 = 0.f, a1 = 0.f, a2 = 0.f, a3 = 0.f; const f32x4 z4 = {0.f, 0.f, 0.f, 0.f}; \
        f32x4 cc = __builtin_amdgcn_mfma_f32_16x16x32_f16(kf0, qf[0][0], z4, 0, 0, 0); cc = __builtin_amdgcn_mfma_f32_16x16x32_f16(kf1, qf[0][1], cc, 0, 0, 0); \
        _Pragma("unroll") for (int h = 0; h < 16; ++h) { f32x4 cn = z4;        \
            if (h < 15) { cn = __builtin_amdgcn_mfma_f32_16x16x32_f16(kf0, qf[h + 1][0], z4, 0, 0, 0); cn = __builtin_amdgcn_mfma_f32_16x16x32_f16(kf1, qf[h + 1][1], cn, 0, 0, 0); } \
            RELU_FMA(a0, cc[0], w[h]); RELU_FMA(a1, cc[1], w[h]); RELU_FMA(a2, cc[2], w[h]); RELU_FMA(a3, cc[3], w[h]); \
            cc = cn; __builtin_amdgcn_sched_barrier(0); } \
        *(LAS f32x4*)(sc + fr * SC_STRIDE + 16 * (kt_) + 4 * fq) = (f32x4){a0, a1, a2, a3}; } while (0)
    KLOAD(ka0, ka1, wave); KLOAD(kb0, kb1, wave + NWAVES);
    for (int rpk = 0; rpk < P2_KT_REP; ++rpk)
    for (int kt = wave; kt < nkt; kt += 3 * NWAVES) {
        KLOAD(kc0, kc1, kt + 2 * NWAVES); KCOMP(ka0, ka1, kt);
        if (kt + NWAVES < nkt) { KLOAD(ka0, ka1, kt + 3 * NWAVES); KCOMP(kb0, kb1, kt + NWAVES); }
        if (kt + 2 * NWAVES < nkt) { KLOAD(kb0, kb1, kt + 4 * NWAVES); KCOMP(kc0, kc1, kt + 2 * NWAVES); }
    }
#undef KCOMP
#undef KLOAD
    __syncthreads();
#pragma unroll 1
    for (int qq = 0; qq < 2 * P2_SEL_REP; ++qq) { const int q = 2 * wave + (qq & 1); const int t = t0 + q;
        wave_topk_mask(sc + q * SC_STRIDE, t, MASK + ((size_t)b * S + t) * 32, lane, (LAS unsigned*)(lds + WSCR_OFF + wave * WSCR_BYTES), (LAS float*)(lds + WSCR_OFF + wave * WSCR_BYTES + 1024)); }
    __syncthreads();
}

__device__ __forceinline__ void p2_phase(const Args& a, LAS unsigned char* lds, int vcu, int G, int wave, int lane) {
    const int gw = vcu * NWAVES + wave, NGW = G * NWAVES;
    for (int rp = 0; rp < P2_REP_A; ++rp) p2_sscore(a, gw, NGW, lane);
    { GAS unsigned long long* MASK = (GAS unsigned long long*)(a.ws + WS_MASK);
      for (int i = gw * 64 + lane; i < NB * TOPK * 32; i += NGW * 64) { const int wd = i & 31, t = (i >> 5) & (TOPK - 1), b = i >> 13; const int lo = 64 * wd;
          const unsigned long long m = lo + 63 <= t ? ~0ull : (lo > t ? 0ull : ((1ull << (t - lo + 1)) - 1ull));
          MASK[((size_t)b * S + t) * 32 + wd] = m; } }
    constexpr int NT = NB * (S - TOPK) / 16;
    for (int rp = 0; rp < P2_REP_C; ++rp)
    for (int r = 0; r * G < NT; ++r) { const int k = (r & 1) ? (r + 1) * G - 1 - vcu : r * G + vcu;
        if (k < NT) { const int j = (NT / NB - 1) - (k >> 2), b = k & 3; p2_index_tile(a, lds, b, TOPK + 16 * j, wave, lane); } }
}

#ifndef P3_REP_S
#define P3_REP_S 1
#define P3_REP_A 1
#endif
namespace att {
typedef short bf16x8 __attribute__((ext_vector_type(8)));
typedef short s16x4 __attribute__((ext_vector_type(4)));
typedef float f32x16 __attribute__((ext_vector_type(16)));
constexpr int QBLK = 32, KVBLK = 64, D = 128;
constexpr int SHM_V = KVBLK * D * 2, SHM_K = KVBLK * D * 2;
constexpr int WS_OFF = 2 * SHM_V + 2 * SHM_K;
constexpr float SCALE = 0.08838834764831845f;
#define KSWZ(row, colB) ((row) * 256 + ((colB) ^ (((row) & 7) << 4)))
#define SBAR() __builtin_amdgcn_sched_barrier(0)
__device__ __forceinline__ int v_st(int k, int c) { const int kk = (k & ~0xC) | ((k & 4) << 1) | ((k & 8) >> 1); return ((kk >> 3) * 4 + (c >> 5)) * 512 + ((kk & 7) * 32 + (c & 31)) * 2; }
__device__ __forceinline__ int v_rd_base(int lane) { return ((lane & 3) << 3) | (((lane >> 2) & 3) << 6) | (((lane >> 4) & 1) << 5) | (((lane >> 5) & 1) << 8); }
constexpr int v_rd_off(int d0, int ks, int half) { return d0 * 512 + ks * 4096 + half * 2048; }
__device__ __forceinline__ int crow(int r, int hi) { return (r & 3) + 8 * (r >> 2) + 4 * hi; }
__device__ __forceinline__ unsigned cvtpk(float lo, float hi) { return pk_bf16(lo, hi); }

template <int KB>
__device__ __forceinline__ void qkt(f32x16& p0, f32x16& p1, const LAS unsigned char* K_lds, int r32, int hi, const LAS unsigned char* qp) {
    p0 = f32x16{}; p1 = f32x16{};
    const LAS unsigned char* kb[4];
#pragma unroll
    for (int dd = 0; dd < 4; ++dd) kb[dd] = K_lds + KB * SHM_K + KSWZ(r32, (dd * 16 + hi * 8) * 2);
#pragma unroll
    for (int d0 = 0; d0 < 8; ++d0) { const LAS unsigned char* a = kb[d0 & 3] + (d0 >> 2) * 128;
        const bf16x8 b0 = *(const LAS bf16x8*)a;
        const bf16x8 b1 = *(const LAS bf16x8*)(a + 32 * 256);
        const bf16x8 qv = *(const LAS bf16x8*)(qp + d0 * 1024);
        p0 = __builtin_amdgcn_mfma_f32_32x32x16_bf16(b0, qv, p0, 0, 0, 0);
        p1 = __builtin_amdgcn_mfma_f32_32x32x16_bf16(b1, qv, p1, 0, 0, 0); }
}
template <int VB>
__device__ __forceinline__ void pv_tile(f32x16* o, int vb0, bf16x8 pa0, bf16x8 pa1, bf16x8 pa2, bf16x8 pa3) {
#define TRRD(dst, off) asm volatile("ds_read_b64_tr_b16 %0, %1 offset:%2" : "=&v"(dst) : "v"(vb0), "i"(off) : "memory")
#define PV_D0(d0) do { s16x4 l0, l1, l2, l3, h0, h1, h2, h3; constexpr int b_ = VB * SHM_V + v_rd_off(d0, 0, 0); \
        TRRD(l0, b_); TRRD(h0, b_ + 2048); TRRD(l1, b_ + 4096); TRRD(h1, b_ + 6144); TRRD(l2, b_ + 8192); TRRD(h2, b_ + 10240); TRRD(l3, b_ + 12288); TRRD(h3, b_ + 14336); \
        asm volatile("s_waitcnt lgkmcnt(0)" ::: "memory"); SBAR(); \
        o[d0] = __builtin_amdgcn_mfma_f32_32x32x16_bf16(pa0, (bf16x8){l0[0], l0[1], l0[2], l0[3], h0[0], h0[1], h0[2], h0[3]}, o[d0], 0, 0, 0); \
        o[d0] = __builtin_amdgcn_mfma_f32_32x32x16_bf16(pa1, (bf16x8){l1[0], l1[1], l1[2], l1[3], h1[0], h1[1], h1[2], h1[3]}, o[d0], 0, 0, 0); \
        o[d0] = __builtin_amdgcn_mfma_f32_32x32x16_bf16(pa2, (bf16x8){l2[0], l2[1], l2[2], l2[3], h2[0], h2[1], h2[2], h2[3]}, o[d0], 0, 0, 0); \
        o[d0] = __builtin_amdgcn_mfma_f32_32x32x16_bf16(pa3, (bf16x8){l3[0], l3[1], l3[2], l3[3], h3[0], h3[1], h3[2], h3[3]}, o[d0], 0, 0, 0); } while (0)
    PV_D0(0); PV_D0(1); PV_D0(2); PV_D0(3);
#undef PV_D0
#undef TRRD
}
__device__ __forceinline__ void partialSM(f32x16& p0, f32x16& p1, unsigned wl, unsigned wh, float sh2) {
    const float NEG = -__builtin_inff(); constexpr float C2 = 1.4426950408889634f * SCALE;
#pragma unroll
    for (int r = 0; r < 16; ++r) { const unsigned bit = 1u << ((r & 3) + 8 * (r >> 2));
        p0[r] = (wl & bit) ? fmaf(p0[r], C2, -sh2) : NEG; p1[r] = (wh & bit) ? fmaf(p1[r], C2, -sh2) : NEG; }
#pragma unroll
    for (int r = 0; r < 16; ++r) p0[r] = __builtin_amdgcn_exp2f(p0[r]);
}
__device__ __forceinline__ void finishSM(f32x16& p0, f32x16& p1, float& l_reg, bf16x8& pa0, bf16x8& pa1, bf16x8& pa2, bf16x8& pa3) {
#pragma unroll
    for (int r = 0; r < 16; ++r) p1[r] = __builtin_amdgcn_exp2f(p1[r]);
    float ps = 0;
#pragma unroll
    for (int r = 0; r < 16; ++r) ps += p0[r];
#pragma unroll
    for (int r = 0; r < 16; ++r) ps += p1[r];
    l_reg += ps;
#define PK4(P, B_, OUT) do { unsigned a0 = cvtpk(P[B_+0], P[B_+1]), a1 = cvtpk(P[B_+2], P[B_+3]); \
        unsigned b0 = cvtpk(P[B_+4], P[B_+5]), b1 = cvtpk(P[B_+6], P[B_+7]); \
        auto r0 = __builtin_amdgcn_permlane32_swap(a0, b0, false, false); auto r1 = __builtin_amdgcn_permlane32_swap(a1, b1, false, false); \
        u32x4 w = {r0[0], r1[0], r0[1], r1[1]}; OUT = __builtin_bit_cast(bf16x8, w); } while (0)
    PK4(p0, 0, pa0); PK4(p0, 8, pa1); PK4(p1, 0, pa2); PK4(p1, 8, pa3);
#undef PK4
}

__device__ __forceinline__ __amdgpu_buffer_rsrc_t mk_rsrc(const GAS void* p, unsigned bytes) {
    const unsigned long long u = (unsigned long long)p; const unsigned lo = __builtin_amdgcn_readfirstlane((unsigned)u), hi = __builtin_amdgcn_readfirstlane((unsigned)(u >> 32));
    return __builtin_amdgcn_make_buffer_rsrc((void*)(((unsigned long long)hi << 32) | lo), (short)0, (int)bytes, 0x00020000);
}
__device__ __forceinline__ void attn_block(const Args& a, LAS unsigned char* lds, int b, int kvh, int q0, float sh2) {
    int tid_ = threadIdx.x; asm volatile("" : "+v"(tid_));
    const int tid = tid_, wid = __builtin_amdgcn_readfirstlane(tid >> 6), lane = tid & 63, r32 = lane & 31, hi = lane >> 5;
    const int head = 4 * kvh + (wid >> 1), qw = q0 + 32 * (wid & 1);
    const GAS bf16_t* Qw = (const GAS bf16_t*)(a.ws + WS_QB) + (((size_t)b * NH + head) * S + qw) * D;
    const GAS bf16_t* Kh = (const GAS bf16_t*)(a.ws + WS_KB) + ((size_t)b * NKV + kvh) * S * D;
    const GAS bf16_t* Vh = (const GAS bf16_t*)(a.ws + WS_VB) + ((size_t)b * NKV + kvh) * S * D;
    const __amdgpu_buffer_rsrc_t rK = mk_rsrc(Kh, S * D * 2), rV = mk_rsrc(Vh, S * D * 2), rM = mk_rsrc((const GAS unsigned long long*)(a.ws + WS_MASK) + ((size_t)b * S + qw) * 32, 32 * 256);
    const unsigned moff = (unsigned)r32 * 256u;
    const int NT = q0 / KVBLK + 1;
    LAS unsigned char* V_lds = lds; LAS unsigned char* K_lds = lds + 2 * SHM_V;
    const int sr = tid >> 4, sc = (tid & 15) * 8, vst0 = v_st(sr, sc), vst1 = v_st(32 + sr, sc), kws = KSWZ(sr, sc * 2);
    const int vb0 = (int)(unsigned)(size_t)V_lds + v_rd_base(lane); const unsigned kvoff = (unsigned)(sr * D + sc) * 2u;
    bf16x8 st_v0, st_v1, st_k0, st_k1;
    LAS unsigned char* qp = lds + WS_OFF + 2048 + wid * 8192 + lane * 16;
#define VMW() asm volatile("s_waitcnt vmcnt(0)" ::: "memory")
#define BL128(r_, so_) __builtin_bit_cast(bf16x8, __builtin_amdgcn_raw_buffer_load_b128(r_, kvoff, (so_), 0))
#define SLOAD_H(k0) do { const int so_ = (k0) * 256; st_v0 = BL128(rV, so_); st_v1 = BL128(rV, so_ + 8192); st_k0 = BL128(rK, so_); st_k1 = BL128(rK, so_ + 8192); } while (0)
#define SWRITE_HK(bf) do { *(LAS bf16x8*)(K_lds + (bf) * SHM_K + kws) = st_k0; *(LAS bf16x8*)(K_lds + (bf) * SHM_K + kws + 32 * 256) = st_k1; } while (0)
#define SWRITE_HV(bf) do { *(LAS bf16x8*)(V_lds + (bf) * SHM_V + vst0) = st_v0; *(LAS bf16x8*)(V_lds + (bf) * SHM_V + vst1) = st_v1; } while (0)
#define SWRITE_H(bf) do { SWRITE_HV(bf); SWRITE_HK(bf); } while (0)
#define MLOAD(t) __builtin_bit_cast(unsigned long long, __builtin_amdgcn_raw_buffer_load_b64(rM, moff, (t) * 8, 0))
#define MSPLIT(mw, wl, wh) do { wl = (unsigned)(mw) >> (4 * hi); wh = (unsigned)((mw) >> 32) >> (4 * hi); } while (0)
    { bf16x8 qt[8];
#pragma unroll
      for (int d0 = 0; d0 < 8; ++d0) qt[d0] = *(const GAS bf16x8*)(Qw + (unsigned)(r32 * D + d0 * 16 + hi * 8));
#pragma unroll
      for (int d0 = 0; d0 < 8; ++d0) *(LAS bf16x8*)(qp + d0 * 1024) = qt[d0]; }
    SLOAD_H(0); unsigned long long mwA = MLOAD(0), mwB = 0ull; VMW(); SWRITE_H(0);
    if (NT > 1) { SLOAD_H(KVBLK); mwB = MLOAD(1); }
    __syncthreads();
    float l_reg = 0.f; f32x16 o[4] = {};
    f32x16 p0, p1; bf16x8 pa0, pa1, pa2, pa3; unsigned wl, wh;
    SBAR(); qkt<0>(p0, p1, K_lds, r32, hi, qp);
    MSPLIT(mwA, wl, wh); partialSM(p0, p1, wl, wh, sh2);
    if (NT > 1) { VMW(); SWRITE_H(1); }
    __syncthreads();
#define STEP(t, KB, VB) do { \
        finishSM(p0, p1, l_reg, pa0, pa1, pa2, pa3); SBAR(); \
        if ((t) + 1 < NT) { SLOAD_H(((t) + 1) * KVBLK); mwA = MLOAD((t) + 1); SBAR(); } \
        pv_tile<VB>(o, vb0, pa0, pa1, pa2, pa3); SBAR(); \
        qkt<KB>(p0, p1, K_lds, r32, hi, qp); \
        MSPLIT(mwB, wl, wh); partialSM(p0, p1, wl, wh, sh2); mwB = mwA; \
        __syncthreads(); \
        if ((t) + 1 < NT) { VMW(); SWRITE_H(VB); } \
        __syncthreads(); } while (0)
    int t = 1;
    for (; t + 1 < NT; t += 2) { STEP(t, 1, 0); STEP(t + 1, 0, 1); }
    if (t < NT) { STEP(t, 1, 0); }
    finishSM(p0, p1, l_reg, pa0, pa1, pa2, pa3); SBAR();
    if ((NT - 1) & 1) pv_tile<1>(o, vb0, pa0, pa1, pa2, pa3); else pv_tile<0>(o, vb0, pa0, pa1, pa2, pa3);
    { auto rr = __builtin_amdgcn_permlane32_swap(__float_as_uint(l_reg), __float_as_uint(l_reg), false, false); l_reg = __uint_as_float(rr[0]) + __uint_as_float(rr[1]); }
    { int te = threadIdx.x; asm volatile("" : "+v"(te));
      const int le = te & 63, r32e = le & 31, hie = le >> 5;
      LAS float* wse = (LAS float*)(lds + WS_OFF) + wid * 64;
      if (hie == 0) wse[r32e] = l_reg;
      asm volatile("s_waitcnt lgkmcnt(0)" ::: "memory");
      __syncthreads();
      LAS f16* stg = (LAS f16*)(lds + wid * 8192);
#pragma unroll
      for (int r = 0; r < 16; ++r) { const int orow = crow(r, hie); const float rl = __builtin_amdgcn_rcpf(wse[orow]);
#pragma unroll
          for (int d0 = 0; d0 < 4; ++d0) stg[orow * 128 + d0 * 32 + r32e] = (f16)(o[d0][r] * rl); }
      asm volatile("s_waitcnt lgkmcnt(0)" ::: "memory");
      const GAS f16* SZ = (const GAS f16*)(a.ws + WS_SZ) + ((size_t)b * S + qw) * 1024 + head * 128; GAS f16* MIX = (GAS f16*)(a.ws + WS_MIX) + ((size_t)b * S + qw) * 2048 + head * 128;
#pragma unroll
      for (int i = 0; i < 8; ++i) { const int c = le + 64 * i, row = c >> 4, ch = c & 15;
          const f16x8 ov = *(const LAS f16x8*)(stg + row * 128 + ch * 8); const f16x8 zv = *(const GAS f16x8*)(SZ + (unsigned)(row * 1024 + ch * 8));
          *(GAS f16x8*)(MIX + (unsigned)(row * 2048 + ch * 8)) = ov * zv; } }
    asm volatile("s_waitcnt lgkmcnt(0)" ::: "memory");
    __syncthreads();
#undef BL128
#undef VMW
#undef SLOAD_H
#undef SWRITE_HK
#undef SWRITE_HV
#undef SWRITE_H
#undef MLOAD
#undef MSPLIT
#undef STEP
}
#undef KSWZ
#undef SBAR
}

__device__ __forceinline__ void p3_sample_item(const Args& a, LAS unsigned char* lds, int item, int tid) {
    const int qi = item >> 1, kvh = item & 1, sb = qi / NST, tl = qi % NST; constexpr int L = PAST + NST, PER = 33;
    const int lane = tid & 63, wave = __builtin_amdgcn_readfirstlane(tid >> 6);
    const GAS float* ck = (const GAS float*)a.in[2]; const GAS float* cv = (const GAS float*)a.in[3]; const GAS int* ptab = (const GAS int*)a.in[6]; const GAS float* out_ro = (const GAS float*)a.out;
    LAS float* q = (LAS float*)lds; LAS float* w = q + 1024; LAS float* newsc = w + 16; LAS float* ctl = newsc + 4; LAS float* red = ctl + 16;
    LAS unsigned* hist = (LAS unsigned*)(red + 32); LAS float* cand = (LAS float*)(hist + 256); LAS unsigned* cnt = (LAS unsigned*)(cand + 64);
    LAS unsigned* rid = cnt + 32; LAS float* qa = (LAS float*)(rid + 512); LAS float* sc = qa + 512; LAS float* inv = sc + 4 * 512; LAS float* part = inv + 4;
    LAS int* nsel = (LAS int*)(ctl + 8); LAS int* ncand = (LAS int*)(ctl + 9);
    const GAS f16* QI = (const GAS f16*)(a.ws + WS_QI) + (size_t)(MP + qi) * 1024; const GAS float* QS = (const GAS float*)(a.ws + WS_QS) + (size_t)qi * 1024 + kvh * 512;
    for (int i = tid; i < 1024; i += 512) q[i] = (float)QI[i];
    qa[tid] = QS[tid];
    if (tid < 16) w[tid] = ((const GAS float*)(a.ws + WS_WI))[(size_t)(MP + qi) * 16 + tid];
    if (tid < 32) cnt[tid] = 0u;
    if (tid < 256) hist[tid] = 0u;
    if (tid == 0) { *nsel = 0; *ncand = 0; }
    const GAS float* ssc = (const GAS float*)(a.ws + WS_SSC) + (size_t)qi * PAST;
    float v[PER];
#pragma unroll
    for (int j = 0; j < PER - 1; ++j) v[j] = ssc[j * 512 + tid];
    __syncthreads();
    if (tid < NST) { const GAS float* kr = out_ro + O_KIS + (size_t)(sb * NST + tid) * 64; float s = 0.f;
#pragma unroll 1
        for (int h = 0; h < 16; ++h) { float dsum = 0.f;
#pragma unroll 8
            for (int d = 0; d < 64; ++d) dsum += q[h * 64 + d] * kr[d];
            s += w[h] * fmaxf(dsum, 0.f); }
        newsc[tid] = s; }
    __syncthreads();
    const float NINF = -__builtin_inff(), PINF = __builtin_inff();
    { const int s = (PER - 1) * 512 + tid; v[PER - 1] = (s < L && (s - PAST) <= tl) ? newsc[s - PAST] : NINF; }
    float mx = NINF, mn = PINF;
#pragma unroll
    for (int j = 0; j < PER; ++j) { mx = fmaxf(mx, v[j]); mn = fminf(mn, v[j] == NINF ? PINF : v[j]); }
#pragma unroll
    for (int o = 1; o < 64; o <<= 1) { mx = fmaxf(mx, __shfl_xor(mx, o)); mn = fminf(mn, __shfl_xor(mn, o)); }
    if (lane == 0) { red[wave] = mx; red[8 + wave] = mn; }
    __syncthreads();
#pragma unroll
    for (int i = 0; i < 8; ++i) { mx = fmaxf(mx, red[i]); mn = fminf(mn, red[8 + i]); }
    const float scale = 255.5f / (mx - mn);
    float tau = 0.f; bool have = false;
    if (mx > mn) {
#pragma unroll
        for (int j = 0; j < PER; ++j) if (v[j] != NINF) { int bn = (int)((v[j] - mn) * scale); bn = bn > 255 ? 255 : bn; __hip_atomic_fetch_add(hist + bn, 1u, __ATOMIC_RELAXED, __HIP_MEMORY_SCOPE_WORKGROUP); }
        __syncthreads();
        if (wave == 0) {
            const u32x4 h = *(const LAS u32x4*)(hist + 4 * lane);
            const unsigned sl = h[0] + h[1] + h[2] + h[3]; unsigned pre = sl;
#pragma unroll
            for (int o = 1; o < 64; o <<= 1) { const unsigned y = __shfl_up(pre, o); if (lane >= o) pre += y; }
            const unsigned tot = __builtin_amdgcn_readlane(pre, 63); const unsigned suf = tot - pre + sl;
            const unsigned long long bm = __ballot(suf >= TOPK);
            const int Ls = 63 - __builtin_clzll(bm);
            unsigned c = __builtin_amdgcn_readlane(suf, Ls) - __builtin_amdgcn_readlane(sl, Ls);
            const unsigned h3 = __builtin_amdgcn_readlane(h[3], Ls), h2 = __builtin_amdgcn_readlane(h[2], Ls), h1 = __builtin_amdgcn_readlane(h[1], Ls);
            int Bs;
            if (c + h3 >= TOPK) Bs = 4 * Ls + 3; else { c += h3; if (c + h2 >= TOPK) Bs = 4 * Ls + 2; else { c += h2; if (c + h1 >= TOPK) Bs = 4 * Ls + 1; else { c += h1; Bs = 4 * Ls; } } }
            if (lane == 0) { ((LAS int*)ctl)[0] = Bs; ((LAS int*)ctl)[1] = TOPK - (int)c; }
        }
        __syncthreads();
        const int Bs = ((LAS int*)ctl)[0], need = ((LAS int*)ctl)[1];
#pragma unroll
        for (int j = 0; j < PER; ++j) if (v[j] != NINF) { int bn = (int)((v[j] - mn) * scale); bn = bn > 255 ? 255 : bn;
            if (bn == Bs) { const int p = __hip_atomic_fetch_add(ncand, 1, __ATOMIC_RELAXED, __HIP_MEMORY_SCOPE_WORKGROUP); if (p < 64) cand[p] = v[j]; } }
        __syncthreads();
        const int base = *ncand;
        if (base <= 64) {
            if (wave == 0) { const float x = lane < base ? cand[lane] : NINF; int rank = 0;
                for (int m = 0; m < base; ++m) { const float y = __builtin_bit_cast(float, __builtin_amdgcn_readlane(__builtin_bit_cast(int, x), m)); rank += y > x ? 1 : 0; }
                float tc = (lane < base && rank <= need - 1) ? x : PINF;
#pragma unroll
                for (int o = 1; o < 64; o <<= 1) tc = fminf(tc, __shfl_xor(tc, o));
                if (lane == 0) ctl[2] = tc; }
            __syncthreads();
            tau = ctl[2]; have = true;
        }
    }
    if (!have) {
        unsigned tk = 0u;
        for (int bit = 31; bit >= 0; --bit) { const unsigned cd = tk | (1u << bit); int c = 0;
#pragma unroll
            for (int j = 0; j < PER; ++j) c += __builtin_popcountll(__ballot(v[j] != NINF && fkey(v[j]) >= cd));
            if (lane == 0) __hip_atomic_fetch_add(cnt + bit, (unsigned)c, __ATOMIC_RELAXED, __HIP_MEMORY_SCOPE_WORKGROUP);
            __syncthreads();
            if (cnt[bit] >= TOPK) tk = cd; }
        tau = __builtin_bit_cast(float, (tk & 0x80000000u) ? (tk ^ 0x80000000u) : ~tk);
    }
#pragma unroll
    for (int j = 0; j < PER; ++j) { if (v[j] >= tau) { const int s = j * 512 + tid; const int p = __hip_atomic_fetch_add(nsel, 1, __ATOMIC_RELAXED, __HIP_MEMORY_SCOPE_WORKGROUP);
        if (p < 512) rid[p] = s < PAST ? (unsigned)(ptab[sb * NPAGES + (s >> 7)] * PAGE + (s & (PAGE - 1))) : (0x80000000u | (unsigned)(s - PAST)); } }
    __syncthreads();
    const int n = *nsel < 512 ? *nsel : 512;
    const int half = lane >> 5, l32 = lane & 31;
    { f32x4 qv[4];
#pragma unroll
      for (int h = 0; h < 4; ++h) qv[h] = *(const LAS f32x4*)(qa + h * 128 + 4 * l32);
      for (int j0 = 2 * wave; j0 < n; j0 += 128) { f32x4 kv[8]; int jj[8];
#pragma unroll
          for (int u = 0; u < 8; ++u) { jj[u] = j0 + 16 * u + half; const unsigned r = rid[jj[u] < n ? jj[u] : 0];
              const GAS float* kr = (r & 0x80000000u) ? out_ro + O_KS + ((size_t)(sb * NST + (r & 3u)) * NKV + kvh) * HD : ck + ((size_t)r * NKV + kvh) * HD;
              kv[u] = *(const GAS f32x4*)(kr + 4 * l32); }
#pragma unroll
          for (int u = 0; u < 8; ++u) { float d[4];
#pragma unroll
              for (int h = 0; h < 4; ++h) { d[h] = (kv[u][0] * qv[h][0] + kv[u][1] * qv[h][1]) + (kv[u][2] * qv[h][2] + kv[u][3] * qv[h][3]);
                  d[h] += __shfl_xor(d[h], 1); d[h] += __shfl_xor(d[h], 2); d[h] += __shfl_xor(d[h], 4); d[h] += __shfl_xor(d[h], 8); d[h] += __shfl_xor(d[h], 16); }
              if (jj[u] < n && l32 < 4) sc[l32 * 512 + jj[u]] = (l32 == 0 ? d[0] : l32 == 1 ? d[1] : l32 == 2 ? d[2] : d[3]) * 0.08838834764831845f; } } }
    __syncthreads();
    if (wave < 4) { LAS float* row = sc + wave * 512; float m2 = -1e30f;
      for (int j = lane; j < n; j += 64) m2 = fmaxf(m2, row[j]);
#pragma unroll
      for (int o = 1; o < 64; o <<= 1) m2 = fmaxf(m2, __shfl_xor(m2, o));
      float sm = 0.f;
      for (int j = lane; j < n; j += 64) { const float e = __expf(row[j] - m2); row[j] = e; sm += e; }
      sm = wave_sum(sm); if (lane == 0) inv[wave] = 1.f / sm; }
    __syncthreads();
    { f32x4 acc[4] = {};
      for (int j0 = 2 * wave; j0 < n; j0 += 128) { f32x4 vv[8]; int jj[8];
#pragma unroll
          for (int u = 0; u < 8; ++u) { jj[u] = j0 + 16 * u + half; const unsigned r = rid[jj[u] < n ? jj[u] : 0];
              const GAS float* vr = (r & 0x80000000u) ? out_ro + O_VS + ((size_t)(sb * NST + (r & 3u)) * NKV + kvh) * HD : cv + ((size_t)r * NKV + kvh) * HD;
              vv[u] = *(const GAS f32x4*)(vr + 4 * l32); }
#pragma unroll
          for (int u = 0; u < 8; ++u)
#pragma unroll
              for (int h = 0; h < 4; ++h) { const float p = jj[u] < n ? sc[h * 512 + jj[u]] : 0.f; acc[h] += vv[u] * p; } }
#pragma unroll
      for (int h = 0; h < 4; ++h) {
#pragma unroll
          for (int e = 0; e < 4; ++e) acc[h][e] += __shfl_xor(acc[h][e], 32);
          if (half == 0) *(LAS f32x4*)(part + (wave * 4 + h) * 128 + 4 * l32) = acc[h]; } }
    __syncthreads();
    { const GAS f16* SZ = (const GAS f16*)(a.ws + WS_SZ) + (size_t)(MP + qi) * 1024 + kvh * 512; GAS f16* MIX = (GAS f16*)(a.ws + WS_MIX) + (size_t)(MP + qi) * 2048 + kvh * 512;
      const int h = tid >> 7, d = tid & 127; float o = 0.f;
#pragma unroll
      for (int p = 0; p < 8; ++p) o += part[(p * 4 + h) * 128 + d];
      MIX[tid] = (f16)(o * inv[h] * (float)SZ[tid]); }
    __syncthreads();
}

__device__ __forceinline__ void p3_phase(const Args& a, LAS unsigned char* lds, int vcu, int G, int tid) {
    float gm = 0.f, km = 0.f;
    for (int i = 0; i < HD; ++i) { gm = fmaxf(gm, fabsf(a.in[9][i])); km = fmaxf(km, fabsf(a.in[10][i])); }
    const float sh2 = fmaxf(0.f, 11.313708498984761f * gm * km - 20.f) * 1.4426950408889634f;
    for (int rp = 0; rp < P3_REP_S; ++rp)
    for (int sidx = G - 1 - vcu; sidx < 2 * MS; sidx += G) p3_sample_item(a, lds, sidx, tid);
    if (G == 256) { if (vcu >= 112 && vcu < 192) p2_convmix(a, (vcu - 112) * NWAVES + (tid >> 6), 80 * NWAVES, tid & 63); }
    else p2_convmix(a, vcu * NWAVES + (tid >> 6), G * NWAVES, tid & 63);
    for (int rp = 0; rp < P3_REP_A; ++rp)
    for (int k = vcu; k < 256; k += G) { const int i = 31 - (k >> 3), bk = k & 7;
        att::attn_block(a, lds, bk >> 1, bk & 1, 64 * i, sh2); }
}

typedef GAS unsigned gu32;
#define XB_TMO      128
#define XB_XCNT(j)  (256  + 64 * (j))
#define XB_XSUB(j)  (1280 + 64 * (j))
#define XB_XGEN(j)  (2304 + 64 * (j))
#define XB_TOP      3328
#define XB_TOPGEN   3392
#define XCD_BAR_WORDS 3456
#define XB_SPIN_CAP (1u << 18)
__device__ __forceinline__ unsigned xb_ld(unsigned* p)              { return __hip_atomic_load(p, __ATOMIC_RELAXED, __HIP_MEMORY_SCOPE_AGENT); }
__device__ __forceinline__ unsigned xb_add(unsigned* p, unsigned v) { return __hip_atomic_fetch_add(p, v, __ATOMIC_RELAXED, __HIP_MEMORY_SCOPE_AGENT); }
__device__ __forceinline__ unsigned xb_xcc_id() { return (unsigned)__builtin_amdgcn_s_getreg((3 << 11) | 20) & 0xFu; }
#define XB_SPIN(cond, bar) do { unsigned _sp = 0; while (cond) { __builtin_amdgcn_s_sleep(1); \
    if ((++_sp & 255u) == 0u) { if (xb_ld(&(bar)[XB_TMO])) break; if (_sp > XB_SPIN_CAP) { atomicAdd(&(bar)[XB_TMO], 1u); break; } } } } while (0)
struct XcdBarrier { unsigned* bar; unsigned x; volatile LAS unsigned* st; };
__device__ __forceinline__ XcdBarrier xcd_barrier_post(unsigned* bar, volatile LAS unsigned* st) {
    XcdBarrier b; b.bar = bar; b.x = xb_xcc_id(); b.st = st;
    if (threadIdx.x == 0) (void)xb_add(&bar[XB_XCNT(b.x)], 1u);
    return b;
}
__device__ __forceinline__ void xcd_barrier_complete(unsigned* bar, unsigned x, unsigned& nloc, unsigned& nx) {
    const unsigned G = gridDim.x * gridDim.y * gridDim.z;
    unsigned sum, cnt, mine, sp = 0u;
    for (;;) {
        sum = 0u; cnt = 0u; mine = 0u;
#pragma unroll
        for (unsigned j = 0; j < 16; ++j) { const unsigned c = xb_ld(&bar[XB_XCNT(j)]); sum += c; cnt += (c > 0u) ? 1u : 0u; mine = (j == x) ? c : mine; }
        if (sum == G) break;
        __builtin_amdgcn_s_sleep(1);
        if ((++sp & 255u) == 0u) { if (xb_ld(&bar[XB_TMO])) break; if (sp > XB_SPIN_CAP) { atomicAdd(&bar[XB_TMO], 1u); break; } }
    }
    nloc = mine > 0u ? mine : 1u; nx = cnt > 0u ? cnt : 1u;
}
__device__ __forceinline__ void xcd_barrier(const XcdBarrier& b) {
    asm volatile("s_waitcnt vmcnt(0)" ::: "memory");
    __syncthreads();
    if (threadIdx.x == 0) {
        unsigned* bar = b.bar;
        __builtin_amdgcn_s_waitcnt(0);
        unsigned nloc = b.st[0], nx = b.st[1];
        if (nloc == 0u) { xcd_barrier_complete(bar, b.x, nloc, nx); b.st[0] = nloc; b.st[1] = nx; }
        const unsigned old = xb_add(&bar[XB_XSUB(b.x)], 1u);
        const unsigned gen = old / nloc;
        if (old + 1u == (gen + 1u) * nloc) {
            __builtin_amdgcn_fence(__ATOMIC_RELEASE, "agent");
            asm volatile("s_waitcnt vmcnt(0)" ::: "memory");
            const unsigned og = xb_add(&bar[XB_TOP], 1u);
            const unsigned tg = og / nx;
            if (og + 1u == (tg + 1u) * nx) xb_add(&bar[XB_TOPGEN], 1u);
            else XB_SPIN(xb_ld(&bar[XB_TOPGEN]) == tg, bar);
            __builtin_amdgcn_fence(__ATOMIC_ACQUIRE, "agent");
            xb_add(&bar[XB_XGEN(b.x)], 1u);
            asm volatile("s_waitcnt vmcnt(0)" ::: "memory");
        } else {
            XB_SPIN(xb_ld(&bar[XB_XGEN(b.x)]) == gen, bar);
            __builtin_amdgcn_fence(__ATOMIC_ACQUIRE, "agent");
            asm volatile("s_waitcnt vmcnt(0)" ::: "memory");
        }
    }
    __syncthreads();
}

__global__ void __launch_bounds__(NWAVES * 64, 2) mk_fwd(Args a) {
    extern __shared__ __attribute__((aligned(16))) unsigned char lds_raw[];
    LAS unsigned char* lds = (LAS unsigned char*)lds_raw;
    const int tid = threadIdx.x, lane = tid & 63, wave = __builtin_amdgcn_readfirstlane(tid >> 6);
    const int G = gridDim.x; const int bx = blockIdx.x; const int vcu = (G % 8 == 0) ? (bx % 8) * (G / 8) + bx / 8 : bx;
    volatile LAS unsigned* MISC = (volatile LAS unsigned*)(lds + MISC_OFF);
    if (tid < 64) MISC[tid] = 0u;
    __syncthreads();
    XcdBarrier bar = xcd_barrier_post((unsigned*)a.ws, MISC + 8);
    { int t_ = threadIdx.x; asm volatile("" : "+v"(t_)); const int lane = t_ & 63, wave = __builtin_amdgcn_readfirstlane(t_ >> 6); p0_prologue(a, lds, vcu, G, wave, lane); }
    xcd_barrier(bar);
    { pg8::Gemm g{(const f16*)(a.ws + WS_XNH), (const f16*)(a.ws + WS_WINT), DM};
      pg8::StaticOrder S; S.init(MPAD / 256, NPAD / 256, G, bx);
      EpiIn E{a.out, a.ws, a.in[9], a.in[10], a.in[11], (LAS float*)(lds + SCR_OFF)};
      pg8::gemm_phase<EpiIn, pg8::StaticOrder>(lds, g, S, E); }
    xcd_barrier(bar);
    { int t_ = threadIdx.x; asm volatile("" : "+v"(t_)); const int lane = t_ & 63, wave = __builtin_amdgcn_readfirstlane(t_ >> 6); p2_phase(a, lds, vcu, G, wave, lane); }
    xcd_barrier(bar);
    { int t_ = threadIdx.x; asm volatile("" : "+v"(t_)); p3_phase(a, lds, vcu, G, t_); }
    xcd_barrier(bar);
    { pg8::Gemm g{(const f16*)(a.ws + WS_MIX), (const f16*)(a.ws + WS_WOUTT), DM};
      pg8::StaticOrder S; S.init(MP / 256, DM / 256, G, bx);
      EpiOut E{a.out, a.in[0]};
      pg8::gemm_phase<EpiOut, pg8::StaticOrder>(lds, g, S, E);
      int t_ = threadIdx.x; asm volatile("" : "+v"(t_)); p4_sample(a, lds, bx, G, t_); }
}

#ifndef PROG
#define PROG 0x11111u
#endif
extern "C" void kernel_launch(void* const* d_in, const int* in_sizes, int n_in, void* d_out, int out_size, void* d_ws, size_t ws_size, hipStream_t stream) {
    static int grid = 0;
    if (grid == 0) {
        if (ws_size < WS_NEED2 || out_size != (int)O_END || n_in != 14) { fprintf(stderr, "kernel_launch: ws %zu (need %zu) out %d (want %zu) n_in %d\n", ws_size, (size_t)WS_NEED2, out_size, (size_t)O_END, n_in); grid = -1; return; }
        int dev = 0, cus = 0; hipGetDevice(&dev); hipDeviceGetAttribute(&cus, hipDeviceAttributeMultiprocessorCount, dev);
        if (hipFuncSetAttribute((const void*)mk_fwd, hipFuncAttributeMaxDynamicSharedMemorySize, LDS_BYTES) != hipSuccess) { fprintf(stderr, "kernel_launch: hipFuncSetAttribute failed\n"); grid = -1; return; }
        int per_cu = 0; hipOccupancyMaxActiveBlocksPerMultiprocessor(&per_cu, (const void*)mk_fwd, NWAVES * 64, LDS_BYTES); (void)hipGetLastError();
        if (per_cu < 1) fprintf(stderr, "kernel_launch: occupancy query says %d blocks per CU\n", per_cu);
        grid = cus > 0 ? cus : 256;
    }
    if (grid < 0) return;
    float* out = (float*)d_out; unsigned char* ws = (unsigned char*)d_ws;
    Args a{};
    for (int i = 0; i < 14; ++i) a.in[i] = (const float*)d_in[i];
    a.out = out; a.ws = ws;
    if (hipMemsetAsync(ws, 0, 65536, stream) != hipSuccess) { fprintf(stderr, "kernel_launch: memset of the control words failed\n"); return; }
    a.ph_lo = (int)PROG; a.ph_hi = 0; hipLaunchKernelGGL(mk_fwd, dim3(grid), dim3(NWAVES * 64), LDS_BYTES, stream, a);
}
```

```cpp
#include <hip/hip_runtime.h>
#include <cstdio>
#include <cstdint>
#include <cmath>

typedef _Float16 f16;
typedef unsigned short bf16_t;

constexpr int DM = 2048, NB = 4, S = 2048, NSB = 8, NST = 4, PAST = 16384, PAGE = 128, NPAGES = PAST / PAGE;
constexpr int MP = NB * S;
constexpr int MS = NSB * NST;
constexpr int MT = MP + MS;
constexpr int DIN = 7760;
constexpr int OQ = 0, OKK = 1024, OV = 1280, OZ = 1536, OQI = 2560, OKI = 3584, OWI = 3648, OH = 3664, OBB = 4688, OC = 5712, OZC = 6736;
constexpr int NH = 8, NKV = 2, HD = 128, NIH = 16, ID = 64, TOPK = 256, DC = 1024;
constexpr float EPS = 1e-6f;
constexpr size_t O_YP = 0, O_YS = 16777216, O_KP = 16842752, O_VP = 18939904, O_KIP = 21037056, O_CVP = 21561344,
                 O_KS = 21569536, O_VS = 21577728, O_KIS = 21585920, O_CVS = 21587968, O_END = 21604352;
constexpr size_t MiB = 1u << 20;
constexpr size_t WS_ROPE = 1 * MiB;
constexpr size_t WS_ROPE_I = WS_ROPE + 2052 * 32 * 4;
constexpr size_t WS_QB = 2 * MiB;
constexpr size_t WS_KB = 18 * MiB;
constexpr size_t WS_VB = 22 * MiB;
constexpr size_t WS_SZ = 26 * MiB;
constexpr size_t WS_QI = 43 * MiB;
constexpr size_t WS_KI = 60 * MiB;
constexpr size_t WS_WI = 61 * MiB;
constexpr size_t WS_U = 62 * MiB;
constexpr size_t WS_G = 79 * MiB;
constexpr size_t WS_MIX = 96 * MiB;
constexpr size_t WS_MASK = 130 * MiB;
constexpr size_t WS_SSC = 132 * MiB;
constexpr size_t WS_QS = 134 * MiB;
constexpr size_t WS_XN = 136 * MiB;
constexpr size_t WS_P = 202 * MiB;
constexpr size_t WS_NEED = 448 * MiB;

__device__ __forceinline__ bf16_t f2bf(float f) { unsigned u = __builtin_bit_cast(unsigned, f); return (bf16_t)((u + 0x7fffu + ((u >> 16) & 1u)) >> 16); }
__device__ __forceinline__ float bf2f(bf16_t h) { return __builtin_bit_cast(float, (unsigned)h << 16); }
__device__ __forceinline__ float silu(float z) { return z * __builtin_amdgcn_rcpf(1.f + __builtin_amdgcn_exp2f(-1.4426950408889634f * z)); }
__device__ __forceinline__ unsigned fkey(float f) { unsigned u = __builtin_bit_cast(unsigned, f); return (u & 0x80000000u) ? ~u : (u | 0x80000000u); }

#define P3_REP_S 1
#define P3_REP_A 1
#define P2_KT_REP 1
#define P2_SEL_REP 1
#define P2_REP_A 1
#define P2_REP_B 1
#define P2_REP_C 1
#define LAS __attribute__((address_space(3)))
#define GAS __attribute__((address_space(1)))
typedef _Float16 f16x8 __attribute__((ext_vector_type(8)));
typedef _Float16 f16x4 __attribute__((ext_vector_type(4)));
typedef _Float16 f16x2 __attribute__((ext_vector_type(2)));
typedef float f32x4 __attribute__((ext_vector_type(4)));
typedef float f32x2 __attribute__((ext_vector_type(2)));
typedef unsigned u32x4 __attribute__((ext_vector_type(4)));
typedef unsigned u32x2 __attribute__((ext_vector_type(2)));
typedef __bf16 bf16x2_t __attribute__((ext_vector_type(2)));
namespace pg8 {
constexpr int BM = 256, BK = 64, HALF = 128, HTB = HALF * BK * 2, STAGE_BYTES = 8 * HTB, NXCD = 8, WGM = 8;
__host__ __device__ __forceinline__ int lds_byte(int r, int c) { const int st = (r >> 4) * 2 + (c >> 5), rr = r & 15, cc = c & 31, ob = rr * 64 + cc * 2; return st * 1024 + (ob ^ (((ob >> 9) & 1) << 5)); }
__host__ __device__ __forceinline__ void stage_rc(int b, int& R, int& C) { const int st = b / 1024, sb = b % 1024, swz = sb ^ (((sb >> 9) & 1) << 5); R = (st >> 1) * 16 + swz / 64; C = (st & 1) * 32 + (swz % 64) / 2; }
struct Unit { int pm, pn; };
struct Gemm { const f16* A; const f16* Bt; int K; };
struct StaticOrder {
    int nM, nN, nwg, G, c;
    __device__ void init(int nM_, int nN_, int G_, int c_) { nM = nM_; nN = nN_; nwg = nM * nN; G = G_; c = c_; }
    __device__ bool next(int i, Unit& u) const {
        const long L = (long)i * G + c; if (L >= nwg) return false;
        int wgid = (int)L; { const int q = nwg / NXCD, r = nwg % NXCD, xcd = wgid % NXCD, off = wgid / NXCD; wgid = (xcd < r ? xcd * (q + 1) : r * (q + 1) + (xcd - r) * q) + off; }
        const int nig = WGM * nN, gid = wgid / nig, fm = gid * WGM, gsz = (nM - fm) < WGM ? (nM - fm) : WGM;
        u.pm = fm + ((wgid % nig) % gsz); u.pn = (wgid % nig) / gsz; return true;
    }
};
struct OneUnit { int pm, pn; __device__ bool next(int i, Unit& u) const { if (i != 0) return false; u.pm = pm; u.pn = pn; return true; } };
template <class Epi, class Sched>
__device__ __forceinline__ void gemm_phase(LAS unsigned char* lds, const Gemm g, const Sched& S, const Epi& E) {
    int tid_ = threadIdx.x; asm volatile("" : "+v"(tid_));
    const int tid = tid_, wid = __builtin_amdgcn_readfirstlane(tid >> 6), lane = tid & 63, wr = wid >> 2, wc = wid & 3, fr = lane & 15, fq = lane >> 4;
    const int K = g.K, nt = K / BK;
    unsigned voffA[2];
#pragma unroll
    for (int i = 0; i < 2; ++i) { int R, C; stage_rc(tid * 16 + i * 8192, R, C); voffA[i] = (unsigned)(R * K + C) * 2u; }
    const size_t kstep = (size_t)(BK * 2);
    const size_t hstep = (size_t)HALF * K * 2;
    const size_t tstep = 2 * hstep;
    const unsigned ldsw = (unsigned)wid * 1024u;
    const int aoff = lds_byte(wr * 64 + fr, fq * 8), boff = lds_byte(wc * 32 + fr, fq * 8);
#define PG8_SA(b, h) (((b) * 2 + (h)) * HTB)
#define PG8_SB(b, h) ((4 + (b) * 2 + (h)) * HTB)
#define PG8_STAGE(bufoff, gbase) do { _Pragma("unroll") for (int _i = 0; _i < 2; ++_i) \
        __builtin_amdgcn_global_load_lds((const unsigned*)((const char*)(gbase) + voffA[_i]), (LAS unsigned*)(lds + (bufoff) + ldsw + _i * 8192), 16, 0, 0); } while (0)
#define PG8_LDA(dst, b, h) do { _Pragma("unroll") for (int m = 0; m < 4; ++m) _Pragma("unroll") for (int k = 0; k < 2; ++k) dst[m][k] = *(const LAS f16x8*)(lds + PG8_SA(b, h) + aoff + m * 2048 + k * 1024); } while (0)
#define PG8_LDB(dst, b, h) do { _Pragma("unroll") for (int n = 0; n < 2; ++n) _Pragma("unroll") for (int k = 0; k < 2; ++k) dst[n][k] = *(const LAS f16x8*)(lds + PG8_SB(b, h) + boff + n * 2048 + k * 1024); } while (0)
#define PG8_MMA(ai, bj, At, Bt) do { __builtin_amdgcn_s_setprio(1); _Pragma("unroll") for (int m = 0; m < 4; ++m) _Pragma("unroll") for (int n = 0; n < 2; ++n) _Pragma("unroll") for (int k = 0; k < 2; ++k) \
        acc[ai][bj][m][n] = __builtin_amdgcn_mfma_f32_16x16x32_f16(Bt[n][k], At[m][k], acc[ai][bj][m][n], 0, 0, 0); __builtin_amdgcn_s_setprio(0); } while (0)
#define PG8_WAIT_V(n) asm volatile("s_waitcnt vmcnt(" #n ")" ::: "memory")
#define PG8_WAIT_L(n) asm volatile("s_waitcnt lgkmcnt(" #n ")" ::: "memory")
#define PG8_BAR __builtin_amdgcn_s_barrier()
#define PG8_SCHED __builtin_amdgcn_sched_barrier(0)
    Unit cur, nxt; int ui = 0;
    if (!S.next(0, cur)) return;
    f32x4 acc[2][2][4][2];
    E.init(acc, cur, wr, wc, fr, fq);
    f16x8 At[4][2], B0[2][2], B1[2][2];
    const char* cA = (const char*)g.A + (size_t)cur.pm * tstep; const char* cB = (const char*)g.Bt + (size_t)cur.pn * tstep;
    PG8_STAGE(PG8_SB(0, 0), cB); PG8_STAGE(PG8_SB(0, 1), cB + hstep); PG8_STAGE(PG8_SA(0, 0), cA); PG8_STAGE(PG8_SA(0, 1), cA + hstep);
    if (wr == 1) PG8_BAR;
    PG8_WAIT_V(2); PG8_BAR;
    PG8_STAGE(PG8_SB(1, 0), cB + kstep); PG8_STAGE(PG8_SA(1, 0), cA + kstep); PG8_STAGE(PG8_SB(1, 1), cB + hstep + kstep);
    PG8_WAIT_V(6); PG8_BAR;
    for (;;) {
        const bool has_next = S.next(ui + 1, nxt);
        const char* nA = has_next ? (const char*)g.A + (size_t)nxt.pm * tstep : cA; const char* nB = has_next ? (const char*)g.Bt + (size_t)nxt.pn * tstep : cB;
        for (int t = 0; t < nt; t += 2) {
            const bool last = (t == nt - 2);
            const char* a1 = cA + (size_t)(t + 1) * kstep;
            const char* a2 = last ? nA : cA + (size_t)(t + 2) * kstep; const char* b2 = last ? nB : cB + (size_t)(t + 2) * kstep;
            const char* a3 = a2 + kstep; const char* b3 = b2 + kstep;
            PG8_LDB(B0, 0, 0); PG8_LDB(B1, 0, 1); PG8_SCHED; PG8_LDA(At, 0, 0); PG8_STAGE(PG8_SA(1, 1), a1 + hstep);
            PG8_WAIT_V(8); PG8_WAIT_L(0); PG8_BAR; PG8_MMA(0, 0, At, B0); PG8_MMA(0, 1, At, B1); PG8_BAR; PG8_SCHED;
            PG8_LDA(At, 0, 1); PG8_STAGE(PG8_SB(0, 0), b2); PG8_STAGE(PG8_SB(0, 1), b2 + hstep); PG8_STAGE(PG8_SA(0, 0), a2);
            PG8_WAIT_V(8); PG8_WAIT_L(0); PG8_BAR; PG8_MMA(1, 0, At, B0); PG8_MMA(1, 1, At, B1); PG8_BAR; PG8_SCHED;
            PG8_LDB(B0, 1, 0); PG8_LDB(B1, 1, 1); PG8_SCHED; PG8_LDA(At, 1, 0); PG8_STAGE(PG8_SA(0, 1), a2 + hstep);
            PG8_WAIT_V(8); PG8_WAIT_L(0); PG8_BAR; PG8_MMA(0, 0, At, B0); PG8_MMA(0, 1, At, B1); PG8_BAR; PG8_SCHED;
            PG8_LDA(At, 1, 1); PG8_STAGE(PG8_SB(1, 0), b3); PG8_STAGE(PG8_SB(1, 1), b3 + hstep); PG8_STAGE(PG8_SA(1, 0), a3);
            PG8_WAIT_V(8); PG8_WAIT_L(0); PG8_BAR; PG8_MMA(1, 0, At, B0); PG8_MMA(1, 1, At, B1); PG8_BAR; PG8_SCHED;
        }
        const bool al = E.aligned(cur);
        if (al && wr == 0) PG8_BAR;
        E(acc, cur, wr, wc, fr, fq);
        if (!has_next) { if (!al && wr == 0) PG8_BAR; break; }
        cur = nxt; cA = nA; cB = nB; ++ui;
        E.init(acc, cur, wr, wc, fr, fq);
        if (al && wr == 1) PG8_BAR;
    }
    PG8_WAIT_V(0);
    PG8_BAR;
#undef PG8_SA
#undef PG8_SB
#undef PG8_STAGE
#undef PG8_LDA
#undef PG8_LDB
#undef PG8_MMA
#undef PG8_WAIT_V
#undef PG8_WAIT_L
#undef PG8_BAR
#undef PG8_SCHED
}
}
constexpr int NWAVES = 8;
constexpr int MPAD = 8448, NPAD = 7936;
constexpr size_t WS_XNH = 450 * MiB;
constexpr size_t WS_WINT = 484 * MiB;
constexpr size_t WS_WOUTT = 516 * MiB;
constexpr size_t WS_PART = 524 * MiB;
constexpr size_t PART_STRIDE = 32768 + 256;
constexpr size_t WS_NEED2 = 536 * MiB;
constexpr int RING_BYTES = 131072, SCR_OFF = RING_BYTES, SCR_BYTES = 8192, MISC_OFF = 145408, LDS_BYTES = 147456;

__device__ __forceinline__ unsigned pk_bf16(float lo, float hi) { f32x2 v = {lo, hi}; bf16x2_t b = __builtin_convertvector(v, bf16x2_t); return __builtin_bit_cast(unsigned, b); }
__device__ __forceinline__ unsigned pk_f16(float lo, float hi) { f32x2 v = {lo, hi}; f16x2 b = __builtin_convertvector(v, f16x2); return __builtin_bit_cast(unsigned, b); }

struct Args { const float* in[14]; float* out; unsigned char* ws; int ph_lo, ph_hi; };

__device__ __forceinline__ int win_src(int np) {
    const int pn = np >> 8, c = np & 255;
    if (pn < 14) return np;
    if (pn == 14) return c < 80 ? np : -1;
    const int T = pn - 15, bj = c >> 7, wc = (c >> 5) & 3, n = (c >> 4) & 1, fqi = c & 15;
    const int base = bj == 0 ? (n == 0 ? OH : OBB) : (n == 0 ? OC : OZC);
    return base + 64 * T + 16 * wc + fqi;
}
template <bool MAP>
__device__ __forceinline__ void p0_transpose_item(const float* W, int N, f16* WT, LAS float* scr, int item, int nblk, int lane) {
    const int kb = item / nblk, nb = item % nblk, k0 = 64 * kb, n0 = 32 * nb;
    const int src = MAP ? win_src(n0 + (lane & 31)) : n0 + (lane & 31);
#pragma unroll 8
    for (int i = 0; i < 32; ++i) { const int kk = 2 * i + (lane >> 5); scr[kk * 33 + (lane & 31)] = src >= 0 ? W[(size_t)(k0 + kk) * N + src] : 0.f; }
    asm volatile("s_waitcnt lgkmcnt(0)" ::: "memory");
    const int c = lane & 7;
#pragma unroll
    for (int j = 0; j < 4; ++j) { const int n = (lane >> 3) + 8 * j; const LAS float* s = scr + (8 * c) * 33 + n;
        u32x4 o; o.x = pk_f16(s[0 * 33], s[1 * 33]); o.y = pk_f16(s[2 * 33], s[3 * 33]); o.z = pk_f16(s[4 * 33], s[5 * 33]); o.w = pk_f16(s[6 * 33], s[7 * 33]);
        *(u32x4*)(WT + (size_t)(n0 + n) * 2048 + k0 + 8 * c) = o; }
    asm volatile("s_waitcnt lgkmcnt(0)" ::: "memory");
}
__device__ __forceinline__ float wave_sum(float v) {
#pragma unroll
    for (int o = 1; o < 64; o <<= 1) v += __shfl_xor(v, o);
    return v;
}
__device__ __forceinline__ void p0_prologue(const Args& a, LAS unsigned char* lds, int vcu, int G, int wave, int lane) {
    LAS float* scr = (LAS float*)(lds + wave * 16384);
    const int gw = vcu * NWAVES + wave, NGW = G * NWAVES;
    const float* win = a.in[8]; const float* wout = a.in[13];
    f16* WinT = (f16*)(a.ws + WS_WINT); f16* WoutT = (f16*)(a.ws + WS_WOUTT); f16* XN = (f16*)(a.ws + WS_XNH);
    constexpr int I_IN = 32 * (NPAD / 32), I_OUT = 32 * (DM / 32);
    for (int it = gw; it < I_IN + I_OUT; it += NGW) {
        if (it < I_IN) p0_transpose_item<true>(win, DIN, WinT, scr, it, NPAD / 32, lane);
        else p0_transpose_item<false>(wout, DM, WoutT, scr, it - I_IN, DM / 32, lane);
    }
    const float* gin = a.in[7];
    for (int m = gw; m < MT; m += NGW) {
        const float* xrow = m < MP ? a.in[0] + (size_t)m * DM : a.in[1] + (size_t)(m - MP) * DM;
        const f32x4* xr = (const f32x4*)xrow + lane; f32x4 v[8]; float s = 0.f;
#pragma unroll
        for (int j = 0; j < 8; ++j) { v[j] = xr[64 * j]; s += (v[j].x * v[j].x + v[j].y * v[j].y) + (v[j].z * v[j].z + v[j].w * v[j].w); }
        const float rs = rsqrtf(wave_sum(s) * (1.f / DM) + EPS);
        u32x2* o8 = (u32x2*)(XN + (size_t)m * DM) + lane;
#pragma unroll
        for (int j = 0; j < 8; ++j) { const f32x4 gv = ((const f32x4*)gin)[lane + 64 * j]; u32x2 w; w.x = pk_f16(v[j].x * rs * gv.x, v[j].y * rs * gv.y); w.y = pk_f16(v[j].z * rs * gv.z, v[j].w * rs * gv.w); o8[64 * j] = w; }
    }
    float* rqk = (float*)(a.ws + WS_ROPE); float* ri = (float*)(a.ws + WS_ROPE_I);
    for (int i = gw * 64 + lane; i < 2052 * 16; i += NGW * 64) {
        { int slot = i / 16, j = i % 16; int pos = slot < 2048 ? slot : PAST + (slot - 2048);
          float inv = (float)pow(500000.0, -(double)j / 16.0); float ang = (float)pos * inv;
          rqk[(slot * 16 + j) * 2] = (float)cos((double)ang); rqk[(slot * 16 + j) * 2 + 1] = (float)sin((double)ang); }
        if (i < 2052 * 8) { int slot = i / 8, j = i % 8; int pos = slot < 2048 ? slot : PAST + (slot - 2048);
          float inv = (float)pow(500000.0, -(double)j / 8.0); float ang = (float)pos * inv;
          ri[(slot * 8 + j) * 2] = (float)cos((double)ang); ri[(slot * 8 + j) * 2 + 1] = (float)sin((double)ang); }
    }
}

struct EpiIn {
    float* out; unsigned char* ws; const float* gq; const float* gk; const float* gki; LAS float* scr;
    __device__ __forceinline__ bool aligned(const pg8::Unit& u) const { return u.pn <= 4 || u.pn == 14; }
    __device__ __forceinline__ void init(f32x4 (&acc)[2][2][4][2], const pg8::Unit&, int, int, int, int) const {
#pragma unroll
        for (int a = 0; a < 2; ++a)
#pragma unroll
            for (int b = 0; b < 2; ++b)
#pragma unroll
                for (int m = 0; m < 4; ++m)
#pragma unroll
                    for (int n = 0; n < 2; ++n) acc[a][b][m][n] = (f32x4){0.f, 0.f, 0.f, 0.f};
    }
    __device__ __forceinline__ void operator()(f32x4 (&acc)[2][2][4][2], const pg8::Unit& u, int wr, int wc, int fr_, int fq_) const {
        int fr = fr_, fq = fq_; asm volatile("" : "+v"(fr), "+v"(fq));
        GAS unsigned char* ws = (GAS unsigned char*)this->ws; GAS float* out = (GAS float*)this->out; asm volatile("" : "+s"(ws), "+s"(out));
        const int pn = u.pn, pm = u.pm; const bool smp = pm == 32;
        const int rbase = 64 * wr + fr;
        const int bb = pm >> 3, t0 = (pm & 7) << 8;
        const GAS float* rqk = (const GAS float*)(ws + WS_ROPE); const GAS float* ri = (const GAS float*)(ws + WS_ROPE_I);
#define ROWLOOP _Pragma("unroll") for (int ai = 0; ai < 2; ++ai) _Pragma("unroll") for (int m = 0; m < 4; ++m)
#define ROWVARS const int r = rbase + 128 * ai + 16 * m; const bool valid = !smp || r < MS; const int grow = smp ? MP + r : pm * 256 + r; const int tt = smp ? (r & 3) : t0 + r; const int slot = smp ? 2048 + (r & 3) : tt; (void)grow; (void)tt; (void)slot; (void)valid;
        if (pn <= 4 || pn == 14) {
            const bool isk = pn == 14;
            ROWLOOP { asm volatile("" ::: "memory"); const int r = rbase + 128 * ai + 16 * m;
#pragma unroll
                for (int bj = 0; bj < 2; ++bj) { float s = 0.f;
#pragma unroll
                    for (int n = 0; n < 2; ++n) { const f32x4 x = acc[ai][bj][m][n]; s += (x[0] * x[0] + x[1] * x[1]) + (x[2] * x[2] + x[3] * x[3]); }
                    if (isk && (wc >= 2 || bj == 1)) s = 0.f;
                    s += __shfl_xor(s, 16); s += __shfl_xor(s, 32);
                    if (fq == 0) scr[(r * 2 + bj) * 4 + wc] = s; } }
            asm volatile("s_waitcnt lgkmcnt(0)" ::: "memory"); __builtin_amdgcn_s_barrier(); asm volatile("" ::: "memory");
            if (!isk) {
                const GAS float* g = (const GAS float*)(pn < 4 ? gq : gk); const int dl = 32 * wc + 4 * fq;
                const f32x4 g0 = *(const GAS f32x4*)(g + dl), g1 = *(const GAS f32x4*)(g + dl + 16);
                GAS bf16_t* Qb = (GAS bf16_t*)(ws + WS_QB); GAS bf16_t* Kb = (GAS bf16_t*)(ws + WS_KB); GAS float* QS = (GAS float*)(ws + WS_QS);
                ROWLOOP { asm volatile("" ::: "memory"); ROWVARS
                    f32x4 cs0 = {1.f, 0.f, 1.f, 0.f}, cs1 = {1.f, 0.f, 1.f, 0.f};
                    if (wc == 0) { const GAS f32x4* cp = (const GAS f32x4*)(rqk + (slot * 16 + 4 * fq) * 2); cs0 = cp[0]; cs1 = cp[1]; }
#pragma unroll
                    for (int bj = 0; bj < 2; ++bj) {
                        const f32x4 p = *(const LAS f32x4*)(scr + (r * 2 + bj) * 4);
                        const float rs = rsqrtf(((p[0] + p[1]) + (p[2] + p[3])) * (1.f / 128.f) + EPS);
                        f32x4 x0 = acc[ai][bj][m][0] * rs * g0, x1 = acc[ai][bj][m][1] * rs * g1;
                        if (wc == 0) { const f32x4 c = {cs0[0], cs0[2], cs1[0], cs1[2]}, s = {cs0[1], cs0[3], cs1[1], cs1[3]};
                            const f32x4 y0 = x0 * c - x1 * s, y1 = x1 * c + x0 * s; x0 = y0; x1 = y1; }
                        const int hh = 2 * pn + bj;
                        if (pn < 4) {
                            if (smp) { if (valid) { GAS float* q = QS + (size_t)r * 1024 + hh * 128 + dl; *(GAS f32x4*)q = x0; *(GAS f32x4*)(q + 16) = x1; } }
                            else { GAS bf16_t* q = Qb + (((size_t)bb * NH + hh) * S + tt) * HD + dl;
                                u32x2 w0 = {pk_bf16(x0[0], x0[1]), pk_bf16(x0[2], x0[3])}, w1 = {pk_bf16(x1[0], x1[1]), pk_bf16(x1[2], x1[3])};
                                *(GAS u32x2*)q = w0; *(GAS u32x2*)(q + 16) = w1; }
                        } else {
                            if (smp) { if (valid) { GAS float* k = out + O_KS + (size_t)r * 256 + bj * 128 + dl; *(GAS f32x4*)k = x0; *(GAS f32x4*)(k + 16) = x1; } }
                            else { GAS float* k = out + O_KP + (size_t)grow * 256 + bj * 128 + dl; *(GAS f32x4*)k = x0; *(GAS f32x4*)(k + 16) = x1;
                                GAS bf16_t* kb = Kb + (((size_t)bb * NKV + bj) * S + tt) * HD + dl;
                                u32x2 w0 = {pk_bf16(x0[0], x0[1]), pk_bf16(x0[2], x0[3])}, w1 = {pk_bf16(x1[0], x1[1]), pk_bf16(x1[2], x1[3])};
                                *(GAS u32x2*)kb = w0; *(GAS u32x2*)(kb + 16) = w1; }
                        } } }
            } else {
                const int dl = 32 * (wc & 1) + 4 * fq;
                const f32x4 g0 = *(const GAS f32x4*)((const GAS float*)gki + dl), g1 = *(const GAS f32x4*)((const GAS float*)gki + dl + 16);
                GAS f16* KI = (GAS f16*)(ws + WS_KI); GAS float* WI = (GAS float*)(ws + WS_WI);
                ROWLOOP { asm volatile("" ::: "memory"); ROWVARS
                    const f32x4 p = *(const LAS f32x4*)(scr + (r * 2) * 4);
                    const float rs = rsqrtf((p[0] + p[1]) * (1.f / 64.f) + EPS);
                    f32x4 x0 = acc[ai][0][m][0] * rs * g0, x1 = acc[ai][0][m][1] * rs * g1;
                    f32x4 xo; xo[0] = __shfl_xor(x0[0], 32); xo[1] = __shfl_xor(x0[1], 32); xo[2] = __shfl_xor(x0[2], 32); xo[3] = __shfl_xor(x0[3], 32);
                    if (wc == 0) { const GAS f32x4* cp = (const GAS f32x4*)(ri + (slot * 8 + 4 * (fq & 1)) * 2); const f32x4 cs0 = cp[0], cs1 = cp[1];
                        const f32x4 c = {cs0[0], cs0[2], cs1[0], cs1[2]}, s = {cs0[1], cs0[3], cs1[1], cs1[3]};
                        x0 = fq < 2 ? x0 * c - xo * s : x0 * c + xo * s; }
                    if (wc < 2 && valid) {
                        GAS float* ko = smp ? out + O_KIS + (size_t)r * 64 + dl : out + O_KIP + (size_t)grow * 64 + dl;
                        *(GAS f32x4*)ko = x0; *(GAS f32x4*)(ko + 16) = x1;
                        if (!smp) { GAS f16* kh = KI + (size_t)grow * 64 + dl; u32x2 w0 = {pk_f16(x0[0], x0[1]), pk_f16(x0[2], x0[3])}, w1 = {pk_f16(x1[0], x1[1]), pk_f16(x1[2], x1[3])};
                            *(GAS u32x2*)kh = w0; *(GAS u32x2*)(kh + 16) = w1; } }
                    if (wc == 2 && valid) *(GAS f32x4*)(WI + (size_t)grow * 16 + 4 * fq) = acc[ai][0][m][0] * (1.f / 32.f);
                }
            }
        } else if (pn == 5) {
            GAS bf16_t* Vb = (GAS bf16_t*)(ws + WS_VB); const int dl = 32 * wc + 4 * fq;
            ROWLOOP { asm volatile("" ::: "memory"); ROWVARS
#pragma unroll
                for (int bj = 0; bj < 2; ++bj) { const f32x4 x0 = acc[ai][bj][m][0], x1 = acc[ai][bj][m][1];
                    if (smp) { if (valid) { GAS float* v = out + O_VS + (size_t)r * 256 + bj * 128 + dl; *(GAS f32x4*)v = x0; *(GAS f32x4*)(v + 16) = x1; } }
                    else { GAS float* v = out + O_VP + (size_t)grow * 256 + bj * 128 + dl; *(GAS f32x4*)v = x0; *(GAS f32x4*)(v + 16) = x1;
                        GAS bf16_t* vb = Vb + (((size_t)bb * NKV + bj) * S + tt) * HD + dl;
                        u32x2 w0 = {pk_bf16(x0[0], x0[1]), pk_bf16(x0[2], x0[3])}, w1 = {pk_bf16(x1[0], x1[1]), pk_bf16(x1[2], x1[3])};
                        *(GAS u32x2*)vb = w0; *(GAS u32x2*)(vb + 16) = w1; } } }
        } else if (pn <= 9) {
            GAS f16* SZ = (GAS f16*)(ws + WS_SZ); const int c0 = 256 * (pn - 6) + 32 * wc + 4 * fq;
            ROWLOOP { asm volatile("" ::: "memory"); ROWVARS
                if (valid) {
#pragma unroll
                    for (int bj = 0; bj < 2; ++bj)
#pragma unroll
                        for (int n = 0; n < 2; ++n) { const f32x4 x = acc[ai][bj][m][n]; u32x2 w = {pk_f16(silu(x[0]), silu(x[1])), pk_f16(silu(x[2]), silu(x[3]))};
                            *(GAS u32x2*)(SZ + (size_t)grow * 1024 + c0 + 128 * bj + 16 * n) = w; } } }
        } else if (pn <= 13) {
            GAS f16* QI = (GAS f16*)(ws + WS_QI); const int c0 = 256 * (pn - 10) + 32 * wc + 4 * fq;
            ROWLOOP { asm volatile("" ::: "memory"); ROWVARS
                f32x4 c = {1.f, 1.f, 1.f, 1.f}, s = {0.f, 0.f, 0.f, 0.f};
                if ((wc & 1) == 0) { const GAS f32x4* cp = (const GAS f32x4*)(ri + (slot * 8 + 4 * (fq & 1)) * 2); const f32x4 cs0 = cp[0], cs1 = cp[1];
                    c = (f32x4){cs0[0], cs0[2], cs1[0], cs1[2]}; s = (f32x4){cs0[1], cs0[3], cs1[1], cs1[3]}; }
#pragma unroll
                for (int bj = 0; bj < 2; ++bj) { f32x4 x0 = acc[ai][bj][m][0]; const f32x4 x1 = acc[ai][bj][m][1];
                    f32x4 xo; xo[0] = __shfl_xor(x0[0], 32); xo[1] = __shfl_xor(x0[1], 32); xo[2] = __shfl_xor(x0[2], 32); xo[3] = __shfl_xor(x0[3], 32);
                    if ((wc & 1) == 0) x0 = fq < 2 ? x0 * c - xo * s : x0 * c + xo * s;
                    if (valid) { GAS f16* q = QI + (size_t)grow * 1024 + c0 + 128 * bj;
                        u32x2 w0 = {pk_f16(x0[0], x0[1]), pk_f16(x0[2], x0[3])}, w1 = {pk_f16(x1[0], x1[1]), pk_f16(x1[2], x1[3])};
                        *(GAS u32x2*)q = w0; *(GAS u32x2*)(q + 16) = w1; } } }
        } else {
            GAS f16* U = (GAS f16*)(ws + WS_U); GAS f16* G = (GAS f16*)(ws + WS_G); const int ch = 64 * (pn - 15) + 16 * wc + 4 * fq;
            ROWLOOP { asm volatile("" ::: "memory"); ROWVARS
                const f32x4 h = acc[ai][0][m][0], b = acc[ai][0][m][1], c = acc[ai][1][m][0], z = acc[ai][1][m][1];
                const f32x4 uu = c * h; f32x4 gg; gg[0] = b[0] * silu(z[0]); gg[1] = b[1] * silu(z[1]); gg[2] = b[2] * silu(z[2]); gg[3] = b[3] * silu(z[3]);
                if (valid) { u32x2 wu = {pk_f16(uu[0], uu[1]), pk_f16(uu[2], uu[3])}, wg = {pk_f16(gg[0], gg[1]), pk_f16(gg[2], gg[3])};
                    *(GAS u32x2*)(U + (size_t)grow * 1024 + ch) = wu; *(GAS u32x2*)(G + (size_t)grow * 1024 + ch) = wg;
                    if (!smp && tt >= S - 2) *(GAS f32x4*)(out + O_CVP + ((size_t)bb * 2 + (tt - (S - 2))) * 1024 + ch) = uu;
                    if (smp && tt >= 2) *(GAS f32x4*)(out + O_CVS + ((size_t)(r >> 2) * 2 + (tt - 2)) * 1024 + ch) = uu; } }
        }
#undef ROWLOOP
#undef ROWVARS
    }
};


struct EpiOut {
    float* out; const float* xp;
    __device__ __forceinline__ bool aligned(const pg8::Unit&) const { return false; }
    __device__ __forceinline__ void init(f32x4 (&acc)[2][2][4][2], const pg8::Unit& u, int wr, int wc, int fr, int fq) const {
        const GAS float* xp = (const GAS float*)this->xp;
        const size_t base = (size_t)(u.pm * 256 + 64 * wr + fr) * DM + u.pn * 256 + 32 * wc + 4 * fq;
#pragma unroll
        for (int ai = 0; ai < 2; ++ai)
#pragma unroll
            for (int m = 0; m < 4; ++m)
#pragma unroll
                for (int bj = 0; bj < 2; ++bj)
#pragma unroll
                    for (int n = 0; n < 2; ++n) acc[ai][bj][m][n] = *(const GAS f32x4*)(xp + base + (size_t)(128 * ai + 16 * m) * DM + 128 * bj + 16 * n);
    }
    __device__ __forceinline__ void operator()(f32x4 (&acc)[2][2][4][2], const pg8::Unit& u, int wr, int wc, int fr_, int fq_) const {
        int fr = fr_, fq = fq_; asm volatile("" : "+v"(fr), "+v"(fq));
        GAS float* out = (GAS float*)this->out; asm volatile("" : "+s"(out));
        const size_t base = (size_t)(u.pm * 256 + 64 * wr + fr) * DM + u.pn * 256 + 32 * wc + 4 * fq;
#pragma unroll
        for (int ai = 0; ai < 2; ++ai)
#pragma unroll
            for (int m = 0; m < 4; ++m) { const size_t off = base + (size_t)(128 * ai + 16 * m) * DM;
#pragma unroll
                for (int bj = 0; bj < 2; ++bj)
#pragma unroll
                    for (int n = 0; n < 2; ++n) *(GAS f32x4*)(out + off + 128 * bj + 16 * n) = acc[ai][bj][m][n]; }
    }
};
__device__ __forceinline__ void p4_sample(const Args& a, LAS unsigned char* lds, int bx, int G, int tid) {
    const GAS f16* MIX = (const GAS f16*)(a.ws + WS_MIX) + (size_t)MP * DM; const GAS f16* WT = (const GAS f16*)(a.ws + WS_WOUTT);
    LAS float* part = (LAS float*)lds;
    const int lane = tid & 63, wave = __builtin_amdgcn_readfirstlane(tid >> 6), fr = lane & 15, fq = lane >> 4;
    for (int cg = bx; cg < DM / 8; cg += G) {
        const GAS f16* wp = WT + (size_t)(cg * 8 + (fr & 7)) * DM + wave * 256 + 8 * fq; const GAS f16* mp = MIX + (size_t)fr * DM + wave * 256 + 8 * fq;
        f16x8 wf[8], m0[8], m1[8];
#pragma unroll
        for (int ks = 0; ks < 8; ++ks) { wf[ks] = *(const GAS f16x8*)(wp + 32 * ks); m0[ks] = *(const GAS f16x8*)(mp + 32 * ks); m1[ks] = *(const GAS f16x8*)(mp + (size_t)16 * DM + 32 * ks); }
        f32x4 c0 = {0.f, 0.f, 0.f, 0.f}, c1 = {0.f, 0.f, 0.f, 0.f};
#pragma unroll
        for (int ks = 0; ks < 8; ++ks) { c0 = __builtin_amdgcn_mfma_f32_16x16x32_f16(wf[ks], m0[ks], c0, 0, 0, 0); c1 = __builtin_amdgcn_mfma_f32_16x16x32_f16(wf[ks], m1[ks], c1, 0, 0, 0); }
        *(LAS f32x4*)(part + ((wave * 2 + 0) * 64 + lane) * 4) = c0; *(LAS f32x4*)(part + ((wave * 2 + 1) * 64 + lane) * 4) = c1;
        __syncthreads();
        if (tid < 256) { const int rr = tid >> 3, cc = tid & 7; const int ln = (rr & 15) + 16 * (cc >> 2), tl = rr >> 4; float s = a.in[1][(size_t)rr * DM + cg * 8 + cc];
#pragma unroll
            for (int w = 0; w < 8; ++w) s += part[((w * 2 + tl) * 64 + ln) * 4 + (cc & 3)];
            a.out[O_YS + (size_t)rr * DM + cg * 8 + cc] = s; }
        __syncthreads();
    }
}
typedef GAS unsigned gu32;
#define XB_TMO      128
#define XB_XCNT(j)  (256  + 64 * (j))
#define XB_XSUB(j)  (1280 + 64 * (j))
#define XB_XGEN(j)  (2304 + 64 * (j))
#define XB_TOP      3328
#define XB_TOPGEN   3392
#define XCD_BAR_WORDS 3456
#define XB_SPIN_CAP (1u << 18)
__device__ __forceinline__ unsigned xb_ld(unsigned* p)              { return __hip_atomic_load(p, __ATOMIC_RELAXED, __HIP_MEMORY_SCOPE_AGENT); }
__device__ __forceinline__ unsigned xb_add(unsigned* p, unsigned v) { return __hip_atomic_fetch_add(p, v, __ATOMIC_RELAXED, __HIP_MEMORY_SCOPE_AGENT); }
__device__ __forceinline__ unsigned xb_xcc_id() { return (unsigned)__builtin_amdgcn_s_getreg((3 << 11) | 20) & 0xFu; }
#define XB_SPIN(cond, bar) do { unsigned _sp = 0; while (cond) { __builtin_amdgcn_s_sleep(1); \
    if ((++_sp & 255u) == 0u) { if (xb_ld(&(bar)[XB_TMO])) break; if (_sp > XB_SPIN_CAP) { atomicAdd(&(bar)[XB_TMO], 1u); break; } } } } while (0)
struct XcdBarrier { unsigned* bar; unsigned x; volatile LAS unsigned* st; };
__device__ __forceinline__ XcdBarrier xcd_barrier_post(unsigned* bar, volatile LAS unsigned* st) {
    XcdBarrier b; b.bar = bar; b.x = xb_xcc_id(); b.st = st;
    if (threadIdx.x == 0) (void)xb_add(&bar[XB_XCNT(b.x)], 1u);
    return b;
}
__device__ __forceinline__ void xcd_barrier_complete(unsigned* bar, unsigned x, unsigned& nloc, unsigned& nx) {
    const unsigned G = gridDim.x * gridDim.y * gridDim.z;
    unsigned sum, cnt, mine, sp = 0u;
    for (;;) {
        sum = 0u; cnt = 0u; mine = 0u;
#pragma unroll
        for (unsigned j = 0; j < 16; ++j) { const unsigned c = xb_ld(&bar[XB_XCNT(j)]); sum += c; cnt += (c > 0u) ? 1u : 0u; mine = (j == x) ? c : mine; }
        if (sum == G) break;
        __builtin_amdgcn_s_sleep(1);
        if ((++sp & 255u) == 0u) { if (xb_ld(&bar[XB_TMO])) break; if (sp > XB_SPIN_CAP) { atomicAdd(&bar[XB_TMO], 1u); break; } }
    }
    nloc = mine > 0u ? mine : 1u; nx = cnt > 0u ? cnt : 1u;
}
__device__ __forceinline__ void xcd_barrier(const XcdBarrier& b) {
    asm volatile("s_waitcnt vmcnt(0)" ::: "memory");
    __syncthreads();
    if (threadIdx.x == 0) {
        unsigned* bar = b.bar;
        __builtin_amdgcn_s_waitcnt(0);
        unsigned nloc = b.st[0], nx = b.st[1];
        if (nloc == 0u) { xcd_barrier_complete(bar, b.x, nloc, nx); b.st[0] = nloc; b.st[1] = nx; }
        const unsigned old = xb_add(&bar[XB_XSUB(b.x)], 1u);
        const unsigned gen = old / nloc;
        if (old + 1u == (gen + 1u) * nloc) {
            __builtin_amdgcn_fence(__ATOMIC_RELEASE, "agent");
            asm volatile("s_waitcnt vmcnt(0)" ::: "memory");
            const unsigned og = xb_add(&bar[XB_TOP], 1u);
            const unsigned tg = og / nx;
            if (og + 1u == (tg + 1u) * nx) xb_add(&bar[XB_TOPGEN], 1u);
            else XB_SPIN(xb_ld(&bar[XB_TOPGEN]) == tg, bar);
            __builtin_amdgcn_fence(__ATOMIC_ACQUIRE, "agent");
            xb_add(&bar[XB_XGEN(b.x)], 1u);
            asm volatile("s_waitcnt vmcnt(0)" ::: "memory");
        } else {
            XB_SPIN(xb_ld(&bar[XB_XGEN(b.x)]) == gen, bar);
            __builtin_amdgcn_fence(__ATOMIC_ACQUIRE, "agent");
            asm volatile("s_waitcnt vmcnt(0)" ::: "memory");
        }
    }
    __syncthreads();
}

constexpr int RDY_WORD0 = 4096;
__device__ __forceinline__ void signal_add(unsigned* ctr) {
    asm volatile("s_waitcnt vmcnt(0)" ::: "memory");
    __syncthreads();
    if (threadIdx.x == 0) { __builtin_amdgcn_fence(__ATOMIC_RELEASE, "agent"); asm volatile("s_waitcnt vmcnt(0)" ::: "memory"); (void)xb_add(ctr, 1u); }
}
__device__ __forceinline__ void wait_ge(unsigned* ctr, unsigned need) {
    if (threadIdx.x == 0) { unsigned sp = 0; while (xb_ld(ctr) < need) { __builtin_amdgcn_s_sleep(2); if (++sp > (1u << 22)) break; }
        __builtin_amdgcn_fence(__ATOMIC_ACQUIRE, "agent"); asm volatile("s_waitcnt vmcnt(0)" ::: "memory"); }
    __syncthreads();
}

__device__ __forceinline__ void signal_add_wt(unsigned* ctr) {
    asm volatile("s_waitcnt vmcnt(0)" ::: "memory");
    __syncthreads();
    if (threadIdx.x == 0) (void)xb_add(ctr, 1u);
}
__device__ __forceinline__ void wait_ge_wt(unsigned* ctr, unsigned need) {
    if (threadIdx.x == 0) { unsigned sp = 0; while (xb_ld(ctr) < need) { __builtin_amdgcn_s_sleep(2); if (++sp > (1u << 22)) break; } }
    __syncthreads();
}

#ifndef P2_KT_REP
#define P2_KT_REP 1
#define P2_SEL_REP 1
#endif
#ifndef P2_REP_A
#define P2_REP_A 1
#define P2_REP_B 1
#define P2_REP_C 1
#endif
constexpr int SC_STRIDE = 2052;
constexpr int SC_BYTES = 16 * SC_STRIDE * 4;
constexpr int WSCR_OFF = 131584, WSCR_BYTES = 1536;
__device__ __forceinline__ f16x8 cvt8(f32x4 a, f32x4 b) { u32x4 w = {pk_f16(a[0], a[1]), pk_f16(a[2], a[3]), pk_f16(b[0], b[1]), pk_f16(b[2], b[3])}; return __builtin_bit_cast(f16x8, w); }

__device__ __forceinline__ void p2_convmix(const Args& a, int gw, int NGW, int lane) {
    const GAS f16* U = (const GAS f16*)(a.ws + WS_U); const GAS f16* Gm = (const GAS f16*)(a.ws + WS_G); GAS f16* MIX = (GAS f16*)(a.ws + WS_MIX);
    const GAS float* wconv = (const GAS float*)a.in[12]; const GAS float* state = (const GAS float*)a.in[5];
    for (int ch = gw; ch < MT / 4; ch += NGW) {
        const int row0 = 4 * ch; const bool smp = row0 >= MP; const int t0 = smp ? 0 : (row0 & (S - 1)); const int seq = (row0 - MP) >> 2;
#pragma unroll
        for (int half = 0; half < 2; ++half) { const int cb = half * 512 + 8 * lane;
            float um2[8], um1[8], w0[8], w1[8], w2[8];
#pragma unroll
            for (int e = 0; e < 8; e += 4) { const f32x4 a0 = *(const GAS f32x4*)(wconv + cb + e), a1 = *(const GAS f32x4*)(wconv + 1024 + cb + e), a2 = *(const GAS f32x4*)(wconv + 2048 + cb + e);
#pragma unroll
                for (int i = 0; i < 4; ++i) { w0[e + i] = a0[i]; w1[e + i] = a1[i]; w2[e + i] = a2[i]; } }
            if (t0 == 0) {
                if (smp) {
#pragma unroll
                    for (int e = 0; e < 8; e += 4) { const f32x4 s0 = *(const GAS f32x4*)(state + ((size_t)seq * 2) * 1024 + cb + e), s1 = *(const GAS f32x4*)(state + ((size_t)seq * 2 + 1) * 1024 + cb + e);
#pragma unroll
                        for (int i = 0; i < 4; ++i) { um2[e + i] = s0[i]; um1[e + i] = s1[i]; } }
                } else {
#pragma unroll
                    for (int e = 0; e < 8; ++e) { um2[e] = 0.f; um1[e] = 0.f; } }
            } else { const f16x8 p2 = *(const GAS f16x8*)(U + (size_t)(row0 - 2) * 1024 + cb), p1 = *(const GAS f16x8*)(U + (size_t)(row0 - 1) * 1024 + cb);
#pragma unroll
                for (int e = 0; e < 8; ++e) { um2[e] = (float)p2[e]; um1[e] = (float)p1[e]; } }
#pragma unroll
            for (int i = 0; i < 4; ++i) { const size_t row = row0 + i;
                const f16x8 uv = *(const GAS f16x8*)(U + row * 1024 + cb), gv = *(const GAS f16x8*)(Gm + row * 1024 + cb); float o[8];
#pragma unroll
                for (int e = 0; e < 8; ++e) { const float u = (float)uv[e]; const float cv = w0[e] * um2[e] + w1[e] * um1[e] + w2[e] * u; o[e] = (float)gv[e] * cv; um2[e] = um1[e]; um1[e] = u; }
                u32x4 w = {pk_f16(o[0], o[1]), pk_f16(o[2], o[3]), pk_f16(o[4], o[5]), pk_f16(o[6], o[7])};
                *(GAS u32x4*)(MIX + row * 2048 + 1024 + cb) = w; }
        }
    }
}

__device__ __forceinline__ void p2_sscore(const Args& a, int gw, int NGW, int lane) {
    const GAS float* cki = (const GAS float*)a.in[4]; const GAS int* ptab = (const GAS int*)a.in[6];
    const GAS f16* QI = (const GAS f16*)(a.ws + WS_QI); const GAS float* WI = (const GAS float*)(a.ws + WS_WI); GAS float* SSC = (GAS float*)(a.ws + WS_SSC);
    const int fr = lane & 15, fq = lane >> 4;
    for (int it = gw; it < NSB * 256; it += NGW) {
        const int sb = it >> 8, hp = it & 255, pg = hp >> 1, k0 = (hp & 1) * 64; const int phys = ptab[sb * NPAGES + pg];
        const GAS float* kbase = cki + ((size_t)phys * PAGE + k0) * 64;
        f16x8 qf[4][2]; f32x4 wv[4];
#pragma unroll
        for (int t = 0; t < 4; ++t) { const size_t row = MP + 4 * sb + t;
            qf[t][0] = *(const GAS f16x8*)(QI + row * 1024 + fr * 64 + 8 * fq); qf[t][1] = *(const GAS f16x8*)(QI + row * 1024 + fr * 64 + 32 + 8 * fq);
            wv[t] = *(const GAS f32x4*)(WI + row * 16 + 4 * fq); }
#pragma unroll
        for (int tile = 0; tile < 4; ++tile) {
            const GAS float* kr = kbase + (size_t)(16 * tile + fr) * 64 + 8 * fq;
            const f16x8 kf0 = cvt8(*(const GAS f32x4*)kr, *(const GAS f32x4*)(kr + 4)), kf1 = cvt8(*(const GAS f32x4*)(kr + 32), *(const GAS f32x4*)(kr + 36));
            float mine = 0.f;
#pragma unroll
            for (int t = 0; t < 4; ++t) { f32x4 c = {0.f, 0.f, 0.f, 0.f};
                c = __builtin_amdgcn_mfma_f32_16x16x32_f16(qf[t][0], kf0, c, 0, 0, 0); c = __builtin_amdgcn_mfma_f32_16x16x32_f16(qf[t][1], kf1, c, 0, 0, 0);
                float s = wv[t][0] * fmaxf(c[0], 0.f) + wv[t][1] * fmaxf(c[1], 0.f) + wv[t][2] * fmaxf(c[2], 0.f) + wv[t][3] * fmaxf(c[3], 0.f);
                s += __shfl_xor(s, 16); s += __shfl_xor(s, 32);
                mine = fq == t ? s : mine; }
            __hip_atomic_store((GAS unsigned*)SSC + ((size_t)(4 * sb + fq) * PAST + pg * PAGE + k0 + 16 * tile + fr), __builtin_bit_cast(unsigned, mine), __ATOMIC_RELAXED, __HIP_MEMORY_SCOPE_AGENT);
        }
    }
}

__device__ __forceinline__ void wave_topk_mask(const LAS float* row, int t, GAS unsigned long long* mrow, int lane, LAS unsigned* hist, LAS float* cand) {
    const float NINF = -__builtin_inff(), PINF = __builtin_inff();
    const int jmax = t >> 6;
    float v[32]; float mx = NINF, mn = PINF;
#pragma unroll
    for (int j = 0; j < 32; ++j) { v[j] = NINF; if (j <= jmax) { const int s = 64 * j + lane; const float x = row[s]; const bool ok = s <= t; v[j] = ok ? x : NINF; mx = fmaxf(mx, v[j]); mn = fminf(mn, ok ? x : PINF); } }
#pragma unroll
    for (int o = 1; o < 64; o <<= 1) { mx = fmaxf(mx, __shfl_xor(mx, o)); mn = fminf(mn, __shfl_xor(mn, o)); }
    *(LAS u32x4*)(hist + 4 * lane) = (u32x4){0u, 0u, 0u, 0u};
    const float scale = 255.5f / (mx - mn);
    float tau = 0.f; bool have = false;
    if (mx > mn) {
        asm volatile("s_waitcnt lgkmcnt(0)" ::: "memory");
        unsigned bins[8];
#pragma unroll
        for (int j = 0; j < 8; ++j) bins[j] = 0u;
#pragma unroll
        for (int j = 0; j < 32; ++j) { if (j <= jmax) { int b = (int)((v[j] - mn) * scale); b = b > 255 ? 255 : (b < 0 ? 0 : b); bins[j >> 2] |= (unsigned)b << (8 * (j & 3));
            if (64 * j + lane <= t) __hip_atomic_fetch_add(hist + b, 1u, __ATOMIC_RELAXED, __HIP_MEMORY_SCOPE_WORKGROUP); } }
        asm volatile("s_waitcnt lgkmcnt(0)" ::: "memory");
        const u32x4 h = *(const LAS u32x4*)(hist + 4 * lane);
        const unsigned sl = h[0] + h[1] + h[2] + h[3]; unsigned pre = sl;
#pragma unroll
        for (int o = 1; o < 64; o <<= 1) { const unsigned y = __shfl_up(pre, o); if (lane >= o) pre += y; }
        const unsigned tot = __builtin_amdgcn_readlane(pre, 63); const unsigned suf = tot - pre + sl;
        const unsigned long long bm = __ballot(suf >= TOPK);
        const int Ls = 63 - __builtin_clzll(bm);
        unsigned c = __builtin_amdgcn_readlane(suf, Ls) - __builtin_amdgcn_readlane(sl, Ls);
        const unsigned h3 = __builtin_amdgcn_readlane(h[3], Ls), h2 = __builtin_amdgcn_readlane(h[2], Ls), h1 = __builtin_amdgcn_readlane(h[1], Ls);
        int Bs;
        if (c + h3 >= TOPK) Bs = 4 * Ls + 3; else { c += h3; if (c + h2 >= TOPK) Bs = 4 * Ls + 2; else { c += h2; if (c + h1 >= TOPK) Bs = 4 * Ls + 1; else { c += h1; Bs = 4 * Ls; } } }
        const int need = TOPK - (int)c;
        int base = 0;
#pragma unroll
        for (int j = 0; j < 32; ++j) { if (j <= jmax) { const int b = (int)((bins[j >> 2] >> (8 * (j & 3))) & 255u); const bool isc = (64 * j + lane <= t) && b == Bs;
            const unsigned long long m = __ballot(isc);
            if (m) { const int pos = base + (int)__builtin_amdgcn_mbcnt_hi((unsigned)(m >> 32), __builtin_amdgcn_mbcnt_lo((unsigned)m, 0u)); if (isc && pos < 64) cand[pos] = v[j]; base += __builtin_popcountll(m); } } }
        if (base <= 64) {
            asm volatile("s_waitcnt lgkmcnt(0)" ::: "memory");
            const float x = lane < base ? cand[lane] : NINF; int rank = 0;
            for (int m = 0; m < base; ++m) { const float y = __builtin_bit_cast(float, __builtin_amdgcn_readlane(__builtin_bit_cast(int, x), m)); rank += y > x ? 1 : 0; }
            float tc = (lane < base && rank <= need - 1) ? x : PINF;
#pragma unroll
            for (int o = 1; o < 64; o <<= 1) tc = fminf(tc, __shfl_xor(tc, o));
            tau = tc; have = true;
        }
    }
    if (!have) {
        unsigned tk = 0u;
        for (int bit = 31; bit >= 0; --bit) { const unsigned cd = tk | (1u << bit); int cnt = 0;
#pragma unroll
            for (int j = 0; j < 32; ++j) cnt += __builtin_popcountll(__ballot((64 * j + lane <= t) && fkey(v[j]) >= cd));
            if (cnt >= TOPK) tk = cd; }
        tau = __builtin_bit_cast(float, (tk & 0x80000000u) ? (tk ^ 0x80000000u) : ~tk);
    }
    unsigned wlo = 0u, whi = 0u;
#pragma unroll
    for (int j = 0; j < 32; ++j) { if (j <= jmax) { const unsigned long long m = __ballot(v[j] >= tau); if (lane == j) { wlo = (unsigned)m; whi = (unsigned)(m >> 32); } } }
    if (lane < 32) __hip_atomic_store(mrow + lane, ((unsigned long long)whi << 32) | wlo, __ATOMIC_RELAXED, __HIP_MEMORY_SCOPE_AGENT);
}

#define RELU_FMA(acc_, c_, w_) do { const float f_ = (c_); const int i_ = __builtin_bit_cast(int, f_); const float r_ = __builtin_bit_cast(float, i_ > 0 ? i_ : 0); asm("v_fmac_f32_e32 %0, %1, %2" : "+v"(acc_) : "v"(r_), "v"(w_)); } while (0)
__device__ __forceinline__ void p2_index_tile(const Args& a, LAS unsigned char* lds, int b, int t0, int wave, int lane) {
    const GAS f16* QI = (const GAS f16*)(a.ws + WS_QI); const GAS float* WI = (const GAS float*)(a.ws + WS_WI); const GAS f16* KI = (const GAS f16*)(a.ws + WS_KI);
    GAS unsigned long long* MASK = (GAS unsigned long long*)(a.ws + WS_MASK);
    LAS float* sc = (LAS float*)lds;
    const int fr = lane & 15, fq = lane >> 4; const size_t rowq = (size_t)b * S + t0 + fr;
    f16x8 qf[16][2]; float w[16];
#pragma unroll
    for (int h = 0; h < 16; ++h) { qf[h][0] = *(const GAS f16x8*)(QI + rowq * 1024 + h * 64 + 8 * fq); qf[h][1] = *(const GAS f16x8*)(QI + rowq * 1024 + h * 64 + 32 + 8 * fq); }
#pragma unroll
    for (int h = 0; h < 16; h += 4) { const f32x4 x = *(const GAS f32x4*)(WI + rowq * 16 + h); w[h] = x[0]; w[h + 1] = x[1]; w[h + 2] = x[2]; w[h + 3] = x[3]; }
    const int nkt = (t0 + 16) >> 4;
    const GAS f16* kp = KI + ((size_t)b * S + fr) * 64 + 8 * fq;
#define KLOAD(d0_, d1_, kt_) do { const int k_ = (kt_) < nkt ? (kt_) : wave; d0_ = *(const GAS f16x8*)(kp + (size_t)k_ * 1024); d1_ = *(const GAS f16x8*)(kp + (size_t)k_ * 1024 + 32); } while (0)
    f16x8 ka0, ka1, kb0, kb1, kc0, kc1;
#define KCOMP(kf0, kf1, kt_) do { float a0 = 0.f, a1 = 0.f, a2 = 0.f, a3 = 0.f; const f32x4 z4 = {0.f, 0.f, 0.f, 0.f}; \
        f32x4 cc = __builtin_amdgcn_mfma_f32_16x16x32_f16(kf0, qf[0][0], z4, 0, 0, 0); cc = __builtin_amdgcn_mfma_f32_16x16x32_f16(kf1, qf[0][1], cc, 0, 0, 0); \
        _Pragma("unroll") for (int h = 0; h < 16; ++h) { f32x4 cn = z4;        \
            if (h < 15) { cn = __builtin_amdgcn_mfma_f32_16x16x32_f16(kf0, qf[h + 1][0], z4, 0, 0, 0); cn = __builtin_amdgcn_mfma_f32_16x16x32_f16(kf1, qf[h + 1][1], cn, 0, 0, 0); } \
            RELU_FMA(a0, cc[0], w[h]); RELU_FMA(a1, cc[1], w[h]); RELU_FMA(a2, cc[2], w[h]); RELU_FMA(a3, cc[3], w[h]); \
            cc = cn; __builtin_amdgcn_sched_barrier(0); } \
        *(LAS f32x4*)(sc + fr * SC_STRIDE + 16 * (kt_) + 4 * fq) = (f32x4){a0, a1, a2, a3}; } while (0)
    KLOAD(ka0, ka1, wave); KLOAD(kb0, kb1, wave + NWAVES);
    for (int rpk = 0; rpk < P2_KT_REP; ++rpk)
    for (int kt = wave; kt < nkt; kt += 3 * NWAVES) {
        KLOAD(kc0, kc1, kt + 2 * NWAVES); KCOMP(ka0, ka1, kt);
        if (kt + NWAVES < nkt) { KLOAD(ka0, ka1, kt + 3 * NWAVES); KCOMP(kb0, kb1, kt + NWAVES); }
        if (kt + 2 * NWAVES < nkt) { KLOAD(kb0, kb1, kt + 4 * NWAVES); KCOMP(kc0, kc1, kt + 2 * NWAVES); }
    }
#undef KCOMP
#undef KLOAD
    __syncthreads();
#pragma unroll 1
    for (int qq = 0; qq < 2 * P2_SEL_REP; ++qq) { const int q = 2 * wave + (qq & 1); const int t = t0 + q;
        wave_topk_mask(sc + q * SC_STRIDE, t, MASK + ((size_t)b * S + t) * 32, lane, (LAS unsigned*)(lds + WSCR_OFF + wave * WSCR_BYTES), (LAS float*)(lds + WSCR_OFF + wave * WSCR_BYTES + 1024)); }
    __syncthreads();
}

__device__ __forceinline__ void p2_phase(const Args& a, LAS unsigned char* lds, int vcu, int G, int wave, int lane) {
    const int gw = vcu * NWAVES + wave, NGW = G * NWAVES;
    unsigned* rdy = (unsigned*)a.ws + RDY_WORD0;
    for (int rp = 0; rp < P2_REP_A; ++rp) p2_sscore(a, gw, NGW, lane);
    signal_add_wt(rdy + 64 * 32);
    { GAS unsigned long long* MASK = (GAS unsigned long long*)(a.ws + WS_MASK);
      for (int i = gw * 64 + lane; i < NB * TOPK * 32; i += NGW * 64) { const int wd = i & 31, t = (i >> 5) & (TOPK - 1), b = i >> 13; const int lo = 64 * wd;
          const unsigned long long m = lo + 63 <= t ? ~0ull : (lo > t ? 0ull : ((1ull << (t - lo + 1)) - 1ull));
          __hip_atomic_store(MASK + ((size_t)b * S + t) * 32 + wd, m, __ATOMIC_RELAXED, __HIP_MEMORY_SCOPE_AGENT); } }
    signal_add_wt(rdy + 64 * 33);
    constexpr int NT = NB * (S - TOPK) / 16;
    for (int rp = 0; rp < P2_REP_C; ++rp)
    for (int r = 0; r * G < NT; ++r) { const int k = (r & 1) ? (r + 1) * G - 1 - vcu : r * G + vcu;
        if (k < NT) { const int j = (NT / NB - 1) - (k >> 2), b = k & 3; p2_index_tile(a, lds, b, TOPK + 16 * j, wave, lane);
            if (rp == 0) signal_add_wt(rdy + 64 * (40 + b * 32 + ((TOPK + 16 * j) >> 6))); } }
}

#ifndef P3_REP_S
#define P3_REP_S 1
#define P3_REP_A 1
#endif
namespace att {
typedef short bf16x8 __attribute__((ext_vector_type(8)));
typedef short s16x4 __attribute__((ext_vector_type(4)));
typedef float f32x16 __attribute__((ext_vector_type(16)));
constexpr int QBLK = 32, KVBLK = 64, D = 128;
constexpr int SHM_V = KVBLK * D * 2, SHM_K = KVBLK * D * 2;
constexpr int WS_OFF = 2 * SHM_V + 2 * SHM_K;
constexpr float SCALE = 0.08838834764831845f;
#define KSWZ(row, colB) ((row) * 256 + ((colB) ^ (((row) & 7) << 4)))
#define SBAR() __builtin_amdgcn_sched_barrier(0)
__device__ __forceinline__ int v_st(int k, int c) { const int kk = (k & ~0xC) | ((k & 4) << 1) | ((k & 8) >> 1); return ((kk >> 3) * 4 + (c >> 5)) * 512 + ((kk & 7) * 32 + (c & 31)) * 2; }
__device__ __forceinline__ int v_rd_base(int lane) { return ((lane & 3) << 3) | (((lane >> 2) & 3) << 6) | (((lane >> 4) & 1) << 5) | (((lane >> 5) & 1) << 8); }
constexpr int v_rd_off(int d0, int ks, int half) { return d0 * 512 + ks * 4096 + half * 2048; }
__device__ __forceinline__ int crow(int r, int hi) { return (r & 3) + 8 * (r >> 2) + 4 * hi; }
__device__ __forceinline__ unsigned cvtpk(float lo, float hi) { return pk_bf16(lo, hi); }

template <int KB>
__device__ __forceinline__ void qkt(f32x16& p0, f32x16& p1, const LAS unsigned char* K_lds, int r32, int hi, const LAS unsigned char* qp) {
    p0 = f32x16{}; p1 = f32x16{};
    const LAS unsigned char* kb[4];
#pragma unroll
    for (int dd = 0; dd < 4; ++dd) kb[dd] = K_lds + KB * SHM_K + KSWZ(r32, (dd * 16 + hi * 8) * 2);
#pragma unroll
    for (int d0 = 0; d0 < 8; ++d0) { const LAS unsigned char* a = kb[d0 & 3] + (d0 >> 2) * 128;
        const bf16x8 b0 = *(const LAS bf16x8*)a;
        const bf16x8 b1 = *(const LAS bf16x8*)(a + 32 * 256);
        const bf16x8 qv = *(const LAS bf16x8*)(qp + d0 * 1024);
        p0 = __builtin_amdgcn_mfma_f32_32x32x16_bf16(b0, qv, p0, 0, 0, 0);
        p1 = __builtin_amdgcn_mfma_f32_32x32x16_bf16(b1, qv, p1, 0, 0, 0); }
}
template <int VB>
__device__ __forceinline__ void pv_tile(f32x16* o, int vb0, bf16x8 pa0, bf16x8 pa1, bf16x8 pa2, bf16x8 pa3) {
#define TRRD(dst, off) asm volatile("ds_read_b64_tr_b16 %0, %1 offset:%2" : "=&v"(dst) : "v"(vb0), "i"(off) : "memory")
#define PV_D0(d0) do { s16x4 l0, l1, l2, l3, h0, h1, h2, h3; constexpr int b_ = VB * SHM_V + v_rd_off(d0, 0, 0); \
        TRRD(l0, b_); TRRD(h0, b_ + 2048); TRRD(l1, b_ + 4096); TRRD(h1, b_ + 6144); TRRD(l2, b_ + 8192); TRRD(h2, b_ + 10240); TRRD(l3, b_ + 12288); TRRD(h3, b_ + 14336); \
        asm volatile("s_waitcnt lgkmcnt(0)" ::: "memory"); SBAR(); \
        o[d0] = __builtin_amdgcn_mfma_f32_32x32x16_bf16(pa0, (bf16x8){l0[0], l0[1], l0[2], l0[3], h0[0], h0[1], h0[2], h0[3]}, o[d0], 0, 0, 0); \
        o[d0] = __builtin_amdgcn_mfma_f32_32x32x16_bf16(pa1, (bf16x8){l1[0], l1[1], l1[2], l1[3], h1[0], h1[1], h1[2], h1[3]}, o[d0], 0, 0, 0); \
        o[d0] = __builtin_amdgcn_mfma_f32_32x32x16_bf16(pa2, (bf16x8){l2[0], l2[1], l2[2], l2[3], h2[0], h2[1], h2[2], h2[3]}, o[d0], 0, 0, 0); \
        o[d0] = __builtin_amdgcn_mfma_f32_32x32x16_bf16(pa3, (bf16x8){l3[0], l3[1], l3[2], l3[3], h3[0], h3[1], h3[2], h3[3]}, o[d0], 0, 0, 0); } while (0)
    PV_D0(0); PV_D0(1); PV_D0(2); PV_D0(3);
#undef PV_D0
#undef TRRD
}
__device__ __forceinline__ void partialSM(f32x16& p0, f32x16& p1, unsigned wl, unsigned wh, float sh2) {
    const float NEG = -__builtin_inff(); constexpr float C2 = 1.4426950408889634f * SCALE;
#pragma unroll
    for (int r = 0; r < 16; ++r) { const unsigned bit = 1u << ((r & 3) + 8 * (r >> 2));
        p0[r] = (wl & bit) ? fmaf(p0[r], C2, -sh2) : NEG; p1[r] = (wh & bit) ? fmaf(p1[r], C2, -sh2) : NEG; }
#pragma unroll
    for (int r = 0; r < 16; ++r) p0[r] = __builtin_amdgcn_exp2f(p0[r]);
}
__device__ __forceinline__ void finishSM(f32x16& p0, f32x16& p1, float& l_reg, bf16x8& pa0, bf16x8& pa1, bf16x8& pa2, bf16x8& pa3) {
#pragma unroll
    for (int r = 0; r < 16; ++r) p1[r] = __builtin_amdgcn_exp2f(p1[r]);
    float ps = 0;
#pragma unroll
    for (int r = 0; r < 16; ++r) ps += p0[r];
#pragma unroll
    for (int r = 0; r < 16; ++r) ps += p1[r];
    l_reg += ps;
#define PK4(P, B_, OUT) do { unsigned a0 = cvtpk(P[B_+0], P[B_+1]), a1 = cvtpk(P[B_+2], P[B_+3]); \
        unsigned b0 = cvtpk(P[B_+4], P[B_+5]), b1 = cvtpk(P[B_+6], P[B_+7]); \
        auto r0 = __builtin_amdgcn_permlane32_swap(a0, b0, false, false); auto r1 = __builtin_amdgcn_permlane32_swap(a1, b1, false, false); \
        u32x4 w = {r0[0], r1[0], r0[1], r1[1]}; OUT = __builtin_bit_cast(bf16x8, w); } while (0)
    PK4(p0, 0, pa0); PK4(p0, 8, pa1); PK4(p1, 0, pa2); PK4(p1, 8, pa3);
#undef PK4
}

__device__ __forceinline__ __amdgpu_buffer_rsrc_t mk_rsrc(const GAS void* p, unsigned bytes) {
    const unsigned long long u = (unsigned long long)p; const unsigned lo = __builtin_amdgcn_readfirstlane((unsigned)u), hi = __builtin_amdgcn_readfirstlane((unsigned)(u >> 32));
    return __builtin_amdgcn_make_buffer_rsrc((void*)(((unsigned long long)hi << 32) | lo), (short)0, (int)bytes, 0x00020000);
}
__device__ __forceinline__ void attn_block(const Args& a, LAS unsigned char* lds, int b, int kvh, int q0, float sh2) {
    int tid_ = threadIdx.x; asm volatile("" : "+v"(tid_));
    const int tid = tid_, wid = __builtin_amdgcn_readfirstlane(tid >> 6), lane = tid & 63, r32 = lane & 31, hi = lane >> 5;
    const int head = 4 * kvh + (wid >> 1), qw = q0 + 32 * (wid & 1);
    const GAS bf16_t* Qw = (const GAS bf16_t*)(a.ws + WS_QB) + (((size_t)b * NH + head) * S + qw) * D;
    const GAS bf16_t* Kh = (const GAS bf16_t*)(a.ws + WS_KB) + ((size_t)b * NKV + kvh) * S * D;
    const GAS bf16_t* Vh = (const GAS bf16_t*)(a.ws + WS_VB) + ((size_t)b * NKV + kvh) * S * D;
    const __amdgpu_buffer_rsrc_t rK = mk_rsrc(Kh, S * D * 2), rV = mk_rsrc(Vh, S * D * 2), rM = mk_rsrc((const GAS unsigned long long*)(a.ws + WS_MASK) + ((size_t)b * S + qw) * 32, 32 * 256);
    const unsigned moff = (unsigned)r32 * 256u;
    const int NT = q0 / KVBLK + 1;
    LAS unsigned char* V_lds = lds; LAS unsigned char* K_lds = lds + 2 * SHM_V;
    const int sr = tid >> 4, sc = (tid & 15) * 8, vst0 = v_st(sr, sc), vst1 = v_st(32 + sr, sc), kws = KSWZ(sr, sc * 2);
    const int vb0 = (int)(unsigned)(size_t)V_lds + v_rd_base(lane); const unsigned kvoff = (unsigned)(sr * D + sc) * 2u;
    bf16x8 st_v0, st_v1, st_k0, st_k1;
    LAS unsigned char* qp = lds + WS_OFF + 2048 + wid * 8192 + lane * 16;
#define VMW() asm volatile("s_waitcnt vmcnt(0)" ::: "memory")
#define BL128(r_, so_) __builtin_bit_cast(bf16x8, __builtin_amdgcn_raw_buffer_load_b128(r_, kvoff, (so_), 0))
#define SLOAD_H(k0) do { const int so_ = (k0) * 256; st_v0 = BL128(rV, so_); st_v1 = BL128(rV, so_ + 8192); st_k0 = BL128(rK, so_); st_k1 = BL128(rK, so_ + 8192); } while (0)
#define SWRITE_HK(bf) do { *(LAS bf16x8*)(K_lds + (bf) * SHM_K + kws) = st_k0; *(LAS bf16x8*)(K_lds + (bf) * SHM_K + kws + 32 * 256) = st_k1; } while (0)
#define SWRITE_HV(bf) do { *(LAS bf16x8*)(V_lds + (bf) * SHM_V + vst0) = st_v0; *(LAS bf16x8*)(V_lds + (bf) * SHM_V + vst1) = st_v1; } while (0)
#define SWRITE_H(bf) do { SWRITE_HV(bf); SWRITE_HK(bf); } while (0)
#define MLOAD(t) __builtin_bit_cast(unsigned long long, __builtin_amdgcn_raw_buffer_load_b64(rM, moff, (t) * 8, 16))
#define MSPLIT(mw, wl, wh) do { wl = (unsigned)(mw) >> (4 * hi); wh = (unsigned)((mw) >> 32) >> (4 * hi); } while (0)
    { bf16x8 qt[8];
#pragma unroll
      for (int d0 = 0; d0 < 8; ++d0) qt[d0] = *(const GAS bf16x8*)(Qw + (unsigned)(r32 * D + d0 * 16 + hi * 8));
#pragma unroll
      for (int d0 = 0; d0 < 8; ++d0) *(LAS bf16x8*)(qp + d0 * 1024) = qt[d0]; }
    SLOAD_H(0); unsigned long long mwA = MLOAD(0), mwB = 0ull; VMW(); SWRITE_H(0);
    if (NT > 1) { SLOAD_H(KVBLK); mwB = MLOAD(1); }
    __syncthreads();
    float l_reg = 0.f; f32x16 o[4] = {};
    f32x16 p0, p1; bf16x8 pa0, pa1, pa2, pa3; unsigned wl, wh;
    SBAR(); qkt<0>(p0, p1, K_lds, r32, hi, qp);
    MSPLIT(mwA, wl, wh); partialSM(p0, p1, wl, wh, sh2);
    if (NT > 1) { VMW(); SWRITE_H(1); }
    __syncthreads();
#define STEP(t, KB, VB) do { \
        finishSM(p0, p1, l_reg, pa0, pa1, pa2, pa3); SBAR(); \
        if ((t) + 1 < NT) { SLOAD_H(((t) + 1) * KVBLK); mwA = MLOAD((t) + 1); SBAR(); } \
        pv_tile<VB>(o, vb0, pa0, pa1, pa2, pa3); SBAR(); \
        qkt<KB>(p0, p1, K_lds, r32, hi, qp); \
        MSPLIT(mwB, wl, wh); partialSM(p0, p1, wl, wh, sh2); mwB = mwA; \
        __syncthreads(); \
        if ((t) + 1 < NT) { VMW(); SWRITE_H(VB); } \
        __syncthreads(); } while (0)
    int t = 1;
    for (; t + 1 < NT; t += 2) { STEP(t, 1, 0); STEP(t + 1, 0, 1); }
    if (t < NT) { STEP(t, 1, 0); }
    finishSM(p0, p1, l_reg, pa0, pa1, pa2, pa3); SBAR();
    if ((NT - 1) & 1) pv_tile<1>(o, vb0, pa0, pa1, pa2, pa3); else pv_tile<0>(o, vb0, pa0, pa1, pa2, pa3);
    { auto rr = __builtin_amdgcn_permlane32_swap(__float_as_uint(l_reg), __float_as_uint(l_reg), false, false); l_reg = __uint_as_float(rr[0]) + __uint_as_float(rr[1]); }
    { int te = threadIdx.x; asm volatile("" : "+v"(te));
      const int le = te & 63, r32e = le & 31, hie = le >> 5;
      LAS float* wse = (LAS float*)(lds + WS_OFF) + wid * 64;
      if (hie == 0) wse[r32e] = l_reg;
      asm volatile("s_waitcnt lgkmcnt(0)" ::: "memory");
      __syncthreads();
      LAS f16* stg = (LAS f16*)(lds + wid * 8192);
#pragma unroll
      for (int r = 0; r < 16; ++r) { const int orow = crow(r, hie); const float rl = __builtin_amdgcn_rcpf(wse[orow]);
#pragma unroll
          for (int d0 = 0; d0 < 4; ++d0) stg[orow * 128 + d0 * 32 + r32e] = (f16)(o[d0][r] * rl); }
      asm volatile("s_waitcnt lgkmcnt(0)" ::: "memory");
      const GAS f16* SZ = (const GAS f16*)(a.ws + WS_SZ) + ((size_t)b * S + qw) * 1024 + head * 128; GAS f16* MIX = (GAS f16*)(a.ws + WS_MIX) + ((size_t)b * S + qw) * 2048 + head * 128;
#pragma unroll
      for (int i = 0; i < 8; ++i) { const int c = le + 64 * i, row = c >> 4, ch = c & 15;
          const f16x8 ov = *(const LAS f16x8*)(stg + row * 128 + ch * 8); const f16x8 zv = *(const GAS f16x8*)(SZ + (unsigned)(row * 1024 + ch * 8));
          *(GAS f16x8*)(MIX + (unsigned)(row * 2048 + ch * 8)) = ov * zv; } }
    asm volatile("s_waitcnt lgkmcnt(0)" ::: "memory");
    __syncthreads();
#undef BL128
#undef VMW
#undef SLOAD_H
#undef SWRITE_HK
#undef SWRITE_HV
#undef SWRITE_H
#undef MLOAD
#undef MSPLIT
#undef STEP
}
#undef KSWZ
#undef SBAR
}

__device__ __forceinline__ void p3_sample_item(const Args& a, LAS unsigned char* lds, int item, int tid) {
    const int qi = item >> 1, kvh = item & 1, sb = qi / NST, tl = qi % NST; constexpr int L = PAST + NST, PER = 33;
    const int lane = tid & 63, wave = __builtin_amdgcn_readfirstlane(tid >> 6);
    const GAS float* ck = (const GAS float*)a.in[2]; const GAS float* cv = (const GAS float*)a.in[3]; const GAS int* ptab = (const GAS int*)a.in[6]; const GAS float* out_ro = (const GAS float*)a.out;
    LAS float* q = (LAS float*)lds; LAS float* w = q + 1024; LAS float* newsc = w + 16; LAS float* ctl = newsc + 4; LAS float* red = ctl + 16;
    LAS unsigned* hist = (LAS unsigned*)(red + 32); LAS float* cand = (LAS float*)(hist + 256); LAS unsigned* cnt = (LAS unsigned*)(cand + 64);
    LAS unsigned* rid = cnt + 32; LAS float* qa = (LAS float*)(rid + 512); LAS float* sc = qa + 512; LAS float* inv = sc + 4 * 512; LAS float* part = inv + 4;
    LAS int* nsel = (LAS int*)(ctl + 8); LAS int* ncand = (LAS int*)(ctl + 9);
    const GAS f16* QI = (const GAS f16*)(a.ws + WS_QI) + (size_t)(MP + qi) * 1024; const GAS float* QS = (const GAS float*)(a.ws + WS_QS) + (size_t)qi * 1024 + kvh * 512;
    for (int i = tid; i < 1024; i += 512) q[i] = (float)QI[i];
    qa[tid] = QS[tid];
    if (tid < 16) w[tid] = ((const GAS float*)(a.ws + WS_WI))[(size_t)(MP + qi) * 16 + tid];
    if (tid < 32) cnt[tid] = 0u;
    if (tid < 256) hist[tid] = 0u;
    if (tid == 0) { *nsel = 0; *ncand = 0; }
    const GAS float* ssc = (const GAS float*)(a.ws + WS_SSC) + (size_t)qi * PAST;
    float v[PER];
#pragma unroll
    for (int j = 0; j < PER - 1; ++j) v[j] = __builtin_bit_cast(float, __hip_atomic_load((const GAS unsigned*)ssc + (j * 512 + tid), __ATOMIC_RELAXED, __HIP_MEMORY_SCOPE_AGENT));
    __syncthreads();
    if (tid < NST) { const GAS float* kr = out_ro + O_KIS + (size_t)(sb * NST + tid) * 64; float s = 0.f;
#pragma unroll 1
        for (int h = 0; h < 16; ++h) { float dsum = 0.f;
#pragma unroll 8
            for (int d = 0; d < 64; ++d) dsum += q[h * 64 + d] * kr[d];
            s += w[h] * fmaxf(dsum, 0.f); }
        newsc[tid] = s; }
    __syncthreads();
    const float NINF = -__builtin_inff(), PINF = __builtin_inff();
    { const int s = (PER - 1) * 512 + tid; v[PER - 1] = (s < L && (s - PAST) <= tl) ? newsc[s - PAST] : NINF; }
    float mx = NINF, mn = PINF;
#pragma unroll
    for (int j = 0; j < PER; ++j) { mx = fmaxf(mx, v[j]); mn = fminf(mn, v[j] == NINF ? PINF : v[j]); }
#pragma unroll
    for (int o = 1; o < 64; o <<= 1) { mx = fmaxf(mx, __shfl_xor(mx, o)); mn = fminf(mn, __shfl_xor(mn, o)); }
    if (lane == 0) { red[wave] = mx; red[8 + wave] = mn; }
    __syncthreads();
#pragma unroll
    for (int i = 0; i < 8; ++i) { mx = fmaxf(mx, red[i]); mn = fminf(mn, red[8 + i]); }
    const float scale = 255.5f / (mx - mn);
    float tau = 0.f; bool have = false;
    if (mx > mn) {
#pragma unroll
        for (int j = 0; j < PER; ++j) if (v[j] != NINF) { int bn = (int)((v[j] - mn) * scale); bn = bn > 255 ? 255 : bn; __hip_atomic_fetch_add(hist + bn, 1u, __ATOMIC_RELAXED, __HIP_MEMORY_SCOPE_WORKGROUP); }
        __syncthreads();
        if (wave == 0) {
            const u32x4 h = *(const LAS u32x4*)(hist + 4 * lane);
            const unsigned sl = h[0] + h[1] + h[2] + h[3]; unsigned pre = sl;
#pragma unroll
            for (int o = 1; o < 64; o <<= 1) { const unsigned y = __shfl_up(pre, o); if (lane >= o) pre += y; }
            const unsigned tot = __builtin_amdgcn_readlane(pre, 63); const unsigned suf = tot - pre + sl;
            const unsigned long long bm = __ballot(suf >= TOPK);
            const int Ls = 63 - __builtin_clzll(bm);
            unsigned c = __builtin_amdgcn_readlane(suf, Ls) - __builtin_amdgcn_readlane(sl, Ls);
            const unsigned h3 = __builtin_amdgcn_readlane(h[3], Ls), h2 = __builtin_amdgcn_readlane(h[2], Ls), h1 = __builtin_amdgcn_readlane(h[1], Ls);
            int Bs;
            if (c + h3 >= TOPK) Bs = 4 * Ls + 3; else { c += h3; if (c + h2 >= TOPK) Bs = 4 * Ls + 2; else { c += h2; if (c + h1 >= TOPK) Bs = 4 * Ls + 1; else { c += h1; Bs = 4 * Ls; } } }
            if (lane == 0) { ((LAS int*)ctl)[0] = Bs; ((LAS int*)ctl)[1] = TOPK - (int)c; }
        }
        __syncthreads();
        const int Bs = ((LAS int*)ctl)[0], need = ((LAS int*)ctl)[1];
#pragma unroll
        for (int j = 0; j < PER; ++j) if (v[j] != NINF) { int bn = (int)((v[j] - mn) * scale); bn = bn > 255 ? 255 : bn;
            if (bn == Bs) { const int p = __hip_atomic_fetch_add(ncand, 1, __ATOMIC_RELAXED, __HIP_MEMORY_SCOPE_WORKGROUP); if (p < 64) cand[p] = v[j]; } }
        __syncthreads();
        const int base = *ncand;
        if (base <= 64) {
            if (wave == 0) { const float x = lane < base ? cand[lane] : NINF; int rank = 0;
                for (int m = 0; m < base; ++m) { const float y = __builtin_bit_cast(float, __builtin_amdgcn_readlane(__builtin_bit_cast(int, x), m)); rank += y > x ? 1 : 0; }
                float tc = (lane < base && rank <= need - 1) ? x : PINF;
#pragma unroll
                for (int o = 1; o < 64; o <<= 1) tc = fminf(tc, __shfl_xor(tc, o));
                if (lane == 0) ctl[2] = tc; }
            __syncthreads();
            tau = ctl[2]; have = true;
        }
    }
    if (!have) {
        unsigned tk = 0u;
        for (int bit = 31; bit >= 0; --bit) { const unsigned cd = tk | (1u << bit); int c = 0;
#pragma unroll
            for (int j = 0; j < PER; ++j) c += __builtin_popcountll(__ballot(v[j] != NINF && fkey(v[j]) >= cd));
            if (lane == 0) __hip_atomic_fetch_add(cnt + bit, (unsigned)c, __ATOMIC_RELAXED, __HIP_MEMORY_SCOPE_WORKGROUP);
            __syncthreads();
            if (cnt[bit] >= TOPK) tk = cd; }
        tau = __builtin_bit_cast(float, (tk & 0x80000000u) ? (tk ^ 0x80000000u) : ~tk);
    }
#pragma unroll
    for (int j = 0; j < PER; ++j) { if (v[j] >= tau) { const int s = j * 512 + tid; const int p = __hip_atomic_fetch_add(nsel, 1, __ATOMIC_RELAXED, __HIP_MEMORY_SCOPE_WORKGROUP);
        if (p < 512) rid[p] = s < PAST ? (unsigned)(ptab[sb * NPAGES + (s >> 7)] * PAGE + (s & (PAGE - 1))) : (0x80000000u | (unsigned)(s - PAST)); } }
    __syncthreads();
    const int n = *nsel < 512 ? *nsel : 512;
    const int half = lane >> 5, l32 = lane & 31;
    { f32x4 qv[4];
#pragma unroll
      for (int h = 0; h < 4; ++h) qv[h] = *(const LAS f32x4*)(qa + h * 128 + 4 * l32);
      for (int j0 = 2 * wave; j0 < n; j0 += 128) { f32x4 kv[8]; int jj[8];
#pragma unroll
          for (int u = 0; u < 8; ++u) { jj[u] = j0 + 16 * u + half; const unsigned r = rid[jj[u] < n ? jj[u] : 0];
              const GAS float* kr = (r & 0x80000000u) ? out_ro + O_KS + ((size_t)(sb * NST + (r & 3u)) * NKV + kvh) * HD : ck + ((size_t)r * NKV + kvh) * HD;
              kv[u] = *(const GAS f32x4*)(kr + 4 * l32); }
#pragma unroll
          for (int u = 0; u < 8; ++u) { float d[4];
#pragma unroll
              for (int h = 0; h < 4; ++h) { d[h] = (kv[u][0] * qv[h][0] + kv[u][1] * qv[h][1]) + (kv[u][2] * qv[h][2] + kv[u][3] * qv[h][3]);
                  d[h] += __shfl_xor(d[h], 1); d[h] += __shfl_xor(d[h], 2); d[h] += __shfl_xor(d[h], 4); d[h] += __shfl_xor(d[h], 8); d[h] += __shfl_xor(d[h], 16); }
              if (jj[u] < n && l32 < 4) sc[l32 * 512 + jj[u]] = (l32 == 0 ? d[0] : l32 == 1 ? d[1] : l32 == 2 ? d[2] : d[3]) * 0.08838834764831845f; } } }
    __syncthreads();
    if (wave < 4) { LAS float* row = sc + wave * 512; float m2 = -1e30f;
      for (int j = lane; j < n; j += 64) m2 = fmaxf(m2, row[j]);
#pragma unroll
      for (int o = 1; o < 64; o <<= 1) m2 = fmaxf(m2, __shfl_xor(m2, o));
      float sm = 0.f;
      for (int j = lane; j < n; j += 64) { const float e = __expf(row[j] - m2); row[j] = e; sm += e; }
      sm = wave_sum(sm); if (lane == 0) inv[wave] = 1.f / sm; }
    __syncthreads();
    { f32x4 acc[4] = {};
      for (int j0 = 2 * wave; j0 < n; j0 += 128) { f32x4 vv[8]; int jj[8];
#pragma unroll
          for (int u = 0; u < 8; ++u) { jj[u] = j0 + 16 * u + half; const unsigned r = rid[jj[u] < n ? jj[u] : 0];
              const GAS float* vr = (r & 0x80000000u) ? out_ro + O_VS + ((size_t)(sb * NST + (r & 3u)) * NKV + kvh) * HD : cv + ((size_t)r * NKV + kvh) * HD;
              vv[u] = *(const GAS f32x4*)(vr + 4 * l32); }
#pragma unroll
          for (int u = 0; u < 8; ++u)
#pragma unroll
              for (int h = 0; h < 4; ++h) { const float p = jj[u] < n ? sc[h * 512 + jj[u]] : 0.f; acc[h] += vv[u] * p; } }
#pragma unroll
      for (int h = 0; h < 4; ++h) {
#pragma unroll
          for (int e = 0; e < 4; ++e) acc[h][e] += __shfl_xor(acc[h][e], 32);
          if (half == 0) *(LAS f32x4*)(part + (wave * 4 + h) * 128 + 4 * l32) = acc[h]; } }
    __syncthreads();
    { const GAS f16* SZ = (const GAS f16*)(a.ws + WS_SZ) + (size_t)(MP + qi) * 1024 + kvh * 512; GAS f16* MIX = (GAS f16*)(a.ws + WS_MIX) + (size_t)(MP + qi) * 2048 + kvh * 512;
      const int h = tid >> 7, d = tid & 127; float o = 0.f;
#pragma unroll
      for (int p = 0; p < 8; ++p) o += part[(p * 4 + h) * 128 + d];
      MIX[tid] = (f16)(o * inv[h] * (float)SZ[tid]); }
    __syncthreads();
}

__device__ __forceinline__ void p3_phase(const Args& a, LAS unsigned char* lds, int vcu, int G, int tid) {
    float gm = 0.f, km = 0.f;
    for (int i = 0; i < HD; ++i) { gm = fmaxf(gm, fabsf(a.in[9][i])); km = fmaxf(km, fabsf(a.in[10][i])); }
    const float sh2 = fmaxf(0.f, 11.313708498984761f * gm * km - 20.f) * 1.4426950408889634f;
    for (int rp = 0; rp < P3_REP_S; ++rp)
    for (int sidx = G - 1 - vcu; sidx < 2 * MS; sidx += G) { wait_ge_wt((unsigned*)a.ws + RDY_WORD0 + 64 * 32, (unsigned)G); p3_sample_item(a, lds, sidx, tid); }
    if (G == 256) { if (vcu >= 112 && vcu < 192) p2_convmix(a, (vcu - 112) * NWAVES + (tid >> 6), 80 * NWAVES, tid & 63); }
    else p2_convmix(a, vcu * NWAVES + (tid >> 6), G * NWAVES, tid & 63);
    for (int rp = 0; rp < P3_REP_A; ++rp)
    for (int k = vcu; k < 256; k += G) { const int i = 31 - (k >> 3), bk = k & 7;
        if (i >= 4) wait_ge_wt((unsigned*)a.ws + RDY_WORD0 + 64 * (40 + (bk >> 1) * 32 + i), 4u); else wait_ge_wt((unsigned*)a.ws + RDY_WORD0 + 64 * 33, (unsigned)G);
        att::attn_block(a, lds, bk >> 1, bk & 1, 64 * i, sh2); }
}

__global__ void __launch_bounds__(NWAVES * 64, 2) mk_fwd(Args a) {
    extern __shared__ __attribute__((aligned(16))) unsigned char lds_raw[];
    LAS unsigned char* lds = (LAS unsigned char*)lds_raw;
    const int tid = threadIdx.x, lane = tid & 63, wave = __builtin_amdgcn_readfirstlane(tid >> 6);
    const int G = gridDim.x; const int bx = blockIdx.x; const int vcu = (G % 8 == 0) ? (bx % 8) * (G / 8) + bx / 8 : bx;
    volatile LAS unsigned* MISC = (volatile LAS unsigned*)(lds + MISC_OFF);
    if (tid < 64) MISC[tid] = 0u;
    __syncthreads();
    XcdBarrier bar = xcd_barrier_post((unsigned*)a.ws, MISC + 8);
    { int t_ = threadIdx.x; asm volatile("" : "+v"(t_)); const int lane = t_ & 63, wave = __builtin_amdgcn_readfirstlane(t_ >> 6); p0_prologue(a, lds, vcu, G, wave, lane); }
    xcd_barrier(bar);
    { pg8::Gemm g{(const f16*)(a.ws + WS_XNH), (const f16*)(a.ws + WS_WINT), DM};
      pg8::StaticOrder S; S.init(MPAD / 256, NPAD / 256, G, bx);
      EpiIn E{a.out, a.ws, a.in[9], a.in[10], a.in[11], (LAS float*)(lds + SCR_OFF)};
      pg8::gemm_phase<EpiIn, pg8::StaticOrder>(lds, g, S, E); }
    xcd_barrier(bar);
    { int t_ = threadIdx.x; asm volatile("" : "+v"(t_)); const int lane = t_ & 63, wave = __builtin_amdgcn_readfirstlane(t_ >> 6); p2_phase(a, lds, vcu, G, wave, lane); }
    { int t_ = threadIdx.x; asm volatile("" : "+v"(t_)); p3_phase(a, lds, vcu, G, t_); }
    xcd_barrier(bar);
    { pg8::Gemm g{(const f16*)(a.ws + WS_MIX), (const f16*)(a.ws + WS_WOUTT), DM};
      pg8::StaticOrder S; S.init(MP / 256, DM / 256, G, bx);
      EpiOut E{a.out, a.in[0]};
      pg8::gemm_phase<EpiOut, pg8::StaticOrder>(lds, g, S, E);
      int t_ = threadIdx.x; asm volatile("" : "+v"(t_)); p4_sample(a, lds, bx, G, t_); }
}

#ifndef PROG
#define PROG 0x11111u
#endif
extern "C" void kernel_launch(void* const* d_in, const int* in_sizes, int n_in, void* d_out, int out_size, void* d_ws, size_t ws_size, hipStream_t stream) {
    static int grid = 0;
    if (grid == 0) {
        if (ws_size < WS_NEED2 || out_size != (int)O_END || n_in != 14) { fprintf(stderr, "kernel_launch: ws %zu (need %zu) out %d (want %zu) n_in %d\n", ws_size, (size_t)WS_NEED2, out_size, (size_t)O_END, n_in); grid = -1; return; }
        int dev = 0, cus = 0; hipGetDevice(&dev); hipDeviceGetAttribute(&cus, hipDeviceAttributeMultiprocessorCount, dev);
        if (hipFuncSetAttribute((const void*)mk_fwd, hipFuncAttributeMaxDynamicSharedMemorySize, LDS_BYTES) != hipSuccess) { fprintf(stderr, "kernel_launch: hipFuncSetAttribute failed\n"); grid = -1; return; }
        int per_cu = 0; hipOccupancyMaxActiveBlocksPerMultiprocessor(&per_cu, (const void*)mk_fwd, NWAVES * 64, LDS_BYTES); (void)hipGetLastError();
        if (per_cu < 1) fprintf(stderr, "kernel_launch: occupancy query says %d blocks per CU\n", per_cu);
        grid = cus > 0 ? cus : 256;
    }
    if (grid < 0) return;
    float* out = (float*)d_out; unsigned char* ws = (unsigned char*)d_ws;
    Args a{};
    for (int i = 0; i < 14; ++i) a.in[i] = (const float*)d_in[i];
    a.out = out; a.ws = ws;
    if (hipMemsetAsync(ws, 0, 65536, stream) != hipSuccess) { fprintf(stderr, "kernel_launch: memset of the control words failed\n"); return; }
    a.ph_lo = (int)PROG; a.ph_hi = 0; hipLaunchKernelGGL(mk_fwd, dim3(grid), dim3(NWAVES * 64), LDS_BYTES, stream, a);
}
```

```cpp
#include <hip/hip_runtime.h>
#include <cstdio>
#include <cstdint>
#include <cmath>

typedef _Float16 f16;
typedef unsigned short bf16_t;

constexpr int DM = 2048, NB = 4, S = 2048, NSB = 8, NST = 4, PAST = 16384, PAGE = 128, NPAGES = PAST / PAGE;
constexpr int MP = NB * S;
constexpr int MS = NSB * NST;
constexpr int MT = MP + MS;
constexpr int DIN = 7760;
constexpr int OQ = 0, OKK = 1024, OV = 1280, OZ = 1536, OQI = 2560, OKI = 3584, OWI = 3648, OH = 3664, OBB = 4688, OC = 5712, OZC = 6736;
constexpr int NH = 8, NKV = 2, HD = 128, NIH = 16, ID = 64, TOPK = 256, DC = 1024;
constexpr float EPS = 1e-6f;
constexpr size_t O_YP = 0, O_YS = 16777216, O_KP = 16842752, O_VP = 18939904, O_KIP = 21037056, O_CVP = 21561344,
                 O_KS = 21569536, O_VS = 21577728, O_KIS = 21585920, O_CVS = 21587968, O_END = 21604352;
constexpr size_t MiB = 1u << 20;
constexpr size_t WS_ROPE = 1 * MiB;
constexpr size_t WS_ROPE_I = WS_ROPE + 2052 * 32 * 4;
constexpr size_t WS_QB = 2 * MiB;
constexpr size_t WS_KB = 18 * MiB;
constexpr size_t WS_VB = 22 * MiB;
constexpr size_t WS_SZ = 26 * MiB;
constexpr size_t WS_QI = 43 * MiB;
constexpr size_t WS_KI = 60 * MiB;
constexpr size_t WS_WI = 61 * MiB;
constexpr size_t WS_U = 62 * MiB;
constexpr size_t WS_G = 79 * MiB;
constexpr size_t WS_MIX = 96 * MiB;
constexpr size_t WS_MASK = 130 * MiB;
constexpr size_t WS_SSC = 132 * MiB;
constexpr size_t WS_QS = 134 * MiB;
constexpr size_t WS_XN = 136 * MiB;
constexpr size_t WS_P = 202 * MiB;
constexpr size_t WS_NEED = 448 * MiB;

__device__ __forceinline__ bf16_t f2bf(float f) { unsigned u = __builtin_bit_cast(unsigned, f); return (bf16_t)((u + 0x7fffu + ((u >> 16) & 1u)) >> 16); }
__device__ __forceinline__ float bf2f(bf16_t h) { return __builtin_bit_cast(float, (unsigned)h << 16); }
__device__ __forceinline__ float silu(float z) { return z * __builtin_amdgcn_rcpf(1.f + __builtin_amdgcn_exp2f(-1.4426950408889634f * z)); }
__device__ __forceinline__ unsigned fkey(float f) { unsigned u = __builtin_bit_cast(unsigned, f); return (u & 0x80000000u) ? ~u : (u | 0x80000000u); }

#define P0_REP_T 1
#define P0_REP_X 1
#define P3_REP_S 1
#define P3_REP_A 1
#define P2_KT_REP 1
#define P2_SEL_REP 1
#define P2_REP_A 1
#define P2_REP_B 1
#define P2_REP_C 1
#define LAS __attribute__((address_space(3)))
#define GAS __attribute__((address_space(1)))
typedef _Float16 f16x8 __attribute__((ext_vector_type(8)));
typedef _Float16 f16x4 __attribute__((ext_vector_type(4)));
typedef _Float16 f16x2 __attribute__((ext_vector_type(2)));
typedef float f32x4 __attribute__((ext_vector_type(4)));
typedef float f32x2 __attribute__((ext_vector_type(2)));
typedef unsigned u32x4 __attribute__((ext_vector_type(4)));
typedef unsigned u32x2 __attribute__((ext_vector_type(2)));
typedef __bf16 bf16x2_t __attribute__((ext_vector_type(2)));
namespace pg8 {
constexpr int BM = 256, BK = 64, HALF = 128, HTB = HALF * BK * 2, STAGE_BYTES = 8 * HTB, NXCD = 8, WGM = 8;
__host__ __device__ __forceinline__ int lds_byte(int r, int c) { const int st = (r >> 4) * 2 + (c >> 5), rr = r & 15, cc = c & 31, ob = rr * 64 + cc * 2; return st * 1024 + (ob ^ (((ob >> 9) & 1) << 5)); }
__host__ __device__ __forceinline__ void stage_rc(int b, int& R, int& C) { const int st = b / 1024, sb = b % 1024, swz = sb ^ (((sb >> 9) & 1) << 5); R = (st >> 1) * 16 + swz / 64; C = (st & 1) * 32 + (swz % 64) / 2; }
struct Unit { int pm, pn; };
struct Gemm { const f16* A; const f16* Bt; int K; };
struct StaticOrder {
    int nM, nN, nwg, G, c;
    __device__ void init(int nM_, int nN_, int G_, int c_) { nM = nM_; nN = nN_; nwg = nM * nN; G = G_; c = c_; }
    __device__ bool next(int i, Unit& u) const {
        const long L = (long)i * G + c; if (L >= nwg) return false;
        int wgid = (int)L; { const int q = nwg / NXCD, r = nwg % NXCD, xcd = wgid % NXCD, off = wgid / NXCD; wgid = (xcd < r ? xcd * (q + 1) : r * (q + 1) + (xcd - r) * q) + off; }
        const int nig = WGM * nN, gid = wgid / nig, fm = gid * WGM, gsz = (nM - fm) < WGM ? (nM - fm) : WGM;
        u.pm = fm + ((wgid % nig) % gsz); u.pn = (wgid % nig) / gsz; return true;
    }
};
struct OneUnit { int pm, pn; __device__ bool next(int i, Unit& u) const { if (i != 0) return false; u.pm = pm; u.pn = pn; return true; } };
template <class Epi, class Sched>
__device__ __forceinline__ void gemm_phase(LAS unsigned char* lds, const Gemm g, const Sched& S, const Epi& E) {
    int tid_ = threadIdx.x; asm volatile("" : "+v"(tid_));
    const int tid = tid_, wid = __builtin_amdgcn_readfirstlane(tid >> 6), lane = tid & 63, wr = wid >> 2, wc = wid & 3, fr = lane & 15, fq = lane >> 4;
    const int K = g.K, nt = K / BK;
    unsigned voffA[2];
#pragma unroll
    for (int i = 0; i < 2; ++i) { int R, C; stage_rc(tid * 16 + i * 8192, R, C); voffA[i] = (unsigned)(R * K + C) * 2u; }
    const size_t kstep = (size_t)(BK * 2);
    const size_t hstep = (size_t)HALF * K * 2;
    const size_t tstep = 2 * hstep;
    const unsigned ldsw = (unsigned)wid * 1024u;
    const int aoff = lds_byte(wr * 64 + fr, fq * 8), boff = lds_byte(wc * 32 + fr, fq * 8);
#define PG8_SA(b, h) (((b) * 2 + (h)) * HTB)
#define PG8_SB(b, h) ((4 + (b) * 2 + (h)) * HTB)
#define PG8_STAGE(bufoff, gbase) do { _Pragma("unroll") for (int _i = 0; _i < 2; ++_i) \
        __builtin_amdgcn_global_load_lds((const unsigned*)((const char*)(gbase) + voffA[_i]), (LAS unsigned*)(lds + (bufoff) + ldsw + _i * 8192), 16, 0, 0); } while (0)
#define PG8_LDA(dst, b, h) do { _Pragma("unroll") for (int m = 0; m < 4; ++m) _Pragma("unroll") for (int k = 0; k < 2; ++k) dst[m][k] = *(const LAS f16x8*)(lds + PG8_SA(b, h) + aoff + m * 2048 + k * 1024); } while (0)
#define PG8_LDB(dst, b, h) do { _Pragma("unroll") for (int n = 0; n < 2; ++n) _Pragma("unroll") for (int k = 0; k < 2; ++k) dst[n][k] = *(const LAS f16x8*)(lds + PG8_SB(b, h) + boff + n * 2048 + k * 1024); } while (0)
#define PG8_MMA(ai, bj, At, Bt) do { __builtin_amdgcn_s_setprio(1); _Pragma("unroll") for (int m = 0; m < 4; ++m) _Pragma("unroll") for (int n = 0; n < 2; ++n) _Pragma("unroll") for (int k = 0; k < 2; ++k) \
        acc[ai][bj][m][n] = __builtin_amdgcn_mfma_f32_16x16x32_f16(Bt[n][k], At[m][k], acc[ai][bj][m][n], 0, 0, 0); __builtin_amdgcn_s_setprio(0); } while (0)
#define PG8_WAIT_V(n) asm volatile("s_waitcnt vmcnt(" #n ")" ::: "memory")
#define PG8_WAIT_L(n) asm volatile("s_waitcnt lgkmcnt(" #n ")" ::: "memory")
#define PG8_BAR __builtin_amdgcn_s_barrier()
#define PG8_SCHED __builtin_amdgcn_sched_barrier(0)
    Unit cur, nxt; int ui = 0;
    if (!S.next(0, cur)) return;
    f32x4 acc[2][2][4][2];
    E.init(acc, cur, wr, wc, fr, fq);
    f16x8 At[4][2], B0[2][2], B1[2][2];
    const char* cA = (const char*)g.A + (size_t)cur.pm * tstep; const char* cB = (const char*)g.Bt + (size_t)cur.pn * tstep;
    PG8_STAGE(PG8_SB(0, 0), cB); PG8_STAGE(PG8_SB(0, 1), cB + hstep); PG8_STAGE(PG8_SA(0, 0), cA); PG8_STAGE(PG8_SA(0, 1), cA + hstep);
    if (wr == 1) PG8_BAR;
    PG8_WAIT_V(2); PG8_BAR;
    PG8_STAGE(PG8_SB(1, 0), cB + kstep); PG8_STAGE(PG8_SA(1, 0), cA + kstep); PG8_STAGE(PG8_SB(1, 1), cB + hstep + kstep);
    PG8_WAIT_V(6); PG8_BAR;
    for (;;) {
        const bool has_next = S.next(ui + 1, nxt);
        const char* nA = has_next ? (const char*)g.A + (size_t)nxt.pm * tstep : cA; const char* nB = has_next ? (const char*)g.Bt + (size_t)nxt.pn * tstep : cB;
        for (int t = 0; t < nt; t += 2) {
            const bool last = (t == nt - 2);
            const char* a1 = cA + (size_t)(t + 1) * kstep;
            const char* a2 = last ? nA : cA + (size_t)(t + 2) * kstep; const char* b2 = last ? nB : cB + (size_t)(t + 2) * kstep;
            const char* a3 = a2 + kstep; const char* b3 = b2 + kstep;
            PG8_LDB(B0, 0, 0); PG8_LDB(B1, 0, 1); PG8_SCHED; PG8_LDA(At, 0, 0); PG8_STAGE(PG8_SA(1, 1), a1 + hstep);
            PG8_WAIT_V(8); PG8_WAIT_L(0); PG8_BAR; PG8_MMA(0, 0, At, B0); PG8_MMA(0, 1, At, B1); PG8_BAR; PG8_SCHED;
            PG8_LDA(At, 0, 1); PG8_STAGE(PG8_SB(0, 0), b2); PG8_STAGE(PG8_SB(0, 1), b2 + hstep); PG8_STAGE(PG8_SA(0, 0), a2);
            PG8_WAIT_V(8); PG8_WAIT_L(0); PG8_BAR; PG8_MMA(1, 0, At, B0); PG8_MMA(1, 1, At, B1); PG8_BAR; PG8_SCHED;
            PG8_LDB(B0, 1, 0); PG8_LDB(B1, 1, 1); PG8_SCHED; PG8_LDA(At, 1, 0); PG8_STAGE(PG8_SA(0, 1), a2 + hstep);
            PG8_WAIT_V(8); PG8_WAIT_L(0); PG8_BAR; PG8_MMA(0, 0, At, B0); PG8_MMA(0, 1, At, B1); PG8_BAR; PG8_SCHED;
            PG8_LDA(At, 1, 1); PG8_STAGE(PG8_SB(1, 0), b3); PG8_STAGE(PG8_SB(1, 1), b3 + hstep); PG8_STAGE(PG8_SA(1, 0), a3);
            PG8_WAIT_V(8); PG8_WAIT_L(0); PG8_BAR; PG8_MMA(1, 0, At, B0); PG8_MMA(1, 1, At, B1); PG8_BAR; PG8_SCHED;
        }
        const bool al = E.aligned(cur);
        if (al && wr == 0) PG8_BAR;
        E(acc, cur, wr, wc, fr, fq);
        if (!has_next) { if (!al && wr == 0) PG8_BAR; break; }
        cur = nxt; cA = nA; cB = nB; ++ui;
        E.init(acc, cur, wr, wc, fr, fq);
        if (al && wr == 1) PG8_BAR;
    }
    PG8_WAIT_V(0);
    PG8_BAR;
#undef PG8_SA
#undef PG8_SB
#undef PG8_STAGE
#undef PG8_LDA
#undef PG8_LDB
#undef PG8_MMA
#undef PG8_WAIT_V
#undef PG8_WAIT_L
#undef PG8_BAR
#undef PG8_SCHED
}
}
#ifndef P0_REP_T
#define P0_REP_T 1
#define P0_REP_X 1
#endif
constexpr int NWAVES = 8;
constexpr int MPAD = 8448, NPAD = 7936;
constexpr size_t WS_XNH = 450 * MiB;
constexpr size_t WS_WINT = 484 * MiB;
constexpr size_t WS_WOUTT = 516 * MiB;
constexpr size_t WS_PART = 524 * MiB;
constexpr size_t PART_STRIDE = 32768 + 256;
constexpr size_t WS_NEED2 = 536 * MiB;
constexpr int RING_BYTES = 131072, SCR_OFF = RING_BYTES, SCR_BYTES = 8192, MISC_OFF = 145408, LDS_BYTES = 147456;

__device__ __forceinline__ unsigned pk_bf16(float lo, float hi) { f32x2 v = {lo, hi}; bf16x2_t b = __builtin_convertvector(v, bf16x2_t); return __builtin_bit_cast(unsigned, b); }
__device__ __forceinline__ unsigned pk_f16(float lo, float hi) { f32x2 v = {lo, hi}; f16x2 b = __builtin_convertvector(v, f16x2); return __builtin_bit_cast(unsigned, b); }

struct Args { const float* in[14]; float* out; unsigned char* ws; int ph_lo, ph_hi; };

__device__ __forceinline__ int win_src(int np) {
    const int pn = np >> 8, c = np & 255;
    if (pn < 14) return np;
    if (pn == 14) return c < 80 ? np : -1;
    const int T = pn - 15, bj = c >> 7, wc = (c >> 5) & 3, n = (c >> 4) & 1, fqi = c & 15;
    const int base = bj == 0 ? (n == 0 ? OH : OBB) : (n == 0 ? OC : OZC);
    return base + 64 * T + 16 * wc + fqi;
}
template <bool MAP>
__device__ __forceinline__ void p0_transpose_item(const float* W, int N, f16* WT, LAS unsigned char* scr, int item, int nblk, int lane) {
    const int kb = item / nblk, nb = item % nblk, k0 = 64 * kb, n0 = 32 * nb;
    const int q = lane & 7, kr = lane >> 3;
    const int src = MAP ? win_src(n0 + 4 * q) : n0 + 4 * q;
    const GAS float* wp = (const GAS float*)W + (size_t)(k0 + 2 * kr) * N + (src >= 0 ? src : 0);
    f32x4 va[4], vb[4];
#pragma unroll
    for (int p = 0; p < 4; ++p) { va[p] = *(const GAS f32x4*)(wp + (size_t)(16 * p) * N); vb[p] = *(const GAS f32x4*)(wp + (size_t)(16 * p + 1) * N); }
#pragma unroll
    for (int p = 0; p < 4; ++p) { if (src < 0) { va[p] = (f32x4){0.f, 0.f, 0.f, 0.f}; vb[p] = va[p]; }
#pragma unroll
        for (int e = 0; e < 4; ++e) *(LAS unsigned*)(scr + (4 * q + e) * 144 + 2 * (16 * p + 2 * kr)) = pk_f16(va[p][e], vb[p][e]); }
    asm volatile("s_waitcnt lgkmcnt(0)" ::: "memory");
    const int ch = lane & 7;
#pragma unroll
    for (int j = 0; j < 4; ++j) { const int n = (lane >> 3) + 8 * j;
        *(GAS u32x4*)(WT + (size_t)(n0 + n) * 2048 + k0 + 8 * ch) = *(const LAS u32x4*)(scr + n * 144 + ch * 16); }
    asm volatile("s_waitcnt lgkmcnt(0)" ::: "memory");
}
__device__ __forceinline__ float wave_sum(float v) {
#pragma unroll
    for (int o = 1; o < 64; o <<= 1) v += __shfl_xor(v, o);
    return v;
}
__device__ __forceinline__ void p0_prologue(const Args& a, LAS unsigned char* lds, int vcu, int G, int wave, int lane) {
    LAS unsigned char* scr = lds + wave * 16384;
    const int gw = vcu * NWAVES + wave, NGW = G * NWAVES;
    const float* win = a.in[8]; const float* wout = a.in[13];
    f16* WinT = (f16*)(a.ws + WS_WINT); f16* WoutT = (f16*)(a.ws + WS_WOUTT); f16* XN = (f16*)(a.ws + WS_XNH);
    constexpr int I_IN = 32 * (NPAD / 32), I_OUT = 32 * (DM / 32);
    for (int rpt = 0; rpt < P0_REP_T; ++rpt)
    for (int it = gw; it < I_IN + I_OUT; it += NGW) {
        if (it < I_IN) p0_transpose_item<true>(win, DIN, WinT, scr, it, NPAD / 32, lane);
        else p0_transpose_item<false>(wout, DM, WoutT, scr, it - I_IN, DM / 32, lane);
    }
    const float* gin = a.in[7];
    for (int rpx = 0; rpx < P0_REP_X; ++rpx)
    for (int m = gw; m < MT; m += NGW) {
        const float* xrow = m < MP ? a.in[0] + (size_t)m * DM : a.in[1] + (size_t)(m - MP) * DM;
        const f32x4* xr = (const f32x4*)xrow + lane; f32x4 v[8]; float s = 0.f;
#pragma unroll
        for (int j = 0; j < 8; ++j) { v[j] = xr[64 * j]; s += (v[j].x * v[j].x + v[j].y * v[j].y) + (v[j].z * v[j].z + v[j].w * v[j].w); }
        const float rs = rsqrtf(wave_sum(s) * (1.f / DM) + EPS);
        u32x2* o8 = (u32x2*)(XN + (size_t)m * DM) + lane;
#pragma unroll
        for (int j = 0; j < 8; ++j) { const f32x4 gv = ((const f32x4*)gin)[lane + 64 * j]; u32x2 w; w.x = pk_f16(v[j].x * rs * gv.x, v[j].y * rs * gv.y); w.y = pk_f16(v[j].z * rs * gv.z, v[j].w * rs * gv.w); o8[64 * j] = w; }
    }
    float* rqk = (float*)(a.ws + WS_ROPE); float* ri = (float*)(a.ws + WS_ROPE_I);
    for (int i = gw * 64 + lane; i < 2052 * 16; i += NGW * 64) {
        { int slot = i / 16, j = i % 16; int pos = slot < 2048 ? slot : PAST + (slot - 2048);
          float inv = (float)pow(500000.0, -(double)j / 16.0); float ang = (float)pos * inv;
          rqk[(slot * 16 + j) * 2] = (float)cos((double)ang); rqk[(slot * 16 + j) * 2 + 1] = (float)sin((double)ang); }
        if (i < 2052 * 8) { int slot = i / 8, j = i % 8; int pos = slot < 2048 ? slot : PAST + (slot - 2048);
          float inv = (float)pow(500000.0, -(double)j / 8.0); float ang = (float)pos * inv;
          ri[(slot * 8 + j) * 2] = (float)cos((double)ang); ri[(slot * 8 + j) * 2 + 1] = (float)sin((double)ang); }
    }
}

struct EpiIn {
    float* out; unsigned char* ws; const float* gq; const float* gk; const float* gki; LAS float* scr;
    __device__ __forceinline__ bool aligned(const pg8::Unit& u) const { return u.pn <= 4 || u.pn == 14; }
    __device__ __forceinline__ void init(f32x4 (&acc)[2][2][4][2], const pg8::Unit&, int, int, int, int) const {
#pragma unroll
        for (int a = 0; a < 2; ++a)
#pragma unroll
            for (int b = 0; b < 2; ++b)
#pragma unroll
                for (int m = 0; m < 4; ++m)
#pragma unroll
                    for (int n = 0; n < 2; ++n) acc[a][b][m][n] = (f32x4){0.f, 0.f, 0.f, 0.f};
    }
    __device__ __forceinline__ void operator()(f32x4 (&acc)[2][2][4][2], const pg8::Unit& u, int wr, int wc, int fr_, int fq_) const {
        int fr = fr_, fq = fq_; asm volatile("" : "+v"(fr), "+v"(fq));
        GAS unsigned char* ws = (GAS unsigned char*)this->ws; GAS float* out = (GAS float*)this->out; asm volatile("" : "+s"(ws), "+s"(out));
        const int pn = u.pn, pm = u.pm; const bool smp = pm == 32;
        const int rbase = 64 * wr + fr;
        const int bb = pm >> 3, t0 = (pm & 7) << 8;
        const GAS float* rqk = (const GAS float*)(ws + WS_ROPE); const GAS float* ri = (const GAS float*)(ws + WS_ROPE_I);
#define ROWLOOP _Pragma("unroll") for (int ai = 0; ai < 2; ++ai) _Pragma("unroll") for (int m = 0; m < 4; ++m)
#define ROWVARS const int r = rbase + 128 * ai + 16 * m; const bool valid = !smp || r < MS; const int grow = smp ? MP + r : pm * 256 + r; const int tt = smp ? (r & 3) : t0 + r; const int slot = smp ? 2048 + (r & 3) : tt; (void)grow; (void)tt; (void)slot; (void)valid;
        if (pn <= 4 || pn == 14) {
            const bool isk = pn == 14;
            ROWLOOP { asm volatile("" ::: "memory"); const int r = rbase + 128 * ai + 16 * m;
#pragma unroll
                for (int bj = 0; bj < 2; ++bj) { float s = 0.f;
#pragma unroll
                    for (int n = 0; n < 2; ++n) { const f32x4 x = acc[ai][bj][m][n]; s += (x[0] * x[0] + x[1] * x[1]) + (x[2] * x[2] + x[3] * x[3]); }
                    if (isk && (wc >= 2 || bj == 1)) s = 0.f;
                    s += __shfl_xor(s, 16); s += __shfl_xor(s, 32);
                    if (fq == 0) scr[(r * 2 + bj) * 4 + wc] = s; } }
            asm volatile("s_waitcnt lgkmcnt(0)" ::: "memory"); __builtin_amdgcn_s_barrier(); asm volatile("" ::: "memory");
            if (!isk) {
                const GAS float* g = (const GAS float*)(pn < 4 ? gq : gk); const int dl = 32 * wc + 4 * fq;
                const f32x4 g0 = *(const GAS f32x4*)(g + dl), g1 = *(const GAS f32x4*)(g + dl + 16);
                GAS bf16_t* Qb = (GAS bf16_t*)(ws + WS_QB); GAS bf16_t* Kb = (GAS bf16_t*)(ws + WS_KB); GAS float* QS = (GAS float*)(ws + WS_QS);
                ROWLOOP { asm volatile("" ::: "memory"); ROWVARS
                    f32x4 cs0 = {1.f, 0.f, 1.f, 0.f}, cs1 = {1.f, 0.f, 1.f, 0.f};
                    if (wc == 0) { const GAS f32x4* cp = (const GAS f32x4*)(rqk + (slot * 16 + 4 * fq) * 2); cs0 = cp[0]; cs1 = cp[1]; }
#pragma unroll
                    for (int bj = 0; bj < 2; ++bj) {
                        const f32x4 p = *(const LAS f32x4*)(scr + (r * 2 + bj) * 4);
                        const float rs = rsqrtf(((p[0] + p[1]) + (p[2] + p[3])) * (1.f / 128.f) + EPS);
                        f32x4 x0 = acc[ai][bj][m][0] * rs * g0, x1 = acc[ai][bj][m][1] * rs * g1;
                        if (wc == 0) { const f32x4 c = {cs0[0], cs0[2], cs1[0], cs1[2]}, s = {cs0[1], cs0[3], cs1[1], cs1[3]};
                            const f32x4 y0 = x0 * c - x1 * s, y1 = x1 * c + x0 * s; x0 = y0; x1 = y1; }
                        const int hh = 2 * pn + bj;
                        if (pn < 4) {
                            if (smp) { if (valid) { GAS float* q = QS + (size_t)r * 1024 + hh * 128 + dl; *(GAS f32x4*)q = x0; *(GAS f32x4*)(q + 16) = x1; } }
                            else { GAS bf16_t* q = Qb + (((size_t)bb * NH + hh) * S + tt) * HD + dl;
                                u32x2 w0 = {pk_bf16(x0[0], x0[1]), pk_bf16(x0[2], x0[3])}, w1 = {pk_bf16(x1[0], x1[1]), pk_bf16(x1[2], x1[3])};
                                *(GAS u32x2*)q = w0; *(GAS u32x2*)(q + 16) = w1; }
                        } else {
                            if (smp) { if (valid) { GAS float* k = out + O_KS + (size_t)r * 256 + bj * 128 + dl; *(GAS f32x4*)k = x0; *(GAS f32x4*)(k + 16) = x1; } }
                            else { GAS float* k = out + O_KP + (size_t)grow * 256 + bj * 128 + dl; *(GAS f32x4*)k = x0; *(GAS f32x4*)(k + 16) = x1;
                                GAS bf16_t* kb = Kb + (((size_t)bb * NKV + bj) * S + tt) * HD + dl;
                                u32x2 w0 = {pk_bf16(x0[0], x0[1]), pk_bf16(x0[2], x0[3])}, w1 = {pk_bf16(x1[0], x1[1]), pk_bf16(x1[2], x1[3])};
                                *(GAS u32x2*)kb = w0; *(GAS u32x2*)(kb + 16) = w1; }
                        } } }
            } else {
                const int dl = 32 * (wc & 1) + 4 * fq;
                const f32x4 g0 = *(const GAS f32x4*)((const GAS float*)gki + dl), g1 = *(const GAS f32x4*)((const GAS float*)gki + dl + 16);
                GAS f16* KI = (GAS f16*)(ws + WS_KI); GAS float* WI = (GAS float*)(ws + WS_WI);
                ROWLOOP { asm volatile("" ::: "memory"); ROWVARS
                    const f32x4 p = *(const LAS f32x4*)(scr + (r * 2) * 4);
                    const float rs = rsqrtf((p[0] + p[1]) * (1.f / 64.f) + EPS);
                    f32x4 x0 = acc[ai][0][m][0] * rs * g0, x1 = acc[ai][0][m][1] * rs * g1;
                    f32x4 xo; xo[0] = __shfl_xor(x0[0], 32); xo[1] = __shfl_xor(x0[1], 32); xo[2] = __shfl_xor(x0[2], 32); xo[3] = __shfl_xor(x0[3], 32);
                    if (wc == 0) { const GAS f32x4* cp = (const GAS f32x4*)(ri + (slot * 8 + 4 * (fq & 1)) * 2); const f32x4 cs0 = cp[0], cs1 = cp[1];
                        const f32x4 c = {cs0[0], cs0[2], cs1[0], cs1[2]}, s = {cs0[1], cs0[3], cs1[1], cs1[3]};
                        x0 = fq < 2 ? x0 * c - xo * s : x0 * c + xo * s; }
                    if (wc < 2 && valid) {
                        GAS float* ko = smp ? out + O_KIS + (size_t)r * 64 + dl : out + O_KIP + (size_t)grow * 64 + dl;
                        *(GAS f32x4*)ko = x0; *(GAS f32x4*)(ko + 16) = x1;
                        if (!smp) { GAS f16* kh = KI + (size_t)grow * 64 + dl; u32x2 w0 = {pk_f16(x0[0], x0[1]), pk_f16(x0[2], x0[3])}, w1 = {pk_f16(x1[0], x1[1]), pk_f16(x1[2], x1[3])};
                            *(GAS u32x2*)kh = w0; *(GAS u32x2*)(kh + 16) = w1; } }
                    if (wc == 2 && valid) *(GAS f32x4*)(WI + (size_t)grow * 16 + 4 * fq) = acc[ai][0][m][0] * (1.f / 32.f);
                }
            }
        } else if (pn == 5) {
            GAS bf16_t* Vb = (GAS bf16_t*)(ws + WS_VB); const int dl = 32 * wc + 4 * fq;
            ROWLOOP { asm volatile("" ::: "memory"); ROWVARS
#pragma unroll
                for (int bj = 0; bj < 2; ++bj) { const f32x4 x0 = acc[ai][bj][m][0], x1 = acc[ai][bj][m][1];
                    if (smp) { if (valid) { GAS float* v = out + O_VS + (size_t)r * 256 + bj * 128 + dl; *(GAS f32x4*)v = x0; *(GAS f32x4*)(v + 16) = x1; } }
                    else { GAS float* v = out + O_VP + (size_t)grow * 256 + bj * 128 + dl; *(GAS f32x4*)v = x0; *(GAS f32x4*)(v + 16) = x1;
                        GAS bf16_t* vb = Vb + (((size_t)bb * NKV + bj) * S + tt) * HD + dl;
                        u32x2 w0 = {pk_bf16(x0[0], x0[1]), pk_bf16(x0[2], x0[3])}, w1 = {pk_bf16(x1[0], x1[1]), pk_bf16(x1[2], x1[3])};
                        *(GAS u32x2*)vb = w0; *(GAS u32x2*)(vb + 16) = w1; } } }
        } else if (pn <= 9) {
            GAS f16* SZ = (GAS f16*)(ws + WS_SZ); const int c0 = 256 * (pn - 6) + 32 * wc + 4 * fq;
            ROWLOOP { asm volatile("" ::: "memory"); ROWVARS
                if (valid) {
#pragma unroll
                    for (int bj = 0; bj < 2; ++bj)
#pragma unroll
                        for (int n = 0; n < 2; ++n) { const f32x4 x = acc[ai][bj][m][n]; u32x2 w = {pk_f16(silu(x[0]), silu(x[1])), pk_f16(silu(x[2]), silu(x[3]))};
                            *(GAS u32x2*)(SZ + (size_t)grow * 1024 + c0 + 128 * bj + 16 * n) = w; } } }
        } else if (pn <= 13) {
            GAS f16* QI = (GAS f16*)(ws + WS_QI); const int c0 = 256 * (pn - 10) + 32 * wc + 4 * fq;
            ROWLOOP { asm volatile("" ::: "memory"); ROWVARS
                f32x4 c = {1.f, 1.f, 1.f, 1.f}, s = {0.f, 0.f, 0.f, 0.f};
                if ((wc & 1) == 0) { const GAS f32x4* cp = (const GAS f32x4*)(ri + (slot * 8 + 4 * (fq & 1)) * 2); const f32x4 cs0 = cp[0], cs1 = cp[1];
                    c = (f32x4){cs0[0], cs0[2], cs1[0], cs1[2]}; s = (f32x4){cs0[1], cs0[3], cs1[1], cs1[3]}; }
#pragma unroll
                for (int bj = 0; bj < 2; ++bj) { f32x4 x0 = acc[ai][bj][m][0]; const f32x4 x1 = acc[ai][bj][m][1];
                    f32x4 xo; xo[0] = __shfl_xor(x0[0], 32); xo[1] = __shfl_xor(x0[1], 32); xo[2] = __shfl_xor(x0[2], 32); xo[3] = __shfl_xor(x0[3], 32);
                    if ((wc & 1) == 0) x0 = fq < 2 ? x0 * c - xo * s : x0 * c + xo * s;
                    if (valid) { GAS f16* q = QI + (size_t)grow * 1024 + c0 + 128 * bj;
                        u32x2 w0 = {pk_f16(x0[0], x0[1]), pk_f16(x0[2], x0[3])}, w1 = {pk_f16(x1[0], x1[1]), pk_f16(x1[2], x1[3])};
                        *(GAS u32x2*)q = w0; *(GAS u32x2*)(q + 16) = w1; } } }
        } else {
            GAS f16* UG = (GAS f16*)(ws + WS_U); const int ch = 64 * (pn - 15) + 16 * wc + 4 * fq;
            ROWLOOP { asm volatile("" ::: "memory"); ROWVARS
                const f32x4 h = acc[ai][0][m][0], b = acc[ai][0][m][1], c = acc[ai][1][m][0], z = acc[ai][1][m][1];
                const f32x4 uu = c * h; f32x4 gg; gg[0] = b[0] * silu(z[0]); gg[1] = b[1] * silu(z[1]); gg[2] = b[2] * silu(z[2]); gg[3] = b[3] * silu(z[3]);
                if (valid) { u32x4 w = {pk_f16(uu[0], uu[1]), pk_f16(uu[2], uu[3]), pk_f16(gg[0], gg[1]), pk_f16(gg[2], gg[3])};
                    *(GAS u32x4*)(UG + (size_t)grow * 2048 + 2 * ch) = w;
                    if (!smp && tt >= S - 2) *(GAS f32x4*)(out + O_CVP + ((size_t)bb * 2 + (tt - (S - 2))) * 1024 + ch) = uu;
                    if (smp && tt >= 2) *(GAS f32x4*)(out + O_CVS + ((size_t)(r >> 2) * 2 + (tt - 2)) * 1024 + ch) = uu; } }
        }
#undef ROWLOOP
#undef ROWVARS
    }
};


struct EpiOut {
    float* out; const float* xp;
    __device__ __forceinline__ bool aligned(const pg8::Unit&) const { return false; }
    __device__ __forceinline__ void init(f32x4 (&acc)[2][2][4][2], const pg8::Unit& u, int wr, int wc, int fr, int fq) const {
        const GAS float* xp = (const GAS float*)this->xp;
        const size_t base = (size_t)(u.pm * 256 + 64 * wr + fr) * DM + u.pn * 256 + 32 * wc + 4 * fq;
#pragma unroll
        for (int ai = 0; ai < 2; ++ai)
#pragma unroll
            for (int m = 0; m < 4; ++m)
#pragma unroll
                for (int bj = 0; bj < 2; ++bj)
#pragma unroll
                    for (int n = 0; n < 2; ++n) acc[ai][bj][m][n] = *(const GAS f32x4*)(xp + base + (size_t)(128 * ai + 16 * m) * DM + 128 * bj + 16 * n);
    }
    __device__ __forceinline__ void operator()(f32x4 (&acc)[2][2][4][2], const pg8::Unit& u, int wr, int wc, int fr_, int fq_) const {
        int fr = fr_, fq = fq_; asm volatile("" : "+v"(fr), "+v"(fq));
        GAS float* out = (GAS float*)this->out; asm volatile("" : "+s"(out));
        const size_t base = (size_t)(u.pm * 256 + 64 * wr + fr) * DM + u.pn * 256 + 32 * wc + 4 * fq;
#pragma unroll
        for (int ai = 0; ai < 2; ++ai)
#pragma unroll
            for (int m = 0; m < 4; ++m) { const size_t off = base + (size_t)(128 * ai + 16 * m) * DM;
#pragma unroll
                for (int bj = 0; bj < 2; ++bj)
#pragma unroll
                    for (int n = 0; n < 2; ++n) *(GAS f32x4*)(out + off + 128 * bj + 16 * n) = acc[ai][bj][m][n]; }
    }
};
__device__ __forceinline__ void p4_sample(const Args& a, LAS unsigned char* lds, int bx, int G, int tid) {
    const GAS f16* MIX = (const GAS f16*)(a.ws + WS_MIX) + (size_t)MP * DM; const GAS f16* WT = (const GAS f16*)(a.ws + WS_WOUTT);
    LAS float* part = (LAS float*)lds;
    const int lane = tid & 63, wave = __builtin_amdgcn_readfirstlane(tid >> 6), fr = lane & 15, fq = lane >> 4;
    for (int cg = bx; cg < DM / 8; cg += G) {
        const GAS f16* wp = WT + (size_t)(cg * 8 + (fr & 7)) * DM + wave * 256 + 8 * fq; const GAS f16* mp = MIX + (size_t)fr * DM + wave * 256 + 8 * fq;
        f16x8 wf[8], m0[8], m1[8];
#pragma unroll
        for (int ks = 0; ks < 8; ++ks) { wf[ks] = *(const GAS f16x8*)(wp + 32 * ks); m0[ks] = *(const GAS f16x8*)(mp + 32 * ks); m1[ks] = *(const GAS f16x8*)(mp + (size_t)16 * DM + 32 * ks); }
        f32x4 c0 = {0.f, 0.f, 0.f, 0.f}, c1 = {0.f, 0.f, 0.f, 0.f};
#pragma unroll
        for (int ks = 0; ks < 8; ++ks) { c0 = __builtin_amdgcn_mfma_f32_16x16x32_f16(wf[ks], m0[ks], c0, 0, 0, 0); c1 = __builtin_amdgcn_mfma_f32_16x16x32_f16(wf[ks], m1[ks], c1, 0, 0, 0); }
        *(LAS f32x4*)(part + ((wave * 2 + 0) * 64 + lane) * 4) = c0; *(LAS f32x4*)(part + ((wave * 2 + 1) * 64 + lane) * 4) = c1;
        __syncthreads();
        if (tid < 256) { const int rr = tid >> 3, cc = tid & 7; const int ln = (rr & 15) + 16 * (cc >> 2), tl = rr >> 4; float s = a.in[1][(size_t)rr * DM + cg * 8 + cc];
#pragma unroll
            for (int w = 0; w < 8; ++w) s += part[((w * 2 + tl) * 64 + ln) * 4 + (cc & 3)];
            a.out[O_YS + (size_t)rr * DM + cg * 8 + cc] = s; }
        __syncthreads();
    }
}
typedef GAS unsigned gu32;
#define XB_TMO      128
#define XB_XCNT(j)  (256  + 64 * (j))
#define XB_XSUB(j)  (1280 + 64 * (j))
#define XB_XGEN(j)  (2304 + 64 * (j))
#define XB_TOP      3328
#define XB_TOPGEN   3392
#define XCD_BAR_WORDS 3456
#define XB_SPIN_CAP (1u << 18)
__device__ __forceinline__ unsigned xb_ld(unsigned* p)              { return __hip_atomic_load(p, __ATOMIC_RELAXED, __HIP_MEMORY_SCOPE_AGENT); }
__device__ __forceinline__ unsigned xb_add(unsigned* p, unsigned v) { return __hip_atomic_fetch_add(p, v, __ATOMIC_RELAXED, __HIP_MEMORY_SCOPE_AGENT); }
__device__ __forceinline__ unsigned xb_xcc_id() { return (unsigned)__builtin_amdgcn_s_getreg((3 << 11) | 20) & 0xFu; }
#define XB_SPIN(cond, bar) do { unsigned _sp = 0; while (cond) { __builtin_amdgcn_s_sleep(1); \
    if ((++_sp & 255u) == 0u) { if (xb_ld(&(bar)[XB_TMO])) break; if (_sp > XB_SPIN_CAP) { atomicAdd(&(bar)[XB_TMO], 1u); break; } } } } while (0)
struct XcdBarrier { unsigned* bar; unsigned x; volatile LAS unsigned* st; };
__device__ __forceinline__ XcdBarrier xcd_barrier_post(unsigned* bar, volatile LAS unsigned* st) {
    XcdBarrier b; b.bar = bar; b.x = xb_xcc_id(); b.st = st;
    if (threadIdx.x == 0) (void)xb_add(&bar[XB_XCNT(b.x)], 1u);
    return b;
}
__device__ __forceinline__ void xcd_barrier_complete(unsigned* bar, unsigned x, unsigned& nloc, unsigned& nx) {
    const unsigned G = gridDim.x * gridDim.y * gridDim.z;
    unsigned sum, cnt, mine, sp = 0u;
    for (;;) {
        sum = 0u; cnt = 0u; mine = 0u;
#pragma unroll
        for (unsigned j = 0; j < 16; ++j) { const unsigned c = xb_ld(&bar[XB_XCNT(j)]); sum += c; cnt += (c > 0u) ? 1u : 0u; mine = (j == x) ? c : mine; }
        if (sum == G) break;
        __builtin_amdgcn_s_sleep(1);
        if ((++sp & 255u) == 0u) { if (xb_ld(&bar[XB_TMO])) break; if (sp > XB_SPIN_CAP) { atomicAdd(&bar[XB_TMO], 1u); break; } }
    }
    nloc = mine > 0u ? mine : 1u; nx = cnt > 0u ? cnt : 1u;
}
__device__ __forceinline__ void xcd_barrier(const XcdBarrier& b) {
    asm volatile("s_waitcnt vmcnt(0)" ::: "memory");
    __syncthreads();
    if (threadIdx.x == 0) {
        unsigned* bar = b.bar;
        __builtin_amdgcn_s_waitcnt(0);
        unsigned nloc = b.st[0], nx = b.st[1];
        if (nloc == 0u) { xcd_barrier_complete(bar, b.x, nloc, nx); b.st[0] = nloc; b.st[1] = nx; }
        const unsigned old = xb_add(&bar[XB_XSUB(b.x)], 1u);
        const unsigned gen = old / nloc;
        if (old + 1u == (gen + 1u) * nloc) {
            __builtin_amdgcn_fence(__ATOMIC_RELEASE, "agent");
            asm volatile("s_waitcnt vmcnt(0)" ::: "memory");
            const unsigned og = xb_add(&bar[XB_TOP], 1u);
            const unsigned tg = og / nx;
            if (og + 1u == (tg + 1u) * nx) xb_add(&bar[XB_TOPGEN], 1u);
            else XB_SPIN(xb_ld(&bar[XB_TOPGEN]) == tg, bar);
            __builtin_amdgcn_fence(__ATOMIC_ACQUIRE, "agent");
            xb_add(&bar[XB_XGEN(b.x)], 1u);
            asm volatile("s_waitcnt vmcnt(0)" ::: "memory");
        } else {
            XB_SPIN(xb_ld(&bar[XB_XGEN(b.x)]) == gen, bar);
            __builtin_amdgcn_fence(__ATOMIC_ACQUIRE, "agent");
            asm volatile("s_waitcnt vmcnt(0)" ::: "memory");
        }
    }
    __syncthreads();
}

constexpr int RDY_WORD0 = 4096;
__device__ __forceinline__ void signal_add(unsigned* ctr) {
    asm volatile("s_waitcnt vmcnt(0)" ::: "memory");
    __syncthreads();
    if (threadIdx.x == 0) { __builtin_amdgcn_fence(__ATOMIC_RELEASE, "agent"); asm volatile("s_waitcnt vmcnt(0)" ::: "memory"); (void)xb_add(ctr, 1u); }
}
__device__ __forceinline__ void wait_ge(unsigned* ctr, unsigned need) {
    if (threadIdx.x == 0) { unsigned sp = 0; while (xb_ld(ctr) < need) { __builtin_amdgcn_s_sleep(2); if (++sp > (1u << 22)) break; }
        __builtin_amdgcn_fence(__ATOMIC_ACQUIRE, "agent"); asm volatile("s_waitcnt vmcnt(0)" ::: "memory"); }
    __syncthreads();
}

__device__ __forceinline__ void signal_add_wt(unsigned* ctr) {
    asm volatile("s_waitcnt vmcnt(0)" ::: "memory");
    __syncthreads();
    if (threadIdx.x == 0) (void)xb_add(ctr, 1u);
}
__device__ __forceinline__ void wait_ge_wt(unsigned* ctr, unsigned need) {
    if (threadIdx.x == 0) { unsigned sp = 0; while (xb_ld(ctr) < need) { __builtin_amdgcn_s_sleep(2); if (++sp > (1u << 22)) break; } }
    __syncthreads();
}

#ifndef P2_KT_REP
#define P2_KT_REP 1
#define P2_SEL_REP 1
#endif
#ifndef P2_REP_A
#define P2_REP_A 1
#define P2_REP_B 1
#define P2_REP_C 1
#endif
constexpr int SC_STRIDE = 2052;
constexpr int SC_BYTES = 16 * SC_STRIDE * 4;
constexpr int WSCR_OFF = 131584, WSCR_BYTES = 1536;
__device__ __forceinline__ f16x8 cvt8(f32x4 a, f32x4 b) { u32x4 w = {pk_f16(a[0], a[1]), pk_f16(a[2], a[3]), pk_f16(b[0], b[1]), pk_f16(b[2], b[3])}; return __builtin_bit_cast(f16x8, w); }

__device__ __forceinline__ void p2_convmix(const Args& a, int gw, int NGW, int lane) {
    const GAS f16* UG = (const GAS f16*)(a.ws + WS_U); GAS f16* MIX = (GAS f16*)(a.ws + WS_MIX);
    const GAS float* wconv = (const GAS float*)a.in[12]; const GAS float* state = (const GAS float*)a.in[5];
    for (int ch = gw; ch < MT / 4; ch += NGW) {
        const int row0 = 4 * ch; const bool smp = row0 >= MP; const int t0 = smp ? 0 : (row0 & (S - 1)); const int seq = (row0 - MP) >> 2;
#pragma unroll
        for (int half = 0; half < 2; ++half) { const int cb = half * 512 + 8 * lane;
            float um2[8], um1[8], w0[8], w1[8], w2[8];
#pragma unroll
            for (int e = 0; e < 8; e += 4) { const f32x4 a0 = *(const GAS f32x4*)(wconv + cb + e), a1 = *(const GAS f32x4*)(wconv + 1024 + cb + e), a2 = *(const GAS f32x4*)(wconv + 2048 + cb + e);
#pragma unroll
                for (int i = 0; i < 4; ++i) { w0[e + i] = a0[i]; w1[e + i] = a1[i]; w2[e + i] = a2[i]; } }
            if (t0 == 0) {
                if (smp) {
#pragma unroll
                    for (int e = 0; e < 8; e += 4) { const f32x4 s0 = *(const GAS f32x4*)(state + ((size_t)seq * 2) * 1024 + cb + e), s1 = *(const GAS f32x4*)(state + ((size_t)seq * 2 + 1) * 1024 + cb + e);
#pragma unroll
                        for (int i = 0; i < 4; ++i) { um2[e + i] = s0[i]; um1[e + i] = s1[i]; } }
                } else {
#pragma unroll
                    for (int e = 0; e < 8; ++e) { um2[e] = 0.f; um1[e] = 0.f; } }
            } else {
#pragma unroll
                for (int gq = 0; gq < 2; ++gq) { const f16x4 p2 = *(const GAS f16x4*)(UG + (size_t)(row0 - 2) * 2048 + 2 * cb + 8 * gq), p1 = *(const GAS f16x4*)(UG + (size_t)(row0 - 1) * 2048 + 2 * cb + 8 * gq);
#pragma unroll
                    for (int e = 0; e < 4; ++e) { um2[4 * gq + e] = (float)p2[e]; um1[4 * gq + e] = (float)p1[e]; } } }
#pragma unroll
            for (int i = 0; i < 4; ++i) { const size_t row = row0 + i;
                const f16x8 x0 = *(const GAS f16x8*)(UG + row * 2048 + 2 * cb), x1 = *(const GAS f16x8*)(UG + row * 2048 + 2 * cb + 8); float o[8];
#pragma unroll
                for (int e = 0; e < 8; ++e) { const float u = (float)(e < 4 ? x0[e] : x1[e - 4]); const float g = (float)(e < 4 ? x0[4 + e] : x1[e]);
                    const float cv = w0[e] * um2[e] + w1[e] * um1[e] + w2[e] * u; o[e] = g * cv; um2[e] = um1[e]; um1[e] = u; }
                u32x4 w = {pk_f16(o[0], o[1]), pk_f16(o[2], o[3]), pk_f16(o[4], o[5]), pk_f16(o[6], o[7])};
                *(GAS u32x4*)(MIX + row * 2048 + 1024 + cb) = w; }
        }
    }
}

__device__ __forceinline__ void p2_sscore(const Args& a, int gw, int NGW, int lane) {
    const GAS float* cki = (const GAS float*)a.in[4]; const GAS int* ptab = (const GAS int*)a.in[6];
    const GAS f16* QI = (const GAS f16*)(a.ws + WS_QI); const GAS float* WI = (const GAS float*)(a.ws + WS_WI); GAS float* SSC = (GAS float*)(a.ws + WS_SSC);
    const int fr = lane & 15, fq = lane >> 4;
    for (int it = gw; it < NSB * 256; it += NGW) {
        const int sb = it >> 8, hp = it & 255, pg = hp >> 1, k0 = (hp & 1) * 64; const int phys = ptab[sb * NPAGES + pg];
        const GAS float* kbase = cki + ((size_t)phys * PAGE + k0) * 64;
        f16x8 qf[4][2]; f32x4 wv[4];
#pragma unroll
        for (int t = 0; t < 4; ++t) { const size_t row = MP + 4 * sb + t;
            qf[t][0] = *(const GAS f16x8*)(QI + row * 1024 + fr * 64 + 8 * fq); qf[t][1] = *(const GAS f16x8*)(QI + row * 1024 + fr * 64 + 32 + 8 * fq);
            wv[t] = *(const GAS f32x4*)(WI + row * 16 + 4 * fq); }
#pragma unroll
        for (int tile = 0; tile < 4; ++tile) {
            const GAS float* kr = kbase + (size_t)(16 * tile + fr) * 64 + 8 * fq;
            const f16x8 kf0 = cvt8(*(const GAS f32x4*)kr, *(const GAS f32x4*)(kr + 4)), kf1 = cvt8(*(const GAS f32x4*)(kr + 32), *(const GAS f32x4*)(kr + 36));
            float mine = 0.f;
#pragma unroll
            for (int t = 0; t < 4; ++t) { f32x4 c = {0.f, 0.f, 0.f, 0.f};
                c = __builtin_amdgcn_mfma_f32_16x16x32_f16(qf[t][0], kf0, c, 0, 0, 0); c = __builtin_amdgcn_mfma_f32_16x16x32_f16(qf[t][1], kf1, c, 0, 0, 0);
                float s = wv[t][0] * fmaxf(c[0], 0.f) + wv[t][1] * fmaxf(c[1], 0.f) + wv[t][2] * fmaxf(c[2], 0.f) + wv[t][3] * fmaxf(c[3], 0.f);
                s += __shfl_xor(s, 16); s += __shfl_xor(s, 32);
                mine = fq == t ? s : mine; }
            __hip_atomic_store((GAS unsigned*)SSC + ((size_t)(4 * sb + fq) * PAST + pg * PAGE + k0 + 16 * tile + fr), __builtin_bit_cast(unsigned, mine), __ATOMIC_RELAXED, __HIP_MEMORY_SCOPE_AGENT);
        }
    }
}

__device__ __forceinline__ void wave_topk_mask(const LAS float* row, int t, GAS unsigned long long* mrow, int lane, LAS unsigned* hist, LAS float* cand) {
    const float NINF = -__builtin_inff(), PINF = __builtin_inff();
    const int jmax = t >> 6;
    const bool lastok = 64 * jmax + lane <= t;
    float v[32]; float mx = NINF, mn = PINF;
#pragma unroll
    for (int j = 0; j < 32; ++j) { v[j] = NINF;
        if (j < jmax) { v[j] = row[64 * j + lane]; mx = fmaxf(mx, v[j]); mn = fminf(mn, v[j]); }
        else if (j == jmax) { const float x = row[64 * j + lane]; v[j] = lastok ? x : NINF; mx = fmaxf(mx, v[j]); mn = fminf(mn, lastok ? x : PINF); } }
#pragma unroll
    for (int o = 1; o < 64; o <<= 1) { mx = fmaxf(mx, __shfl_xor(mx, o)); mn = fminf(mn, __shfl_xor(mn, o)); }
    *(LAS u32x4*)(hist + 4 * lane) = (u32x4){0u, 0u, 0u, 0u};
    const float scale = 255.5f / (mx - mn);
    float tau = 0.f; bool have = false;
    if (mx > mn) {
        asm volatile("s_waitcnt lgkmcnt(0)" ::: "memory");
        unsigned bins[8];
#pragma unroll
        for (int j = 0; j < 8; ++j) bins[j] = 0u;
#pragma unroll
        for (int j = 0; j < 32; ++j) {
            if (j < jmax) { const unsigned b = (unsigned)((v[j] - mn) * scale); bins[j >> 2] |= b << (8 * (j & 3)); __hip_atomic_fetch_add(hist + b, 1u, __ATOMIC_RELAXED, __HIP_MEMORY_SCOPE_WORKGROUP); }
            else if (j == jmax) { const unsigned b = lastok ? (unsigned)((v[j] - mn) * scale) : 0u; bins[j >> 2] |= b << (8 * (j & 3)); if (lastok) __hip_atomic_fetch_add(hist + b, 1u, __ATOMIC_RELAXED, __HIP_MEMORY_SCOPE_WORKGROUP); } }
        asm volatile("s_waitcnt lgkmcnt(0)" ::: "memory");
        const u32x4 h = *(const LAS u32x4*)(hist + 4 * lane);
        const unsigned sl = h[0] + h[1] + h[2] + h[3]; unsigned pre = sl;
#pragma unroll
        for (int o = 1; o < 64; o <<= 1) { const unsigned y = __shfl_up(pre, o); if (lane >= o) pre += y; }
        const unsigned tot = __builtin_amdgcn_readlane(pre, 63); const unsigned suf = tot - pre + sl;
        const unsigned long long bm = __ballot(suf >= TOPK);
        const int Ls = 63 - __builtin_clzll(bm);
        unsigned c = __builtin_amdgcn_readlane(suf, Ls) - __builtin_amdgcn_readlane(sl, Ls);
        const unsigned h3 = __builtin_amdgcn_readlane(h[3], Ls), h2 = __builtin_amdgcn_readlane(h[2], Ls), h1 = __builtin_amdgcn_readlane(h[1], Ls);
        int Bs;
        if (c + h3 >= TOPK) Bs = 4 * Ls + 3; else { c += h3; if (c + h2 >= TOPK) Bs = 4 * Ls + 2; else { c += h2; if (c + h1 >= TOPK) Bs = 4 * Ls + 1; else { c += h1; Bs = 4 * Ls; } } }
        const int need = TOPK - (int)c;
        int base = 0;
#pragma unroll
        for (int j = 0; j < 32; ++j) { if (j <= jmax) { const int b = (int)((bins[j >> 2] >> (8 * (j & 3))) & 255u); const bool isc = (j < jmax || lastok) && b == Bs;
            const unsigned long long m = __ballot(isc);
            if (m) { const int pos = base + (int)__builtin_amdgcn_mbcnt_hi((unsigned)(m >> 32), __builtin_amdgcn_mbcnt_lo((unsigned)m, 0u)); if (isc && pos < 64) cand[pos] = v[j]; base += __builtin_popcountll(m); } } }
        if (base <= 64) {
            asm volatile("s_waitcnt lgkmcnt(0)" ::: "memory");
            const float x = lane < base ? cand[lane] : NINF; int rank = 0;
            for (int m = 0; m < base; ++m) { const float y = __builtin_bit_cast(float, __builtin_amdgcn_readlane(__builtin_bit_cast(int, x), m)); rank += y > x ? 1 : 0; }
            float tc = (lane < base && rank <= need - 1) ? x : PINF;
#pragma unroll
            for (int o = 1; o < 64; o <<= 1) tc = fminf(tc, __shfl_xor(tc, o));
            tau = tc; have = true;
        }
    }
    if (!have) {
        unsigned tk = 0u;
        for (int bit = 31; bit >= 0; --bit) { const unsigned cd = tk | (1u << bit); int cnt = 0;
#pragma unroll
            for (int j = 0; j < 32; ++j) cnt += __builtin_popcountll(__ballot((64 * j + lane <= t) && fkey(v[j]) >= cd));
            if (cnt >= TOPK) tk = cd; }
        tau = __builtin_bit_cast(float, (tk & 0x80000000u) ? (tk ^ 0x80000000u) : ~tk);
    }
    unsigned wlo = 0u, whi = 0u;
#pragma unroll
    for (int j = 0; j < 32; ++j) { if (j <= jmax) { const unsigned long long m = __ballot(v[j] >= tau);
        if (lane == j) { wlo = (unsigned)m; whi = (unsigned)(m >> 32); } } }
    if (lane < 32) __hip_atomic_store(mrow + lane, ((unsigned long long)whi << 32) | wlo, __ATOMIC_RELAXED, __HIP_MEMORY_SCOPE_AGENT);
}

#define RELU_FMA(acc_, c_, w_) do { const float f_ = (c_); const int i_ = __builtin_bit_cast(int, f_); const float r_ = __builtin_bit_cast(float, i_ > 0 ? i_ : 0); asm("v_fmac_f32_e32 %0, %1, %2" : "+v"(acc_) : "v"(r_), "v"(w_)); } while (0)
__device__ __forceinline__ void p2_index_tile(const Args& a, LAS unsigned char* lds, int b, int t0, int wave, int lane) {
    const GAS f16* QI = (const GAS f16*)(a.ws + WS_QI); const GAS float* WI = (const GAS float*)(a.ws + WS_WI); const GAS f16* KI = (const GAS f16*)(a.ws + WS_KI);
    GAS unsigned long long* MASK = (GAS unsigned long long*)(a.ws + WS_MASK);
    LAS float* sc = (LAS float*)lds;
    const int fr = lane & 15, fq = lane >> 4; const size_t rowq = (size_t)b * S + t0 + fr;
    f16x8 qf[16][2]; float w[16];
#pragma unroll
    for (int h = 0; h < 16; ++h) { qf[h][0] = *(const GAS f16x8*)(QI + rowq * 1024 + h * 64 + 8 * fq); qf[h][1] = *(const GAS f16x8*)(QI + rowq * 1024 + h * 64 + 32 + 8 * fq); }
#pragma unroll
    for (int h = 0; h < 16; h += 4) { const f32x4 x = *(const GAS f32x4*)(WI + rowq * 16 + h); w[h] = x[0]; w[h + 1] = x[1]; w[h + 2] = x[2]; w[h + 3] = x[3]; }
    const int nkt = (t0 + 16) >> 4;
    const GAS f16* kp = KI + ((size_t)b * S + fr) * 64 + 8 * fq;
#define KLOAD(d0_, d1_, kt_) do { const int k_ = (kt_) < nkt ? (kt_) : wave; d0_ = *(const GAS f16x8*)(kp + (size_t)k_ * 1024); d1_ = *(const GAS f16x8*)(kp + (size_t)k_ * 1024 + 32); } while (0)
    f16x8 ka0, ka1, kb0, kb1, kc0, kc1;
#define KCOMP(kf0, kf1, kt_) do { float a0 = 0.f, a1 = 0.f, a2 = 0.f, a3 = 0.f; const f32x4 z4 = {0.f, 0.f, 0.f, 0.f}; \
        f32x4 cc = __builtin_amdgcn_mfma_f32_16x16x32_f16(kf0, qf[0][0], z4, 0, 0, 0); cc = __builtin_amdgcn_mfma_f32_16x16x32_f16(kf1, qf[0][1], cc, 0, 0, 0); \
        _Pragma("unroll") for (int h = 0; h < 16; ++h) { f32x4 cn = z4;        \
            if (h < 15) { cn = __builtin_amdgcn_mfma_f32_16x16x32_f16(kf0, qf[h + 1][0], z4, 0, 0, 0); cn = __builtin_amdgcn_mfma_f32_16x16x32_f16(kf1, qf[h + 1][1], cn, 0, 0, 0); } \
            RELU_FMA(a0, cc[0], w[h]); RELU_FMA(a1, cc[1], w[h]); RELU_FMA(a2, cc[2], w[h]); RELU_FMA(a3, cc[3], w[h]); \
            cc = cn; __builtin_amdgcn_sched_barrier(0); } \
        *(LAS f32x4*)(sc + fr * SC_STRIDE + 16 * (kt_) + 4 * fq) = (f32x4){a0, a1, a2, a3}; } while (0)
    KLOAD(ka0, ka1, wave); KLOAD(kb0, kb1, wave + NWAVES);
    for (int rpk = 0; rpk < P2_KT_REP; ++rpk)
    for (int kt = wave; kt < nkt; kt += 3 * NWAVES) {
        KLOAD(kc0, kc1, kt + 2 * NWAVES); KCOMP(ka0, ka1, kt);
        if (kt + NWAVES < nkt) { KLOAD(ka0, ka1, kt + 3 * NWAVES); KCOMP(kb0, kb1, kt + NWAVES); }
        if (kt + 2 * NWAVES < nkt) { KLOAD(kb0, kb1, kt + 4 * NWAVES); KCOMP(kc0, kc1, kt + 2 * NWAVES); }
    }
#undef KCOMP
#undef KLOAD
    __syncthreads();
#pragma unroll 1
    for (int qq = 0; qq < 2 * P2_SEL_REP; ++qq) { const int q = 2 * wave + (qq & 1); const int t = t0 + q;
        wave_topk_mask(sc + q * SC_STRIDE, t, MASK + ((size_t)b * S + t) * 32, lane, (LAS unsigned*)(lds + WSCR_OFF + wave * WSCR_BYTES), (LAS float*)(lds + WSCR_OFF + wave * WSCR_BYTES + 1024)); }
    __syncthreads();
}

__device__ __forceinline__ void p2_phase(const Args& a, LAS unsigned char* lds, int vcu, int G, int wave, int lane) {
    const int gw = vcu * NWAVES + wave, NGW = G * NWAVES;
    unsigned* rdy = (unsigned*)a.ws + RDY_WORD0;
    for (int rp = 0; rp < P2_REP_A; ++rp) p2_sscore(a, gw, NGW, lane);
    signal_add_wt(rdy + 64 * 32);
    { GAS unsigned long long* MASK = (GAS unsigned long long*)(a.ws + WS_MASK);
      for (int i = gw * 64 + lane; i < NB * TOPK * 32; i += NGW * 64) { const int wd = i & 31, t = (i >> 5) & (TOPK - 1), b = i >> 13; const int lo = 64 * wd;
          const unsigned long long m = lo + 63 <= t ? ~0ull : (lo > t ? 0ull : ((1ull << (t - lo + 1)) - 1ull));
          __hip_atomic_store(MASK + ((size_t)b * S + t) * 32 + wd, m, __ATOMIC_RELAXED, __HIP_MEMORY_SCOPE_AGENT); } }
    signal_add_wt(rdy + 64 * 33);
    constexpr int NT = NB * (S - TOPK) / 16;
    for (int rp = 0; rp < P2_REP_C; ++rp)
    for (int r = 0; r * G < NT; ++r) { const int k = (r & 1) ? (r + 1) * G - 1 - vcu : r * G + vcu;
        if (k < NT) { const int j = (NT / NB - 1) - (k >> 2), b = k & 3; p2_index_tile(a, lds, b, TOPK + 16 * j, wave, lane);
            if (rp == 0) signal_add_wt(rdy + 64 * (40 + b * 32 + ((TOPK + 16 * j) >> 6))); } }
}

#ifndef P3_REP_S
#define P3_REP_S 1
#define P3_REP_A 1
#endif
namespace att {
typedef short bf16x8 __attribute__((ext_vector_type(8)));
typedef short s16x4 __attribute__((ext_vector_type(4)));
typedef float f32x16 __attribute__((ext_vector_type(16)));
constexpr int QBLK = 32, KVBLK = 64, D = 128;
constexpr int SHM_V = KVBLK * D * 2, SHM_K = KVBLK * D * 2;
constexpr int WS_OFF = 2 * SHM_V + 2 * SHM_K;
constexpr float SCALE = 0.08838834764831845f;
#define KSWZ(row, colB) ((row) * 256 + ((colB) ^ (((row) & 7) << 4)))
#define SBAR() __builtin_amdgcn_sched_barrier(0)
__device__ __forceinline__ int v_st(int k, int c) { const int kk = (k & ~0xC) | ((k & 4) << 1) | ((k & 8) >> 1); return ((kk >> 3) * 4 + (c >> 5)) * 512 + ((kk & 7) * 32 + (c & 31)) * 2; }
__device__ __forceinline__ int v_rd_base(int lane) { return ((lane & 3) << 3) | (((lane >> 2) & 3) << 6) | (((lane >> 4) & 1) << 5) | (((lane >> 5) & 1) << 8); }
constexpr int v_rd_off(int d0, int ks, int half) { return d0 * 512 + ks * 4096 + half * 2048; }
__device__ __forceinline__ int crow(int r, int hi) { return (r & 3) + 8 * (r >> 2) + 4 * hi; }
__device__ __forceinline__ unsigned cvtpk(float lo, float hi) { return pk_bf16(lo, hi); }

template <int KB>
__device__ __forceinline__ void qkt(f32x16& p0, f32x16& p1, const LAS unsigned char* K_lds, int r32, int hi, const LAS unsigned char* qp) {
    p0 = f32x16{}; p1 = f32x16{};
    const LAS unsigned char* kb[4];
#pragma unroll
    for (int dd = 0; dd < 4; ++dd) kb[dd] = K_lds + KB * SHM_K + KSWZ(r32, (dd * 16 + hi * 8) * 2);
#pragma unroll
    for (int d0 = 0; d0 < 8; ++d0) { const LAS unsigned char* a = kb[d0 & 3] + (d0 >> 2) * 128;
        const bf16x8 b0 = *(const LAS bf16x8*)a;
        const bf16x8 b1 = *(const LAS bf16x8*)(a + 32 * 256);
        const bf16x8 qv = *(const LAS bf16x8*)(qp + d0 * 1024);
        p0 = __builtin_amdgcn_mfma_f32_32x32x16_bf16(b0, qv, p0, 0, 0, 0);
        p1 = __builtin_amdgcn_mfma_f32_32x32x16_bf16(b1, qv, p1, 0, 0, 0); }
}
template <int VB>
__device__ __forceinline__ void pv_tile(f32x16* o, int vb0, bf16x8 pa0, bf16x8 pa1, bf16x8 pa2, bf16x8 pa3) {
#define TRRD(dst, off) asm volatile("ds_read_b64_tr_b16 %0, %1 offset:%2" : "=&v"(dst) : "v"(vb0), "i"(off) : "memory")
#define PV_D0(d0) do { s16x4 l0, l1, l2, l3, h0, h1, h2, h3; constexpr int b_ = VB * SHM_V + v_rd_off(d0, 0, 0); \
        TRRD(l0, b_); TRRD(h0, b_ + 2048); TRRD(l1, b_ + 4096); TRRD(h1, b_ + 6144); TRRD(l2, b_ + 8192); TRRD(h2, b_ + 10240); TRRD(l3, b_ + 12288); TRRD(h3, b_ + 14336); \
        asm volatile("s_waitcnt lgkmcnt(0)" ::: "memory"); SBAR(); \
        o[d0] = __builtin_amdgcn_mfma_f32_32x32x16_bf16(pa0, (bf16x8){l0[0], l0[1], l0[2], l0[3], h0[0], h0[1], h0[2], h0[3]}, o[d0], 0, 0, 0); \
        o[d0] = __builtin_amdgcn_mfma_f32_32x32x16_bf16(pa1, (bf16x8){l1[0], l1[1], l1[2], l1[3], h1[0], h1[1], h1[2], h1[3]}, o[d0], 0, 0, 0); \
        o[d0] = __builtin_amdgcn_mfma_f32_32x32x16_bf16(pa2, (bf16x8){l2[0], l2[1], l2[2], l2[3], h2[0], h2[1], h2[2], h2[3]}, o[d0], 0, 0, 0); \
        o[d0] = __builtin_amdgcn_mfma_f32_32x32x16_bf16(pa3, (bf16x8){l3[0], l3[1], l3[2], l3[3], h3[0], h3[1], h3[2], h3[3]}, o[d0], 0, 0, 0); } while (0)
    PV_D0(0); PV_D0(1); PV_D0(2); PV_D0(3);
#undef PV_D0
#undef TRRD
}
__device__ __forceinline__ void partialSM(f32x16& p0, f32x16& p1, unsigned wl, unsigned wh, float sh2) {
    const float NEG = -__builtin_inff(); constexpr float C2 = 1.4426950408889634f * SCALE;
#pragma unroll
    for (int r = 0; r < 16; ++r) { const unsigned bit = 1u << ((r & 3) + 8 * (r >> 2));
        p0[r] = (wl & bit) ? fmaf(p0[r], C2, -sh2) : NEG; p1[r] = (wh & bit) ? fmaf(p1[r], C2, -sh2) : NEG; }
#pragma unroll
    for (int r = 0; r < 16; ++r) p0[r] = __builtin_amdgcn_exp2f(p0[r]);
}
__device__ __forceinline__ void finishSM(f32x16& p0, f32x16& p1, float& l_reg, bf16x8& pa0, bf16x8& pa1, bf16x8& pa2, bf16x8& pa3) {
#pragma unroll
    for (int r = 0; r < 16; ++r) p1[r] = __builtin_amdgcn_exp2f(p1[r]);
    float ps = 0;
#pragma unroll
    for (int r = 0; r < 16; ++r) ps += p0[r];
#pragma unroll
    for (int r = 0; r < 16; ++r) ps += p1[r];
    l_reg += ps;
#define PK4(P, B_, OUT) do { unsigned a0 = cvtpk(P[B_+0], P[B_+1]), a1 = cvtpk(P[B_+2], P[B_+3]); \
        unsigned b0 = cvtpk(P[B_+4], P[B_+5]), b1 = cvtpk(P[B_+6], P[B_+7]); \
        auto r0 = __builtin_amdgcn_permlane32_swap(a0, b0, false, false); auto r1 = __builtin_amdgcn_permlane32_swap(a1, b1, false, false); \
        u32x4 w = {r0[0], r1[0], r0[1], r1[1]}; OUT = __builtin_bit_cast(bf16x8, w); } while (0)
    PK4(p0, 0, pa0); PK4(p0, 8, pa1); PK4(p1, 0, pa2); PK4(p1, 8, pa3);
#undef PK4
}

__device__ __forceinline__ __amdgpu_buffer_rsrc_t mk_rsrc(const GAS void* p, unsigned bytes) {
    const unsigned long long u = (unsigned long long)p; const unsigned lo = __builtin_amdgcn_readfirstlane((unsigned)u), hi = __builtin_amdgcn_readfirstlane((unsigned)(u >> 32));
    return __builtin_amdgcn_make_buffer_rsrc((void*)(((unsigned long long)hi << 32) | lo), (short)0, (int)bytes, 0x00020000);
}
__device__ __forceinline__ void attn_block(const Args& a, LAS unsigned char* lds, int b, int kvh, int q0, float sh2) {
    int tid_ = threadIdx.x; asm volatile("" : "+v"(tid_));
    const int tid = tid_, wid = __builtin_amdgcn_readfirstlane(tid >> 6), lane = tid & 63, r32 = lane & 31, hi = lane >> 5;
    const int head = 4 * kvh + (wid >> 1), qw = q0 + 32 * (wid & 1);
    const GAS bf16_t* Qw = (const GAS bf16_t*)(a.ws + WS_QB) + (((size_t)b * NH + head) * S + qw) * D;
    const GAS bf16_t* Kh = (const GAS bf16_t*)(a.ws + WS_KB) + ((size_t)b * NKV + kvh) * S * D;
    const GAS bf16_t* Vh = (const GAS bf16_t*)(a.ws + WS_VB) + ((size_t)b * NKV + kvh) * S * D;
    const __amdgpu_buffer_rsrc_t rK = mk_rsrc(Kh, S * D * 2), rV = mk_rsrc(Vh, S * D * 2), rM = mk_rsrc((const GAS unsigned long long*)(a.ws + WS_MASK) + ((size_t)b * S + qw) * 32, 32 * 256);
    const unsigned moff = (unsigned)r32 * 256u;
    const int NT = q0 / KVBLK + 1;
    LAS unsigned char* V_lds = lds; LAS unsigned char* K_lds = lds + 2 * SHM_V;
    const int sr = tid >> 4, sc = (tid & 15) * 8, vst0 = v_st(sr, sc), vst1 = v_st(32 + sr, sc), kws = KSWZ(sr, sc * 2);
    const int vb0 = (int)(unsigned)(size_t)V_lds + v_rd_base(lane); const unsigned kvoff = (unsigned)(sr * D + sc) * 2u;
    bf16x8 st_v0, st_v1, st_k0, st_k1;
    LAS unsigned char* qp = lds + WS_OFF + 2048 + wid * 8192 + lane * 16;
#define VMW() asm volatile("s_waitcnt vmcnt(0)" ::: "memory")
#define BL128(r_, so_) __builtin_bit_cast(bf16x8, __builtin_amdgcn_raw_buffer_load_b128(r_, kvoff, (so_), 0))
#define SLOAD_H(k0) do { const int so_ = (k0) * 256; st_v0 = BL128(rV, so_); st_v1 = BL128(rV, so_ + 8192); st_k0 = BL128(rK, so_); st_k1 = BL128(rK, so_ + 8192); } while (0)
#define SWRITE_HK(bf) do { *(LAS bf16x8*)(K_lds + (bf) * SHM_K + kws) = st_k0; *(LAS bf16x8*)(K_lds + (bf) * SHM_K + kws + 32 * 256) = st_k1; } while (0)
#define SWRITE_HV(bf) do { *(LAS bf16x8*)(V_lds + (bf) * SHM_V + vst0) = st_v0; *(LAS bf16x8*)(V_lds + (bf) * SHM_V + vst1) = st_v1; } while (0)
#define SWRITE_H(bf) do { SWRITE_HV(bf); SWRITE_HK(bf); } while (0)
#define MLOAD(t) __builtin_bit_cast(unsigned long long, __builtin_amdgcn_raw_buffer_load_b64(rM, moff, (t) * 8, 16))
#define MSPLIT(mw, wl, wh) do { wl = (unsigned)(mw) >> (4 * hi); wh = (unsigned)((mw) >> 32) >> (4 * hi); } while (0)
    { bf16x8 qt[8];
#pragma unroll
      for (int d0 = 0; d0 < 8; ++d0) qt[d0] = *(const GAS bf16x8*)(Qw + (unsigned)(r32 * D + d0 * 16 + hi * 8));
#pragma unroll
      for (int d0 = 0; d0 < 8; ++d0) *(LAS bf16x8*)(qp + d0 * 1024) = qt[d0]; }
    SLOAD_H(0); unsigned long long mwA = MLOAD(0), mwB = 0ull; VMW(); SWRITE_H(0);
    if (NT > 1) { SLOAD_H(KVBLK); mwB = MLOAD(1); }
    __syncthreads();
    float l_reg = 0.f; f32x16 o[4] = {};
    f32x16 p0, p1; bf16x8 pa0, pa1, pa2, pa3; unsigned wl, wh;
    SBAR(); qkt<0>(p0, p1, K_lds, r32, hi, qp);
    MSPLIT(mwA, wl, wh); partialSM(p0, p1, wl, wh, sh2);
    if (NT > 1) { VMW(); SWRITE_H(1); }
    __syncthreads();
#define STEP(t, KB, VB) do { \
        finishSM(p0, p1, l_reg, pa0, pa1, pa2, pa3); SBAR(); \
        if ((t) + 1 < NT) { SLOAD_H(((t) + 1) * KVBLK); mwA = MLOAD((t) + 1); SBAR(); } \
        pv_tile<VB>(o, vb0, pa0, pa1, pa2, pa3); SBAR(); \
        qkt<KB>(p0, p1, K_lds, r32, hi, qp); \
        MSPLIT(mwB, wl, wh); partialSM(p0, p1, wl, wh, sh2); mwB = mwA; \
        __syncthreads(); \
        if ((t) + 1 < NT) { VMW(); SWRITE_H(VB); } \
        __syncthreads(); } while (0)
    int t = 1;
    for (; t + 1 < NT; t += 2) { STEP(t, 1, 0); STEP(t + 1, 0, 1); }
    if (t < NT) { STEP(t, 1, 0); }
    finishSM(p0, p1, l_reg, pa0, pa1, pa2, pa3); SBAR();
    if ((NT - 1) & 1) pv_tile<1>(o, vb0, pa0, pa1, pa2, pa3); else pv_tile<0>(o, vb0, pa0, pa1, pa2, pa3);
    { auto rr = __builtin_amdgcn_permlane32_swap(__float_as_uint(l_reg), __float_as_uint(l_reg), false, false); l_reg = __uint_as_float(rr[0]) + __uint_as_float(rr[1]); }
    { int te = threadIdx.x; asm volatile("" : "+v"(te));
      const int le = te & 63, r32e = le & 31, hie = le >> 5;
      LAS float* wse = (LAS float*)(lds + WS_OFF) + wid * 64;
      if (hie == 0) wse[r32e] = l_reg;
      asm volatile("s_waitcnt lgkmcnt(0)" ::: "memory");
      __syncthreads();
      LAS f16* stg = (LAS f16*)(lds + wid * 8192);
#pragma unroll
      for (int r = 0; r < 16; ++r) { const int orow = crow(r, hie); const float rl = __builtin_amdgcn_rcpf(wse[orow]);
#pragma unroll
          for (int d0 = 0; d0 < 4; ++d0) stg[orow * 128 + d0 * 32 + r32e] = (f16)(o[d0][r] * rl); }
      asm volatile("s_waitcnt lgkmcnt(0)" ::: "memory");
      const GAS f16* SZ = (const GAS f16*)(a.ws + WS_SZ) + ((size_t)b * S + qw) * 1024 + head * 128; GAS f16* MIX = (GAS f16*)(a.ws + WS_MIX) + ((size_t)b * S + qw) * 2048 + head * 128;
#pragma unroll
      for (int i = 0; i < 8; ++i) { const int c = le + 64 * i, row = c >> 4, ch = c & 15;
          const f16x8 ov = *(const LAS f16x8*)(stg + row * 128 + ch * 8); const f16x8 zv = *(const GAS f16x8*)(SZ + (unsigned)(row * 1024 + ch * 8));
          *(GAS f16x8*)(MIX + (unsigned)(row * 2048 + ch * 8)) = ov * zv; } }
    asm volatile("s_waitcnt lgkmcnt(0)" ::: "memory");
    __syncthreads();
#undef BL128
#undef VMW
#undef SLOAD_H
#undef SWRITE_HK
#undef SWRITE_HV
#undef SWRITE_H
#undef MLOAD
#undef MSPLIT
#undef STEP
}
#undef KSWZ
#undef SBAR
}

__device__ __forceinline__ void p3_sample_item(const Args& a, LAS unsigned char* lds, int item, int tid) {
    const int qi = item >> 1, kvh = item & 1, sb = qi / NST, tl = qi % NST; constexpr int L = PAST + NST, PER = 33;
    const int lane = tid & 63, wave = __builtin_amdgcn_readfirstlane(tid >> 6);
    const GAS float* ck = (const GAS float*)a.in[2]; const GAS float* cv = (const GAS float*)a.in[3]; const GAS int* ptab = (const GAS int*)a.in[6]; const GAS float* out_ro = (const GAS float*)a.out;
    LAS float* q = (LAS float*)lds; LAS float* w = q + 1024; LAS float* newsc = w + 16; LAS float* ctl = newsc + 4; LAS float* red = ctl + 16;
    LAS unsigned* hist = (LAS unsigned*)(red + 32); LAS float* cand = (LAS float*)(hist + 256); LAS unsigned* cnt = (LAS unsigned*)(cand + 64);
    LAS unsigned* rid = cnt + 32; LAS float* qa = (LAS float*)(rid + 512); LAS float* sc = qa + 512; LAS float* inv = sc + 4 * 512; LAS float* part = inv + 4;
    LAS int* nsel = (LAS int*)(ctl + 8); LAS int* ncand = (LAS int*)(ctl + 9);
    const GAS f16* QI = (const GAS f16*)(a.ws + WS_QI) + (size_t)(MP + qi) * 1024; const GAS float* QS = (const GAS float*)(a.ws + WS_QS) + (size_t)qi * 1024 + kvh * 512;
    for (int i = tid; i < 1024; i += 512) q[i] = (float)QI[i];
    qa[tid] = QS[tid];
    if (tid < 16) w[tid] = ((const GAS float*)(a.ws + WS_WI))[(size_t)(MP + qi) * 16 + tid];
    if (tid < 32) cnt[tid] = 0u;
    if (tid < 256) hist[tid] = 0u;
    if (tid == 0) { *nsel = 0; *ncand = 0; }
    const GAS float* ssc = (const GAS float*)(a.ws + WS_SSC) + (size_t)qi * PAST;
    float v[PER];
#pragma unroll
    for (int j = 0; j < PER - 1; ++j) v[j] = __builtin_bit_cast(float, __hip_atomic_load((const GAS unsigned*)ssc + (j * 512 + tid), __ATOMIC_RELAXED, __HIP_MEMORY_SCOPE_AGENT));
    __syncthreads();
    if (tid < NST) { const GAS float* kr = out_ro + O_KIS + (size_t)(sb * NST + tid) * 64; float s = 0.f;
#pragma unroll 1
        for (int h = 0; h < 16; ++h) { float dsum = 0.f;
#pragma unroll 8
            for (int d = 0; d < 64; ++d) dsum += q[h * 64 + d] * kr[d];
            s += w[h] * fmaxf(dsum, 0.f); }
        newsc[tid] = s; }
    __syncthreads();
    const float NINF = -__builtin_inff(), PINF = __builtin_inff();
    { const int s = (PER - 1) * 512 + tid; v[PER - 1] = (s < L && (s - PAST) <= tl) ? newsc[s - PAST] : NINF; }
    float mx = NINF, mn = PINF;
#pragma unroll
    for (int j = 0; j < PER; ++j) { mx = fmaxf(mx, v[j]); mn = fminf(mn, v[j] == NINF ? PINF : v[j]); }
#pragma unroll
    for (int o = 1; o < 64; o <<= 1) { mx = fmaxf(mx, __shfl_xor(mx, o)); mn = fminf(mn, __shfl_xor(mn, o)); }
    if (lane == 0) { red[wave] = mx; red[8 + wave] = mn; }
    __syncthreads();
#pragma unroll
    for (int i = 0; i < 8; ++i) { mx = fmaxf(mx, red[i]); mn = fminf(mn, red[8 + i]); }
    const float scale = 255.5f / (mx - mn);
    float tau = 0.f; bool have = false;
    if (mx > mn) {
#pragma unroll
        for (int j = 0; j < PER; ++j) if (v[j] != NINF) { int bn = (int)((v[j] - mn) * scale); bn = bn > 255 ? 255 : bn; __hip_atomic_fetch_add(hist + bn, 1u, __ATOMIC_RELAXED, __HIP_MEMORY_SCOPE_WORKGROUP); }
        __syncthreads();
        if (wave == 0) {
            const u32x4 h = *(const LAS u32x4*)(hist + 4 * lane);
            const unsigned sl = h[0] + h[1] + h[2] + h[3]; unsigned pre = sl;
#pragma unroll
            for (int o = 1; o < 64; o <<= 1) { const unsigned y = __shfl_up(pre, o); if (lane >= o) pre += y; }
            const unsigned tot = __builtin_amdgcn_readlane(pre, 63); const unsigned suf = tot - pre + sl;
            const unsigned long long bm = __ballot(suf >= TOPK);
            const int Ls = 63 - __builtin_clzll(bm);
            unsigned c = __builtin_amdgcn_readlane(suf, Ls) - __builtin_amdgcn_readlane(sl, Ls);
            const unsigned h3 = __builtin_amdgcn_readlane(h[3], Ls), h2 = __builtin_amdgcn_readlane(h[2], Ls), h1 = __builtin_amdgcn_readlane(h[1], Ls);
            int Bs;
            if (c + h3 >= TOPK) Bs = 4 * Ls + 3; else { c += h3; if (c + h2 >= TOPK) Bs = 4 * Ls + 2; else { c += h2; if (c + h1 >= TOPK) Bs = 4 * Ls + 1; else { c += h1; Bs = 4 * Ls; } } }
            if (lane == 0) { ((LAS int*)ctl)[0] = Bs; ((LAS int*)ctl)[1] = TOPK - (int)c; }
        }
        __syncthreads();
        const int Bs = ((LAS int*)ctl)[0], need = ((LAS int*)ctl)[1];
#pragma unroll
        for (int j = 0; j < PER; ++j) if (v[j] != NINF) { int bn = (int)((v[j] - mn) * scale); bn = bn > 255 ? 255 : bn;
            if (bn == Bs) { const int p = __hip_atomic_fetch_add(ncand, 1, __ATOMIC_RELAXED, __HIP_MEMORY_SCOPE_WORKGROUP); if (p < 64) cand[p] = v[j]; } }
        __syncthreads();
        const int base = *ncand;
        if (base <= 64) {
            if (wave == 0) { const float x = lane < base ? cand[lane] : NINF; int rank = 0;
                for (int m = 0; m < base; ++m) { const float y = __builtin_bit_cast(float, __builtin_amdgcn_readlane(__builtin_bit_cast(int, x), m)); rank += y > x ? 1 : 0; }
                float tc = (lane < base && rank <= need - 1) ? x : PINF;
#pragma unroll
                for (int o = 1; o < 64; o <<= 1) tc = fminf(tc, __shfl_xor(tc, o));
                if (lane == 0) ctl[2] = tc; }
            __syncthreads();
            tau = ctl[2]; have = true;
        }
    }
    if (!have) {
        unsigned tk = 0u;
        for (int bit = 31; bit >= 0; --bit) { const unsigned cd = tk | (1u << bit); int c = 0;
#pragma unroll
            for (int j = 0; j < PER; ++j) c += __builtin_popcountll(__ballot(v[j] != NINF && fkey(v[j]) >= cd));
            if (lane == 0) __hip_atomic_fetch_add(cnt + bit, (unsigned)c, __ATOMIC_RELAXED, __HIP_MEMORY_SCOPE_WORKGROUP);
            __syncthreads();
            if (cnt[bit] >= TOPK) tk = cd; }
        tau = __builtin_bit_cast(float, (tk & 0x80000000u) ? (tk ^ 0x80000000u) : ~tk);
    }
#pragma unroll
    for (int j = 0; j < PER; ++j) { if (v[j] >= tau) { const int s = j * 512 + tid; const int p = __hip_atomic_fetch_add(nsel, 1, __ATOMIC_RELAXED, __HIP_MEMORY_SCOPE_WORKGROUP);
        if (p < 512) rid[p] = s < PAST ? (unsigned)(ptab[sb * NPAGES + (s >> 7)] * PAGE + (s & (PAGE - 1))) : (0x80000000u | (unsigned)(s - PAST)); } }
    __syncthreads();
    const int n = *nsel < 512 ? *nsel : 512;
    const int half = lane >> 5, l32 = lane & 31;
    { f32x4 qv[4];
#pragma unroll
      for (int h = 0; h < 4; ++h) qv[h] = *(const LAS f32x4*)(qa + h * 128 + 4 * l32);
      for (int j0 = 2 * wave; j0 < n; j0 += 128) { f32x4 kv[8]; int jj[8];
#pragma unroll
          for (int u = 0; u < 8; ++u) { jj[u] = j0 + 16 * u + half; const unsigned r = rid[jj[u] < n ? jj[u] : 0];
              const GAS float* kr = (r & 0x80000000u) ? out_ro + O_KS + ((size_t)(sb * NST + (r & 3u)) * NKV + kvh) * HD : ck + ((size_t)r * NKV + kvh) * HD;
              kv[u] = *(const GAS f32x4*)(kr + 4 * l32); }
#pragma unroll
          for (int u = 0; u < 8; ++u) { float d[4];
#pragma unroll
              for (int h = 0; h < 4; ++h) { d[h] = (kv[u][0] * qv[h][0] + kv[u][1] * qv[h][1]) + (kv[u][2] * qv[h][2] + kv[u][3] * qv[h][3]);
                  d[h] += __shfl_xor(d[h], 1); d[h] += __shfl_xor(d[h], 2); d[h] += __shfl_xor(d[h], 4); d[h] += __shfl_xor(d[h], 8); d[h] += __shfl_xor(d[h], 16); }
              if (jj[u] < n && l32 < 4) sc[l32 * 512 + jj[u]] = (l32 == 0 ? d[0] : l32 == 1 ? d[1] : l32 == 2 ? d[2] : d[3]) * 0.08838834764831845f; } } }
    __syncthreads();
    if (wave < 4) { LAS float* row = sc + wave * 512; float m2 = -1e30f;
      for (int j = lane; j < n; j += 64) m2 = fmaxf(m2, row[j]);
#pragma unroll
      for (int o = 1; o < 64; o <<= 1) m2 = fmaxf(m2, __shfl_xor(m2, o));
      float sm = 0.f;
      for (int j = lane; j < n; j += 64) { const float e = __expf(row[j] - m2); row[j] = e; sm += e; }
      sm = wave_sum(sm); if (lane == 0) inv[wave] = 1.f / sm; }
    __syncthreads();
    { f32x4 acc[4] = {};
      for (int j0 = 2 * wave; j0 < n; j0 += 128) { f32x4 vv[8]; int jj[8];
#pragma unroll
          for (int u = 0; u < 8; ++u) { jj[u] = j0 + 16 * u + half; const unsigned r = rid[jj[u] < n ? jj[u] : 0];
              const GAS float* vr = (r & 0x80000000u) ? out_ro + O_VS + ((size_t)(sb * NST + (r & 3u)) * NKV + kvh) * HD : cv + ((size_t)r * NKV + kvh) * HD;
              vv[u] = *(const GAS f32x4*)(vr + 4 * l32); }
#pragma unroll
          for (int u = 0; u < 8; ++u)
#pragma unroll
              for (int h = 0; h < 4; ++h) { const float p = jj[u] < n ? sc[h * 512 + jj[u]] : 0.f; acc[h] += vv[u] * p; } }
#pragma unroll
      for (int h = 0; h < 4; ++h) {
#pragma unroll
          for (int e = 0; e < 4; ++e) acc[h][e] += __shfl_xor(acc[h][e], 32);
          if (half == 0) *(LAS f32x4*)(part + (wave * 4 + h) * 128 + 4 * l32) = acc[h]; } }
    __syncthreads();
    { const GAS f16* SZ = (const GAS f16*)(a.ws + WS_SZ) + (size_t)(MP + qi) * 1024 + kvh * 512; GAS f16* MIX = (GAS f16*)(a.ws + WS_MIX) + (size_t)(MP + qi) * 2048 + kvh * 512;
      const int h = tid >> 7, d = tid & 127; float o = 0.f;
#pragma unroll
      for (int p = 0; p < 8; ++p) o += part[(p * 4 + h) * 128 + d];
      MIX[tid] = (f16)(o * inv[h] * (float)SZ[tid]); }
    __syncthreads();
}

__device__ __forceinline__ void p3_phase(const Args& a, LAS unsigned char* lds, int vcu, int G, int tid) {
    float gm = 0.f, km = 0.f;
    for (int i = 0; i < HD; ++i) { gm = fmaxf(gm, fabsf(a.in[9][i])); km = fmaxf(km, fabsf(a.in[10][i])); }
    const float sh2 = fmaxf(0.f, 11.313708498984761f * gm * km - 20.f) * 1.4426950408889634f;
    for (int rp = 0; rp < P3_REP_S; ++rp)
    for (int sidx = G - 1 - vcu; sidx < 2 * MS; sidx += G) { wait_ge_wt((unsigned*)a.ws + RDY_WORD0 + 64 * 32, (unsigned)G); p3_sample_item(a, lds, sidx, tid); }
    if (G == 256) { if (vcu >= 112 && vcu < 192) p2_convmix(a, (vcu - 112) * NWAVES + (tid >> 6), 80 * NWAVES, tid & 63); }
    else p2_convmix(a, vcu * NWAVES + (tid >> 6), G * NWAVES, tid & 63);
    for (int rp = 0; rp < P3_REP_A; ++rp)
    for (int k = vcu; k < 256; k += G) { const int i = 31 - (k >> 3), bk = k & 7;
        if (i >= 4) wait_ge_wt((unsigned*)a.ws + RDY_WORD0 + 64 * (40 + (bk >> 1) * 32 + i), 4u); else wait_ge_wt((unsigned*)a.ws + RDY_WORD0 + 64 * 33, (unsigned)G);
        att::attn_block(a, lds, bk >> 1, bk & 1, 64 * i, sh2); }
}

__global__ void __launch_bounds__(NWAVES * 64, 2) mk_fwd(Args a) {
    extern __shared__ __attribute__((aligned(16))) unsigned char lds_raw[];
    LAS unsigned char* lds = (LAS unsigned char*)lds_raw;
    const int tid = threadIdx.x, lane = tid & 63, wave = __builtin_amdgcn_readfirstlane(tid >> 6);
    const int G = gridDim.x; const int bx = blockIdx.x; const int vcu = (G % 8 == 0) ? (bx % 8) * (G / 8) + bx / 8 : bx;
    volatile LAS unsigned* MISC = (volatile LAS unsigned*)(lds + MISC_OFF);
    if (tid < 64) MISC[tid] = 0u;
    __syncthreads();
    XcdBarrier bar = xcd_barrier_post((unsigned*)a.ws, MISC + 8);
    { int t_ = threadIdx.x; asm volatile("" : "+v"(t_)); const int lane = t_ & 63, wave = __builtin_amdgcn_readfirstlane(t_ >> 6); p0_prologue(a, lds, vcu, G, wave, lane); }
    xcd_barrier(bar);
    { pg8::Gemm g{(const f16*)(a.ws + WS_XNH), (const f16*)(a.ws + WS_WINT), DM};
      pg8::StaticOrder S; S.init(MPAD / 256, NPAD / 256, G, bx);
      EpiIn E{a.out, a.ws, a.in[9], a.in[10], a.in[11], (LAS float*)(lds + SCR_OFF)};
      pg8::gemm_phase<EpiIn, pg8::StaticOrder>(lds, g, S, E); }
    xcd_barrier(bar);
    { int t_ = threadIdx.x; asm volatile("" : "+v"(t_)); const int lane = t_ & 63, wave = __builtin_amdgcn_readfirstlane(t_ >> 6); p2_phase(a, lds, vcu, G, wave, lane); }
    { int t_ = threadIdx.x; asm volatile("" : "+v"(t_)); p3_phase(a, lds, vcu, G, t_); }
    xcd_barrier(bar);
    { pg8::Gemm g{(const f16*)(a.ws + WS_MIX), (const f16*)(a.ws + WS_WOUTT), DM};
      pg8::StaticOrder S; S.init(MP / 256, DM / 256, G, bx);
      EpiOut E{a.out, a.in[0]};
      pg8::gemm_phase<EpiOut, pg8::StaticOrder>(lds, g, S, E);
      int t_ = threadIdx.x; asm volatile("" : "+v"(t_)); p4_sample(a, lds, bx, G, t_); }
}

#ifndef PROG
#define PROG 0x11111u
#endif
extern "C" void kernel_launch(void* const* d_in, const int* in_sizes, int n_in, void* d_out, int out_size, void* d_ws, size_t ws_size, hipStream_t stream) {
    static int grid = 0;
    if (grid == 0) {
        if (ws_size < WS_NEED2 || out_size != (int)O_END || n_in != 14) { fprintf(stderr, "kernel_launch: ws %zu (need %zu) out %d (want %zu) n_in %d\n", ws_size, (size_t)WS_NEED2, out_size, (size_t)O_END, n_in); grid = -1; return; }
        int dev = 0, cus = 0; hipGetDevice(&dev); hipDeviceGetAttribute(&cus, hipDeviceAttributeMultiprocessorCount, dev);
        if (hipFuncSetAttribute((const void*)mk_fwd, hipFuncAttributeMaxDynamicSharedMemorySize, LDS_BYTES) != hipSuccess) { fprintf(stderr, "kernel_launch: hipFuncSetAttribute failed\n"); grid = -1; return; }
        int per_cu = 0; hipOccupancyMaxActiveBlocksPerMultiprocessor(&per_cu, (const void*)mk_fwd, NWAVES * 64, LDS_BYTES); (void)hipGetLastError();
        if (per_cu < 1) fprintf(stderr, "kernel_launch: occupancy query says %d blocks per CU\n", per_cu);
        grid = cus > 0 ? cus : 256;
    }
    if (grid < 0) return;
    float* out = (float*)d_out; unsigned char* ws = (unsigned char*)d_ws;
    Args a{};
    for (int i = 0; i < 14; ++i) a.in[i] = (const float*)d_in[i];
    a.out = out; a.ws = ws;
    if (hipMemsetAsync(ws, 0, 65536, stream) != hipSuccess) { fprintf(stderr, "kernel_launch: memset of the control words failed\n"); return; }
    a.ph_lo = (int)PROG; a.ph_hi = 0; hipLaunchKernelGGL(mk_fwd, dim3(grid), dim3(NWAVES * 64), LDS_BYTES, stream, a);
}
```

```cpp
#include <hip/hip_runtime.h>
#include <cstdio>
#include <cstdint>
#include <cmath>

typedef _Float16 f16;
typedef unsigned short bf16_t;

constexpr int DM = 2048, NB = 4, S = 2048, NSB = 8, NST = 4, PAST = 16384, PAGE = 128, NPAGES = PAST / PAGE;
constexpr int MP = NB * S;
constexpr int MS = NSB * NST;
constexpr int MT = MP + MS;
constexpr int DIN = 7760;
constexpr int OQ = 0, OKK = 1024, OV = 1280, OZ = 1536, OQI = 2560, OKI = 3584, OWI = 3648, OH = 3664, OBB = 4688, OC = 5712, OZC = 6736;
constexpr int NH = 8, NKV = 2, HD = 128, NIH = 16, ID = 64, TOPK = 256, DC = 1024;
constexpr float EPS = 1e-6f;
constexpr size_t O_YP = 0, O_YS = 16777216, O_KP = 16842752, O_VP = 18939904, O_KIP = 21037056, O_CVP = 21561344,
                 O_KS = 21569536, O_VS = 21577728, O_KIS = 21585920, O_CVS = 21587968, O_END = 21604352;
constexpr size_t MiB = 1u << 20;
constexpr size_t WS_ROPE = 1 * MiB;
constexpr size_t WS_ROPE_I = WS_ROPE + 2052 * 32 * 4;
constexpr size_t WS_QB = 2 * MiB;
constexpr size_t WS_KB = 18 * MiB;
constexpr size_t WS_VB = 22 * MiB;
constexpr size_t WS_SZ = 26 * MiB;
constexpr size_t WS_QI = 43 * MiB;
constexpr size_t WS_KI = 60 * MiB;
constexpr size_t WS_WI = 61 * MiB;
constexpr size_t WS_U = 62 * MiB;
constexpr size_t WS_G = 79 * MiB;
constexpr size_t WS_MIX = 96 * MiB;
constexpr size_t WS_MASK = 130 * MiB;
constexpr size_t WS_SSC = 132 * MiB;
constexpr size_t WS_QS = 134 * MiB;
constexpr size_t WS_XN = 136 * MiB;
constexpr size_t WS_P = 202 * MiB;
constexpr size_t WS_NEED = 448 * MiB;

__device__ __forceinline__ bf16_t f2bf(float f) { unsigned u = __builtin_bit_cast(unsigned, f); return (bf16_t)((u + 0x7fffu + ((u >> 16) & 1u)) >> 16); }
__device__ __forceinline__ float bf2f(bf16_t h) { return __builtin_bit_cast(float, (unsigned)h << 16); }
__device__ __forceinline__ float silu(float z) { return z * __builtin_amdgcn_rcpf(1.f + __builtin_amdgcn_exp2f(-1.4426950408889634f * z)); }
__device__ __forceinline__ unsigned fkey(float f) { unsigned u = __builtin_bit_cast(unsigned, f); return (u & 0x80000000u) ? ~u : (u | 0x80000000u); }

#define P0_REP_T 1
#define P0_REP_X 1
#define P3_REP_S 1
#define P3_REP_A 1
#define P2_KT_REP 1
#define P2_SEL_REP 1
#define P2_REP_A 1
#define P2_REP_B 1
#define P2_REP_C 1
#define LAS __attribute__((address_space(3)))
#define GAS __attribute__((address_space(1)))
typedef _Float16 f16x8 __attribute__((ext_vector_type(8)));
typedef _Float16 f16x4 __attribute__((ext_vector_type(4)));
typedef _Float16 f16x2 __attribute__((ext_vector_type(2)));
typedef float f32x4 __attribute__((ext_vector_type(4)));
typedef float f32x2 __attribute__((ext_vector_type(2)));
typedef unsigned u32x4 __attribute__((ext_vector_type(4)));
typedef unsigned u32x2 __attribute__((ext_vector_type(2)));
typedef __bf16 bf16x2_t __attribute__((ext_vector_type(2)));
namespace pg8 {
constexpr int BM = 256, BK = 64, HALF = 128, HTB = HALF * BK * 2, STAGE_BYTES = 8 * HTB, NXCD = 8, WGM = 8;
__host__ __device__ __forceinline__ int lds_byte(int r, int c) { const int st = (r >> 4) * 2 + (c >> 5), rr = r & 15, cc = c & 31, ob = rr * 64 + cc * 2; return st * 1024 + (ob ^ (((ob >> 9) & 1) << 5)); }
__host__ __device__ __forceinline__ void stage_rc(int b, int& R, int& C) { const int st = b / 1024, sb = b % 1024, swz = sb ^ (((sb >> 9) & 1) << 5); R = (st >> 1) * 16 + swz / 64; C = (st & 1) * 32 + (swz % 64) / 2; }
struct Unit { int pm, pn; };
struct Gemm { const f16* A; const f16* Bt; int K; };
struct StaticOrder {
    int nM, nN, nwg, G, c;
    __device__ void init(int nM_, int nN_, int G_, int c_) { nM = nM_; nN = nN_; nwg = nM * nN; G = G_; c = c_; }
    __device__ bool next(int i, Unit& u) const {
        const long L = (long)i * G + c; if (L >= nwg) return false;
        int wgid = (int)L; { const int q = nwg / NXCD, r = nwg % NXCD, xcd = wgid % NXCD, off = wgid / NXCD; wgid = (xcd < r ? xcd * (q + 1) : r * (q + 1) + (xcd - r) * q) + off; }
        const int nig = WGM * nN, gid = wgid / nig, fm = gid * WGM, gsz = (nM - fm) < WGM ? (nM - fm) : WGM;
        u.pm = fm + ((wgid % nig) % gsz); u.pn = (wgid % nig) / gsz; return true;
    }
};
struct OneUnit { int pm, pn; __device__ bool next(int i, Unit& u) const { if (i != 0) return false; u.pm = pm; u.pn = pn; return true; } };
template <class Epi, class Sched>
__device__ __forceinline__ void gemm_phase(LAS unsigned char* lds, const Gemm g, const Sched& S, const Epi& E) {
    int tid_ = threadIdx.x; asm volatile("" : "+v"(tid_));
    const int tid = tid_, wid = __builtin_amdgcn_readfirstlane(tid >> 6), lane = tid & 63, wr = wid >> 2, wc = wid & 3, fr = lane & 15, fq = lane >> 4;
    const int K = g.K, nt = K / BK;
    unsigned voffA[2];
#pragma unroll
    for (int i = 0; i < 2; ++i) { int R, C; stage_rc(tid * 16 + i * 8192, R, C); voffA[i] = (unsigned)(R * K + C) * 2u; }
    const size_t kstep = (size_t)(BK * 2);
    const size_t hstep = (size_t)HALF * K * 2;
    const size_t tstep = 2 * hstep;
    const unsigned ldsw = (unsigned)wid * 1024u;
    const int aoff = lds_byte(wr * 64 + fr, fq * 8), boff = lds_byte(wc * 32 + fr, fq * 8);
#define PG8_SA(b, h) (((b) * 2 + (h)) * HTB)
#define PG8_SB(b, h) ((4 + (b) * 2 + (h)) * HTB)
#define PG8_STAGE(bufoff, gbase) do { _Pragma("unroll") for (int _i = 0; _i < 2; ++_i) \
        __builtin_amdgcn_global_load_lds((const unsigned*)((const char*)(gbase) + voffA[_i]), (LAS unsigned*)(lds + (bufoff) + ldsw + _i * 8192), 16, 0, 0); } while (0)
#define PG8_LDA(dst, b, h) do { _Pragma("unroll") for (int m = 0; m < 4; ++m) _Pragma("unroll") for (int k = 0; k < 2; ++k) dst[m][k] = *(const LAS f16x8*)(lds + PG8_SA(b, h) + aoff + m * 2048 + k * 1024); } while (0)
#define PG8_LDB(dst, b, h) do { _Pragma("unroll") for (int n = 0; n < 2; ++n) _Pragma("unroll") for (int k = 0; k < 2; ++k) dst[n][k] = *(const LAS f16x8*)(lds + PG8_SB(b, h) + boff + n * 2048 + k * 1024); } while (0)
#define PG8_MMA(ai, bj, At, Bt) do { __builtin_amdgcn_s_setprio(1); _Pragma("unroll") for (int m = 0; m < 4; ++m) _Pragma("unroll") for (int n = 0; n < 2; ++n) _Pragma("unroll") for (int k = 0; k < 2; ++k) \
        acc[ai][bj][m][n] = __builtin_amdgcn_mfma_f32_16x16x32_f16(Bt[n][k], At[m][k], acc[ai][bj][m][n], 0, 0, 0); __builtin_amdgcn_s_setprio(0); } while (0)
#define PG8_WAIT_V(n) asm volatile("s_waitcnt vmcnt(" #n ")" ::: "memory")
#define PG8_WAIT_L(n) asm volatile("s_waitcnt lgkmcnt(" #n ")" ::: "memory")
#define PG8_BAR __builtin_amdgcn_s_barrier()
#define PG8_SCHED __builtin_amdgcn_sched_barrier(0)
    Unit cur, nxt; int ui = 0;
    if (!S.next(0, cur)) return;
    f32x4 acc[2][2][4][2];
    E.init(acc, cur, wr, wc, fr, fq);
    f16x8 At[4][2], B0[2][2], B1[2][2];
    const char* cA = (const char*)g.A + (size_t)cur.pm * tstep; const char* cB = (const char*)g.Bt + (size_t)cur.pn * tstep;
    PG8_STAGE(PG8_SB(0, 0), cB); PG8_STAGE(PG8_SB(0, 1), cB + hstep); PG8_STAGE(PG8_SA(0, 0), cA); PG8_STAGE(PG8_SA(0, 1), cA + hstep);
    if (wr == 1) PG8_BAR;
    PG8_WAIT_V(2); PG8_BAR;
    PG8_STAGE(PG8_SB(1, 0), cB + kstep); PG8_STAGE(PG8_SA(1, 0), cA + kstep); PG8_STAGE(PG8_SB(1, 1), cB + hstep + kstep);
    PG8_WAIT_V(6); PG8_BAR;
    for (;;) {
        const bool has_next = S.next(ui + 1, nxt);
        const char* nA = has_next ? (const char*)g.A + (size_t)nxt.pm * tstep : cA; const char* nB = has_next ? (const char*)g.Bt + (size_t)nxt.pn * tstep : cB;
        for (int t = 0; t < nt; t += 2) {
            const bool last = (t == nt - 2);
            const char* a1 = cA + (size_t)(t + 1) * kstep;
            const char* a2 = last ? nA : cA + (size_t)(t + 2) * kstep; const char* b2 = last ? nB : cB + (size_t)(t + 2) * kstep;
            const char* a3 = a2 + kstep; const char* b3 = b2 + kstep;
            PG8_LDB(B0, 0, 0); PG8_LDB(B1, 0, 1); PG8_SCHED; PG8_LDA(At, 0, 0); PG8_STAGE(PG8_SA(1, 1), a1 + hstep);
            PG8_WAIT_V(8); PG8_WAIT_L(0); PG8_BAR; PG8_MMA(0, 0, At, B0); PG8_MMA(0, 1, At, B1); PG8_BAR; PG8_SCHED;
            PG8_LDA(At, 0, 1); PG8_STAGE(PG8_SB(0, 0), b2); PG8_STAGE(PG8_SB(0, 1), b2 + hstep); PG8_STAGE(PG8_SA(0, 0), a2);
            PG8_WAIT_V(8); PG8_WAIT_L(0); PG8_BAR; PG8_MMA(1, 0, At, B0); PG8_MMA(1, 1, At, B1); PG8_BAR; PG8_SCHED;
            PG8_LDB(B0, 1, 0); PG8_LDB(B1, 1, 1); PG8_SCHED; PG8_LDA(At, 1, 0); PG8_STAGE(PG8_SA(0, 1), a2 + hstep);
            PG8_WAIT_V(8); PG8_WAIT_L(0); PG8_BAR; PG8_MMA(0, 0, At, B0); PG8_MMA(0, 1, At, B1); PG8_BAR; PG8_SCHED;
            PG8_LDA(At, 1, 1); PG8_STAGE(PG8_SB(1, 0), b3); PG8_STAGE(PG8_SB(1, 1), b3 + hstep); PG8_STAGE(PG8_SA(1, 0), a3);
            PG8_WAIT_V(8); PG8_WAIT_L(0); PG8_BAR; PG8_MMA(1, 0, At, B0); PG8_MMA(1, 1, At, B1); PG8_BAR; PG8_SCHED;
        }
        const bool al = E.aligned(cur);
        if (al && wr == 0) PG8_BAR;
        E(acc, cur, wr, wc, fr, fq);
        if (!has_next) { if (!al && wr == 0) PG8_BAR; break; }
        cur = nxt; cA = nA; cB = nB; ++ui;
        E.init(acc, cur, wr, wc, fr, fq);
        if (al && wr == 1) PG8_BAR;
    }
    PG8_WAIT_V(0);
    PG8_BAR;
#undef PG8_SA
#undef PG8_SB
#undef PG8_STAGE
#undef PG8_LDA
#undef PG8_LDB
#undef PG8_MMA
#undef PG8_WAIT_V
#undef PG8_WAIT_L
#undef PG8_BAR
#undef PG8_SCHED
}
}
#ifndef P0_REP_T
#define P0_REP_T 1
#define P0_REP_X 1
#endif
constexpr int NWAVES = 8;
constexpr int MPAD = 8448, NPAD = 7936;
constexpr size_t WS_XNH = 450 * MiB;
constexpr size_t WS_WINT = 484 * MiB;
constexpr size_t WS_WOUTT = 516 * MiB;
constexpr size_t WS_PART = 524 * MiB;
constexpr size_t PART_STRIDE = 32768 + 256;
constexpr size_t WS_NEED2 = 536 * MiB;
constexpr int RING_BYTES = 131072, SCR_OFF = RING_BYTES, SCR_BYTES = 8192, MISC_OFF = 145408, LDS_BYTES = 147456;

__device__ __forceinline__ unsigned pk_bf16(float lo, float hi) { f32x2 v = {lo, hi}; bf16x2_t b = __builtin_convertvector(v, bf16x2_t); return __builtin_bit_cast(unsigned, b); }
__device__ __forceinline__ unsigned pk_f16(float lo, float hi) { f32x2 v = {lo, hi}; f16x2 b = __builtin_convertvector(v, f16x2); return __builtin_bit_cast(unsigned, b); }

struct Args { const float* in[14]; float* out; unsigned char* ws; int ph_lo, ph_hi; };

__device__ __forceinline__ int win_src(int np) {
    const int pn = np >> 8, c = np & 255;
    if (pn < 15) { const int rho = c & 31, nn = rho >> 4, ii = rho & 15; const int L = (np & ~31) | (8 * (ii >> 2) + 4 * nn + (ii & 3));
        if (pn < 14) return L;
        return (L & 255) < 80 ? L : -1; }
    const int T = pn - 15, bj = c >> 7, wc = (c >> 5) & 3, n = (c >> 4) & 1, fqi = c & 15;
    const int base = bj == 0 ? (n == 0 ? OH : OBB) : (n == 0 ? OC : OZC);
    return base + 64 * T + 16 * wc + fqi;
}
template <bool MAP>
__device__ __forceinline__ void p0_transpose_item(const float* W, int N, f16* WT, LAS unsigned char* scr, int item, int nblk, int lane) {
    const int kb = item / nblk, nb = item % nblk, k0 = 64 * kb, n0 = 32 * nb;
    const int q = lane & 7, kr = lane >> 3;
    const int src = MAP ? win_src(n0 + 4 * q) : n0 + 4 * q;
    const GAS float* wp = (const GAS float*)W + (size_t)(k0 + 2 * kr) * N + (src >= 0 ? src : 0);
    f32x4 va[4], vb[4];
#pragma unroll
    for (int p = 0; p < 4; ++p) { va[p] = *(const GAS f32x4*)(wp + (size_t)(16 * p) * N); vb[p] = *(const GAS f32x4*)(wp + (size_t)(16 * p + 1) * N); }
#pragma unroll
    for (int p = 0; p < 4; ++p) { if (src < 0) { va[p] = (f32x4){0.f, 0.f, 0.f, 0.f}; vb[p] = va[p]; }
#pragma unroll
        for (int e = 0; e < 4; ++e) *(LAS unsigned*)(scr + (4 * q + e) * 144 + 2 * (16 * p + 2 * kr)) = pk_f16(va[p][e], vb[p][e]); }
    asm volatile("s_waitcnt lgkmcnt(0)" ::: "memory");
    const int ch = lane & 7;
#pragma unroll
    for (int j = 0; j < 4; ++j) { const int n = (lane >> 3) + 8 * j;
        *(GAS u32x4*)(WT + (size_t)(n0 + n) * 2048 + k0 + 8 * ch) = *(const LAS u32x4*)(scr + n * 144 + ch * 16); }
    asm volatile("s_waitcnt lgkmcnt(0)" ::: "memory");
}
__device__ __forceinline__ float wave_sum(float v) {
#pragma unroll
    for (int o = 1; o < 64; o <<= 1) v += __shfl_xor(v, o);
    return v;
}
__device__ __forceinline__ void p0_prologue(const Args& a, LAS unsigned char* lds, int vcu, int G, int wave, int lane) {
    LAS unsigned char* scr = lds + wave * 16384;
    const int gw = vcu * NWAVES + wave, NGW = G * NWAVES;
    const float* win = a.in[8]; const float* wout = a.in[13];
    f16* WinT = (f16*)(a.ws + WS_WINT); f16* WoutT = (f16*)(a.ws + WS_WOUTT); f16* XN = (f16*)(a.ws + WS_XNH);
    constexpr int I_IN = 32 * (NPAD / 32), I_OUT = 32 * (DM / 32);
    for (int rpt = 0; rpt < P0_REP_T; ++rpt)
    for (int it = gw; it < I_IN + I_OUT; it += NGW) {
        if (it < I_IN) p0_transpose_item<true>(win, DIN, WinT, scr, it, NPAD / 32, lane);
        else p0_transpose_item<false>(wout, DM, WoutT, scr, it - I_IN, DM / 32, lane);
    }
    const float* gin = a.in[7];
    for (int rpx = 0; rpx < P0_REP_X; ++rpx)
    for (int m = gw; m < MT; m += NGW) {
        const float* xrow = m < MP ? a.in[0] + (size_t)m * DM : a.in[1] + (size_t)(m - MP) * DM;
        const f32x4* xr = (const f32x4*)xrow + lane; f32x4 v[8]; float s = 0.f;
#pragma unroll
        for (int j = 0; j < 8; ++j) { v[j] = xr[64 * j]; s += (v[j].x * v[j].x + v[j].y * v[j].y) + (v[j].z * v[j].z + v[j].w * v[j].w); }
        const float rs = rsqrtf(wave_sum(s) * (1.f / DM) + EPS);
        u32x2* o8 = (u32x2*)(XN + (size_t)m * DM) + lane;
#pragma unroll
        for (int j = 0; j < 8; ++j) { const f32x4 gv = ((const f32x4*)gin)[lane + 64 * j]; u32x2 w; w.x = pk_f16(v[j].x * rs * gv.x, v[j].y * rs * gv.y); w.y = pk_f16(v[j].z * rs * gv.z, v[j].w * rs * gv.w); o8[64 * j] = w; }
    }
    float* rqk = (float*)(a.ws + WS_ROPE); float* ri = (float*)(a.ws + WS_ROPE_I);
    for (int i = gw * 64 + lane; i < 2052 * 16; i += NGW * 64) {
        { int slot = i / 16, j = i % 16; int pos = slot < 2048 ? slot : PAST + (slot - 2048);
          float inv = (float)pow(500000.0, -(double)j / 16.0); float ang = (float)pos * inv;
          rqk[(slot * 16 + j) * 2] = (float)cos((double)ang); rqk[(slot * 16 + j) * 2 + 1] = (float)sin((double)ang); }
        if (i < 2052 * 8) { int slot = i / 8, j = i % 8; int pos = slot < 2048 ? slot : PAST + (slot - 2048);
          float inv = (float)pow(500000.0, -(double)j / 8.0); float ang = (float)pos * inv;
          ri[(slot * 8 + j) * 2] = (float)cos((double)ang); ri[(slot * 8 + j) * 2 + 1] = (float)sin((double)ang); }
    }
}

struct EpiIn {
    float* out; unsigned char* ws; const float* gq; const float* gk; const float* gki; LAS float* scr;
    __device__ __forceinline__ bool aligned(const pg8::Unit& u) const { return u.pn <= 4 || u.pn == 14; }
    __device__ __forceinline__ void init(f32x4 (&acc)[2][2][4][2], const pg8::Unit&, int, int, int, int) const {
#pragma unroll
        for (int a = 0; a < 2; ++a)
#pragma unroll
            for (int b = 0; b < 2; ++b)
#pragma unroll
                for (int m = 0; m < 4; ++m)
#pragma unroll
                    for (int n = 0; n < 2; ++n) acc[a][b][m][n] = (f32x4){0.f, 0.f, 0.f, 0.f};
    }
    __device__ __forceinline__ void operator()(f32x4 (&acc)[2][2][4][2], const pg8::Unit& u, int wr, int wc, int fr_, int fq_) const {
        int fr = fr_, fq = fq_; asm volatile("" : "+v"(fr), "+v"(fq));
        GAS unsigned char* ws = (GAS unsigned char*)this->ws; GAS float* out = (GAS float*)this->out; asm volatile("" : "+s"(ws), "+s"(out));
        const int pn = u.pn, pm = u.pm; const bool smp = pm == 32;
        const int rbase = 64 * wr + fr;
        const int bb = pm >> 3, t0 = (pm & 7) << 8;
        const GAS float* rqk = (const GAS float*)(ws + WS_ROPE); const GAS float* ri = (const GAS float*)(ws + WS_ROPE_I);
#define ROWLOOP _Pragma("unroll") for (int ai = 0; ai < 2; ++ai) _Pragma("unroll") for (int m = 0; m < 4; ++m)
#define ROWVARS const int r = rbase + 128 * ai + 16 * m; const bool valid = !smp || r < MS; const int grow = smp ? MP + r : pm * 256 + r; const int tt = smp ? (r & 3) : t0 + r; const int slot = smp ? 2048 + (r & 3) : tt; (void)grow; (void)tt; (void)slot; (void)valid;
        const int cl = 32 * wc + 8 * fq;
#define PK8B(x0_, x1_) ((u32x4){pk_bf16(x0_[0], x0_[1]), pk_bf16(x0_[2], x0_[3]), pk_bf16(x1_[0], x1_[1]), pk_bf16(x1_[2], x1_[3])})
#define PK8H(x0_, x1_) ((u32x4){pk_f16(x0_[0], x0_[1]), pk_f16(x0_[2], x0_[3]), pk_f16(x1_[0], x1_[1]), pk_f16(x1_[2], x1_[3])})
#define SHX4(dst_, src_, off_) do { dst_[0] = __shfl_xor(src_[0], off_); dst_[1] = __shfl_xor(src_[1], off_); dst_[2] = __shfl_xor(src_[2], off_); dst_[3] = __shfl_xor(src_[3], off_); } while (0)
        if (pn <= 4 || pn == 14) {
            const bool isk = pn == 14;
            ROWLOOP { asm volatile("" ::: "memory"); const int r = rbase + 128 * ai + 16 * m;
#pragma unroll
                for (int bj = 0; bj < 2; ++bj) { float s = 0.f;
#pragma unroll
                    for (int n = 0; n < 2; ++n) { const f32x4 x = acc[ai][bj][m][n]; s += (x[0] * x[0] + x[1] * x[1]) + (x[2] * x[2] + x[3] * x[3]); }
                    if (isk && (wc >= 2 || bj == 1)) s = 0.f;
                    s += __shfl_xor(s, 16); s += __shfl_xor(s, 32);
                    if (fq == 0) scr[(r * 2 + bj) * 4 + wc] = s; } }
            asm volatile("s_waitcnt lgkmcnt(0)" ::: "memory"); __builtin_amdgcn_s_barrier(); asm volatile("" ::: "memory");
            if (!isk) {
                const GAS float* g = (const GAS float*)(pn < 4 ? gq : gk);
                const f32x4 g0 = *(const GAS f32x4*)(g + cl), g1 = *(const GAS f32x4*)(g + cl + 4);
                GAS bf16_t* Qb = (GAS bf16_t*)(ws + WS_QB); GAS bf16_t* Kb = (GAS bf16_t*)(ws + WS_KB); GAS float* QS = (GAS float*)(ws + WS_QS);
                ROWLOOP { asm volatile("" ::: "memory"); ROWVARS
                    f32x4 c0 = {1.f, 1.f, 1.f, 1.f}, s0 = {0.f, 0.f, 0.f, 0.f}, c1 = c0, s1 = s0;
                    if (wc == 0) { const GAS f32x4* cp = (const GAS f32x4*)(rqk + (slot * 16 + 8 * (fq & 1)) * 2); const f32x4 t0_ = cp[0], t1_ = cp[1], t2_ = cp[2], t3_ = cp[3];
                        c0 = (f32x4){t0_[0], t0_[2], t1_[0], t1_[2]}; s0 = (f32x4){t0_[1], t0_[3], t1_[1], t1_[3]}; c1 = (f32x4){t2_[0], t2_[2], t3_[0], t3_[2]}; s1 = (f32x4){t2_[1], t2_[3], t3_[1], t3_[3]}; }
#pragma unroll
                    for (int bj = 0; bj < 2; ++bj) {
                        const f32x4 p = *(const LAS f32x4*)(scr + (r * 2 + bj) * 4);
                        const float rs = rsqrtf(((p[0] + p[1]) + (p[2] + p[3])) * (1.f / 128.f) + EPS);
                        f32x4 x0 = acc[ai][bj][m][0] * rs * g0, x1 = acc[ai][bj][m][1] * rs * g1;
                        if (wc == 0) { f32x4 o0, o1; SHX4(o0, x0, 32); SHX4(o1, x1, 32);
                            if (fq < 2) { x0 = x0 * c0 - o0 * s0; x1 = x1 * c1 - o1 * s1; } else { x0 = x0 * c0 + o0 * s0; x1 = x1 * c1 + o1 * s1; } }
                        const int hh = 2 * pn + bj;
                        if (pn < 4) {
                            if (smp) { if (valid) { GAS float* q = QS + (size_t)r * 1024 + hh * 128 + cl; *(GAS f32x4*)q = x0; *(GAS f32x4*)(q + 4) = x1; } }
                            else *(GAS u32x4*)(Qb + (((size_t)bb * NH + hh) * S + tt) * HD + cl) = PK8B(x0, x1);
                        } else {
                            if (smp) { if (valid) { GAS float* k = out + O_KS + (size_t)r * 256 + bj * 128 + cl; *(GAS f32x4*)k = x0; *(GAS f32x4*)(k + 4) = x1; } }
                            else { GAS float* k = out + O_KP + (size_t)grow * 256 + bj * 128 + cl; *(GAS f32x4*)k = x0; *(GAS f32x4*)(k + 4) = x1;
                                *(GAS u32x4*)(Kb + (((size_t)bb * NKV + bj) * S + tt) * HD + cl) = PK8B(x0, x1); }
                        } } }
            } else {
                const int dl = 32 * (wc & 1) + 8 * fq;
                const f32x4 g0 = *(const GAS f32x4*)((const GAS float*)gki + dl), g1 = *(const GAS f32x4*)((const GAS float*)gki + dl + 4);
                GAS f16* KI = (GAS f16*)(ws + WS_KI); GAS float* WI = (GAS float*)(ws + WS_WI);
                ROWLOOP { asm volatile("" ::: "memory"); ROWVARS
                    const f32x4 p = *(const LAS f32x4*)(scr + (r * 2) * 4);
                    const float rs = rsqrtf((p[0] + p[1]) * (1.f / 64.f) + EPS);
                    f32x4 x0 = acc[ai][0][m][0] * rs * g0, x1 = acc[ai][0][m][1] * rs * g1;
                    f32x4 o0, o1; SHX4(o0, x0, 16); SHX4(o1, x1, 16);
                    if (wc == 0 && fq < 2) { const GAS f32x4* cp = (const GAS f32x4*)(ri + (slot * 8) * 2); const f32x4 t0_ = cp[0], t1_ = cp[1], t2_ = cp[2], t3_ = cp[3];
                        const f32x4 c0 = {t0_[0], t0_[2], t1_[0], t1_[2]}, s0 = {t0_[1], t0_[3], t1_[1], t1_[3]}, c1 = {t2_[0], t2_[2], t3_[0], t3_[2]}, s1 = {t2_[1], t2_[3], t3_[1], t3_[3]};
                        if (fq == 0) { x0 = x0 * c0 - o0 * s0; x1 = x1 * c1 - o1 * s1; } else { x0 = x0 * c0 + o0 * s0; x1 = x1 * c1 + o1 * s1; } }
                    if (wc < 2 && valid) {
                        GAS float* ko = smp ? out + O_KIS + (size_t)r * 64 + dl : out + O_KIP + (size_t)grow * 64 + dl;
                        *(GAS f32x4*)ko = x0; *(GAS f32x4*)(ko + 4) = x1;
                        if (!smp) *(GAS u32x4*)(KI + (size_t)grow * 64 + dl) = PK8H(x0, x1); }
                    if (wc == 2 && fq < 2 && valid) { GAS float* wo = WI + (size_t)grow * 16 + 8 * fq; *(GAS f32x4*)wo = acc[ai][0][m][0] * (1.f / 32.f); *(GAS f32x4*)(wo + 4) = acc[ai][0][m][1] * (1.f / 32.f); }
                }
            }
        } else if (pn == 5) {
            GAS bf16_t* Vb = (GAS bf16_t*)(ws + WS_VB);
            ROWLOOP { asm volatile("" ::: "memory"); ROWVARS
#pragma unroll
                for (int bj = 0; bj < 2; ++bj) { const f32x4 x0 = acc[ai][bj][m][0], x1 = acc[ai][bj][m][1];
                    if (smp) { if (valid) { GAS float* v = out + O_VS + (size_t)r * 256 + bj * 128 + cl; *(GAS f32x4*)v = x0; *(GAS f32x4*)(v + 4) = x1; } }
                    else { GAS float* v = out + O_VP + (size_t)grow * 256 + bj * 128 + cl; *(GAS f32x4*)v = x0; *(GAS f32x4*)(v + 4) = x1;
                        *(GAS u32x4*)(Vb + (((size_t)bb * NKV + bj) * S + tt) * HD + cl) = PK8B(x0, x1); } } }
        } else if (pn <= 9) {
            GAS f16* SZ = (GAS f16*)(ws + WS_SZ); const int c0 = 256 * (pn - 6) + cl;
            ROWLOOP { asm volatile("" ::: "memory"); ROWVARS
                if (valid) {
#pragma unroll
                    for (int bj = 0; bj < 2; ++bj) { const f32x4 a0 = acc[ai][bj][m][0], a1 = acc[ai][bj][m][1];
                        f32x4 z0, z1; z0[0] = silu(a0[0]); z0[1] = silu(a0[1]); z0[2] = silu(a0[2]); z0[3] = silu(a0[3]); z1[0] = silu(a1[0]); z1[1] = silu(a1[1]); z1[2] = silu(a1[2]); z1[3] = silu(a1[3]);
                        *(GAS u32x4*)(SZ + (size_t)grow * 1024 + c0 + 128 * bj) = PK8H(z0, z1); } } }
        } else if (pn <= 13) {
            GAS f16* QI = (GAS f16*)(ws + WS_QI); const int c0 = 256 * (pn - 10) + cl;
            ROWLOOP { asm volatile("" ::: "memory"); ROWVARS
                f32x4 c0v = {1.f, 1.f, 1.f, 1.f}, s0v = {0.f, 0.f, 0.f, 0.f}, c1v = c0v, s1v = s0v;
                const bool rp = (wc & 1) == 0;
                if (rp) { const GAS f32x4* cp = (const GAS f32x4*)(ri + (slot * 8) * 2); const f32x4 t0_ = cp[0], t1_ = cp[1], t2_ = cp[2], t3_ = cp[3];
                    c0v = (f32x4){t0_[0], t0_[2], t1_[0], t1_[2]}; s0v = (f32x4){t0_[1], t0_[3], t1_[1], t1_[3]}; c1v = (f32x4){t2_[0], t2_[2], t3_[0], t3_[2]}; s1v = (f32x4){t2_[1], t2_[3], t3_[1], t3_[3]}; }
#pragma unroll
                for (int bj = 0; bj < 2; ++bj) { f32x4 x0 = acc[ai][bj][m][0], x1 = acc[ai][bj][m][1];
                    f32x4 o0, o1; SHX4(o0, x0, 16); SHX4(o1, x1, 16);
                    if (rp && fq < 2) { if (fq == 0) { x0 = x0 * c0v - o0 * s0v; x1 = x1 * c1v - o1 * s1v; } else { x0 = x0 * c0v + o0 * s0v; x1 = x1 * c1v + o1 * s1v; } }
                    if (valid) *(GAS u32x4*)(QI + (size_t)grow * 1024 + c0 + 128 * bj) = PK8H(x0, x1); } }
        } else {
            GAS f16* UG = (GAS f16*)(ws + WS_U); const int ch = 64 * (pn - 15) + 16 * wc + 4 * fq;
            ROWLOOP { asm volatile("" ::: "memory"); ROWVARS
                const f32x4 h = acc[ai][0][m][0], b = acc[ai][0][m][1], c = acc[ai][1][m][0], z = acc[ai][1][m][1];
                const f32x4 uu = c * h; f32x4 gg; gg[0] = b[0] * silu(z[0]); gg[1] = b[1] * silu(z[1]); gg[2] = b[2] * silu(z[2]); gg[3] = b[3] * silu(z[3]);
                if (valid) { u32x4 w = {pk_f16(uu[0], uu[1]), pk_f16(uu[2], uu[3]), pk_f16(gg[0], gg[1]), pk_f16(gg[2], gg[3])};
                    *(GAS u32x4*)(UG + (size_t)grow * 2048 + 2 * ch) = w;
                    if (!smp && tt >= S - 2) *(GAS f32x4*)(out + O_CVP + ((size_t)bb * 2 + (tt - (S - 2))) * 1024 + ch) = uu;
                    if (smp && tt >= 2) *(GAS f32x4*)(out + O_CVS + ((size_t)(r >> 2) * 2 + (tt - 2)) * 1024 + ch) = uu; } }
        }
#undef ROWLOOP
#undef ROWVARS
#undef PK8B
#undef PK8H
#undef SHX4
    }
};


struct EpiOut {
    float* out; const float* xp;
    __device__ __forceinline__ bool aligned(const pg8::Unit&) const { return false; }
    __device__ __forceinline__ void init(f32x4 (&acc)[2][2][4][2], const pg8::Unit& u, int wr, int wc, int fr, int fq) const {
        const GAS float* xp = (const GAS float*)this->xp;
        const size_t base = (size_t)(u.pm * 256 + 64 * wr + fr) * DM + u.pn * 256 + 32 * wc + 4 * fq;
#pragma unroll
        for (int ai = 0; ai < 2; ++ai)
#pragma unroll
            for (int m = 0; m < 4; ++m)
#pragma unroll
                for (int bj = 0; bj < 2; ++bj)
#pragma unroll
                    for (int n = 0; n < 2; ++n) acc[ai][bj][m][n] = *(const GAS f32x4*)(xp + base + (size_t)(128 * ai + 16 * m) * DM + 128 * bj + 16 * n);
    }
    __device__ __forceinline__ void operator()(f32x4 (&acc)[2][2][4][2], const pg8::Unit& u, int wr, int wc, int fr_, int fq_) const {
        int fr = fr_, fq = fq_; asm volatile("" : "+v"(fr), "+v"(fq));
        GAS float* out = (GAS float*)this->out; asm volatile("" : "+s"(out));
        const size_t base = (size_t)(u.pm * 256 + 64 * wr + fr) * DM + u.pn * 256 + 32 * wc + 4 * fq;
#pragma unroll
        for (int ai = 0; ai < 2; ++ai)
#pragma unroll
            for (int m = 0; m < 4; ++m) { const size_t off = base + (size_t)(128 * ai + 16 * m) * DM;
#pragma unroll
                for (int bj = 0; bj < 2; ++bj)
#pragma unroll
                    for (int n = 0; n < 2; ++n) *(GAS f32x4*)(out + off + 128 * bj + 16 * n) = acc[ai][bj][m][n]; }
    }
};
__device__ __forceinline__ void p4_sample(const Args& a, LAS unsigned char* lds, int bx, int G, int tid) {
    const GAS f16* MIX = (const GAS f16*)(a.ws + WS_MIX) + (size_t)MP * DM; const GAS f16* WT = (const GAS f16*)(a.ws + WS_WOUTT);
    LAS float* part = (LAS float*)lds;
    const int lane = tid & 63, wave = __builtin_amdgcn_readfirstlane(tid >> 6), fr = lane & 15, fq = lane >> 4;
    for (int cg = bx; cg < DM / 8; cg += G) {
        const GAS f16* wp = WT + (size_t)(cg * 8 + (fr & 7)) * DM + wave * 256 + 8 * fq; const GAS f16* mp = MIX + (size_t)fr * DM + wave * 256 + 8 * fq;
        f16x8 wf[8], m0[8], m1[8];
#pragma unroll
        for (int ks = 0; ks < 8; ++ks) { wf[ks] = *(const GAS f16x8*)(wp + 32 * ks); m0[ks] = *(const GAS f16x8*)(mp + 32 * ks); m1[ks] = *(const GAS f16x8*)(mp + (size_t)16 * DM + 32 * ks); }
        f32x4 c0 = {0.f, 0.f, 0.f, 0.f}, c1 = {0.f, 0.f, 0.f, 0.f};
#pragma unroll
        for (int ks = 0; ks < 8; ++ks) { c0 = __builtin_amdgcn_mfma_f32_16x16x32_f16(wf[ks], m0[ks], c0, 0, 0, 0); c1 = __builtin_amdgcn_mfma_f32_16x16x32_f16(wf[ks], m1[ks], c1, 0, 0, 0); }
        *(LAS f32x4*)(part + ((wave * 2 + 0) * 64 + lane) * 4) = c0; *(LAS f32x4*)(part + ((wave * 2 + 1) * 64 + lane) * 4) = c1;
        __syncthreads();
        if (tid < 256) { const int rr = tid >> 3, cc = tid & 7; const int ln = (rr & 15) + 16 * (cc >> 2), tl = rr >> 4; float s = a.in[1][(size_t)rr * DM + cg * 8 + cc];
#pragma unroll
            for (int w = 0; w < 8; ++w) s += part[((w * 2 + tl) * 64 + ln) * 4 + (cc & 3)];
            a.out[O_YS + (size_t)rr * DM + cg * 8 + cc] = s; }
        __syncthreads();
    }
}
typedef GAS unsigned gu32;
#define XB_TMO      128
#define XB_XCNT(j)  (256  + 64 * (j))
#define XB_XSUB(j)  (1280 + 64 * (j))
#define XB_XGEN(j)  (2304 + 64 * (j))
#define XB_TOP      3328
#define XB_TOPGEN   3392
#define XCD_BAR_WORDS 3456
#define XB_SPIN_CAP (1u << 18)
__device__ __forceinline__ unsigned xb_ld(unsigned* p)              { return __hip_atomic_load(p, __ATOMIC_RELAXED, __HIP_MEMORY_SCOPE_AGENT); }
__device__ __forceinline__ unsigned xb_add(unsigned* p, unsigned v) { return __hip_atomic_fetch_add(p, v, __ATOMIC_RELAXED, __HIP_MEMORY_SCOPE_AGENT); }
__device__ __forceinline__ unsigned xb_xcc_id() { return (unsigned)__builtin_amdgcn_s_getreg((3 << 11) | 20) & 0xFu; }
#define XB_SPIN(cond, bar) do { unsigned _sp = 0; while (cond) { __builtin_amdgcn_s_sleep(1); \
    if ((++_sp & 255u) == 0u) { if (xb_ld(&(bar)[XB_TMO])) break; if (_sp > XB_SPIN_CAP) { atomicAdd(&(bar)[XB_TMO], 1u); break; } } } } while (0)
struct XcdBarrier { unsigned* bar; unsigned x; volatile LAS unsigned* st; };
__device__ __forceinline__ XcdBarrier xcd_barrier_post(unsigned* bar, volatile LAS unsigned* st) {
    XcdBarrier b; b.bar = bar; b.x = xb_xcc_id(); b.st = st;
    if (threadIdx.x == 0) (void)xb_add(&bar[XB_XCNT(b.x)], 1u);
    return b;
}
__device__ __forceinline__ void xcd_barrier_complete(unsigned* bar, unsigned x, unsigned& nloc, unsigned& nx) {
    const unsigned G = gridDim.x * gridDim.y * gridDim.z;
    unsigned sum, cnt, mine, sp = 0u;
    for (;;) {
        sum = 0u; cnt = 0u; mine = 0u;
#pragma unroll
        for (unsigned j = 0; j < 16; ++j) { const unsigned c = xb_ld(&bar[XB_XCNT(j)]); sum += c; cnt += (c > 0u) ? 1u : 0u; mine = (j == x) ? c : mine; }
        if (sum == G) break;
        __builtin_amdgcn_s_sleep(1);
        if ((++sp & 255u) == 0u) { if (xb_ld(&bar[XB_TMO])) break; if (sp > XB_SPIN_CAP) { atomicAdd(&bar[XB_TMO], 1u); break; } }
    }
    nloc = mine > 0u ? mine : 1u; nx = cnt > 0u ? cnt : 1u;
}
__device__ __forceinline__ void xcd_barrier(const XcdBarrier& b) {
    asm volatile("s_waitcnt vmcnt(0)" ::: "memory");
    __syncthreads();
    if (threadIdx.x == 0) {
        unsigned* bar = b.bar;
        __builtin_amdgcn_s_waitcnt(0);
        unsigned nloc = b.st[0], nx = b.st[1];
        if (nloc == 0u) { xcd_barrier_complete(bar, b.x, nloc, nx); b.st[0] = nloc; b.st[1] = nx; }
        const unsigned old = xb_add(&bar[XB_XSUB(b.x)], 1u);
        const unsigned gen = old / nloc;
        if (old + 1u == (gen + 1u) * nloc) {
            __builtin_amdgcn_fence(__ATOMIC_RELEASE, "agent");
            asm volatile("s_waitcnt vmcnt(0)" ::: "memory");
            const unsigned og = xb_add(&bar[XB_TOP], 1u);
            const unsigned tg = og / nx;
            if (og + 1u == (tg + 1u) * nx) xb_add(&bar[XB_TOPGEN], 1u);
            else XB_SPIN(xb_ld(&bar[XB_TOPGEN]) == tg, bar);
            __builtin_amdgcn_fence(__ATOMIC_ACQUIRE, "agent");
            xb_add(&bar[XB_XGEN(b.x)], 1u);
            asm volatile("s_waitcnt vmcnt(0)" ::: "memory");
        } else {
            XB_SPIN(xb_ld(&bar[XB_XGEN(b.x)]) == gen, bar);
            __builtin_amdgcn_fence(__ATOMIC_ACQUIRE, "agent");
            asm volatile("s_waitcnt vmcnt(0)" ::: "memory");
        }
    }
    __syncthreads();
}

constexpr int RDY_WORD0 = 4096;
__device__ __forceinline__ void signal_add(unsigned* ctr) {
    asm volatile("s_waitcnt vmcnt(0)" ::: "memory");
    __syncthreads();
    if (threadIdx.x == 0) { __builtin_amdgcn_fence(__ATOMIC_RELEASE, "agent"); asm volatile("s_waitcnt vmcnt(0)" ::: "memory"); (void)xb_add(ctr, 1u); }
}
__device__ __forceinline__ void wait_ge(unsigned* ctr, unsigned need) {
    if (threadIdx.x == 0) { unsigned sp = 0; while (xb_ld(ctr) < need) { __builtin_amdgcn_s_sleep(2); if (++sp > (1u << 22)) break; }
        __builtin_amdgcn_fence(__ATOMIC_ACQUIRE, "agent"); asm volatile("s_waitcnt vmcnt(0)" ::: "memory"); }
    __syncthreads();
}

__device__ __forceinline__ void signal_add_wt(unsigned* ctr) {
    asm volatile("s_waitcnt vmcnt(0)" ::: "memory");
    __syncthreads();
    if (threadIdx.x == 0) (void)xb_add(ctr, 1u);
}
__device__ __forceinline__ void wait_ge_wt(unsigned* ctr, unsigned need) {
    if (threadIdx.x == 0) { unsigned sp = 0; while (xb_ld(ctr) < need) { __builtin_amdgcn_s_sleep(2); if (++sp > (1u << 22)) break; } }
    __syncthreads();
}

#ifndef P2_KT_REP
#define P2_KT_REP 1
#define P2_SEL_REP 1
#endif
#ifndef P2_REP_A
#define P2_REP_A 1
#define P2_REP_B 1
#define P2_REP_C 1
#endif
constexpr int SC_STRIDE = 2052;
constexpr int SC_BYTES = 16 * SC_STRIDE * 4;
constexpr int WSCR_OFF = 131584, WSCR_BYTES = 1536;
__device__ __forceinline__ f16x8 cvt8(f32x4 a, f32x4 b) { u32x4 w = {pk_f16(a[0], a[1]), pk_f16(a[2], a[3]), pk_f16(b[0], b[1]), pk_f16(b[2], b[3])}; return __builtin_bit_cast(f16x8, w); }

__device__ __forceinline__ void p2_convmix(const Args& a, int gw, int NGW, int lane) {
    const GAS f16* UG = (const GAS f16*)(a.ws + WS_U); GAS f16* MIX = (GAS f16*)(a.ws + WS_MIX);
    const GAS float* wconv = (const GAS float*)a.in[12]; const GAS float* state = (const GAS float*)a.in[5];
    for (int ch = gw; ch < MT / 4; ch += NGW) {
        const int row0 = 4 * ch; const bool smp = row0 >= MP; const int t0 = smp ? 0 : (row0 & (S - 1)); const int seq = (row0 - MP) >> 2;
#pragma unroll
        for (int half = 0; half < 2; ++half) { const int cb = half * 512 + 8 * lane;
            float um2[8], um1[8], w0[8], w1[8], w2[8];
#pragma unroll
            for (int e = 0; e < 8; e += 4) { const f32x4 a0 = *(const GAS f32x4*)(wconv + cb + e), a1 = *(const GAS f32x4*)(wconv + 1024 + cb + e), a2 = *(const GAS f32x4*)(wconv + 2048 + cb + e);
#pragma unroll
                for (int i = 0; i < 4; ++i) { w0[e + i] = a0[i]; w1[e + i] = a1[i]; w2[e + i] = a2[i]; } }
            if (t0 == 0) {
                if (smp) {
#pragma unroll
                    for (int e = 0; e < 8; e += 4) { const f32x4 s0 = *(const GAS f32x4*)(state + ((size_t)seq * 2) * 1024 + cb + e), s1 = *(const GAS f32x4*)(state + ((size_t)seq * 2 + 1) * 1024 + cb + e);
#pragma unroll
                        for (int i = 0; i < 4; ++i) { um2[e + i] = s0[i]; um1[e + i] = s1[i]; } }
                } else {
#pragma unroll
                    for (int e = 0; e < 8; ++e) { um2[e] = 0.f; um1[e] = 0.f; } }
            } else {
#pragma unroll
                for (int gq = 0; gq < 2; ++gq) { const f16x4 p2 = *(const GAS f16x4*)(UG + (size_t)(row0 - 2) * 2048 + 2 * cb + 8 * gq), p1 = *(const GAS f16x4*)(UG + (size_t)(row0 - 1) * 2048 + 2 * cb + 8 * gq);
#pragma unroll
                    for (int e = 0; e < 4; ++e) { um2[4 * gq + e] = (float)p2[e]; um1[4 * gq + e] = (float)p1[e]; } } }
#pragma unroll
            for (int i = 0; i < 4; ++i) { const size_t row = row0 + i;
                const f16x8 x0 = *(const GAS f16x8*)(UG + row * 2048 + 2 * cb), x1 = *(const GAS f16x8*)(UG + row * 2048 + 2 * cb + 8); float o[8];
#pragma unroll
                for (int e = 0; e < 8; ++e) { const float u = (float)(e < 4 ? x0[e] : x1[e - 4]); const float g = (float)(e < 4 ? x0[4 + e] : x1[e]);
                    const float cv = w0[e] * um2[e] + w1[e] * um1[e] + w2[e] * u; o[e] = g * cv; um2[e] = um1[e]; um1[e] = u; }
                u32x4 w = {pk_f16(o[0], o[1]), pk_f16(o[2], o[3]), pk_f16(o[4], o[5]), pk_f16(o[6], o[7])};
                *(GAS u32x4*)(MIX + row * 2048 + 1024 + cb) = w; }
        }
    }
}

__device__ __forceinline__ void p2_sscore(const Args& a, int gw, int NGW, int lane) {
    const GAS float* cki = (const GAS float*)a.in[4]; const GAS int* ptab = (const GAS int*)a.in[6];
    const GAS f16* QI = (const GAS f16*)(a.ws + WS_QI); const GAS float* WI = (const GAS float*)(a.ws + WS_WI); GAS float* SSC = (GAS float*)(a.ws + WS_SSC);
    const int fr = lane & 15, fq = lane >> 4;
    for (int it = gw; it < NSB * 256; it += NGW) {
        const int sb = it >> 8, hp = it & 255, pg = hp >> 1, k0 = (hp & 1) * 64; const int phys = ptab[sb * NPAGES + pg];
        const GAS float* kbase = cki + ((size_t)phys * PAGE + k0) * 64;
        f16x8 qf[4][2]; f32x4 wv[4];
#pragma unroll
        for (int t = 0; t < 4; ++t) { const size_t row = MP + 4 * sb + t;
            qf[t][0] = *(const GAS f16x8*)(QI + row * 1024 + fr * 64 + 8 * fq); qf[t][1] = *(const GAS f16x8*)(QI + row * 1024 + fr * 64 + 32 + 8 * fq);
            wv[t] = *(const GAS f32x4*)(WI + row * 16 + 4 * fq); }
#pragma unroll
        for (int tile = 0; tile < 4; ++tile) {
            const GAS float* kr = kbase + (size_t)(16 * tile + fr) * 64 + 8 * fq;
            const f16x8 kf0 = cvt8(*(const GAS f32x4*)kr, *(const GAS f32x4*)(kr + 4)), kf1 = cvt8(*(const GAS f32x4*)(kr + 32), *(const GAS f32x4*)(kr + 36));
            float mine = 0.f;
#pragma unroll
            for (int t = 0; t < 4; ++t) { f32x4 c = {0.f, 0.f, 0.f, 0.f};
                c = __builtin_amdgcn_mfma_f32_16x16x32_f16(qf[t][0], kf0, c, 0, 0, 0); c = __builtin_amdgcn_mfma_f32_16x16x32_f16(qf[t][1], kf1, c, 0, 0, 0);
                float s = wv[t][0] * fmaxf(c[0], 0.f) + wv[t][1] * fmaxf(c[1], 0.f) + wv[t][2] * fmaxf(c[2], 0.f) + wv[t][3] * fmaxf(c[3], 0.f);
                s += __shfl_xor(s, 16); s += __shfl_xor(s, 32);
                mine = fq == t ? s : mine; }
            __hip_atomic_store((GAS unsigned*)SSC + ((size_t)(4 * sb + fq) * PAST + pg * PAGE + k0 + 16 * tile + fr), __builtin_bit_cast(unsigned, mine), __ATOMIC_RELAXED, __HIP_MEMORY_SCOPE_AGENT);
        }
    }
}

__device__ __forceinline__ void wave_topk_mask(const LAS float* row, int t, GAS unsigned long long* mrow, int lane, LAS unsigned* hist, LAS float* cand) {
    const float NINF = -__builtin_inff(), PINF = __builtin_inff();
    const int jmax = t >> 6;
    const bool lastok = 64 * jmax + lane <= t;
    float v[32]; float mx = NINF, mn = PINF;
#pragma unroll
    for (int j = 0; j < 32; ++j) { v[j] = NINF;
        if (j < jmax) { v[j] = row[64 * j + lane]; mx = fmaxf(mx, v[j]); mn = fminf(mn, v[j]); }
        else if (j == jmax) { const float x = row[64 * j + lane]; v[j] = lastok ? x : NINF; mx = fmaxf(mx, v[j]); mn = fminf(mn, lastok ? x : PINF); } }
#pragma unroll
    for (int o = 1; o < 64; o <<= 1) { mx = fmaxf(mx, __shfl_xor(mx, o)); mn = fminf(mn, __shfl_xor(mn, o)); }
    *(LAS u32x4*)(hist + 4 * lane) = (u32x4){0u, 0u, 0u, 0u};
    const float scale = 255.5f / (mx - mn);
    float tau = 0.f; bool have = false;
    if (mx > mn) {
        asm volatile("s_waitcnt lgkmcnt(0)" ::: "memory");
        unsigned bins[8];
#pragma unroll
        for (int j = 0; j < 8; ++j) bins[j] = 0u;
#pragma unroll
        for (int j = 0; j < 32; ++j) {
            if (j < jmax) { const unsigned b = (unsigned)((v[j] - mn) * scale); bins[j >> 2] |= b << (8 * (j & 3)); __hip_atomic_fetch_add(hist + b, 1u, __ATOMIC_RELAXED, __HIP_MEMORY_SCOPE_WORKGROUP); }
            else if (j == jmax) { const unsigned b = lastok ? (unsigned)((v[j] - mn) * scale) : 0u; bins[j >> 2] |= b << (8 * (j & 3)); if (lastok) __hip_atomic_fetch_add(hist + b, 1u, __ATOMIC_RELAXED, __HIP_MEMORY_SCOPE_WORKGROUP); } }
        asm volatile("s_waitcnt lgkmcnt(0)" ::: "memory");
        const u32x4 h = *(const LAS u32x4*)(hist + 4 * lane);
        const unsigned sl = h[0] + h[1] + h[2] + h[3]; unsigned pre = sl;
#pragma unroll
        for (int o = 1; o < 64; o <<= 1) { const unsigned y = __shfl_up(pre, o); if (lane >= o) pre += y; }
        const unsigned tot = __builtin_amdgcn_readlane(pre, 63); const unsigned suf = tot - pre + sl;
        const unsigned long long bm = __ballot(suf >= TOPK);
        const int Ls = 63 - __builtin_clzll(bm);
        unsigned c = __builtin_amdgcn_readlane(suf, Ls) - __builtin_amdgcn_readlane(sl, Ls);
        const unsigned h3 = __builtin_amdgcn_readlane(h[3], Ls), h2 = __builtin_amdgcn_readlane(h[2], Ls), h1 = __builtin_amdgcn_readlane(h[1], Ls);
        int Bs;
        if (c + h3 >= TOPK) Bs = 4 * Ls + 3; else { c += h3; if (c + h2 >= TOPK) Bs = 4 * Ls + 2; else { c += h2; if (c + h1 >= TOPK) Bs = 4 * Ls + 1; else { c += h1; Bs = 4 * Ls; } } }
        const int need = TOPK - (int)c;
        int base = 0;
#pragma unroll
        for (int j = 0; j < 32; ++j) { if (j <= jmax) { const int b = (int)((bins[j >> 2] >> (8 * (j & 3))) & 255u); const bool isc = (j < jmax || lastok) && b == Bs;
            const unsigned long long m = __ballot(isc);
            if (m) { const int pos = base + (int)__builtin_amdgcn_mbcnt_hi((unsigned)(m >> 32), __builtin_amdgcn_mbcnt_lo((unsigned)m, 0u)); if (isc && pos < 64) cand[pos] = v[j]; base += __builtin_popcountll(m); } } }
        if (base <= 64) {
            asm volatile("s_waitcnt lgkmcnt(0)" ::: "memory");
            const float x = lane < base ? cand[lane] : NINF; int rank = 0;
            for (int m = 0; m < base; ++m) { const float y = __builtin_bit_cast(float, __builtin_amdgcn_readlane(__builtin_bit_cast(int, x), m)); rank += y > x ? 1 : 0; }
            float tc = (lane < base && rank <= need - 1) ? x : PINF;
#pragma unroll
            for (int o = 1; o < 64; o <<= 1) tc = fminf(tc, __shfl_xor(tc, o));
            tau = tc; have = true;
        }
    }
    if (!have) {
        unsigned tk = 0u;
        for (int bit = 31; bit >= 0; --bit) { const unsigned cd = tk | (1u << bit); int cnt = 0;
#pragma unroll
            for (int j = 0; j < 32; ++j) cnt += __builtin_popcountll(__ballot((64 * j + lane <= t) && fkey(v[j]) >= cd));
            if (cnt >= TOPK) tk = cd; }
        tau = __builtin_bit_cast(float, (tk & 0x80000000u) ? (tk ^ 0x80000000u) : ~tk);
    }
    unsigned wlo = 0u, whi = 0u;
#pragma unroll
    for (int j = 0; j < 32; ++j) { if (j <= jmax) { const unsigned long long m = __ballot(v[j] >= tau);
        if (lane == j) { wlo = (unsigned)m; whi = (unsigned)(m >> 32); } } }
    if (lane < 32) __hip_atomic_store(mrow + lane, ((unsigned long long)whi << 32) | wlo, __ATOMIC_RELAXED, __HIP_MEMORY_SCOPE_AGENT);
}

#define RELU_FMA(acc_, c_, w_) do { const float f_ = (c_); const int i_ = __builtin_bit_cast(int, f_); const float r_ = __builtin_bit_cast(float, i_ > 0 ? i_ : 0); asm("v_fmac_f32_e32 %0, %1, %2" : "+v"(acc_) : "v"(r_), "v"(w_)); } while (0)
__device__ __forceinline__ void p2_index_tile(const Args& a, LAS unsigned char* lds, int b, int t0, int wave, int lane) {
    const GAS f16* QI = (const GAS f16*)(a.ws + WS_QI); const GAS float* WI = (const GAS float*)(a.ws + WS_WI); const GAS f16* KI = (const GAS f16*)(a.ws + WS_KI);
    GAS unsigned long long* MASK = (GAS unsigned long long*)(a.ws + WS_MASK);
    LAS float* sc = (LAS float*)lds;
    const int fr = lane & 15, fq = lane >> 4; const size_t rowq = (size_t)b * S + t0 + fr;
    f16x8 qf[16][2]; float w[16];
#pragma unroll
    for (int h = 0; h < 16; ++h) { qf[h][0] = *(const GAS f16x8*)(QI + rowq * 1024 + h * 64 + 8 * fq); qf[h][1] = *(const GAS f16x8*)(QI + rowq * 1024 + h * 64 + 32 + 8 * fq); }
#pragma unroll
    for (int h = 0; h < 16; h += 4) { const f32x4 x = *(const GAS f32x4*)(WI + rowq * 16 + h); w[h] = x[0]; w[h + 1] = x[1]; w[h + 2] = x[2]; w[h + 3] = x[3]; }
    const int nkt = (t0 + 16) >> 4;
    const GAS f16* kp = KI + ((size_t)b * S + fr) * 64 + 8 * fq;
#define KLOAD(d0_, d1_, kt_) do { const int k_ = (kt_) < nkt ? (kt_) : wave; d0_ = *(const GAS f16x8*)(kp + (size_t)k_ * 1024); d1_ = *(const GAS f16x8*)(kp + (size_t)k_ * 1024 + 32); } while (0)
    f16x8 ka0, ka1, kb0, kb1, kc0, kc1;
#define KCOMP(kf0, kf1, kt_) do { float a0 = 0.f, a1 = 0.f, a2 = 0.f, a3 = 0.f; const f32x4 z4 = {0.f, 0.f, 0.f, 0.f}; \
        f32x4 cc = __builtin_amdgcn_mfma_f32_16x16x32_f16(kf0, qf[0][0], z4, 0, 0, 0); cc = __builtin_amdgcn_mfma_f32_16x16x32_f16(kf1, qf[0][1], cc, 0, 0, 0); \
        _Pragma("unroll") for (int h = 0; h < 16; ++h) { f32x4 cn = z4;        \
            if (h < 15) { cn = __builtin_amdgcn_mfma_f32_16x16x32_f16(kf0, qf[h + 1][0], z4, 0, 0, 0); cn = __builtin_amdgcn_mfma_f32_16x16x32_f16(kf1, qf[h + 1][1], cn, 0, 0, 0); } \
            RELU_FMA(a0, cc[0], w[h]); RELU_FMA(a1, cc[1], w[h]); RELU_FMA(a2, cc[2], w[h]); RELU_FMA(a3, cc[3], w[h]); \
            cc = cn; __builtin_amdgcn_sched_barrier(0); } \
        *(LAS f32x4*)(sc + fr * SC_STRIDE + 16 * (kt_) + 4 * fq) = (f32x4){a0, a1, a2, a3}; } while (0)
    KLOAD(ka0, ka1, wave); KLOAD(kb0, kb1, wave + NWAVES);
    for (int rpk = 0; rpk < P2_KT_REP; ++rpk)
    for (int kt = wave; kt < nkt; kt += 3 * NWAVES) {
        KLOAD(kc0, kc1, kt + 2 * NWAVES); KCOMP(ka0, ka1, kt);
        if (kt + NWAVES < nkt) { KLOAD(ka0, ka1, kt + 3 * NWAVES); KCOMP(kb0, kb1, kt + NWAVES); }
        if (kt + 2 * NWAVES < nkt) { KLOAD(kb0, kb1, kt + 4 * NWAVES); KCOMP(kc0, kc1, kt + 2 * NWAVES); }
    }
#undef KCOMP
#undef KLOAD
    __syncthreads();
#pragma unroll 1
    for (int qq = 0; qq < 2 * P2_SEL_REP; ++qq) { const int q = 2 * wave + (qq & 1); const int t = t0 + q;
        wave_topk_mask(sc + q * SC_STRIDE, t, MASK + ((size_t)b * S + t) * 32, lane, (LAS unsigned*)(lds + WSCR_OFF + wave * WSCR_BYTES), (LAS float*)(lds + WSCR_OFF + wave * WSCR_BYTES + 1024)); }
    __syncthreads();
}

__device__ __forceinline__ void p2_phase(const Args& a, LAS unsigned char* lds, int vcu, int G, int wave, int lane) {
    const int gw = vcu * NWAVES + wave, NGW = G * NWAVES;
    unsigned* rdy = (unsigned*)a.ws + RDY_WORD0;
    for (int rp = 0; rp < P2_REP_A; ++rp) p2_sscore(a, gw, NGW, lane);
    signal_add_wt(rdy + 64 * 32);
    { GAS unsigned long long* MASK = (GAS unsigned long long*)(a.ws + WS_MASK);
      for (int i = gw * 64 + lane; i < NB * TOPK * 32; i += NGW * 64) { const int wd = i & 31, t = (i >> 5) & (TOPK - 1), b = i >> 13; const int lo = 64 * wd;
          const unsigned long long m = lo + 63 <= t ? ~0ull : (lo > t ? 0ull : ((1ull << (t - lo + 1)) - 1ull));
          __hip_atomic_store(MASK + ((size_t)b * S + t) * 32 + wd, m, __ATOMIC_RELAXED, __HIP_MEMORY_SCOPE_AGENT); } }
    signal_add_wt(rdy + 64 * 33);
    constexpr int NT = NB * (S - TOPK) / 16;
    for (int rp = 0; rp < P2_REP_C; ++rp)
    for (int r = 0; r * G < NT; ++r) { const int k = (r & 1) ? (r + 1) * G - 1 - vcu : r * G + vcu;
        if (k < NT) { const int j = (NT / NB - 1) - (k >> 2), b = k & 3; p2_index_tile(a, lds, b, TOPK + 16 * j, wave, lane);
            if (rp == 0) signal_add_wt(rdy + 64 * (40 + b * 32 + ((TOPK + 16 * j) >> 6))); } }
}

#ifndef P3_REP_S
#define P3_REP_S 1
#define P3_REP_A 1
#endif
namespace att {
typedef short bf16x8 __attribute__((ext_vector_type(8)));
typedef short s16x4 __attribute__((ext_vector_type(4)));
typedef float f32x16 __attribute__((ext_vector_type(16)));
constexpr int QBLK = 32, KVBLK = 64, D = 128;
constexpr int SHM_V = KVBLK * D * 2, SHM_K = KVBLK * D * 2;
constexpr int WS_OFF = 2 * SHM_V + 2 * SHM_K;
constexpr float SCALE = 0.08838834764831845f;
#define KSWZ(row, colB) ((row) * 256 + ((colB) ^ (((row) & 7) << 4)))
#define SBAR() __builtin_amdgcn_sched_barrier(0)
__device__ __forceinline__ int v_st(int k, int c) { const int kk = (k & ~0xC) | ((k & 4) << 1) | ((k & 8) >> 1); return ((kk >> 3) * 4 + (c >> 5)) * 512 + ((kk & 7) * 32 + (c & 31)) * 2; }
__device__ __forceinline__ int v_rd_base(int lane) { return ((lane & 3) << 3) | (((lane >> 2) & 3) << 6) | (((lane >> 4) & 1) << 5) | (((lane >> 5) & 1) << 8); }
constexpr int v_rd_off(int d0, int ks, int half) { return d0 * 512 + ks * 4096 + half * 2048; }
__device__ __forceinline__ int crow(int r, int hi) { return (r & 3) + 8 * (r >> 2) + 4 * hi; }
__device__ __forceinline__ unsigned cvtpk(float lo, float hi) { return pk_bf16(lo, hi); }

template <int KB>
__device__ __forceinline__ void qkt(f32x16& p0, f32x16& p1, const LAS unsigned char* K_lds, int r32, int hi, const LAS unsigned char* qp) {
    p0 = f32x16{}; p1 = f32x16{};
    const LAS unsigned char* kb[4];
#pragma unroll
    for (int dd = 0; dd < 4; ++dd) kb[dd] = K_lds + KB * SHM_K + KSWZ(r32, (dd * 16 + hi * 8) * 2);
#pragma unroll
    for (int d0 = 0; d0 < 8; ++d0) { const LAS unsigned char* a = kb[d0 & 3] + (d0 >> 2) * 128;
        const bf16x8 b0 = *(const LAS bf16x8*)a;
        const bf16x8 b1 = *(const LAS bf16x8*)(a + 32 * 256);
        const bf16x8 qv = *(const LAS bf16x8*)(qp + d0 * 1024);
        p0 = __builtin_amdgcn_mfma_f32_32x32x16_bf16(b0, qv, p0, 0, 0, 0);
        p1 = __builtin_amdgcn_mfma_f32_32x32x16_bf16(b1, qv, p1, 0, 0, 0); }
}
template <int VB>
__device__ __forceinline__ void pv_tile(f32x16* o, int vb0, bf16x8 pa0, bf16x8 pa1, bf16x8 pa2, bf16x8 pa3) {
#define TRRD(dst, off) asm volatile("ds_read_b64_tr_b16 %0, %1 offset:%2" : "=&v"(dst) : "v"(vb0), "i"(off) : "memory")
#define PV_D0(d0) do { s16x4 l0, l1, l2, l3, h0, h1, h2, h3; constexpr int b_ = VB * SHM_V + v_rd_off(d0, 0, 0); \
        TRRD(l0, b_); TRRD(h0, b_ + 2048); TRRD(l1, b_ + 4096); TRRD(h1, b_ + 6144); TRRD(l2, b_ + 8192); TRRD(h2, b_ + 10240); TRRD(l3, b_ + 12288); TRRD(h3, b_ + 14336); \
        asm volatile("s_waitcnt lgkmcnt(0)" ::: "memory"); SBAR(); \
        o[d0] = __builtin_amdgcn_mfma_f32_32x32x16_bf16(pa0, (bf16x8){l0[0], l0[1], l0[2], l0[3], h0[0], h0[1], h0[2], h0[3]}, o[d0], 0, 0, 0); \
        o[d0] = __builtin_amdgcn_mfma_f32_32x32x16_bf16(pa1, (bf16x8){l1[0], l1[1], l1[2], l1[3], h1[0], h1[1], h1[2], h1[3]}, o[d0], 0, 0, 0); \
        o[d0] = __builtin_amdgcn_mfma_f32_32x32x16_bf16(pa2, (bf16x8){l2[0], l2[1], l2[2], l2[3], h2[0], h2[1], h2[2], h2[3]}, o[d0], 0, 0, 0); \
        o[d0] = __builtin_amdgcn_mfma_f32_32x32x16_bf16(pa3, (bf16x8){l3[0], l3[1], l3[2], l3[3], h3[0], h3[1], h3[2], h3[3]}, o[d0], 0, 0, 0); } while (0)
    PV_D0(0); PV_D0(1); PV_D0(2); PV_D0(3);
#undef PV_D0
#undef TRRD
}
__device__ __forceinline__ void partialSM(f32x16& p0, f32x16& p1, unsigned wl, unsigned wh, float sh2) {
    const float NEG = -__builtin_inff(); constexpr float C2 = 1.4426950408889634f * SCALE;
#pragma unroll
    for (int r = 0; r < 16; ++r) { const unsigned bit = 1u << ((r & 3) + 8 * (r >> 2));
        p0[r] = (wl & bit) ? fmaf(p0[r], C2, -sh2) : NEG; p1[r] = (wh & bit) ? fmaf(p1[r], C2, -sh2) : NEG; }
#pragma unroll
    for (int r = 0; r < 16; ++r) p0[r] = __builtin_amdgcn_exp2f(p0[r]);
}
__device__ __forceinline__ void finishSM(f32x16& p0, f32x16& p1, float& l_reg, bf16x8& pa0, bf16x8& pa1, bf16x8& pa2, bf16x8& pa3) {
#pragma unroll
    for (int r = 0; r < 16; ++r) p1[r] = __builtin_amdgcn_exp2f(p1[r]);
    float ps = 0;
#pragma unroll
    for (int r = 0; r < 16; ++r) ps += p0[r];
#pragma unroll
    for (int r = 0; r < 16; ++r) ps += p1[r];
    l_reg += ps;
#define PK4(P, B_, OUT) do { unsigned a0 = cvtpk(P[B_+0], P[B_+1]), a1 = cvtpk(P[B_+2], P[B_+3]); \
        unsigned b0 = cvtpk(P[B_+4], P[B_+5]), b1 = cvtpk(P[B_+6], P[B_+7]); \
        auto r0 = __builtin_amdgcn_permlane32_swap(a0, b0, false, false); auto r1 = __builtin_amdgcn_permlane32_swap(a1, b1, false, false); \
        u32x4 w = {r0[0], r1[0], r0[1], r1[1]}; OUT = __builtin_bit_cast(bf16x8, w); } while (0)
    PK4(p0, 0, pa0); PK4(p0, 8, pa1); PK4(p1, 0, pa2); PK4(p1, 8, pa3);
#undef PK4
}

__device__ __forceinline__ __amdgpu_buffer_rsrc_t mk_rsrc(const GAS void* p, unsigned bytes) {
    const unsigned long long u = (unsigned long long)p; const unsigned lo = __builtin_amdgcn_readfirstlane((unsigned)u), hi = __builtin_amdgcn_readfirstlane((unsigned)(u >> 32));
    return __builtin_amdgcn_make_buffer_rsrc((void*)(((unsigned long long)hi << 32) | lo), (short)0, (int)bytes, 0x00020000);
}
__device__ __forceinline__ void attn_block(const Args& a, LAS unsigned char* lds, int b, int kvh, int q0, float sh2) {
    int tid_ = threadIdx.x; asm volatile("" : "+v"(tid_));
    const int tid = tid_, wid = __builtin_amdgcn_readfirstlane(tid >> 6), lane = tid & 63, r32 = lane & 31, hi = lane >> 5;
    const int head = 4 * kvh + (wid >> 1), qw = q0 + 32 * (wid & 1);
    const GAS bf16_t* Qw = (const GAS bf16_t*)(a.ws + WS_QB) + (((size_t)b * NH + head) * S + qw) * D;
    const GAS bf16_t* Kh = (const GAS bf16_t*)(a.ws + WS_KB) + ((size_t)b * NKV + kvh) * S * D;
    const GAS bf16_t* Vh = (const GAS bf16_t*)(a.ws + WS_VB) + ((size_t)b * NKV + kvh) * S * D;
    const __amdgpu_buffer_rsrc_t rK = mk_rsrc(Kh, S * D * 2), rV = mk_rsrc(Vh, S * D * 2), rM = mk_rsrc((const GAS unsigned long long*)(a.ws + WS_MASK) + ((size_t)b * S + qw) * 32, 32 * 256);
    const unsigned moff = (unsigned)r32 * 256u;
    const int NT = q0 / KVBLK + 1;
    LAS unsigned char* V_lds = lds; LAS unsigned char* K_lds = lds + 2 * SHM_V;
    const int sr = tid >> 4, sc = (tid & 15) * 8, vst0 = v_st(sr, sc), vst1 = v_st(32 + sr, sc), kws = KSWZ(sr, sc * 2);
    const int vb0 = (int)(unsigned)(size_t)V_lds + v_rd_base(lane); const unsigned kvoff = (unsigned)(sr * D + sc) * 2u;
    bf16x8 st_v0, st_v1, st_k0, st_k1;
    LAS unsigned char* qp = lds + WS_OFF + 2048 + wid * 8192 + lane * 16;
#define VMW() asm volatile("s_waitcnt vmcnt(0)" ::: "memory")
#define BL128(r_, so_) __builtin_bit_cast(bf16x8, __builtin_amdgcn_raw_buffer_load_b128(r_, kvoff, (so_), 0))
#define SLOAD_H(k0) do { const int so_ = (k0) * 256; st_v0 = BL128(rV, so_); st_v1 = BL128(rV, so_ + 8192); st_k0 = BL128(rK, so_); st_k1 = BL128(rK, so_ + 8192); } while (0)
#define SWRITE_HK(bf) do { *(LAS bf16x8*)(K_lds + (bf) * SHM_K + kws) = st_k0; *(LAS bf16x8*)(K_lds + (bf) * SHM_K + kws + 32 * 256) = st_k1; } while (0)
#define SWRITE_HV(bf) do { *(LAS bf16x8*)(V_lds + (bf) * SHM_V + vst0) = st_v0; *(LAS bf16x8*)(V_lds + (bf) * SHM_V + vst1) = st_v1; } while (0)
#define SWRITE_H(bf) do { SWRITE_HV(bf); SWRITE_HK(bf); } while (0)
#define MLOAD(t) __builtin_bit_cast(unsigned long long, __builtin_amdgcn_raw_buffer_load_b64(rM, moff, (t) * 8, 16))
#define MSPLIT(mw, wl, wh) do { wl = (unsigned)(mw) >> (4 * hi); wh = (unsigned)((mw) >> 32) >> (4 * hi); } while (0)
    { bf16x8 qt[8];
#pragma unroll
      for (int d0 = 0; d0 < 8; ++d0) qt[d0] = *(const GAS bf16x8*)(Qw + (unsigned)(r32 * D + d0 * 16 + hi * 8));
#pragma unroll
      for (int d0 = 0; d0 < 8; ++d0) *(LAS bf16x8*)(qp + d0 * 1024) = qt[d0]; }
    SLOAD_H(0); unsigned long long mwA = MLOAD(0), mwB = 0ull; VMW(); SWRITE_H(0);
    if (NT > 1) { SLOAD_H(KVBLK); mwB = MLOAD(1); }
    __syncthreads();
    float l_reg = 0.f; f32x16 o[4] = {};
    f32x16 p0, p1; bf16x8 pa0, pa1, pa2, pa3; unsigned wl, wh;
    SBAR(); qkt<0>(p0, p1, K_lds, r32, hi, qp);
    MSPLIT(mwA, wl, wh); partialSM(p0, p1, wl, wh, sh2);
    if (NT > 1) { VMW(); SWRITE_H(1); }
    __syncthreads();
#define STEP(t, KB, VB) do { \
        finishSM(p0, p1, l_reg, pa0, pa1, pa2, pa3); SBAR(); \
        if ((t) + 1 < NT) { SLOAD_H(((t) + 1) * KVBLK); mwA = MLOAD((t) + 1); SBAR(); } \
        pv_tile<VB>(o, vb0, pa0, pa1, pa2, pa3); SBAR(); \
        qkt<KB>(p0, p1, K_lds, r32, hi, qp); \
        MSPLIT(mwB, wl, wh); partialSM(p0, p1, wl, wh, sh2); mwB = mwA; \
        __syncthreads(); \
        if ((t) + 1 < NT) { VMW(); SWRITE_H(VB); } \
        __syncthreads(); } while (0)
    int t = 1;
    for (; t + 1 < NT; t += 2) { STEP(t, 1, 0); STEP(t + 1, 0, 1); }
    if (t < NT) { STEP(t, 1, 0); }
    finishSM(p0, p1, l_reg, pa0, pa1, pa2, pa3); SBAR();
    if ((NT - 1) & 1) pv_tile<1>(o, vb0, pa0, pa1, pa2, pa3); else pv_tile<0>(o, vb0, pa0, pa1, pa2, pa3);
    { auto rr = __builtin_amdgcn_permlane32_swap(__float_as_uint(l_reg), __float_as_uint(l_reg), false, false); l_reg = __uint_as_float(rr[0]) + __uint_as_float(rr[1]); }
    { int te = threadIdx.x; asm volatile("" : "+v"(te));
      const int le = te & 63, r32e = le & 31, hie = le >> 5;
      LAS float* wse = (LAS float*)(lds + WS_OFF) + wid * 64;
      if (hie == 0) wse[r32e] = l_reg;
      asm volatile("s_waitcnt lgkmcnt(0)" ::: "memory");
      __syncthreads();
      LAS f16* stg = (LAS f16*)(lds + wid * 8192);
#pragma unroll
      for (int r = 0; r < 16; ++r) { const int orow = crow(r, hie); const float rl = __builtin_amdgcn_rcpf(wse[orow]);
#pragma unroll
          for (int d0 = 0; d0 < 4; ++d0) stg[orow * 128 + d0 * 32 + r32e] = (f16)(o[d0][r] * rl); }
      asm volatile("s_waitcnt lgkmcnt(0)" ::: "memory");
      const GAS f16* SZ = (const GAS f16*)(a.ws + WS_SZ) + ((size_t)b * S + qw) * 1024 + head * 128; GAS f16* MIX = (GAS f16*)(a.ws + WS_MIX) + ((size_t)b * S + qw) * 2048 + head * 128;
#pragma unroll
      for (int i = 0; i < 8; ++i) { const int c = le + 64 * i, row = c >> 4, ch = c & 15;
          const f16x8 ov = *(const LAS f16x8*)(stg + row * 128 + ch * 8); const f16x8 zv = *(const GAS f16x8*)(SZ + (unsigned)(row * 1024 + ch * 8));
          *(GAS f16x8*)(MIX + (unsigned)(row * 2048 + ch * 8)) = ov * zv; } }
    asm volatile("s_waitcnt lgkmcnt(0)" ::: "memory");
    __syncthreads();
#undef BL128
#undef VMW
#undef SLOAD_H
#undef SWRITE_HK
#undef SWRITE_HV
#undef SWRITE_H
#undef MLOAD
#undef MSPLIT
#undef STEP
}
#undef KSWZ
#undef SBAR
}

__device__ __forceinline__ void p3_sample_item(const Args& a, LAS unsigned char* lds, int item, int tid) {
    const int qi = item >> 1, kvh = item & 1, sb = qi / NST, tl = qi % NST; constexpr int L = PAST + NST, PER = 33;
    const int lane = tid & 63, wave = __builtin_amdgcn_readfirstlane(tid >> 6);
    const GAS float* ck = (const GAS float*)a.in[2]; const GAS float* cv = (const GAS float*)a.in[3]; const GAS int* ptab = (const GAS int*)a.in[6]; const GAS float* out_ro = (const GAS float*)a.out;
    LAS float* q = (LAS float*)lds; LAS float* w = q + 1024; LAS float* newsc = w + 16; LAS float* ctl = newsc + 4; LAS float* red = ctl + 16;
    LAS unsigned* hist = (LAS unsigned*)(red + 32); LAS float* cand = (LAS float*)(hist + 256); LAS unsigned* cnt = (LAS unsigned*)(cand + 64);
    LAS unsigned* rid = cnt + 32; LAS float* qa = (LAS float*)(rid + 512); LAS float* sc = qa + 512; LAS float* inv = sc + 4 * 512; LAS float* part = inv + 4;
    LAS int* nsel = (LAS int*)(ctl + 8); LAS int* ncand = (LAS int*)(ctl + 9);
    const GAS f16* QI = (const GAS f16*)(a.ws + WS_QI) + (size_t)(MP + qi) * 1024; const GAS float* QS = (const GAS float*)(a.ws + WS_QS) + (size_t)qi * 1024 + kvh * 512;
    for (int i = tid; i < 1024; i += 512) q[i] = (float)QI[i];
    qa[tid] = QS[tid];
    if (tid < 16) w[tid] = ((const GAS float*)(a.ws + WS_WI))[(size_t)(MP + qi) * 16 + tid];
    if (tid < 32) cnt[tid] = 0u;
    if (tid < 256) hist[tid] = 0u;
    if (tid == 0) { *nsel = 0; *ncand = 0; }
    const GAS float* ssc = (const GAS float*)(a.ws + WS_SSC) + (size_t)qi * PAST;
    float v[PER];
#pragma unroll
    for (int j = 0; j < PER - 1; ++j) v[j] = __builtin_bit_cast(float, __hip_atomic_load((const GAS unsigned*)ssc + (j * 512 + tid), __ATOMIC_RELAXED, __HIP_MEMORY_SCOPE_AGENT));
    __syncthreads();
    if (tid < NST) { const GAS float* kr = out_ro + O_KIS + (size_t)(sb * NST + tid) * 64; float s = 0.f;
#pragma unroll 1
        for (int h = 0; h < 16; ++h) { float dsum = 0.f;
#pragma unroll 8
            for (int d = 0; d < 64; ++d) dsum += q[h * 64 + d] * kr[d];
            s += w[h] * fmaxf(dsum, 0.f); }
        newsc[tid] = s; }
    __syncthreads();
    const float NINF = -__builtin_inff(), PINF = __builtin_inff();
    { const int s = (PER - 1) * 512 + tid; v[PER - 1] = (s < L && (s - PAST) <= tl) ? newsc[s - PAST] : NINF; }
    float mx = NINF, mn = PINF;
#pragma unroll
    for (int j = 0; j < PER; ++j) { mx = fmaxf(mx, v[j]); mn = fminf(mn, v[j] == NINF ? PINF : v[j]); }
#pragma unroll
    for (int o = 1; o < 64; o <<= 1) { mx = fmaxf(mx, __shfl_xor(mx, o)); mn = fminf(mn, __shfl_xor(mn, o)); }
    if (lane == 0) { red[wave] = mx; red[8 + wave] = mn; }
    __syncthreads();
#pragma unroll
    for (int i = 0; i < 8; ++i) { mx = fmaxf(mx, red[i]); mn = fminf(mn, red[8 + i]); }
    const float scale = 255.5f / (mx - mn);
    float tau = 0.f; bool have = false;
    if (mx > mn) {
#pragma unroll
        for (int j = 0; j < PER; ++j) if (v[j] != NINF) { int bn = (int)((v[j] - mn) * scale); bn = bn > 255 ? 255 : bn; __hip_atomic_fetch_add(hist + bn, 1u, __ATOMIC_RELAXED, __HIP_MEMORY_SCOPE_WORKGROUP); }
        __syncthreads();
        if (wave == 0) {
            const u32x4 h = *(const LAS u32x4*)(hist + 4 * lane);
            const unsigned sl = h[0] + h[1] + h[2] + h[3]; unsigned pre = sl;
#pragma unroll
            for (int o = 1; o < 64; o <<= 1) { const unsigned y = __shfl_up(pre, o); if (lane >= o) pre += y; }
            const unsigned tot = __builtin_amdgcn_readlane(pre, 63); const unsigned suf = tot - pre + sl;
            const unsigned long long bm = __ballot(suf >= TOPK);
            const int Ls = 63 - __builtin_clzll(bm);
            unsigned c = __builtin_amdgcn_readlane(suf, Ls) - __builtin_amdgcn_readlane(sl, Ls);
            const unsigned h3 = __builtin_amdgcn_readlane(h[3], Ls), h2 = __builtin_amdgcn_readlane(h[2], Ls), h1 = __builtin_amdgcn_readlane(h[1], Ls);
            int Bs;
            if (c + h3 >= TOPK) Bs = 4 * Ls + 3; else { c += h3; if (c + h2 >= TOPK) Bs = 4 * Ls + 2; else { c += h2; if (c + h1 >= TOPK) Bs = 4 * Ls + 1; else { c += h1; Bs = 4 * Ls; } } }
            if (lane == 0) { ((LAS int*)ctl)[0] = Bs; ((LAS int*)ctl)[1] = TOPK - (int)c; }
        }
        __syncthreads();
        const int Bs = ((LAS int*)ctl)[0], need = ((LAS int*)ctl)[1];
#pragma unroll
        for (int j = 0; j < PER; ++j) if (v[j] != NINF) { int bn = (int)((v[j] - mn) * scale); bn = bn > 255 ? 255 : bn;
            if (bn == Bs) { const int p = __hip_atomic_fetch_add(ncand, 1, __ATOMIC_RELAXED, __HIP_MEMORY_SCOPE_WORKGROUP); if (p < 64) cand[p] = v[j]; } }
        __syncthreads();
        const int base = *ncand;
        if (base <= 64) {
            if (wave == 0) { const float x = lane < base ? cand[lane] : NINF; int rank = 0;
                for (int m = 0; m < base; ++m) { const float y = __builtin_bit_cast(float, __builtin_amdgcn_readlane(__builtin_bit_cast(int, x), m)); rank += y > x ? 1 : 0; }
                float tc = (lane < base && rank <= need - 1) ? x : PINF;
#pragma unroll
                for (int o = 1; o < 64; o <<= 1) tc = fminf(tc, __shfl_xor(tc, o));
                if (lane == 0) ctl[2] = tc; }
            __syncthreads();
            tau = ctl[2]; have = true;
        }
    }
    if (!have) {
        unsigned tk = 0u;
        for (int bit = 31; bit >= 0; --bit) { const unsigned cd = tk | (1u << bit); int c = 0;
#pragma unroll
            for (int j = 0; j < PER; ++j) c += __builtin_popcountll(__ballot(v[j] != NINF && fkey(v[j]) >= cd));
            if (lane == 0) __hip_atomic_fetch_add(cnt + bit, (unsigned)c, __ATOMIC_RELAXED, __HIP_MEMORY_SCOPE_WORKGROUP);
            __syncthreads();
            if (cnt[bit] >= TOPK) tk = cd; }
        tau = __builtin_bit_cast(float, (tk & 0x80000000u) ? (tk ^ 0x80000000u) : ~tk);
    }
#pragma unroll
    for (int j = 0; j < PER; ++j) { if (v[j] >= tau) { const int s = j * 512 + tid; const int p = __hip_atomic_fetch_add(nsel, 1, __ATOMIC_RELAXED, __HIP_MEMORY_SCOPE_WORKGROUP);
        if (p < 512) rid[p] = s < PAST ? (unsigned)(ptab[sb * NPAGES + (s >> 7)] * PAGE + (s & (PAGE - 1))) : (0x80000000u | (unsigned)(s - PAST)); } }
    __syncthreads();
    const int n = *nsel < 512 ? *nsel : 512;
    const int half = lane >> 5, l32 = lane & 31;
    { f32x4 qv[4];
#pragma unroll
      for (int h = 0; h < 4; ++h) qv[h] = *(const LAS f32x4*)(qa + h * 128 + 4 * l32);
      for (int j0 = 2 * wave; j0 < n; j0 += 128) { f32x4 kv[8]; int jj[8];
#pragma unroll
          for (int u = 0; u < 8; ++u) { jj[u] = j0 + 16 * u + half; const unsigned r = rid[jj[u] < n ? jj[u] : 0];
              const GAS float* kr = (r & 0x80000000u) ? out_ro + O_KS + ((size_t)(sb * NST + (r & 3u)) * NKV + kvh) * HD : ck + ((size_t)r * NKV + kvh) * HD;
              kv[u] = *(const GAS f32x4*)(kr + 4 * l32); }
#pragma unroll
          for (int u = 0; u < 8; ++u) { float d[4];
#pragma unroll
              for (int h = 0; h < 4; ++h) { d[h] = (kv[u][0] * qv[h][0] + kv[u][1] * qv[h][1]) + (kv[u][2] * qv[h][2] + kv[u][3] * qv[h][3]);
                  d[h] += __shfl_xor(d[h], 1); d[h] += __shfl_xor(d[h], 2); d[h] += __shfl_xor(d[h], 4); d[h] += __shfl_xor(d[h], 8); d[h] += __shfl_xor(d[h], 16); }
              if (jj[u] < n && l32 < 4) sc[l32 * 512 + jj[u]] = (l32 == 0 ? d[0] : l32 == 1 ? d[1] : l32 == 2 ? d[2] : d[3]) * 0.08838834764831845f; } } }
    __syncthreads();
    if (wave < 4) { LAS float* row = sc + wave * 512; float m2 = -1e30f;
      for (int j = lane; j < n; j += 64) m2 = fmaxf(m2, row[j]);
#pragma unroll
      for (int o = 1; o < 64; o <<= 1) m2 = fmaxf(m2, __shfl_xor(m2, o));
      float sm = 0.f;
      for (int j = lane; j < n; j += 64) { const float e = __expf(row[j] - m2); row[j] = e; sm += e; }
      sm = wave_sum(sm); if (lane == 0) inv[wave] = 1.f / sm; }
    __syncthreads();
    { f32x4 acc[4] = {};
      for (int j0 = 2 * wave; j0 < n; j0 += 128) { f32x4 vv[8]; int jj[8];
#pragma unroll
          for (int u = 0; u < 8; ++u) { jj[u] = j0 + 16 * u + half; const unsigned r = rid[jj[u] < n ? jj[u] : 0];
              const GAS float* vr = (r & 0x80000000u) ? out_ro + O_VS + ((size_t)(sb * NST + (r & 3u)) * NKV + kvh) * HD : cv + ((size_t)r * NKV + kvh) * HD;
              vv[u] = *(const GAS f32x4*)(vr + 4 * l32); }
#pragma unroll
          for (int u = 0; u < 8; ++u)
#pragma unroll
              for (int h = 0; h < 4; ++h) { const float p = jj[u] < n ? sc[h * 512 + jj[u]] : 0.f; acc[h] += vv[u] * p; } }
#pragma unroll
      for (int h = 0; h < 4; ++h) {
#pragma unroll
          for (int e = 0; e < 4; ++e) acc[h][e] += __shfl_xor(acc[h][e], 32);
          if (half == 0) *(LAS f32x4*)(part + (wave * 4 + h) * 128 + 4 * l32) = acc[h]; } }
    __syncthreads();
    { const GAS f16* SZ = (const GAS f16*)(a.ws + WS_SZ) + (size_t)(MP + qi) * 1024 + kvh * 512; GAS f16* MIX = (GAS f16*)(a.ws + WS_MIX) + (size_t)(MP + qi) * 2048 + kvh * 512;
      const int h = tid >> 7, d = tid & 127; float o = 0.f;
#pragma unroll
      for (int p = 0; p < 8; ++p) o += part[(p * 4 + h) * 128 + d];
      MIX[tid] = (f16)(o * inv[h] * (float)SZ[tid]); }
    __syncthreads();
}

__device__ __forceinline__ void p3_phase(const Args& a, LAS unsigned char* lds, int vcu, int G, int tid) {
    float gm = 0.f, km = 0.f;
    for (int i = 0; i < HD; ++i) { gm = fmaxf(gm, fabsf(a.in[9][i])); km = fmaxf(km, fabsf(a.in[10][i])); }
    const float sh2 = fmaxf(0.f, 11.313708498984761f * gm * km - 20.f) * 1.4426950408889634f;
    for (int rp = 0; rp < P3_REP_S; ++rp)
    for (int sidx = G - 1 - vcu; sidx < 2 * MS; sidx += G) { wait_ge_wt((unsigned*)a.ws + RDY_WORD0 + 64 * 32, (unsigned)G); p3_sample_item(a, lds, sidx, tid); }
    if (G == 256) { if (vcu >= 112 && vcu < 192) p2_convmix(a, (vcu - 112) * NWAVES + (tid >> 6), 80 * NWAVES, tid & 63); }
    else p2_convmix(a, vcu * NWAVES + (tid >> 6), G * NWAVES, tid & 63);
    for (int rp = 0; rp < P3_REP_A; ++rp)
    for (int k = vcu; k < 256; k += G) { const int i = 31 - (k >> 3), bk = k & 7;
        if (i >= 4) wait_ge_wt((unsigned*)a.ws + RDY_WORD0 + 64 * (40 + (bk >> 1) * 32 + i), 4u); else wait_ge_wt((unsigned*)a.ws + RDY_WORD0 + 64 * 33, (unsigned)G);
        att::attn_block(a, lds, bk >> 1, bk & 1, 64 * i, sh2); }
}

__global__ void __launch_bounds__(NWAVES * 64, 2) mk_fwd(Args a) {
    extern __shared__ __attribute__((aligned(16))) unsigned char lds_raw[];
    LAS unsigned char* lds = (LAS unsigned char*)lds_raw;
    const int tid = threadIdx.x, lane = tid & 63, wave = __builtin_amdgcn_readfirstlane(tid >> 6);
    const int G = gridDim.x; const int bx = blockIdx.x; const int vcu = (G % 8 == 0) ? (bx % 8) * (G / 8) + bx / 8 : bx;
    volatile LAS unsigned* MISC = (volatile LAS unsigned*)(lds + MISC_OFF);
    if (tid < 64) MISC[tid] = 0u;
    __syncthreads();
    XcdBarrier bar = xcd_barrier_post((unsigned*)a.ws, MISC + 8);
    { int t_ = threadIdx.x; asm volatile("" : "+v"(t_)); const int lane = t_ & 63, wave = __builtin_amdgcn_readfirstlane(t_ >> 6); p0_prologue(a, lds, vcu, G, wave, lane); }
    xcd_barrier(bar);
    { pg8::Gemm g{(const f16*)(a.ws + WS_XNH), (const f16*)(a.ws + WS_WINT), DM};
      pg8::StaticOrder S; S.init(MPAD / 256, NPAD / 256, G, bx);
      EpiIn E{a.out, a.ws, a.in[9], a.in[10], a.in[11], (LAS float*)(lds + SCR_OFF)};
      pg8::gemm_phase<EpiIn, pg8::StaticOrder>(lds, g, S, E); }
    xcd_barrier(bar);
    { int t_ = threadIdx.x; asm volatile("" : "+v"(t_)); const int lane = t_ & 63, wave = __builtin_amdgcn_readfirstlane(t_ >> 6); p2_phase(a, lds, vcu, G, wave, lane); }
    { int t_ = threadIdx.x; asm volatile("" : "+v"(t_)); p3_phase(a, lds, vcu, G, t_); }
    xcd_barrier(bar);
    { pg8::Gemm g{(const f16*)(a.ws + WS_MIX), (const f16*)(a.ws + WS_WOUTT), DM};
      pg8::StaticOrder S; S.init(MP / 256, DM / 256, G, bx);
      EpiOut E{a.out, a.in[0]};
      pg8::gemm_phase<EpiOut, pg8::StaticOrder>(lds, g, S, E);
      int t_ = threadIdx.x; asm volatile("" : "+v"(t_)); p4_sample(a, lds, bx, G, t_); }
}

#ifndef PROG
#define PROG 0x11111u
#endif
extern "C" void kernel_launch(void* const* d_in, const int* in_sizes, int n_in, void* d_out, int out_size, void* d_ws, size_t ws_size, hipStream_t stream) {
    static int grid = 0;
    if (grid == 0) {
        if (ws_size < WS_NEED2 || out_size != (int)O_END || n_in != 14) { fprintf(stderr, "kernel_launch: ws %zu (need %zu) out %d (want %zu) n_in %d\n", ws_size, (size_t)WS_NEED2, out_size, (size_t)O_END, n_in); grid = -1; return; }
        int dev = 0, cus = 0; hipGetDevice(&dev); hipDeviceGetAttribute(&cus, hipDeviceAttributeMultiprocessorCount, dev);
        if (hipFuncSetAttribute((const void*)mk_fwd, hipFuncAttributeMaxDynamicSharedMemorySize, LDS_BYTES) != hipSuccess) { fprintf(stderr, "kernel_launch: hipFuncSetAttribute failed\n"); grid = -1; return; }
        int per_cu = 0; hipOccupancyMaxActiveBlocksPerMultiprocessor(&per_cu, (const void*)mk_fwd, NWAVES * 64, LDS_BYTES); (void)hipGetLastError();
        if (per_cu < 1) fprintf(stderr, "kernel_launch: occupancy query says %d blocks per CU\n", per_cu);
        grid = cus > 0 ? cus : 256;
    }
    if (grid < 0) return;
    float* out = (float*)d_out; unsigned char* ws = (unsigned char*)d_ws;
    Args a{};
    for (int i = 0; i < 14; ++i) a.in[i] = (const float*)d_in[i];
    a.out = out; a.ws = ws;
    if (hipMemsetAsync(ws, 0, 65536, stream) != hipSuccess) { fprintf(stderr, "kernel_launch: memset of the control words failed\n"); return; }
    a.ph_lo = (int)PROG; a.ph_hi = 0; hipLaunchKernelGGL(mk_fwd, dim3(grid), dim3(NWAVES * 64), LDS_BYTES, stream, a);
}
```

```cpp
#include <hip/hip_runtime.h>
#include <cstdio>
#include <cstdint>
#include <cmath>

typedef _Float16 f16;
typedef unsigned short bf16_t;

constexpr int DM = 2048, NB = 4, S = 2048, NSB = 8, NST = 4, PAST = 16384, PAGE = 128, NPAGES = PAST / PAGE;
constexpr int MP = NB * S;
constexpr int MS = NSB * NST;
constexpr int MT = MP + MS;
constexpr int DIN = 7760;
constexpr int OQ = 0, OKK = 1024, OV = 1280, OZ = 1536, OQI = 2560, OKI = 3584, OWI = 3648, OH = 3664, OBB = 4688, OC = 5712, OZC = 6736;
constexpr int NH = 8, NKV = 2, HD = 128, NIH = 16, ID = 64, TOPK = 256, DC = 1024;
constexpr float EPS = 1e-6f;
constexpr size_t O_YP = 0, O_YS = 16777216, O_KP = 16842752, O_VP = 18939904, O_KIP = 21037056, O_CVP = 21561344,
                 O_KS = 21569536, O_VS = 21577728, O_KIS = 21585920, O_CVS = 21587968, O_END = 21604352;
constexpr size_t MiB = 1u << 20;
constexpr size_t WS_ROPE = 1 * MiB;
constexpr size_t WS_ROPE_I = WS_ROPE + 2052 * 32 * 4;
constexpr size_t WS_QB = 2 * MiB;
constexpr size_t WS_KB = 18 * MiB;
constexpr size_t WS_VB = 22 * MiB;
constexpr size_t WS_SZ = 26 * MiB;
constexpr size_t WS_QI = 43 * MiB;
constexpr size_t WS_KI = 60 * MiB;
constexpr size_t WS_WI = 61 * MiB;
constexpr size_t WS_U = 62 * MiB;
constexpr size_t WS_G = 79 * MiB;
constexpr size_t WS_MIX = 96 * MiB;
constexpr size_t WS_MASK = 130 * MiB;
constexpr size_t WS_SSC = 132 * MiB;
constexpr size_t WS_QS = 134 * MiB;
constexpr size_t WS_XN = 136 * MiB;
constexpr size_t WS_P = 202 * MiB;
constexpr size_t WS_NEED = 448 * MiB;

__device__ __forceinline__ bf16_t f2bf(float f) { unsigned u = __builtin_bit_cast(unsigned, f); return (bf16_t)((u + 0x7fffu + ((u >> 16) & 1u)) >> 16); }
__device__ __forceinline__ float bf2f(bf16_t h) { return __builtin_bit_cast(float, (unsigned)h << 16); }
__device__ __forceinline__ float silu(float z) { return z * __builtin_amdgcn_rcpf(1.f + __builtin_amdgcn_exp2f(-1.4426950408889634f * z)); }
__device__ __forceinline__ unsigned fkey(float f) { unsigned u = __builtin_bit_cast(unsigned, f); return (u & 0x80000000u) ? ~u : (u | 0x80000000u); }

#define P0_REP_T 1
#define P0_REP_X 1
#define P3_REP_S 1
#define P3_REP_A 1
#define P2_KT_REP 1
#define P2_SEL_REP 1
#define P2_REP_A 1
#define P2_REP_B 1
#define P2_REP_C 1
#define LAS __attribute__((address_space(3)))
#define GAS __attribute__((address_space(1)))
typedef _Float16 f16x8 __attribute__((ext_vector_type(8)));
typedef _Float16 f16x4 __attribute__((ext_vector_type(4)));
typedef _Float16 f16x2 __attribute__((ext_vector_type(2)));
typedef float f32x4 __attribute__((ext_vector_type(4)));
typedef float f32x2 __attribute__((ext_vector_type(2)));
typedef unsigned u32x4 __attribute__((ext_vector_type(4)));
typedef unsigned u32x2 __attribute__((ext_vector_type(2)));
typedef __bf16 bf16x2_t __attribute__((ext_vector_type(2)));
namespace pg8 {
constexpr int BM = 256, BK = 64, HALF = 128, HTB = HALF * BK * 2, STAGE_BYTES = 8 * HTB, NXCD = 8, WGM = 8;
__host__ __device__ __forceinline__ int lds_byte(int r, int c) { const int st = (r >> 4) * 2 + (c >> 5), rr = r & 15, cc = c & 31, ob = rr * 64 + cc * 2; return st * 1024 + (ob ^ (((ob >> 9) & 1) << 5)); }
__host__ __device__ __forceinline__ void stage_rc(int b, int& R, int& C) { const int st = b / 1024, sb = b % 1024, swz = sb ^ (((sb >> 9) & 1) << 5); R = (st >> 1) * 16 + swz / 64; C = (st & 1) * 32 + (swz % 64) / 2; }
struct Unit { int pm, pn; };
struct Gemm { const f16* A; const f16* Bt; int K; };
struct StaticOrder {
    int nM, nN, nwg, G, c;
    __device__ __forceinline__ void init(int nM_, int nN_, int G_, int c_) { nM = nM_; nN = nN_; nwg = nM * nN; G = G_; c = c_; }
    __device__ __forceinline__ bool next(int i, Unit& u) const {
        const long L = (long)i * G + c; if (L >= nwg) return false;
        int wgid = (int)L; { const int q = nwg / NXCD, r = nwg % NXCD, xcd = wgid % NXCD, off = wgid / NXCD; wgid = (xcd < r ? xcd * (q + 1) : r * (q + 1) + (xcd - r) * q) + off; }
        const int nig = WGM * nN, gid = wgid / nig, fm = gid * WGM, gsz = (nM - fm) < WGM ? (nM - fm) : WGM;
        u.pm = fm + ((wgid % nig) % gsz); u.pn = (wgid % nig) / gsz; return true;
    }
};
struct OneUnit { int pm, pn; __device__ __forceinline__ bool next(int i, Unit& u) const { if (i != 0) return false; u.pm = pm; u.pn = pn; return true; } };
template <class Epi, class Sched, bool PRE = false>
__device__ __forceinline__ void gemm_phase(LAS unsigned char* lds, const Gemm g, const Sched& S, const Epi& E, const f32x4 (*pre)[2][4][2] = nullptr) {
    int tid_ = threadIdx.x; asm volatile("" : "+v"(tid_));
    const int tid = tid_, wid = __builtin_amdgcn_readfirstlane(tid >> 6), lane = tid & 63, wr = wid >> 2, wc = wid & 3, fr = lane & 15, fq = lane >> 4;
    const int K = g.K, nt = K / BK;
    unsigned voffA[2];
#pragma unroll
    for (int i = 0; i < 2; ++i) { int R, C; stage_rc(tid * 16 + i * 8192, R, C); voffA[i] = (unsigned)(R * K + C) * 2u; }
    const size_t kstep = (size_t)(BK * 2);
    const size_t hstep = (size_t)HALF * K * 2;
    const size_t tstep = 2 * hstep;
    const unsigned ldsw = (unsigned)wid * 1024u;
    const int aoff = lds_byte(wr * 64 + fr, fq * 8), boff = lds_byte(wc * 32 + fr, fq * 8);
#define PG8_SA(b, h) (((b) * 2 + (h)) * HTB)
#define PG8_SB(b, h) ((4 + (b) * 2 + (h)) * HTB)
#define PG8_STAGE(bufoff, gbase) do { _Pragma("unroll") for (int _i = 0; _i < 2; ++_i) \
        __builtin_amdgcn_global_load_lds((const unsigned*)((const char*)(gbase) + voffA[_i]), (LAS unsigned*)(lds + (bufoff) + ldsw + _i * 8192), 16, 0, 0); } while (0)
#define PG8_LDA(dst, b, h) do { _Pragma("unroll") for (int m = 0; m < 4; ++m) _Pragma("unroll") for (int k = 0; k < 2; ++k) dst[m][k] = *(const LAS f16x8*)(lds + PG8_SA(b, h) + aoff + m * 2048 + k * 1024); } while (0)
#define PG8_LDB(dst, b, h) do { _Pragma("unroll") for (int n = 0; n < 2; ++n) _Pragma("unroll") for (int k = 0; k < 2; ++k) dst[n][k] = *(const LAS f16x8*)(lds + PG8_SB(b, h) + boff + n * 2048 + k * 1024); } while (0)
#define PG8_MMA(ai, bj, At, Bt) do { __builtin_amdgcn_s_setprio(1); _Pragma("unroll") for (int m = 0; m < 4; ++m) _Pragma("unroll") for (int n = 0; n < 2; ++n) _Pragma("unroll") for (int k = 0; k < 2; ++k) \
        acc[ai][bj][m][n] = __builtin_amdgcn_mfma_f32_16x16x32_f16(Bt[n][k], At[m][k], acc[ai][bj][m][n], 0, 0, 0); __builtin_amdgcn_s_setprio(0); } while (0)
#define PG8_WAIT_V(n) asm volatile("s_waitcnt vmcnt(" #n ")" ::: "memory")
#define PG8_WAIT_L(n) asm volatile("s_waitcnt lgkmcnt(" #n ")" ::: "memory")
#define PG8_BAR __builtin_amdgcn_s_barrier()
#define PG8_SCHED __builtin_amdgcn_sched_barrier(0)
    Unit cur, nxt; int ui = 0;
    if (!S.next(0, cur)) return;
    f32x4 acc[2][2][4][2];
    if constexpr (PRE) {
#pragma unroll
        for (int a = 0; a < 2; ++a)
#pragma unroll
            for (int b = 0; b < 2; ++b)
#pragma unroll
                for (int m = 0; m < 4; ++m)
#pragma unroll
                    for (int n = 0; n < 2; ++n) acc[a][b][m][n] = pre[a][b][m][n];
    } else E.init(acc, cur, wr, wc, fr, fq);
    f16x8 At[4][2], B0[2][2], B1[2][2];
    const char* cA = (const char*)g.A + (size_t)cur.pm * tstep; const char* cB = (const char*)g.Bt + (size_t)cur.pn * tstep;
    PG8_STAGE(PG8_SB(0, 0), cB); PG8_STAGE(PG8_SB(0, 1), cB + hstep); PG8_STAGE(PG8_SA(0, 0), cA); PG8_STAGE(PG8_SA(0, 1), cA + hstep);
    if (wr == 1) PG8_BAR;
    PG8_WAIT_V(2); PG8_BAR;
    PG8_STAGE(PG8_SB(1, 0), cB + kstep); PG8_STAGE(PG8_SA(1, 0), cA + kstep); PG8_STAGE(PG8_SB(1, 1), cB + hstep + kstep);
    PG8_WAIT_V(6); PG8_BAR;
    for (;;) {
        const bool has_next = S.next(ui + 1, nxt);
        const char* nA = has_next ? (const char*)g.A + (size_t)nxt.pm * tstep : cA; const char* nB = has_next ? (const char*)g.Bt + (size_t)nxt.pn * tstep : cB;
        for (int t = 0; t < nt; t += 2) {
            const bool last = (t == nt - 2);
            const char* a1 = cA + (size_t)(t + 1) * kstep;
            const char* a2 = last ? nA : cA + (size_t)(t + 2) * kstep; const char* b2 = last ? nB : cB + (size_t)(t + 2) * kstep;
            const char* a3 = a2 + kstep; const char* b3 = b2 + kstep;
            PG8_LDB(B0, 0, 0); PG8_LDB(B1, 0, 1); PG8_SCHED; PG8_LDA(At, 0, 0); PG8_STAGE(PG8_SA(1, 1), a1 + hstep);
            PG8_WAIT_V(8); PG8_WAIT_L(0); PG8_BAR; PG8_MMA(0, 0, At, B0); PG8_MMA(0, 1, At, B1); PG8_BAR; PG8_SCHED;
            PG8_LDA(At, 0, 1); PG8_STAGE(PG8_SB(0, 0), b2); PG8_STAGE(PG8_SB(0, 1), b2 + hstep); PG8_STAGE(PG8_SA(0, 0), a2);
            PG8_WAIT_V(8); PG8_WAIT_L(0); PG8_BAR; PG8_MMA(1, 0, At, B0); PG8_MMA(1, 1, At, B1); PG8_BAR; PG8_SCHED;
            PG8_LDB(B0, 1, 0); PG8_LDB(B1, 1, 1); PG8_SCHED; PG8_LDA(At, 1, 0); PG8_STAGE(PG8_SA(0, 1), a2 + hstep);
            PG8_WAIT_V(8); PG8_WAIT_L(0); PG8_BAR; PG8_MMA(0, 0, At, B0); PG8_MMA(0, 1, At, B1); PG8_BAR; PG8_SCHED;
            PG8_LDA(At, 1, 1); PG8_STAGE(PG8_SB(1, 0), b3); PG8_STAGE(PG8_SB(1, 1), b3 + hstep); PG8_STAGE(PG8_SA(1, 0), a3);
            PG8_WAIT_V(8); PG8_WAIT_L(0); PG8_BAR; PG8_MMA(1, 0, At, B0); PG8_MMA(1, 1, At, B1); PG8_BAR; PG8_SCHED;
        }
        const bool al = E.aligned(cur);
        if (al && wr == 0) PG8_BAR;
        E(acc, cur, wr, wc, fr, fq);
        if (!has_next) { if (!al && wr == 0) PG8_BAR; break; }
        cur = nxt; cA = nA; cB = nB; ++ui;
        E.init(acc, cur, wr, wc, fr, fq);
        if (al && wr == 1) PG8_BAR;
    }
    PG8_WAIT_V(0);
    PG8_BAR;
#undef PG8_SA
#undef PG8_SB
#undef PG8_STAGE
#undef PG8_LDA
#undef PG8_LDB
#undef PG8_MMA
#undef PG8_WAIT_V
#undef PG8_WAIT_L
#undef PG8_BAR
#undef PG8_SCHED
}
}
#ifndef P0_REP_T
#define P0_REP_T 1
#define P0_REP_X 1
#endif
constexpr int NWAVES = 8;
constexpr int MPAD = 8448, NPAD = 7936;
constexpr size_t WS_XNH = 450 * MiB;
constexpr size_t WS_WINT = 484 * MiB;
constexpr size_t WS_WOUTT = 516 * MiB;
constexpr size_t WS_PART = 524 * MiB;
constexpr size_t PART_STRIDE = 32768 + 256;
constexpr size_t WS_NEED2 = 536 * MiB;
constexpr int RING_BYTES = 131072, SCR_OFF = RING_BYTES, SCR_BYTES = 8192, MISC_OFF = 145408, LDS_BYTES = 147456;

__device__ __forceinline__ unsigned pk_bf16(float lo, float hi) { f32x2 v = {lo, hi}; bf16x2_t b = __builtin_convertvector(v, bf16x2_t); return __builtin_bit_cast(unsigned, b); }
__device__ __forceinline__ unsigned pk_f16(float lo, float hi) { f32x2 v = {lo, hi}; f16x2 b = __builtin_convertvector(v, f16x2); return __builtin_bit_cast(unsigned, b); }

struct Args { const float* in[14]; float* out; unsigned char* ws; int ph_lo, ph_hi; };

__device__ __forceinline__ int win_src(int np) {
    const int pn = np >> 8, c = np & 255;
    if (pn < 15) { const int rho = c & 31, nn = rho >> 4, ii = rho & 15; const int L = (np & ~31) | (8 * (ii >> 2) + 4 * nn + (ii & 3));
        if (pn < 14) return L;
        return (L & 255) < 80 ? L : -1; }
    const int T = pn - 15, bj = c >> 7, wc = (c >> 5) & 3, n = (c >> 4) & 1, fqi = c & 15;
    const int base = bj == 0 ? (n == 0 ? OH : OBB) : (n == 0 ? OC : OZC);
    return base + 64 * T + 16 * wc + fqi;
}
template <bool MAP>
__device__ __forceinline__ void p0_transpose_item(const float* W, int N, f16* WT, LAS unsigned char* scr, int item, int nblk, int lane) {
    const int kb = item / nblk, nb = item % nblk, k0 = 64 * kb, n0 = 32 * nb;
    const int q = lane & 7, kr = lane >> 3;
    const int src = MAP ? win_src(n0 + 4 * q) : n0 + 4 * q;
    const GAS float* wp = (const GAS float*)W + (size_t)(k0 + 2 * kr) * N + (src >= 0 ? src : 0);
    f32x4 va[4], vb[4];
#pragma unroll
    for (int p = 0; p < 4; ++p) { va[p] = *(const GAS f32x4*)(wp + (size_t)(16 * p) * N); vb[p] = *(const GAS f32x4*)(wp + (size_t)(16 * p + 1) * N); }
#pragma unroll
    for (int p = 0; p < 4; ++p) { if (src < 0) { va[p] = (f32x4){0.f, 0.f, 0.f, 0.f}; vb[p] = va[p]; }
#pragma unroll
        for (int e = 0; e < 4; ++e) *(LAS unsigned*)(scr + (4 * q + e) * 144 + 2 * (16 * p + 2 * kr)) = pk_f16(va[p][e], vb[p][e]); }
    asm volatile("s_waitcnt lgkmcnt(0)" ::: "memory");
    const int ch = lane & 7;
#pragma unroll
    for (int j = 0; j < 4; ++j) { const int n = (lane >> 3) + 8 * j;
        *(GAS u32x4*)(WT + (size_t)(n0 + n) * 2048 + k0 + 8 * ch) = *(const LAS u32x4*)(scr + n * 144 + ch * 16); }
    asm volatile("s_waitcnt lgkmcnt(0)" ::: "memory");
}
__device__ __forceinline__ float wave_sum(float v) {
#pragma unroll
    for (int o = 1; o < 64; o <<= 1) v += __shfl_xor(v, o);
    return v;
}
__device__ __forceinline__ void p0_prologue(const Args& a, LAS unsigned char* lds, int vcu, int G, int wave, int lane) {
    LAS unsigned char* scr = lds + wave * 16384;
    const int gw = vcu * NWAVES + wave, NGW = G * NWAVES;
    const float* win = a.in[8]; const float* wout = a.in[13];
    f16* WinT = (f16*)(a.ws + WS_WINT); f16* WoutT = (f16*)(a.ws + WS_WOUTT); f16* XN = (f16*)(a.ws + WS_XNH);
    constexpr int I_IN = 32 * (NPAD / 32), I_OUT = 32 * (DM / 32);
    for (int rpt = 0; rpt < P0_REP_T; ++rpt)
    for (int it = gw; it < I_IN + I_OUT; it += NGW) {
        if (it < I_IN) p0_transpose_item<true>(win, DIN, WinT, scr, it, NPAD / 32, lane);
        else p0_transpose_item<false>(wout, DM, WoutT, scr, it - I_IN, DM / 32, lane);
    }
    const float* gin = a.in[7];
    for (int rpx = 0; rpx < P0_REP_X; ++rpx)
    for (int m = gw; m < MT; m += NGW) {
        const float* xrow = m < MP ? a.in[0] + (size_t)m * DM : a.in[1] + (size_t)(m - MP) * DM;
        const f32x4* xr = (const f32x4*)xrow + lane; f32x4 v[8]; float s = 0.f;
#pragma unroll
        for (int j = 0; j < 8; ++j) { v[j] = xr[64 * j]; s += (v[j].x * v[j].x + v[j].y * v[j].y) + (v[j].z * v[j].z + v[j].w * v[j].w); }
        const float rs = rsqrtf(wave_sum(s) * (1.f / DM) + EPS);
        u32x2* o8 = (u32x2*)(XN + (size_t)m * DM) + lane;
#pragma unroll
        for (int j = 0; j < 8; ++j) { const f32x4 gv = ((const f32x4*)gin)[lane + 64 * j]; u32x2 w; w.x = pk_f16(v[j].x * rs * gv.x, v[j].y * rs * gv.y); w.y = pk_f16(v[j].z * rs * gv.z, v[j].w * rs * gv.w); o8[64 * j] = w; }
    }
    float* rqk = (float*)(a.ws + WS_ROPE); float* ri = (float*)(a.ws + WS_ROPE_I);
    for (int i = gw * 64 + lane; i < 2052 * 16; i += NGW * 64) {
        { int slot = i / 16, j = i % 16; int pos = slot < 2048 ? slot : PAST + (slot - 2048);
          float inv = (float)pow(500000.0, -(double)j / 16.0); float ang = (float)pos * inv;
          rqk[(slot * 16 + j) * 2] = (float)cos((double)ang); rqk[(slot * 16 + j) * 2 + 1] = (float)sin((double)ang); }
        if (i < 2052 * 8) { int slot = i / 8, j = i % 8; int pos = slot < 2048 ? slot : PAST + (slot - 2048);
          float inv = (float)pow(500000.0, -(double)j / 8.0); float ang = (float)pos * inv;
          ri[(slot * 8 + j) * 2] = (float)cos((double)ang); ri[(slot * 8 + j) * 2 + 1] = (float)sin((double)ang); }
    }
}

struct EpiIn {
    float* out; unsigned char* ws; const float* gq; const float* gk; const float* gki; LAS float* scr;
    __device__ __forceinline__ bool aligned(const pg8::Unit& u) const { return u.pn <= 4 || u.pn == 14; }
    __device__ __forceinline__ void init(f32x4 (&acc)[2][2][4][2], const pg8::Unit&, int, int, int, int) const {
#pragma unroll
        for (int a = 0; a < 2; ++a)
#pragma unroll
            for (int b = 0; b < 2; ++b)
#pragma unroll
                for (int m = 0; m < 4; ++m)
#pragma unroll
                    for (int n = 0; n < 2; ++n) acc[a][b][m][n] = (f32x4){0.f, 0.f, 0.f, 0.f};
    }
    __device__ __forceinline__ void operator()(f32x4 (&acc)[2][2][4][2], const pg8::Unit& u, int wr, int wc, int fr_, int fq_) const {
        int fr = fr_, fq = fq_; asm volatile("" : "+v"(fr), "+v"(fq));
        GAS unsigned char* ws = (GAS unsigned char*)this->ws; GAS float* out = (GAS float*)this->out; asm volatile("" : "+s"(ws), "+s"(out));
        const int pn = u.pn, pm = u.pm; const bool smp = pm == 32;
        const int rbase = 64 * wr + fr;
        const int bb = pm >> 3, t0 = (pm & 7) << 8;
        const GAS float* rqk = (const GAS float*)(ws + WS_ROPE); const GAS float* ri = (const GAS float*)(ws + WS_ROPE_I);
#define ROWLOOP _Pragma("unroll") for (int ai = 0; ai < 2; ++ai) _Pragma("unroll") for (int m = 0; m < 4; ++m)
#define ROWVARS const int r = rbase + 128 * ai + 16 * m; const bool valid = !smp || r < MS; const int grow = smp ? MP + r : pm * 256 + r; const int tt = smp ? (r & 3) : t0 + r; const int slot = smp ? 2048 + (r & 3) : tt; (void)grow; (void)tt; (void)slot; (void)valid;
        const int cl = 32 * wc + 8 * fq;
#define PK8B(x0_, x1_) ((u32x4){pk_bf16(x0_[0], x0_[1]), pk_bf16(x0_[2], x0_[3]), pk_bf16(x1_[0], x1_[1]), pk_bf16(x1_[2], x1_[3])})
#define PK8H(x0_, x1_) ((u32x4){pk_f16(x0_[0], x0_[1]), pk_f16(x0_[2], x0_[3]), pk_f16(x1_[0], x1_[1]), pk_f16(x1_[2], x1_[3])})
#define SHX4(dst_, src_, off_) do { dst_[0] = __shfl_xor(src_[0], off_); dst_[1] = __shfl_xor(src_[1], off_); dst_[2] = __shfl_xor(src_[2], off_); dst_[3] = __shfl_xor(src_[3], off_); } while (0)
        if (pn <= 4 || pn == 14) {
            const bool isk = pn == 14;
            ROWLOOP { asm volatile("" ::: "memory"); const int r = rbase + 128 * ai + 16 * m;
#pragma unroll
                for (int bj = 0; bj < 2; ++bj) { float s = 0.f;
#pragma unroll
                    for (int n = 0; n < 2; ++n) { const f32x4 x = acc[ai][bj][m][n]; s += (x[0] * x[0] + x[1] * x[1]) + (x[2] * x[2] + x[3] * x[3]); }
                    if (isk && (wc >= 2 || bj == 1)) s = 0.f;
                    s += __shfl_xor(s, 16); s += __shfl_xor(s, 32);
                    if (fq == 0) scr[(r * 2 + bj) * 4 + wc] = s; } }
            asm volatile("s_waitcnt lgkmcnt(0)" ::: "memory"); __builtin_amdgcn_s_barrier(); asm volatile("" ::: "memory");
            if (!isk) {
                const GAS float* g = (const GAS float*)(pn < 4 ? gq : gk);
                const f32x4 g0 = *(const GAS f32x4*)(g + cl), g1 = *(const GAS f32x4*)(g + cl + 4);
                GAS bf16_t* Qb = (GAS bf16_t*)(ws + WS_QB); GAS bf16_t* Kb = (GAS bf16_t*)(ws + WS_KB); GAS float* QS = (GAS float*)(ws + WS_QS);
                ROWLOOP { asm volatile("" ::: "memory"); ROWVARS
                    f32x4 c0 = {1.f, 1.f, 1.f, 1.f}, s0 = {0.f, 0.f, 0.f, 0.f}, c1 = c0, s1 = s0;
                    if (wc == 0) { const GAS f32x4* cp = (const GAS f32x4*)(rqk + (slot * 16 + 8 * (fq & 1)) * 2); const f32x4 t0_ = cp[0], t1_ = cp[1], t2_ = cp[2], t3_ = cp[3];
                        c0 = (f32x4){t0_[0], t0_[2], t1_[0], t1_[2]}; s0 = (f32x4){t0_[1], t0_[3], t1_[1], t1_[3]}; c1 = (f32x4){t2_[0], t2_[2], t3_[0], t3_[2]}; s1 = (f32x4){t2_[1], t2_[3], t3_[1], t3_[3]}; }
#pragma unroll
                    for (int bj = 0; bj < 2; ++bj) {
                        const f32x4 p = *(const LAS f32x4*)(scr + (r * 2 + bj) * 4);
                        const float rs = rsqrtf(((p[0] + p[1]) + (p[2] + p[3])) * (1.f / 128.f) + EPS);
                        f32x4 x0 = acc[ai][bj][m][0] * rs * g0, x1 = acc[ai][bj][m][1] * rs * g1;
                        if (wc == 0) { f32x4 o0, o1; SHX4(o0, x0, 32); SHX4(o1, x1, 32);
                            if (fq < 2) { x0 = x0 * c0 - o0 * s0; x1 = x1 * c1 - o1 * s1; } else { x0 = x0 * c0 + o0 * s0; x1 = x1 * c1 + o1 * s1; } }
                        const int hh = 2 * pn + bj;
                        if (pn < 4) {
                            if (smp) { if (valid) { GAS float* q = QS + (size_t)r * 1024 + hh * 128 + cl; *(GAS f32x4*)q = x0; *(GAS f32x4*)(q + 4) = x1; } }
                            else *(GAS u32x4*)(Qb + (((size_t)bb * NH + hh) * S + tt) * HD + cl) = PK8B(x0, x1);
                        } else {
                            if (smp) { if (valid) { GAS float* k = out + O_KS + (size_t)r * 256 + bj * 128 + cl; *(GAS f32x4*)k = x0; *(GAS f32x4*)(k + 4) = x1; } }
                            else { GAS float* k = out + O_KP + (size_t)grow * 256 + bj * 128 + cl; *(GAS f32x4*)k = x0; *(GAS f32x4*)(k + 4) = x1;
                                *(GAS u32x4*)(Kb + (((size_t)bb * NKV + bj) * S + tt) * HD + cl) = PK8B(x0, x1); }
                        } } }
            } else {
                const int dl = 32 * (wc & 1) + 8 * fq;
                const f32x4 g0 = *(const GAS f32x4*)((const GAS float*)gki + dl), g1 = *(const GAS f32x4*)((const GAS float*)gki + dl + 4);
                GAS f16* KI = (GAS f16*)(ws + WS_KI); GAS float* WI = (GAS float*)(ws + WS_WI);
                ROWLOOP { asm volatile("" ::: "memory"); ROWVARS
                    const f32x4 p = *(const LAS f32x4*)(scr + (r * 2) * 4);
                    const float rs = rsqrtf((p[0] + p[1]) * (1.f / 64.f) + EPS);
                    f32x4 x0 = acc[ai][0][m][0] * rs * g0, x1 = acc[ai][0][m][1] * rs * g1;
                    f32x4 o0, o1; SHX4(o0, x0, 16); SHX4(o1, x1, 16);
                    if (wc == 0 && fq < 2) { const GAS f32x4* cp = (const GAS f32x4*)(ri + (slot * 8) * 2); const f32x4 t0_ = cp[0], t1_ = cp[1], t2_ = cp[2], t3_ = cp[3];
                        const f32x4 c0 = {t0_[0], t0_[2], t1_[0], t1_[2]}, s0 = {t0_[1], t0_[3], t1_[1], t1_[3]}, c1 = {t2_[0], t2_[2], t3_[0], t3_[2]}, s1 = {t2_[1], t2_[3], t3_[1], t3_[3]};
                        if (fq == 0) { x0 = x0 * c0 - o0 * s0; x1 = x1 * c1 - o1 * s1; } else { x0 = x0 * c0 + o0 * s0; x1 = x1 * c1 + o1 * s1; } }
                    if (wc < 2 && valid) {
                        GAS float* ko = smp ? out + O_KIS + (size_t)r * 64 + dl : out + O_KIP + (size_t)grow * 64 + dl;
                        *(GAS f32x4*)ko = x0; *(GAS f32x4*)(ko + 4) = x1;
                        if (!smp) *(GAS u32x4*)(KI + (size_t)grow * 64 + dl) = PK8H(x0, x1); }
                    if (wc == 2 && fq < 2 && valid) { GAS float* wo = WI + (size_t)grow * 16 + 8 * fq; *(GAS f32x4*)wo = acc[ai][0][m][0] * (1.f / 32.f); *(GAS f32x4*)(wo + 4) = acc[ai][0][m][1] * (1.f / 32.f); }
                }
            }
        } else if (pn == 5) {
            GAS bf16_t* Vb = (GAS bf16_t*)(ws + WS_VB);
            ROWLOOP { asm volatile("" ::: "memory"); ROWVARS
#pragma unroll
                for (int bj = 0; bj < 2; ++bj) { const f32x4 x0 = acc[ai][bj][m][0], x1 = acc[ai][bj][m][1];
                    if (smp) { if (valid) { GAS float* v = out + O_VS + (size_t)r * 256 + bj * 128 + cl; *(GAS f32x4*)v = x0; *(GAS f32x4*)(v + 4) = x1; } }
                    else { GAS float* v = out + O_VP + (size_t)grow * 256 + bj * 128 + cl; *(GAS f32x4*)v = x0; *(GAS f32x4*)(v + 4) = x1;
                        *(GAS u32x4*)(Vb + (((size_t)bb * NKV + bj) * S + tt) * HD + cl) = PK8B(x0, x1); } } }
        } else if (pn <= 9) {
            GAS f16* SZ = (GAS f16*)(ws + WS_SZ); const int c0 = 256 * (pn - 6) + cl;
            ROWLOOP { asm volatile("" ::: "memory"); ROWVARS
                if (valid) {
#pragma unroll
                    for (int bj = 0; bj < 2; ++bj) { const f32x4 a0 = acc[ai][bj][m][0], a1 = acc[ai][bj][m][1];
                        f32x4 z0, z1; z0[0] = silu(a0[0]); z0[1] = silu(a0[1]); z0[2] = silu(a0[2]); z0[3] = silu(a0[3]); z1[0] = silu(a1[0]); z1[1] = silu(a1[1]); z1[2] = silu(a1[2]); z1[3] = silu(a1[3]);
                        *(GAS u32x4*)(SZ + (size_t)grow * 1024 + c0 + 128 * bj) = PK8H(z0, z1); } } }
        } else if (pn <= 13) {
            GAS f16* QI = (GAS f16*)(ws + WS_QI); const int c0 = 256 * (pn - 10) + cl;
            ROWLOOP { asm volatile("" ::: "memory"); ROWVARS
                f32x4 c0v = {1.f, 1.f, 1.f, 1.f}, s0v = {0.f, 0.f, 0.f, 0.f}, c1v = c0v, s1v = s0v;
                const bool rp = (wc & 1) == 0;
                if (rp) { const GAS f32x4* cp = (const GAS f32x4*)(ri + (slot * 8) * 2); const f32x4 t0_ = cp[0], t1_ = cp[1], t2_ = cp[2], t3_ = cp[3];
                    c0v = (f32x4){t0_[0], t0_[2], t1_[0], t1_[2]}; s0v = (f32x4){t0_[1], t0_[3], t1_[1], t1_[3]}; c1v = (f32x4){t2_[0], t2_[2], t3_[0], t3_[2]}; s1v = (f32x4){t2_[1], t2_[3], t3_[1], t3_[3]}; }
#pragma unroll
                for (int bj = 0; bj < 2; ++bj) { f32x4 x0 = acc[ai][bj][m][0], x1 = acc[ai][bj][m][1];
                    f32x4 o0, o1; SHX4(o0, x0, 16); SHX4(o1, x1, 16);
                    if (rp && fq < 2) { if (fq == 0) { x0 = x0 * c0v - o0 * s0v; x1 = x1 * c1v - o1 * s1v; } else { x0 = x0 * c0v + o0 * s0v; x1 = x1 * c1v + o1 * s1v; } }
                    if (valid) *(GAS u32x4*)(QI + (size_t)grow * 1024 + c0 + 128 * bj) = PK8H(x0, x1); } }
        } else {
            GAS f16* UG = (GAS f16*)(ws + WS_U); const int ch = 64 * (pn - 15) + 16 * wc + 4 * fq;
            ROWLOOP { asm volatile("" ::: "memory"); ROWVARS
                const f32x4 h = acc[ai][0][m][0], b = acc[ai][0][m][1], c = acc[ai][1][m][0], z = acc[ai][1][m][1];
                const f32x4 uu = c * h; f32x4 gg; gg[0] = b[0] * silu(z[0]); gg[1] = b[1] * silu(z[1]); gg[2] = b[2] * silu(z[2]); gg[3] = b[3] * silu(z[3]);
                if (valid) { u32x4 w = {pk_f16(uu[0], uu[1]), pk_f16(uu[2], uu[3]), pk_f16(gg[0], gg[1]), pk_f16(gg[2], gg[3])};
                    *(GAS u32x4*)(UG + (size_t)grow * 2048 + 2 * ch) = w;
                    if (!smp && tt >= S - 2) *(GAS f32x4*)(out + O_CVP + ((size_t)bb * 2 + (tt - (S - 2))) * 1024 + ch) = uu;
                    if (smp && tt >= 2) *(GAS f32x4*)(out + O_CVS + ((size_t)(r >> 2) * 2 + (tt - 2)) * 1024 + ch) = uu; } }
        }
#undef ROWLOOP
#undef ROWVARS
#undef PK8B
#undef PK8H
#undef SHX4
    }
};


struct EpiOut {
    float* out; const float* xp;
    __device__ __forceinline__ bool aligned(const pg8::Unit&) const { return false; }
    __device__ __forceinline__ void init(f32x4 (&acc)[2][2][4][2], const pg8::Unit& u, int wr, int wc, int fr, int fq) const {
        const GAS float* xp = (const GAS float*)this->xp;
        const size_t base = (size_t)(u.pm * 256 + 64 * wr + fr) * DM + u.pn * 256 + 32 * wc + 4 * fq;
#pragma unroll
        for (int ai = 0; ai < 2; ++ai)
#pragma unroll
            for (int m = 0; m < 4; ++m)
#pragma unroll
                for (int bj = 0; bj < 2; ++bj)
#pragma unroll
                    for (int n = 0; n < 2; ++n) acc[ai][bj][m][n] = *(const GAS f32x4*)(xp + base + (size_t)(128 * ai + 16 * m) * DM + 128 * bj + 16 * n);
    }
    __device__ __forceinline__ void operator()(f32x4 (&acc)[2][2][4][2], const pg8::Unit& u, int wr, int wc, int fr_, int fq_) const {
        int fr = fr_, fq = fq_; asm volatile("" : "+v"(fr), "+v"(fq));
        GAS float* out = (GAS float*)this->out; asm volatile("" : "+s"(out));
        const size_t base = (size_t)(u.pm * 256 + 64 * wr + fr) * DM + u.pn * 256 + 32 * wc + 4 * fq;
#pragma unroll
        for (int ai = 0; ai < 2; ++ai)
#pragma unroll
            for (int m = 0; m < 4; ++m) { const size_t off = base + (size_t)(128 * ai + 16 * m) * DM;
#pragma unroll
                for (int bj = 0; bj < 2; ++bj)
#pragma unroll
                    for (int n = 0; n < 2; ++n) *(GAS f32x4*)(out + off + 128 * bj + 16 * n) = acc[ai][bj][m][n]; }
    }
};
__device__ __forceinline__ void p4_sample(const Args& a, LAS unsigned char* lds, int bx, int G, int tid) {
    const GAS f16* MIX = (const GAS f16*)(a.ws + WS_MIX) + (size_t)MP * DM; const GAS f16* WT = (const GAS f16*)(a.ws + WS_WOUTT);
    LAS float* part = (LAS float*)lds;
    const int lane = tid & 63, wave = __builtin_amdgcn_readfirstlane(tid >> 6), fr = lane & 15, fq = lane >> 4;
    for (int cg = bx; cg < DM / 8; cg += G) {
        const GAS f16* wp = WT + (size_t)(cg * 8 + (fr & 7)) * DM + wave * 256 + 8 * fq; const GAS f16* mp = MIX + (size_t)fr * DM + wave * 256 + 8 * fq;
        f16x8 wf[8], m0[8], m1[8];
#pragma unroll
        for (int ks = 0; ks < 8; ++ks) { wf[ks] = *(const GAS f16x8*)(wp + 32 * ks); m0[ks] = *(const GAS f16x8*)(mp + 32 * ks); m1[ks] = *(const GAS f16x8*)(mp + (size_t)16 * DM + 32 * ks); }
        f32x4 c0 = {0.f, 0.f, 0.f, 0.f}, c1 = {0.f, 0.f, 0.f, 0.f};
#pragma unroll
        for (int ks = 0; ks < 8; ++ks) { c0 = __builtin_amdgcn_mfma_f32_16x16x32_f16(wf[ks], m0[ks], c0, 0, 0, 0); c1 = __builtin_amdgcn_mfma_f32_16x16x32_f16(wf[ks], m1[ks], c1, 0, 0, 0); }
        *(LAS f32x4*)(part + ((wave * 2 + 0) * 64 + lane) * 4) = c0; *(LAS f32x4*)(part + ((wave * 2 + 1) * 64 + lane) * 4) = c1;
        __syncthreads();
        if (tid < 256) { const int rr = tid >> 3, cc = tid & 7; const int ln = (rr & 15) + 16 * (cc >> 2), tl = rr >> 4; float s = a.in[1][(size_t)rr * DM + cg * 8 + cc];
#pragma unroll
            for (int w = 0; w < 8; ++w) s += part[((w * 2 + tl) * 64 + ln) * 4 + (cc & 3)];
            a.out[O_YS + (size_t)rr * DM + cg * 8 + cc] = s; }
        __syncthreads();
    }
}
typedef GAS unsigned gu32;
#define XB_TMO      128
#define XB_XCNT(j)  (256  + 64 * (j))
#define XB_XSUB(j)  (1280 + 64 * (j))
#define XB_XGEN(j)  (2304 + 64 * (j))
#define XB_TOP      3328
#define XB_TOPGEN   3392
#define XCD_BAR_WORDS 3456
#define XB_SPIN_CAP (1u << 18)
__device__ __forceinline__ unsigned xb_ld(unsigned* p)              { return __hip_atomic_load(p, __ATOMIC_RELAXED, __HIP_MEMORY_SCOPE_AGENT); }
__device__ __forceinline__ unsigned xb_add(unsigned* p, unsigned v) { return __hip_atomic_fetch_add(p, v, __ATOMIC_RELAXED, __HIP_MEMORY_SCOPE_AGENT); }
__device__ __forceinline__ unsigned xb_xcc_id() { return (unsigned)__builtin_amdgcn_s_getreg((3 << 11) | 20) & 0xFu; }
#define XB_SPIN(cond, bar) do { unsigned _sp = 0; while (cond) { __builtin_amdgcn_s_sleep(1); \
    if ((++_sp & 255u) == 0u) { if (xb_ld(&(bar)[XB_TMO])) break; if (_sp > XB_SPIN_CAP) { atomicAdd(&(bar)[XB_TMO], 1u); break; } } } } while (0)
struct XcdBarrier { unsigned* bar; unsigned x; volatile LAS unsigned* st; };
__device__ __forceinline__ XcdBarrier xcd_barrier_post(unsigned* bar, volatile LAS unsigned* st) {
    XcdBarrier b; b.bar = bar; b.x = xb_xcc_id(); b.st = st;
    if (threadIdx.x == 0) (void)xb_add(&bar[XB_XCNT(b.x)], 1u);
    return b;
}
__device__ __forceinline__ void xcd_barrier_complete(unsigned* bar, unsigned x, unsigned& nloc, unsigned& nx) {
    const unsigned G = gridDim.x * gridDim.y * gridDim.z;
    unsigned sum, cnt, mine, sp = 0u;
    for (;;) {
        sum = 0u; cnt = 0u; mine = 0u;
#pragma unroll
        for (unsigned j = 0; j < 16; ++j) { const unsigned c = xb_ld(&bar[XB_XCNT(j)]); sum += c; cnt += (c > 0u) ? 1u : 0u; mine = (j == x) ? c : mine; }
        if (sum == G) break;
        __builtin_amdgcn_s_sleep(1);
        if ((++sp & 255u) == 0u) { if (xb_ld(&bar[XB_TMO])) break; if (sp > XB_SPIN_CAP) { atomicAdd(&bar[XB_TMO], 1u); break; } }
    }
    nloc = mine > 0u ? mine : 1u; nx = cnt > 0u ? cnt : 1u;
}
__device__ __forceinline__ void xcd_barrier(const XcdBarrier& b) {
    asm volatile("s_waitcnt vmcnt(0)" ::: "memory");
    __syncthreads();
    if (threadIdx.x == 0) {
        unsigned* bar = b.bar;
        __builtin_amdgcn_s_waitcnt(0);
        unsigned nloc = b.st[0], nx = b.st[1];
        if (nloc == 0u) { xcd_barrier_complete(bar, b.x, nloc, nx); b.st[0] = nloc; b.st[1] = nx; }
        const unsigned old = xb_add(&bar[XB_XSUB(b.x)], 1u);
        const unsigned gen = old / nloc;
        if (old + 1u == (gen + 1u) * nloc) {
            __builtin_amdgcn_fence(__ATOMIC_RELEASE, "agent");
            asm volatile("s_waitcnt vmcnt(0)" ::: "memory");
            const unsigned og = xb_add(&bar[XB_TOP], 1u);
            const unsigned tg = og / nx;
            if (og + 1u == (tg + 1u) * nx) xb_add(&bar[XB_TOPGEN], 1u);
            else XB_SPIN(xb_ld(&bar[XB_TOPGEN]) == tg, bar);
            __builtin_amdgcn_fence(__ATOMIC_ACQUIRE, "agent");
            xb_add(&bar[XB_XGEN(b.x)], 1u);
            asm volatile("s_waitcnt vmcnt(0)" ::: "memory");
        } else {
            XB_SPIN(xb_ld(&bar[XB_XGEN(b.x)]) == gen, bar);
            __builtin_amdgcn_fence(__ATOMIC_ACQUIRE, "agent");
            asm volatile("s_waitcnt vmcnt(0)" ::: "memory");
        }
    }
    __syncthreads();
}

constexpr int RDY_WORD0 = 4096;
__device__ __forceinline__ void signal_add(unsigned* ctr) {
    asm volatile("s_waitcnt vmcnt(0)" ::: "memory");
    __syncthreads();
    if (threadIdx.x == 0) { __builtin_amdgcn_fence(__ATOMIC_RELEASE, "agent"); asm volatile("s_waitcnt vmcnt(0)" ::: "memory"); (void)xb_add(ctr, 1u); }
}
__device__ __forceinline__ void wait_ge(unsigned* ctr, unsigned need) {
    if (threadIdx.x == 0) { unsigned sp = 0; while (xb_ld(ctr) < need) { __builtin_amdgcn_s_sleep(2); if (++sp > (1u << 22)) break; }
        __builtin_amdgcn_fence(__ATOMIC_ACQUIRE, "agent"); asm volatile("s_waitcnt vmcnt(0)" ::: "memory"); }
    __syncthreads();
}

__device__ __forceinline__ void signal_add_wt(unsigned* ctr) {
    asm volatile("s_waitcnt vmcnt(0)" ::: "memory");
    __syncthreads();
    if (threadIdx.x == 0) (void)xb_add(ctr, 1u);
}
__device__ __forceinline__ void wait_ge_wt(unsigned* ctr, unsigned need) {
    if (threadIdx.x == 0) { unsigned sp = 0; while (xb_ld(ctr) < need) { __builtin_amdgcn_s_sleep(2); if (++sp > (1u << 22)) break; } }
    __syncthreads();
}

#ifndef P2_KT_REP
#define P2_KT_REP 1
#define P2_SEL_REP 1
#endif
#ifndef P2_REP_A
#define P2_REP_A 1
#define P2_REP_B 1
#define P2_REP_C 1
#endif
constexpr int SC_STRIDE = 2052;
constexpr int SC_BYTES = 16 * SC_STRIDE * 4;
constexpr int WSCR_OFF = 131584, WSCR_BYTES = 1536;
__device__ __forceinline__ f16x8 cvt8(f32x4 a, f32x4 b) { u32x4 w = {pk_f16(a[0], a[1]), pk_f16(a[2], a[3]), pk_f16(b[0], b[1]), pk_f16(b[2], b[3])}; return __builtin_bit_cast(f16x8, w); }

__device__ __forceinline__ void p2_convmix(const Args& a, int gw, int NGW, int lane) {
    const GAS f16* UG = (const GAS f16*)(a.ws + WS_U); GAS f16* MIX = (GAS f16*)(a.ws + WS_MIX);
    const GAS float* wconv = (const GAS float*)a.in[12]; const GAS float* state = (const GAS float*)a.in[5];
    for (int ch = gw; ch < MT / 4; ch += NGW) {
        const int row0 = 4 * ch; const bool smp = row0 >= MP; const int t0 = smp ? 0 : (row0 & (S - 1)); const int seq = (row0 - MP) >> 2;
#pragma unroll
        for (int half = 0; half < 2; ++half) { const int cb = half * 512 + 8 * lane;
            float um2[8], um1[8], w0[8], w1[8], w2[8];
#pragma unroll
            for (int e = 0; e < 8; e += 4) { const f32x4 a0 = *(const GAS f32x4*)(wconv + cb + e), a1 = *(const GAS f32x4*)(wconv + 1024 + cb + e), a2 = *(const GAS f32x4*)(wconv + 2048 + cb + e);
#pragma unroll
                for (int i = 0; i < 4; ++i) { w0[e + i] = a0[i]; w1[e + i] = a1[i]; w2[e + i] = a2[i]; } }
            if (t0 == 0) {
                if (smp) {
#pragma unroll
                    for (int e = 0; e < 8; e += 4) { const f32x4 s0 = *(const GAS f32x4*)(state + ((size_t)seq * 2) * 1024 + cb + e), s1 = *(const GAS f32x4*)(state + ((size_t)seq * 2 + 1) * 1024 + cb + e);
#pragma unroll
                        for (int i = 0; i < 4; ++i) { um2[e + i] = s0[i]; um1[e + i] = s1[i]; } }
                } else {
#pragma unroll
                    for (int e = 0; e < 8; ++e) { um2[e] = 0.f; um1[e] = 0.f; } }
            } else {
#pragma unroll
                for (int gq = 0; gq < 2; ++gq) { const f16x4 p2 = *(const GAS f16x4*)(UG + (size_t)(row0 - 2) * 2048 + 2 * cb + 8 * gq), p1 = *(const GAS f16x4*)(UG + (size_t)(row0 - 1) * 2048 + 2 * cb + 8 * gq);
#pragma unroll
                    for (int e = 0; e < 4; ++e) { um2[4 * gq + e] = (float)p2[e]; um1[4 * gq + e] = (float)p1[e]; } } }
#pragma unroll
            for (int i = 0; i < 4; ++i) { const size_t row = row0 + i;
                const f16x8 x0 = *(const GAS f16x8*)(UG + row * 2048 + 2 * cb), x1 = *(const GAS f16x8*)(UG + row * 2048 + 2 * cb + 8); float o[8];
#pragma unroll
                for (int e = 0; e < 8; ++e) { const float u = (float)(e < 4 ? x0[e] : x1[e - 4]); const float g = (float)(e < 4 ? x0[4 + e] : x1[e]);
                    const float cv = w0[e] * um2[e] + w1[e] * um1[e] + w2[e] * u; o[e] = g * cv; um2[e] = um1[e]; um1[e] = u; }
                u32x4 w = {pk_f16(o[0], o[1]), pk_f16(o[2], o[3]), pk_f16(o[4], o[5]), pk_f16(o[6], o[7])};
                *(GAS u32x4*)(MIX + row * 2048 + 1024 + cb) = w; }
        }
    }
}

__device__ __forceinline__ void p2_sscore(const Args& a, int gw, int NGW, int lane) {
    const GAS float* cki = (const GAS float*)a.in[4]; const GAS int* ptab = (const GAS int*)a.in[6];
    const GAS f16* QI = (const GAS f16*)(a.ws + WS_QI); const GAS float* WI = (const GAS float*)(a.ws + WS_WI); GAS float* SSC = (GAS float*)(a.ws + WS_SSC);
    const int fr = lane & 15, fq = lane >> 4;
    for (int it = gw; it < NSB * 256; it += NGW) {
        const int sb = it >> 8, hp = it & 255, pg = hp >> 1, k0 = (hp & 1) * 64; const int phys = ptab[sb * NPAGES + pg];
        const GAS float* kbase = cki + ((size_t)phys * PAGE + k0) * 64;
        f16x8 qf[4][2]; f32x4 wv[4];
#pragma unroll
        for (int t = 0; t < 4; ++t) { const size_t row = MP + 4 * sb + t;
            qf[t][0] = *(const GAS f16x8*)(QI + row * 1024 + fr * 64 + 8 * fq); qf[t][1] = *(const GAS f16x8*)(QI + row * 1024 + fr * 64 + 32 + 8 * fq);
            wv[t] = *(const GAS f32x4*)(WI + row * 16 + 4 * fq); }
#pragma unroll
        for (int tile = 0; tile < 4; ++tile) {
            const GAS float* kr = kbase + (size_t)(16 * tile + fr) * 64 + 8 * fq;
            const f16x8 kf0 = cvt8(*(const GAS f32x4*)kr, *(const GAS f32x4*)(kr + 4)), kf1 = cvt8(*(const GAS f32x4*)(kr + 32), *(const GAS f32x4*)(kr + 36));
            float mine = 0.f;
#pragma unroll
            for (int t = 0; t < 4; ++t) { f32x4 c = {0.f, 0.f, 0.f, 0.f};
                c = __builtin_amdgcn_mfma_f32_16x16x32_f16(qf[t][0], kf0, c, 0, 0, 0); c = __builtin_amdgcn_mfma_f32_16x16x32_f16(qf[t][1], kf1, c, 0, 0, 0);
                float s = wv[t][0] * fmaxf(c[0], 0.f) + wv[t][1] * fmaxf(c[1], 0.f) + wv[t][2] * fmaxf(c[2], 0.f) + wv[t][3] * fmaxf(c[3], 0.f);
                s += __shfl_xor(s, 16); s += __shfl_xor(s, 32);
                mine = fq == t ? s : mine; }
            __hip_atomic_store((GAS unsigned*)SSC + ((size_t)(4 * sb + fq) * PAST + pg * PAGE + k0 + 16 * tile + fr), __builtin_bit_cast(unsigned, mine), __ATOMIC_RELAXED, __HIP_MEMORY_SCOPE_AGENT);
        }
    }
}

__device__ __forceinline__ void wave_topk_mask(const LAS float* row, int t, GAS unsigned long long* mrow, int lane, LAS unsigned* hist, LAS float* cand) {
    const float NINF = -__builtin_inff(), PINF = __builtin_inff();
    const int jmax = t >> 6;
    const bool lastok = 64 * jmax + lane <= t;
    float v[32]; float mx = NINF, mn = PINF;
#pragma unroll
    for (int j = 0; j < 32; ++j) { v[j] = NINF;
        if (j < jmax) { v[j] = row[64 * j + lane]; mx = fmaxf(mx, v[j]); mn = fminf(mn, v[j]); }
        else if (j == jmax) { const float x = row[64 * j + lane]; v[j] = lastok ? x : NINF; mx = fmaxf(mx, v[j]); mn = fminf(mn, lastok ? x : PINF); } }
#pragma unroll
    for (int o = 1; o < 64; o <<= 1) { mx = fmaxf(mx, __shfl_xor(mx, o)); mn = fminf(mn, __shfl_xor(mn, o)); }
    *(LAS u32x4*)(hist + 4 * lane) = (u32x4){0u, 0u, 0u, 0u};
    const float scale = 255.5f / (mx - mn);
    float tau = 0.f; bool have = false;
    if (mx > mn) {
        asm volatile("s_waitcnt lgkmcnt(0)" ::: "memory");
        unsigned bins[8];
#pragma unroll
        for (int j = 0; j < 8; ++j) bins[j] = 0u;
#pragma unroll
        for (int j = 0; j < 32; ++j) {
            if (j < jmax) { const unsigned b = (unsigned)((v[j] - mn) * scale); bins[j >> 2] |= b << (8 * (j & 3)); __hip_atomic_fetch_add(hist + b, 1u, __ATOMIC_RELAXED, __HIP_MEMORY_SCOPE_WORKGROUP); }
            else if (j == jmax) { const unsigned b = lastok ? (unsigned)((v[j] - mn) * scale) : 0u; bins[j >> 2] |= b << (8 * (j & 3)); if (lastok) __hip_atomic_fetch_add(hist + b, 1u, __ATOMIC_RELAXED, __HIP_MEMORY_SCOPE_WORKGROUP); } }
        asm volatile("s_waitcnt lgkmcnt(0)" ::: "memory");
        const u32x4 h = *(const LAS u32x4*)(hist + 4 * lane);
        const unsigned sl = h[0] + h[1] + h[2] + h[3]; unsigned pre = sl;
#pragma unroll
        for (int o = 1; o < 64; o <<= 1) { const unsigned y = __shfl_up(pre, o); if (lane >= o) pre += y; }
        const unsigned tot = __builtin_amdgcn_readlane(pre, 63); const unsigned suf = tot - pre + sl;
        const unsigned long long bm = __ballot(suf >= TOPK);
        const int Ls = 63 - __builtin_clzll(bm);
        unsigned c = __builtin_amdgcn_readlane(suf, Ls) - __builtin_amdgcn_readlane(sl, Ls);
        const unsigned h3 = __builtin_amdgcn_readlane(h[3], Ls), h2 = __builtin_amdgcn_readlane(h[2], Ls), h1 = __builtin_amdgcn_readlane(h[1], Ls);
        int Bs;
        if (c + h3 >= TOPK) Bs = 4 * Ls + 3; else { c += h3; if (c + h2 >= TOPK) Bs = 4 * Ls + 2; else { c += h2; if (c + h1 >= TOPK) Bs = 4 * Ls + 1; else { c += h1; Bs = 4 * Ls; } } }
        const int need = TOPK - (int)c;
        int base = 0;
#pragma unroll
        for (int j = 0; j < 32; ++j) { if (j <= jmax) { const int b = (int)((bins[j >> 2] >> (8 * (j & 3))) & 255u); const bool isc = (j < jmax || lastok) && b == Bs;
            const unsigned long long m = __ballot(isc);
            if (m) { const int pos = base + (int)__builtin_amdgcn_mbcnt_hi((unsigned)(m >> 32), __builtin_amdgcn_mbcnt_lo((unsigned)m, 0u)); if (isc && pos < 64) cand[pos] = v[j]; base += __builtin_popcountll(m); } } }
        if (base <= 64) {
            asm volatile("s_waitcnt lgkmcnt(0)" ::: "memory");
            const float x = lane < base ? cand[lane] : NINF; int rank = 0;
            for (int m = 0; m < base; ++m) { const float y = __builtin_bit_cast(float, __builtin_amdgcn_readlane(__builtin_bit_cast(int, x), m)); rank += y > x ? 1 : 0; }
            float tc = (lane < base && rank <= need - 1) ? x : PINF;
#pragma unroll
            for (int o = 1; o < 64; o <<= 1) tc = fminf(tc, __shfl_xor(tc, o));
            tau = tc; have = true;
        }
    }
    if (!have) {
        unsigned tk = 0u;
        for (int bit = 31; bit >= 0; --bit) { const unsigned cd = tk | (1u << bit); int cnt = 0;
#pragma unroll
            for (int j = 0; j < 32; ++j) cnt += __builtin_popcountll(__ballot((64 * j + lane <= t) && fkey(v[j]) >= cd));
            if (cnt >= TOPK) tk = cd; }
        tau = __builtin_bit_cast(float, (tk & 0x80000000u) ? (tk ^ 0x80000000u) : ~tk);
    }
    unsigned wlo = 0u, whi = 0u;
#pragma unroll
    for (int j = 0; j < 32; ++j) { if (j <= jmax) { const unsigned long long m = __ballot(v[j] >= tau);
        if (lane == j) { wlo = (unsigned)m; whi = (unsigned)(m >> 32); } } }
    if (lane < 32) __hip_atomic_store(mrow + lane, ((unsigned long long)whi << 32) | wlo, __ATOMIC_RELAXED, __HIP_MEMORY_SCOPE_AGENT);
}

#define RELU_FMA(acc_, c_, w_) do { const float f_ = (c_); const int i_ = __builtin_bit_cast(int, f_); const float r_ = __builtin_bit_cast(float, i_ > 0 ? i_ : 0); asm("v_fmac_f32_e32 %0, %1, %2" : "+v"(acc_) : "v"(r_), "v"(w_)); } while (0)
__device__ __forceinline__ void p2_index_tile(const Args& a, LAS unsigned char* lds, int b, int t0, int wave, int lane) {
    const GAS f16* QI = (const GAS f16*)(a.ws + WS_QI); const GAS float* WI = (const GAS float*)(a.ws + WS_WI); const GAS f16* KI = (const GAS f16*)(a.ws + WS_KI);
    GAS unsigned long long* MASK = (GAS unsigned long long*)(a.ws + WS_MASK);
    LAS float* sc = (LAS float*)lds;
    const int fr = lane & 15, fq = lane >> 4; const size_t rowq = (size_t)b * S + t0 + fr;
    f16x8 qf[16][2]; float w[16];
#pragma unroll
    for (int h = 0; h < 16; ++h) { qf[h][0] = *(const GAS f16x8*)(QI + rowq * 1024 + h * 64 + 8 * fq); qf[h][1] = *(const GAS f16x8*)(QI + rowq * 1024 + h * 64 + 32 + 8 * fq); }
#pragma unroll
    for (int h = 0; h < 16; h += 4) { const f32x4 x = *(const GAS f32x4*)(WI + rowq * 16 + h); w[h] = x[0]; w[h + 1] = x[1]; w[h + 2] = x[2]; w[h + 3] = x[3]; }
    const int nkt = (t0 + 16) >> 4;
    const GAS f16* kp = KI + ((size_t)b * S + fr) * 64 + 8 * fq;
#define KLOAD(d0_, d1_, kt_) do { const int k_ = (kt_) < nkt ? (kt_) : wave; d0_ = *(const GAS f16x8*)(kp + (size_t)k_ * 1024); d1_ = *(const GAS f16x8*)(kp + (size_t)k_ * 1024 + 32); } while (0)
    f16x8 ka0, ka1, kb0, kb1, kc0, kc1;
#define KCOMP(kf0, kf1, kt_) do { float a0 = 0.f, a1 = 0.f, a2 = 0.f, a3 = 0.f; const f32x4 z4 = {0.f, 0.f, 0.f, 0.f}; \
        f32x4 cc = __builtin_amdgcn_mfma_f32_16x16x32_f16(kf0, qf[0][0], z4, 0, 0, 0); cc = __builtin_amdgcn_mfma_f32_16x16x32_f16(kf1, qf[0][1], cc, 0, 0, 0); \
        _Pragma("unroll") for (int h = 0; h < 16; ++h) { f32x4 cn = z4;        \
            if (h < 15) { cn = __builtin_amdgcn_mfma_f32_16x16x32_f16(kf0, qf[h + 1][0], z4, 0, 0, 0); cn = __builtin_amdgcn_mfma_f32_16x16x32_f16(kf1, qf[h + 1][1], cn, 0, 0, 0); } \
            RELU_FMA(a0, cc[0], w[h]); RELU_FMA(a1, cc[1], w[h]); RELU_FMA(a2, cc[2], w[h]); RELU_FMA(a3, cc[3], w[h]); \
            cc = cn; __builtin_amdgcn_sched_barrier(0); } \
        *(LAS f32x4*)(sc + fr * SC_STRIDE + 16 * (kt_) + 4 * fq) = (f32x4){a0, a1, a2, a3}; } while (0)
    KLOAD(ka0, ka1, wave); KLOAD(kb0, kb1, wave + NWAVES);
    for (int rpk = 0; rpk < P2_KT_REP; ++rpk)
    for (int kt = wave; kt < nkt; kt += 3 * NWAVES) {
        KLOAD(kc0, kc1, kt + 2 * NWAVES); KCOMP(ka0, ka1, kt);
        if (kt + NWAVES < nkt) { KLOAD(ka0, ka1, kt + 3 * NWAVES); KCOMP(kb0, kb1, kt + NWAVES); }
        if (kt + 2 * NWAVES < nkt) { KLOAD(kb0, kb1, kt + 4 * NWAVES); KCOMP(kc0, kc1, kt + 2 * NWAVES); }
    }
#undef KCOMP
#undef KLOAD
    __syncthreads();
#pragma unroll 1
    for (int qq = 0; qq < 2 * P2_SEL_REP; ++qq) { const int q = 2 * wave + (qq & 1); const int t = t0 + q;
        wave_topk_mask(sc + q * SC_STRIDE, t, MASK + ((size_t)b * S + t) * 32, lane, (LAS unsigned*)(lds + WSCR_OFF + wave * WSCR_BYTES), (LAS float*)(lds + WSCR_OFF + wave * WSCR_BYTES + 1024)); }
    __syncthreads();
}

__device__ __forceinline__ void p2_phase(const Args& a, LAS unsigned char* lds, int vcu, int G, int wave, int lane) {
    const int gw = vcu * NWAVES + wave, NGW = G * NWAVES;
    unsigned* rdy = (unsigned*)a.ws + RDY_WORD0;
    for (int rp = 0; rp < P2_REP_A; ++rp) p2_sscore(a, gw, NGW, lane);
    signal_add_wt(rdy + 64 * 32);
    { GAS unsigned long long* MASK = (GAS unsigned long long*)(a.ws + WS_MASK);
      for (int i = gw * 64 + lane; i < NB * TOPK * 32; i += NGW * 64) { const int wd = i & 31, t = (i >> 5) & (TOPK - 1), b = i >> 13; const int lo = 64 * wd;
          const unsigned long long m = lo + 63 <= t ? ~0ull : (lo > t ? 0ull : ((1ull << (t - lo + 1)) - 1ull));
          __hip_atomic_store(MASK + ((size_t)b * S + t) * 32 + wd, m, __ATOMIC_RELAXED, __HIP_MEMORY_SCOPE_AGENT); } }
    signal_add_wt(rdy + 64 * 33);
    constexpr int NT = NB * (S - TOPK) / 16;
    for (int rp = 0; rp < P2_REP_C; ++rp)
    for (int r = 0; r * G < NT; ++r) { const int k = (r & 1) ? (r + 1) * G - 1 - vcu : r * G + vcu;
        if (k < NT) { const int j = (NT / NB - 1) - (k >> 2), b = k & 3; p2_index_tile(a, lds, b, TOPK + 16 * j, wave, lane);
            if (rp == 0) signal_add_wt(rdy + 64 * (40 + b * 32 + ((TOPK + 16 * j) >> 6))); } }
}

#ifndef P3_REP_S
#define P3_REP_S 1
#define P3_REP_A 1
#endif
namespace att {
typedef short bf16x8 __attribute__((ext_vector_type(8)));
typedef short s16x4 __attribute__((ext_vector_type(4)));
typedef float f32x16 __attribute__((ext_vector_type(16)));
constexpr int QBLK = 32, KVBLK = 64, D = 128;
constexpr int SHM_V = KVBLK * D * 2, SHM_K = KVBLK * D * 2;
constexpr int WS_OFF = 2 * SHM_V + 2 * SHM_K;
constexpr float SCALE = 0.08838834764831845f;
#define KSWZ(row, colB) ((row) * 256 + ((colB) ^ (((row) & 7) << 4)))
#define SBAR() __builtin_amdgcn_sched_barrier(0)
__device__ __forceinline__ int v_st(int k, int c) { const int kk = (k & ~0xC) | ((k & 4) << 1) | ((k & 8) >> 1); return ((kk >> 3) * 4 + (c >> 5)) * 512 + ((kk & 7) * 32 + (c & 31)) * 2; }
__device__ __forceinline__ int v_rd_base(int lane) { return ((lane & 3) << 3) | (((lane >> 2) & 3) << 6) | (((lane >> 4) & 1) << 5) | (((lane >> 5) & 1) << 8); }
constexpr int v_rd_off(int d0, int ks, int half) { return d0 * 512 + ks * 4096 + half * 2048; }
__device__ __forceinline__ int crow(int r, int hi) { return (r & 3) + 8 * (r >> 2) + 4 * hi; }
__device__ __forceinline__ unsigned cvtpk(float lo, float hi) { return pk_bf16(lo, hi); }

template <int KB>
__device__ __forceinline__ void qkt(f32x16& p0, f32x16& p1, const LAS unsigned char* K_lds, int r32, int hi, const LAS unsigned char* qp) {
    p0 = f32x16{}; p1 = f32x16{};
    const LAS unsigned char* kb[4];
#pragma unroll
    for (int dd = 0; dd < 4; ++dd) kb[dd] = K_lds + KB * SHM_K + KSWZ(r32, (dd * 16 + hi * 8) * 2);
#pragma unroll
    for (int d0 = 0; d0 < 8; ++d0) { const LAS unsigned char* a = kb[d0 & 3] + (d0 >> 2) * 128;
        const bf16x8 b0 = *(const LAS bf16x8*)a;
        const bf16x8 b1 = *(const LAS bf16x8*)(a + 32 * 256);
        const bf16x8 qv = *(const LAS bf16x8*)(qp + d0 * 1024);
        p0 = __builtin_amdgcn_mfma_f32_32x32x16_bf16(b0, qv, p0, 0, 0, 0);
        p1 = __builtin_amdgcn_mfma_f32_32x32x16_bf16(b1, qv, p1, 0, 0, 0); }
}
template <int VB>
__device__ __forceinline__ void pv_tile(f32x16* o, int vb0, bf16x8 pa0, bf16x8 pa1, bf16x8 pa2, bf16x8 pa3) {
#define TRRD(dst, off) asm volatile("ds_read_b64_tr_b16 %0, %1 offset:%2" : "=&v"(dst) : "v"(vb0), "i"(off) : "memory")
#define PV_D0(d0) do { s16x4 l0, l1, l2, l3, h0, h1, h2, h3; constexpr int b_ = VB * SHM_V + v_rd_off(d0, 0, 0); \
        TRRD(l0, b_); TRRD(h0, b_ + 2048); TRRD(l1, b_ + 4096); TRRD(h1, b_ + 6144); TRRD(l2, b_ + 8192); TRRD(h2, b_ + 10240); TRRD(l3, b_ + 12288); TRRD(h3, b_ + 14336); \
        asm volatile("s_waitcnt lgkmcnt(0)" ::: "memory"); SBAR(); \
        o[d0] = __builtin_amdgcn_mfma_f32_32x32x16_bf16(pa0, (bf16x8){l0[0], l0[1], l0[2], l0[3], h0[0], h0[1], h0[2], h0[3]}, o[d0], 0, 0, 0); \
        o[d0] = __builtin_amdgcn_mfma_f32_32x32x16_bf16(pa1, (bf16x8){l1[0], l1[1], l1[2], l1[3], h1[0], h1[1], h1[2], h1[3]}, o[d0], 0, 0, 0); \
        o[d0] = __builtin_amdgcn_mfma_f32_32x32x16_bf16(pa2, (bf16x8){l2[0], l2[1], l2[2], l2[3], h2[0], h2[1], h2[2], h2[3]}, o[d0], 0, 0, 0); \
        o[d0] = __builtin_amdgcn_mfma_f32_32x32x16_bf16(pa3, (bf16x8){l3[0], l3[1], l3[2], l3[3], h3[0], h3[1], h3[2], h3[3]}, o[d0], 0, 0, 0); } while (0)
    PV_D0(0); PV_D0(1); PV_D0(2); PV_D0(3);
#undef PV_D0
#undef TRRD
}
__device__ __forceinline__ void partialSM(f32x16& p0, f32x16& p1, unsigned wl, unsigned wh, float sh2) {
    const float NEG = -__builtin_inff(); constexpr float C2 = 1.4426950408889634f * SCALE;
#pragma unroll
    for (int r = 0; r < 16; ++r) { const unsigned bit = 1u << ((r & 3) + 8 * (r >> 2));
        p0[r] = (wl & bit) ? fmaf(p0[r], C2, -sh2) : NEG; p1[r] = (wh & bit) ? fmaf(p1[r], C2, -sh2) : NEG; }
#pragma unroll
    for (int r = 0; r < 16; ++r) p0[r] = __builtin_amdgcn_exp2f(p0[r]);
}
__device__ __forceinline__ void finishSM(f32x16& p0, f32x16& p1, float& l_reg, bf16x8& pa0, bf16x8& pa1, bf16x8& pa2, bf16x8& pa3) {
#pragma unroll
    for (int r = 0; r < 16; ++r) p1[r] = __builtin_amdgcn_exp2f(p1[r]);
    float ps = 0;
#pragma unroll
    for (int r = 0; r < 16; ++r) ps += p0[r];
#pragma unroll
    for (int r = 0; r < 16; ++r) ps += p1[r];
    l_reg += ps;
#define PK4(P, B_, OUT) do { unsigned a0 = cvtpk(P[B_+0], P[B_+1]), a1 = cvtpk(P[B_+2], P[B_+3]); \
        unsigned b0 = cvtpk(P[B_+4], P[B_+5]), b1 = cvtpk(P[B_+6], P[B_+7]); \
        auto r0 = __builtin_amdgcn_permlane32_swap(a0, b0, false, false); auto r1 = __builtin_amdgcn_permlane32_swap(a1, b1, false, false); \
        u32x4 w = {r0[0], r1[0], r0[1], r1[1]}; OUT = __builtin_bit_cast(bf16x8, w); } while (0)
    PK4(p0, 0, pa0); PK4(p0, 8, pa1); PK4(p1, 0, pa2); PK4(p1, 8, pa3);
#undef PK4
}

__device__ __forceinline__ __amdgpu_buffer_rsrc_t mk_rsrc(const GAS void* p, unsigned bytes) {
    const unsigned long long u = (unsigned long long)p; const unsigned lo = __builtin_amdgcn_readfirstlane((unsigned)u), hi = __builtin_amdgcn_readfirstlane((unsigned)(u >> 32));
    return __builtin_amdgcn_make_buffer_rsrc((void*)(((unsigned long long)hi << 32) | lo), (short)0, (int)bytes, 0x00020000);
}
__device__ __forceinline__ void attn_block(const Args& a, LAS unsigned char* lds, int b, int kvh, int q0, float sh2) {
    int tid_ = threadIdx.x; asm volatile("" : "+v"(tid_));
    const int tid = tid_, wid = __builtin_amdgcn_readfirstlane(tid >> 6), lane = tid & 63, r32 = lane & 31, hi = lane >> 5;
    const int head = 4 * kvh + (wid >> 1), qw = q0 + 32 * (wid & 1);
    const GAS bf16_t* Qw = (const GAS bf16_t*)(a.ws + WS_QB) + (((size_t)b * NH + head) * S + qw) * D;
    const GAS bf16_t* Kh = (const GAS bf16_t*)(a.ws + WS_KB) + ((size_t)b * NKV + kvh) * S * D;
    const GAS bf16_t* Vh = (const GAS bf16_t*)(a.ws + WS_VB) + ((size_t)b * NKV + kvh) * S * D;
    const __amdgpu_buffer_rsrc_t rK = mk_rsrc(Kh, S * D * 2), rV = mk_rsrc(Vh, S * D * 2), rM = mk_rsrc((const GAS unsigned long long*)(a.ws + WS_MASK) + ((size_t)b * S + qw) * 32, 32 * 256);
    const unsigned moff = (unsigned)r32 * 256u;
    const int NT = q0 / KVBLK + 1;
    LAS unsigned char* V_lds = lds; LAS unsigned char* K_lds = lds + 2 * SHM_V;
    const int sr = tid >> 4, sc = (tid & 15) * 8, vst0 = v_st(sr, sc), vst1 = v_st(32 + sr, sc), kws = KSWZ(sr, sc * 2);
    const int vb0 = (int)(unsigned)(size_t)V_lds + v_rd_base(lane); const unsigned kvoff = (unsigned)(sr * D + sc) * 2u;
    bf16x8 st_v0, st_v1, st_k0, st_k1;
    LAS unsigned char* qp = lds + WS_OFF + 2048 + wid * 8192 + lane * 16;
#define VMW() asm volatile("s_waitcnt vmcnt(0)" ::: "memory")
#define BL128(r_, so_) __builtin_bit_cast(bf16x8, __builtin_amdgcn_raw_buffer_load_b128(r_, kvoff, (so_), 0))
#define SLOAD_H(k0) do { const int so_ = (k0) * 256; st_v0 = BL128(rV, so_); st_v1 = BL128(rV, so_ + 8192); st_k0 = BL128(rK, so_); st_k1 = BL128(rK, so_ + 8192); } while (0)
#define SWRITE_HK(bf) do { *(LAS bf16x8*)(K_lds + (bf) * SHM_K + kws) = st_k0; *(LAS bf16x8*)(K_lds + (bf) * SHM_K + kws + 32 * 256) = st_k1; } while (0)
#define SWRITE_HV(bf) do { *(LAS bf16x8*)(V_lds + (bf) * SHM_V + vst0) = st_v0; *(LAS bf16x8*)(V_lds + (bf) * SHM_V + vst1) = st_v1; } while (0)
#define SWRITE_H(bf) do { SWRITE_HV(bf); SWRITE_HK(bf); } while (0)
#define MLOAD(t) __builtin_bit_cast(unsigned long long, __builtin_amdgcn_raw_buffer_load_b64(rM, moff, (t) * 8, 16))
#define MSPLIT(mw, wl, wh) do { wl = (unsigned)(mw) >> (4 * hi); wh = (unsigned)((mw) >> 32) >> (4 * hi); } while (0)
    { bf16x8 qt[8];
#pragma unroll
      for (int d0 = 0; d0 < 8; ++d0) qt[d0] = *(const GAS bf16x8*)(Qw + (unsigned)(r32 * D + d0 * 16 + hi * 8));
#pragma unroll
      for (int d0 = 0; d0 < 8; ++d0) *(LAS bf16x8*)(qp + d0 * 1024) = qt[d0]; }
    SLOAD_H(0); unsigned long long mwA = MLOAD(0), mwB = 0ull; VMW(); SWRITE_H(0);
    if (NT > 1) { SLOAD_H(KVBLK); mwB = MLOAD(1); }
    __syncthreads();
    float l_reg = 0.f; f32x16 o[4] = {};
    f32x16 p0, p1; bf16x8 pa0, pa1, pa2, pa3; unsigned wl, wh;
    SBAR(); qkt<0>(p0, p1, K_lds, r32, hi, qp);
    MSPLIT(mwA, wl, wh); partialSM(p0, p1, wl, wh, sh2);
    if (NT > 1) { VMW(); SWRITE_H(1); }
    __syncthreads();
#define STEP(t, KB, VB) do { \
        finishSM(p0, p1, l_reg, pa0, pa1, pa2, pa3); SBAR(); \
        if ((t) + 1 < NT) { SLOAD_H(((t) + 1) * KVBLK); mwA = MLOAD((t) + 1); SBAR(); } \
        pv_tile<VB>(o, vb0, pa0, pa1, pa2, pa3); SBAR(); \
        qkt<KB>(p0, p1, K_lds, r32, hi, qp); \
        MSPLIT(mwB, wl, wh); partialSM(p0, p1, wl, wh, sh2); mwB = mwA; \
        __syncthreads(); \
        if ((t) + 1 < NT) { VMW(); SWRITE_H(VB); } \
        __syncthreads(); } while (0)
    int t = 1;
    for (; t + 1 < NT; t += 2) { STEP(t, 1, 0); STEP(t + 1, 0, 1); }
    if (t < NT) { STEP(t, 1, 0); }
    finishSM(p0, p1, l_reg, pa0, pa1, pa2, pa3); SBAR();
    if ((NT - 1) & 1) pv_tile<1>(o, vb0, pa0, pa1, pa2, pa3); else pv_tile<0>(o, vb0, pa0, pa1, pa2, pa3);
    { auto rr = __builtin_amdgcn_permlane32_swap(__float_as_uint(l_reg), __float_as_uint(l_reg), false, false); l_reg = __uint_as_float(rr[0]) + __uint_as_float(rr[1]); }
    { int te = threadIdx.x; asm volatile("" : "+v"(te));
      const int le = te & 63, r32e = le & 31, hie = le >> 5;
      LAS float* wse = (LAS float*)(lds + WS_OFF) + wid * 64;
      if (hie == 0) wse[r32e] = l_reg;
      asm volatile("s_waitcnt lgkmcnt(0)" ::: "memory");
      __syncthreads();
      LAS f16* stg = (LAS f16*)(lds + wid * 8192);
#pragma unroll
      for (int r = 0; r < 16; ++r) { const int orow = crow(r, hie); const float rl = __builtin_amdgcn_rcpf(wse[orow]);
#pragma unroll
          for (int d0 = 0; d0 < 4; ++d0) stg[orow * 128 + d0 * 32 + r32e] = (f16)(o[d0][r] * rl); }
      asm volatile("s_waitcnt lgkmcnt(0)" ::: "memory");
      const GAS f16* SZ = (const GAS f16*)(a.ws + WS_SZ) + ((size_t)b * S + qw) * 1024 + head * 128; GAS f16* MIX = (GAS f16*)(a.ws + WS_MIX) + ((size_t)b * S + qw) * 2048 + head * 128;
#pragma unroll
      for (int i = 0; i < 8; ++i) { const int c = le + 64 * i, row = c >> 4, ch = c & 15;
          const f16x8 ov = *(const LAS f16x8*)(stg + row * 128 + ch * 8); const f16x8 zv = *(const GAS f16x8*)(SZ + (unsigned)(row * 1024 + ch * 8));
          *(GAS f16x8*)(MIX + (unsigned)(row * 2048 + ch * 8)) = ov * zv; } }
    asm volatile("s_waitcnt lgkmcnt(0)" ::: "memory");
    __syncthreads();
#undef BL128
#undef VMW
#undef SLOAD_H
#undef SWRITE_HK
#undef SWRITE_HV
#undef SWRITE_H
#undef MLOAD
#undef MSPLIT
#undef STEP
}
#undef KSWZ
#undef SBAR
}

__device__ __forceinline__ void p3_sample_item(const Args& a, LAS unsigned char* lds, int item, int tid) {
    const int qi = item >> 1, kvh = item & 1, sb = qi / NST, tl = qi % NST; constexpr int L = PAST + NST, PER = 33;
    const int lane = tid & 63, wave = __builtin_amdgcn_readfirstlane(tid >> 6);
    const GAS float* ck = (const GAS float*)a.in[2]; const GAS float* cv = (const GAS float*)a.in[3]; const GAS int* ptab = (const GAS int*)a.in[6]; const GAS float* out_ro = (const GAS float*)a.out;
    LAS float* q = (LAS float*)lds; LAS float* w = q + 1024; LAS float* newsc = w + 16; LAS float* ctl = newsc + 4; LAS float* red = ctl + 16;
    LAS unsigned* hist = (LAS unsigned*)(red + 32); LAS float* cand = (LAS float*)(hist + 256); LAS unsigned* cnt = (LAS unsigned*)(cand + 64);
    LAS unsigned* rid = cnt + 32; LAS float* qa = (LAS float*)(rid + 512); LAS float* sc = qa + 512; LAS float* inv = sc + 4 * 512; LAS float* part = inv + 4;
    LAS int* nsel = (LAS int*)(ctl + 8); LAS int* ncand = (LAS int*)(ctl + 9);
    const GAS f16* QI = (const GAS f16*)(a.ws + WS_QI) + (size_t)(MP + qi) * 1024; const GAS float* QS = (const GAS float*)(a.ws + WS_QS) + (size_t)qi * 1024 + kvh * 512;
    for (int i = tid; i < 1024; i += 512) q[i] = (float)QI[i];
    qa[tid] = QS[tid];
    if (tid < 16) w[tid] = ((const GAS float*)(a.ws + WS_WI))[(size_t)(MP + qi) * 16 + tid];
    if (tid < 32) cnt[tid] = 0u;
    if (tid < 256) hist[tid] = 0u;
    if (tid == 0) { *nsel = 0; *ncand = 0; }
    const GAS float* ssc = (const GAS float*)(a.ws + WS_SSC) + (size_t)qi * PAST;
    float v[PER];
#pragma unroll
    for (int j = 0; j < PER - 1; ++j) v[j] = __builtin_bit_cast(float, __hip_atomic_load((const GAS unsigned*)ssc + (j * 512 + tid), __ATOMIC_RELAXED, __HIP_MEMORY_SCOPE_AGENT));
    __syncthreads();
    if (tid < NST) { const GAS float* kr = out_ro + O_KIS + (size_t)(sb * NST + tid) * 64; float s = 0.f;
#pragma unroll 1
        for (int h = 0; h < 16; ++h) { float dsum = 0.f;
#pragma unroll 8
            for (int d = 0; d < 64; ++d) dsum += q[h * 64 + d] * kr[d];
            s += w[h] * fmaxf(dsum, 0.f); }
        newsc[tid] = s; }
    __syncthreads();
    const float NINF = -__builtin_inff(), PINF = __builtin_inff();
    { const int s = (PER - 1) * 512 + tid; v[PER - 1] = (s < L && (s - PAST) <= tl) ? newsc[s - PAST] : NINF; }
    float mx = NINF, mn = PINF;
#pragma unroll
    for (int j = 0; j < PER; ++j) { mx = fmaxf(mx, v[j]); mn = fminf(mn, v[j] == NINF ? PINF : v[j]); }
#pragma unroll
    for (int o = 1; o < 64; o <<= 1) { mx = fmaxf(mx, __shfl_xor(mx, o)); mn = fminf(mn, __shfl_xor(mn, o)); }
    if (lane == 0) { red[wave] = mx; red[8 + wave] = mn; }
    __syncthreads();
#pragma unroll
    for (int i = 0; i < 8; ++i) { mx = fmaxf(mx, red[i]); mn = fminf(mn, red[8 + i]); }
    const float scale = 255.5f / (mx - mn);
    float tau = 0.f; bool have = false;
    if (mx > mn) {
#pragma unroll
        for (int j = 0; j < PER; ++j) if (v[j] != NINF) { int bn = (int)((v[j] - mn) * scale); bn = bn > 255 ? 255 : bn; __hip_atomic_fetch_add(hist + bn, 1u, __ATOMIC_RELAXED, __HIP_MEMORY_SCOPE_WORKGROUP); }
        __syncthreads();
        if (wave == 0) {
            const u32x4 h = *(const LAS u32x4*)(hist + 4 * lane);
            const unsigned sl = h[0] + h[1] + h[2] + h[3]; unsigned pre = sl;
#pragma unroll
            for (int o = 1; o < 64; o <<= 1) { const unsigned y = __shfl_up(pre, o); if (lane >= o) pre += y; }
            const unsigned tot = __builtin_amdgcn_readlane(pre, 63); const unsigned suf = tot - pre + sl;
            const unsigned long long bm = __ballot(suf >= TOPK);
            const int Ls = 63 - __builtin_clzll(bm);
            unsigned c = __builtin_amdgcn_readlane(suf, Ls) - __builtin_amdgcn_readlane(sl, Ls);
            const unsigned h3 = __builtin_amdgcn_readlane(h[3], Ls), h2 = __builtin_amdgcn_readlane(h[2], Ls), h1 = __builtin_amdgcn_readlane(h[1], Ls);
            int Bs;
            if (c + h3 >= TOPK) Bs = 4 * Ls + 3; else { c += h3; if (c + h2 >= TOPK) Bs = 4 * Ls + 2; else { c += h2; if (c + h1 >= TOPK) Bs = 4 * Ls + 1; else { c += h1; Bs = 4 * Ls; } } }
            if (lane == 0) { ((LAS int*)ctl)[0] = Bs; ((LAS int*)ctl)[1] = TOPK - (int)c; }
        }
        __syncthreads();
        const int Bs = ((LAS int*)ctl)[0], need = ((LAS int*)ctl)[1];
#pragma unroll
        for (int j = 0; j < PER; ++j) if (v[j] != NINF) { int bn = (int)((v[j] - mn) * scale); bn = bn > 255 ? 255 : bn;
            if (bn == Bs) { const int p = __hip_atomic_fetch_add(ncand, 1, __ATOMIC_RELAXED, __HIP_MEMORY_SCOPE_WORKGROUP); if (p < 64) cand[p] = v[j]; } }
        __syncthreads();
        const int base = *ncand;
        if (base <= 64) {
            if (wave == 0) { const float x = lane < base ? cand[lane] : NINF; int rank = 0;
                for (int m = 0; m < base; ++m) { const float y = __builtin_bit_cast(float, __builtin_amdgcn_readlane(__builtin_bit_cast(int, x), m)); rank += y > x ? 1 : 0; }
                float tc = (lane < base && rank <= need - 1) ? x : PINF;
#pragma unroll
                for (int o = 1; o < 64; o <<= 1) tc = fminf(tc, __shfl_xor(tc, o));
                if (lane == 0) ctl[2] = tc; }
            __syncthreads();
            tau = ctl[2]; have = true;
        }
    }
    if (!have) {
        unsigned tk = 0u;
        for (int bit = 31; bit >= 0; --bit) { const unsigned cd = tk | (1u << bit); int c = 0;
#pragma unroll
            for (int j = 0; j < PER; ++j) c += __builtin_popcountll(__ballot(v[j] != NINF && fkey(v[j]) >= cd));
            if (lane == 0) __hip_atomic_fetch_add(cnt + bit, (unsigned)c, __ATOMIC_RELAXED, __HIP_MEMORY_SCOPE_WORKGROUP);
            __syncthreads();
            if (cnt[bit] >= TOPK) tk = cd; }
        tau = __builtin_bit_cast(float, (tk & 0x80000000u) ? (tk ^ 0x80000000u) : ~tk);
    }
#pragma unroll
    for (int j = 0; j < PER; ++j) { if (v[j] >= tau) { const int s = j * 512 + tid; const int p = __hip_atomic_fetch_add(nsel, 1, __ATOMIC_RELAXED, __HIP_MEMORY_SCOPE_WORKGROUP);
        if (p < 512) rid[p] = s < PAST ? (unsigned)(ptab[sb * NPAGES + (s >> 7)] * PAGE + (s & (PAGE - 1))) : (0x80000000u | (unsigned)(s - PAST)); } }
    __syncthreads();
    const int n = *nsel < 512 ? *nsel : 512;
    const int half = lane >> 5, l32 = lane & 31;
    { f32x4 qv[4];
#pragma unroll
      for (int h = 0; h < 4; ++h) qv[h] = *(const LAS f32x4*)(qa + h * 128 + 4 * l32);
      for (int j0 = 2 * wave; j0 < n; j0 += 128) { f32x4 kv[8]; int jj[8];
#pragma unroll
          for (int u = 0; u < 8; ++u) { jj[u] = j0 + 16 * u + half; const unsigned r = rid[jj[u] < n ? jj[u] : 0];
              const GAS float* kr = (r & 0x80000000u) ? out_ro + O_KS + ((size_t)(sb * NST + (r & 3u)) * NKV + kvh) * HD : ck + ((size_t)r * NKV + kvh) * HD;
              kv[u] = *(const GAS f32x4*)(kr + 4 * l32); }
#pragma unroll
          for (int u = 0; u < 8; ++u) { float d[4];
#pragma unroll
              for (int h = 0; h < 4; ++h) { d[h] = (kv[u][0] * qv[h][0] + kv[u][1] * qv[h][1]) + (kv[u][2] * qv[h][2] + kv[u][3] * qv[h][3]);
                  d[h] += __shfl_xor(d[h], 1); d[h] += __shfl_xor(d[h], 2); d[h] += __shfl_xor(d[h], 4); d[h] += __shfl_xor(d[h], 8); d[h] += __shfl_xor(d[h], 16); }
              if (jj[u] < n && l32 < 4) sc[l32 * 512 + jj[u]] = (l32 == 0 ? d[0] : l32 == 1 ? d[1] : l32 == 2 ? d[2] : d[3]) * 0.08838834764831845f; } } }
    __syncthreads();
    if (wave < 4) { LAS float* row = sc + wave * 512; float m2 = -1e30f;
      for (int j = lane; j < n; j += 64) m2 = fmaxf(m2, row[j]);
#pragma unroll
      for (int o = 1; o < 64; o <<= 1) m2 = fmaxf(m2, __shfl_xor(m2, o));
      float sm = 0.f;
      for (int j = lane; j < n; j += 64) { const float e = __expf(row[j] - m2); row[j] = e; sm += e; }
      sm = wave_sum(sm); if (lane == 0) inv[wave] = 1.f / sm; }
    __syncthreads();
    { f32x4 acc[4] = {};
      for (int j0 = 2 * wave; j0 < n; j0 += 128) { f32x4 vv[8]; int jj[8];
#pragma unroll
          for (int u = 0; u < 8; ++u) { jj[u] = j0 + 16 * u + half; const unsigned r = rid[jj[u] < n ? jj[u] : 0];
              const GAS float* vr = (r & 0x80000000u) ? out_ro + O_VS + ((size_t)(sb * NST + (r & 3u)) * NKV + kvh) * HD : cv + ((size_t)r * NKV + kvh) * HD;
              vv[u] = *(const GAS f32x4*)(vr + 4 * l32); }
#pragma unroll
          for (int u = 0; u < 8; ++u)
#pragma unroll
              for (int h = 0; h < 4; ++h) { const float p = jj[u] < n ? sc[h * 512 + jj[u]] : 0.f; acc[h] += vv[u] * p; } }
#pragma unroll
      for (int h = 0; h < 4; ++h) {
#pragma unroll
          for (int e = 0; e < 4; ++e) acc[h][e] += __shfl_xor(acc[h][e], 32);
          if (half == 0) *(LAS f32x4*)(part + (wave * 4 + h) * 128 + 4 * l32) = acc[h]; } }
    __syncthreads();
    { const GAS f16* SZ = (const GAS f16*)(a.ws + WS_SZ) + (size_t)(MP + qi) * 1024 + kvh * 512; GAS f16* MIX = (GAS f16*)(a.ws + WS_MIX) + (size_t)(MP + qi) * 2048 + kvh * 512;
      const int h = tid >> 7, d = tid & 127; float o = 0.f;
#pragma unroll
      for (int p = 0; p < 8; ++p) o += part[(p * 4 + h) * 128 + d];
      MIX[tid] = (f16)(o * inv[h] * (float)SZ[tid]); }
    __syncthreads();
}

__device__ __forceinline__ void p3_phase(const Args& a, LAS unsigned char* lds, int vcu, int G, int tid) {
    float gm = 0.f, km = 0.f;
    for (int i = 0; i < HD; ++i) { gm = fmaxf(gm, fabsf(a.in[9][i])); km = fmaxf(km, fabsf(a.in[10][i])); }
    const float sh2 = fmaxf(0.f, 11.313708498984761f * gm * km - 20.f) * 1.4426950408889634f;
    for (int rp = 0; rp < P3_REP_S; ++rp)
    for (int sidx = G - 1 - vcu; sidx < 2 * MS; sidx += G) { wait_ge_wt((unsigned*)a.ws + RDY_WORD0 + 64 * 32, (unsigned)G); p3_sample_item(a, lds, sidx, tid); }
    if (G == 256) { if (vcu >= 112 && vcu < 192) p2_convmix(a, (vcu - 112) * NWAVES + (tid >> 6), 80 * NWAVES, tid & 63); }
    else p2_convmix(a, vcu * NWAVES + (tid >> 6), G * NWAVES, tid & 63);
    for (int rp = 0; rp < P3_REP_A; ++rp)
    for (int k = vcu; k < 256; k += G) { const int i = 31 - (k >> 3), bk = k & 7;
        if (i >= 4) wait_ge_wt((unsigned*)a.ws + RDY_WORD0 + 64 * (40 + (bk >> 1) * 32 + i), 4u); else wait_ge_wt((unsigned*)a.ws + RDY_WORD0 + 64 * 33, (unsigned)G);
        att::attn_block(a, lds, bk >> 1, bk & 1, 64 * i, sh2); }
}

__global__ void __launch_bounds__(NWAVES * 64, 2) mk_fwd(Args a) {
    extern __shared__ __attribute__((aligned(16))) unsigned char lds_raw[];
    LAS unsigned char* lds = (LAS unsigned char*)lds_raw;
    const int tid = threadIdx.x, lane = tid & 63, wave = __builtin_amdgcn_readfirstlane(tid >> 6);
    const int G = gridDim.x; const int bx = blockIdx.x; const int vcu = (G % 8 == 0) ? (bx % 8) * (G / 8) + bx / 8 : bx;
    volatile LAS unsigned* MISC = (volatile LAS unsigned*)(lds + MISC_OFF);
    if (tid < 64) MISC[tid] = 0u;
    __syncthreads();
    XcdBarrier bar = xcd_barrier_post((unsigned*)a.ws, MISC + 8);
    { int t_ = threadIdx.x; asm volatile("" : "+v"(t_)); const int lane = t_ & 63, wave = __builtin_amdgcn_readfirstlane(t_ >> 6); p0_prologue(a, lds, vcu, G, wave, lane); }
    xcd_barrier(bar);
    { pg8::Gemm g{(const f16*)(a.ws + WS_XNH), (const f16*)(a.ws + WS_WINT), DM};
      pg8::StaticOrder S; S.init(MPAD / 256, NPAD / 256, G, bx);
      EpiIn E{a.out, a.ws, a.in[9], a.in[10], a.in[11], (LAS float*)(lds + SCR_OFF)};
      pg8::gemm_phase<EpiIn, pg8::StaticOrder>(lds, g, S, E); }
    { int t_ = threadIdx.x; asm volatile("" : "+v"(t_)); const int lane = t_ & 63, wave = __builtin_amdgcn_readfirstlane(t_ >> 6);
      xcd_barrier(bar);
      p2_phase(a, lds, vcu, G, wave, lane); }
    { int t_ = threadIdx.x; asm volatile("" : "+v"(t_)); p3_phase(a, lds, vcu, G, t_); }
    { pg8::Gemm g{(const f16*)(a.ws + WS_MIX), (const f16*)(a.ws + WS_WOUTT), DM};
      pg8::StaticOrder S; S.init(MP / 256, DM / 256, G, bx);
      EpiOut E{a.out, a.in[0]};
      f32x4 accp[2][2][4][2]; { pg8::Unit u0; int t0_ = threadIdx.x; asm volatile("" : "+v"(t0_)); const int w0_ = __builtin_amdgcn_readfirstlane(t0_ >> 6), l0_ = t0_ & 63;
          if (S.next(0, u0)) E.init(accp, u0, w0_ >> 2, w0_ & 3, l0_ & 15, l0_ >> 4); }
      xcd_barrier(bar);
      pg8::gemm_phase<EpiOut, pg8::StaticOrder, true>(lds, g, S, E, accp);
      int t_ = threadIdx.x; asm volatile("" : "+v"(t_)); p4_sample(a, lds, bx, G, t_); }
}

#ifndef PROG
#define PROG 0x11111u
#endif
extern "C" void kernel_launch(void* const* d_in, const int* in_sizes, int n_in, void* d_out, int out_size, void* d_ws, size_t ws_size, hipStream_t stream) {
    static int grid = 0;
    if (grid == 0) {
        if (ws_size < WS_NEED2 || out_size != (int)O_END || n_in != 14) { fprintf(stderr, "kernel_launch: ws %zu (need %zu) out %d (want %zu) n_in %d\n", ws_size, (size_t)WS_NEED2, out_size, (size_t)O_END, n_in); grid = -1; return; }
        int dev = 0, cus = 0; hipGetDevice(&dev); hipDeviceGetAttribute(&cus, hipDeviceAttributeMultiprocessorCount, dev);
        if (hipFuncSetAttribute((const void*)mk_fwd, hipFuncAttributeMaxDynamicSharedMemorySize, LDS_BYTES) != hipSuccess) { fprintf(stderr, "kernel_launch: hipFuncSetAttribute failed\n"); grid = -1; return; }
        int per_cu = 0; hipOccupancyMaxActiveBlocksPerMultiprocessor(&per_cu, (const void*)mk_fwd, NWAVES * 64, LDS_BYTES); (void)hipGetLastError();
        if (per_cu < 1) fprintf(stderr, "kernel_launch: occupancy query says %d blocks per CU\n", per_cu);
        grid = cus > 0 ? cus : 256;
    }
    if (grid < 0) return;
    float* out = (float*)d_out; unsigned char* ws = (unsigned char*)d_ws;
    Args a{};
    for (int i = 0; i < 14; ++i) a.in[i] = (const float*)d_in[i];
    a.out = out; a.ws = ws;
    if (hipMemsetAsync(ws, 0, 65536, stream) != hipSuccess) { fprintf(stderr, "kernel_launch: memset of the control words failed\n"); return; }
    a.ph_lo = (int)PROG; a.ph_hi = 0; hipLaunchKernelGGL(mk_fwd, dim3(grid), dim3(NWAVES * 64), LDS_BYTES, stream, a);
}
```

```cpp
#include <hip/hip_runtime.h>
#include <cstdio>
#include <cstdint>
#include <cmath>

typedef _Float16 f16;
typedef unsigned short bf16_t;

constexpr int DM = 2048, NB = 4, S = 2048, NSB = 8, NST = 4, PAST = 16384, PAGE = 128, NPAGES = PAST / PAGE;
constexpr int MP = NB * S;
constexpr int MS = NSB * NST;
constexpr int MT = MP + MS;
constexpr int DIN = 7760;
constexpr int OQ = 0, OKK = 1024, OV = 1280, OZ = 1536, OQI = 2560, OKI = 3584, OWI = 3648, OH = 3664, OBB = 4688, OC = 5712, OZC = 6736;
constexpr int NH = 8, NKV = 2, HD = 128, NIH = 16, ID = 64, TOPK = 256, DC = 1024;
constexpr float EPS = 1e-6f;
constexpr size_t O_YP = 0, O_YS = 16777216, O_KP = 16842752, O_VP = 18939904, O_KIP = 21037056, O_CVP = 21561344,
                 O_KS = 21569536, O_VS = 21577728, O_KIS = 21585920, O_CVS = 21587968, O_END = 21604352;
constexpr size_t MiB = 1u << 20;
constexpr size_t WS_ROPE = 1 * MiB;
constexpr size_t WS_ROPE_I = WS_ROPE + 2052 * 32 * 4;
constexpr size_t WS_QB = 2 * MiB;
constexpr size_t WS_KB = 18 * MiB;
constexpr size_t WS_VB = 22 * MiB;
constexpr size_t WS_SZ = 26 * MiB;
constexpr size_t WS_QI = 43 * MiB;
constexpr size_t WS_KI = 60 * MiB;
constexpr size_t WS_WI = 61 * MiB;
constexpr size_t WS_U = 62 * MiB;
constexpr size_t WS_G = 79 * MiB;
constexpr size_t WS_MIX = 96 * MiB;
constexpr size_t WS_MASK = 130 * MiB;
constexpr size_t WS_SSC = 132 * MiB;
constexpr size_t WS_QS = 134 * MiB;
constexpr size_t WS_XN = 136 * MiB;
constexpr size_t WS_P = 202 * MiB;
constexpr size_t WS_NEED = 448 * MiB;

__device__ __forceinline__ bf16_t f2bf(float f) { unsigned u = __builtin_bit_cast(unsigned, f); return (bf16_t)((u + 0x7fffu + ((u >> 16) & 1u)) >> 16); }
__device__ __forceinline__ float bf2f(bf16_t h) { return __builtin_bit_cast(float, (unsigned)h << 16); }
__device__ __forceinline__ float silu(float z) { return z * __builtin_amdgcn_rcpf(1.f + __builtin_amdgcn_exp2f(-1.4426950408889634f * z)); }
__device__ __forceinline__ unsigned fkey(float f) { unsigned u = __builtin_bit_cast(unsigned, f); return (u & 0x80000000u) ? ~u : (u | 0x80000000u); }

#define P0_REP_T 1
#define P0_REP_X 1
#define P3_REP_S 1
#define P3_REP_A 1
#define P2_KT_REP 1
#define P2_SEL_REP 1
#define P2_REP_A 1
#define P2_REP_B 1
#define P2_REP_C 1
#define LAS __attribute__((address_space(3)))
#define GAS __attribute__((address_space(1)))
typedef _Float16 f16x8 __attribute__((ext_vector_type(8)));
typedef _Float16 f16x4 __attribute__((ext_vector_type(4)));
typedef _Float16 f16x2 __attribute__((ext_vector_type(2)));
typedef float f32x4 __attribute__((ext_vector_type(4)));
typedef float f32x2 __attribute__((ext_vector_type(2)));
typedef unsigned u32x4 __attribute__((ext_vector_type(4)));
typedef unsigned u32x2 __attribute__((ext_vector_type(2)));
typedef __bf16 bf16x2_t __attribute__((ext_vector_type(2)));
namespace pg8 {
constexpr int BM = 256, BK = 64, HALF = 128, HTB = HALF * BK * 2, STAGE_BYTES = 8 * HTB, NXCD = 8, WGM = 8;
__host__ __device__ __forceinline__ int lds_byte(int r, int c) { const int st = (r >> 4) * 2 + (c >> 5), rr = r & 15, cc = c & 31, ob = rr * 64 + cc * 2; return st * 1024 + (ob ^ (((ob >> 9) & 1) << 5)); }
__host__ __device__ __forceinline__ void stage_rc(int b, int& R, int& C) { const int st = b / 1024, sb = b % 1024, swz = sb ^ (((sb >> 9) & 1) << 5); R = (st >> 1) * 16 + swz / 64; C = (st & 1) * 32 + (swz % 64) / 2; }
struct Unit { int pm, pn; };
struct Gemm { const f16* A; const f16* Bt; int K; };
struct StaticOrder {
    int nM, nN, nwg, G, c;
    __device__ __forceinline__ void init(int nM_, int nN_, int G_, int c_) { nM = nM_; nN = nN_; nwg = nM * nN; G = G_; c = c_; }
    __device__ __forceinline__ bool next(int i, Unit& u) const {
        const long L = (long)i * G + c; if (L >= nwg) return false;
        int wgid = (int)L; { const int q = nwg / NXCD, r = nwg % NXCD, xcd = wgid % NXCD, off = wgid / NXCD; wgid = (xcd < r ? xcd * (q + 1) : r * (q + 1) + (xcd - r) * q) + off; }
        const int nig = WGM * nN, gid = wgid / nig, fm = gid * WGM, gsz = (nM - fm) < WGM ? (nM - fm) : WGM;
        u.pm = fm + ((wgid % nig) % gsz); u.pn = (wgid % nig) / gsz; return true;
    }
};
struct OneUnit { int pm, pn; __device__ __forceinline__ bool next(int i, Unit& u) const { if (i != 0) return false; u.pm = pm; u.pn = pn; return true; } };
template <class Epi, class Sched, bool PRE = false>
__device__ __forceinline__ void gemm_phase(LAS unsigned char* lds, const Gemm g, const Sched& S, const Epi& E, const f32x4 (*pre)[2][4][2] = nullptr) {
    int tid_ = threadIdx.x; asm volatile("" : "+v"(tid_));
    const int tid = tid_, wid = __builtin_amdgcn_readfirstlane(tid >> 6), lane = tid & 63, wr = wid >> 2, wc = wid & 3, fr = lane & 15, fq = lane >> 4;
    const int K = g.K, nt = K / BK;
    unsigned voffA[2];
#pragma unroll
    for (int i = 0; i < 2; ++i) { int R, C; stage_rc(tid * 16 + i * 8192, R, C); voffA[i] = (unsigned)(R * K + C) * 2u; }
    const size_t kstep = (size_t)(BK * 2);
    const size_t hstep = (size_t)HALF * K * 2;
    const size_t tstep = 2 * hstep;
    const unsigned ldsw = (unsigned)wid * 1024u;
    const int aoff = lds_byte(wr * 64 + fr, fq * 8), boff = lds_byte(wc * 32 + fr, fq * 8);
#define PG8_SA(b, h) (((b) * 2 + (h)) * HTB)
#define PG8_SB(b, h) ((4 + (b) * 2 + (h)) * HTB)
#define PG8_STAGE(bufoff, gbase) do { _Pragma("unroll") for (int _i = 0; _i < 2; ++_i) \
        __builtin_amdgcn_global_load_lds((const unsigned*)((const char*)(gbase) + voffA[_i]), (LAS unsigned*)(lds + (bufoff) + ldsw + _i * 8192), 16, 0, 0); } while (0)
#define PG8_LDA(dst, b, h) do { _Pragma("unroll") for (int m = 0; m < 4; ++m) _Pragma("unroll") for (int k = 0; k < 2; ++k) dst[m][k] = *(const LAS f16x8*)(lds + PG8_SA(b, h) + aoff + m * 2048 + k * 1024); } while (0)
#define PG8_LDB(dst, b, h) do { _Pragma("unroll") for (int n = 0; n < 2; ++n) _Pragma("unroll") for (int k = 0; k < 2; ++k) dst[n][k] = *(const LAS f16x8*)(lds + PG8_SB(b, h) + boff + n * 2048 + k * 1024); } while (0)
#define PG8_MMA(ai, bj, At, Bt) do { __builtin_amdgcn_s_setprio(1); _Pragma("unroll") for (int m = 0; m < 4; ++m) _Pragma("unroll") for (int n = 0; n < 2; ++n) _Pragma("unroll") for (int k = 0; k < 2; ++k) \
        acc[ai][bj][m][n] = __builtin_amdgcn_mfma_f32_16x16x32_f16(Bt[n][k], At[m][k], acc[ai][bj][m][n], 0, 0, 0); __builtin_amdgcn_s_setprio(0); } while (0)
#define PG8_WAIT_V(n) asm volatile("s_waitcnt vmcnt(" #n ")" ::: "memory")
#define PG8_WAIT_L(n) asm volatile("s_waitcnt lgkmcnt(" #n ")" ::: "memory")
#define PG8_BAR __builtin_amdgcn_s_barrier()
#define PG8_SCHED __builtin_amdgcn_sched_barrier(0)
    Unit cur, nxt; int ui = 0;
    if (!S.next(0, cur)) return;
    f32x4 acc[2][2][4][2];
    if constexpr (PRE) {
#pragma unroll
        for (int a = 0; a < 2; ++a)
#pragma unroll
            for (int b = 0; b < 2; ++b)
#pragma unroll
                for (int m = 0; m < 4; ++m)
#pragma unroll
                    for (int n = 0; n < 2; ++n) acc[a][b][m][n] = pre[a][b][m][n];
    } else E.init(acc, cur, wr, wc, fr, fq);
    f16x8 At[4][2], B0[2][2], B1[2][2];
    const char* cA = (const char*)g.A + (size_t)cur.pm * tstep; const char* cB = (const char*)g.Bt + (size_t)cur.pn * tstep;
    PG8_STAGE(PG8_SB(0, 0), cB); PG8_STAGE(PG8_SB(0, 1), cB + hstep); PG8_STAGE(PG8_SA(0, 0), cA); PG8_STAGE(PG8_SA(0, 1), cA + hstep);
    if (wr == 1) PG8_BAR;
    PG8_WAIT_V(2); PG8_BAR;
    PG8_STAGE(PG8_SB(1, 0), cB + kstep); PG8_STAGE(PG8_SA(1, 0), cA + kstep); PG8_STAGE(PG8_SB(1, 1), cB + hstep + kstep);
    PG8_WAIT_V(6); PG8_BAR;
    for (;;) {
        const bool has_next = S.next(ui + 1, nxt);
        const char* nA = has_next ? (const char*)g.A + (size_t)nxt.pm * tstep : cA; const char* nB = has_next ? (const char*)g.Bt + (size_t)nxt.pn * tstep : cB;
        for (int t = 0; t < nt; t += 2) {
            const bool last = (t == nt - 2);
            const char* a1 = cA + (size_t)(t + 1) * kstep;
            const char* a2 = last ? nA : cA + (size_t)(t + 2) * kstep; const char* b2 = last ? nB : cB + (size_t)(t + 2) * kstep;
            const char* a3 = a2 + kstep; const char* b3 = b2 + kstep;
            PG8_LDB(B0, 0, 0); PG8_LDB(B1, 0, 1); PG8_SCHED; PG8_LDA(At, 0, 0); PG8_STAGE(PG8_SA(1, 1), a1 + hstep);
            PG8_WAIT_V(8); PG8_WAIT_L(0); PG8_BAR; PG8_MMA(0, 0, At, B0); PG8_MMA(0, 1, At, B1); PG8_BAR; PG8_SCHED;
            PG8_LDA(At, 0, 1); PG8_STAGE(PG8_SB(0, 0), b2); PG8_STAGE(PG8_SB(0, 1), b2 + hstep); PG8_STAGE(PG8_SA(0, 0), a2);
            PG8_WAIT_V(8); PG8_WAIT_L(0); PG8_BAR; PG8_MMA(1, 0, At, B0); PG8_MMA(1, 1, At, B1); PG8_BAR; PG8_SCHED;
            PG8_LDB(B0, 1, 0); PG8_LDB(B1, 1, 1); PG8_SCHED; PG8_LDA(At, 1, 0); PG8_STAGE(PG8_SA(0, 1), a2 + hstep);
            PG8_WAIT_V(8); PG8_WAIT_L(0); PG8_BAR; PG8_MMA(0, 0, At, B0); PG8_MMA(0, 1, At, B1); PG8_BAR; PG8_SCHED;
            PG8_LDA(At, 1, 1); PG8_STAGE(PG8_SB(1, 0), b3); PG8_STAGE(PG8_SB(1, 1), b3 + hstep); PG8_STAGE(PG8_SA(1, 0), a3);
            PG8_WAIT_V(8); PG8_WAIT_L(0); PG8_BAR; PG8_MMA(1, 0, At, B0); PG8_MMA(1, 1, At, B1); PG8_BAR; PG8_SCHED;
        }
        const bool al = E.aligned(cur);
        if (al && wr == 0) PG8_BAR;
        E(acc, cur, wr, wc, fr, fq);
        if (!has_next) { if (!al && wr == 0) PG8_BAR; break; }
        cur = nxt; cA = nA; cB = nB; ++ui;
        E.init(acc, cur, wr, wc, fr, fq);
        if (al && wr == 1) PG8_BAR;
    }
    PG8_WAIT_V(0);
    PG8_BAR;
#undef PG8_SA
#undef PG8_SB
#undef PG8_STAGE
#undef PG8_LDA
#undef PG8_LDB
#undef PG8_MMA
#undef PG8_WAIT_V
#undef PG8_WAIT_L
#undef PG8_BAR
#undef PG8_SCHED
}
}
#ifndef P0_REP_T
#define P0_REP_T 1
#define P0_REP_X 1
#endif
constexpr int NWAVES = 8;
constexpr int MPAD = 8448, NPAD = 7936;
constexpr size_t WS_XNH = 450 * MiB;
constexpr size_t WS_WINT = 484 * MiB;
constexpr size_t WS_WOUTT = 516 * MiB;
constexpr size_t WS_PART = 524 * MiB;
constexpr size_t PART_STRIDE = 32768 + 256;
constexpr size_t WS_NEED2 = 536 * MiB;
constexpr int RING_BYTES = 131072, SCR_OFF = RING_BYTES, SCR_BYTES = 8192, MISC_OFF = 145408, LDS_BYTES = 147456;

__device__ __forceinline__ unsigned pk_bf16(float lo, float hi) { f32x2 v = {lo, hi}; bf16x2_t b = __builtin_convertvector(v, bf16x2_t); return __builtin_bit_cast(unsigned, b); }
__device__ __forceinline__ unsigned pk_f16(float lo, float hi) { f32x2 v = {lo, hi}; f16x2 b = __builtin_convertvector(v, f16x2); return __builtin_bit_cast(unsigned, b); }

struct Args { const float* in[14]; float* out; unsigned char* ws; int ph_lo, ph_hi; };

__device__ __forceinline__ int win_src(int np) {
    const int pn = np >> 8, c = np & 255;
    if (pn < 15) { const int rho = c & 31, nn = rho >> 4, ii = rho & 15; const int L = (np & ~31) | (8 * (ii >> 2) + 4 * nn + (ii & 3));
        if (pn < 14) return L;
        return (L & 255) < 80 ? L : -1; }
    const int T = pn - 15, bj = c >> 7, wc = (c >> 5) & 3, n = (c >> 4) & 1, fqi = c & 15;
    const int base = bj == 0 ? (n == 0 ? OH : OBB) : (n == 0 ? OC : OZC);
    return base + 64 * T + 16 * wc + fqi;
}
template <bool MAP>
__device__ __forceinline__ void p0_transpose_item(const float* W, int N, f16* WT, LAS unsigned char* scr, int item, int nblk, int lane) {
    const int kb = item / nblk, nb = item % nblk, k0 = 64 * kb, n0 = 32 * nb;
    const int q = lane & 7, kr = lane >> 3;
    const int src = MAP ? win_src(n0 + 4 * q) : n0 + 4 * q;
    const GAS float* wp = (const GAS float*)W + (size_t)(k0 + 2 * kr) * N + (src >= 0 ? src : 0);
    f32x4 va[4], vb[4];
#pragma unroll
    for (int p = 0; p < 4; ++p) { va[p] = *(const GAS f32x4*)(wp + (size_t)(16 * p) * N); vb[p] = *(const GAS f32x4*)(wp + (size_t)(16 * p + 1) * N); }
#pragma unroll
    for (int p = 0; p < 4; ++p) { if (src < 0) { va[p] = (f32x4){0.f, 0.f, 0.f, 0.f}; vb[p] = va[p]; }
#pragma unroll
        for (int e = 0; e < 4; ++e) *(LAS unsigned*)(scr + (4 * q + e) * 144 + 2 * (16 * p + 2 * kr)) = pk_f16(va[p][e], vb[p][e]); }
    asm volatile("s_waitcnt lgkmcnt(0)" ::: "memory");
    const int ch = lane & 7;
#pragma unroll
    for (int j = 0; j < 4; ++j) { const int n = (lane >> 3) + 8 * j;
        *(GAS u32x4*)(WT + (size_t)(n0 + n) * 2048 + k0 + 8 * ch) = *(const LAS u32x4*)(scr + n * 144 + ch * 16); }
    asm volatile("s_waitcnt lgkmcnt(0)" ::: "memory");
}
template <int CTRL, int RM, int BM> __device__ __forceinline__ float dppf(float old, float src) { return __builtin_bit_cast(float, __builtin_amdgcn_update_dpp(__builtin_bit_cast(int, old), __builtin_bit_cast(int, src), CTRL, RM, BM, false)); }
template <int CTRL, int RM, int BM> __device__ __forceinline__ unsigned dppu(unsigned old, unsigned src) { return (unsigned)__builtin_amdgcn_update_dpp((int)old, (int)src, CTRL, RM, BM, false); }
__device__ __forceinline__ float wave_max_dpp(float v) {
    v = fmaxf(v, dppf<0xB1, 0xF, 0xF>(v, v)); v = fmaxf(v, dppf<0x4E, 0xF, 0xF>(v, v)); v = fmaxf(v, dppf<0x141, 0xF, 0xF>(v, v)); v = fmaxf(v, dppf<0x140, 0xF, 0xF>(v, v));
    v = fmaxf(v, dppf<0x142, 0xA, 0xF>(v, v)); v = fmaxf(v, dppf<0x143, 0xC, 0xF>(v, v));
    return __builtin_bit_cast(float, __builtin_amdgcn_readlane(__builtin_bit_cast(int, v), 63));
}
__device__ __forceinline__ float wave_sum_dpp(float v) {
    v += dppf<0xB1, 0xF, 0xF>(0.f, v); v += dppf<0x4E, 0xF, 0xF>(0.f, v); v += dppf<0x141, 0xF, 0xF>(0.f, v); v += dppf<0x140, 0xF, 0xF>(0.f, v);
    v += dppf<0x142, 0xA, 0xF>(0.f, v); v += dppf<0x143, 0xC, 0xF>(0.f, v);
    return __builtin_bit_cast(float, __builtin_amdgcn_readlane(__builtin_bit_cast(int, v), 63));
}
__device__ __forceinline__ float half_sum_dpp(float v) {
    v += dppf<0xB1, 0xF, 0xF>(0.f, v); v += dppf<0x4E, 0xF, 0xF>(0.f, v); v += dppf<0x141, 0xF, 0xF>(0.f, v); v += dppf<0x140, 0xF, 0xF>(0.f, v);
    v += dppf<0x142, 0xA, 0xF>(0.f, v);
    return v;
}
__device__ __forceinline__ unsigned wave_scan_dpp(unsigned x) {
    x += dppu<0x111, 0xF, 0xF>(0u, x); x += dppu<0x112, 0xF, 0xF>(0u, x); x += dppu<0x114, 0xF, 0xF>(0u, x); x += dppu<0x118, 0xF, 0xF>(0u, x);
    x += dppu<0x142, 0xA, 0xF>(0u, x); x += dppu<0x143, 0xC, 0xF>(0u, x);
    return x;
}
__device__ __forceinline__ float wave_sum(float v) {
#pragma unroll
    for (int o = 1; o < 64; o <<= 1) v += __shfl_xor(v, o);
    return v;
}
__device__ __forceinline__ void p0_prologue(const Args& a, LAS unsigned char* lds, int vcu, int G, int wave, int lane) {
    LAS unsigned char* scr = lds + wave * 16384;
    const int gw = vcu * NWAVES + wave, NGW = G * NWAVES;
    const float* win = a.in[8]; const float* wout = a.in[13];
    f16* WinT = (f16*)(a.ws + WS_WINT); f16* WoutT = (f16*)(a.ws + WS_WOUTT); f16* XN = (f16*)(a.ws + WS_XNH);
    constexpr int I_IN = 32 * (NPAD / 32), I_OUT = 32 * (DM / 32);
    for (int rpt = 0; rpt < P0_REP_T; ++rpt)
    for (int it = gw; it < I_IN + I_OUT; it += NGW) {
        if (it < I_IN) p0_transpose_item<true>(win, DIN, WinT, scr, it, NPAD / 32, lane);
        else p0_transpose_item<false>(wout, DM, WoutT, scr, it - I_IN, DM / 32, lane);
    }
    const float* gin = a.in[7];
    for (int rpx = 0; rpx < P0_REP_X; ++rpx)
    for (int m = gw; m < MT; m += NGW) {
        const float* xrow = m < MP ? a.in[0] + (size_t)m * DM : a.in[1] + (size_t)(m - MP) * DM;
        const f32x4* xr = (const f32x4*)xrow + lane; f32x4 v[8]; float s = 0.f;
#pragma unroll
        for (int j = 0; j < 8; ++j) { v[j] = xr[64 * j]; s += (v[j].x * v[j].x + v[j].y * v[j].y) + (v[j].z * v[j].z + v[j].w * v[j].w); }
        const float rs = rsqrtf(wave_sum_dpp(s) * (1.f / DM) + EPS);
        u32x2* o8 = (u32x2*)(XN + (size_t)m * DM) + lane;
#pragma unroll
        for (int j = 0; j < 8; ++j) { const f32x4 gv = ((const f32x4*)gin)[lane + 64 * j]; u32x2 w; w.x = pk_f16(v[j].x * rs * gv.x, v[j].y * rs * gv.y); w.y = pk_f16(v[j].z * rs * gv.z, v[j].w * rs * gv.w); o8[64 * j] = w; }
    }
    float* rqk = (float*)(a.ws + WS_ROPE); float* ri = (float*)(a.ws + WS_ROPE_I);
    for (int i = gw * 64 + lane; i < 2052 * 16; i += NGW * 64) {
        { int slot = i / 16, j = i % 16; int pos = slot < 2048 ? slot : PAST + (slot - 2048);
          float inv = (float)pow(500000.0, -(double)j / 16.0); float ang = (float)pos * inv;
          rqk[(slot * 16 + j) * 2] = (float)cos((double)ang); rqk[(slot * 16 + j) * 2 + 1] = (float)sin((double)ang); }
        if (i < 2052 * 8) { int slot = i / 8, j = i % 8; int pos = slot < 2048 ? slot : PAST + (slot - 2048);
          float inv = (float)pow(500000.0, -(double)j / 8.0); float ang = (float)pos * inv;
          ri[(slot * 8 + j) * 2] = (float)cos((double)ang); ri[(slot * 8 + j) * 2 + 1] = (float)sin((double)ang); }
    }
}

struct EpiIn {
    float* out; unsigned char* ws; const float* gq; const float* gk; const float* gki; LAS float* scr;
    __device__ __forceinline__ bool aligned(const pg8::Unit& u) const { return u.pn <= 4 || u.pn == 14; }
    __device__ __forceinline__ void init(f32x4 (&acc)[2][2][4][2], const pg8::Unit&, int, int, int, int) const {
#pragma unroll
        for (int a = 0; a < 2; ++a)
#pragma unroll
            for (int b = 0; b < 2; ++b)
#pragma unroll
                for (int m = 0; m < 4; ++m)
#pragma unroll
                    for (int n = 0; n < 2; ++n) acc[a][b][m][n] = (f32x4){0.f, 0.f, 0.f, 0.f};
    }
    __device__ __forceinline__ void operator()(f32x4 (&acc)[2][2][4][2], const pg8::Unit& u, int wr, int wc, int fr_, int fq_) const {
        int fr = fr_, fq = fq_; asm volatile("" : "+v"(fr), "+v"(fq));
        GAS unsigned char* ws = (GAS unsigned char*)this->ws; GAS float* out = (GAS float*)this->out; asm volatile("" : "+s"(ws), "+s"(out));
        const int pn = u.pn, pm = u.pm; const bool smp = pm == 32;
        const int rbase = 64 * wr + fr;
        const int bb = pm >> 3, t0 = (pm & 7) << 8;
        const GAS float* rqk = (const GAS float*)(ws + WS_ROPE); const GAS float* ri = (const GAS float*)(ws + WS_ROPE_I);
#define ROWLOOP _Pragma("unroll") for (int ai = 0; ai < 2; ++ai) _Pragma("unroll") for (int m = 0; m < 4; ++m)
#define ROWVARS const int r = rbase + 128 * ai + 16 * m; const bool valid = !smp || r < MS; const int grow = smp ? MP + r : pm * 256 + r; const int tt = smp ? (r & 3) : t0 + r; const int slot = smp ? 2048 + (r & 3) : tt; (void)grow; (void)tt; (void)slot; (void)valid;
        const int cl = 32 * wc + 8 * fq;
#define PK8B(x0_, x1_) ((u32x4){pk_bf16(x0_[0], x0_[1]), pk_bf16(x0_[2], x0_[3]), pk_bf16(x1_[0], x1_[1]), pk_bf16(x1_[2], x1_[3])})
#define PK8H(x0_, x1_) ((u32x4){pk_f16(x0_[0], x0_[1]), pk_f16(x0_[2], x0_[3]), pk_f16(x1_[0], x1_[1]), pk_f16(x1_[2], x1_[3])})
#define SHX4(dst_, src_, off_) do { dst_[0] = __shfl_xor(src_[0], off_); dst_[1] = __shfl_xor(src_[1], off_); dst_[2] = __shfl_xor(src_[2], off_); dst_[3] = __shfl_xor(src_[3], off_); } while (0)
        if (pn <= 4 || pn == 14) {
            const bool isk = pn == 14;
            ROWLOOP { asm volatile("" ::: "memory"); const int r = rbase + 128 * ai + 16 * m;
#pragma unroll
                for (int bj = 0; bj < 2; ++bj) { float s = 0.f;
#pragma unroll
                    for (int n = 0; n < 2; ++n) { const f32x4 x = acc[ai][bj][m][n]; s += (x[0] * x[0] + x[1] * x[1]) + (x[2] * x[2] + x[3] * x[3]); }
                    if (isk && (wc >= 2 || bj == 1)) s = 0.f;
                    s += __shfl_xor(s, 16); s += __shfl_xor(s, 32);
                    if (fq == 0) scr[(r * 2 + bj) * 4 + wc] = s; } }
            asm volatile("s_waitcnt lgkmcnt(0)" ::: "memory"); __builtin_amdgcn_s_barrier(); asm volatile("" ::: "memory");
            if (!isk) {
                const GAS float* g = (const GAS float*)(pn < 4 ? gq : gk);
                const f32x4 g0 = *(const GAS f32x4*)(g + cl), g1 = *(const GAS f32x4*)(g + cl + 4);
                GAS bf16_t* Qb = (GAS bf16_t*)(ws + WS_QB); GAS bf16_t* Kb = (GAS bf16_t*)(ws + WS_KB); GAS float* QS = (GAS float*)(ws + WS_QS);
                ROWLOOP { asm volatile("" ::: "memory"); ROWVARS
                    f32x4 c0 = {1.f, 1.f, 1.f, 1.f}, s0 = {0.f, 0.f, 0.f, 0.f}, c1 = c0, s1 = s0;
                    if (wc == 0) { const GAS f32x4* cp = (const GAS f32x4*)(rqk + (slot * 16 + 8 * (fq & 1)) * 2); const f32x4 t0_ = cp[0], t1_ = cp[1], t2_ = cp[2], t3_ = cp[3];
                        c0 = (f32x4){t0_[0], t0_[2], t1_[0], t1_[2]}; s0 = (f32x4){t0_[1], t0_[3], t1_[1], t1_[3]}; c1 = (f32x4){t2_[0], t2_[2], t3_[0], t3_[2]}; s1 = (f32x4){t2_[1], t2_[3], t3_[1], t3_[3]}; }
#pragma unroll
                    for (int bj = 0; bj < 2; ++bj) {
                        const f32x4 p = *(const LAS f32x4*)(scr + (r * 2 + bj) * 4);
                        const float rs = rsqrtf(((p[0] + p[1]) + (p[2] + p[3])) * (1.f / 128.f) + EPS);
                        f32x4 x0 = acc[ai][bj][m][0] * rs * g0, x1 = acc[ai][bj][m][1] * rs * g1;
                        if (wc == 0) { f32x4 o0, o1; SHX4(o0, x0, 32); SHX4(o1, x1, 32);
                            if (fq < 2) { x0 = x0 * c0 - o0 * s0; x1 = x1 * c1 - o1 * s1; } else { x0 = x0 * c0 + o0 * s0; x1 = x1 * c1 + o1 * s1; } }
                        const int hh = 2 * pn + bj;
                        if (pn < 4) {
                            if (smp) { if (valid) { GAS float* q = QS + (size_t)r * 1024 + hh * 128 + cl; *(GAS f32x4*)q = x0; *(GAS f32x4*)(q + 4) = x1; } }
                            else *(GAS u32x4*)(Qb + (((size_t)bb * NH + hh) * S + tt) * HD + cl) = PK8B(x0, x1);
                        } else {
                            if (smp) { if (valid) { GAS float* k = out + O_KS + (size_t)r * 256 + bj * 128 + cl; *(GAS f32x4*)k = x0; *(GAS f32x4*)(k + 4) = x1; } }
                            else { GAS float* k = out + O_KP + (size_t)grow * 256 + bj * 128 + cl; *(GAS f32x4*)k = x0; *(GAS f32x4*)(k + 4) = x1;
                                *(GAS u32x4*)(Kb + (((size_t)bb * NKV + bj) * S + tt) * HD + cl) = PK8B(x0, x1); }
                        } } }
            } else {
                const int dl = 32 * (wc & 1) + 8 * fq;
                const f32x4 g0 = *(const GAS f32x4*)((const GAS float*)gki + dl), g1 = *(const GAS f32x4*)((const GAS float*)gki + dl + 4);
                GAS f16* KI = (GAS f16*)(ws + WS_KI); GAS float* WI = (GAS float*)(ws + WS_WI);
                ROWLOOP { asm volatile("" ::: "memory"); ROWVARS
                    const f32x4 p = *(const LAS f32x4*)(scr + (r * 2) * 4);
                    const float rs = rsqrtf((p[0] + p[1]) * (1.f / 64.f) + EPS);
                    f32x4 x0 = acc[ai][0][m][0] * rs * g0, x1 = acc[ai][0][m][1] * rs * g1;
                    f32x4 o0, o1; SHX4(o0, x0, 16); SHX4(o1, x1, 16);
                    if (wc == 0 && fq < 2) { const GAS f32x4* cp = (const GAS f32x4*)(ri + (slot * 8) * 2); const f32x4 t0_ = cp[0], t1_ = cp[1], t2_ = cp[2], t3_ = cp[3];
                        const f32x4 c0 = {t0_[0], t0_[2], t1_[0], t1_[2]}, s0 = {t0_[1], t0_[3], t1_[1], t1_[3]}, c1 = {t2_[0], t2_[2], t3_[0], t3_[2]}, s1 = {t2_[1], t2_[3], t3_[1], t3_[3]};
                        if (fq == 0) { x0 = x0 * c0 - o0 * s0; x1 = x1 * c1 - o1 * s1; } else { x0 = x0 * c0 + o0 * s0; x1 = x1 * c1 + o1 * s1; } }
                    if (wc < 2 && valid) {
                        GAS float* ko = smp ? out + O_KIS + (size_t)r * 64 + dl : out + O_KIP + (size_t)grow * 64 + dl;
                        *(GAS f32x4*)ko = x0; *(GAS f32x4*)(ko + 4) = x1;
                        if (!smp) *(GAS u32x4*)(KI + (size_t)grow * 64 + dl) = PK8H(x0, x1); }
                    if (wc == 2 && fq < 2 && valid) { GAS float* wo = WI + (size_t)grow * 16 + 8 * fq; *(GAS f32x4*)wo = acc[ai][0][m][0] * (1.f / 32.f); *(GAS f32x4*)(wo + 4) = acc[ai][0][m][1] * (1.f / 32.f); }
                }
            }
        } else if (pn == 5) {
            GAS bf16_t* Vb = (GAS bf16_t*)(ws + WS_VB);
            ROWLOOP { asm volatile("" ::: "memory"); ROWVARS
#pragma unroll
                for (int bj = 0; bj < 2; ++bj) { const f32x4 x0 = acc[ai][bj][m][0], x1 = acc[ai][bj][m][1];
                    if (smp) { if (valid) { GAS float* v = out + O_VS + (size_t)r * 256 + bj * 128 + cl; *(GAS f32x4*)v = x0; *(GAS f32x4*)(v + 4) = x1; } }
                    else { GAS float* v = out + O_VP + (size_t)grow * 256 + bj * 128 + cl; *(GAS f32x4*)v = x0; *(GAS f32x4*)(v + 4) = x1;
                        *(GAS u32x4*)(Vb + (((size_t)bb * NKV + bj) * S + tt) * HD + cl) = PK8B(x0, x1); } } }
        } else if (pn <= 9) {
            GAS f16* SZ = (GAS f16*)(ws + WS_SZ); const int c0 = 256 * (pn - 6) + cl;
            ROWLOOP { asm volatile("" ::: "memory"); ROWVARS
                if (valid) {
#pragma unroll
                    for (int bj = 0; bj < 2; ++bj) { const f32x4 a0 = acc[ai][bj][m][0], a1 = acc[ai][bj][m][1];
                        f32x4 z0, z1; z0[0] = silu(a0[0]); z0[1] = silu(a0[1]); z0[2] = silu(a0[2]); z0[3] = silu(a0[3]); z1[0] = silu(a1[0]); z1[1] = silu(a1[1]); z1[2] = silu(a1[2]); z1[3] = silu(a1[3]);
                        *(GAS u32x4*)(SZ + (size_t)grow * 1024 + c0 + 128 * bj) = PK8H(z0, z1); } } }
        } else if (pn <= 13) {
            GAS f16* QI = (GAS f16*)(ws + WS_QI); const int c0 = 256 * (pn - 10) + cl;
            ROWLOOP { asm volatile("" ::: "memory"); ROWVARS
                f32x4 c0v = {1.f, 1.f, 1.f, 1.f}, s0v = {0.f, 0.f, 0.f, 0.f}, c1v = c0v, s1v = s0v;
                const bool rp = (wc & 1) == 0;
                if (rp) { const GAS f32x4* cp = (const GAS f32x4*)(ri + (slot * 8) * 2); const f32x4 t0_ = cp[0], t1_ = cp[1], t2_ = cp[2], t3_ = cp[3];
                    c0v = (f32x4){t0_[0], t0_[2], t1_[0], t1_[2]}; s0v = (f32x4){t0_[1], t0_[3], t1_[1], t1_[3]}; c1v = (f32x4){t2_[0], t2_[2], t3_[0], t3_[2]}; s1v = (f32x4){t2_[1], t2_[3], t3_[1], t3_[3]}; }
#pragma unroll
                for (int bj = 0; bj < 2; ++bj) { f32x4 x0 = acc[ai][bj][m][0], x1 = acc[ai][bj][m][1];
                    f32x4 o0, o1; SHX4(o0, x0, 16); SHX4(o1, x1, 16);
                    if (rp && fq < 2) { if (fq == 0) { x0 = x0 * c0v - o0 * s0v; x1 = x1 * c1v - o1 * s1v; } else { x0 = x0 * c0v + o0 * s0v; x1 = x1 * c1v + o1 * s1v; } }
                    if (valid) *(GAS u32x4*)(QI + (size_t)grow * 1024 + c0 + 128 * bj) = PK8H(x0, x1); } }
        } else {
            GAS f16* UG = (GAS f16*)(ws + WS_U); const int ch = 64 * (pn - 15) + 16 * wc + 4 * fq;
            ROWLOOP { asm volatile("" ::: "memory"); ROWVARS
                const f32x4 h = acc[ai][0][m][0], b = acc[ai][0][m][1], c = acc[ai][1][m][0], z = acc[ai][1][m][1];
                const f32x4 uu = c * h; f32x4 gg; gg[0] = b[0] * silu(z[0]); gg[1] = b[1] * silu(z[1]); gg[2] = b[2] * silu(z[2]); gg[3] = b[3] * silu(z[3]);
                if (valid) { u32x4 w = {pk_f16(uu[0], uu[1]), pk_f16(uu[2], uu[3]), pk_f16(gg[0], gg[1]), pk_f16(gg[2], gg[3])};
                    *(GAS u32x4*)(UG + (size_t)grow * 2048 + 2 * ch) = w;
                    if (!smp && tt >= S - 2) *(GAS f32x4*)(out + O_CVP + ((size_t)bb * 2 + (tt - (S - 2))) * 1024 + ch) = uu;
                    if (smp && tt >= 2) *(GAS f32x4*)(out + O_CVS + ((size_t)(r >> 2) * 2 + (tt - 2)) * 1024 + ch) = uu; } }
        }
#undef ROWLOOP
#undef ROWVARS
#undef PK8B
#undef PK8H
#undef SHX4
    }
};


struct EpiOut {
    float* out; const float* xp;
    __device__ __forceinline__ bool aligned(const pg8::Unit&) const { return false; }
    __device__ __forceinline__ void init(f32x4 (&acc)[2][2][4][2], const pg8::Unit& u, int wr, int wc, int fr, int fq) const {
        const GAS float* xp = (const GAS float*)this->xp;
        const size_t base = (size_t)(u.pm * 256 + 64 * wr + fr) * DM + u.pn * 256 + 32 * wc + 4 * fq;
#pragma unroll
        for (int ai = 0; ai < 2; ++ai)
#pragma unroll
            for (int m = 0; m < 4; ++m)
#pragma unroll
                for (int bj = 0; bj < 2; ++bj)
#pragma unroll
                    for (int n = 0; n < 2; ++n) acc[ai][bj][m][n] = *(const GAS f32x4*)(xp + base + (size_t)(128 * ai + 16 * m) * DM + 128 * bj + 16 * n);
    }
    __device__ __forceinline__ void operator()(f32x4 (&acc)[2][2][4][2], const pg8::Unit& u, int wr, int wc, int fr_, int fq_) const {
        int fr = fr_, fq = fq_; asm volatile("" : "+v"(fr), "+v"(fq));
        GAS float* out = (GAS float*)this->out; asm volatile("" : "+s"(out));
        const size_t base = (size_t)(u.pm * 256 + 64 * wr + fr) * DM + u.pn * 256 + 32 * wc + 4 * fq;
#pragma unroll
        for (int ai = 0; ai < 2; ++ai)
#pragma unroll
            for (int m = 0; m < 4; ++m) { const size_t off = base + (size_t)(128 * ai + 16 * m) * DM;
#pragma unroll
                for (int bj = 0; bj < 2; ++bj)
#pragma unroll
                    for (int n = 0; n < 2; ++n) *(GAS f32x4*)(out + off + 128 * bj + 16 * n) = acc[ai][bj][m][n]; }
    }
};
__device__ __forceinline__ void p4_sample(const Args& a, LAS unsigned char* lds, int bx, int G, int tid) {
    const GAS f16* MIX = (const GAS f16*)(a.ws + WS_MIX) + (size_t)MP * DM; const GAS f16* WT = (const GAS f16*)(a.ws + WS_WOUTT);
    LAS float* part = (LAS float*)lds;
    const int lane = tid & 63, wave = __builtin_amdgcn_readfirstlane(tid >> 6), fr = lane & 15, fq = lane >> 4;
    for (int cg = bx; cg < DM / 8; cg += G) {
        const GAS f16* wp = WT + (size_t)(cg * 8 + (fr & 7)) * DM + wave * 256 + 8 * fq; const GAS f16* mp = MIX + (size_t)fr * DM + wave * 256 + 8 * fq;
        f16x8 wf[8], m0[8], m1[8];
#pragma unroll
        for (int ks = 0; ks < 8; ++ks) { wf[ks] = *(const GAS f16x8*)(wp + 32 * ks); m0[ks] = *(const GAS f16x8*)(mp + 32 * ks); m1[ks] = *(const GAS f16x8*)(mp + (size_t)16 * DM + 32 * ks); }
        f32x4 c0 = {0.f, 0.f, 0.f, 0.f}, c1 = {0.f, 0.f, 0.f, 0.f};
#pragma unroll
        for (int ks = 0; ks < 8; ++ks) { c0 = __builtin_amdgcn_mfma_f32_16x16x32_f16(wf[ks], m0[ks], c0, 0, 0, 0); c1 = __builtin_amdgcn_mfma_f32_16x16x32_f16(wf[ks], m1[ks], c1, 0, 0, 0); }
        *(LAS f32x4*)(part + ((wave * 2 + 0) * 64 + lane) * 4) = c0; *(LAS f32x4*)(part + ((wave * 2 + 1) * 64 + lane) * 4) = c1;
        __syncthreads();
        if (tid < 256) { const int rr = tid >> 3, cc = tid & 7; const int ln = (rr & 15) + 16 * (cc >> 2), tl = rr >> 4; float s = a.in[1][(size_t)rr * DM + cg * 8 + cc];
#pragma unroll
            for (int w = 0; w < 8; ++w) s += part[((w * 2 + tl) * 64 + ln) * 4 + (cc & 3)];
            a.out[O_YS + (size_t)rr * DM + cg * 8 + cc] = s; }
        __syncthreads();
    }
}
typedef GAS unsigned gu32;
#define XB_TMO      128
#define XB_XCNT(j)  (256  + 64 * (j))
#define XB_XSUB(j)  (1280 + 64 * (j))
#define XB_XGEN(j)  (2304 + 64 * (j))
#define XB_TOP      3328
#define XB_TOPGEN   3392
#define XCD_BAR_WORDS 3456
#define XB_SPIN_CAP (1u << 18)
__device__ __forceinline__ unsigned xb_ld(unsigned* p)              { return __hip_atomic_load(p, __ATOMIC_RELAXED, __HIP_MEMORY_SCOPE_AGENT); }
__device__ __forceinline__ unsigned xb_add(unsigned* p, unsigned v) { return __hip_atomic_fetch_add(p, v, __ATOMIC_RELAXED, __HIP_MEMORY_SCOPE_AGENT); }
__device__ __forceinline__ unsigned xb_xcc_id() { return (unsigned)__builtin_amdgcn_s_getreg((3 << 11) | 20) & 0xFu; }
#define XB_SPIN(cond, bar) do { unsigned _sp = 0; while (cond) { __builtin_amdgcn_s_sleep(1); \
    if ((++_sp & 255u) == 0u) { if (xb_ld(&(bar)[XB_TMO])) break; if (_sp > XB_SPIN_CAP) { atomicAdd(&(bar)[XB_TMO], 1u); break; } } } } while (0)
struct XcdBarrier { unsigned* bar; unsigned x; volatile LAS unsigned* st; };
__device__ __forceinline__ XcdBarrier xcd_barrier_post(unsigned* bar, volatile LAS unsigned* st) {
    XcdBarrier b; b.bar = bar; b.x = xb_xcc_id(); b.st = st;
    if (threadIdx.x == 0) (void)xb_add(&bar[XB_XCNT(b.x)], 1u);
    return b;
}
__device__ __forceinline__ void xcd_barrier_complete(unsigned* bar, unsigned x, unsigned& nloc, unsigned& nx) {
    const unsigned G = gridDim.x * gridDim.y * gridDim.z;
    unsigned sum, cnt, mine, sp = 0u;
    for (;;) {
        sum = 0u; cnt = 0u; mine = 0u;
#pragma unroll
        for (unsigned j = 0; j < 16; ++j) { const unsigned c = xb_ld(&bar[XB_XCNT(j)]); sum += c; cnt += (c > 0u) ? 1u : 0u; mine = (j == x) ? c : mine; }
        if (sum == G) break;
        __builtin_amdgcn_s_sleep(1);
        if ((++sp & 255u) == 0u) { if (xb_ld(&bar[XB_TMO])) break; if (sp > XB_SPIN_CAP) { atomicAdd(&bar[XB_TMO], 1u); break; } }
    }
    nloc = mine > 0u ? mine : 1u; nx = cnt > 0u ? cnt : 1u;
}
__device__ __forceinline__ void xcd_barrier(const XcdBarrier& b) {
    asm volatile("s_waitcnt vmcnt(0)" ::: "memory");
    __syncthreads();
    if (threadIdx.x == 0) {
        unsigned* bar = b.bar;
        __builtin_amdgcn_s_waitcnt(0);
        unsigned nloc = b.st[0], nx = b.st[1];
        if (nloc == 0u) { xcd_barrier_complete(bar, b.x, nloc, nx); b.st[0] = nloc; b.st[1] = nx; }
        const unsigned old = xb_add(&bar[XB_XSUB(b.x)], 1u);
        const unsigned gen = old / nloc;
        if (old + 1u == (gen + 1u) * nloc) {
            __builtin_amdgcn_fence(__ATOMIC_RELEASE, "agent");
            asm volatile("s_waitcnt vmcnt(0)" ::: "memory");
            const unsigned og = xb_add(&bar[XB_TOP], 1u);
            const unsigned tg = og / nx;
            if (og + 1u == (tg + 1u) * nx) xb_add(&bar[XB_TOPGEN], 1u);
            else XB_SPIN(xb_ld(&bar[XB_TOPGEN]) == tg, bar);
            __builtin_amdgcn_fence(__ATOMIC_ACQUIRE, "agent");
            xb_add(&bar[XB_XGEN(b.x)], 1u);
            asm volatile("s_waitcnt vmcnt(0)" ::: "memory");
        } else {
            XB_SPIN(xb_ld(&bar[XB_XGEN(b.x)]) == gen, bar);
            __builtin_amdgcn_fence(__ATOMIC_ACQUIRE, "agent");
            asm volatile("s_waitcnt vmcnt(0)" ::: "memory");
        }
    }
    __syncthreads();
}

constexpr int RDY_WORD0 = 4096;
__device__ __forceinline__ void signal_add(unsigned* ctr) {
    asm volatile("s_waitcnt vmcnt(0)" ::: "memory");
    __syncthreads();
    if (threadIdx.x == 0) { __builtin_amdgcn_fence(__ATOMIC_RELEASE, "agent"); asm volatile("s_waitcnt vmcnt(0)" ::: "memory"); (void)xb_add(ctr, 1u); }
}
__device__ __forceinline__ void wait_ge(unsigned* ctr, unsigned need) {
    if (threadIdx.x == 0) { unsigned sp = 0; while (xb_ld(ctr) < need) { __builtin_amdgcn_s_sleep(2); if (++sp > (1u << 22)) break; }
        __builtin_amdgcn_fence(__ATOMIC_ACQUIRE, "agent"); asm volatile("s_waitcnt vmcnt(0)" ::: "memory"); }
    __syncthreads();
}

__device__ __forceinline__ void signal_add_wt(unsigned* ctr) {
    asm volatile("s_waitcnt vmcnt(0)" ::: "memory");
    __syncthreads();
    if (threadIdx.x == 0) (void)xb_add(ctr, 1u);
}
__device__ __forceinline__ void wait_ge_wt(unsigned* ctr, unsigned need) {
    if (threadIdx.x == 0) { unsigned sp = 0; while (xb_ld(ctr) < need) { __builtin_amdgcn_s_sleep(2); if (++sp > (1u << 22)) break; } }
    __syncthreads();
}

#ifndef P2_KT_REP
#define P2_KT_REP 1
#define P2_SEL_REP 1
#endif
#ifndef P2_REP_A
#define P2_REP_A 1
#define P2_REP_B 1
#define P2_REP_C 1
#endif
constexpr int SC_STRIDE = 2052;
constexpr int SC_BYTES = 16 * SC_STRIDE * 4;
constexpr int WSCR_OFF = 131584, WSCR_BYTES = 1536;
__device__ __forceinline__ f16x8 cvt8(f32x4 a, f32x4 b) { u32x4 w = {pk_f16(a[0], a[1]), pk_f16(a[2], a[3]), pk_f16(b[0], b[1]), pk_f16(b[2], b[3])}; return __builtin_bit_cast(f16x8, w); }

__device__ __forceinline__ void p2_convmix(const Args& a, int gw, int NGW, int lane) {
    const GAS f16* UG = (const GAS f16*)(a.ws + WS_U); GAS f16* MIX = (GAS f16*)(a.ws + WS_MIX);
    const GAS float* wconv = (const GAS float*)a.in[12]; const GAS float* state = (const GAS float*)a.in[5];
    for (int ch = gw; ch < MT / 4; ch += NGW) {
        const int row0 = 4 * ch; const bool smp = row0 >= MP; const int t0 = smp ? 0 : (row0 & (S - 1)); const int seq = (row0 - MP) >> 2;
#pragma unroll
        for (int half = 0; half < 2; ++half) { const int cb = half * 512 + 8 * lane;
            float um2[8], um1[8], w0[8], w1[8], w2[8];
#pragma unroll
            for (int e = 0; e < 8; e += 4) { const f32x4 a0 = *(const GAS f32x4*)(wconv + cb + e), a1 = *(const GAS f32x4*)(wconv + 1024 + cb + e), a2 = *(const GAS f32x4*)(wconv + 2048 + cb + e);
#pragma unroll
                for (int i = 0; i < 4; ++i) { w0[e + i] = a0[i]; w1[e + i] = a1[i]; w2[e + i] = a2[i]; } }
            if (t0 == 0) {
                if (smp) {
#pragma unroll
                    for (int e = 0; e < 8; e += 4) { const f32x4 s0 = *(const GAS f32x4*)(state + ((size_t)seq * 2) * 1024 + cb + e), s1 = *(const GAS f32x4*)(state + ((size_t)seq * 2 + 1) * 1024 + cb + e);
#pragma unroll
                        for (int i = 0; i < 4; ++i) { um2[e + i] = s0[i]; um1[e + i] = s1[i]; } }
                } else {
#pragma unroll
                    for (int e = 0; e < 8; ++e) { um2[e] = 0.f; um1[e] = 0.f; } }
            } else {
#pragma unroll
                for (int gq = 0; gq < 2; ++gq) { const f16x4 p2 = *(const GAS f16x4*)(UG + (size_t)(row0 - 2) * 2048 + 2 * cb + 8 * gq), p1 = *(const GAS f16x4*)(UG + (size_t)(row0 - 1) * 2048 + 2 * cb + 8 * gq);
#pragma unroll
                    for (int e = 0; e < 4; ++e) { um2[4 * gq + e] = (float)p2[e]; um1[4 * gq + e] = (float)p1[e]; } } }
#pragma unroll
            for (int i = 0; i < 4; ++i) { const size_t row = row0 + i;
                const f16x8 x0 = *(const GAS f16x8*)(UG + row * 2048 + 2 * cb), x1 = *(const GAS f16x8*)(UG + row * 2048 + 2 * cb + 8); float o[8];
#pragma unroll
                for (int e = 0; e < 8; ++e) { const float u = (float)(e < 4 ? x0[e] : x1[e - 4]); const float g = (float)(e < 4 ? x0[4 + e] : x1[e]);
                    const float cv = w0[e] * um2[e] + w1[e] * um1[e] + w2[e] * u; o[e] = g * cv; um2[e] = um1[e]; um1[e] = u; }
                u32x4 w = {pk_f16(o[0], o[1]), pk_f16(o[2], o[3]), pk_f16(o[4], o[5]), pk_f16(o[6], o[7])};
                *(GAS u32x4*)(MIX + row * 2048 + 1024 + cb) = w; }
        }
    }
}

__device__ __forceinline__ void p2_sscore(const Args& a, int gw, int NGW, int lane) {
    const GAS float* cki = (const GAS float*)a.in[4]; const GAS int* ptab = (const GAS int*)a.in[6];
    const GAS f16* QI = (const GAS f16*)(a.ws + WS_QI); const GAS float* WI = (const GAS float*)(a.ws + WS_WI); GAS float* SSC = (GAS float*)(a.ws + WS_SSC);
    const int fr = lane & 15, fq = lane >> 4;
    for (int it = gw; it < NSB * 256; it += NGW) {
        const int sb = it >> 8, hp = it & 255, pg = hp >> 1, k0 = (hp & 1) * 64; const int phys = ptab[sb * NPAGES + pg];
        const GAS float* kbase = cki + ((size_t)phys * PAGE + k0) * 64;
        f16x8 qf[4][2]; f32x4 wv[4];
#pragma unroll
        for (int t = 0; t < 4; ++t) { const size_t row = MP + 4 * sb + t;
            qf[t][0] = *(const GAS f16x8*)(QI + row * 1024 + fr * 64 + 8 * fq); qf[t][1] = *(const GAS f16x8*)(QI + row * 1024 + fr * 64 + 32 + 8 * fq);
            wv[t] = *(const GAS f32x4*)(WI + row * 16 + 4 * fq); }
#pragma unroll
        for (int tile = 0; tile < 4; ++tile) {
            const GAS float* kr = kbase + (size_t)(16 * tile + fr) * 64 + 8 * fq;
            const f16x8 kf0 = cvt8(*(const GAS f32x4*)kr, *(const GAS f32x4*)(kr + 4)), kf1 = cvt8(*(const GAS f32x4*)(kr + 32), *(const GAS f32x4*)(kr + 36));
            float mine = 0.f;
#pragma unroll
            for (int t = 0; t < 4; ++t) { f32x4 c = {0.f, 0.f, 0.f, 0.f};
                c = __builtin_amdgcn_mfma_f32_16x16x32_f16(qf[t][0], kf0, c, 0, 0, 0); c = __builtin_amdgcn_mfma_f32_16x16x32_f16(qf[t][1], kf1, c, 0, 0, 0);
                float s = wv[t][0] * fmaxf(c[0], 0.f) + wv[t][1] * fmaxf(c[1], 0.f) + wv[t][2] * fmaxf(c[2], 0.f) + wv[t][3] * fmaxf(c[3], 0.f);
                s += __shfl_xor(s, 16); s += __shfl_xor(s, 32);
                mine = fq == t ? s : mine; }
            __hip_atomic_store((GAS unsigned*)SSC + ((size_t)(4 * sb + fq) * PAST + pg * PAGE + k0 + 16 * tile + fr), __builtin_bit_cast(unsigned, mine), __ATOMIC_RELAXED, __HIP_MEMORY_SCOPE_AGENT);
        }
    }
}

__device__ __forceinline__ void wave_topk_mask(const LAS float* row, int t, GAS unsigned long long* mrow, int lane, LAS unsigned* hist, LAS float* cand) {
    const float NINF = -__builtin_inff(), PINF = __builtin_inff();
    const int jmax = t >> 6;
    const int rem = t - lane;
    float v[32]; float mx = NINF, mn = PINF;
#pragma unroll
    for (int g = 0; g < 4; ++g) {
        if (8 * g <= jmax) {
#pragma unroll
            for (int jj = 0; jj < 8; ++jj) { const int j = 8 * g + jj; const float x = row[64 * j + lane]; const bool ok = 64 * j <= rem; v[j] = ok ? x : NINF; mx = fmaxf(mx, v[j]); mn = fminf(mn, ok ? x : PINF); }
        } else {
#pragma unroll
            for (int jj = 0; jj < 8; ++jj) v[8 * g + jj] = NINF; } }
    mx = wave_max_dpp(mx); mn = -wave_max_dpp(-mn);
    *(LAS u32x4*)(hist + 4 * lane) = (u32x4){0u, 0u, 0u, 0u};
    const float scale = 255.5f / (mx - mn), off = -mn * scale;
    float tau = 0.f; bool have = false;
    if (mx > mn) {
        asm volatile("s_waitcnt lgkmcnt(0)" ::: "memory");
        unsigned bins[32];
#pragma unroll
        for (int g = 0; g < 4; ++g) {
            if (8 * g <= jmax) {
#pragma unroll
                for (int jj = 0; jj < 8; ++jj) { const int j = 8 * g + jj; unsigned b = (unsigned)fmaf(v[j], scale, off); b = b > 255u ? 255u : b; bins[j] = b;
                    __hip_atomic_fetch_add(hist + b, 1u, __ATOMIC_RELAXED, __HIP_MEMORY_SCOPE_WORKGROUP); }
            } else {
#pragma unroll
                for (int jj = 0; jj < 8; ++jj) bins[8 * g + jj] = 0u; } }
        asm volatile("s_waitcnt lgkmcnt(0)" ::: "memory");
        const u32x4 h = *(const LAS u32x4*)(hist + 4 * lane);
        const unsigned sl = h[0] + h[1] + h[2] + h[3]; const unsigned pre = wave_scan_dpp(sl);
        const unsigned tot = __builtin_amdgcn_readlane(pre, 63); const unsigned suf = tot - pre + sl;
        const unsigned long long bm = __ballot(suf >= TOPK);
        const int Ls = 63 - __builtin_clzll(bm);
        unsigned c = __builtin_amdgcn_readlane(suf, Ls) - __builtin_amdgcn_readlane(sl, Ls);
        const unsigned h3 = __builtin_amdgcn_readlane(h[3], Ls), h2 = __builtin_amdgcn_readlane(h[2], Ls), h1 = __builtin_amdgcn_readlane(h[1], Ls);
        int Bs;
        if (c + h3 >= TOPK) Bs = 4 * Ls + 3; else { c += h3; if (c + h2 >= TOPK) Bs = 4 * Ls + 2; else { c += h2; if (c + h1 >= TOPK) Bs = 4 * Ls + 1; else { c += h1; Bs = 4 * Ls; } } }
        const int need = TOPK - (int)c;
        if (Bs > 0) {
            int base = 0;
#pragma unroll
            for (int g = 0; g < 4; ++g) {
                if (8 * g <= jmax) {
#pragma unroll
                    for (int jj = 0; jj < 8; ++jj) { const int j = 8 * g + jj; const bool isc = bins[j] == (unsigned)Bs;
                        const unsigned long long m = __ballot(isc);
                        if (m) { const int pos = base + (int)__builtin_amdgcn_mbcnt_hi((unsigned)(m >> 32), __builtin_amdgcn_mbcnt_lo((unsigned)m, 0u)); if (isc && pos < 64) cand[pos] = v[j]; base += __builtin_popcountll(m); } } } }
            if (base <= 64) {
                asm volatile("s_waitcnt lgkmcnt(0)" ::: "memory");
                const float x = lane < base ? cand[lane] : NINF; int rank = 0;
                for (int m = 0; m < base; ++m) { const float y = __builtin_bit_cast(float, __builtin_amdgcn_readlane(__builtin_bit_cast(int, x), m)); rank += y > x ? 1 : 0; }
                float tc = (lane < base && rank <= need - 1) ? x : PINF;
                tau = -wave_max_dpp(-tc); have = true;
            }
        }
    }
    if (!have) {
        unsigned tk = 0u;
        for (int bit = 31; bit >= 0; --bit) { const unsigned cd = tk | (1u << bit); int cnt = 0;
#pragma unroll
            for (int j = 0; j < 32; ++j) cnt += __builtin_popcountll(__ballot((64 * j + lane <= t) && fkey(v[j]) >= cd));
            if (cnt >= TOPK) tk = cd; }
        tau = __builtin_bit_cast(float, (tk & 0x80000000u) ? (tk ^ 0x80000000u) : ~tk);
    }
    unsigned wlo = 0u, whi = 0u;
#pragma unroll
    for (int g = 0; g < 4; ++g) {
        if (8 * g <= jmax) {
#pragma unroll
            for (int jj = 0; jj < 8; ++jj) { const int j = 8 * g + jj; const unsigned long long m = __ballot(v[j] >= tau);
                if (lane == j) { wlo = (unsigned)m; whi = (unsigned)(m >> 32); } } } }
    if (lane < 32) __hip_atomic_store(mrow + lane, ((unsigned long long)whi << 32) | wlo, __ATOMIC_RELAXED, __HIP_MEMORY_SCOPE_AGENT);
}

#define RELU_FMA(acc_, c_, w_) do { const float f_ = (c_); const int i_ = __builtin_bit_cast(int, f_); const float r_ = __builtin_bit_cast(float, i_ > 0 ? i_ : 0); asm("v_fmac_f32_e32 %0, %1, %2" : "+v"(acc_) : "v"(r_), "v"(w_)); } while (0)
__device__ __forceinline__ void p2_index_tile(const Args& a, LAS unsigned char* lds, int b, int t0, int wave, int lane) {
    const GAS f16* QI = (const GAS f16*)(a.ws + WS_QI); const GAS float* WI = (const GAS float*)(a.ws + WS_WI); const GAS f16* KI = (const GAS f16*)(a.ws + WS_KI);
    GAS unsigned long long* MASK = (GAS unsigned long long*)(a.ws + WS_MASK);
    LAS float* sc = (LAS float*)lds;
    const int fr = lane & 15, fq = lane >> 4; const size_t rowq = (size_t)b * S + t0 + fr;
    f16x8 qf[16][2]; float w[16];
#pragma unroll
    for (int h = 0; h < 16; ++h) { qf[h][0] = *(const GAS f16x8*)(QI + rowq * 1024 + h * 64 + 8 * fq); qf[h][1] = *(const GAS f16x8*)(QI + rowq * 1024 + h * 64 + 32 + 8 * fq); }
#pragma unroll
    for (int h = 0; h < 16; h += 4) { const f32x4 x = *(const GAS f32x4*)(WI + rowq * 16 + h); w[h] = x[0]; w[h + 1] = x[1]; w[h + 2] = x[2]; w[h + 3] = x[3]; }
    const int nkt = (t0 + 16) >> 4;
    const GAS f16* kp = KI + ((size_t)b * S + fr) * 64 + 8 * fq;
#define KLOAD(d0_, d1_, kt_) do { const int k_ = (kt_) < nkt ? (kt_) : wave; d0_ = *(const GAS f16x8*)(kp + (size_t)k_ * 1024); d1_ = *(const GAS f16x8*)(kp + (size_t)k_ * 1024 + 32); } while (0)
    f16x8 ka0, ka1, kb0, kb1, kc0, kc1;
#define KCOMP(kf0, kf1, kt_) do { float a0 = 0.f, a1 = 0.f, a2 = 0.f, a3 = 0.f; const f32x4 z4 = {0.f, 0.f, 0.f, 0.f}; \
        f32x4 cc = __builtin_amdgcn_mfma_f32_16x16x32_f16(kf0, qf[0][0], z4, 0, 0, 0); cc = __builtin_amdgcn_mfma_f32_16x16x32_f16(kf1, qf[0][1], cc, 0, 0, 0); \
        _Pragma("unroll") for (int h = 0; h < 16; ++h) { f32x4 cn = z4;        \
            if (h < 15) { cn = __builtin_amdgcn_mfma_f32_16x16x32_f16(kf0, qf[h + 1][0], z4, 0, 0, 0); cn = __builtin_amdgcn_mfma_f32_16x16x32_f16(kf1, qf[h + 1][1], cn, 0, 0, 0); } \
            RELU_FMA(a0, cc[0], w[h]); RELU_FMA(a1, cc[1], w[h]); RELU_FMA(a2, cc[2], w[h]); RELU_FMA(a3, cc[3], w[h]); \
            cc = cn; __builtin_amdgcn_sched_barrier(0); } \
        *(LAS f32x4*)(sc + fr * SC_STRIDE + 16 * (kt_) + 4 * fq) = (f32x4){a0, a1, a2, a3}; } while (0)
    KLOAD(ka0, ka1, wave); KLOAD(kb0, kb1, wave + NWAVES);
    for (int rpk = 0; rpk < P2_KT_REP; ++rpk)
    for (int kt = wave; kt < nkt; kt += 3 * NWAVES) {
        KLOAD(kc0, kc1, kt + 2 * NWAVES); KCOMP(ka0, ka1, kt);
        if (kt + NWAVES < nkt) { KLOAD(ka0, ka1, kt + 3 * NWAVES); KCOMP(kb0, kb1, kt + NWAVES); }
        if (kt + 2 * NWAVES < nkt) { KLOAD(kb0, kb1, kt + 4 * NWAVES); KCOMP(kc0, kc1, kt + 2 * NWAVES); }
    }
#undef KCOMP
#undef KLOAD
    __syncthreads();
#pragma unroll 1
    for (int qq = 0; qq < 2 * P2_SEL_REP; ++qq) { const int q = 2 * wave + (qq & 1); const int t = t0 + q;
        wave_topk_mask(sc + q * SC_STRIDE, t, MASK + ((size_t)b * S + t) * 32, lane, (LAS unsigned*)(lds + WSCR_OFF + wave * WSCR_BYTES), (LAS float*)(lds + WSCR_OFF + wave * WSCR_BYTES + 1024)); }
    __syncthreads();
}

__device__ __forceinline__ void p2_phase(const Args& a, LAS unsigned char* lds, int vcu, int G, int wave, int lane) {
    const int gw = vcu * NWAVES + wave, NGW = G * NWAVES;
    unsigned* rdy = (unsigned*)a.ws + RDY_WORD0;
    for (int rp = 0; rp < P2_REP_A; ++rp) p2_sscore(a, gw, NGW, lane);
    signal_add_wt(rdy + 64 * 32);
    { GAS unsigned long long* MASK = (GAS unsigned long long*)(a.ws + WS_MASK);
      for (int i = gw * 64 + lane; i < NB * TOPK * 32; i += NGW * 64) { const int wd = i & 31, t = (i >> 5) & (TOPK - 1), b = i >> 13; const int lo = 64 * wd;
          const unsigned long long m = lo + 63 <= t ? ~0ull : (lo > t ? 0ull : ((1ull << (t - lo + 1)) - 1ull));
          __hip_atomic_store(MASK + ((size_t)b * S + t) * 32 + wd, m, __ATOMIC_RELAXED, __HIP_MEMORY_SCOPE_AGENT); } }
    signal_add_wt(rdy + 64 * 33);
    constexpr int NT = NB * (S - TOPK) / 16;
    for (int rp = 0; rp < P2_REP_C; ++rp)
    for (int r = 0; r * G < NT; ++r) { const int k = (r & 1) ? (r + 1) * G - 1 - vcu : r * G + vcu;
        if (k < NT) { const int j = (NT / NB - 1) - (k >> 2), b = k & 3; p2_index_tile(a, lds, b, TOPK + 16 * j, wave, lane);
            if (rp == 0) signal_add_wt(rdy + 64 * (40 + b * 32 + ((TOPK + 16 * j) >> 6))); } }
}

#ifndef P3_REP_S
#define P3_REP_S 1
#define P3_REP_A 1
#endif
namespace att {
typedef short bf16x8 __attribute__((ext_vector_type(8)));
typedef short s16x4 __attribute__((ext_vector_type(4)));
typedef float f32x16 __attribute__((ext_vector_type(16)));
constexpr int QBLK = 32, KVBLK = 64, D = 128;
constexpr int SHM_V = KVBLK * D * 2, SHM_K = KVBLK * D * 2;
constexpr int WS_OFF = 2 * SHM_V + 2 * SHM_K;
constexpr float SCALE = 0.08838834764831845f;
#define KSWZ(row, colB) ((row) * 256 + ((colB) ^ (((row) & 7) << 4)))
#define SBAR() __builtin_amdgcn_sched_barrier(0)
__device__ __forceinline__ int v_st(int k, int c) { const int kk = (k & ~0xC) | ((k & 4) << 1) | ((k & 8) >> 1); return ((kk >> 3) * 4 + (c >> 5)) * 512 + ((kk & 7) * 32 + (c & 31)) * 2; }
__device__ __forceinline__ int v_rd_base(int lane) { return ((lane & 3) << 3) | (((lane >> 2) & 3) << 6) | (((lane >> 4) & 1) << 5) | (((lane >> 5) & 1) << 8); }
constexpr int v_rd_off(int d0, int ks, int half) { return d0 * 512 + ks * 4096 + half * 2048; }
__device__ __forceinline__ int crow(int r, int hi) { return (r & 3) + 8 * (r >> 2) + 4 * hi; }
__device__ __forceinline__ unsigned cvtpk(float lo, float hi) { return pk_bf16(lo, hi); }

template <int KB>
__device__ __forceinline__ void qkt(f32x16& p0, f32x16& p1, const LAS unsigned char* K_lds, int r32, int hi, const LAS unsigned char* qp) {
    p0 = f32x16{}; p1 = f32x16{};
    const LAS unsigned char* kb[4];
#pragma unroll
    for (int dd = 0; dd < 4; ++dd) kb[dd] = K_lds + KB * SHM_K + KSWZ(r32, (dd * 16 + hi * 8) * 2);
#pragma unroll
    for (int d0 = 0; d0 < 8; ++d0) { const LAS unsigned char* a = kb[d0 & 3] + (d0 >> 2) * 128;
        const bf16x8 b0 = *(const LAS bf16x8*)a;
        const bf16x8 b1 = *(const LAS bf16x8*)(a + 32 * 256);
        const bf16x8 qv = *(const LAS bf16x8*)(qp + d0 * 1024);
        p0 = __builtin_amdgcn_mfma_f32_32x32x16_bf16(b0, qv, p0, 0, 0, 0);
        p1 = __builtin_amdgcn_mfma_f32_32x32x16_bf16(b1, qv, p1, 0, 0, 0); }
}
template <int VB>
__device__ __forceinline__ void pv_tile(f32x16* o, int vb0, bf16x8 pa0, bf16x8 pa1, bf16x8 pa2, bf16x8 pa3) {
#define TRRD(dst, off) asm volatile("ds_read_b64_tr_b16 %0, %1 offset:%2" : "=&v"(dst) : "v"(vb0), "i"(off) : "memory")
#define PV_D0(d0) do { s16x4 l0, l1, l2, l3, h0, h1, h2, h3; constexpr int b_ = VB * SHM_V + v_rd_off(d0, 0, 0); \
        TRRD(l0, b_); TRRD(h0, b_ + 2048); TRRD(l1, b_ + 4096); TRRD(h1, b_ + 6144); TRRD(l2, b_ + 8192); TRRD(h2, b_ + 10240); TRRD(l3, b_ + 12288); TRRD(h3, b_ + 14336); \
        asm volatile("s_waitcnt lgkmcnt(0)" ::: "memory"); SBAR(); \
        o[d0] = __builtin_amdgcn_mfma_f32_32x32x16_bf16(pa0, (bf16x8){l0[0], l0[1], l0[2], l0[3], h0[0], h0[1], h0[2], h0[3]}, o[d0], 0, 0, 0); \
        o[d0] = __builtin_amdgcn_mfma_f32_32x32x16_bf16(pa1, (bf16x8){l1[0], l1[1], l1[2], l1[3], h1[0], h1[1], h1[2], h1[3]}, o[d0], 0, 0, 0); \
        o[d0] = __builtin_amdgcn_mfma_f32_32x32x16_bf16(pa2, (bf16x8){l2[0], l2[1], l2[2], l2[3], h2[0], h2[1], h2[2], h2[3]}, o[d0], 0, 0, 0); \
        o[d0] = __builtin_amdgcn_mfma_f32_32x32x16_bf16(pa3, (bf16x8){l3[0], l3[1], l3[2], l3[3], h3[0], h3[1], h3[2], h3[3]}, o[d0], 0, 0, 0); } while (0)
    PV_D0(0); PV_D0(1); PV_D0(2); PV_D0(3);
#undef PV_D0
#undef TRRD
}
__device__ __forceinline__ void partialSM(f32x16& p0, f32x16& p1, unsigned wl, unsigned wh, float sh2) {
    const float NEG = -__builtin_inff(); constexpr float C2 = 1.4426950408889634f * SCALE;
#pragma unroll
    for (int r = 0; r < 16; ++r) { const unsigned bit = 1u << ((r & 3) + 8 * (r >> 2));
        p0[r] = (wl & bit) ? fmaf(p0[r], C2, -sh2) : NEG; p1[r] = (wh & bit) ? fmaf(p1[r], C2, -sh2) : NEG; }
#pragma unroll
    for (int r = 0; r < 16; ++r) p0[r] = __builtin_amdgcn_exp2f(p0[r]);
}
__device__ __forceinline__ void finishSM(f32x16& p0, f32x16& p1, float& l_reg, bf16x8& pa0, bf16x8& pa1, bf16x8& pa2, bf16x8& pa3) {
#pragma unroll
    for (int r = 0; r < 16; ++r) p1[r] = __builtin_amdgcn_exp2f(p1[r]);
    float ps = 0;
#pragma unroll
    for (int r = 0; r < 16; ++r) ps += p0[r];
#pragma unroll
    for (int r = 0; r < 16; ++r) ps += p1[r];
    l_reg += ps;
#define PK4(P, B_, OUT) do { unsigned a0 = cvtpk(P[B_+0], P[B_+1]), a1 = cvtpk(P[B_+2], P[B_+3]); \
        unsigned b0 = cvtpk(P[B_+4], P[B_+5]), b1 = cvtpk(P[B_+6], P[B_+7]); \
        auto r0 = __builtin_amdgcn_permlane32_swap(a0, b0, false, false); auto r1 = __builtin_amdgcn_permlane32_swap(a1, b1, false, false); \
        u32x4 w = {r0[0], r1[0], r0[1], r1[1]}; OUT = __builtin_bit_cast(bf16x8, w); } while (0)
    PK4(p0, 0, pa0); PK4(p0, 8, pa1); PK4(p1, 0, pa2); PK4(p1, 8, pa3);
#undef PK4
}

__device__ __forceinline__ __amdgpu_buffer_rsrc_t mk_rsrc(const GAS void* p, unsigned bytes) {
    const unsigned long long u = (unsigned long long)p; const unsigned lo = __builtin_amdgcn_readfirstlane((unsigned)u), hi = __builtin_amdgcn_readfirstlane((unsigned)(u >> 32));
    return __builtin_amdgcn_make_buffer_rsrc((void*)(((unsigned long long)hi << 32) | lo), (short)0, (int)bytes, 0x00020000);
}
__device__ __forceinline__ void attn_block(const Args& a, LAS unsigned char* lds, int b, int kvh, int q0, float sh2) {
    int tid_ = threadIdx.x; asm volatile("" : "+v"(tid_));
    const int tid = tid_, wid = __builtin_amdgcn_readfirstlane(tid >> 6), lane = tid & 63, r32 = lane & 31, hi = lane >> 5;
    const int head = 4 * kvh + (wid >> 1), qw = q0 + 32 * (wid & 1);
    const GAS bf16_t* Qw = (const GAS bf16_t*)(a.ws + WS_QB) + (((size_t)b * NH + head) * S + qw) * D;
    const GAS bf16_t* Kh = (const GAS bf16_t*)(a.ws + WS_KB) + ((size_t)b * NKV + kvh) * S * D;
    const GAS bf16_t* Vh = (const GAS bf16_t*)(a.ws + WS_VB) + ((size_t)b * NKV + kvh) * S * D;
    const __amdgpu_buffer_rsrc_t rK = mk_rsrc(Kh, S * D * 2), rV = mk_rsrc(Vh, S * D * 2), rM = mk_rsrc((const GAS unsigned long long*)(a.ws + WS_MASK) + ((size_t)b * S + qw) * 32, 32 * 256);
    const unsigned moff = (unsigned)r32 * 256u;
    const int NT = q0 / KVBLK + 1;
    LAS unsigned char* V_lds = lds; LAS unsigned char* K_lds = lds + 2 * SHM_V;
    const int sr = tid >> 4, sc = (tid & 15) * 8, vst0 = v_st(sr, sc), vst1 = v_st(32 + sr, sc), kws = KSWZ(sr, sc * 2);
    const int vb0 = (int)(unsigned)(size_t)V_lds + v_rd_base(lane); const unsigned kvoff = (unsigned)(sr * D + sc) * 2u;
    bf16x8 st_v0, st_v1, st_k0, st_k1;
    LAS unsigned char* qp = lds + WS_OFF + 2048 + wid * 8192 + lane * 16;
#define VMW() asm volatile("s_waitcnt vmcnt(0)" ::: "memory")
#define BL128(r_, so_) __builtin_bit_cast(bf16x8, __builtin_amdgcn_raw_buffer_load_b128(r_, kvoff, (so_), 0))
#define SLOAD_H(k0) do { const int so_ = (k0) * 256; st_v0 = BL128(rV, so_); st_v1 = BL128(rV, so_ + 8192); st_k0 = BL128(rK, so_); st_k1 = BL128(rK, so_ + 8192); } while (0)
#define SWRITE_HK(bf) do { *(LAS bf16x8*)(K_lds + (bf) * SHM_K + kws) = st_k0; *(LAS bf16x8*)(K_lds + (bf) * SHM_K + kws + 32 * 256) = st_k1; } while (0)
#define SWRITE_HV(bf) do { *(LAS bf16x8*)(V_lds + (bf) * SHM_V + vst0) = st_v0; *(LAS bf16x8*)(V_lds + (bf) * SHM_V + vst1) = st_v1; } while (0)
#define SWRITE_H(bf) do { SWRITE_HV(bf); SWRITE_HK(bf); } while (0)
#define MLOAD(t) __builtin_bit_cast(unsigned long long, __builtin_amdgcn_raw_buffer_load_b64(rM, moff, (t) * 8, 16))
#define MSPLIT(mw, wl, wh) do { wl = (unsigned)(mw) >> (4 * hi); wh = (unsigned)((mw) >> 32) >> (4 * hi); } while (0)
    { bf16x8 qt[8];
#pragma unroll
      for (int d0 = 0; d0 < 8; ++d0) qt[d0] = *(const GAS bf16x8*)(Qw + (unsigned)(r32 * D + d0 * 16 + hi * 8));
#pragma unroll
      for (int d0 = 0; d0 < 8; ++d0) *(LAS bf16x8*)(qp + d0 * 1024) = qt[d0]; }
    SLOAD_H(0); unsigned long long mwA = MLOAD(0), mwB = 0ull; VMW(); SWRITE_H(0);
    if (NT > 1) { SLOAD_H(KVBLK); mwB = MLOAD(1); }
    __syncthreads();
    float l_reg = 0.f; f32x16 o[4] = {};
    f32x16 p0, p1; bf16x8 pa0, pa1, pa2, pa3; unsigned wl, wh;
    SBAR(); qkt<0>(p0, p1, K_lds, r32, hi, qp);
    MSPLIT(mwA, wl, wh); partialSM(p0, p1, wl, wh, sh2);
    if (NT > 1) { VMW(); SWRITE_H(1); }
    __syncthreads();
#define STEP(t, KB, VB) do { \
        finishSM(p0, p1, l_reg, pa0, pa1, pa2, pa3); SBAR(); \
        if ((t) + 1 < NT) { SLOAD_H(((t) + 1) * KVBLK); mwA = MLOAD((t) + 1); SBAR(); } \
        pv_tile<VB>(o, vb0, pa0, pa1, pa2, pa3); SBAR(); \
        qkt<KB>(p0, p1, K_lds, r32, hi, qp); \
        MSPLIT(mwB, wl, wh); partialSM(p0, p1, wl, wh, sh2); mwB = mwA; \
        __syncthreads(); \
        if ((t) + 1 < NT) { VMW(); SWRITE_H(VB); } \
        __syncthreads(); } while (0)
    int t = 1;
    for (; t + 1 < NT; t += 2) { STEP(t, 1, 0); STEP(t + 1, 0, 1); }
    if (t < NT) { STEP(t, 1, 0); }
    finishSM(p0, p1, l_reg, pa0, pa1, pa2, pa3); SBAR();
    if ((NT - 1) & 1) pv_tile<1>(o, vb0, pa0, pa1, pa2, pa3); else pv_tile<0>(o, vb0, pa0, pa1, pa2, pa3);
    { auto rr = __builtin_amdgcn_permlane32_swap(__float_as_uint(l_reg), __float_as_uint(l_reg), false, false); l_reg = __uint_as_float(rr[0]) + __uint_as_float(rr[1]); }
    { int te = threadIdx.x; asm volatile("" : "+v"(te));
      const int le = te & 63, r32e = le & 31, hie = le >> 5;
      LAS float* wse = (LAS float*)(lds + WS_OFF) + wid * 64;
      if (hie == 0) wse[r32e] = l_reg;
      asm volatile("s_waitcnt lgkmcnt(0)" ::: "memory");
      __syncthreads();
      LAS f16* stg = (LAS f16*)(lds + wid * 8192);
#pragma unroll
      for (int r = 0; r < 16; ++r) { const int orow = crow(r, hie); const float rl = __builtin_amdgcn_rcpf(wse[orow]);
#pragma unroll
          for (int d0 = 0; d0 < 4; ++d0) stg[orow * 128 + d0 * 32 + r32e] = (f16)(o[d0][r] * rl); }
      asm volatile("s_waitcnt lgkmcnt(0)" ::: "memory");
      const GAS f16* SZ = (const GAS f16*)(a.ws + WS_SZ) + ((size_t)b * S + qw) * 1024 + head * 128; GAS f16* MIX = (GAS f16*)(a.ws + WS_MIX) + ((size_t)b * S + qw) * 2048 + head * 128;
#pragma unroll
      for (int i = 0; i < 8; ++i) { const int c = le + 64 * i, row = c >> 4, ch = c & 15;
          const f16x8 ov = *(const LAS f16x8*)(stg + row * 128 + ch * 8); const f16x8 zv = *(const GAS f16x8*)(SZ + (unsigned)(row * 1024 + ch * 8));
          *(GAS f16x8*)(MIX + (unsigned)(row * 2048 + ch * 8)) = ov * zv; } }
    asm volatile("s_waitcnt lgkmcnt(0)" ::: "memory");
    __syncthreads();
#undef BL128
#undef VMW
#undef SLOAD_H
#undef SWRITE_HK
#undef SWRITE_HV
#undef SWRITE_H
#undef MLOAD
#undef MSPLIT
#undef STEP
}
#undef KSWZ
#undef SBAR
}

__device__ __forceinline__ void p3_sample_item(const Args& a, LAS unsigned char* lds, int item, int tid) {
    const int qi = item >> 1, kvh = item & 1, sb = qi / NST, tl = qi % NST; constexpr int L = PAST + NST, PER = 33;
    const int lane = tid & 63, wave = __builtin_amdgcn_readfirstlane(tid >> 6);
    const GAS float* ck = (const GAS float*)a.in[2]; const GAS float* cv = (const GAS float*)a.in[3]; const GAS int* ptab = (const GAS int*)a.in[6]; const GAS float* out_ro = (const GAS float*)a.out;
    LAS float* q = (LAS float*)lds; LAS float* w = q + 1024; LAS float* newsc = w + 16; LAS float* ctl = newsc + 4; LAS float* red = ctl + 16;
    LAS unsigned* hist = (LAS unsigned*)(red + 32); LAS float* cand = (LAS float*)(hist + 256); LAS unsigned* cnt = (LAS unsigned*)(cand + 64);
    LAS unsigned* rid = cnt + 32; LAS float* qa = (LAS float*)(rid + 512); LAS float* sc = qa + 512; LAS float* inv = sc + 4 * 512; LAS float* part = inv + 4;
    LAS int* nsel = (LAS int*)(ctl + 8); LAS int* ncand = (LAS int*)(ctl + 9);
    const GAS f16* QI = (const GAS f16*)(a.ws + WS_QI) + (size_t)(MP + qi) * 1024; const GAS float* QS = (const GAS float*)(a.ws + WS_QS) + (size_t)qi * 1024 + kvh * 512;
    for (int i = tid; i < 1024; i += 512) q[i] = (float)QI[i];
    qa[tid] = QS[tid];
    if (tid < 16) w[tid] = ((const GAS float*)(a.ws + WS_WI))[(size_t)(MP + qi) * 16 + tid];
    if (tid < 32) cnt[tid] = 0u;
    if (tid < 256) hist[tid] = 0u;
    if (tid == 0) { *nsel = 0; *ncand = 0; }
    const GAS float* ssc = (const GAS float*)(a.ws + WS_SSC) + (size_t)qi * PAST;
    float v[PER];
#pragma unroll
    for (int j = 0; j < PER - 1; ++j) v[j] = __builtin_bit_cast(float, __hip_atomic_load((const GAS unsigned*)ssc + (j * 512 + tid), __ATOMIC_RELAXED, __HIP_MEMORY_SCOPE_AGENT));
    __syncthreads();
    if (tid < NST) { const GAS float* kr = out_ro + O_KIS + (size_t)(sb * NST + tid) * 64; float s = 0.f;
#pragma unroll 1
        for (int h = 0; h < 16; ++h) { float dsum = 0.f;
#pragma unroll 8
            for (int d = 0; d < 64; ++d) dsum += q[h * 64 + d] * kr[d];
            s += w[h] * fmaxf(dsum, 0.f); }
        newsc[tid] = s; }
    __syncthreads();
    const float NINF = -__builtin_inff(), PINF = __builtin_inff();
    { const int s = (PER - 1) * 512 + tid; v[PER - 1] = (s < L && (s - PAST) <= tl) ? newsc[s - PAST] : NINF; }
    float mx = NINF, mn = PINF;
#pragma unroll
    for (int j = 0; j < PER; ++j) { mx = fmaxf(mx, v[j]); mn = fminf(mn, v[j] == NINF ? PINF : v[j]); }
#pragma unroll
    for (int o = 1; o < 64; o <<= 1) { mx = fmaxf(mx, __shfl_xor(mx, o)); mn = fminf(mn, __shfl_xor(mn, o)); }
    if (lane == 0) { red[wave] = mx; red[8 + wave] = mn; }
    __syncthreads();
#pragma unroll
    for (int i = 0; i < 8; ++i) { mx = fmaxf(mx, red[i]); mn = fminf(mn, red[8 + i]); }
    const float scale = 255.5f / (mx - mn);
    float tau = 0.f; bool have = false;
    if (mx > mn) {
#pragma unroll
        for (int j = 0; j < PER; ++j) if (v[j] != NINF) { int bn = (int)((v[j] - mn) * scale); bn = bn > 255 ? 255 : bn; __hip_atomic_fetch_add(hist + bn, 1u, __ATOMIC_RELAXED, __HIP_MEMORY_SCOPE_WORKGROUP); }
        __syncthreads();
        if (wave == 0) {
            const u32x4 h = *(const LAS u32x4*)(hist + 4 * lane);
            const unsigned sl = h[0] + h[1] + h[2] + h[3]; unsigned pre = sl;
#pragma unroll
            for (int o = 1; o < 64; o <<= 1) { const unsigned y = __shfl_up(pre, o); if (lane >= o) pre += y; }
            const unsigned tot = __builtin_amdgcn_readlane(pre, 63); const unsigned suf = tot - pre + sl;
            const unsigned long long bm = __ballot(suf >= TOPK);
            const int Ls = 63 - __builtin_clzll(bm);
            unsigned c = __builtin_amdgcn_readlane(suf, Ls) - __builtin_amdgcn_readlane(sl, Ls);
            const unsigned h3 = __builtin_amdgcn_readlane(h[3], Ls), h2 = __builtin_amdgcn_readlane(h[2], Ls), h1 = __builtin_amdgcn_readlane(h[1], Ls);
            int Bs;
            if (c + h3 >= TOPK) Bs = 4 * Ls + 3; else { c += h3; if (c + h2 >= TOPK) Bs = 4 * Ls + 2; else { c += h2; if (c + h1 >= TOPK) Bs = 4 * Ls + 1; else { c += h1; Bs = 4 * Ls; } } }
            if (lane == 0) { ((LAS int*)ctl)[0] = Bs; ((LAS int*)ctl)[1] = TOPK - (int)c; }
        }
        __syncthreads();
        const int Bs = ((LAS int*)ctl)[0], need = ((LAS int*)ctl)[1];
#pragma unroll
        for (int j = 0; j < PER; ++j) if (v[j] != NINF) { int bn = (int)((v[j] - mn) * scale); bn = bn > 255 ? 255 : bn;
            if (bn == Bs) { const int p = __hip_atomic_fetch_add(ncand, 1, __ATOMIC_RELAXED, __HIP_MEMORY_SCOPE_WORKGROUP); if (p < 64) cand[p] = v[j]; } }
        __syncthreads();
        const int base = *ncand;
        if (base <= 64) {
            if (wave == 0) { const float x = lane < base ? cand[lane] : NINF; int rank = 0;
                for (int m = 0; m < base; ++m) { const float y = __builtin_bit_cast(float, __builtin_amdgcn_readlane(__builtin_bit_cast(int, x), m)); rank += y > x ? 1 : 0; }
                float tc = (lane < base && rank <= need - 1) ? x : PINF;
#pragma unroll
                for (int o = 1; o < 64; o <<= 1) tc = fminf(tc, __shfl_xor(tc, o));
                if (lane == 0) ctl[2] = tc; }
            __syncthreads();
            tau = ctl[2]; have = true;
        }
    }
    if (!have) {
        unsigned tk = 0u;
        for (int bit = 31; bit >= 0; --bit) { const unsigned cd = tk | (1u << bit); int c = 0;
#pragma unroll
            for (int j = 0; j < PER; ++j) c += __builtin_popcountll(__ballot(v[j] != NINF && fkey(v[j]) >= cd));
            if (lane == 0) __hip_atomic_fetch_add(cnt + bit, (unsigned)c, __ATOMIC_RELAXED, __HIP_MEMORY_SCOPE_WORKGROUP);
            __syncthreads();
            if (cnt[bit] >= TOPK) tk = cd; }
        tau = __builtin_bit_cast(float, (tk & 0x80000000u) ? (tk ^ 0x80000000u) : ~tk);
    }
#pragma unroll
    for (int j = 0; j < PER; ++j) { if (v[j] >= tau) { const int s = j * 512 + tid; const int p = __hip_atomic_fetch_add(nsel, 1, __ATOMIC_RELAXED, __HIP_MEMORY_SCOPE_WORKGROUP);
        if (p < 512) rid[p] = s < PAST ? (unsigned)(ptab[sb * NPAGES + (s >> 7)] * PAGE + (s & (PAGE - 1))) : (0x80000000u | (unsigned)(s - PAST)); } }
    __syncthreads();
    const int n = *nsel < 512 ? *nsel : 512;
    const int half = lane >> 5, l32 = lane & 31;
    { f32x4 qv[4];
#pragma unroll
      for (int h = 0; h < 4; ++h) qv[h] = *(const LAS f32x4*)(qa + h * 128 + 4 * l32);
      for (int j0 = 2 * wave; j0 < n; j0 += 128) { f32x4 kv[8]; int jj[8];
#pragma unroll
          for (int u = 0; u < 8; ++u) { jj[u] = j0 + 16 * u + half; const unsigned r = rid[jj[u] < n ? jj[u] : 0];
              const GAS float* kr = (r & 0x80000000u) ? out_ro + O_KS + ((size_t)(sb * NST + (r & 3u)) * NKV + kvh) * HD : ck + ((size_t)r * NKV + kvh) * HD;
              kv[u] = *(const GAS f32x4*)(kr + 4 * l32); }
#pragma unroll
          for (int u = 0; u < 8; ++u) { float d[4];
#pragma unroll
              for (int h = 0; h < 4; ++h) d[h] = half_sum_dpp((kv[u][0] * qv[h][0] + kv[u][1] * qv[h][1]) + (kv[u][2] * qv[h][2] + kv[u][3] * qv[h][3]));
              if (jj[u] < n && l32 >= 16 && l32 < 20) { const int hq = l32 & 3; sc[hq * 512 + jj[u]] = (hq == 0 ? d[0] : hq == 1 ? d[1] : hq == 2 ? d[2] : d[3]) * 0.08838834764831845f; } } } }
    __syncthreads();
    if (wave < 4) { LAS float* row = sc + wave * 512; float m2 = -1e30f;
      for (int j = lane; j < n; j += 64) m2 = fmaxf(m2, row[j]);
      m2 = wave_max_dpp(m2);
      float sm = 0.f;
      for (int j = lane; j < n; j += 64) { const float e = __expf(row[j] - m2); row[j] = e; sm += e; }
      sm = wave_sum_dpp(sm); if (lane == 0) inv[wave] = 1.f / sm; }
    __syncthreads();
    { f32x4 acc[4] = {};
      for (int j0 = 2 * wave; j0 < n; j0 += 128) { f32x4 vv[8]; int jj[8];
#pragma unroll
          for (int u = 0; u < 8; ++u) { jj[u] = j0 + 16 * u + half; const unsigned r = rid[jj[u] < n ? jj[u] : 0];
              const GAS float* vr = (r & 0x80000000u) ? out_ro + O_VS + ((size_t)(sb * NST + (r & 3u)) * NKV + kvh) * HD : cv + ((size_t)r * NKV + kvh) * HD;
              vv[u] = *(const GAS f32x4*)(vr + 4 * l32); }
#pragma unroll
          for (int u = 0; u < 8; ++u)
#pragma unroll
              for (int h = 0; h < 4; ++h) { const float p = jj[u] < n ? sc[h * 512 + jj[u]] : 0.f; acc[h] += vv[u] * p; } }
#pragma unroll
      for (int h = 0; h < 4; ++h) {
#pragma unroll
          for (int e = 0; e < 4; ++e) acc[h][e] += __shfl_xor(acc[h][e], 32);
          if (half == 0) *(LAS f32x4*)(part + (wave * 4 + h) * 128 + 4 * l32) = acc[h]; } }
    __syncthreads();
    { const GAS f16* SZ = (const GAS f16*)(a.ws + WS_SZ) + (size_t)(MP + qi) * 1024 + kvh * 512; GAS f16* MIX = (GAS f16*)(a.ws + WS_MIX) + (size_t)(MP + qi) * 2048 + kvh * 512;
      const int h = tid >> 7, d = tid & 127; float o = 0.f;
#pragma unroll
      for (int p = 0; p < 8; ++p) o += part[(p * 4 + h) * 128 + d];
      MIX[tid] = (f16)(o * inv[h] * (float)SZ[tid]); }
    __syncthreads();
}

__device__ __forceinline__ void p3_phase(const Args& a, LAS unsigned char* lds, int vcu, int G, int tid) {
    float gm = 0.f, km = 0.f;
    for (int i = 0; i < HD; ++i) { gm = fmaxf(gm, fabsf(a.in[9][i])); km = fmaxf(km, fabsf(a.in[10][i])); }
    const float sh2 = fmaxf(0.f, 11.313708498984761f * gm * km - 20.f) * 1.4426950408889634f;
    for (int rp = 0; rp < P3_REP_S; ++rp)
    for (int sidx = G - 1 - vcu; sidx < 2 * MS; sidx += G) { wait_ge_wt((unsigned*)a.ws + RDY_WORD0 + 64 * 32, (unsigned)G); p3_sample_item(a, lds, sidx, tid); }
    if (G == 256) { if (vcu >= 112 && vcu < 192) p2_convmix(a, (vcu - 112) * NWAVES + (tid >> 6), 80 * NWAVES, tid & 63); }
    else p2_convmix(a, vcu * NWAVES + (tid >> 6), G * NWAVES, tid & 63);
    for (int rp = 0; rp < P3_REP_A; ++rp)
    for (int k = vcu; k < 256; k += G) { const int i = 31 - (k >> 3), bk = k & 7;
        if (i >= 4) wait_ge_wt((unsigned*)a.ws + RDY_WORD0 + 64 * (40 + (bk >> 1) * 32 + i), 4u); else wait_ge_wt((unsigned*)a.ws + RDY_WORD0 + 64 * 33, (unsigned)G);
        att::attn_block(a, lds, bk >> 1, bk & 1, 64 * i, sh2); }
}

__global__ void __launch_bounds__(NWAVES * 64, 2) mk_fwd(Args a) {
    extern __shared__ __attribute__((aligned(16))) unsigned char lds_raw[];
    LAS unsigned char* lds = (LAS unsigned char*)lds_raw;
    const int tid = threadIdx.x, lane = tid & 63, wave = __builtin_amdgcn_readfirstlane(tid >> 6);
    const int G = gridDim.x; const int bx = blockIdx.x; const int vcu = (G % 8 == 0) ? (bx % 8) * (G / 8) + bx / 8 : bx;
    volatile LAS unsigned* MISC = (volatile LAS unsigned*)(lds + MISC_OFF);
    if (tid < 64) MISC[tid] = 0u;
    __syncthreads();
    XcdBarrier bar = xcd_barrier_post((unsigned*)a.ws, MISC + 8);
    { int t_ = threadIdx.x; asm volatile("" : "+v"(t_)); const int lane = t_ & 63, wave = __builtin_amdgcn_readfirstlane(t_ >> 6); p0_prologue(a, lds, vcu, G, wave, lane); }
    xcd_barrier(bar);
    { pg8::Gemm g{(const f16*)(a.ws + WS_XNH), (const f16*)(a.ws + WS_WINT), DM};
      pg8::StaticOrder S; S.init(MPAD / 256, NPAD / 256, G, bx);
      EpiIn E{a.out, a.ws, a.in[9], a.in[10], a.in[11], (LAS float*)(lds + SCR_OFF)};
      pg8::gemm_phase<EpiIn, pg8::StaticOrder>(lds, g, S, E); }
    { int t_ = threadIdx.x; asm volatile("" : "+v"(t_)); const int lane = t_ & 63, wave = __builtin_amdgcn_readfirstlane(t_ >> 6);
      xcd_barrier(bar);
      p2_phase(a, lds, vcu, G, wave, lane); }
    { int t_ = threadIdx.x; asm volatile("" : "+v"(t_)); p3_phase(a, lds, vcu, G, t_); }
    { pg8::Gemm g{(const f16*)(a.ws + WS_MIX), (const f16*)(a.ws + WS_WOUTT), DM};
      pg8::StaticOrder S; S.init(MP / 256, DM / 256, G, bx);
      EpiOut E{a.out, a.in[0]};
      f32x4 accp[2][2][4][2]; { pg8::Unit u0; int t0_ = threadIdx.x; asm volatile("" : "+v"(t0_)); const int w0_ = __builtin_amdgcn_readfirstlane(t0_ >> 6), l0_ = t0_ & 63;
          if (S.next(0, u0)) E.init(accp, u0, w0_ >> 2, w0_ & 3, l0_ & 15, l0_ >> 4); }
      xcd_barrier(bar);
      pg8::gemm_phase<EpiOut, pg8::StaticOrder, true>(lds, g, S, E, accp);
      int t_ = threadIdx.x; asm volatile("" : "+v"(t_)); p4_sample(a, lds, bx, G, t_); }
}

#ifndef PROG
#define PROG 0x11111u
#endif
extern "C" void kernel_launch(void* const* d_in, const int* in_sizes, int n_in, void* d_out, int out_size, void* d_ws, size_t ws_size, hipStream_t stream) {
    static int grid = 0;
    if (grid == 0) {
        if (ws_size < WS_NEED2 || out_size != (int)O_END || n_in != 14) { fprintf(stderr, "kernel_launch: ws %zu (need %zu) out %d (want %zu) n_in %d\n", ws_size, (size_t)WS_NEED2, out_size, (size_t)O_END, n_in); grid = -1; return; }
        int dev = 0, cus = 0; hipGetDevice(&dev); hipDeviceGetAttribute(&cus, hipDeviceAttributeMultiprocessorCount, dev);
        if (hipFuncSetAttribute((const void*)mk_fwd, hipFuncAttributeMaxDynamicSharedMemorySize, LDS_BYTES) != hipSuccess) { fprintf(stderr, "kernel_launch: hipFuncSetAttribute failed\n"); grid = -1; return; }
        int per_cu = 0; hipOccupancyMaxActiveBlocksPerMultiprocessor(&per_cu, (const void*)mk_fwd, NWAVES * 64, LDS_BYTES); (void)hipGetLastError();
        if (per_cu < 1) fprintf(stderr, "kernel_launch: occupancy query says %d blocks per CU\n", per_cu);
        grid = cus > 0 ? cus : 256;
    }
    if (grid < 0) return;
    float* out = (float*)d_out; unsigned char* ws = (unsigned char*)d_ws;
    Args a{};
    for (int i = 0; i < 14; ++i) a.in[i] = (const float*)d_in[i];
    a.out = out; a.ws = ws;
    if (hipMemsetAsync(ws, 0, 65536, stream) != hipSuccess) { fprintf(stderr, "kernel_launch: memset of the control words failed\n"); return; }
    a.ph_lo = (int)PROG; a.ph_hi = 0; hipLaunchKernelGGL(mk_fwd, dim3(grid), dim3(NWAVES * 64), LDS_BYTES, stream, a);
}
```

```cpp
#include <hip/hip_runtime.h>
#include <cstdio>
#include <cstdint>
#include <cmath>

typedef _Float16 f16;
typedef unsigned short bf16_t;

constexpr int DM = 2048, NB = 4, S = 2048, NSB = 8, NST = 4, PAST = 16384, PAGE = 128, NPAGES = PAST / PAGE;
constexpr int MP = NB * S;
constexpr int MS = NSB * NST;
constexpr int MT = MP + MS;
constexpr int DIN = 7760;
constexpr int OQ = 0, OKK = 1024, OV = 1280, OZ = 1536, OQI = 2560, OKI = 3584, OWI = 3648, OH = 3664, OBB = 4688, OC = 5712, OZC = 6736;
constexpr int NH = 8, NKV = 2, HD = 128, NIH = 16, ID = 64, TOPK = 256, DC = 1024;
constexpr float EPS = 1e-6f;
constexpr size_t O_YP = 0, O_YS = 16777216, O_KP = 16842752, O_VP = 18939904, O_KIP = 21037056, O_CVP = 21561344,
                 O_KS = 21569536, O_VS = 21577728, O_KIS = 21585920, O_CVS = 21587968, O_END = 21604352;
constexpr size_t MiB = 1u << 20;
constexpr size_t WS_ROPE = 1 * MiB;
constexpr size_t WS_ROPE_I = WS_ROPE + 2052 * 32 * 4;
constexpr size_t WS_QB = 2 * MiB;
constexpr size_t WS_KB = 18 * MiB;
constexpr size_t WS_VB = 22 * MiB;
constexpr size_t WS_SZ = 26 * MiB;
constexpr size_t WS_QI = 43 * MiB;
constexpr size_t WS_KI = 60 * MiB;
constexpr size_t WS_WI = 61 * MiB;
constexpr size_t WS_U = 62 * MiB;
constexpr size_t WS_G = 79 * MiB;
constexpr size_t WS_MIX = 96 * MiB;
constexpr size_t WS_MASK = 130 * MiB;
constexpr size_t WS_SSC = 132 * MiB;
constexpr size_t WS_QS = 134 * MiB;
constexpr size_t WS_XN = 136 * MiB;
constexpr size_t WS_P = 202 * MiB;
constexpr size_t WS_NEED = 448 * MiB;

__device__ __forceinline__ bf16_t f2bf(float f) { unsigned u = __builtin_bit_cast(unsigned, f); return (bf16_t)((u + 0x7fffu + ((u >> 16) & 1u)) >> 16); }
__device__ __forceinline__ float bf2f(bf16_t h) { return __builtin_bit_cast(float, (unsigned)h << 16); }
__device__ __forceinline__ float silu(float z) { return z * __builtin_amdgcn_rcpf(1.f + __builtin_amdgcn_exp2f(-1.4426950408889634f * z)); }
__device__ __forceinline__ unsigned fkey(float f) { unsigned u = __builtin_bit_cast(unsigned, f); return (u & 0x80000000u) ? ~u : (u | 0x80000000u); }

#define HOOK_0
#define HOOK_1
#define HOOK_2
#define HOOK_3
#define HOOK_4
#define HOOK_5
#define HOOK_6
#define HOOK_7
#define HOOK_8
#define HOOK_9
#define HOOK_10
#define HOOK_11
#define HOOK_12
#define HOOK_13
#define P0_REP_T 1
#define P0_REP_X 1
#define P3_REP_S 1
#define P3_REP_A 1
#define P2_KT_REP 1
#define P2_SEL_REP 1
#define P2_REP_A 1
#define P2_REP_B 1
#define P2_REP_C 1
#define LAS __attribute__((address_space(3)))
#define GAS __attribute__((address_space(1)))
typedef _Float16 f16x8 __attribute__((ext_vector_type(8)));
typedef _Float16 f16x4 __attribute__((ext_vector_type(4)));
typedef _Float16 f16x2 __attribute__((ext_vector_type(2)));
typedef float f32x4 __attribute__((ext_vector_type(4)));
typedef float f32x2 __attribute__((ext_vector_type(2)));
typedef unsigned u32x4 __attribute__((ext_vector_type(4)));
typedef unsigned u32x2 __attribute__((ext_vector_type(2)));
typedef __bf16 bf16x2_t __attribute__((ext_vector_type(2)));
namespace pg8 {
constexpr int BM = 256, BK = 64, HALF = 128, HTB = HALF * BK * 2, STAGE_BYTES = 8 * HTB, NXCD = 8, WGM = 8;
__host__ __device__ __forceinline__ int lds_byte(int r, int c) { const int st = (r >> 4) * 2 + (c >> 5), rr = r & 15, cc = c & 31, ob = rr * 64 + cc * 2; return st * 1024 + (ob ^ (((ob >> 9) & 1) << 5)); }
__host__ __device__ __forceinline__ void stage_rc(int b, int& R, int& C) { const int st = b / 1024, sb = b % 1024, swz = sb ^ (((sb >> 9) & 1) << 5); R = (st >> 1) * 16 + swz / 64; C = (st & 1) * 32 + (swz % 64) / 2; }
struct Unit { int pm, pn; };
struct Gemm { const f16* A; const f16* Bt; int K; };
struct StaticOrder {
    int nM, nN, nwg, G, c;
    __device__ __forceinline__ void init(int nM_, int nN_, int G_, int c_) { nM = nM_; nN = nN_; nwg = nM * nN; G = G_; c = c_; }
    __device__ __forceinline__ bool next(int i, Unit& u) const {
        const long L = (long)i * G + c; if (L >= nwg) return false;
        int wgid = (int)L; { const int q = nwg / NXCD, r = nwg % NXCD, xcd = wgid % NXCD, off = wgid / NXCD; wgid = (xcd < r ? xcd * (q + 1) : r * (q + 1) + (xcd - r) * q) + off; }
        const int nig = WGM * nN, gid = wgid / nig, fm = gid * WGM, gsz = (nM - fm) < WGM ? (nM - fm) : WGM;
        u.pm = fm + ((wgid % nig) % gsz); u.pn = (wgid % nig) / gsz; return true;
    }
};
struct OneUnit { int pm, pn; __device__ __forceinline__ bool next(int i, Unit& u) const { if (i != 0) return false; u.pm = pm; u.pn = pn; return true; } };
template <class Epi, class Sched, bool PRE = false>
__device__ __forceinline__ void gemm_phase(LAS unsigned char* lds, const Gemm g, const Sched& S, const Epi& E, const f32x4 (*pre)[2][4][2] = nullptr) {
    int tid_ = threadIdx.x; asm volatile("" : "+v"(tid_));
    const int tid = tid_, wid = __builtin_amdgcn_readfirstlane(tid >> 6), lane = tid & 63, wr = wid >> 2, wc = wid & 3, fr = lane & 15, fq = lane >> 4;
    const int K = g.K, nt = K / BK;
    unsigned voffA[2];
#pragma unroll
    for (int i = 0; i < 2; ++i) { int R, C; stage_rc(tid * 16 + i * 8192, R, C); voffA[i] = (unsigned)(R * K + C) * 2u; }
    const size_t kstep = (size_t)(BK * 2);
    const size_t hstep = (size_t)HALF * K * 2;
    const size_t tstep = 2 * hstep;
    const unsigned ldsw = (unsigned)wid * 1024u;
    const int aoff = lds_byte(wr * 64 + fr, fq * 8), boff = lds_byte(wc * 32 + fr, fq * 8);
#define PG8_SA(b, h) (((b) * 2 + (h)) * HTB)
#define PG8_SB(b, h) ((4 + (b) * 2 + (h)) * HTB)
#define PG8_STAGE(bufoff, gbase) do { _Pragma("unroll") for (int _i = 0; _i < 2; ++_i) \
        __builtin_amdgcn_global_load_lds((const unsigned*)((const char*)(gbase) + voffA[_i]), (LAS unsigned*)(lds + (bufoff) + ldsw + _i * 8192), 16, 0, 0); } while (0)
#define PG8_LDA(dst, b, h) do { _Pragma("unroll") for (int m = 0; m < 4; ++m) _Pragma("unroll") for (int k = 0; k < 2; ++k) dst[m][k] = *(const LAS f16x8*)(lds + PG8_SA(b, h) + aoff + m * 2048 + k * 1024); } while (0)
#define PG8_LDB(dst, b, h) do { _Pragma("unroll") for (int n = 0; n < 2; ++n) _Pragma("unroll") for (int k = 0; k < 2; ++k) dst[n][k] = *(const LAS f16x8*)(lds + PG8_SB(b, h) + boff + n * 2048 + k * 1024); } while (0)
#define PG8_MMA(ai, bj, At, Bt) do { __builtin_amdgcn_s_setprio(1); _Pragma("unroll") for (int m = 0; m < 4; ++m) _Pragma("unroll") for (int n = 0; n < 2; ++n) _Pragma("unroll") for (int k = 0; k < 2; ++k) \
        acc[ai][bj][m][n] = __builtin_amdgcn_mfma_f32_16x16x32_f16(Bt[n][k], At[m][k], acc[ai][bj][m][n], 0, 0, 0); __builtin_amdgcn_s_setprio(0); } while (0)
#define PG8_WAIT_V(n) asm volatile("s_waitcnt vmcnt(" #n ")" ::: "memory")
#define PG8_WAIT_L(n) asm volatile("s_waitcnt lgkmcnt(" #n ")" ::: "memory")
#define PG8_BAR __builtin_amdgcn_s_barrier()
#define PG8_SCHED __builtin_amdgcn_sched_barrier(0)
    Unit cur, nxt; int ui = 0;
    if (!S.next(0, cur)) return;
    f32x4 acc[2][2][4][2];
    if constexpr (PRE) {
#pragma unroll
        for (int a = 0; a < 2; ++a)
#pragma unroll
            for (int b = 0; b < 2; ++b)
#pragma unroll
                for (int m = 0; m < 4; ++m)
#pragma unroll
                    for (int n = 0; n < 2; ++n) acc[a][b][m][n] = pre[a][b][m][n];
    } else E.init(acc, cur, wr, wc, fr, fq);
    f16x8 At[4][2], B0[2][2], B1[2][2];
    const char* cA = (const char*)g.A + (size_t)cur.pm * tstep; const char* cB = (const char*)g.Bt + (size_t)cur.pn * tstep;
    PG8_STAGE(PG8_SB(0, 0), cB); PG8_STAGE(PG8_SB(0, 1), cB + hstep); PG8_STAGE(PG8_SA(0, 0), cA); PG8_STAGE(PG8_SA(0, 1), cA + hstep);
    if (wr == 1) PG8_BAR;
    PG8_WAIT_V(2); PG8_BAR;
    PG8_STAGE(PG8_SB(1, 0), cB + kstep); PG8_STAGE(PG8_SA(1, 0), cA + kstep); PG8_STAGE(PG8_SB(1, 1), cB + hstep + kstep);
    PG8_WAIT_V(6); PG8_BAR;
    for (;;) {
        const bool has_next = S.next(ui + 1, nxt);
        const char* nA = has_next ? (const char*)g.A + (size_t)nxt.pm * tstep : cA; const char* nB = has_next ? (const char*)g.Bt + (size_t)nxt.pn * tstep : cB;
        for (int t = 0; t < nt; t += 2) {
            const bool last = (t == nt - 2);
            const char* a1 = cA + (size_t)(t + 1) * kstep;
            const char* a2 = last ? nA : cA + (size_t)(t + 2) * kstep; const char* b2 = last ? nB : cB + (size_t)(t + 2) * kstep;
            const char* a3 = a2 + kstep; const char* b3 = b2 + kstep;
            PG8_LDB(B0, 0, 0); PG8_LDB(B1, 0, 1); PG8_SCHED; PG8_LDA(At, 0, 0); PG8_STAGE(PG8_SA(1, 1), a1 + hstep);
            PG8_WAIT_V(8); PG8_WAIT_L(0); PG8_BAR; PG8_MMA(0, 0, At, B0); PG8_MMA(0, 1, At, B1); PG8_BAR; PG8_SCHED;
            PG8_LDA(At, 0, 1); PG8_STAGE(PG8_SB(0, 0), b2); PG8_STAGE(PG8_SB(0, 1), b2 + hstep); PG8_STAGE(PG8_SA(0, 0), a2);
            PG8_WAIT_V(8); PG8_WAIT_L(0); PG8_BAR; PG8_MMA(1, 0, At, B0); PG8_MMA(1, 1, At, B1); PG8_BAR; PG8_SCHED;
            PG8_LDB(B0, 1, 0); PG8_LDB(B1, 1, 1); PG8_SCHED; PG8_LDA(At, 1, 0); PG8_STAGE(PG8_SA(0, 1), a2 + hstep);
            PG8_WAIT_V(8); PG8_WAIT_L(0); PG8_BAR; PG8_MMA(0, 0, At, B0); PG8_MMA(0, 1, At, B1); PG8_BAR; PG8_SCHED;
            PG8_LDA(At, 1, 1); PG8_STAGE(PG8_SB(1, 0), b3); PG8_STAGE(PG8_SB(1, 1), b3 + hstep); PG8_STAGE(PG8_SA(1, 0), a3);
            PG8_WAIT_V(8); PG8_WAIT_L(0); PG8_BAR; PG8_MMA(1, 0, At, B0); PG8_MMA(1, 1, At, B1); PG8_BAR; PG8_SCHED;
        }
        const bool al = E.aligned(cur);
        if (al && wr == 0) PG8_BAR;
        E(acc, cur, wr, wc, fr, fq);
        if (!has_next) { if (!al && wr == 0) PG8_BAR; break; }
        cur = nxt; cA = nA; cB = nB; ++ui;
        E.init(acc, cur, wr, wc, fr, fq);
        if (al && wr == 1) PG8_BAR;
    }
    PG8_WAIT_V(0);
    PG8_BAR;
#undef PG8_SA
#undef PG8_SB
#undef PG8_STAGE
#undef PG8_LDA
#undef PG8_LDB
#undef PG8_MMA
#undef PG8_WAIT_V
#undef PG8_WAIT_L
#undef PG8_BAR
#undef PG8_SCHED
}
}
#ifndef P0_REP_T
#define P0_REP_T 1
#define P0_REP_X 1
#endif
constexpr int NWAVES = 8;
constexpr int MPAD = 8448, NPAD = 7936;
constexpr size_t WS_XNH = 450 * MiB;
constexpr size_t WS_WINT = 484 * MiB;
constexpr size_t WS_WOUTT = 516 * MiB;
constexpr size_t WS_PART = 524 * MiB;
constexpr size_t PART_STRIDE = 32768 + 256;
constexpr size_t WS_NEED2 = 536 * MiB;
constexpr int RING_BYTES = 131072, SCR_OFF = RING_BYTES, SCR_BYTES = 8192, MISC_OFF = 145408, LDS_BYTES = 147456;

__device__ __forceinline__ unsigned pk_bf16(float lo, float hi) { f32x2 v = {lo, hi}; bf16x2_t b = __builtin_convertvector(v, bf16x2_t); return __builtin_bit_cast(unsigned, b); }
__device__ __forceinline__ unsigned pk_f16(float lo, float hi) { f32x2 v = {lo, hi}; f16x2 b = __builtin_convertvector(v, f16x2); return __builtin_bit_cast(unsigned, b); }

struct Args { const float* in[14]; float* out; unsigned char* ws; int ph_lo, ph_hi; };

__device__ __forceinline__ int win_src(int np) {
    const int pn = np >> 8, c = np & 255;
    if (pn < 15) { const int rho = c & 31, nn = rho >> 4, ii = rho & 15; const int L = (np & ~31) | (8 * (ii >> 2) + 4 * nn + (ii & 3));
        if (pn < 14) return L;
        return (L & 255) < 80 ? L : -1; }
    const int T = pn - 15, bj = c >> 7, wc = (c >> 5) & 3, n = (c >> 4) & 1, fqi = c & 15;
    const int base = bj == 0 ? (n == 0 ? OH : OBB) : (n == 0 ? OC : OZC);
    return base + 64 * T + 16 * wc + fqi;
}
template <bool MAP>
__device__ __forceinline__ void p0_transpose_item(const float* W, int N, f16* WT, LAS unsigned char* scr, int item, int nblk, int lane) {
    const int kb = item / nblk, nb = item % nblk, k0 = 64 * kb, n0 = 32 * nb;
    const int q = lane & 7, kr = lane >> 3;
    const int src = MAP ? win_src(n0 + 4 * q) : n0 + 4 * q;
    const GAS float* wp = (const GAS float*)W + (size_t)(k0 + 2 * kr) * N + (src >= 0 ? src : 0);
    f32x4 va[4], vb[4];
#pragma unroll
    for (int p = 0; p < 4; ++p) { va[p] = *(const GAS f32x4*)(wp + (size_t)(16 * p) * N); vb[p] = *(const GAS f32x4*)(wp + (size_t)(16 * p + 1) * N); }
#pragma unroll
    for (int p = 0; p < 4; ++p) { if (src < 0) { va[p] = (f32x4){0.f, 0.f, 0.f, 0.f}; vb[p] = va[p]; }
#pragma unroll
        for (int e = 0; e < 4; ++e) *(LAS unsigned*)(scr + (4 * q + e) * 144 + 2 * (16 * p + 2 * kr)) = pk_f16(va[p][e], vb[p][e]); }
    asm volatile("s_waitcnt lgkmcnt(0)" ::: "memory");
    const int ch = lane & 7;
#pragma unroll
    for (int j = 0; j < 4; ++j) { const int n = (lane >> 3) + 8 * j;
        *(GAS u32x4*)(WT + (size_t)(n0 + n) * 2048 + k0 + 8 * ch) = *(const LAS u32x4*)(scr + n * 144 + ch * 16); }
    asm volatile("s_waitcnt lgkmcnt(0)" ::: "memory");
}
template <int CTRL, int RM, int BM> __device__ __forceinline__ float dppf(float old, float src) { return __builtin_bit_cast(float, __builtin_amdgcn_update_dpp(__builtin_bit_cast(int, old), __builtin_bit_cast(int, src), CTRL, RM, BM, false)); }
template <int CTRL, int RM, int BM> __device__ __forceinline__ unsigned dppu(unsigned old, unsigned src) { return (unsigned)__builtin_amdgcn_update_dpp((int)old, (int)src, CTRL, RM, BM, false); }
__device__ __forceinline__ float wave_max_dpp(float v) {
    v = fmaxf(v, dppf<0xB1, 0xF, 0xF>(v, v)); v = fmaxf(v, dppf<0x4E, 0xF, 0xF>(v, v)); v = fmaxf(v, dppf<0x141, 0xF, 0xF>(v, v)); v = fmaxf(v, dppf<0x140, 0xF, 0xF>(v, v));
    v = fmaxf(v, dppf<0x142, 0xA, 0xF>(v, v)); v = fmaxf(v, dppf<0x143, 0xC, 0xF>(v, v));
    return __builtin_bit_cast(float, __builtin_amdgcn_readlane(__builtin_bit_cast(int, v), 63));
}
__device__ __forceinline__ float wave_sum_dpp(float v) {
    v += dppf<0xB1, 0xF, 0xF>(0.f, v); v += dppf<0x4E, 0xF, 0xF>(0.f, v); v += dppf<0x141, 0xF, 0xF>(0.f, v); v += dppf<0x140, 0xF, 0xF>(0.f, v);
    v += dppf<0x142, 0xA, 0xF>(0.f, v); v += dppf<0x143, 0xC, 0xF>(0.f, v);
    return __builtin_bit_cast(float, __builtin_amdgcn_readlane(__builtin_bit_cast(int, v), 63));
}
__device__ __forceinline__ float half_sum_dpp(float v) {
    v += dppf<0xB1, 0xF, 0xF>(0.f, v); v += dppf<0x4E, 0xF, 0xF>(0.f, v); v += dppf<0x141, 0xF, 0xF>(0.f, v); v += dppf<0x140, 0xF, 0xF>(0.f, v);
    v += dppf<0x142, 0xA, 0xF>(0.f, v);
    return v;
}
__device__ __forceinline__ unsigned wave_scan_dpp(unsigned x) {
    x += dppu<0x111, 0xF, 0xF>(0u, x); x += dppu<0x112, 0xF, 0xF>(0u, x); x += dppu<0x114, 0xF, 0xF>(0u, x); x += dppu<0x118, 0xF, 0xF>(0u, x);
    x += dppu<0x142, 0xA, 0xF>(0u, x); x += dppu<0x143, 0xC, 0xF>(0u, x);
    return x;
}
__device__ __forceinline__ float wave_sum(float v) {
#pragma unroll
    for (int o = 1; o < 64; o <<= 1) v += __shfl_xor(v, o);
    return v;
}
__device__ __forceinline__ void p0_prologue(const Args& a, LAS unsigned char* lds, int vcu, int G, int wave, int lane) {
    LAS unsigned char* scr = lds + wave * 16384;
    const int gw = vcu * NWAVES + wave, NGW = G * NWAVES;
    const float* win = a.in[8]; const float* wout = a.in[13];
    f16* WinT = (f16*)(a.ws + WS_WINT); f16* WoutT = (f16*)(a.ws + WS_WOUTT); f16* XN = (f16*)(a.ws + WS_XNH);
    constexpr int I_IN = 32 * (NPAD / 32), I_OUT = 32 * (DM / 32);
    for (int rpt = 0; rpt < P0_REP_T; ++rpt)
    for (int it = gw; it < I_IN + I_OUT; it += NGW) {
        if (it < I_IN) p0_transpose_item<true>(win, DIN, WinT, scr, it, NPAD / 32, lane);
        else p0_transpose_item<false>(wout, DM, WoutT, scr, it - I_IN, DM / 32, lane);
    }
    const float* gin = a.in[7];
    for (int rpx = 0; rpx < P0_REP_X; ++rpx)
    for (int m = gw; m < MT; m += NGW) {
        const float* xrow = m < MP ? a.in[0] + (size_t)m * DM : a.in[1] + (size_t)(m - MP) * DM;
        const f32x4* xr = (const f32x4*)xrow + lane; f32x4 v[8]; float s = 0.f;
#pragma unroll
        for (int j = 0; j < 8; ++j) { v[j] = xr[64 * j]; s += (v[j].x * v[j].x + v[j].y * v[j].y) + (v[j].z * v[j].z + v[j].w * v[j].w); }
        const float rs = rsqrtf(wave_sum_dpp(s) * (1.f / DM) + EPS);
        u32x2* o8 = (u32x2*)(XN + (size_t)m * DM) + lane;
#pragma unroll
        for (int j = 0; j < 8; ++j) { const f32x4 gv = ((const f32x4*)gin)[lane + 64 * j]; u32x2 w; w.x = pk_f16(v[j].x * rs * gv.x, v[j].y * rs * gv.y); w.y = pk_f16(v[j].z * rs * gv.z, v[j].w * rs * gv.w); o8[64 * j] = w; }
    }
    float* rqk = (float*)(a.ws + WS_ROPE); float* ri = (float*)(a.ws + WS_ROPE_I);
    for (int i = gw * 64 + lane; i < 2052 * 16; i += NGW * 64) {
        { int slot = i / 16, j = i % 16; int pos = slot < 2048 ? slot : PAST + (slot - 2048);
          float inv = (float)pow(500000.0, -(double)j / 16.0); float ang = (float)pos * inv;
          rqk[(slot * 16 + j) * 2] = (float)cos((double)ang); rqk[(slot * 16 + j) * 2 + 1] = (float)sin((double)ang); }
        if (i < 2052 * 8) { int slot = i / 8, j = i % 8; int pos = slot < 2048 ? slot : PAST + (slot - 2048);
          float inv = (float)pow(500000.0, -(double)j / 8.0); float ang = (float)pos * inv;
          ri[(slot * 8 + j) * 2] = (float)cos((double)ang); ri[(slot * 8 + j) * 2 + 1] = (float)sin((double)ang); }
    }
}

struct EpiIn {
    float* out; unsigned char* ws; const float* gq; const float* gk; const float* gki; LAS float* scr;
    __device__ __forceinline__ bool aligned(const pg8::Unit& u) const { return u.pn <= 4 || u.pn == 14; }
    __device__ __forceinline__ void init(f32x4 (&acc)[2][2][4][2], const pg8::Unit&, int, int, int, int) const {
#pragma unroll
        for (int a = 0; a < 2; ++a)
#pragma unroll
            for (int b = 0; b < 2; ++b)
#pragma unroll
                for (int m = 0; m < 4; ++m)
#pragma unroll
                    for (int n = 0; n < 2; ++n) acc[a][b][m][n] = (f32x4){0.f, 0.f, 0.f, 0.f};
    }
    __device__ __forceinline__ void operator()(f32x4 (&acc)[2][2][4][2], const pg8::Unit& u, int wr, int wc, int fr_, int fq_) const {
        int fr = fr_, fq = fq_; asm volatile("" : "+v"(fr), "+v"(fq));
        GAS unsigned char* ws = (GAS unsigned char*)this->ws; GAS float* out = (GAS float*)this->out; asm volatile("" : "+s"(ws), "+s"(out));
        const int pn = u.pn, pm = u.pm; const bool smp = pm == 32;
        const int rbase = 64 * wr + fr;
        const int bb = pm >> 3, t0 = (pm & 7) << 8;
        const GAS float* rqk = (const GAS float*)(ws + WS_ROPE); const GAS float* ri = (const GAS float*)(ws + WS_ROPE_I);
#define ROWLOOP _Pragma("unroll") for (int ai = 0; ai < 2; ++ai) _Pragma("unroll") for (int m = 0; m < 4; ++m)
#define ROWVARS const int r = rbase + 128 * ai + 16 * m; const bool valid = !smp || r < MS; const int grow = smp ? MP + r : pm * 256 + r; const int tt = smp ? (r & 3) : t0 + r; const int slot = smp ? 2048 + (r & 3) : tt; (void)grow; (void)tt; (void)slot; (void)valid;
        const int cl = 32 * wc + 8 * fq;
#define PK8B(x0_, x1_) ((u32x4){pk_bf16(x0_[0], x0_[1]), pk_bf16(x0_[2], x0_[3]), pk_bf16(x1_[0], x1_[1]), pk_bf16(x1_[2], x1_[3])})
#define PK8H(x0_, x1_) ((u32x4){pk_f16(x0_[0], x0_[1]), pk_f16(x0_[2], x0_[3]), pk_f16(x1_[0], x1_[1]), pk_f16(x1_[2], x1_[3])})
#define SHX4(dst_, src_, off_) do { dst_[0] = __shfl_xor(src_[0], off_); dst_[1] = __shfl_xor(src_[1], off_); dst_[2] = __shfl_xor(src_[2], off_); dst_[3] = __shfl_xor(src_[3], off_); } while (0)
        if (pn <= 4 || pn == 14) {
            const bool isk = pn == 14;
            ROWLOOP { asm volatile("" ::: "memory"); const int r = rbase + 128 * ai + 16 * m;
#pragma unroll
                for (int bj = 0; bj < 2; ++bj) { float s = 0.f;
#pragma unroll
                    for (int n = 0; n < 2; ++n) { const f32x4 x = acc[ai][bj][m][n]; s += (x[0] * x[0] + x[1] * x[1]) + (x[2] * x[2] + x[3] * x[3]); }
                    if (isk && (wc >= 2 || bj == 1)) s = 0.f;
                    s += __shfl_xor(s, 16); s += __shfl_xor(s, 32);
                    if (fq == 0) scr[(r * 2 + bj) * 4 + wc] = s; } }
            asm volatile("s_waitcnt lgkmcnt(0)" ::: "memory"); __builtin_amdgcn_s_barrier(); asm volatile("" ::: "memory");
            if (!isk) {
                const GAS float* g = (const GAS float*)(pn < 4 ? gq : gk);
                const f32x4 g0 = *(const GAS f32x4*)(g + cl), g1 = *(const GAS f32x4*)(g + cl + 4);
                GAS bf16_t* Qb = (GAS bf16_t*)(ws + WS_QB); GAS bf16_t* Kb = (GAS bf16_t*)(ws + WS_KB); GAS float* QS = (GAS float*)(ws + WS_QS);
                ROWLOOP { asm volatile("" ::: "memory"); ROWVARS
                    f32x4 c0 = {1.f, 1.f, 1.f, 1.f}, s0 = {0.f, 0.f, 0.f, 0.f}, c1 = c0, s1 = s0;
                    if (wc == 0) { const GAS f32x4* cp = (const GAS f32x4*)(rqk + (slot * 16 + 8 * (fq & 1)) * 2); const f32x4 t0_ = cp[0], t1_ = cp[1], t2_ = cp[2], t3_ = cp[3];
                        c0 = (f32x4){t0_[0], t0_[2], t1_[0], t1_[2]}; s0 = (f32x4){t0_[1], t0_[3], t1_[1], t1_[3]}; c1 = (f32x4){t2_[0], t2_[2], t3_[0], t3_[2]}; s1 = (f32x4){t2_[1], t2_[3], t3_[1], t3_[3]}; }
#pragma unroll
                    for (int bj = 0; bj < 2; ++bj) {
                        const f32x4 p = *(const LAS f32x4*)(scr + (r * 2 + bj) * 4);
                        const float rs = rsqrtf(((p[0] + p[1]) + (p[2] + p[3])) * (1.f / 128.f) + EPS);
                        f32x4 x0 = acc[ai][bj][m][0] * rs * g0, x1 = acc[ai][bj][m][1] * rs * g1;
                        if (wc == 0) { f32x4 o0, o1; SHX4(o0, x0, 32); SHX4(o1, x1, 32);
                            if (fq < 2) { x0 = x0 * c0 - o0 * s0; x1 = x1 * c1 - o1 * s1; } else { x0 = x0 * c0 + o0 * s0; x1 = x1 * c1 + o1 * s1; } }
                        const int hh = 2 * pn + bj;
                        if (pn < 4) {
                            if (smp) { if (valid) { GAS float* q = QS + (size_t)r * 1024 + hh * 128 + cl; *(GAS f32x4*)q = x0; *(GAS f32x4*)(q + 4) = x1; } }
                            else *(GAS u32x4*)(Qb + (((size_t)bb * NH + hh) * S + tt) * HD + cl) = PK8B(x0, x1);
                        } else {
                            if (smp) { if (valid) { GAS float* k = out + O_KS + (size_t)r * 256 + bj * 128 + cl; *(GAS f32x4*)k = x0; *(GAS f32x4*)(k + 4) = x1; } }
                            else { GAS float* k = out + O_KP + (size_t)grow * 256 + bj * 128 + cl; *(GAS f32x4*)k = x0; *(GAS f32x4*)(k + 4) = x1;
                                *(GAS u32x4*)(Kb + (((size_t)bb * NKV + bj) * S + tt) * HD + cl) = PK8B(x0, x1); }
                        } } }
            } else {
                const int dl = 32 * (wc & 1) + 8 * fq;
                const f32x4 g0 = *(const GAS f32x4*)((const GAS float*)gki + dl), g1 = *(const GAS f32x4*)((const GAS float*)gki + dl + 4);
                GAS f16* KI = (GAS f16*)(ws + WS_KI); GAS float* WI = (GAS float*)(ws + WS_WI);
                ROWLOOP { asm volatile("" ::: "memory"); ROWVARS
                    const f32x4 p = *(const LAS f32x4*)(scr + (r * 2) * 4);
                    const float rs = rsqrtf((p[0] + p[1]) * (1.f / 64.f) + EPS);
                    f32x4 x0 = acc[ai][0][m][0] * rs * g0, x1 = acc[ai][0][m][1] * rs * g1;
                    f32x4 o0, o1; SHX4(o0, x0, 16); SHX4(o1, x1, 16);
                    if (wc == 0 && fq < 2) { const GAS f32x4* cp = (const GAS f32x4*)(ri + (slot * 8) * 2); const f32x4 t0_ = cp[0], t1_ = cp[1], t2_ = cp[2], t3_ = cp[3];
                        const f32x4 c0 = {t0_[0], t0_[2], t1_[0], t1_[2]}, s0 = {t0_[1], t0_[3], t1_[1], t1_[3]}, c1 = {t2_[0], t2_[2], t3_[0], t3_[2]}, s1 = {t2_[1], t2_[3], t3_[1], t3_[3]};
                        if (fq == 0) { x0 = x0 * c0 - o0 * s0; x1 = x1 * c1 - o1 * s1; } else { x0 = x0 * c0 + o0 * s0; x1 = x1 * c1 + o1 * s1; } }
                    if (wc < 2 && valid) {
                        GAS float* ko = smp ? out + O_KIS + (size_t)r * 64 + dl : out + O_KIP + (size_t)grow * 64 + dl;
                        *(GAS f32x4*)ko = x0; *(GAS f32x4*)(ko + 4) = x1;
                        if (!smp) *(GAS u32x4*)(KI + (size_t)grow * 64 + dl) = PK8H(x0, x1); }
                    if (wc == 2 && fq < 2 && valid) { GAS float* wo = WI + (size_t)grow * 16 + 8 * fq; *(GAS f32x4*)wo = acc[ai][0][m][0] * (1.f / 32.f); *(GAS f32x4*)(wo + 4) = acc[ai][0][m][1] * (1.f / 32.f); }
                }
            }
        } else if (pn == 5) {
            GAS bf16_t* Vb = (GAS bf16_t*)(ws + WS_VB);
            ROWLOOP { asm volatile("" ::: "memory"); ROWVARS
#pragma unroll
                for (int bj = 0; bj < 2; ++bj) { const f32x4 x0 = acc[ai][bj][m][0], x1 = acc[ai][bj][m][1];
                    if (smp) { if (valid) { GAS float* v = out + O_VS + (size_t)r * 256 + bj * 128 + cl; *(GAS f32x4*)v = x0; *(GAS f32x4*)(v + 4) = x1; } }
                    else { GAS float* v = out + O_VP + (size_t)grow * 256 + bj * 128 + cl; *(GAS f32x4*)v = x0; *(GAS f32x4*)(v + 4) = x1;
                        *(GAS u32x4*)(Vb + (((size_t)bb * NKV + bj) * S + tt) * HD + cl) = PK8B(x0, x1); } } }
        } else if (pn <= 9) {
            GAS f16* SZ = (GAS f16*)(ws + WS_SZ); const int c0 = 256 * (pn - 6) + cl;
            ROWLOOP { asm volatile("" ::: "memory"); ROWVARS
                if (valid) {
#pragma unroll
                    for (int bj = 0; bj < 2; ++bj) { const f32x4 a0 = acc[ai][bj][m][0], a1 = acc[ai][bj][m][1];
                        f32x4 z0, z1; z0[0] = silu(a0[0]); z0[1] = silu(a0[1]); z0[2] = silu(a0[2]); z0[3] = silu(a0[3]); z1[0] = silu(a1[0]); z1[1] = silu(a1[1]); z1[2] = silu(a1[2]); z1[3] = silu(a1[3]);
                        *(GAS u32x4*)(SZ + (size_t)grow * 1024 + c0 + 128 * bj) = PK8H(z0, z1); } } }
        } else if (pn <= 13) {
            GAS f16* QI = (GAS f16*)(ws + WS_QI); const int c0 = 256 * (pn - 10) + cl;
            ROWLOOP { asm volatile("" ::: "memory"); ROWVARS
                f32x4 c0v = {1.f, 1.f, 1.f, 1.f}, s0v = {0.f, 0.f, 0.f, 0.f}, c1v = c0v, s1v = s0v;
                const bool rp = (wc & 1) == 0;
                if (rp) { const GAS f32x4* cp = (const GAS f32x4*)(ri + (slot * 8) * 2); const f32x4 t0_ = cp[0], t1_ = cp[1], t2_ = cp[2], t3_ = cp[3];
                    c0v = (f32x4){t0_[0], t0_[2], t1_[0], t1_[2]}; s0v = (f32x4){t0_[1], t0_[3], t1_[1], t1_[3]}; c1v = (f32x4){t2_[0], t2_[2], t3_[0], t3_[2]}; s1v = (f32x4){t2_[1], t2_[3], t3_[1], t3_[3]}; }
#pragma unroll
                for (int bj = 0; bj < 2; ++bj) { f32x4 x0 = acc[ai][bj][m][0], x1 = acc[ai][bj][m][1];
                    f32x4 o0, o1; SHX4(o0, x0, 16); SHX4(o1, x1, 16);
                    if (rp && fq < 2) { if (fq == 0) { x0 = x0 * c0v - o0 * s0v; x1 = x1 * c1v - o1 * s1v; } else { x0 = x0 * c0v + o0 * s0v; x1 = x1 * c1v + o1 * s1v; } }
                    if (valid) *(GAS u32x4*)(QI + (size_t)grow * 1024 + c0 + 128 * bj) = PK8H(x0, x1); } }
        } else {
            GAS f16* UG = (GAS f16*)(ws + WS_U); const int ch = 64 * (pn - 15) + 16 * wc + 4 * fq;
            ROWLOOP { asm volatile("" ::: "memory"); ROWVARS
                const f32x4 h = acc[ai][0][m][0], b = acc[ai][0][m][1], c = acc[ai][1][m][0], z = acc[ai][1][m][1];
                const f32x4 uu = c * h; f32x4 gg; gg[0] = b[0] * silu(z[0]); gg[1] = b[1] * silu(z[1]); gg[2] = b[2] * silu(z[2]); gg[3] = b[3] * silu(z[3]);
                if (valid) { u32x4 w = {pk_f16(uu[0], uu[1]), pk_f16(uu[2], uu[3]), pk_f16(gg[0], gg[1]), pk_f16(gg[2], gg[3])};
                    *(GAS u32x4*)(UG + (size_t)grow * 2048 + 2 * ch) = w;
                    if (!smp && tt >= S - 2) *(GAS f32x4*)(out + O_CVP + ((size_t)bb * 2 + (tt - (S - 2))) * 1024 + ch) = uu;
                    if (smp && tt >= 2) *(GAS f32x4*)(out + O_CVS + ((size_t)(r >> 2) * 2 + (tt - 2)) * 1024 + ch) = uu; } }
        }
#undef ROWLOOP
#undef ROWVARS
#undef PK8B
#undef PK8H
#undef SHX4
    }
};


struct EpiOut {
    float* out; const float* xp;
    __device__ __forceinline__ bool aligned(const pg8::Unit&) const { return false; }
    __device__ __forceinline__ void init(f32x4 (&acc)[2][2][4][2], const pg8::Unit& u, int wr, int wc, int fr, int fq) const {
        const GAS float* xp = (const GAS float*)this->xp;
        const size_t base = (size_t)(u.pm * 256 + 64 * wr + fr) * DM + u.pn * 256 + 32 * wc + 4 * fq;
#pragma unroll
        for (int ai = 0; ai < 2; ++ai)
#pragma unroll
            for (int m = 0; m < 4; ++m)
#pragma unroll
                for (int bj = 0; bj < 2; ++bj)
#pragma unroll
                    for (int n = 0; n < 2; ++n) acc[ai][bj][m][n] = *(const GAS f32x4*)(xp + base + (size_t)(128 * ai + 16 * m) * DM + 128 * bj + 16 * n);
    }
    __device__ __forceinline__ void operator()(f32x4 (&acc)[2][2][4][2], const pg8::Unit& u, int wr, int wc, int fr_, int fq_) const {
        int fr = fr_, fq = fq_; asm volatile("" : "+v"(fr), "+v"(fq));
        GAS float* out = (GAS float*)this->out; asm volatile("" : "+s"(out));
        const size_t base = (size_t)(u.pm * 256 + 64 * wr + fr) * DM + u.pn * 256 + 32 * wc + 4 * fq;
#pragma unroll
        for (int ai = 0; ai < 2; ++ai)
#pragma unroll
            for (int m = 0; m < 4; ++m) { const size_t off = base + (size_t)(128 * ai + 16 * m) * DM;
#pragma unroll
                for (int bj = 0; bj < 2; ++bj)
#pragma unroll
                    for (int n = 0; n < 2; ++n) *(GAS f32x4*)(out + off + 128 * bj + 16 * n) = acc[ai][bj][m][n]; }
    }
};
__device__ __forceinline__ void p4_sample(const Args& a, LAS unsigned char* lds, int bx, int G, int tid) {
    const GAS f16* MIX = (const GAS f16*)(a.ws + WS_MIX) + (size_t)MP * DM; const GAS f16* WT = (const GAS f16*)(a.ws + WS_WOUTT);
    LAS float* part = (LAS float*)lds;
    const int lane = tid & 63, wave = __builtin_amdgcn_readfirstlane(tid >> 6), fr = lane & 15, fq = lane >> 4;
    for (int cg = bx; cg < DM / 8; cg += G) {
        const GAS f16* wp = WT + (size_t)(cg * 8 + (fr & 7)) * DM + wave * 256 + 8 * fq; const GAS f16* mp = MIX + (size_t)fr * DM + wave * 256 + 8 * fq;
        f16x8 wf[8], m0[8], m1[8];
#pragma unroll
        for (int ks = 0; ks < 8; ++ks) { wf[ks] = *(const GAS f16x8*)(wp + 32 * ks); m0[ks] = *(const GAS f16x8*)(mp + 32 * ks); m1[ks] = *(const GAS f16x8*)(mp + (size_t)16 * DM + 32 * ks); }
        f32x4 c0 = {0.f, 0.f, 0.f, 0.f}, c1 = {0.f, 0.f, 0.f, 0.f};
#pragma unroll
        for (int ks = 0; ks < 8; ++ks) { c0 = __builtin_amdgcn_mfma_f32_16x16x32_f16(wf[ks], m0[ks], c0, 0, 0, 0); c1 = __builtin_amdgcn_mfma_f32_16x16x32_f16(wf[ks], m1[ks], c1, 0, 0, 0); }
        *(LAS f32x4*)(part + ((wave * 2 + 0) * 64 + lane) * 4) = c0; *(LAS f32x4*)(part + ((wave * 2 + 1) * 64 + lane) * 4) = c1;
        __syncthreads();
        if (tid < 256) { const int rr = tid >> 3, cc = tid & 7; const int ln = (rr & 15) + 16 * (cc >> 2), tl = rr >> 4; float s = a.in[1][(size_t)rr * DM + cg * 8 + cc];
#pragma unroll
            for (int w = 0; w < 8; ++w) s += part[((w * 2 + tl) * 64 + ln) * 4 + (cc & 3)];
            a.out[O_YS + (size_t)rr * DM + cg * 8 + cc] = s; }
        __syncthreads();
    }
}
#define STAT_WORD 16000
#define SPAN_T0() (*(LAS unsigned*)(size_t)(MISC_OFF + 164))
#define SPAN_BEGIN() do { __syncthreads(); if (threadIdx.x == 0) SPAN_T0() = (unsigned)__builtin_amdgcn_s_memrealtime(); } while (0)
#ifdef SPAN_WAITACC
#define SPAN_VAL() (*(LAS unsigned*)(size_t)(MISC_OFF + 160))
#else
#define SPAN_VAL() ((unsigned)__builtin_amdgcn_s_memrealtime() - SPAN_T0())
#endif
#if defined(SPAN_MODE_MAX)
#define SPAN_ACC(p_, d_) (void)__hip_atomic_fetch_max(p_, d_, __ATOMIC_RELAXED, __HIP_MEMORY_SCOPE_AGENT)
#define SPAN_DIV 1u
#elif defined(SPAN_MODE_AVG)
#define SPAN_ACC(p_, d_) (void)__hip_atomic_fetch_add(p_, d_, __ATOMIC_RELAXED, __HIP_MEMORY_SCOPE_AGENT)
#define SPAN_DIV (unsigned)gridDim.x
#else
#define SPAN_ACC(p_, d_) (void)0
#define SPAN_DIV 1u
#endif
#define SPAN_END() do { __syncthreads(); if (threadIdx.x == 0) { const unsigned d_ = SPAN_VAL(); unsigned* sw_ = (unsigned*)a.ws + STAT_WORD; SPAN_ACC(sw_, d_); } } while (0)
#define SPAN_SPIN() do { if (threadIdx.x == 0) { const unsigned d_ = __hip_atomic_load((unsigned*)a.ws + STAT_WORD, __ATOMIC_RELAXED, __HIP_MEMORY_SCOPE_AGENT) / SPAN_DIV; \
        const unsigned long long s_ = __builtin_amdgcn_s_memrealtime(); while ((unsigned)(__builtin_amdgcn_s_memrealtime() - s_) < d_) __builtin_amdgcn_s_sleep(4); } __syncthreads(); } while (0)
#define SPAN_SELF() do { __syncthreads(); if (threadIdx.x == 0) { const unsigned d_ = SPAN_VAL(); \
        const unsigned long long s_ = __builtin_amdgcn_s_memrealtime(); while ((unsigned)(__builtin_amdgcn_s_memrealtime() - s_) < d_) __builtin_amdgcn_s_sleep(4); } __syncthreads(); } while (0)
typedef GAS unsigned gu32;
#define XB_TMO      128
#define XB_XCNT(j)  (256  + 64 * (j))
#define XB_XSUB(j)  (1280 + 64 * (j))
#define XB_XGEN(j)  (2304 + 64 * (j))
#define XB_TOP      3328
#define XB_TOPGEN   3392
#define XCD_BAR_WORDS 3456
#define XB_SPIN_CAP (1u << 18)
__device__ __forceinline__ unsigned xb_ld(unsigned* p)              { return __hip_atomic_load(p, __ATOMIC_RELAXED, __HIP_MEMORY_SCOPE_AGENT); }
__device__ __forceinline__ unsigned xb_add(unsigned* p, unsigned v) { return __hip_atomic_fetch_add(p, v, __ATOMIC_RELAXED, __HIP_MEMORY_SCOPE_AGENT); }
__device__ __forceinline__ unsigned xb_xcc_id() { return (unsigned)__builtin_amdgcn_s_getreg((3 << 11) | 20) & 0xFu; }
#define XB_SPIN(cond, bar) do { unsigned _sp = 0; while (cond) { __builtin_amdgcn_s_sleep(1); \
    if ((++_sp & 255u) == 0u) { if (xb_ld(&(bar)[XB_TMO])) break; if (_sp > XB_SPIN_CAP) { atomicAdd(&(bar)[XB_TMO], 1u); break; } } } } while (0)
struct XcdBarrier { unsigned* bar; unsigned x; volatile LAS unsigned* st; };
__device__ __forceinline__ XcdBarrier xcd_barrier_post(unsigned* bar, volatile LAS unsigned* st) {
    XcdBarrier b; b.bar = bar; b.x = xb_xcc_id(); b.st = st;
    if (threadIdx.x == 0) (void)xb_add(&bar[XB_XCNT(b.x)], 1u);
    return b;
}
__device__ __forceinline__ void xcd_barrier_complete(unsigned* bar, unsigned x, unsigned& nloc, unsigned& nx) {
    const unsigned G = gridDim.x * gridDim.y * gridDim.z;
    unsigned sum, cnt, mine, sp = 0u;
    for (;;) {
        sum = 0u; cnt = 0u; mine = 0u;
#pragma unroll
        for (unsigned j = 0; j < 16; ++j) { const unsigned c = xb_ld(&bar[XB_XCNT(j)]); sum += c; cnt += (c > 0u) ? 1u : 0u; mine = (j == x) ? c : mine; }
        if (sum == G) break;
        __builtin_amdgcn_s_sleep(1);
        if ((++sp & 255u) == 0u) { if (xb_ld(&bar[XB_TMO])) break; if (sp > XB_SPIN_CAP) { atomicAdd(&bar[XB_TMO], 1u); break; } }
    }
    nloc = mine > 0u ? mine : 1u; nx = cnt > 0u ? cnt : 1u;
}
__device__ __forceinline__ void xcd_barrier(const XcdBarrier& b) {
    asm volatile("s_waitcnt vmcnt(0)" ::: "memory");
    __syncthreads();
    if (threadIdx.x == 0) {
        unsigned* bar = b.bar;
        __builtin_amdgcn_s_waitcnt(0);
        unsigned nloc = b.st[0], nx = b.st[1];
        if (nloc == 0u) { xcd_barrier_complete(bar, b.x, nloc, nx); b.st[0] = nloc; b.st[1] = nx; }
        const unsigned old = xb_add(&bar[XB_XSUB(b.x)], 1u);
        const unsigned gen = old / nloc;
        if (old + 1u == (gen + 1u) * nloc) {
            __builtin_amdgcn_fence(__ATOMIC_RELEASE, "agent");
            asm volatile("s_waitcnt vmcnt(0)" ::: "memory");
            const unsigned og = xb_add(&bar[XB_TOP], 1u);
            const unsigned tg = og / nx;
            if (og + 1u == (tg + 1u) * nx) xb_add(&bar[XB_TOPGEN], 1u);
            else XB_SPIN(xb_ld(&bar[XB_TOPGEN]) == tg, bar);
            __builtin_amdgcn_fence(__ATOMIC_ACQUIRE, "agent");
            xb_add(&bar[XB_XGEN(b.x)], 1u);
            asm volatile("s_waitcnt vmcnt(0)" ::: "memory");
        } else {
            XB_SPIN(xb_ld(&bar[XB_XGEN(b.x)]) == gen, bar);
            __builtin_amdgcn_fence(__ATOMIC_ACQUIRE, "agent");
            asm volatile("s_waitcnt vmcnt(0)" ::: "memory");
        }
    }
    __syncthreads();
}

constexpr int CMQ_WORD = 16064;
constexpr int RDY_WORD0 = 4096;
__device__ __forceinline__ void signal_add(unsigned* ctr) {
    asm volatile("s_waitcnt vmcnt(0)" ::: "memory");
    __syncthreads();
    if (threadIdx.x == 0) { __builtin_amdgcn_fence(__ATOMIC_RELEASE, "agent"); asm volatile("s_waitcnt vmcnt(0)" ::: "memory"); (void)xb_add(ctr, 1u); }
}
__device__ __forceinline__ void wait_ge(unsigned* ctr, unsigned need) {
    if (threadIdx.x == 0) { unsigned sp = 0; while (xb_ld(ctr) < need) { __builtin_amdgcn_s_sleep(2); if (++sp > (1u << 22)) break; }
        __builtin_amdgcn_fence(__ATOMIC_ACQUIRE, "agent"); asm volatile("s_waitcnt vmcnt(0)" ::: "memory"); }
    __syncthreads();
}

__device__ __forceinline__ void signal_add_wt(unsigned* ctr) {
    asm volatile("s_waitcnt vmcnt(0)" ::: "memory");
    __syncthreads();
    if (threadIdx.x == 0) (void)xb_add(ctr, 1u);
}
__device__ __forceinline__ void wait_ge_wt(unsigned* ctr, unsigned need) {
#ifdef SPAN_WAITACC
    if (threadIdx.x == 0) { const unsigned long long w0_ = __builtin_amdgcn_s_memrealtime(); unsigned sp = 0; while (xb_ld(ctr) < need) { __builtin_amdgcn_s_sleep(2); if (++sp > (1u << 22)) break; }
        *(LAS unsigned*)(size_t)(145408 + 160) += (unsigned)(__builtin_amdgcn_s_memrealtime() - w0_); }
#else
    if (threadIdx.x == 0) { unsigned sp = 0; while (xb_ld(ctr) < need) { __builtin_amdgcn_s_sleep(2); if (++sp > (1u << 22)) break; } }
#endif
    __syncthreads();
}

#ifndef P2_KT_REP
#define P2_KT_REP 1
#define P2_SEL_REP 1
#endif
#ifndef P2_REP_A
#define P2_REP_A 1
#define P2_REP_B 1
#define P2_REP_C 1
#endif
constexpr int SC_STRIDE = 2052;
constexpr int SC_BYTES = 16 * SC_STRIDE * 4;
constexpr int WSCR_OFF = 131584, WSCR_BYTES = 1536;
__device__ __forceinline__ f16x8 cvt8(f32x4 a, f32x4 b) { u32x4 w = {pk_f16(a[0], a[1]), pk_f16(a[2], a[3]), pk_f16(b[0], b[1]), pk_f16(b[2], b[3])}; return __builtin_bit_cast(f16x8, w); }

__device__ __forceinline__ void convmix_task(const Args& a, int ch, int half, int lane) {
    const GAS f16* UG = (const GAS f16*)(a.ws + WS_U); GAS f16* MIX = (GAS f16*)(a.ws + WS_MIX);
    const GAS float* wconv = (const GAS float*)a.in[12]; const GAS float* state = (const GAS float*)a.in[5];
    {
        const int row0 = 4 * ch; const bool smp = row0 >= MP; const int t0 = smp ? 0 : (row0 & (S - 1)); const int seq = (row0 - MP) >> 2;
        { const int cb = half * 512 + 8 * lane;
            float um2[8], um1[8], w0[8], w1[8], w2[8];
#pragma unroll
            for (int e = 0; e < 8; e += 4) { const f32x4 a0 = *(const GAS f32x4*)(wconv + cb + e), a1 = *(const GAS f32x4*)(wconv + 1024 + cb + e), a2 = *(const GAS f32x4*)(wconv + 2048 + cb + e);
#pragma unroll
                for (int i = 0; i < 4; ++i) { w0[e + i] = a0[i]; w1[e + i] = a1[i]; w2[e + i] = a2[i]; } }
            if (t0 == 0) {
                if (smp) {
#pragma unroll
                    for (int e = 0; e < 8; e += 4) { const f32x4 s0 = *(const GAS f32x4*)(state + ((size_t)seq * 2) * 1024 + cb + e), s1 = *(const GAS f32x4*)(state + ((size_t)seq * 2 + 1) * 1024 + cb + e);
#pragma unroll
                        for (int i = 0; i < 4; ++i) { um2[e + i] = s0[i]; um1[e + i] = s1[i]; } }
                } else {
#pragma unroll
                    for (int e = 0; e < 8; ++e) { um2[e] = 0.f; um1[e] = 0.f; } }
            } else {
#pragma unroll
                for (int gq = 0; gq < 2; ++gq) { const f16x4 p2 = *(const GAS f16x4*)(UG + (size_t)(row0 - 2) * 2048 + 2 * cb + 8 * gq), p1 = *(const GAS f16x4*)(UG + (size_t)(row0 - 1) * 2048 + 2 * cb + 8 * gq);
#pragma unroll
                    for (int e = 0; e < 4; ++e) { um2[4 * gq + e] = (float)p2[e]; um1[4 * gq + e] = (float)p1[e]; } } }
#pragma unroll
            for (int i = 0; i < 4; ++i) { const size_t row = row0 + i;
                const f16x8 x0 = *(const GAS f16x8*)(UG + row * 2048 + 2 * cb), x1 = *(const GAS f16x8*)(UG + row * 2048 + 2 * cb + 8); float o[8];
#pragma unroll
                for (int e = 0; e < 8; ++e) { const float u = (float)(e < 4 ? x0[e] : x1[e - 4]); const float g = (float)(e < 4 ? x0[4 + e] : x1[e]);
                    const float cv = w0[e] * um2[e] + w1[e] * um1[e] + w2[e] * u; o[e] = g * cv; um2[e] = um1[e]; um1[e] = u; }
                u32x4 w = {pk_f16(o[0], o[1]), pk_f16(o[2], o[3]), pk_f16(o[4], o[5]), pk_f16(o[6], o[7])};
                *(GAS u32x4*)(MIX + row * 2048 + 1024 + cb) = w; }
        }
    }
}

__device__ __forceinline__ void p2_sscore(const Args& a, int gw, int NGW, int lane) {
    const GAS float* cki = (const GAS float*)a.in[4]; const GAS int* ptab = (const GAS int*)a.in[6];
    const GAS f16* QI = (const GAS f16*)(a.ws + WS_QI); const GAS float* WI = (const GAS float*)(a.ws + WS_WI); GAS float* SSC = (GAS float*)(a.ws + WS_SSC);
    const int fr = lane & 15, fq = lane >> 4;
    for (int it = gw; it < NSB * 256; it += NGW) {
        const int sb = it >> 8, hp = it & 255, pg = hp >> 1, k0 = (hp & 1) * 64; const int phys = ptab[sb * NPAGES + pg];
        const GAS float* kbase = cki + ((size_t)phys * PAGE + k0) * 64;
        f16x8 qf[4][2]; f32x4 wv[4];
#pragma unroll
        for (int t = 0; t < 4; ++t) { const size_t row = MP + 4 * sb + t;
            qf[t][0] = *(const GAS f16x8*)(QI + row * 1024 + fr * 64 + 8 * fq); qf[t][1] = *(const GAS f16x8*)(QI + row * 1024 + fr * 64 + 32 + 8 * fq);
            wv[t] = *(const GAS f32x4*)(WI + row * 16 + 4 * fq); }
        f32x4 kraw[4][4];
#pragma unroll
        for (int tile = 0; tile < 4; ++tile) { const GAS float* kr = kbase + (size_t)(16 * tile + fr) * 64 + 8 * fq;
            kraw[tile][0] = *(const GAS f32x4*)kr; kraw[tile][1] = *(const GAS f32x4*)(kr + 4); kraw[tile][2] = *(const GAS f32x4*)(kr + 32); kraw[tile][3] = *(const GAS f32x4*)(kr + 36); }
#pragma unroll
        for (int tile = 0; tile < 4; ++tile) {
            const f16x8 kf0 = cvt8(kraw[tile][0], kraw[tile][1]), kf1 = cvt8(kraw[tile][2], kraw[tile][3]);
            float mine = 0.f;
#pragma unroll
            for (int t = 0; t < 4; ++t) { f32x4 c = {0.f, 0.f, 0.f, 0.f};
                c = __builtin_amdgcn_mfma_f32_16x16x32_f16(qf[t][0], kf0, c, 0, 0, 0); c = __builtin_amdgcn_mfma_f32_16x16x32_f16(qf[t][1], kf1, c, 0, 0, 0);
                float s = wv[t][0] * fmaxf(c[0], 0.f) + wv[t][1] * fmaxf(c[1], 0.f) + wv[t][2] * fmaxf(c[2], 0.f) + wv[t][3] * fmaxf(c[3], 0.f);
                s += __shfl_xor(s, 16); s += __shfl_xor(s, 32);
                mine = fq == t ? s : mine; }
            __hip_atomic_store((GAS unsigned*)SSC + ((size_t)(4 * sb + fq) * PAST + pg * PAGE + k0 + 16 * tile + fr), __builtin_bit_cast(unsigned, mine), __ATOMIC_RELAXED, __HIP_MEMORY_SCOPE_AGENT);
        }
    }
}

__device__ __forceinline__ void wave_topk_mask(const LAS float* row, int t, GAS unsigned long long* mrow, int lane, LAS unsigned* hist, LAS float* cand) {
    const float NINF = -__builtin_inff(), PINF = __builtin_inff();
    const int jmax = t >> 6;
    const int rem = t - lane;
    float v[32]; float mx = NINF, mn = PINF;
#pragma unroll
    for (int g = 0; g < 4; ++g) {
        if (8 * g <= jmax) {
#pragma unroll
            for (int jj = 0; jj < 8; ++jj) { const int j = 8 * g + jj; const float x = row[64 * j + lane]; const bool ok = 64 * j <= rem; v[j] = ok ? x : NINF; mx = fmaxf(mx, v[j]); mn = fminf(mn, ok ? x : PINF); }
        } else {
#pragma unroll
            for (int jj = 0; jj < 8; ++jj) v[8 * g + jj] = NINF; } }
    mx = wave_max_dpp(mx); mn = -wave_max_dpp(-mn);
    *(LAS u32x4*)(hist + 4 * lane) = (u32x4){0u, 0u, 0u, 0u};
    const float scale = 255.5f / (mx - mn), off = -mn * scale;
    float tau = 0.f; bool have = false;
    if (mx > mn) {
        asm volatile("s_waitcnt lgkmcnt(0)" ::: "memory");
        unsigned bins[32];
#pragma unroll
        for (int g = 0; g < 4; ++g) {
            if (8 * g <= jmax) {
#pragma unroll
                for (int jj = 0; jj < 8; ++jj) { const int j = 8 * g + jj; unsigned b = (unsigned)fmaf(v[j], scale, off); b = b > 255u ? 255u : b; bins[j] = b;
                    __hip_atomic_fetch_add(hist + b, 1u, __ATOMIC_RELAXED, __HIP_MEMORY_SCOPE_WORKGROUP); }
            } else {
#pragma unroll
                for (int jj = 0; jj < 8; ++jj) bins[8 * g + jj] = 0u; } }
        asm volatile("s_waitcnt lgkmcnt(0)" ::: "memory");
        const u32x4 h = *(const LAS u32x4*)(hist + 4 * lane);
        const unsigned sl = h[0] + h[1] + h[2] + h[3]; const unsigned pre = wave_scan_dpp(sl);
        const unsigned tot = __builtin_amdgcn_readlane(pre, 63); const unsigned suf = tot - pre + sl;
        const unsigned long long bm = __ballot(suf >= TOPK);
        const int Ls = 63 - __builtin_clzll(bm);
        unsigned c = __builtin_amdgcn_readlane(suf, Ls) - __builtin_amdgcn_readlane(sl, Ls);
        const unsigned h3 = __builtin_amdgcn_readlane(h[3], Ls), h2 = __builtin_amdgcn_readlane(h[2], Ls), h1 = __builtin_amdgcn_readlane(h[1], Ls);
        int Bs;
        if (c + h3 >= TOPK) Bs = 4 * Ls + 3; else { c += h3; if (c + h2 >= TOPK) Bs = 4 * Ls + 2; else { c += h2; if (c + h1 >= TOPK) Bs = 4 * Ls + 1; else { c += h1; Bs = 4 * Ls; } } }
        const int need = TOPK - (int)c;
        if (Bs > 0) {
            int base = 0;
#pragma unroll
            for (int g = 0; g < 4; ++g) {
                if (8 * g <= jmax) {
#pragma unroll
                    for (int jj = 0; jj < 8; ++jj) { const int j = 8 * g + jj; const bool isc = bins[j] == (unsigned)Bs;
                        const unsigned long long m = __ballot(isc);
                        if (m) { const int pos = base + (int)__builtin_amdgcn_mbcnt_hi((unsigned)(m >> 32), __builtin_amdgcn_mbcnt_lo((unsigned)m, 0u)); if (isc && pos < 64) cand[pos] = v[j]; base += __builtin_popcountll(m); } } } }
            if (base <= 64) {
                asm volatile("s_waitcnt lgkmcnt(0)" ::: "memory");
                const float x = lane < base ? cand[lane] : NINF; int rank = 0;
                for (int m = 0; m < base; ++m) { const float y = __builtin_bit_cast(float, __builtin_amdgcn_readlane(__builtin_bit_cast(int, x), m)); rank += y > x ? 1 : 0; }
                float tc = (lane < base && rank <= need - 1) ? x : PINF;
                tau = -wave_max_dpp(-tc); have = true;
            }
        }
    }
    if (!have) {
        unsigned tk = 0u;
        for (int bit = 31; bit >= 0; --bit) { const unsigned cd = tk | (1u << bit); int cnt = 0;
#pragma unroll
            for (int j = 0; j < 32; ++j) cnt += __builtin_popcountll(__ballot((64 * j + lane <= t) && fkey(v[j]) >= cd));
            if (cnt >= TOPK) tk = cd; }
        tau = __builtin_bit_cast(float, (tk & 0x80000000u) ? (tk ^ 0x80000000u) : ~tk);
    }
    unsigned wlo = 0u, whi = 0u;
#pragma unroll
    for (int g = 0; g < 4; ++g) {
        if (8 * g <= jmax) {
#pragma unroll
            for (int jj = 0; jj < 8; ++jj) { const int j = 8 * g + jj; const unsigned long long m = __ballot(v[j] >= tau);
                if (lane == j) { wlo = (unsigned)m; whi = (unsigned)(m >> 32); } } } }
    if (lane < 32) __hip_atomic_store(mrow + lane, ((unsigned long long)whi << 32) | wlo, __ATOMIC_RELAXED, __HIP_MEMORY_SCOPE_AGENT);
}

__device__ __forceinline__ void wave_topk_mask2(const LAS float* rowA, const LAS float* rowB, int tA, GAS unsigned long long* mrowA, GAS unsigned long long* mrowB, int lane, LAS unsigned* hist, LAS float* cand) {
    const float NINF = -__builtin_inff(), PINF = __builtin_inff();
    const int tB = tA + 1, jmax = tB >> 6;
    const int remA = tA - lane, remB = tB - lane;
    float vA[32], vB[32]; float mxA = NINF, mnA = PINF, mxB = NINF, mnB = PINF;
#pragma unroll
    for (int g = 0; g < 4; ++g) {
        if (8 * g <= jmax) {
#pragma unroll
            for (int jj = 0; jj < 8; ++jj) { const int j = 8 * g + jj; const float xA = rowA[64 * j + lane], xB = rowB[64 * j + lane]; const bool okA = 64 * j <= remA, okB = 64 * j <= remB;
                vA[j] = okA ? xA : NINF; mxA = fmaxf(mxA, vA[j]); mnA = fminf(mnA, okA ? xA : PINF);
                vB[j] = okB ? xB : NINF; mxB = fmaxf(mxB, vB[j]); mnB = fminf(mnB, okB ? xB : PINF); }
        } else {
#pragma unroll
            for (int jj = 0; jj < 8; ++jj) { vA[8 * g + jj] = NINF; vB[8 * g + jj] = NINF; } } }
    mxA = wave_max_dpp(mxA); mxB = wave_max_dpp(mxB); mnA = -wave_max_dpp(-mnA); mnB = -wave_max_dpp(-mnB);
    *(LAS u32x4*)(hist + 4 * lane) = (u32x4){0u, 0u, 0u, 0u};
    const float scA = 255.5f / (mxA - mnA), ofA = -mnA * scA, scB = 255.5f / (mxB - mnB), ofB = -mnB * scB;
    float tauA = 0.f, tauB = 0.f; bool haveA = false, haveB = false;
#define BIN_OF(x_, sc_, of_) ({ unsigned b_ = (unsigned)fmaf((x_), (sc_), (of_)); b_ > 255u ? 255u : b_; })
    if (mxA > mnA && mxB > mnB) {
        asm volatile("s_waitcnt lgkmcnt(0)" ::: "memory");
#pragma unroll
        for (int g = 0; g < 4; ++g) {
            if (8 * g <= jmax) {
#pragma unroll
                for (int jj = 0; jj < 8; ++jj) { const int j = 8 * g + jj;
                    __hip_atomic_fetch_add(hist + BIN_OF(vA[j], scA, ofA), 1u, __ATOMIC_RELAXED, __HIP_MEMORY_SCOPE_WORKGROUP);
                    __hip_atomic_fetch_add(hist + BIN_OF(vB[j], scB, ofB), 0x10000u, __ATOMIC_RELAXED, __HIP_MEMORY_SCOPE_WORKGROUP); } } }
        asm volatile("s_waitcnt lgkmcnt(0)" ::: "memory");
        const u32x4 h = *(const LAS u32x4*)(hist + 4 * lane);
        const unsigned a0 = h[0] & 0xffffu, a1 = h[1] & 0xffffu, a2 = h[2] & 0xffffu, a3 = h[3] & 0xffffu, b0 = h[0] >> 16, b1 = h[1] >> 16, b2 = h[2] >> 16, b3 = h[3] >> 16;
        const unsigned slA = a0 + a1 + a2 + a3, slB = b0 + b1 + b2 + b3; const unsigned preA = wave_scan_dpp(slA), preB = wave_scan_dpp(slB);
        const unsigned sufA = __builtin_amdgcn_readlane(preA, 63) - preA + slA, sufB = __builtin_amdgcn_readlane(preB, 63) - preB + slB;
        const unsigned long long bmA = __ballot(sufA >= TOPK), bmB = __ballot(sufB >= TOPK);
        const int LA = 63 - __builtin_clzll(bmA), LB = 63 - __builtin_clzll(bmB);
        int BsA, BsB, needA, needB;
        { unsigned c = __builtin_amdgcn_readlane(sufA, LA) - __builtin_amdgcn_readlane(slA, LA);
          const unsigned h3 = __builtin_amdgcn_readlane(a3, LA), h2 = __builtin_amdgcn_readlane(a2, LA), h1 = __builtin_amdgcn_readlane(a1, LA);
          if (c + h3 >= TOPK) BsA = 4 * LA + 3; else { c += h3; if (c + h2 >= TOPK) BsA = 4 * LA + 2; else { c += h2; if (c + h1 >= TOPK) BsA = 4 * LA + 1; else { c += h1; BsA = 4 * LA; } } }
          needA = TOPK - (int)c; }
        { unsigned c = __builtin_amdgcn_readlane(sufB, LB) - __builtin_amdgcn_readlane(slB, LB);
          const unsigned h3 = __builtin_amdgcn_readlane(b3, LB), h2 = __builtin_amdgcn_readlane(b2, LB), h1 = __builtin_amdgcn_readlane(b1, LB);
          if (c + h3 >= TOPK) BsB = 4 * LB + 3; else { c += h3; if (c + h2 >= TOPK) BsB = 4 * LB + 2; else { c += h2; if (c + h1 >= TOPK) BsB = 4 * LB + 1; else { c += h1; BsB = 4 * LB; } } }
          needB = TOPK - (int)c; }
        int baseA = 65, baseB = 65;
        if (BsA > 0) { baseA = 0;
#pragma unroll
            for (int g = 0; g < 4; ++g) {
                if (8 * g <= jmax) {
#pragma unroll
                    for (int jj = 0; jj < 8; ++jj) { const int j = 8 * g + jj; const bool isc = BIN_OF(vA[j], scA, ofA) == (unsigned)BsA;
                        const unsigned long long m = __ballot(isc);
                        if (m) { const int pos = baseA + (int)__builtin_amdgcn_mbcnt_hi((unsigned)(m >> 32), __builtin_amdgcn_mbcnt_lo((unsigned)m, 0u)); if (isc && pos < 64) cand[pos] = vA[j]; baseA += __builtin_popcountll(m); } } } } }
        if (BsB > 0) { baseB = 0;
#pragma unroll
            for (int g = 0; g < 4; ++g) {
                if (8 * g <= jmax) {
#pragma unroll
                    for (int jj = 0; jj < 8; ++jj) { const int j = 8 * g + jj; const bool isc = BIN_OF(vB[j], scB, ofB) == (unsigned)BsB;
                        const unsigned long long m = __ballot(isc);
                        if (m) { const int pos = baseB + (int)__builtin_amdgcn_mbcnt_hi((unsigned)(m >> 32), __builtin_amdgcn_mbcnt_lo((unsigned)m, 0u)); if (isc && pos < 64) cand[64 + pos] = vB[j]; baseB += __builtin_popcountll(m); } } } } }
        asm volatile("s_waitcnt lgkmcnt(0)" ::: "memory");
        if (baseA <= 64) { const float x = lane < baseA ? cand[lane] : NINF; int rank = 0;
            for (int m = 0; m < baseA; ++m) { const float y = __builtin_bit_cast(float, __builtin_amdgcn_readlane(__builtin_bit_cast(int, x), m)); rank += y > x ? 1 : 0; }
            const float tc = (lane < baseA && rank <= needA - 1) ? x : PINF; tauA = -wave_max_dpp(-tc); haveA = true; }
        if (baseB <= 64) { const float x = lane < baseB ? cand[64 + lane] : NINF; int rank = 0;
            for (int m = 0; m < baseB; ++m) { const float y = __builtin_bit_cast(float, __builtin_amdgcn_readlane(__builtin_bit_cast(int, x), m)); rank += y > x ? 1 : 0; }
            const float tc = (lane < baseB && rank <= needB - 1) ? x : PINF; tauB = -wave_max_dpp(-tc); haveB = true; }
    }
#undef BIN_OF
    if (haveA) { unsigned wlo = 0u, whi = 0u;
#pragma unroll
        for (int g = 0; g < 4; ++g) {
            if (8 * g <= jmax) {
#pragma unroll
                for (int jj = 0; jj < 8; ++jj) { const int j = 8 * g + jj; const unsigned long long m = __ballot(vA[j] >= tauA);
                    if (lane == j) { wlo = (unsigned)m; whi = (unsigned)(m >> 32); } } } }
        if (lane < 32) __hip_atomic_store(mrowA + lane, ((unsigned long long)whi << 32) | wlo, __ATOMIC_RELAXED, __HIP_MEMORY_SCOPE_AGENT); }
    if (haveB) { unsigned wlo = 0u, whi = 0u;
#pragma unroll
        for (int g = 0; g < 4; ++g) {
            if (8 * g <= jmax) {
#pragma unroll
                for (int jj = 0; jj < 8; ++jj) { const int j = 8 * g + jj; const unsigned long long m = __ballot(vB[j] >= tauB);
                    if (lane == j) { wlo = (unsigned)m; whi = (unsigned)(m >> 32); } } } }
        if (lane < 32) __hip_atomic_store(mrowB + lane, ((unsigned long long)whi << 32) | wlo, __ATOMIC_RELAXED, __HIP_MEMORY_SCOPE_AGENT); }
    if (!haveA) wave_topk_mask(rowA, tA, mrowA, lane, hist, cand);
    if (!haveB) wave_topk_mask(rowB, tB, mrowB, lane, hist, cand);
}

#define RELU_FMA(acc_, c_, w_) do { const float f_ = (c_); const int i_ = __builtin_bit_cast(int, f_); const float r_ = __builtin_bit_cast(float, i_ > 0 ? i_ : 0); asm("v_fmac_f32_e32 %0, %1, %2" : "+v"(acc_) : "v"(r_), "v"(w_)); } while (0)
__device__ __forceinline__ void p2_index_tile(const Args& a, LAS unsigned char* lds, int b, int t0, int wave, int lane) {
    const GAS f16* QI = (const GAS f16*)(a.ws + WS_QI); const GAS float* WI = (const GAS float*)(a.ws + WS_WI); const GAS f16* KI = (const GAS f16*)(a.ws + WS_KI);
    GAS unsigned long long* MASK = (GAS unsigned long long*)(a.ws + WS_MASK);
    LAS float* sc = (LAS float*)lds;
    const int fr = lane & 15, fq = lane >> 4; const size_t rowq = (size_t)b * S + t0 + fr;
    f16x8 qf[16][2]; float w[16];
#pragma unroll
    for (int h = 0; h < 16; ++h) { qf[h][0] = *(const GAS f16x8*)(QI + rowq * 1024 + h * 64 + 8 * fq); qf[h][1] = *(const GAS f16x8*)(QI + rowq * 1024 + h * 64 + 32 + 8 * fq); }
#pragma unroll
    for (int h = 0; h < 16; h += 4) { const f32x4 x = *(const GAS f32x4*)(WI + rowq * 16 + h); w[h] = x[0]; w[h + 1] = x[1]; w[h + 2] = x[2]; w[h + 3] = x[3]; }
    const int nkt = (t0 + 16) >> 4;
    const GAS f16* kp = KI + ((size_t)b * S + fr) * 64 + 8 * fq;
#define KLOAD(d0_, d1_, kt_) do { const int k_ = (kt_) < nkt ? (kt_) : wave; d0_ = *(const GAS f16x8*)(kp + (size_t)k_ * 1024); d1_ = *(const GAS f16x8*)(kp + (size_t)k_ * 1024 + 32); } while (0)
    f16x8 ka0, ka1, kb0, kb1, kc0, kc1;
#define KCOMP(kf0, kf1, kt_) do { float a0 = 0.f, a1 = 0.f, a2 = 0.f, a3 = 0.f; const f32x4 z4 = {0.f, 0.f, 0.f, 0.f}; \
        f32x4 cc = __builtin_amdgcn_mfma_f32_16x16x32_f16(kf0, qf[0][0], z4, 0, 0, 0); cc = __builtin_amdgcn_mfma_f32_16x16x32_f16(kf1, qf[0][1], cc, 0, 0, 0); \
        _Pragma("unroll") for (int h = 0; h < 16; ++h) { f32x4 cn = z4;        \
            if (h < 15) { cn = __builtin_amdgcn_mfma_f32_16x16x32_f16(kf0, qf[h + 1][0], z4, 0, 0, 0); cn = __builtin_amdgcn_mfma_f32_16x16x32_f16(kf1, qf[h + 1][1], cn, 0, 0, 0); } \
            RELU_FMA(a0, cc[0], w[h]); RELU_FMA(a1, cc[1], w[h]); RELU_FMA(a2, cc[2], w[h]); RELU_FMA(a3, cc[3], w[h]); \
            cc = cn; __builtin_amdgcn_sched_barrier(0); } \
        *(LAS f32x4*)(sc + fr * SC_STRIDE + 16 * (kt_) + 4 * fq) = (f32x4){a0, a1, a2, a3}; } while (0)
    for (int rpk = 0; rpk < P2_KT_REP; ++rpk) {
    KLOAD(ka0, ka1, wave); KLOAD(kb0, kb1, wave + NWAVES);
    for (int kt = wave; kt < nkt; kt += 3 * NWAVES) {
        KLOAD(kc0, kc1, kt + 2 * NWAVES); KCOMP(ka0, ka1, kt);
        if (kt + NWAVES < nkt) { KLOAD(ka0, ka1, kt + 3 * NWAVES); KCOMP(kb0, kb1, kt + NWAVES); }
        if (kt + 2 * NWAVES < nkt) { KLOAD(kb0, kb1, kt + 4 * NWAVES); KCOMP(kc0, kc1, kt + 2 * NWAVES); }
    } }
#undef KCOMP
#undef KLOAD
    __syncthreads();
#pragma unroll 1
    for (int qq = 0; qq < P2_SEL_REP; ++qq) { const int q = 2 * wave; const int t = t0 + q;
        wave_topk_mask2(sc + q * SC_STRIDE, sc + (q + 1) * SC_STRIDE, t, MASK + ((size_t)b * S + t) * 32, MASK + ((size_t)b * S + t + 1) * 32, lane,
                        (LAS unsigned*)(lds + WSCR_OFF + wave * WSCR_BYTES), (LAS float*)(lds + WSCR_OFF + wave * WSCR_BYTES + 1024)); }
    __syncthreads();
}

__device__ __forceinline__ void p2_phase(const Args& a, LAS unsigned char* lds, int vcu, int G, int wave, int lane) {
    const int gw = vcu * NWAVES + wave, NGW = G * NWAVES;
    unsigned* rdy = (unsigned*)a.ws + RDY_WORD0;
    for (int rp = 0; rp < P2_REP_A; ++rp) p2_sscore(a, gw, NGW, lane);
    signal_add_wt(rdy + 64 * 32);
    HOOK_5
    { GAS unsigned long long* MASK = (GAS unsigned long long*)(a.ws + WS_MASK);
      for (int i = gw * 64 + lane; i < NB * TOPK * 32; i += NGW * 64) { const int wd = i & 31, t = (i >> 5) & (TOPK - 1), b = i >> 13; const int lo = 64 * wd;
          const unsigned long long m = lo + 63 <= t ? ~0ull : (lo > t ? 0ull : ((1ull << (t - lo + 1)) - 1ull));
          __hip_atomic_store(MASK + ((size_t)b * S + t) * 32 + wd, m, __ATOMIC_RELAXED, __HIP_MEMORY_SCOPE_AGENT); } }
    signal_add_wt(rdy + 64 * 33);
    HOOK_6
    constexpr int NT = NB * (S - TOPK) / 16;
    for (int rp = 0; rp < P2_REP_C; ++rp)
    for (int r = 0; r * G < NT; ++r) { const int k = (r & 1) ? (r + 1) * G - 1 - vcu : r * G + vcu;
        if (k < NT) { const int j = (NT / NB - 1) - (k >> 2), b = k & 3; p2_index_tile(a, lds, b, TOPK + 16 * j, wave, lane);
            if (rp == 0) signal_add_wt(rdy + 64 * (40 + b * 32 + ((TOPK + 16 * j) >> 6))); } }
}

#ifndef P3_REP_S
#define P3_REP_S 1
#define P3_REP_A 1
#endif
namespace att {
typedef short bf16x8 __attribute__((ext_vector_type(8)));
typedef short s16x4 __attribute__((ext_vector_type(4)));
typedef float f32x16 __attribute__((ext_vector_type(16)));
constexpr int QBLK = 32, KVBLK = 64, D = 128;
constexpr int SHM_V = KVBLK * D * 2, SHM_K = KVBLK * D * 2;
constexpr int WS_OFF = 2 * SHM_V + 2 * SHM_K;
constexpr float SCALE = 0.08838834764831845f;
#define KSWZ(row, colB) ((row) * 256 + ((colB) ^ (((row) & 7) << 4)))
#define SBAR() __builtin_amdgcn_sched_barrier(0)
__device__ __forceinline__ int v_st(int k, int c) { const int kk = (k & ~0xC) | ((k & 4) << 1) | ((k & 8) >> 1); return ((kk >> 3) * 4 + (c >> 5)) * 512 + ((kk & 7) * 32 + (c & 31)) * 2; }
__device__ __forceinline__ int v_rd_base(int lane) { return ((lane & 3) << 3) | (((lane >> 2) & 3) << 6) | (((lane >> 4) & 1) << 5) | (((lane >> 5) & 1) << 8); }
constexpr int v_rd_off(int d0, int ks, int half) { return d0 * 512 + ks * 4096 + half * 2048; }
__device__ __forceinline__ int crow(int r, int hi) { return (r & 3) + 8 * (r >> 2) + 4 * hi; }
__device__ __forceinline__ unsigned cvtpk(float lo, float hi) { return pk_bf16(lo, hi); }

template <int KB>
__device__ __forceinline__ void qkt(f32x16& p0, f32x16& p1, const LAS unsigned char* K_lds, int r32, int hi, const LAS unsigned char* qp) {
    p0 = f32x16{}; p1 = f32x16{};
    const LAS unsigned char* kb[4];
#pragma unroll
    for (int dd = 0; dd < 4; ++dd) kb[dd] = K_lds + KB * SHM_K + KSWZ(r32, (dd * 16 + hi * 8) * 2);
#pragma unroll
    for (int d0 = 0; d0 < 8; ++d0) { const LAS unsigned char* a = kb[d0 & 3] + (d0 >> 2) * 128;
        const bf16x8 b0 = *(const LAS bf16x8*)a;
        const bf16x8 b1 = *(const LAS bf16x8*)(a + 32 * 256);
        const bf16x8 qv = *(const LAS bf16x8*)(qp + d0 * 1024);
        p0 = __builtin_amdgcn_mfma_f32_32x32x16_bf16(b0, qv, p0, 0, 0, 0);
        p1 = __builtin_amdgcn_mfma_f32_32x32x16_bf16(b1, qv, p1, 0, 0, 0); }
}
template <int VB>
__device__ __forceinline__ void pv_tile(f32x16* o, int vb0, bf16x8 pa0, bf16x8 pa1, bf16x8 pa2, bf16x8 pa3) {
#define TRRD(dst, off) asm volatile("ds_read_b64_tr_b16 %0, %1 offset:%2" : "=&v"(dst) : "v"(vb0), "i"(off) : "memory")
#define PV_D0(d0) do { s16x4 l0, l1, l2, l3, h0, h1, h2, h3; constexpr int b_ = VB * SHM_V + v_rd_off(d0, 0, 0); \
        TRRD(l0, b_); TRRD(h0, b_ + 2048); TRRD(l1, b_ + 4096); TRRD(h1, b_ + 6144); TRRD(l2, b_ + 8192); TRRD(h2, b_ + 10240); TRRD(l3, b_ + 12288); TRRD(h3, b_ + 14336); \
        asm volatile("s_waitcnt lgkmcnt(0)" ::: "memory"); SBAR(); \
        o[d0] = __builtin_amdgcn_mfma_f32_32x32x16_bf16(pa0, (bf16x8){l0[0], l0[1], l0[2], l0[3], h0[0], h0[1], h0[2], h0[3]}, o[d0], 0, 0, 0); \
        o[d0] = __builtin_amdgcn_mfma_f32_32x32x16_bf16(pa1, (bf16x8){l1[0], l1[1], l1[2], l1[3], h1[0], h1[1], h1[2], h1[3]}, o[d0], 0, 0, 0); \
        o[d0] = __builtin_amdgcn_mfma_f32_32x32x16_bf16(pa2, (bf16x8){l2[0], l2[1], l2[2], l2[3], h2[0], h2[1], h2[2], h2[3]}, o[d0], 0, 0, 0); \
        o[d0] = __builtin_amdgcn_mfma_f32_32x32x16_bf16(pa3, (bf16x8){l3[0], l3[1], l3[2], l3[3], h3[0], h3[1], h3[2], h3[3]}, o[d0], 0, 0, 0); } while (0)
    PV_D0(0); PV_D0(1); PV_D0(2); PV_D0(3);
#undef PV_D0
#undef TRRD
}
__device__ __forceinline__ void partialSM(f32x16& p0, f32x16& p1, unsigned wl, unsigned wh, float sh2) {
    const float NEG = -__builtin_inff(); constexpr float C2 = 1.4426950408889634f * SCALE;
#pragma unroll
    for (int r = 0; r < 16; ++r) { const unsigned bit = 1u << ((r & 3) + 8 * (r >> 2));
        p0[r] = (wl & bit) ? fmaf(p0[r], C2, -sh2) : NEG; p1[r] = (wh & bit) ? fmaf(p1[r], C2, -sh2) : NEG; }
#pragma unroll
    for (int r = 0; r < 16; ++r) p0[r] = __builtin_amdgcn_exp2f(p0[r]);
}
__device__ __forceinline__ void finishSM(f32x16& p0, f32x16& p1, float& l_reg, bf16x8& pa0, bf16x8& pa1, bf16x8& pa2, bf16x8& pa3) {
#pragma unroll
    for (int r = 0; r < 16; ++r) p1[r] = __builtin_amdgcn_exp2f(p1[r]);
    float ps = 0;
#pragma unroll
    for (int r = 0; r < 16; ++r) ps += p0[r];
#pragma unroll
    for (int r = 0; r < 16; ++r) ps += p1[r];
    l_reg += ps;
#define PK4(P, B_, OUT) do { unsigned a0 = cvtpk(P[B_+0], P[B_+1]), a1 = cvtpk(P[B_+2], P[B_+3]); \
        unsigned b0 = cvtpk(P[B_+4], P[B_+5]), b1 = cvtpk(P[B_+6], P[B_+7]); \
        auto r0 = __builtin_amdgcn_permlane32_swap(a0, b0, false, false); auto r1 = __builtin_amdgcn_permlane32_swap(a1, b1, false, false); \
        u32x4 w = {r0[0], r1[0], r0[1], r1[1]}; OUT = __builtin_bit_cast(bf16x8, w); } while (0)
    PK4(p0, 0, pa0); PK4(p0, 8, pa1); PK4(p1, 0, pa2); PK4(p1, 8, pa3);
#undef PK4
}

__device__ __forceinline__ __amdgpu_buffer_rsrc_t mk_rsrc(const GAS void* p, unsigned bytes) {
    const unsigned long long u = (unsigned long long)p; const unsigned lo = __builtin_amdgcn_readfirstlane((unsigned)u), hi = __builtin_amdgcn_readfirstlane((unsigned)(u >> 32));
    return __builtin_amdgcn_make_buffer_rsrc((void*)(((unsigned long long)hi << 32) | lo), (short)0, (int)bytes, 0x00020000);
}
__device__ __forceinline__ void attn_block(const Args& a, LAS unsigned char* lds, int b, int kvh, int q0, float sh2) {
    int tid_ = threadIdx.x; asm volatile("" : "+v"(tid_));
    const int tid = tid_, wid = __builtin_amdgcn_readfirstlane(tid >> 6), lane = tid & 63, r32 = lane & 31, hi = lane >> 5;
    const int head = 4 * kvh + (wid >> 1), qw = q0 + 32 * (wid & 1);
    const GAS bf16_t* Qw = (const GAS bf16_t*)(a.ws + WS_QB) + (((size_t)b * NH + head) * S + qw) * D;
    const GAS bf16_t* Kh = (const GAS bf16_t*)(a.ws + WS_KB) + ((size_t)b * NKV + kvh) * S * D;
    const GAS bf16_t* Vh = (const GAS bf16_t*)(a.ws + WS_VB) + ((size_t)b * NKV + kvh) * S * D;
    const __amdgpu_buffer_rsrc_t rK = mk_rsrc(Kh, S * D * 2), rV = mk_rsrc(Vh, S * D * 2), rM = mk_rsrc((const GAS unsigned long long*)(a.ws + WS_MASK) + ((size_t)b * S + qw) * 32, 32 * 256);
    const unsigned moff = (unsigned)r32 * 256u;
    const int NT = q0 / KVBLK + 1;
    LAS unsigned char* V_lds = lds; LAS unsigned char* K_lds = lds + 2 * SHM_V;
    const int sr = tid >> 4, sc = (tid & 15) * 8, vst0 = v_st(sr, sc), vst1 = v_st(32 + sr, sc), kws = KSWZ(sr, sc * 2);
    const int vb0 = (int)(unsigned)(size_t)V_lds + v_rd_base(lane); const unsigned kvoff = (unsigned)(sr * D + sc) * 2u;
    bf16x8 st_v0, st_v1, st_k0, st_k1;
    LAS unsigned char* qp = lds + WS_OFF + 2048 + wid * 8192 + lane * 16;
#define VMW() asm volatile("s_waitcnt vmcnt(0)" ::: "memory")
#define BL128(r_, so_) __builtin_bit_cast(bf16x8, __builtin_amdgcn_raw_buffer_load_b128(r_, kvoff, (so_), 0))
#define SLOAD_H(k0) do { const int so_ = (k0) * 256; st_v0 = BL128(rV, so_); st_v1 = BL128(rV, so_ + 8192); st_k0 = BL128(rK, so_); st_k1 = BL128(rK, so_ + 8192); } while (0)
#define SWRITE_HK(bf) do { *(LAS bf16x8*)(K_lds + (bf) * SHM_K + kws) = st_k0; *(LAS bf16x8*)(K_lds + (bf) * SHM_K + kws + 32 * 256) = st_k1; } while (0)
#define SWRITE_HV(bf) do { *(LAS bf16x8*)(V_lds + (bf) * SHM_V + vst0) = st_v0; *(LAS bf16x8*)(V_lds + (bf) * SHM_V + vst1) = st_v1; } while (0)
#define SWRITE_H(bf) do { SWRITE_HV(bf); SWRITE_HK(bf); } while (0)
#define MLOAD(t) __builtin_bit_cast(unsigned long long, __builtin_amdgcn_raw_buffer_load_b64(rM, moff, (t) * 8, 16))
#define MSPLIT(mw, wl, wh) do { wl = (unsigned)(mw) >> (4 * hi); wh = (unsigned)((mw) >> 32) >> (4 * hi); } while (0)
    { bf16x8 qt[8];
#pragma unroll
      for (int d0 = 0; d0 < 8; ++d0) qt[d0] = *(const GAS bf16x8*)(Qw + (unsigned)(r32 * D + d0 * 16 + hi * 8));
#pragma unroll
      for (int d0 = 0; d0 < 8; ++d0) *(LAS bf16x8*)(qp + d0 * 1024) = qt[d0]; }
    SLOAD_H(0); unsigned long long mwA = MLOAD(0), mwB = 0ull; VMW(); SWRITE_H(0);
    if (NT > 1) { SLOAD_H(KVBLK); mwB = MLOAD(1); }
    __syncthreads();
    float l_reg = 0.f; f32x16 o[4] = {};
    f32x16 p0, p1; bf16x8 pa0, pa1, pa2, pa3; unsigned wl, wh;
    SBAR(); qkt<0>(p0, p1, K_lds, r32, hi, qp);
    MSPLIT(mwA, wl, wh); partialSM(p0, p1, wl, wh, sh2);
    if (NT > 1) { VMW(); SWRITE_H(1); }
    __syncthreads();
#define STEP(t, KB, VB) do { \
        finishSM(p0, p1, l_reg, pa0, pa1, pa2, pa3); SBAR(); \
        if ((t) + 1 < NT) { SLOAD_H(((t) + 1) * KVBLK); mwA = MLOAD((t) + 1); SBAR(); } \
        pv_tile<VB>(o, vb0, pa0, pa1, pa2, pa3); SBAR(); \
        qkt<KB>(p0, p1, K_lds, r32, hi, qp); \
        MSPLIT(mwB, wl, wh); partialSM(p0, p1, wl, wh, sh2); mwB = mwA; \
        __syncthreads(); \
        if ((t) + 1 < NT) { VMW(); SWRITE_H(VB); } \
        __syncthreads(); } while (0)
    int t = 1;
    for (; t + 1 < NT; t += 2) { STEP(t, 1, 0); STEP(t + 1, 0, 1); }
    if (t < NT) { STEP(t, 1, 0); }
    finishSM(p0, p1, l_reg, pa0, pa1, pa2, pa3); SBAR();
    if ((NT - 1) & 1) pv_tile<1>(o, vb0, pa0, pa1, pa2, pa3); else pv_tile<0>(o, vb0, pa0, pa1, pa2, pa3);
    { auto rr = __builtin_amdgcn_permlane32_swap(__float_as_uint(l_reg), __float_as_uint(l_reg), false, false); l_reg = __uint_as_float(rr[0]) + __uint_as_float(rr[1]); }
    { int te = threadIdx.x; asm volatile("" : "+v"(te));
      const int le = te & 63, r32e = le & 31, hie = le >> 5;
      LAS float* wse = (LAS float*)(lds + WS_OFF) + wid * 64;
      if (hie == 0) wse[r32e] = l_reg;
      asm volatile("s_waitcnt lgkmcnt(0)" ::: "memory");
      __syncthreads();
      LAS f16* stg = (LAS f16*)(lds + wid * 8192);
#pragma unroll
      for (int r = 0; r < 16; ++r) { const int orow = crow(r, hie); const float rl = __builtin_amdgcn_rcpf(wse[orow]);
#pragma unroll
          for (int d0 = 0; d0 < 4; ++d0) stg[orow * 128 + d0 * 32 + r32e] = (f16)(o[d0][r] * rl); }
      asm volatile("s_waitcnt lgkmcnt(0)" ::: "memory");
      const GAS f16* SZ = (const GAS f16*)(a.ws + WS_SZ) + ((size_t)b * S + qw) * 1024 + head * 128; GAS f16* MIX = (GAS f16*)(a.ws + WS_MIX) + ((size_t)b * S + qw) * 2048 + head * 128;
#pragma unroll
      for (int i = 0; i < 8; ++i) { const int c = le + 64 * i, row = c >> 4, ch = c & 15;
          const f16x8 ov = *(const LAS f16x8*)(stg + row * 128 + ch * 8); const f16x8 zv = *(const GAS f16x8*)(SZ + (unsigned)(row * 1024 + ch * 8));
          *(GAS f16x8*)(MIX + (unsigned)(row * 2048 + ch * 8)) = ov * zv; } }
    asm volatile("s_waitcnt lgkmcnt(0)" ::: "memory");
    __syncthreads();
#undef BL128
#undef VMW
#undef SLOAD_H
#undef SWRITE_HK
#undef SWRITE_HV
#undef SWRITE_H
#undef MLOAD
#undef MSPLIT
#undef STEP
}
#undef KSWZ
#undef SBAR
}

__device__ __forceinline__ void p3_sample_item(const Args& a, LAS unsigned char* lds, int item, int tid) {
    const int qi = item >> 1, kvh = item & 1, sb = qi / NST, tl = qi % NST; constexpr int L = PAST + NST, PER = 33;
    const int lane = tid & 63, wave = __builtin_amdgcn_readfirstlane(tid >> 6);
    const GAS float* ck = (const GAS float*)a.in[2]; const GAS float* cv = (const GAS float*)a.in[3]; const GAS int* ptab = (const GAS int*)a.in[6]; const GAS float* out_ro = (const GAS float*)a.out;
    LAS float* q = (LAS float*)lds; LAS float* w = q + 1024; LAS float* newsc = w + 16; LAS float* ctl = newsc + 4; LAS float* red = ctl + 16;
    LAS unsigned* hist = (LAS unsigned*)(red + 32); LAS float* cand = (LAS float*)(hist + 256); LAS unsigned* cnt = (LAS unsigned*)(cand + 64);
    LAS unsigned* rid = cnt + 32; LAS float* qa = (LAS float*)(rid + 512); LAS float* sc = qa + 512; LAS float* inv = sc + 4 * 512; LAS float* part = inv + 4;
    LAS int* nsel = (LAS int*)(ctl + 8); LAS int* ncand = (LAS int*)(ctl + 9);
    const GAS f16* QI = (const GAS f16*)(a.ws + WS_QI) + (size_t)(MP + qi) * 1024; const GAS float* QS = (const GAS float*)(a.ws + WS_QS) + (size_t)qi * 1024 + kvh * 512;
    for (int i = tid; i < 1024; i += 512) q[i] = (float)QI[i];
    qa[tid] = QS[tid];
    if (tid < 16) w[tid] = ((const GAS float*)(a.ws + WS_WI))[(size_t)(MP + qi) * 16 + tid];
    if (tid < 32) cnt[tid] = 0u;
    if (tid < 256) hist[tid] = 0u;
    if (tid == 0) { *nsel = 0; *ncand = 0; }
    const GAS float* ssc = (const GAS float*)(a.ws + WS_SSC) + (size_t)qi * PAST;
    float v[PER];
#pragma unroll
    for (int j = 0; j < PER - 1; ++j) v[j] = __builtin_bit_cast(float, __hip_atomic_load((const GAS unsigned*)ssc + (j * 512 + tid), __ATOMIC_RELAXED, __HIP_MEMORY_SCOPE_AGENT));
    __syncthreads();
    if (tid < NST) { const GAS float* kr = out_ro + O_KIS + (size_t)(sb * NST + tid) * 64; float s = 0.f;
#pragma unroll 1
        for (int h = 0; h < 16; ++h) { float dsum = 0.f;
#pragma unroll 8
            for (int d = 0; d < 64; ++d) dsum += q[h * 64 + d] * kr[d];
            s += w[h] * fmaxf(dsum, 0.f); }
        newsc[tid] = s; }
    __syncthreads();
    const float NINF = -__builtin_inff(), PINF = __builtin_inff();
    { const int s = (PER - 1) * 512 + tid; v[PER - 1] = (s < L && (s - PAST) <= tl) ? newsc[s - PAST] : NINF; }
    float mx = NINF, mn = PINF;
#pragma unroll
    for (int j = 0; j < PER; ++j) { mx = fmaxf(mx, v[j]); mn = fminf(mn, v[j] == NINF ? PINF : v[j]); }
#pragma unroll
    for (int o = 1; o < 64; o <<= 1) { mx = fmaxf(mx, __shfl_xor(mx, o)); mn = fminf(mn, __shfl_xor(mn, o)); }
    if (lane == 0) { red[wave] = mx; red[8 + wave] = mn; }
    __syncthreads();
#pragma unroll
    for (int i = 0; i < 8; ++i) { mx = fmaxf(mx, red[i]); mn = fminf(mn, red[8 + i]); }
    const float scale = 255.5f / (mx - mn);
    float tau = 0.f; bool have = false;
    if (mx > mn) {
#pragma unroll
        for (int j = 0; j < PER; ++j) if (v[j] != NINF) { int bn = (int)((v[j] - mn) * scale); bn = bn > 255 ? 255 : bn; __hip_atomic_fetch_add(hist + bn, 1u, __ATOMIC_RELAXED, __HIP_MEMORY_SCOPE_WORKGROUP); }
        __syncthreads();
        if (wave == 0) {
            const u32x4 h = *(const LAS u32x4*)(hist + 4 * lane);
            const unsigned sl = h[0] + h[1] + h[2] + h[3]; unsigned pre = sl;
#pragma unroll
            for (int o = 1; o < 64; o <<= 1) { const unsigned y = __shfl_up(pre, o); if (lane >= o) pre += y; }
            const unsigned tot = __builtin_amdgcn_readlane(pre, 63); const unsigned suf = tot - pre + sl;
            const unsigned long long bm = __ballot(suf >= TOPK);
            const int Ls = 63 - __builtin_clzll(bm);
            unsigned c = __builtin_amdgcn_readlane(suf, Ls) - __builtin_amdgcn_readlane(sl, Ls);
            const unsigned h3 = __builtin_amdgcn_readlane(h[3], Ls), h2 = __builtin_amdgcn_readlane(h[2], Ls), h1 = __builtin_amdgcn_readlane(h[1], Ls);
            int Bs;
            if (c + h3 >= TOPK) Bs = 4 * Ls + 3; else { c += h3; if (c + h2 >= TOPK) Bs = 4 * Ls + 2; else { c += h2; if (c + h1 >= TOPK) Bs = 4 * Ls + 1; else { c += h1; Bs = 4 * Ls; } } }
            if (lane == 0) { ((LAS int*)ctl)[0] = Bs; ((LAS int*)ctl)[1] = TOPK - (int)c; }
        }
        __syncthreads();
        const int Bs = ((LAS int*)ctl)[0], need = ((LAS int*)ctl)[1];
#pragma unroll
        for (int j = 0; j < PER; ++j) if (v[j] != NINF) { int bn = (int)((v[j] - mn) * scale); bn = bn > 255 ? 255 : bn;
            if (bn == Bs) { const int p = __hip_atomic_fetch_add(ncand, 1, __ATOMIC_RELAXED, __HIP_MEMORY_SCOPE_WORKGROUP); if (p < 64) cand[p] = v[j]; } }
        __syncthreads();
        const int base = *ncand;
        if (base <= 64) {
            if (wave == 0) { const float x = lane < base ? cand[lane] : NINF; int rank = 0;
                for (int m = 0; m < base; ++m) { const float y = __builtin_bit_cast(float, __builtin_amdgcn_readlane(__builtin_bit_cast(int, x), m)); rank += y > x ? 1 : 0; }
                float tc = (lane < base && rank <= need - 1) ? x : PINF;
#pragma unroll
                for (int o = 1; o < 64; o <<= 1) tc = fminf(tc, __shfl_xor(tc, o));
                if (lane == 0) ctl[2] = tc; }
            __syncthreads();
            tau = ctl[2]; have = true;
        }
    }
    if (!have) {
        unsigned tk = 0u;
        for (int bit = 31; bit >= 0; --bit) { const unsigned cd = tk | (1u << bit); int c = 0;
#pragma unroll
            for (int j = 0; j < PER; ++j) c += __builtin_popcountll(__ballot(v[j] != NINF && fkey(v[j]) >= cd));
            if (lane == 0) __hip_atomic_fetch_add(cnt + bit, (unsigned)c, __ATOMIC_RELAXED, __HIP_MEMORY_SCOPE_WORKGROUP);
            __syncthreads();
            if (cnt[bit] >= TOPK) tk = cd; }
        tau = __builtin_bit_cast(float, (tk & 0x80000000u) ? (tk ^ 0x80000000u) : ~tk);
    }
#pragma unroll
    for (int j = 0; j < PER; ++j) { if (v[j] >= tau) { const int s = j * 512 + tid; const int p = __hip_atomic_fetch_add(nsel, 1, __ATOMIC_RELAXED, __HIP_MEMORY_SCOPE_WORKGROUP);
        if (p < 512) rid[p] = s < PAST ? (unsigned)(ptab[sb * NPAGES + (s >> 7)] * PAGE + (s & (PAGE - 1))) : (0x80000000u | (unsigned)(s - PAST)); } }
    __syncthreads();
    const int n = *nsel < 512 ? *nsel : 512;
    const int half = lane >> 5, l32 = lane & 31;
    { f32x4 qv[4];
#pragma unroll
      for (int h = 0; h < 4; ++h) qv[h] = *(const LAS f32x4*)(qa + h * 128 + 4 * l32);
      for (int j0 = 2 * wave; j0 < n; j0 += 128) { f32x4 kv[8]; int jj[8];
#pragma unroll
          for (int u = 0; u < 8; ++u) { jj[u] = j0 + 16 * u + half; const unsigned r = rid[jj[u] < n ? jj[u] : 0];
              const GAS float* kr = (r & 0x80000000u) ? out_ro + O_KS + ((size_t)(sb * NST + (r & 3u)) * NKV + kvh) * HD : ck + ((size_t)r * NKV + kvh) * HD;
              kv[u] = *(const GAS f32x4*)(kr + 4 * l32); }
#pragma unroll
          for (int u = 0; u < 8; ++u) { float d[4];
#pragma unroll
              for (int h = 0; h < 4; ++h) d[h] = half_sum_dpp((kv[u][0] * qv[h][0] + kv[u][1] * qv[h][1]) + (kv[u][2] * qv[h][2] + kv[u][3] * qv[h][3]));
              if (jj[u] < n && l32 >= 16 && l32 < 20) { const int hq = l32 & 3; sc[hq * 512 + jj[u]] = (hq == 0 ? d[0] : hq == 1 ? d[1] : hq == 2 ? d[2] : d[3]) * 0.08838834764831845f; } } } }
    __syncthreads();
    if (wave < 4) { LAS float* row = sc + wave * 512; float m2 = -1e30f;
      for (int j = lane; j < n; j += 64) m2 = fmaxf(m2, row[j]);
      m2 = wave_max_dpp(m2);
      float sm = 0.f;
      for (int j = lane; j < n; j += 64) { const float e = __expf(row[j] - m2); row[j] = e; sm += e; }
      sm = wave_sum_dpp(sm); if (lane == 0) inv[wave] = 1.f / sm; }
    __syncthreads();
    { f32x4 acc[4] = {};
      for (int j0 = 2 * wave; j0 < n; j0 += 128) { f32x4 vv[8]; int jj[8];
#pragma unroll
          for (int u = 0; u < 8; ++u) { jj[u] = j0 + 16 * u + half; const unsigned r = rid[jj[u] < n ? jj[u] : 0];
              const GAS float* vr = (r & 0x80000000u) ? out_ro + O_VS + ((size_t)(sb * NST + (r & 3u)) * NKV + kvh) * HD : cv + ((size_t)r * NKV + kvh) * HD;
              vv[u] = *(const GAS f32x4*)(vr + 4 * l32); }
#pragma unroll
          for (int u = 0; u < 8; ++u)
#pragma unroll
              for (int h = 0; h < 4; ++h) { const float p = jj[u] < n ? sc[h * 512 + jj[u]] : 0.f; acc[h] += vv[u] * p; } }
#pragma unroll
      for (int h = 0; h < 4; ++h) {
#pragma unroll
          for (int e = 0; e < 4; ++e) acc[h][e] += __shfl_xor(acc[h][e], 32);
          if (half == 0) *(LAS f32x4*)(part + (wave * 4 + h) * 128 + 4 * l32) = acc[h]; } }
    __syncthreads();
    { const GAS f16* SZ = (const GAS f16*)(a.ws + WS_SZ) + (size_t)(MP + qi) * 1024 + kvh * 512; GAS f16* MIX = (GAS f16*)(a.ws + WS_MIX) + (size_t)(MP + qi) * 2048 + kvh * 512;
      const int h = tid >> 7, d = tid & 127; float o = 0.f;
#pragma unroll
      for (int p = 0; p < 8; ++p) o += part[(p * 4 + h) * 128 + d];
      MIX[tid] = (f16)(o * inv[h] * (float)SZ[tid]); }
    __syncthreads();
}

__device__ __forceinline__ void p3_phase(const Args& a, LAS unsigned char* lds, int vcu, int G, int tid) {
    float gm = 0.f, km = 0.f;
    for (int i = 0; i < HD; ++i) { gm = fmaxf(gm, fabsf(a.in[9][i])); km = fmaxf(km, fabsf(a.in[10][i])); }
    const float sh2 = fmaxf(0.f, 11.313708498984761f * gm * km - 20.f) * 1.4426950408889634f;
    for (int rp = 0; rp < P3_REP_S; ++rp)
    for (int sidx = G - 1 - vcu; sidx < 2 * MS; sidx += G) { wait_ge_wt((unsigned*)a.ws + RDY_WORD0 + 64 * 32, (unsigned)G); p3_sample_item(a, lds, sidx, tid); }
    HOOK_8
    HOOK_9
    for (int rp = 0; rp < P3_REP_A; ++rp)
    for (int k = vcu; k < 256; k += G) { const int i = 31 - (k >> 3), bk = k & 7;
        if (i >= 4) wait_ge_wt((unsigned*)a.ws + RDY_WORD0 + 64 * (40 + (bk >> 1) * 32 + i), 4u); else wait_ge_wt((unsigned*)a.ws + RDY_WORD0 + 64 * 33, (unsigned)G);
        att::attn_block(a, lds, bk >> 1, bk & 1, 64 * i, sh2); }
    { unsigned* qctr = (unsigned*)a.ws + CMQ_WORD; LAS int* cq = (LAS int*)(lds + MISC_OFF + 168); const int wave = tid >> 6, lane = tid & 63;
      unsigned nxt = 0u; if (tid == 0) nxt = xb_add(qctr, 1u);
      for (int it = 0;; ++it) {
          if (tid == 0) { cq[it & 1] = (int)nxt; nxt = xb_add(qctr, 1u); }
          __syncthreads();
          const int c = cq[it & 1];
          if (c >= MT / 16) break;
          convmix_task(a, 4 * c + (wave >> 1), wave & 1, lane); } }
}

__global__ void __launch_bounds__(NWAVES * 64, 2) mk_fwd(Args a) {
    extern __shared__ __attribute__((aligned(16))) unsigned char lds_raw[];
    LAS unsigned char* lds = (LAS unsigned char*)lds_raw;
    const int tid = threadIdx.x, lane = tid & 63, wave = __builtin_amdgcn_readfirstlane(tid >> 6);
    const int G = gridDim.x; const int bx = blockIdx.x; const int vcu = (G % 8 == 0) ? (bx % 8) * (G / 8) + bx / 8 : bx;
    volatile LAS unsigned* MISC = (volatile LAS unsigned*)(lds + MISC_OFF);
    if (tid < 64) MISC[tid] = 0u;
    __syncthreads();
    XcdBarrier bar = xcd_barrier_post((unsigned*)a.ws, MISC + 8);
    { int t_ = threadIdx.x; asm volatile("" : "+v"(t_)); const int lane = t_ & 63, wave = __builtin_amdgcn_readfirstlane(t_ >> 6); HOOK_0 p0_prologue(a, lds, vcu, G, wave, lane); HOOK_1 }
    xcd_barrier(bar);
    { pg8::Gemm g{(const f16*)(a.ws + WS_XNH), (const f16*)(a.ws + WS_WINT), DM};
      pg8::StaticOrder S; S.init(MPAD / 256, NPAD / 256, G, bx);
      EpiIn E{a.out, a.ws, a.in[9], a.in[10], a.in[11], (LAS float*)(lds + SCR_OFF)};
      HOOK_2 pg8::gemm_phase<EpiIn, pg8::StaticOrder>(lds, g, S, E); HOOK_3 }
    { int t_ = threadIdx.x; asm volatile("" : "+v"(t_)); const int lane = t_ & 63, wave = __builtin_amdgcn_readfirstlane(t_ >> 6);
      xcd_barrier(bar);
      HOOK_4 p2_phase(a, lds, vcu, G, wave, lane); HOOK_7 }
    { int t_ = threadIdx.x; asm volatile("" : "+v"(t_)); p3_phase(a, lds, vcu, G, t_); HOOK_10 }
    { pg8::Gemm g{(const f16*)(a.ws + WS_MIX), (const f16*)(a.ws + WS_WOUTT), DM};
      pg8::StaticOrder S; S.init(MP / 256, DM / 256, G, bx);
      EpiOut E{a.out, a.in[0]};
      f32x4 accp[2][2][4][2]; { pg8::Unit u0; int t0_ = threadIdx.x; asm volatile("" : "+v"(t0_)); const int w0_ = __builtin_amdgcn_readfirstlane(t0_ >> 6), l0_ = t0_ & 63;
          if (S.next(0, u0)) E.init(accp, u0, w0_ >> 2, w0_ & 3, l0_ & 15, l0_ >> 4); }
      xcd_barrier(bar);
      HOOK_11 pg8::gemm_phase<EpiOut, pg8::StaticOrder, true>(lds, g, S, E, accp); HOOK_12
      int t_ = threadIdx.x; asm volatile("" : "+v"(t_)); p4_sample(a, lds, bx, G, t_); HOOK_13 }
}

#ifndef PROG
#define PROG 0x11111u
#endif
extern "C" void kernel_launch(void* const* d_in, const int* in_sizes, int n_in, void* d_out, int out_size, void* d_ws, size_t ws_size, hipStream_t stream) {
    static int grid = 0;
    if (grid == 0) {
        if (ws_size < WS_NEED2 || out_size != (int)O_END || n_in != 14) { fprintf(stderr, "kernel_launch: ws %zu (need %zu) out %d (want %zu) n_in %d\n", ws_size, (size_t)WS_NEED2, out_size, (size_t)O_END, n_in); grid = -1; return; }
        int dev = 0, cus = 0; hipGetDevice(&dev); hipDeviceGetAttribute(&cus, hipDeviceAttributeMultiprocessorCount, dev);
        if (hipFuncSetAttribute((const void*)mk_fwd, hipFuncAttributeMaxDynamicSharedMemorySize, LDS_BYTES) != hipSuccess) { fprintf(stderr, "kernel_launch: hipFuncSetAttribute failed\n"); grid = -1; return; }
        int per_cu = 0; hipOccupancyMaxActiveBlocksPerMultiprocessor(&per_cu, (const void*)mk_fwd, NWAVES * 64, LDS_BYTES); (void)hipGetLastError();
        if (per_cu < 1) fprintf(stderr, "kernel_launch: occupancy query says %d blocks per CU\n", per_cu);
        grid = cus > 0 ? cus : 256;
    }
    if (grid < 0) return;
    float* out = (float*)d_out; unsigned char* ws = (unsigned char*)d_ws;
    Args a{};
    for (int i = 0; i < 14; ++i) a.in[i] = (const float*)d_in[i];
    a.out = out; a.ws = ws;
    if (hipMemsetAsync(ws, 0, 65536, stream) != hipSuccess) { fprintf(stderr, "kernel_launch: memset of the control words failed\n"); return; }
    a.ph_lo = (int)PROG; a.ph_hi = 0; hipLaunchKernelGGL(mk_fwd, dim3(grid), dim3(NWAVES * 64), LDS_BYTES, stream, a);
}
```

```cpp
#include <hip/hip_runtime.h>
#include <cstdio>
#include <cstdint>
#include <cmath>

typedef _Float16 f16;
typedef unsigned short bf16_t;

constexpr int DM = 2048, NB = 4, S = 2048, NSB = 8, NST = 4, PAST = 16384, PAGE = 128, NPAGES = PAST / PAGE;
constexpr int MP = NB * S;
constexpr int MS = NSB * NST;
constexpr int MT = MP + MS;
constexpr int DIN = 7760;
constexpr int OQ = 0, OKK = 1024, OV = 1280, OZ = 1536, OQI = 2560, OKI = 3584, OWI = 3648, OH = 3664, OBB = 4688, OC = 5712, OZC = 6736;
constexpr int NH = 8, NKV = 2, HD = 128, NIH = 16, ID = 64, TOPK = 256, DC = 1024;
constexpr float EPS = 1e-6f;
constexpr size_t O_YP = 0, O_YS = 16777216, O_KP = 16842752, O_VP = 18939904, O_KIP = 21037056, O_CVP = 21561344,
                 O_KS = 21569536, O_VS = 21577728, O_KIS = 21585920, O_CVS = 21587968, O_END = 21604352;
constexpr size_t MiB = 1u << 20;
constexpr size_t WS_ROPE = 1 * MiB;
constexpr size_t WS_ROPE_I = WS_ROPE + 2052 * 32 * 4;
constexpr size_t WS_QB = 2 * MiB;
constexpr size_t WS_KB = 18 * MiB;
constexpr size_t WS_VB = 22 * MiB;
constexpr size_t WS_SZ = 26 * MiB;
constexpr size_t WS_QI = 43 * MiB;
constexpr size_t WS_KI = 60 * MiB;
constexpr size_t WS_WI = 61 * MiB;
constexpr size_t WS_U = 62 * MiB;
constexpr size_t WS_G = 79 * MiB;
constexpr size_t WS_MIX = 96 * MiB;
constexpr size_t WS_MASK = 130 * MiB;
constexpr size_t WS_SSC = 132 * MiB;
constexpr size_t WS_QS = 134 * MiB;
constexpr size_t WS_XN = 136 * MiB;
constexpr size_t WS_P = 202 * MiB;
constexpr size_t WS_NEED = 448 * MiB;

__device__ __forceinline__ bf16_t f2bf(float f) { unsigned u = __builtin_bit_cast(unsigned, f); return (bf16_t)((u + 0x7fffu + ((u >> 16) & 1u)) >> 16); }
__device__ __forceinline__ float bf2f(bf16_t h) { return __builtin_bit_cast(float, (unsigned)h << 16); }
__device__ __forceinline__ float silu(float z) { return z * __builtin_amdgcn_rcpf(1.f + __builtin_amdgcn_exp2f(-1.4426950408889634f * z)); }
__device__ __forceinline__ unsigned fkey(float f) { unsigned u = __builtin_bit_cast(unsigned, f); return (u & 0x80000000u) ? ~u : (u | 0x80000000u); }

#define HOOK_0
#define HOOK_1
#define HOOK_2
#define HOOK_3
#define HOOK_4
#define HOOK_5
#define HOOK_6
#define HOOK_7
#define HOOK_8
#define HOOK_9
#define HOOK_10
#define HOOK_11
#define HOOK_12
#define HOOK_13
#define HOOK_14
#define HOOK_15
#define HOOK_16
#define P0_REP_T 1
#define P0_REP_X 1
#define P3_REP_S 1
#define P3_REP_A 1
#define P2_KT_REP 1
#define P2_SEL_REP 1
#define P2_REP_A 1
#define P2_REP_B 1
#define P2_REP_C 1
#define LAS __attribute__((address_space(3)))
#define GAS __attribute__((address_space(1)))
typedef _Float16 f16x8 __attribute__((ext_vector_type(8)));
typedef _Float16 f16x4 __attribute__((ext_vector_type(4)));
typedef _Float16 f16x2 __attribute__((ext_vector_type(2)));
typedef float f32x4 __attribute__((ext_vector_type(4)));
typedef float f32x2 __attribute__((ext_vector_type(2)));
typedef unsigned u32x4 __attribute__((ext_vector_type(4)));
typedef unsigned u32x2 __attribute__((ext_vector_type(2)));
typedef __bf16 bf16x2_t __attribute__((ext_vector_type(2)));
__device__ __forceinline__ void st16_wt(GAS void* p, u32x4 v) { asm volatile("global_store_dwordx4 %0, %1, off sc0 sc1\n\ts_nop 1" :: "v"(p), "v"(v) : "memory"); }
namespace pg8 {
constexpr int BM = 256, BK = 64, HALF = 128, HTB = HALF * BK * 2, STAGE_BYTES = 8 * HTB, NXCD = 8, WGM = 8;
__host__ __device__ __forceinline__ int lds_byte(int r, int c) { const int st = (r >> 4) * 2 + (c >> 5), rr = r & 15, cc = c & 31, ob = rr * 64 + cc * 2; return st * 1024 + (ob ^ (((ob >> 9) & 1) << 5)); }
__host__ __device__ __forceinline__ void stage_rc(int b, int& R, int& C) { const int st = b / 1024, sb = b % 1024, swz = sb ^ (((sb >> 9) & 1) << 5); R = (st >> 1) * 16 + swz / 64; C = (st & 1) * 32 + (swz % 64) / 2; }
struct Unit { int pm, pn; };
struct Gemm { const f16* A; const f16* Bt; int K; };
struct StaticOrder {
    int nM, nN, nwg, G, c, mix;
    __device__ __forceinline__ void init(int nM_, int nN_, int G_, int c_, int mix_ = 0) { nM = nM_; nN = nN_; nwg = nM * nN; G = G_; c = c_; mix = mix_; }
    __device__ __forceinline__ bool next(int i, Unit& u) const {
        const long L = (long)i * G + c; if (L >= nwg) return false;
        int wgid = (int)L;
        if (mix == 2) {
            const int nidx = nM * 5;
            if (wgid < nidx) { u.pm = wgid % nM; u.pn = 10 + wgid / nM; return true; }
            wgid -= nidx; const int nN2 = nN - 5, nwg2 = nM * nN2;
            { const int q = nwg2 / NXCD, r = nwg2 % NXCD, xcd = wgid % NXCD, off = wgid / NXCD; wgid = (xcd < r ? xcd * (q + 1) : r * (q + 1) + (xcd - r) * q) + off; }
            const int nig = WGM * nN2, gid = wgid / nig, fm = gid * WGM, gsz = (nM - fm) < WGM ? (nM - fm) : WGM;
            u.pm = fm + ((wgid % nig) % gsz); const int p2 = (wgid % nig) / gsz; u.pn = p2 < 10 ? p2 : p2 + 5; return true;
        }
        { const int q = nwg / NXCD, r = nwg % NXCD, xcd = wgid % NXCD, off = wgid / NXCD; wgid = (xcd < r ? xcd * (q + 1) : r * (q + 1) + (xcd - r) * q) + off; }
        const int nig = WGM * nN, gid = wgid / nig, fm = gid * WGM, gsz = (nM - fm) < WGM ? (nM - fm) : WGM;
        u.pm = fm + ((wgid % nig) % gsz); u.pn = (wgid % nig) / gsz; if (mix) u.pn = (u.pn & 1) ? (u.pn >> 1) : 15 + (u.pn >> 1); return true;
    }
};
struct OneUnit { int pm, pn; __device__ __forceinline__ bool next(int i, Unit& u) const { if (i != 0) return false; u.pm = pm; u.pn = pn; return true; } };
template <class Epi, class Sched, bool PRE = false>
__device__ __forceinline__ void gemm_phase(LAS unsigned char* lds, const Gemm g, const Sched& S, const Epi& E, const f32x4 (*pre)[2][4][2] = nullptr) {
    int tid_ = threadIdx.x; asm volatile("" : "+v"(tid_));
    const int tid = tid_, wid = __builtin_amdgcn_readfirstlane(tid >> 6), lane = tid & 63, wr = wid >> 2, wc = wid & 3, fr = lane & 15, fq = lane >> 4;
    const int K = g.K, nt = K / BK;
    unsigned voffA[2];
#pragma unroll
    for (int i = 0; i < 2; ++i) { int R, C; stage_rc(tid * 16 + i * 8192, R, C); voffA[i] = (unsigned)(R * K + C) * 2u; }
    const size_t kstep = (size_t)(BK * 2);
    const size_t hstep = (size_t)HALF * K * 2;
    const size_t tstep = 2 * hstep;
    const unsigned ldsw = (unsigned)wid * 1024u;
    const int aoff = lds_byte(wr * 64 + fr, fq * 8), boff = lds_byte(wc * 32 + fr, fq * 8);
#define PG8_SA(b, h) (((b) * 2 + (h)) * HTB)
#define PG8_SB(b, h) ((4 + (b) * 2 + (h)) * HTB)
#define PG8_STAGE(bufoff, gbase) do { _Pragma("unroll") for (int _i = 0; _i < 2; ++_i) \
        __builtin_amdgcn_global_load_lds((const unsigned*)((const char*)(gbase) + voffA[_i]), (LAS unsigned*)(lds + (bufoff) + ldsw + _i * 8192), 16, 0, 0); } while (0)
#define PG8_LDA(dst, b, h) do { _Pragma("unroll") for (int m = 0; m < 4; ++m) _Pragma("unroll") for (int k = 0; k < 2; ++k) dst[m][k] = *(const LAS f16x8*)(lds + PG8_SA(b, h) + aoff + m * 2048 + k * 1024); } while (0)
#define PG8_LDB(dst, b, h) do { _Pragma("unroll") for (int n = 0; n < 2; ++n) _Pragma("unroll") for (int k = 0; k < 2; ++k) dst[n][k] = *(const LAS f16x8*)(lds + PG8_SB(b, h) + boff + n * 2048 + k * 1024); } while (0)
#define PG8_MMA(ai, bj, At, Bt) do { __builtin_amdgcn_s_setprio(1); _Pragma("unroll") for (int m = 0; m < 4; ++m) _Pragma("unroll") for (int n = 0; n < 2; ++n) _Pragma("unroll") for (int k = 0; k < 2; ++k) \
        acc[ai][bj][m][n] = __builtin_amdgcn_mfma_f32_16x16x32_f16(Bt[n][k], At[m][k], acc[ai][bj][m][n], 0, 0, 0); __builtin_amdgcn_s_setprio(0); } while (0)
#define PG8_WAIT_V(n) asm volatile("s_waitcnt vmcnt(" #n ")" ::: "memory")
#define PG8_WAIT_L(n) asm volatile("s_waitcnt lgkmcnt(" #n ")" ::: "memory")
#define PG8_BAR __builtin_amdgcn_s_barrier()
#define PG8_SCHED __builtin_amdgcn_sched_barrier(0)
    Unit cur, nxt; int ui = 0;
    if (!S.next(0, cur)) return;
    f32x4 acc[2][2][4][2];
    if constexpr (PRE) {
#pragma unroll
        for (int a = 0; a < 2; ++a)
#pragma unroll
            for (int b = 0; b < 2; ++b)
#pragma unroll
                for (int m = 0; m < 4; ++m)
#pragma unroll
                    for (int n = 0; n < 2; ++n) acc[a][b][m][n] = pre[a][b][m][n];
    } else E.init(acc, cur, wr, wc, fr, fq);
    f16x8 At[4][2], B0[2][2], B1[2][2];
    const char* cA = (const char*)g.A + (size_t)cur.pm * tstep; const char* cB = (const char*)g.Bt + (size_t)cur.pn * tstep;
    PG8_STAGE(PG8_SB(0, 0), cB); PG8_STAGE(PG8_SB(0, 1), cB + hstep); PG8_STAGE(PG8_SA(0, 0), cA); PG8_STAGE(PG8_SA(0, 1), cA + hstep);
    if (wr == 1) PG8_BAR;
    PG8_WAIT_V(2); PG8_BAR;
    PG8_STAGE(PG8_SB(1, 0), cB + kstep); PG8_STAGE(PG8_SA(1, 0), cA + kstep); PG8_STAGE(PG8_SB(1, 1), cB + hstep + kstep);
    PG8_WAIT_V(6); PG8_BAR;
    for (;;) {
        const bool has_next = S.next(ui + 1, nxt);
        const char* nA = has_next ? (const char*)g.A + (size_t)nxt.pm * tstep : cA; const char* nB = has_next ? (const char*)g.Bt + (size_t)nxt.pn * tstep : cB;
        for (int t = 0; t < nt; t += 2) {
            const bool last = (t == nt - 2);
            const char* a1 = cA + (size_t)(t + 1) * kstep;
            const char* a2 = last ? nA : cA + (size_t)(t + 2) * kstep; const char* b2 = last ? nB : cB + (size_t)(t + 2) * kstep;
            const char* a3 = a2 + kstep; const char* b3 = b2 + kstep;
            PG8_LDB(B0, 0, 0); PG8_LDB(B1, 0, 1); PG8_SCHED; PG8_LDA(At, 0, 0); PG8_STAGE(PG8_SA(1, 1), a1 + hstep);
            PG8_WAIT_V(8); PG8_WAIT_L(0); PG8_BAR; PG8_MMA(0, 0, At, B0); PG8_MMA(0, 1, At, B1); PG8_BAR; PG8_SCHED;
            PG8_LDA(At, 0, 1); PG8_STAGE(PG8_SB(0, 0), b2); PG8_STAGE(PG8_SB(0, 1), b2 + hstep); PG8_STAGE(PG8_SA(0, 0), a2);
            PG8_WAIT_V(8); PG8_WAIT_L(0); PG8_BAR; PG8_MMA(1, 0, At, B0); PG8_MMA(1, 1, At, B1); PG8_BAR; PG8_SCHED;
            PG8_LDB(B0, 1, 0); PG8_LDB(B1, 1, 1); PG8_SCHED; PG8_LDA(At, 1, 0); PG8_STAGE(PG8_SA(0, 1), a2 + hstep);
            PG8_WAIT_V(8); PG8_WAIT_L(0); PG8_BAR; PG8_MMA(0, 0, At, B0); PG8_MMA(0, 1, At, B1); PG8_BAR; PG8_SCHED;
            PG8_LDA(At, 1, 1); PG8_STAGE(PG8_SB(1, 0), b3); PG8_STAGE(PG8_SB(1, 1), b3 + hstep); PG8_STAGE(PG8_SA(1, 0), a3);
            PG8_WAIT_V(8); PG8_WAIT_L(0); PG8_BAR; PG8_MMA(1, 0, At, B0); PG8_MMA(1, 1, At, B1); PG8_BAR; PG8_SCHED;
        }
        const bool al = E.aligned(cur);
        if (al && wr == 0) PG8_BAR;
        E(acc, cur, wr, wc, fr, fq);
        E.done(cur, ui);
        if (!has_next) { if (!al && wr == 0) PG8_BAR; break; }
        cur = nxt; cA = nA; cB = nB; ++ui;
        E.init(acc, cur, wr, wc, fr, fq);
        if (al && wr == 1) PG8_BAR;
    }
    PG8_WAIT_V(0);
    PG8_BAR;
#undef PG8_SA
#undef PG8_SB
#undef PG8_STAGE
#undef PG8_LDA
#undef PG8_LDB
#undef PG8_MMA
#undef PG8_WAIT_V
#undef PG8_WAIT_L
#undef PG8_BAR
#undef PG8_SCHED
}
}
#ifndef P0_REP_T
#define P0_REP_T 1
#define P0_REP_X 1
#endif
constexpr int NWAVES = 8;
constexpr int MPAD = 8448, NPAD = 7936;
constexpr size_t WS_XNH = 450 * MiB;
constexpr size_t WS_WINT = 484 * MiB;
constexpr size_t WS_WOUTT = 516 * MiB;
constexpr size_t WS_PART = 524 * MiB;
constexpr size_t PART_STRIDE = 32768 + 256;
constexpr size_t WS_NEED2 = 536 * MiB;
constexpr int RING_BYTES = 131072, SCR_OFF = RING_BYTES, SCR_BYTES = 8192, MISC_OFF = 145408, LDS_BYTES = 147456;
constexpr int RDYA_WORD = 4096 + 64 * 35, RDYB_WORD = 4096 + 64 * 36, TICKET_WORD = 4096 + 64 * 37;
#define STAT_WORD 16000
#define SPAN_T0() (*(LAS unsigned*)(size_t)(MISC_OFF + 164))
#define SPAN_BEGIN() do { __syncthreads(); if (threadIdx.x == 0) SPAN_T0() = (unsigned)__builtin_amdgcn_s_memrealtime(); } while (0)
#ifdef SPAN_WAITACC
#define SPAN_VAL() (*(LAS unsigned*)(size_t)(MISC_OFF + 160))
#else
#define SPAN_VAL() ((unsigned)__builtin_amdgcn_s_memrealtime() - SPAN_T0())
#endif
#if defined(SPAN_MODE_MAX)
#define SPAN_ACC(p_, d_) (void)__hip_atomic_fetch_max(p_, d_, __ATOMIC_RELAXED, __HIP_MEMORY_SCOPE_AGENT)
#define SPAN_DIV 1u
#elif defined(SPAN_MODE_AVG)
#define SPAN_ACC(p_, d_) (void)__hip_atomic_fetch_add(p_, d_, __ATOMIC_RELAXED, __HIP_MEMORY_SCOPE_AGENT)
#define SPAN_DIV (unsigned)gridDim.x
#else
#define SPAN_ACC(p_, d_) (void)0
#define SPAN_DIV 1u
#endif
#ifndef SPAN_CU_LO
#define SPAN_CU_LO 0
#define SPAN_CU_HI 100000
#endif
#define SPAN_END() do { __syncthreads(); if (threadIdx.x == 0 && vcu >= SPAN_CU_LO && vcu < SPAN_CU_HI) { const unsigned d_ = SPAN_VAL(); unsigned* sw_ = (unsigned*)a.ws + STAT_WORD; SPAN_ACC(sw_, d_); } } while (0)
#define SPAN_SPIN() do { if (threadIdx.x == 0) { const unsigned d_ = __hip_atomic_load((unsigned*)a.ws + STAT_WORD, __ATOMIC_RELAXED, __HIP_MEMORY_SCOPE_AGENT) / SPAN_DIV; \
        const unsigned long long s_ = __builtin_amdgcn_s_memrealtime(); while ((unsigned)(__builtin_amdgcn_s_memrealtime() - s_) < d_) __builtin_amdgcn_s_sleep(4); } __syncthreads(); } while (0)
#define SPAN_SELF() do { __syncthreads(); if (threadIdx.x == 0) { const unsigned d_ = SPAN_VAL(); \
        const unsigned long long s_ = __builtin_amdgcn_s_memrealtime(); while ((unsigned)(__builtin_amdgcn_s_memrealtime() - s_) < d_) __builtin_amdgcn_s_sleep(4); } __syncthreads(); } while (0)

__device__ __forceinline__ unsigned pk_bf16(float lo, float hi) { f32x2 v = {lo, hi}; bf16x2_t b = __builtin_convertvector(v, bf16x2_t); return __builtin_bit_cast(unsigned, b); }
__device__ __forceinline__ unsigned pk_f16(float lo, float hi) { f32x2 v = {lo, hi}; f16x2 b = __builtin_convertvector(v, f16x2); return __builtin_bit_cast(unsigned, b); }

struct Args { const float* in[14]; float* out; unsigned char* ws; int ph_lo, ph_hi; };

__device__ __forceinline__ int win_src(int np) {
    const int pn = np >> 8, c = np & 255;
    if (pn < 15) { const int rho = c & 31, nn = rho >> 4, ii = rho & 15; const int L = (np & ~31) | (8 * (ii >> 2) + 4 * nn + (ii & 3));
        if (pn < 14) return L;
        return (L & 255) < 80 ? L : -1; }
    const int T = pn - 15, bj = c >> 7, wc = (c >> 5) & 3, n = (c >> 4) & 1, fqi = c & 15;
    const int base = bj == 0 ? (n == 0 ? OH : OBB) : (n == 0 ? OC : OZC);
    return base + 64 * T + 16 * wc + fqi;
}
template <bool MAP>
__device__ __forceinline__ void p0_t_load(const float* W, int N, int item, int nblk, int lane, f32x4 (&va)[4], f32x4 (&vb)[4]) {
    const int kb = item / nblk, nb = item % nblk, k0 = 64 * kb, n0 = 32 * nb;
    const int q = lane & 7, kr = lane >> 3;
    const int src = MAP ? win_src(n0 + 4 * q) : n0 + 4 * q;
    const GAS float* wp = (const GAS float*)W + (size_t)(k0 + 2 * kr) * N + (src >= 0 ? src : 0);
#pragma unroll
    for (int p = 0; p < 4; ++p) { va[p] = *(const GAS f32x4*)(wp + (size_t)(16 * p) * N); vb[p] = *(const GAS f32x4*)(wp + (size_t)(16 * p + 1) * N); }
}
template <bool MAP>
__device__ __forceinline__ void p0_t_finish(f16* WT, LAS unsigned char* scr, int item, int nblk, int lane, f32x4 (&va)[4], f32x4 (&vb)[4]) {
    const int kb = item / nblk, nb = item % nblk, k0 = 64 * kb, n0 = 32 * nb;
    const int q = lane & 7, kr = lane >> 3;
    const int src = MAP ? win_src(n0 + 4 * q) : n0 + 4 * q;
#pragma unroll
    for (int p = 0; p < 4; ++p) { if (src < 0) { va[p] = (f32x4){0.f, 0.f, 0.f, 0.f}; vb[p] = va[p]; }
#pragma unroll
        for (int e = 0; e < 4; ++e) *(LAS unsigned*)(scr + (4 * q + e) * 144 + 2 * (16 * p + 2 * kr)) = pk_f16(va[p][e], vb[p][e]); }
    asm volatile("s_waitcnt lgkmcnt(0)" ::: "memory");
    const int ch = lane & 7;
#pragma unroll
    for (int j = 0; j < 4; ++j) { const int n = (lane >> 3) + 8 * j;
        *(GAS u32x4*)(WT + (size_t)(n0 + n) * 2048 + k0 + 8 * ch) = *(const LAS u32x4*)(scr + n * 144 + ch * 16); }
    asm volatile("s_waitcnt lgkmcnt(0)" ::: "memory");
}
template <bool MAP>
__device__ __forceinline__ void p0_transpose_all(const float* W, int N, f16* WT, LAS unsigned char* scr, int nitems, int nblk, int gw, int NGW, int lane) {
    f32x4 a0[4], b0[4], a1[4], b1[4]; const int last = nitems - 1;
    int it = gw; if (it >= nitems) return;
    p0_t_load<MAP>(W, N, it, nblk, lane, a0, b0);
    for (; it < nitems; it += 2 * NGW) {
        { const int nx = it + NGW; p0_t_load<MAP>(W, N, nx < last ? nx : last, nblk, lane, a1, b1); }
        p0_t_finish<MAP>(WT, scr, it, nblk, lane, a0, b0);
        { const int nx = it + 2 * NGW; p0_t_load<MAP>(W, N, nx < last ? nx : last, nblk, lane, a0, b0); }
        if (it + NGW < nitems) p0_t_finish<MAP>(WT, scr, it + NGW, nblk, lane, a1, b1);
    }
}
template <int CTRL, int RM, int BM> __device__ __forceinline__ float dppf(float old, float src) { return __builtin_bit_cast(float, __builtin_amdgcn_update_dpp(__builtin_bit_cast(int, old), __builtin_bit_cast(int, src), CTRL, RM, BM, false)); }
template <int CTRL, int RM, int BM> __device__ __forceinline__ unsigned dppu(unsigned old, unsigned src) { return (unsigned)__builtin_amdgcn_update_dpp((int)old, (int)src, CTRL, RM, BM, false); }
__device__ __forceinline__ float wave_max_dpp(float v) {
    v = fmaxf(v, dppf<0xB1, 0xF, 0xF>(v, v)); v = fmaxf(v, dppf<0x4E, 0xF, 0xF>(v, v)); v = fmaxf(v, dppf<0x141, 0xF, 0xF>(v, v)); v = fmaxf(v, dppf<0x140, 0xF, 0xF>(v, v));
    v = fmaxf(v, dppf<0x142, 0xA, 0xF>(v, v)); v = fmaxf(v, dppf<0x143, 0xC, 0xF>(v, v));
    return __builtin_bit_cast(float, __builtin_amdgcn_readlane(__builtin_bit_cast(int, v), 63));
}
__device__ __forceinline__ float wave_sum_dpp(float v) {
    v += dppf<0xB1, 0xF, 0xF>(0.f, v); v += dppf<0x4E, 0xF, 0xF>(0.f, v); v += dppf<0x141, 0xF, 0xF>(0.f, v); v += dppf<0x140, 0xF, 0xF>(0.f, v);
    v += dppf<0x142, 0xA, 0xF>(0.f, v); v += dppf<0x143, 0xC, 0xF>(0.f, v);
    return __builtin_bit_cast(float, __builtin_amdgcn_readlane(__builtin_bit_cast(int, v), 63));
}
__device__ __forceinline__ float half_sum_dpp(float v) {
    v += dppf<0xB1, 0xF, 0xF>(0.f, v); v += dppf<0x4E, 0xF, 0xF>(0.f, v); v += dppf<0x141, 0xF, 0xF>(0.f, v); v += dppf<0x140, 0xF, 0xF>(0.f, v);
    v += dppf<0x142, 0xA, 0xF>(0.f, v);
    return v;
}
__device__ __forceinline__ unsigned wave_scan_dpp(unsigned x) {
    x += dppu<0x111, 0xF, 0xF>(0u, x); x += dppu<0x112, 0xF, 0xF>(0u, x); x += dppu<0x114, 0xF, 0xF>(0u, x); x += dppu<0x118, 0xF, 0xF>(0u, x);
    x += dppu<0x142, 0xA, 0xF>(0u, x); x += dppu<0x143, 0xC, 0xF>(0u, x);
    return x;
}
__device__ __forceinline__ float wave_sum(float v) {
#pragma unroll
    for (int o = 1; o < 64; o <<= 1) v += __shfl_xor(v, o);
    return v;
}
__device__ __forceinline__ void p0_prologue(const Args& a, LAS unsigned char* lds, int vcu, int G, int wave, int lane) {
    LAS unsigned char* scr = lds + wave * 16384;
    const int gw = vcu * NWAVES + wave, NGW = G * NWAVES;
    const float* win = a.in[8]; const float* wout = a.in[13];
    f16* WinT = (f16*)(a.ws + WS_WINT); f16* WoutT = (f16*)(a.ws + WS_WOUTT); f16* XN = (f16*)(a.ws + WS_XNH);
    constexpr int I_IN = 32 * (NPAD / 32), I_OUT = 32 * (DM / 32);
    for (int rpt = 0; rpt < P0_REP_T; ++rpt) {
        p0_transpose_all<true>(win, DIN, WinT, scr, I_IN, NPAD / 32, gw, NGW, lane);
        p0_transpose_all<false>(wout, DM, WoutT, scr, I_OUT, DM / 32, gw, NGW, lane); }
    HOOK_15
    const float* gin = a.in[7];
    f32x4 gv[8];
#pragma unroll
    for (int j = 0; j < 8; ++j) gv[j] = ((const f32x4*)gin)[lane + 64 * j];
#define XLOAD(V, m_) do { const int mm_ = (m_) < MT - 1 ? (m_) : MT - 1; const float* xrow_ = mm_ < MP ? a.in[0] + (size_t)mm_ * DM : a.in[1] + (size_t)(mm_ - MP) * DM; \
        const f32x4* xr_ = (const f32x4*)xrow_ + lane; _Pragma("unroll") for (int j = 0; j < 8; ++j) V[j] = xr_[64 * j]; } while (0)
#define XPROC(V, m_) do { float s_ = 0.f; _Pragma("unroll") for (int j = 0; j < 8; ++j) s_ += (V[j].x * V[j].x + V[j].y * V[j].y) + (V[j].z * V[j].z + V[j].w * V[j].w); \
        const float rs_ = rsqrtf(wave_sum_dpp(s_) * (1.f / DM) + EPS); u32x2* o8_ = (u32x2*)(XN + (size_t)(m_) * DM) + lane; \
        _Pragma("unroll") for (int j = 0; j < 8; ++j) { u32x2 w_; w_.x = pk_f16(V[j].x * rs_ * gv[j].x, V[j].y * rs_ * gv[j].y); w_.y = pk_f16(V[j].z * rs_ * gv[j].z, V[j].w * rs_ * gv[j].w); o8_[64 * j] = w_; } } while (0)
    for (int rpx = 0; rpx < P0_REP_X; ++rpx) {
        f32x4 v0[8], v1[8]; int m = gw;
        if (m < MT) { XLOAD(v0, m);
            for (; m < MT; m += 2 * NGW) {
                XLOAD(v1, m + NGW); XPROC(v0, m);
                XLOAD(v0, m + 2 * NGW); if (m + NGW < MT) XPROC(v1, m + NGW); } } }
#undef XLOAD
#undef XPROC
    HOOK_16
    float* rqk = (float*)(a.ws + WS_ROPE); float* ri = (float*)(a.ws + WS_ROPE_I);
    for (int i = gw * 64 + lane; i < 2052 * 16; i += NGW * 64) {
        { int slot = i / 16, j = i % 16; int pos = slot < 2048 ? slot : PAST + (slot - 2048);
          float inv = (float)pow(500000.0, -(double)j / 16.0); float ang = (float)pos * inv;
          rqk[(slot * 16 + j) * 2] = (float)cos((double)ang); rqk[(slot * 16 + j) * 2 + 1] = (float)sin((double)ang); }
        if (i < 2052 * 8) { int slot = i / 8, j = i % 8; int pos = slot < 2048 ? slot : PAST + (slot - 2048);
          float inv = (float)pow(500000.0, -(double)j / 8.0); float ang = (float)pos * inv;
          ri[(slot * 8 + j) * 2] = (float)cos((double)ang); ri[(slot * 8 + j) * 2 + 1] = (float)sin((double)ang); }
    }
}

struct EpiIn {
    float* out; unsigned char* ws; const float* gq; const float* gk; const float* gki; LAS float* scr;
    __device__ __forceinline__ bool aligned(const pg8::Unit& u) const { return u.pn <= 4 || u.pn == 14; }
    __device__ __forceinline__ void done(const pg8::Unit& u, int ui) const {
        if (ui == 0 && u.pn >= 10 && u.pn <= 14) { asm volatile("s_waitcnt vmcnt(0)" ::: "memory");
            if ((threadIdx.x & 63) == 0) (void)__hip_atomic_fetch_add((unsigned*)ws + RDYA_WORD, 1u, __ATOMIC_RELAXED, __HIP_MEMORY_SCOPE_AGENT); } }
    __device__ __forceinline__ void init(f32x4 (&acc)[2][2][4][2], const pg8::Unit&, int, int, int, int) const {
#pragma unroll
        for (int a = 0; a < 2; ++a)
#pragma unroll
            for (int b = 0; b < 2; ++b)
#pragma unroll
                for (int m = 0; m < 4; ++m)
#pragma unroll
                    for (int n = 0; n < 2; ++n) acc[a][b][m][n] = (f32x4){0.f, 0.f, 0.f, 0.f};
    }
    __device__ __forceinline__ void operator()(f32x4 (&acc)[2][2][4][2], const pg8::Unit& u, int wr, int wc, int fr_, int fq_) const {
        int fr = fr_, fq = fq_; asm volatile("" : "+v"(fr), "+v"(fq));
        GAS unsigned char* ws = (GAS unsigned char*)this->ws; GAS float* out = (GAS float*)this->out; asm volatile("" : "+s"(ws), "+s"(out));
        const int pn = u.pn, pm = u.pm; const bool smp = pm == 32;
        const int rbase = 64 * wr + fr;
        const int bb = pm >> 3, t0 = (pm & 7) << 8;
        const GAS float* rqk = (const GAS float*)(ws + WS_ROPE); const GAS float* ri = (const GAS float*)(ws + WS_ROPE_I);
#define ROWLOOP _Pragma("unroll") for (int ai = 0; ai < 2; ++ai) _Pragma("unroll") for (int m = 0; m < 4; ++m)
#define ROWVARS const int r = rbase + 128 * ai + 16 * m; const bool valid = !smp || r < MS; const int grow = smp ? MP + r : pm * 256 + r; const int tt = smp ? (r & 3) : t0 + r; const int slot = smp ? 2048 + (r & 3) : tt; (void)grow; (void)tt; (void)slot; (void)valid;
        const int cl = 32 * wc + 8 * fq;
#define PK8B(x0_, x1_) ((u32x4){pk_bf16(x0_[0], x0_[1]), pk_bf16(x0_[2], x0_[3]), pk_bf16(x1_[0], x1_[1]), pk_bf16(x1_[2], x1_[3])})
#define PK8H(x0_, x1_) ((u32x4){pk_f16(x0_[0], x0_[1]), pk_f16(x0_[2], x0_[3]), pk_f16(x1_[0], x1_[1]), pk_f16(x1_[2], x1_[3])})
#define SHX4(dst_, src_, off_) do { dst_[0] = __shfl_xor(src_[0], off_); dst_[1] = __shfl_xor(src_[1], off_); dst_[2] = __shfl_xor(src_[2], off_); dst_[3] = __shfl_xor(src_[3], off_); } while (0)
        if (pn <= 4 || pn == 14) {
            const bool isk = pn == 14;
            ROWLOOP { asm volatile("" ::: "memory"); const int r = rbase + 128 * ai + 16 * m;
#pragma unroll
                for (int bj = 0; bj < 2; ++bj) { float s = 0.f;
#pragma unroll
                    for (int n = 0; n < 2; ++n) { const f32x4 x = acc[ai][bj][m][n]; s += (x[0] * x[0] + x[1] * x[1]) + (x[2] * x[2] + x[3] * x[3]); }
                    if (isk && (wc >= 2 || bj == 1)) s = 0.f;
                    s += __shfl_xor(s, 16); s += __shfl_xor(s, 32);
                    if (fq == 0) scr[(r * 2 + bj) * 4 + wc] = s; } }
            asm volatile("s_waitcnt lgkmcnt(0)" ::: "memory"); __builtin_amdgcn_s_barrier(); asm volatile("" ::: "memory");
            if (!isk) {
                const GAS float* g = (const GAS float*)(pn < 4 ? gq : gk);
                const f32x4 g0 = *(const GAS f32x4*)(g + cl), g1 = *(const GAS f32x4*)(g + cl + 4);
                GAS bf16_t* Qb = (GAS bf16_t*)(ws + WS_QB); GAS bf16_t* Kb = (GAS bf16_t*)(ws + WS_KB); GAS float* QS = (GAS float*)(ws + WS_QS);
                ROWLOOP { asm volatile("" ::: "memory"); ROWVARS
                    f32x4 c0 = {1.f, 1.f, 1.f, 1.f}, s0 = {0.f, 0.f, 0.f, 0.f}, c1 = c0, s1 = s0;
                    if (wc == 0) { const GAS f32x4* cp = (const GAS f32x4*)(rqk + (slot * 16 + 8 * (fq & 1)) * 2); const f32x4 t0_ = cp[0], t1_ = cp[1], t2_ = cp[2], t3_ = cp[3];
                        c0 = (f32x4){t0_[0], t0_[2], t1_[0], t1_[2]}; s0 = (f32x4){t0_[1], t0_[3], t1_[1], t1_[3]}; c1 = (f32x4){t2_[0], t2_[2], t3_[0], t3_[2]}; s1 = (f32x4){t2_[1], t2_[3], t3_[1], t3_[3]}; }
#pragma unroll
                    for (int bj = 0; bj < 2; ++bj) {
                        const f32x4 p = *(const LAS f32x4*)(scr + (r * 2 + bj) * 4);
                        const float rs = rsqrtf(((p[0] + p[1]) + (p[2] + p[3])) * (1.f / 128.f) + EPS);
                        f32x4 x0 = acc[ai][bj][m][0] * rs * g0, x1 = acc[ai][bj][m][1] * rs * g1;
                        if (wc == 0) { f32x4 o0, o1; SHX4(o0, x0, 32); SHX4(o1, x1, 32);
                            if (fq < 2) { x0 = x0 * c0 - o0 * s0; x1 = x1 * c1 - o1 * s1; } else { x0 = x0 * c0 + o0 * s0; x1 = x1 * c1 + o1 * s1; } }
                        const int hh = 2 * pn + bj;
                        if (pn < 4) {
                            if (smp) { if (valid) { GAS float* q = QS + (size_t)r * 1024 + hh * 128 + cl; *(GAS f32x4*)q = x0; *(GAS f32x4*)(q + 4) = x1; } }
                            else *(GAS u32x4*)(Qb + (((size_t)bb * NH + hh) * S + tt) * HD + cl) = PK8B(x0, x1);
                        } else {
                            if (smp) { if (valid) { GAS float* k = out + O_KS + (size_t)r * 256 + bj * 128 + cl; *(GAS f32x4*)k = x0; *(GAS f32x4*)(k + 4) = x1; } }
                            else { GAS float* k = out + O_KP + (size_t)grow * 256 + bj * 128 + cl; *(GAS f32x4*)k = x0; *(GAS f32x4*)(k + 4) = x1;
                                *(GAS u32x4*)(Kb + (((size_t)bb * NKV + bj) * S + tt) * HD + cl) = PK8B(x0, x1); }
                        } } }
            } else {
                const int dl = 32 * (wc & 1) + 8 * fq;
                const f32x4 g0 = *(const GAS f32x4*)((const GAS float*)gki + dl), g1 = *(const GAS f32x4*)((const GAS float*)gki + dl + 4);
                GAS f16* KI = (GAS f16*)(ws + WS_KI); GAS float* WI = (GAS float*)(ws + WS_WI);
                ROWLOOP { asm volatile("" ::: "memory"); ROWVARS
                    const f32x4 p = *(const LAS f32x4*)(scr + (r * 2) * 4);
                    const float rs = rsqrtf((p[0] + p[1]) * (1.f / 64.f) + EPS);
                    f32x4 x0 = acc[ai][0][m][0] * rs * g0, x1 = acc[ai][0][m][1] * rs * g1;
                    f32x4 o0, o1; SHX4(o0, x0, 16); SHX4(o1, x1, 16);
                    if (wc == 0 && fq < 2) { const GAS f32x4* cp = (const GAS f32x4*)(ri + (slot * 8) * 2); const f32x4 t0_ = cp[0], t1_ = cp[1], t2_ = cp[2], t3_ = cp[3];
                        const f32x4 c0 = {t0_[0], t0_[2], t1_[0], t1_[2]}, s0 = {t0_[1], t0_[3], t1_[1], t1_[3]}, c1 = {t2_[0], t2_[2], t3_[0], t3_[2]}, s1 = {t2_[1], t2_[3], t3_[1], t3_[3]};
                        if (fq == 0) { x0 = x0 * c0 - o0 * s0; x1 = x1 * c1 - o1 * s1; } else { x0 = x0 * c0 + o0 * s0; x1 = x1 * c1 + o1 * s1; } }
                    if (wc < 2 && valid) {
                        GAS float* ko = smp ? out + O_KIS + (size_t)r * 64 + dl : out + O_KIP + (size_t)grow * 64 + dl;
                        *(GAS f32x4*)ko = x0; *(GAS f32x4*)(ko + 4) = x1;
                        if (!smp) st16_wt((GAS void*)(KI + (size_t)grow * 64 + dl), PK8H(x0, x1)); }
                    if (wc == 2 && fq < 2 && valid) { GAS float* wo = WI + (size_t)grow * 16 + 8 * fq; const f32x4 w0_ = acc[ai][0][m][0] * (1.f / 32.f), w1_ = acc[ai][0][m][1] * (1.f / 32.f); st16_wt((GAS void*)wo, __builtin_bit_cast(u32x4, w0_)); st16_wt((GAS void*)(wo + 4), __builtin_bit_cast(u32x4, w1_)); }
                }
            }
        } else if (pn == 5) {
            GAS bf16_t* Vb = (GAS bf16_t*)(ws + WS_VB);
            ROWLOOP { asm volatile("" ::: "memory"); ROWVARS
#pragma unroll
                for (int bj = 0; bj < 2; ++bj) { const f32x4 x0 = acc[ai][bj][m][0], x1 = acc[ai][bj][m][1];
                    if (smp) { if (valid) { GAS float* v = out + O_VS + (size_t)r * 256 + bj * 128 + cl; *(GAS f32x4*)v = x0; *(GAS f32x4*)(v + 4) = x1; } }
                    else { GAS float* v = out + O_VP + (size_t)grow * 256 + bj * 128 + cl; *(GAS f32x4*)v = x0; *(GAS f32x4*)(v + 4) = x1;
                        *(GAS u32x4*)(Vb + (((size_t)bb * NKV + bj) * S + tt) * HD + cl) = PK8B(x0, x1); } } }
        } else if (pn <= 9) {
            GAS f16* SZ = (GAS f16*)(ws + WS_SZ); const int c0 = 256 * (pn - 6) + cl;
            ROWLOOP { asm volatile("" ::: "memory"); ROWVARS
                if (valid) {
#pragma unroll
                    for (int bj = 0; bj < 2; ++bj) { const f32x4 a0 = acc[ai][bj][m][0], a1 = acc[ai][bj][m][1];
                        f32x4 z0, z1; z0[0] = silu(a0[0]); z0[1] = silu(a0[1]); z0[2] = silu(a0[2]); z0[3] = silu(a0[3]); z1[0] = silu(a1[0]); z1[1] = silu(a1[1]); z1[2] = silu(a1[2]); z1[3] = silu(a1[3]);
                        *(GAS u32x4*)(SZ + (size_t)grow * 1024 + c0 + 128 * bj) = PK8H(z0, z1); } } }
        } else if (pn <= 13) {
            GAS f16* QI = (GAS f16*)(ws + WS_QI); const int c0 = 256 * (pn - 10) + cl;
            ROWLOOP { asm volatile("" ::: "memory"); ROWVARS
                f32x4 c0v = {1.f, 1.f, 1.f, 1.f}, s0v = {0.f, 0.f, 0.f, 0.f}, c1v = c0v, s1v = s0v;
                const bool rp = (wc & 1) == 0;
                if (rp) { const GAS f32x4* cp = (const GAS f32x4*)(ri + (slot * 8) * 2); const f32x4 t0_ = cp[0], t1_ = cp[1], t2_ = cp[2], t3_ = cp[3];
                    c0v = (f32x4){t0_[0], t0_[2], t1_[0], t1_[2]}; s0v = (f32x4){t0_[1], t0_[3], t1_[1], t1_[3]}; c1v = (f32x4){t2_[0], t2_[2], t3_[0], t3_[2]}; s1v = (f32x4){t2_[1], t2_[3], t3_[1], t3_[3]}; }
#pragma unroll
                for (int bj = 0; bj < 2; ++bj) { f32x4 x0 = acc[ai][bj][m][0], x1 = acc[ai][bj][m][1];
                    f32x4 o0, o1; SHX4(o0, x0, 16); SHX4(o1, x1, 16);
                    if (rp && fq < 2) { if (fq == 0) { x0 = x0 * c0v - o0 * s0v; x1 = x1 * c1v - o1 * s1v; } else { x0 = x0 * c0v + o0 * s0v; x1 = x1 * c1v + o1 * s1v; } }
                    if (valid) st16_wt((GAS void*)(QI + (size_t)grow * 1024 + c0 + 128 * bj), PK8H(x0, x1)); } }
        } else {
            GAS f16* UG = (GAS f16*)(ws + WS_U); const int ch = 64 * (pn - 15) + 16 * wc + 4 * fq;
            ROWLOOP { asm volatile("" ::: "memory"); ROWVARS
                const f32x4 h = acc[ai][0][m][0], b = acc[ai][0][m][1], c = acc[ai][1][m][0], z = acc[ai][1][m][1];
                const f32x4 uu = c * h; f32x4 gg; gg[0] = b[0] * silu(z[0]); gg[1] = b[1] * silu(z[1]); gg[2] = b[2] * silu(z[2]); gg[3] = b[3] * silu(z[3]);
                if (valid) { u32x4 w = {pk_f16(uu[0], uu[1]), pk_f16(uu[2], uu[3]), pk_f16(gg[0], gg[1]), pk_f16(gg[2], gg[3])};
                    *(GAS u32x4*)(UG + (size_t)grow * 2048 + 2 * ch) = w;
                    if (!smp && tt >= S - 2) *(GAS f32x4*)(out + O_CVP + ((size_t)bb * 2 + (tt - (S - 2))) * 1024 + ch) = uu;
                    if (smp && tt >= 2) *(GAS f32x4*)(out + O_CVS + ((size_t)(r >> 2) * 2 + (tt - 2)) * 1024 + ch) = uu; } }
        }
#undef ROWLOOP
#undef ROWVARS
#undef PK8B
#undef PK8H
#undef SHX4
    }
};


struct EpiOut {
    float* out; const float* xp;
    __device__ __forceinline__ void done(const pg8::Unit&, int) const {}
    __device__ __forceinline__ bool aligned(const pg8::Unit&) const { return false; }
    __device__ __forceinline__ void init(f32x4 (&acc)[2][2][4][2], const pg8::Unit& u, int wr, int wc, int fr, int fq) const {
        const GAS float* xp = (const GAS float*)this->xp;
        const size_t base = (size_t)(u.pm * 256 + 64 * wr + fr) * DM + u.pn * 256 + 32 * wc + 4 * fq;
#pragma unroll
        for (int ai = 0; ai < 2; ++ai)
#pragma unroll
            for (int m = 0; m < 4; ++m)
#pragma unroll
                for (int bj = 0; bj < 2; ++bj)
#pragma unroll
                    for (int n = 0; n < 2; ++n) acc[ai][bj][m][n] = *(const GAS f32x4*)(xp + base + (size_t)(128 * ai + 16 * m) * DM + 128 * bj + 16 * n);
    }
    __device__ __forceinline__ void operator()(f32x4 (&acc)[2][2][4][2], const pg8::Unit& u, int wr, int wc, int fr_, int fq_) const {
        int fr = fr_, fq = fq_; asm volatile("" : "+v"(fr), "+v"(fq));
        GAS float* out = (GAS float*)this->out; asm volatile("" : "+s"(out));
        const size_t base = (size_t)(u.pm * 256 + 64 * wr + fr) * DM + u.pn * 256 + 32 * wc + 4 * fq;
#pragma unroll
        for (int ai = 0; ai < 2; ++ai)
#pragma unroll
            for (int m = 0; m < 4; ++m) { const size_t off = base + (size_t)(128 * ai + 16 * m) * DM;
#pragma unroll
                for (int bj = 0; bj < 2; ++bj)
#pragma unroll
                    for (int n = 0; n < 2; ++n) *(GAS f32x4*)(out + off + 128 * bj + 16 * n) = acc[ai][bj][m][n]; }
    }
};
__device__ __forceinline__ void p4_item(const Args& a, LAS unsigned char* lds, int cg, int tid) {
    const GAS f16* WT = (const GAS f16*)(a.ws + WS_WOUTT);
    LAS float* part = (LAS float*)lds;
    const int lane = tid & 63, wave = __builtin_amdgcn_readfirstlane(tid >> 6), fr = lane & 15, fq = lane >> 4;
    const unsigned long long mu = (unsigned long long)(a.ws + WS_MIX + (size_t)MP * DM * 2);
    const unsigned mlo = __builtin_amdgcn_readfirstlane((unsigned)mu), mhi = __builtin_amdgcn_readfirstlane((unsigned)(mu >> 32));
    const __amdgpu_buffer_rsrc_t rm = __builtin_amdgcn_make_buffer_rsrc((void*)(((unsigned long long)mhi << 32) | mlo), (short)0, MS * DM * 2, 0x00020000);
    const unsigned mvo = (unsigned)(fr * DM + wave * 256 + 8 * fq) * 2u;
    float res = 0.f; const int rr = tid >> 3, cc = tid & 7;
    if (tid < 256) res = a.in[1][(size_t)rr * DM + cg * 8 + cc];
    const GAS f16* wp = WT + (size_t)(cg * 8 + (fr & 7)) * DM + wave * 256 + 8 * fq;
    f16x8 wf[8], m0[8], m1[8];
#pragma unroll
    for (int ks = 0; ks < 8; ++ks) { wf[ks] = *(const GAS f16x8*)(wp + 32 * ks);
        m0[ks] = __builtin_bit_cast(f16x8, __builtin_amdgcn_raw_buffer_load_b128(rm, mvo, 64 * ks, 16)); m1[ks] = __builtin_bit_cast(f16x8, __builtin_amdgcn_raw_buffer_load_b128(rm, mvo, 16 * DM * 2 + 64 * ks, 16)); }
    f32x4 c0 = {0.f, 0.f, 0.f, 0.f}, c1 = {0.f, 0.f, 0.f, 0.f};
#pragma unroll
    for (int ks = 0; ks < 8; ++ks) { c0 = __builtin_amdgcn_mfma_f32_16x16x32_f16(wf[ks], m0[ks], c0, 0, 0, 0); c1 = __builtin_amdgcn_mfma_f32_16x16x32_f16(wf[ks], m1[ks], c1, 0, 0, 0); }
    *(LAS f32x4*)(part + ((wave * 2 + 0) * 64 + lane) * 4) = c0; *(LAS f32x4*)(part + ((wave * 2 + 1) * 64 + lane) * 4) = c1;
    __syncthreads();
    if (tid < 256) { const int ln = (rr & 15) + 16 * (cc >> 2), tl = rr >> 4; float s = res;
#pragma unroll
        for (int w = 0; w < 8; ++w) s += part[((w * 2 + tl) * 64 + ln) * 4 + (cc & 3)];
        a.out[O_YS + (size_t)rr * DM + cg * 8 + cc] = s; }
    __syncthreads();
}
typedef GAS unsigned gu32;
#define XB_TMO      128
#define XB_XCNT(j)  (256  + 64 * (j))
#define XB_XSUB(j)  (1280 + 64 * (j))
#define XB_XGEN(j)  (2304 + 64 * (j))
#define XB_TOP      3328
#define XB_TOPGEN   3392
#define XCD_BAR_WORDS 3456
#define XB_SPIN_CAP (1u << 18)
__device__ __forceinline__ unsigned xb_ld(unsigned* p)              { return __hip_atomic_load(p, __ATOMIC_RELAXED, __HIP_MEMORY_SCOPE_AGENT); }
__device__ __forceinline__ unsigned xb_add(unsigned* p, unsigned v) { return __hip_atomic_fetch_add(p, v, __ATOMIC_RELAXED, __HIP_MEMORY_SCOPE_AGENT); }
__device__ __forceinline__ unsigned xb_xcc_id() { return (unsigned)__builtin_amdgcn_s_getreg((3 << 11) | 20) & 0xFu; }
#define XB_SPIN(cond, bar) do { unsigned _sp = 0; while (cond) { __builtin_amdgcn_s_sleep(1); \
    if ((++_sp & 255u) == 0u) { if (xb_ld(&(bar)[XB_TMO])) break; if (_sp > XB_SPIN_CAP) { atomicAdd(&(bar)[XB_TMO], 1u); break; } } } } while (0)
struct XcdBarrier { unsigned* bar; unsigned x; volatile LAS unsigned* st; };
__device__ __forceinline__ XcdBarrier xcd_barrier_post(unsigned* bar, volatile LAS unsigned* st) {
    XcdBarrier b; b.bar = bar; b.x = xb_xcc_id(); b.st = st;
    if (threadIdx.x == 0) (void)xb_add(&bar[XB_XCNT(b.x)], 1u);
    return b;
}
__device__ __forceinline__ void xcd_barrier_complete(unsigned* bar, unsigned x, unsigned& nloc, unsigned& nx) {
    const unsigned G = gridDim.x * gridDim.y * gridDim.z;
    unsigned sum, cnt, mine, sp = 0u;
    for (;;) {
        sum = 0u; cnt = 0u; mine = 0u;
#pragma unroll
        for (unsigned j = 0; j < 16; ++j) { const unsigned c = xb_ld(&bar[XB_XCNT(j)]); sum += c; cnt += (c > 0u) ? 1u : 0u; mine = (j == x) ? c : mine; }
        if (sum == G) break;
        __builtin_amdgcn_s_sleep(1);
        if ((++sp & 255u) == 0u) { if (xb_ld(&bar[XB_TMO])) break; if (sp > XB_SPIN_CAP) { atomicAdd(&bar[XB_TMO], 1u); break; } }
    }
    nloc = mine > 0u ? mine : 1u; nx = cnt > 0u ? cnt : 1u;
}
__device__ __forceinline__ void xcd_barrier(const XcdBarrier& b) {
    asm volatile("s_waitcnt vmcnt(0)" ::: "memory");
    __syncthreads();
    if (threadIdx.x == 0) {
        unsigned* bar = b.bar;
        __builtin_amdgcn_s_waitcnt(0);
        unsigned nloc = b.st[0], nx = b.st[1];
        if (nloc == 0u) { xcd_barrier_complete(bar, b.x, nloc, nx); b.st[0] = nloc; b.st[1] = nx; }
        const unsigned old = xb_add(&bar[XB_XSUB(b.x)], 1u);
        const unsigned gen = old / nloc;
        if (old + 1u == (gen + 1u) * nloc) {
            __builtin_amdgcn_fence(__ATOMIC_RELEASE, "agent");
            asm volatile("s_waitcnt vmcnt(0)" ::: "memory");
            const unsigned og = xb_add(&bar[XB_TOP], 1u);
            const unsigned tg = og / nx;
            if (og + 1u == (tg + 1u) * nx) xb_add(&bar[XB_TOPGEN], 1u);
            else XB_SPIN(xb_ld(&bar[XB_TOPGEN]) == tg, bar);
            __builtin_amdgcn_fence(__ATOMIC_ACQUIRE, "agent");
            xb_add(&bar[XB_XGEN(b.x)], 1u);
            asm volatile("s_waitcnt vmcnt(0)" ::: "memory");
        } else {
            XB_SPIN(xb_ld(&bar[XB_XGEN(b.x)]) == gen, bar);
            __builtin_amdgcn_fence(__ATOMIC_ACQUIRE, "agent");
            asm volatile("s_waitcnt vmcnt(0)" ::: "memory");
        }
    }
    __syncthreads();
}

constexpr int CMQ_WORD = 16064;
constexpr int RDY_WORD0 = 4096;
__device__ __forceinline__ void signal_add(unsigned* ctr) {
    asm volatile("s_waitcnt vmcnt(0)" ::: "memory");
    __syncthreads();
    if (threadIdx.x == 0) { __builtin_amdgcn_fence(__ATOMIC_RELEASE, "agent"); asm volatile("s_waitcnt vmcnt(0)" ::: "memory"); (void)xb_add(ctr, 1u); }
}
__device__ __forceinline__ void wait_ge(unsigned* ctr, unsigned need) {
    if (threadIdx.x == 0) { unsigned sp = 0; while (xb_ld(ctr) < need) { __builtin_amdgcn_s_sleep(2); if (++sp > (1u << 22)) break; }
        __builtin_amdgcn_fence(__ATOMIC_ACQUIRE, "agent"); asm volatile("s_waitcnt vmcnt(0)" ::: "memory"); }
    __syncthreads();
}

constexpr int PMR_WORD0 = 16384;
__device__ __forceinline__ void signal_add_wt(unsigned* ctr) {
    asm volatile("s_waitcnt vmcnt(0)" ::: "memory");
    __syncthreads();
    if (threadIdx.x == 0) (void)xb_add(ctr, 1u);
}
__device__ __forceinline__ void wait_ge_wt(unsigned* ctr, unsigned need) {
#ifdef SPAN_WAITACC
    if (threadIdx.x == 0) { const unsigned long long w0_ = __builtin_amdgcn_s_memrealtime(); unsigned sp = 0; while (xb_ld(ctr) < need) { __builtin_amdgcn_s_sleep(2); if (++sp > (1u << 22)) break; }
        *(LAS unsigned*)(size_t)(145408 + 160) += (unsigned)(__builtin_amdgcn_s_memrealtime() - w0_); }
#else
    if (threadIdx.x == 0) { unsigned sp = 0; while (xb_ld(ctr) < need) { __builtin_amdgcn_s_sleep(2); if (++sp > (1u << 22)) break; } }
#endif
    __syncthreads();
}

#ifndef P2_KT_REP
#define P2_KT_REP 1
#define P2_SEL_REP 1
#endif
#ifndef P2_REP_A
#define P2_REP_A 1
#define P2_REP_B 1
#define P2_REP_C 1
#endif
constexpr int SC_STRIDE = 2052;
constexpr int SC_BYTES = 16 * SC_STRIDE * 4;
constexpr int WSCR_OFF = 131584, WSCR_BYTES = 1536;
__device__ __forceinline__ f16x8 cvt8(f32x4 a, f32x4 b) { u32x4 w = {pk_f16(a[0], a[1]), pk_f16(a[2], a[3]), pk_f16(b[0], b[1]), pk_f16(b[2], b[3])}; return __builtin_bit_cast(f16x8, w); }

__device__ __forceinline__ void convmix_task(const Args& a, int ch, int half, int lane) {
    const GAS f16* UG = (const GAS f16*)(a.ws + WS_U); GAS f16* MIX = (GAS f16*)(a.ws + WS_MIX);
    const GAS float* wconv = (const GAS float*)a.in[12]; const GAS float* state = (const GAS float*)a.in[5];
    {
        const int row0 = 4 * ch; const bool smp = row0 >= MP; const int t0 = smp ? 0 : (row0 & (S - 1)); const int seq = (row0 - MP) >> 2;
        { const int cb = half * 512 + 8 * lane;
            float um2[8], um1[8], w0[8], w1[8], w2[8];
#pragma unroll
            for (int e = 0; e < 8; e += 4) { const f32x4 a0 = *(const GAS f32x4*)(wconv + cb + e), a1 = *(const GAS f32x4*)(wconv + 1024 + cb + e), a2 = *(const GAS f32x4*)(wconv + 2048 + cb + e);
#pragma unroll
                for (int i = 0; i < 4; ++i) { w0[e + i] = a0[i]; w1[e + i] = a1[i]; w2[e + i] = a2[i]; } }
            if (t0 == 0) {
                if (smp) {
#pragma unroll
                    for (int e = 0; e < 8; e += 4) { const f32x4 s0 = *(const GAS f32x4*)(state + ((size_t)seq * 2) * 1024 + cb + e), s1 = *(const GAS f32x4*)(state + ((size_t)seq * 2 + 1) * 1024 + cb + e);
#pragma unroll
                        for (int i = 0; i < 4; ++i) { um2[e + i] = s0[i]; um1[e + i] = s1[i]; } }
                } else {
#pragma unroll
                    for (int e = 0; e < 8; ++e) { um2[e] = 0.f; um1[e] = 0.f; } }
            } else {
#pragma unroll
                for (int gq = 0; gq < 2; ++gq) { const f16x4 p2 = *(const GAS f16x4*)(UG + (size_t)(row0 - 2) * 2048 + 2 * cb + 8 * gq), p1 = *(const GAS f16x4*)(UG + (size_t)(row0 - 1) * 2048 + 2 * cb + 8 * gq);
#pragma unroll
                    for (int e = 0; e < 4; ++e) { um2[4 * gq + e] = (float)p2[e]; um1[4 * gq + e] = (float)p1[e]; } } }
#pragma unroll
            for (int i = 0; i < 4; ++i) { const size_t row = row0 + i;
                const f16x8 x0 = *(const GAS f16x8*)(UG + row * 2048 + 2 * cb), x1 = *(const GAS f16x8*)(UG + row * 2048 + 2 * cb + 8); float o[8];
#pragma unroll
                for (int e = 0; e < 8; ++e) { const float u = (float)(e < 4 ? x0[e] : x1[e - 4]); const float g = (float)(e < 4 ? x0[4 + e] : x1[e]);
                    const float cv = w0[e] * um2[e] + w1[e] * um1[e] + w2[e] * u; o[e] = g * cv; um2[e] = um1[e]; um1[e] = u; }
                u32x4 w = {pk_f16(o[0], o[1]), pk_f16(o[2], o[3]), pk_f16(o[4], o[5]), pk_f16(o[6], o[7])};
                st16_wt((GAS void*)(MIX + row * 2048 + 1024 + cb), w); }
        }
    }
}

__device__ __forceinline__ void p2_sscore(const Args& a, int gw, int NGW, int lane) {
    const GAS float* cki = (const GAS float*)a.in[4]; const GAS int* ptab = (const GAS int*)a.in[6];
    const GAS f16* QI = (const GAS f16*)(a.ws + WS_QI); const GAS float* WI = (const GAS float*)(a.ws + WS_WI); GAS float* SSC = (GAS float*)(a.ws + WS_SSC);
    const int fr = lane & 15, fq = lane >> 4;
    for (int it = gw; it < NSB * 256; it += NGW) {
        const int sb = it >> 8, hp = it & 255, pg = hp >> 1, k0 = (hp & 1) * 64; const int phys = ptab[sb * NPAGES + pg];
        const GAS float* kbase = cki + ((size_t)phys * PAGE + k0) * 64;
        f16x8 qf[4][2]; f32x4 wv[4];
#pragma unroll
        for (int t = 0; t < 4; ++t) { const size_t row = MP + 4 * sb + t;
            qf[t][0] = *(const GAS f16x8*)(QI + row * 1024 + fr * 64 + 8 * fq); qf[t][1] = *(const GAS f16x8*)(QI + row * 1024 + fr * 64 + 32 + 8 * fq);
            wv[t] = *(const GAS f32x4*)(WI + row * 16 + 4 * fq); }
        f32x4 kraw[4][4];
#pragma unroll
        for (int tile = 0; tile < 4; ++tile) { const GAS float* kr = kbase + (size_t)(16 * tile + fr) * 64 + 8 * fq;
            kraw[tile][0] = *(const GAS f32x4*)kr; kraw[tile][1] = *(const GAS f32x4*)(kr + 4); kraw[tile][2] = *(const GAS f32x4*)(kr + 32); kraw[tile][3] = *(const GAS f32x4*)(kr + 36); }
#pragma unroll
        for (int tile = 0; tile < 4; ++tile) {
            const f16x8 kf0 = cvt8(kraw[tile][0], kraw[tile][1]), kf1 = cvt8(kraw[tile][2], kraw[tile][3]);
            float mine = 0.f;
#pragma unroll
            for (int t = 0; t < 4; ++t) { f32x4 c = {0.f, 0.f, 0.f, 0.f};
                c = __builtin_amdgcn_mfma_f32_16x16x32_f16(qf[t][0], kf0, c, 0, 0, 0); c = __builtin_amdgcn_mfma_f32_16x16x32_f16(qf[t][1], kf1, c, 0, 0, 0);
                float s = wv[t][0] * fmaxf(c[0], 0.f) + wv[t][1] * fmaxf(c[1], 0.f) + wv[t][2] * fmaxf(c[2], 0.f) + wv[t][3] * fmaxf(c[3], 0.f);
                s += __shfl_xor(s, 16); s += __shfl_xor(s, 32);
                mine = fq == t ? s : mine; }
            __hip_atomic_store((GAS unsigned*)SSC + ((size_t)(4 * sb + fq) * PAST + pg * PAGE + k0 + 16 * tile + fr), __builtin_bit_cast(unsigned, mine), __ATOMIC_RELAXED, __HIP_MEMORY_SCOPE_AGENT);
        }
    }
}

__device__ __forceinline__ void wave_topk_mask(const LAS float* row, int t, GAS unsigned long long* mrow, int lane, LAS unsigned* hist, LAS float* cand) {
    const float NINF = -__builtin_inff(), PINF = __builtin_inff();
    const int jmax = t >> 6;
    const int rem = t - lane;
    float v[32]; float mx = NINF, mn = PINF;
#pragma unroll
    for (int g = 0; g < 4; ++g) {
        if (8 * g <= jmax) {
#pragma unroll
            for (int jj = 0; jj < 8; ++jj) { const int j = 8 * g + jj; const float x = row[64 * j + lane]; const bool ok = 64 * j <= rem; v[j] = ok ? x : NINF; mx = fmaxf(mx, v[j]); mn = fminf(mn, ok ? x : PINF); }
        } else {
#pragma unroll
            for (int jj = 0; jj < 8; ++jj) v[8 * g + jj] = NINF; } }
    mx = wave_max_dpp(mx); mn = -wave_max_dpp(-mn);
    *(LAS u32x4*)(hist + 4 * lane) = (u32x4){0u, 0u, 0u, 0u};
    const float scale = 255.5f / (mx - mn), off = -mn * scale;
    float tau = 0.f; bool have = false;
    if (mx > mn) {
        asm volatile("s_waitcnt lgkmcnt(0)" ::: "memory");
        unsigned bins[32];
#pragma unroll
        for (int g = 0; g < 4; ++g) {
            if (8 * g <= jmax) {
#pragma unroll
                for (int jj = 0; jj < 8; ++jj) { const int j = 8 * g + jj; unsigned b = (unsigned)fmaf(v[j], scale, off); b = b > 255u ? 255u : b; bins[j] = b;
                    __hip_atomic_fetch_add(hist + b, 1u, __ATOMIC_RELAXED, __HIP_MEMORY_SCOPE_WORKGROUP); }
            } else {
#pragma unroll
                for (int jj = 0; jj < 8; ++jj) bins[8 * g + jj] = 0u; } }
        asm volatile("s_waitcnt lgkmcnt(0)" ::: "memory");
        const u32x4 h = *(const LAS u32x4*)(hist + 4 * lane);
        const unsigned sl = h[0] + h[1] + h[2] + h[3]; const unsigned pre = wave_scan_dpp(sl);
        const unsigned tot = __builtin_amdgcn_readlane(pre, 63); const unsigned suf = tot - pre + sl;
        const unsigned long long bm = __ballot(suf >= TOPK);
        const int Ls = 63 - __builtin_clzll(bm);
        unsigned c = __builtin_amdgcn_readlane(suf, Ls) - __builtin_amdgcn_readlane(sl, Ls);
        const unsigned h3 = __builtin_amdgcn_readlane(h[3], Ls), h2 = __builtin_amdgcn_readlane(h[2], Ls), h1 = __builtin_amdgcn_readlane(h[1], Ls);
        int Bs;
        if (c + h3 >= TOPK) Bs = 4 * Ls + 3; else { c += h3; if (c + h2 >= TOPK) Bs = 4 * Ls + 2; else { c += h2; if (c + h1 >= TOPK) Bs = 4 * Ls + 1; else { c += h1; Bs = 4 * Ls; } } }
        const int need = TOPK - (int)c;
        if (Bs > 0) {
            int base = 0;
#pragma unroll
            for (int g = 0; g < 4; ++g) {
                if (8 * g <= jmax) {
#pragma unroll
                    for (int jj = 0; jj < 8; ++jj) { const int j = 8 * g + jj; const bool isc = bins[j] == (unsigned)Bs;
                        const unsigned long long m = __ballot(isc);
                        if (m) { const int pos = base + (int)__builtin_amdgcn_mbcnt_hi((unsigned)(m >> 32), __builtin_amdgcn_mbcnt_lo((unsigned)m, 0u)); if (isc && pos < 64) cand[pos] = v[j]; base += __builtin_popcountll(m); } } } }
            if (base <= 64) {
                asm volatile("s_waitcnt lgkmcnt(0)" ::: "memory");
                const float x = lane < base ? cand[lane] : NINF; int rank = 0;
                for (int m = 0; m < base; ++m) { const float y = __builtin_bit_cast(float, __builtin_amdgcn_readlane(__builtin_bit_cast(int, x), m)); rank += y > x ? 1 : 0; }
                float tc = (lane < base && rank <= need - 1) ? x : PINF;
                tau = -wave_max_dpp(-tc); have = true;
            }
        }
    }
    if (!have) {
        unsigned tk = 0u;
        for (int bit = 31; bit >= 0; --bit) { const unsigned cd = tk | (1u << bit); int cnt = 0;
#pragma unroll
            for (int j = 0; j < 32; ++j) cnt += __builtin_popcountll(__ballot((64 * j + lane <= t) && fkey(v[j]) >= cd));
            if (cnt >= TOPK) tk = cd; }
        tau = __builtin_bit_cast(float, (tk & 0x80000000u) ? (tk ^ 0x80000000u) : ~tk);
    }
    unsigned wlo = 0u, whi = 0u;
#pragma unroll
    for (int g = 0; g < 4; ++g) {
        if (8 * g <= jmax) {
#pragma unroll
            for (int jj = 0; jj < 8; ++jj) { const int j = 8 * g + jj; const unsigned long long m = __ballot(v[j] >= tau);
                if (lane == j) { wlo = (unsigned)m; whi = (unsigned)(m >> 32); } } } }
    if (lane < 32) __hip_atomic_store(mrow + lane, ((unsigned long long)whi << 32) | wlo, __ATOMIC_RELAXED, __HIP_MEMORY_SCOPE_AGENT);
}

__device__ __forceinline__ void wave_topk_mask2(const LAS float* rowA, const LAS float* rowB, int tA, GAS unsigned long long* mrowA, GAS unsigned long long* mrowB, int lane, LAS unsigned* hist, LAS float* cand) {
    const float NINF = -__builtin_inff(), PINF = __builtin_inff();
    const int tB = tA + 1, jmax = tB >> 6;
    const int remA = tA - lane, remB = tB - lane;
    float vA[32], vB[32]; float mxA = NINF, mnA = PINF, mxB = NINF, mnB = PINF;
#pragma unroll
    for (int g = 0; g < 4; ++g) {
        if (8 * g <= jmax) {
#pragma unroll
            for (int jj = 0; jj < 8; ++jj) { const int j = 8 * g + jj; const float xA = rowA[64 * j + lane], xB = rowB[64 * j + lane]; const bool okA = 64 * j <= remA, okB = 64 * j <= remB;
                vA[j] = okA ? xA : NINF; mxA = fmaxf(mxA, vA[j]); mnA = fminf(mnA, okA ? xA : PINF);
                vB[j] = okB ? xB : NINF; mxB = fmaxf(mxB, vB[j]); mnB = fminf(mnB, okB ? xB : PINF); }
        } else {
#pragma unroll
            for (int jj = 0; jj < 8; ++jj) { vA[8 * g + jj] = NINF; vB[8 * g + jj] = NINF; } } }
    mxA = wave_max_dpp(mxA); mxB = wave_max_dpp(mxB); mnA = -wave_max_dpp(-mnA); mnB = -wave_max_dpp(-mnB);
    *(LAS u32x4*)(hist + 4 * lane) = (u32x4){0u, 0u, 0u, 0u};
    const float scA = 255.5f / (mxA - mnA), ofA = -mnA * scA, scB = 255.5f / (mxB - mnB), ofB = -mnB * scB;
    float tauA = 0.f, tauB = 0.f; bool haveA = false, haveB = false;
#define BIN_OF(x_, sc_, of_) ({ unsigned b_ = (unsigned)fmaf((x_), (sc_), (of_)); b_ > 255u ? 255u : b_; })
    if (mxA > mnA && mxB > mnB) {
        asm volatile("s_waitcnt lgkmcnt(0)" ::: "memory");
#pragma unroll
        for (int g = 0; g < 4; ++g) {
            if (8 * g <= jmax) {
#pragma unroll
                for (int jj = 0; jj < 8; ++jj) { const int j = 8 * g + jj;
                    __hip_atomic_fetch_add(hist + BIN_OF(vA[j], scA, ofA), 1u, __ATOMIC_RELAXED, __HIP_MEMORY_SCOPE_WORKGROUP);
                    __hip_atomic_fetch_add(hist + BIN_OF(vB[j], scB, ofB), 0x10000u, __ATOMIC_RELAXED, __HIP_MEMORY_SCOPE_WORKGROUP); } } }
        asm volatile("s_waitcnt lgkmcnt(0)" ::: "memory");
        const u32x4 h = *(const LAS u32x4*)(hist + 4 * lane);
        const unsigned a0 = h[0] & 0xffffu, a1 = h[1] & 0xffffu, a2 = h[2] & 0xffffu, a3 = h[3] & 0xffffu, b0 = h[0] >> 16, b1 = h[1] >> 16, b2 = h[2] >> 16, b3 = h[3] >> 16;
        const unsigned slA = a0 + a1 + a2 + a3, slB = b0 + b1 + b2 + b3; const unsigned preA = wave_scan_dpp(slA), preB = wave_scan_dpp(slB);
        const unsigned sufA = __builtin_amdgcn_readlane(preA, 63) - preA + slA, sufB = __builtin_amdgcn_readlane(preB, 63) - preB + slB;
        const unsigned long long bmA = __ballot(sufA >= TOPK), bmB = __ballot(sufB >= TOPK);
        const int LA = 63 - __builtin_clzll(bmA), LB = 63 - __builtin_clzll(bmB);
        int BsA, BsB, needA, needB;
        { unsigned c = __builtin_amdgcn_readlane(sufA, LA) - __builtin_amdgcn_readlane(slA, LA);
          const unsigned h3 = __builtin_amdgcn_readlane(a3, LA), h2 = __builtin_amdgcn_readlane(a2, LA), h1 = __builtin_amdgcn_readlane(a1, LA);
          if (c + h3 >= TOPK) BsA = 4 * LA + 3; else { c += h3; if (c + h2 >= TOPK) BsA = 4 * LA + 2; else { c += h2; if (c + h1 >= TOPK) BsA = 4 * LA + 1; else { c += h1; BsA = 4 * LA; } } }
          needA = TOPK - (int)c; }
        { unsigned c = __builtin_amdgcn_readlane(sufB, LB) - __builtin_amdgcn_readlane(slB, LB);
          const unsigned h3 = __builtin_amdgcn_readlane(b3, LB), h2 = __builtin_amdgcn_readlane(b2, LB), h1 = __builtin_amdgcn_readlane(b1, LB);
          if (c + h3 >= TOPK) BsB = 4 * LB + 3; else { c += h3; if (c + h2 >= TOPK) BsB = 4 * LB + 2; else { c += h2; if (c + h1 >= TOPK) BsB = 4 * LB + 1; else { c += h1; BsB = 4 * LB; } } }
          needB = TOPK - (int)c; }
        int baseA = 65, baseB = 65;
        if (BsA > 0) { baseA = 0;
#pragma unroll
            for (int g = 0; g < 4; ++g) {
                if (8 * g <= jmax) {
#pragma unroll
                    for (int jj = 0; jj < 8; ++jj) { const int j = 8 * g + jj; const bool isc = BIN_OF(vA[j], scA, ofA) == (unsigned)BsA;
                        const unsigned long long m = __ballot(isc);
                        if (m) { const int pos = baseA + (int)__builtin_amdgcn_mbcnt_hi((unsigned)(m >> 32), __builtin_amdgcn_mbcnt_lo((unsigned)m, 0u)); if (isc && pos < 64) cand[pos] = vA[j]; baseA += __builtin_popcountll(m); } } } } }
        if (BsB > 0) { baseB = 0;
#pragma unroll
            for (int g = 0; g < 4; ++g) {
                if (8 * g <= jmax) {
#pragma unroll
                    for (int jj = 0; jj < 8; ++jj) { const int j = 8 * g + jj; const bool isc = BIN_OF(vB[j], scB, ofB) == (unsigned)BsB;
                        const unsigned long long m = __ballot(isc);
                        if (m) { const int pos = baseB + (int)__builtin_amdgcn_mbcnt_hi((unsigned)(m >> 32), __builtin_amdgcn_mbcnt_lo((unsigned)m, 0u)); if (isc && pos < 64) cand[64 + pos] = vB[j]; baseB += __builtin_popcountll(m); } } } } }
        asm volatile("s_waitcnt lgkmcnt(0)" ::: "memory");
        if (baseA <= 64) { const float x = lane < baseA ? cand[lane] : NINF; int rank = 0;
            for (int m = 0; m < baseA; ++m) { const float y = __builtin_bit_cast(float, __builtin_amdgcn_readlane(__builtin_bit_cast(int, x), m)); rank += y > x ? 1 : 0; }
            const float tc = (lane < baseA && rank <= needA - 1) ? x : PINF; tauA = -wave_max_dpp(-tc); haveA = true; }
        if (baseB <= 64) { const float x = lane < baseB ? cand[64 + lane] : NINF; int rank = 0;
            for (int m = 0; m < baseB; ++m) { const float y = __builtin_bit_cast(float, __builtin_amdgcn_readlane(__builtin_bit_cast(int, x), m)); rank += y > x ? 1 : 0; }
            const float tc = (lane < baseB && rank <= needB - 1) ? x : PINF; tauB = -wave_max_dpp(-tc); haveB = true; }
    }
#undef BIN_OF
    if (haveA) { unsigned wlo = 0u, whi = 0u;
#pragma unroll
        for (int g = 0; g < 4; ++g) {
            if (8 * g <= jmax) {
#pragma unroll
                for (int jj = 0; jj < 8; ++jj) { const int j = 8 * g + jj; const unsigned long long m = __ballot(vA[j] >= tauA);
                    if (lane == j) { wlo = (unsigned)m; whi = (unsigned)(m >> 32); } } } }
        if (lane < 32) __hip_atomic_store(mrowA + lane, ((unsigned long long)whi << 32) | wlo, __ATOMIC_RELAXED, __HIP_MEMORY_SCOPE_AGENT); }
    if (haveB) { unsigned wlo = 0u, whi = 0u;
#pragma unroll
        for (int g = 0; g < 4; ++g) {
            if (8 * g <= jmax) {
#pragma unroll
                for (int jj = 0; jj < 8; ++jj) { const int j = 8 * g + jj; const unsigned long long m = __ballot(vB[j] >= tauB);
                    if (lane == j) { wlo = (unsigned)m; whi = (unsigned)(m >> 32); } } } }
        if (lane < 32) __hip_atomic_store(mrowB + lane, ((unsigned long long)whi << 32) | wlo, __ATOMIC_RELAXED, __HIP_MEMORY_SCOPE_AGENT); }
    if (!haveA) wave_topk_mask(rowA, tA, mrowA, lane, hist, cand);
    if (!haveB) wave_topk_mask(rowB, tB, mrowB, lane, hist, cand);
}

#define RELU_FMA(acc_, c_, w_) do { const float f_ = (c_); const int i_ = __builtin_bit_cast(int, f_); const float r_ = __builtin_bit_cast(float, i_ > 0 ? i_ : 0); asm("v_fmac_f32_e32 %0, %1, %2" : "+v"(acc_) : "v"(r_), "v"(w_)); } while (0)
__device__ __forceinline__ void p2_index_tile(const Args& a, LAS unsigned char* lds, int b, int t0, int wave, int lane) {
    const GAS f16* QI = (const GAS f16*)(a.ws + WS_QI); const GAS float* WI = (const GAS float*)(a.ws + WS_WI); const GAS f16* KI = (const GAS f16*)(a.ws + WS_KI);
    GAS unsigned long long* MASK = (GAS unsigned long long*)(a.ws + WS_MASK);
    LAS float* sc = (LAS float*)lds;
    const int fr = lane & 15, fq = lane >> 4; const size_t rowq = (size_t)b * S + t0 + fr;
    f16x8 qf[16][2]; float w[16];
#pragma unroll
    for (int h = 0; h < 16; ++h) { qf[h][0] = *(const GAS f16x8*)(QI + rowq * 1024 + h * 64 + 8 * fq); qf[h][1] = *(const GAS f16x8*)(QI + rowq * 1024 + h * 64 + 32 + 8 * fq); }
#pragma unroll
    for (int h = 0; h < 16; h += 4) { const f32x4 x = *(const GAS f32x4*)(WI + rowq * 16 + h); w[h] = x[0]; w[h + 1] = x[1]; w[h + 2] = x[2]; w[h + 3] = x[3]; }
    const int nkt = (t0 + 16) >> 4;
    const GAS f16* kp = KI + ((size_t)b * S + fr) * 64 + 8 * fq;
#define KLOAD(d0_, d1_, kt_) do { const int k_ = (kt_) < nkt ? (kt_) : wave; d0_ = *(const GAS f16x8*)(kp + (size_t)k_ * 1024); d1_ = *(const GAS f16x8*)(kp + (size_t)k_ * 1024 + 32); } while (0)
    f16x8 ka0, ka1, kb0, kb1, kc0, kc1;
#define KCOMP(kf0, kf1, kt_) do { float a0 = 0.f, a1 = 0.f, a2 = 0.f, a3 = 0.f; const f32x4 z4 = {0.f, 0.f, 0.f, 0.f}; \
        f32x4 cc = __builtin_amdgcn_mfma_f32_16x16x32_f16(kf0, qf[0][0], z4, 0, 0, 0); cc = __builtin_amdgcn_mfma_f32_16x16x32_f16(kf1, qf[0][1], cc, 0, 0, 0); \
        _Pragma("unroll") for (int h = 0; h < 16; ++h) { f32x4 cn = z4;        \
            if (h < 15) { cn = __builtin_amdgcn_mfma_f32_16x16x32_f16(kf0, qf[h + 1][0], z4, 0, 0, 0); cn = __builtin_amdgcn_mfma_f32_16x16x32_f16(kf1, qf[h + 1][1], cn, 0, 0, 0); } \
            RELU_FMA(a0, cc[0], w[h]); RELU_FMA(a1, cc[1], w[h]); RELU_FMA(a2, cc[2], w[h]); RELU_FMA(a3, cc[3], w[h]); \
            cc = cn; __builtin_amdgcn_sched_barrier(0); } \
        *(LAS f32x4*)(sc + fr * SC_STRIDE + 16 * (kt_) + 4 * fq) = (f32x4){a0, a1, a2, a3}; } while (0)
    for (int rpk = 0; rpk < P2_KT_REP; ++rpk) {
    KLOAD(ka0, ka1, wave); KLOAD(kb0, kb1, wave + NWAVES);
    for (int kt = wave; kt < nkt; kt += 3 * NWAVES) {
        KLOAD(kc0, kc1, kt + 2 * NWAVES); KCOMP(ka0, ka1, kt);
        if (kt + NWAVES < nkt) { KLOAD(ka0, ka1, kt + 3 * NWAVES); KCOMP(kb0, kb1, kt + NWAVES); }
        if (kt + 2 * NWAVES < nkt) { KLOAD(kb0, kb1, kt + 4 * NWAVES); KCOMP(kc0, kc1, kt + 2 * NWAVES); }
    } }
#undef KCOMP
#undef KLOAD
    __syncthreads();
#pragma unroll 1
    for (int qq = 0; qq < P2_SEL_REP; ++qq) { const int q = 2 * wave; const int t = t0 + q;
        wave_topk_mask2(sc + q * SC_STRIDE, sc + (q + 1) * SC_STRIDE, t, MASK + ((size_t)b * S + t) * 32, MASK + ((size_t)b * S + t + 1) * 32, lane,
                        (LAS unsigned*)(lds + WSCR_OFF + wave * WSCR_BYTES), (LAS float*)(lds + WSCR_OFF + wave * WSCR_BYTES + 1024)); }
    __syncthreads();
}

__device__ __forceinline__ void p2_phase(const Args& a, LAS unsigned char* lds, int vcu, int G, int wave, int lane) {
    unsigned* rdy = (unsigned*)a.ws + RDY_WORD0;
    const int skip = (G == 256) ? 32 : 0;
    if (vcu >= skip) { const int gw = (vcu - skip) * NWAVES + wave, NGW = (G - skip) * NWAVES;
      for (int rp = 0; rp < P2_REP_A; ++rp) p2_sscore(a, gw, NGW, lane);
      HOOK_5
      GAS unsigned long long* MASK = (GAS unsigned long long*)(a.ws + WS_MASK);
      for (int i = gw * 64 + lane; i < NB * TOPK * 32; i += NGW * 64) { const int wd = i & 31, t = (i >> 5) & (TOPK - 1), b = i >> 13; const int lo = 64 * wd;
          const unsigned long long m = lo + 63 <= t ? ~0ull : (lo > t ? 0ull : ((1ull << (t - lo + 1)) - 1ull));
          __hip_atomic_store(MASK + ((size_t)b * S + t) * 32 + wd, m, __ATOMIC_RELAXED, __HIP_MEMORY_SCOPE_AGENT); } }
    signal_add_wt(rdy + 64 * 32);
    HOOK_6
    constexpr int NT = NB * (S - TOPK) / 16;
    for (int rp = 0; rp < P2_REP_C; ++rp)
    for (int r = 0; r * G < NT; ++r) { const int k = (r & 1) ? (r + 1) * G - 1 - vcu : r * G + vcu;
        if (k < NT) { const int j = (NT / NB - 1) - (k >> 2), b = k & 3; p2_index_tile(a, lds, b, TOPK + 16 * j, wave, lane);
            if (rp == 0) signal_add_wt(rdy + 64 * (40 + b * 32 + ((TOPK + 16 * j) >> 6))); } }
}

#ifndef P3_REP_S
#define P3_REP_S 1
#define P3_REP_A 1
#endif
namespace att {
typedef short bf16x8 __attribute__((ext_vector_type(8)));
typedef short s16x4 __attribute__((ext_vector_type(4)));
typedef float f32x16 __attribute__((ext_vector_type(16)));
constexpr int QBLK = 32, KVBLK = 64, D = 128;
constexpr int SHM_V = KVBLK * D * 2, SHM_K = KVBLK * D * 2;
constexpr int WS_OFF = 2 * SHM_V + 2 * SHM_K;
constexpr float SCALE = 0.08838834764831845f;
#define KSWZ(row, colB) ((row) * 256 + ((colB) ^ (((row) & 7) << 4)))
#define SBAR() __builtin_amdgcn_sched_barrier(0)
__device__ __forceinline__ int v_st(int k, int c) { const int kk = (k & ~0xC) | ((k & 4) << 1) | ((k & 8) >> 1); return ((kk >> 3) * 4 + (c >> 5)) * 512 + ((kk & 7) * 32 + (c & 31)) * 2; }
__device__ __forceinline__ int v_rd_base(int lane) { return ((lane & 3) << 3) | (((lane >> 2) & 3) << 6) | (((lane >> 4) & 1) << 5) | (((lane >> 5) & 1) << 8); }
constexpr int v_rd_off(int d0, int ks, int half) { return d0 * 512 + ks * 4096 + half * 2048; }
__device__ __forceinline__ int crow(int r, int hi) { return (r & 3) + 8 * (r >> 2) + 4 * hi; }
__device__ __forceinline__ unsigned cvtpk(float lo, float hi) { return pk_bf16(lo, hi); }

template <int KB>
__device__ __forceinline__ void qkt(f32x16& p0, f32x16& p1, const LAS unsigned char* K_lds, int r32, int hi, const LAS unsigned char* qp) {
    p0 = f32x16{}; p1 = f32x16{};
    const LAS unsigned char* kb[4];
#pragma unroll
    for (int dd = 0; dd < 4; ++dd) kb[dd] = K_lds + KB * SHM_K + KSWZ(r32, (dd * 16 + hi * 8) * 2);
#pragma unroll
    for (int d0 = 0; d0 < 8; ++d0) { const LAS unsigned char* a = kb[d0 & 3] + (d0 >> 2) * 128;
        const bf16x8 b0 = *(const LAS bf16x8*)a;
        const bf16x8 b1 = *(const LAS bf16x8*)(a + 32 * 256);
        const bf16x8 qv = *(const LAS bf16x8*)(qp + d0 * 1024);
        p0 = __builtin_amdgcn_mfma_f32_32x32x16_bf16(b0, qv, p0, 0, 0, 0);
        p1 = __builtin_amdgcn_mfma_f32_32x32x16_bf16(b1, qv, p1, 0, 0, 0); }
}
template <int VB>
__device__ __forceinline__ void pv_tile(f32x16* o, int vb0, bf16x8 pa0, bf16x8 pa1, bf16x8 pa2, bf16x8 pa3) {
#define TRRD(dst, off) asm volatile("ds_read_b64_tr_b16 %0, %1 offset:%2" : "=&v"(dst) : "v"(vb0), "i"(off) : "memory")
#define PV_D0(d0) do { s16x4 l0, l1, l2, l3, h0, h1, h2, h3; constexpr int b_ = VB * SHM_V + v_rd_off(d0, 0, 0); \
        TRRD(l0, b_); TRRD(h0, b_ + 2048); TRRD(l1, b_ + 4096); TRRD(h1, b_ + 6144); TRRD(l2, b_ + 8192); TRRD(h2, b_ + 10240); TRRD(l3, b_ + 12288); TRRD(h3, b_ + 14336); \
        asm volatile("s_waitcnt lgkmcnt(0)" ::: "memory"); SBAR(); \
        o[d0] = __builtin_amdgcn_mfma_f32_32x32x16_bf16(pa0, (bf16x8){l0[0], l0[1], l0[2], l0[3], h0[0], h0[1], h0[2], h0[3]}, o[d0], 0, 0, 0); \
        o[d0] = __builtin_amdgcn_mfma_f32_32x32x16_bf16(pa1, (bf16x8){l1[0], l1[1], l1[2], l1[3], h1[0], h1[1], h1[2], h1[3]}, o[d0], 0, 0, 0); \
        o[d0] = __builtin_amdgcn_mfma_f32_32x32x16_bf16(pa2, (bf16x8){l2[0], l2[1], l2[2], l2[3], h2[0], h2[1], h2[2], h2[3]}, o[d0], 0, 0, 0); \
        o[d0] = __builtin_amdgcn_mfma_f32_32x32x16_bf16(pa3, (bf16x8){l3[0], l3[1], l3[2], l3[3], h3[0], h3[1], h3[2], h3[3]}, o[d0], 0, 0, 0); } while (0)
    PV_D0(0); PV_D0(1); PV_D0(2); PV_D0(3);
#undef PV_D0
#undef TRRD
}
__device__ __forceinline__ void partialSM(f32x16& p0, f32x16& p1, unsigned wl, unsigned wh, float sh2) {
    const float NEG = -__builtin_inff(); constexpr float C2 = 1.4426950408889634f * SCALE;
#pragma unroll
    for (int r = 0; r < 16; ++r) { const unsigned bit = 1u << ((r & 3) + 8 * (r >> 2));
        p0[r] = (wl & bit) ? fmaf(p0[r], C2, -sh2) : NEG; p1[r] = (wh & bit) ? fmaf(p1[r], C2, -sh2) : NEG; }
#pragma unroll
    for (int r = 0; r < 16; ++r) p0[r] = __builtin_amdgcn_exp2f(p0[r]);
}
__device__ __forceinline__ void finishSM(f32x16& p0, f32x16& p1, float& l_reg, bf16x8& pa0, bf16x8& pa1, bf16x8& pa2, bf16x8& pa3) {
#pragma unroll
    for (int r = 0; r < 16; ++r) p1[r] = __builtin_amdgcn_exp2f(p1[r]);
    float ps = 0;
#pragma unroll
    for (int r = 0; r < 16; ++r) ps += p0[r];
#pragma unroll
    for (int r = 0; r < 16; ++r) ps += p1[r];
    l_reg += ps;
#define PK4(P, B_, OUT) do { unsigned a0 = cvtpk(P[B_+0], P[B_+1]), a1 = cvtpk(P[B_+2], P[B_+3]); \
        unsigned b0 = cvtpk(P[B_+4], P[B_+5]), b1 = cvtpk(P[B_+6], P[B_+7]); \
        auto r0 = __builtin_amdgcn_permlane32_swap(a0, b0, false, false); auto r1 = __builtin_amdgcn_permlane32_swap(a1, b1, false, false); \
        u32x4 w = {r0[0], r1[0], r0[1], r1[1]}; OUT = __builtin_bit_cast(bf16x8, w); } while (0)
    PK4(p0, 0, pa0); PK4(p0, 8, pa1); PK4(p1, 0, pa2); PK4(p1, 8, pa3);
#undef PK4
}

__device__ __forceinline__ __amdgpu_buffer_rsrc_t mk_rsrc(const GAS void* p, unsigned bytes) {
    const unsigned long long u = (unsigned long long)p; const unsigned lo = __builtin_amdgcn_readfirstlane((unsigned)u), hi = __builtin_amdgcn_readfirstlane((unsigned)(u >> 32));
    return __builtin_amdgcn_make_buffer_rsrc((void*)(((unsigned long long)hi << 32) | lo), (short)0, (int)bytes, 0x00020000);
}
__device__ __forceinline__ void attn_block(const Args& a, LAS unsigned char* lds, int b, int kvh, int q0, float sh2) {
    int tid_ = threadIdx.x; asm volatile("" : "+v"(tid_));
    const int tid = tid_, wid = __builtin_amdgcn_readfirstlane(tid >> 6), lane = tid & 63, r32 = lane & 31, hi = lane >> 5;
    const int head = 4 * kvh + (wid >> 1), qw = q0 + 32 * (wid & 1);
    const GAS bf16_t* Qw = (const GAS bf16_t*)(a.ws + WS_QB) + (((size_t)b * NH + head) * S + qw) * D;
    const GAS bf16_t* Kh = (const GAS bf16_t*)(a.ws + WS_KB) + ((size_t)b * NKV + kvh) * S * D;
    const GAS bf16_t* Vh = (const GAS bf16_t*)(a.ws + WS_VB) + ((size_t)b * NKV + kvh) * S * D;
    const __amdgpu_buffer_rsrc_t rK = mk_rsrc(Kh, S * D * 2), rV = mk_rsrc(Vh, S * D * 2), rM = mk_rsrc((const GAS unsigned long long*)(a.ws + WS_MASK) + ((size_t)b * S + qw) * 32, 32 * 256);
    const unsigned moff = (unsigned)r32 * 256u;
    const int NT = q0 / KVBLK + 1;
    LAS unsigned char* V_lds = lds; LAS unsigned char* K_lds = lds + 2 * SHM_V;
    const int sr = tid >> 4, sc = (tid & 15) * 8, vst0 = v_st(sr, sc), vst1 = v_st(32 + sr, sc), kws = KSWZ(sr, sc * 2);
    const int vb0 = (int)(unsigned)(size_t)V_lds + v_rd_base(lane); const unsigned kvoff = (unsigned)(sr * D + sc) * 2u;
    bf16x8 sA_v0, sA_v1, sA_k0, sA_k1, sB_v0, sB_v1, sB_k0, sB_k1;
    LAS unsigned char* qp = lds + WS_OFF + 2048 + wid * 8192 + lane * 16;
#define VMW() asm volatile("s_waitcnt vmcnt(0)" ::: "memory")
#define BL128(r_, so_) __builtin_bit_cast(bf16x8, __builtin_amdgcn_raw_buffer_load_b128(r_, kvoff, (so_), 0))
#define SLOAD_S(S_, k0) do { const int so_ = (k0) * 256; S_##_v0 = BL128(rV, so_); S_##_v1 = BL128(rV, so_ + 8192); S_##_k0 = BL128(rK, so_); S_##_k1 = BL128(rK, so_ + 8192); } while (0)
#define SWRITE_S(S_, bf) do { *(LAS bf16x8*)(V_lds + (bf) * SHM_V + vst0) = S_##_v0; *(LAS bf16x8*)(V_lds + (bf) * SHM_V + vst1) = S_##_v1; \
        *(LAS bf16x8*)(K_lds + (bf) * SHM_K + kws) = S_##_k0; *(LAS bf16x8*)(K_lds + (bf) * SHM_K + kws + 32 * 256) = S_##_k1; } while (0)
#define MLOAD(t) __builtin_bit_cast(unsigned long long, __builtin_amdgcn_raw_buffer_load_b64(rM, moff, (t) * 8, 16))
#define MSPLIT(mw, wl, wh) do { wl = (unsigned)(mw) >> (4 * hi); wh = (unsigned)((mw) >> 32) >> (4 * hi); } while (0)
    { bf16x8 qt[8];
#pragma unroll
      for (int d0 = 0; d0 < 8; ++d0) qt[d0] = *(const GAS bf16x8*)(Qw + (unsigned)(r32 * D + d0 * 16 + hi * 8));
#pragma unroll
      for (int d0 = 0; d0 < 8; ++d0) *(LAS bf16x8*)(qp + d0 * 1024) = qt[d0]; }
    SLOAD_S(sA, 0); unsigned long long mwA = MLOAD(0), mwB = 0ull; VMW(); SWRITE_S(sA, 0);
    SLOAD_S(sB, KVBLK); mwB = MLOAD(1); SLOAD_S(sA, 2 * KVBLK);
    __syncthreads();
    float l_reg = 0.f; f32x16 o[4] = {};
    f32x16 p0, p1; bf16x8 pa0, pa1, pa2, pa3; unsigned wl, wh;
    SBAR(); qkt<0>(p0, p1, K_lds, r32, hi, qp);
    MSPLIT(mwA, wl, wh); partialSM(p0, p1, wl, wh, sh2);
    if (NT > 1) { SWRITE_S(sB, 1); }
    __syncthreads();
#define STEP(t, KB, VB, SW, SL) do { \
        finishSM(p0, p1, l_reg, pa0, pa1, pa2, pa3); SBAR(); \
        mwA = MLOAD((t) + 1); SLOAD_S(SL, ((t) + 2) * KVBLK); SBAR();        \
        pv_tile<VB>(o, vb0, pa0, pa1, pa2, pa3); SBAR(); \
        qkt<KB>(p0, p1, K_lds, r32, hi, qp); \
        MSPLIT(mwB, wl, wh); partialSM(p0, p1, wl, wh, sh2); mwB = mwA; \
        __syncthreads(); \
        if ((t) + 1 < NT) { SWRITE_S(SW, VB); } \
        __syncthreads(); } while (0)
    int t = 1;
    for (; t + 1 < NT; t += 2) { STEP(t, 1, 0, sA, sB); STEP(t + 1, 0, 1, sB, sA); }
    if (t < NT) { STEP(t, 1, 0, sA, sB); }
    finishSM(p0, p1, l_reg, pa0, pa1, pa2, pa3); SBAR();
    if ((NT - 1) & 1) pv_tile<1>(o, vb0, pa0, pa1, pa2, pa3); else pv_tile<0>(o, vb0, pa0, pa1, pa2, pa3);
    { auto rr = __builtin_amdgcn_permlane32_swap(__float_as_uint(l_reg), __float_as_uint(l_reg), false, false); l_reg = __uint_as_float(rr[0]) + __uint_as_float(rr[1]); }
    { int te = threadIdx.x; asm volatile("" : "+v"(te));
      const int le = te & 63, r32e = le & 31, hie = le >> 5;
      LAS float* wse = (LAS float*)(lds + WS_OFF) + wid * 64;
      if (hie == 0) wse[r32e] = l_reg;
      asm volatile("s_waitcnt lgkmcnt(0)" ::: "memory");
      __syncthreads();
      LAS f16* stg = (LAS f16*)(lds + wid * 8192);
#pragma unroll
      for (int r = 0; r < 16; ++r) { const int orow = crow(r, hie); const float rl = __builtin_amdgcn_rcpf(wse[orow]);
#pragma unroll
          for (int d0 = 0; d0 < 4; ++d0) stg[orow * 128 + d0 * 32 + r32e] = (f16)(o[d0][r] * rl); }
      asm volatile("s_waitcnt lgkmcnt(0)" ::: "memory");
      const GAS f16* SZ = (const GAS f16*)(a.ws + WS_SZ) + ((size_t)b * S + qw) * 1024 + head * 128; GAS f16* MIX = (GAS f16*)(a.ws + WS_MIX) + ((size_t)b * S + qw) * 2048 + head * 128;
#pragma unroll
      for (int i = 0; i < 8; ++i) { const int c = le + 64 * i, row = c >> 4, ch = c & 15;
          const f16x8 ov = *(const LAS f16x8*)(stg + row * 128 + ch * 8); const f16x8 zv = *(const GAS f16x8*)(SZ + (unsigned)(row * 1024 + ch * 8));
          const f16x8 mv_ = ov * zv; st16_wt((GAS void*)(MIX + (unsigned)(row * 2048 + ch * 8)), __builtin_bit_cast(u32x4, mv_)); } }
    asm volatile("s_waitcnt lgkmcnt(0)" ::: "memory");
    __syncthreads();
#undef BL128
#undef VMW
#undef SLOAD_S
#undef SWRITE_S
#undef MLOAD
#undef MSPLIT
#undef STEP
}
#undef KSWZ
#undef SBAR
}

__device__ __forceinline__ void p3_sample_item(const Args& a, LAS unsigned char* lds, int item, int tid) {
    const int qi = item >> 1, kvh = item & 1, sb = qi / NST, tl = qi % NST; constexpr int L = PAST + NST, PER = 33;
    const int lane = tid & 63, wave = __builtin_amdgcn_readfirstlane(tid >> 6);
    const GAS float* ck = (const GAS float*)a.in[2]; const GAS float* cv = (const GAS float*)a.in[3]; const GAS int* ptab = (const GAS int*)a.in[6]; const GAS float* out_ro = (const GAS float*)a.out;
    LAS float* q = (LAS float*)lds; LAS float* w = q + 1024; LAS float* newsc = w + 16; LAS float* ctl = newsc + 4; LAS float* red = ctl + 16;
    LAS unsigned* hist = (LAS unsigned*)(red + 32); LAS float* cand = (LAS float*)(hist + 256); LAS unsigned* cnt = (LAS unsigned*)(cand + 64);
    LAS unsigned* rid = cnt + 32; LAS float* qa = (LAS float*)(rid + 512); LAS float* sc = qa + 512; LAS float* inv = sc + 4 * 512; LAS float* part = inv + 4;
    LAS int* nsel = (LAS int*)(ctl + 8); LAS int* ncand = (LAS int*)(ctl + 9);
    const GAS f16* QI = (const GAS f16*)(a.ws + WS_QI) + (size_t)(MP + qi) * 1024; const GAS float* QS = (const GAS float*)(a.ws + WS_QS) + (size_t)qi * 1024 + kvh * 512;
    for (int i = tid; i < 1024; i += 512) q[i] = (float)QI[i];
    qa[tid] = QS[tid];
    if (tid < 16) w[tid] = ((const GAS float*)(a.ws + WS_WI))[(size_t)(MP + qi) * 16 + tid];
    if (tid < 32) cnt[tid] = 0u;
    if (tid < 256) hist[tid] = 0u;
    if (tid == 0) { *nsel = 0; *ncand = 0; }
    const GAS float* ssc = (const GAS float*)(a.ws + WS_SSC) + (size_t)qi * PAST;
    float v[PER];
#pragma unroll
    for (int j = 0; j < PER - 1; ++j) v[j] = __builtin_bit_cast(float, __hip_atomic_load((const GAS unsigned*)ssc + (j * 512 + tid), __ATOMIC_RELAXED, __HIP_MEMORY_SCOPE_AGENT));
    __syncthreads();
    if (tid < NST) { const GAS float* kr = out_ro + O_KIS + (size_t)(sb * NST + tid) * 64; float s = 0.f;
#pragma unroll 1
        for (int h = 0; h < 16; ++h) { float dsum = 0.f;
#pragma unroll 8
            for (int d = 0; d < 64; ++d) dsum += q[h * 64 + d] * kr[d];
            s += w[h] * fmaxf(dsum, 0.f); }
        newsc[tid] = s; }
    __syncthreads();
    const float NINF = -__builtin_inff(), PINF = __builtin_inff();
    { const int s = (PER - 1) * 512 + tid; v[PER - 1] = (s < L && (s - PAST) <= tl) ? newsc[s - PAST] : NINF; }
    float mx = NINF, mn = PINF;
#pragma unroll
    for (int j = 0; j < PER; ++j) { mx = fmaxf(mx, v[j]); mn = fminf(mn, v[j] == NINF ? PINF : v[j]); }
#pragma unroll
    for (int o = 1; o < 64; o <<= 1) { mx = fmaxf(mx, __shfl_xor(mx, o)); mn = fminf(mn, __shfl_xor(mn, o)); }
    if (lane == 0) { red[wave] = mx; red[8 + wave] = mn; }
    __syncthreads();
#pragma unroll
    for (int i = 0; i < 8; ++i) { mx = fmaxf(mx, red[i]); mn = fminf(mn, red[8 + i]); }
    const float scale = 255.5f / (mx - mn);
    float tau = 0.f; bool have = false;
    if (mx > mn) {
#pragma unroll
        for (int j = 0; j < PER; ++j) if (v[j] != NINF) { int bn = (int)((v[j] - mn) * scale); bn = bn > 255 ? 255 : bn; __hip_atomic_fetch_add(hist + bn, 1u, __ATOMIC_RELAXED, __HIP_MEMORY_SCOPE_WORKGROUP); }
        __syncthreads();
        if (wave == 0) {
            const u32x4 h = *(const LAS u32x4*)(hist + 4 * lane);
            const unsigned sl = h[0] + h[1] + h[2] + h[3]; unsigned pre = sl;
#pragma unroll
            for (int o = 1; o < 64; o <<= 1) { const unsigned y = __shfl_up(pre, o); if (lane >= o) pre += y; }
            const unsigned tot = __builtin_amdgcn_readlane(pre, 63); const unsigned suf = tot - pre + sl;
            const unsigned long long bm = __ballot(suf >= TOPK);
            const int Ls = 63 - __builtin_clzll(bm);
            unsigned c = __builtin_amdgcn_readlane(suf, Ls) - __builtin_amdgcn_readlane(sl, Ls);
            const unsigned h3 = __builtin_amdgcn_readlane(h[3], Ls), h2 = __builtin_amdgcn_readlane(h[2], Ls), h1 = __builtin_amdgcn_readlane(h[1], Ls);
            int Bs;
            if (c + h3 >= TOPK) Bs = 4 * Ls + 3; else { c += h3; if (c + h2 >= TOPK) Bs = 4 * Ls + 2; else { c += h2; if (c + h1 >= TOPK) Bs = 4 * Ls + 1; else { c += h1; Bs = 4 * Ls; } } }
            if (lane == 0) { ((LAS int*)ctl)[0] = Bs; ((LAS int*)ctl)[1] = TOPK - (int)c; }
        }
        __syncthreads();
        const int Bs = ((LAS int*)ctl)[0], need = ((LAS int*)ctl)[1];
#pragma unroll
        for (int j = 0; j < PER; ++j) if (v[j] != NINF) { int bn = (int)((v[j] - mn) * scale); bn = bn > 255 ? 255 : bn;
            if (bn == Bs) { const int p = __hip_atomic_fetch_add(ncand, 1, __ATOMIC_RELAXED, __HIP_MEMORY_SCOPE_WORKGROUP); if (p < 64) cand[p] = v[j]; } }
        __syncthreads();
        const int base = *ncand;
        if (base <= 64) {
            if (wave == 0) { const float x = lane < base ? cand[lane] : NINF; int rank = 0;
                for (int m = 0; m < base; ++m) { const float y = __builtin_bit_cast(float, __builtin_amdgcn_readlane(__builtin_bit_cast(int, x), m)); rank += y > x ? 1 : 0; }
                float tc = (lane < base && rank <= need - 1) ? x : PINF;
#pragma unroll
                for (int o = 1; o < 64; o <<= 1) tc = fminf(tc, __shfl_xor(tc, o));
                if (lane == 0) ctl[2] = tc; }
            __syncthreads();
            tau = ctl[2]; have = true;
        }
    }
    if (!have) {
        unsigned tk = 0u;
        for (int bit = 31; bit >= 0; --bit) { const unsigned cd = tk | (1u << bit); int c = 0;
#pragma unroll
            for (int j = 0; j < PER; ++j) c += __builtin_popcountll(__ballot(v[j] != NINF && fkey(v[j]) >= cd));
            if (lane == 0) __hip_atomic_fetch_add(cnt + bit, (unsigned)c, __ATOMIC_RELAXED, __HIP_MEMORY_SCOPE_WORKGROUP);
            __syncthreads();
            if (cnt[bit] >= TOPK) tk = cd; }
        tau = __builtin_bit_cast(float, (tk & 0x80000000u) ? (tk ^ 0x80000000u) : ~tk);
    }
#pragma unroll
    for (int j = 0; j < PER; ++j) { if (v[j] >= tau) { const int s = j * 512 + tid; const int p = __hip_atomic_fetch_add(nsel, 1, __ATOMIC_RELAXED, __HIP_MEMORY_SCOPE_WORKGROUP);
        if (p < 512) rid[p] = s < PAST ? (unsigned)(ptab[sb * NPAGES + (s >> 7)] * PAGE + (s & (PAGE - 1))) : (0x80000000u | (unsigned)(s - PAST)); } }
    __syncthreads();
    const int n = *nsel < 512 ? *nsel : 512;
    const int half = lane >> 5, l32 = lane & 31;
    { f32x4 qv[4];
#pragma unroll
      for (int h = 0; h < 4; ++h) qv[h] = *(const LAS f32x4*)(qa + h * 128 + 4 * l32);
      for (int j0 = 2 * wave; j0 < n; j0 += 128) { f32x4 kv[8]; int jj[8];
#pragma unroll
          for (int u = 0; u < 8; ++u) { jj[u] = j0 + 16 * u + half; const unsigned r = rid[jj[u] < n ? jj[u] : 0];
              const GAS float* kr = (r & 0x80000000u) ? out_ro + O_KS + ((size_t)(sb * NST + (r & 3u)) * NKV + kvh) * HD : ck + ((size_t)r * NKV + kvh) * HD;
              kv[u] = *(const GAS f32x4*)(kr + 4 * l32); }
#pragma unroll
          for (int u = 0; u < 8; ++u) { float d[4];
#pragma unroll
              for (int h = 0; h < 4; ++h) d[h] = half_sum_dpp((kv[u][0] * qv[h][0] + kv[u][1] * qv[h][1]) + (kv[u][2] * qv[h][2] + kv[u][3] * qv[h][3]));
              if (jj[u] < n && l32 >= 16 && l32 < 20) { const int hq = l32 & 3; sc[hq * 512 + jj[u]] = (hq == 0 ? d[0] : hq == 1 ? d[1] : hq == 2 ? d[2] : d[3]) * 0.08838834764831845f; } } } }
    __syncthreads();
    if (wave < 4) { LAS float* row = sc + wave * 512; float m2 = -1e30f;
      for (int j = lane; j < n; j += 64) m2 = fmaxf(m2, row[j]);
      m2 = wave_max_dpp(m2);
      float sm = 0.f;
      for (int j = lane; j < n; j += 64) { const float e = __expf(row[j] - m2); row[j] = e; sm += e; }
      sm = wave_sum_dpp(sm); if (lane == 0) inv[wave] = 1.f / sm; }
    __syncthreads();
    { f32x4 acc[4] = {};
      for (int j0 = 2 * wave; j0 < n; j0 += 128) { f32x4 vv[8]; int jj[8];
#pragma unroll
          for (int u = 0; u < 8; ++u) { jj[u] = j0 + 16 * u + half; const unsigned r = rid[jj[u] < n ? jj[u] : 0];
              const GAS float* vr = (r & 0x80000000u) ? out_ro + O_VS + ((size_t)(sb * NST + (r & 3u)) * NKV + kvh) * HD : cv + ((size_t)r * NKV + kvh) * HD;
              vv[u] = *(const GAS f32x4*)(vr + 4 * l32); }
#pragma unroll
          for (int u = 0; u < 8; ++u)
#pragma unroll
              for (int h = 0; h < 4; ++h) { const float p = jj[u] < n ? sc[h * 512 + jj[u]] : 0.f; acc[h] += vv[u] * p; } }
#pragma unroll
      for (int h = 0; h < 4; ++h) {
#pragma unroll
          for (int e = 0; e < 4; ++e) acc[h][e] += __shfl_xor(acc[h][e], 32);
          if (half == 0) *(LAS f32x4*)(part + (wave * 4 + h) * 128 + 4 * l32) = acc[h]; } }
    __syncthreads();
    { const GAS f16* SZ = (const GAS f16*)(a.ws + WS_SZ) + (size_t)(MP + qi) * 1024 + kvh * 512; GAS f16* MIX = (GAS f16*)(a.ws + WS_MIX) + (size_t)(MP + qi) * 2048 + kvh * 512;
      const int h = tid >> 7, d = tid & 127; float o = 0.f;
#pragma unroll
      for (int p = 0; p < 8; ++p) o += part[(p * 4 + h) * 128 + d];
      const float val = o * inv[h] * (float)SZ[tid]; const float nbv = __shfl_down(val, 1);
      if (!(tid & 1)) __hip_atomic_store((GAS unsigned*)(MIX + tid), pk_f16(val, nbv), __ATOMIC_RELAXED, __HIP_MEMORY_SCOPE_AGENT); }
    __syncthreads();
}

__device__ __forceinline__ void p3_phase(const Args& a, LAS unsigned char* lds, int vcu, int G, int tid) {
    float gm = 0.f, km = 0.f;
    for (int i = 0; i < HD; ++i) { gm = fmaxf(gm, fabsf(a.in[9][i])); km = fmaxf(km, fabsf(a.in[10][i])); }
    const float sh2 = fmaxf(0.f, 11.313708498984761f * gm * km - 20.f) * 1.4426950408889634f;
    wait_ge((unsigned*)a.ws + RDYB_WORD, (unsigned)G);
    for (int rp = 0; rp < P3_REP_S; ++rp)
    for (int sidx = G - 1 - vcu; sidx < 2 * MS; sidx += G) { wait_ge_wt((unsigned*)a.ws + RDY_WORD0 + 64 * 32, (unsigned)G); p3_sample_item(a, lds, sidx, tid); if (rp == 0) signal_add_wt((unsigned*)a.ws + RDY_WORD0 + 64 * 34); }
    HOOK_8
    HOOK_9
    for (int rp = 0; rp < P3_REP_A; ++rp)
    for (int k = vcu; k < 256; k += G) { const int i = 31 - (k >> 3), bk = k & 7;
        if (i >= 4) wait_ge_wt((unsigned*)a.ws + RDY_WORD0 + 64 * (40 + (bk >> 1) * 32 + i), 4u); else wait_ge_wt((unsigned*)a.ws + RDY_WORD0 + 64 * 32, (unsigned)G);
        att::attn_block(a, lds, bk >> 1, bk & 1, 64 * i, sh2);
        if (rp == 0) { asm volatile("s_waitcnt vmcnt(0)" ::: "memory"); __syncthreads(); if (tid == 0) (void)xb_add((unsigned*)a.ws + PMR_WORD0 + 64 * (8 * (bk >> 1) + (i >> 2)), 16u); } }
    { unsigned* qctr = (unsigned*)a.ws + CMQ_WORD; unsigned* srdy = (unsigned*)a.ws + RDY_WORD0 + 64 * 34; LAS int* cq = (LAS int*)(lds + MISC_OFF + 168); const int wave = tid >> 6, lane = tid & 63;
      constexpr int NCH = MT / 16;
      unsigned nxt = 0u; if (tid == 0) nxt = xb_add(qctr, 1u);
      for (int it = 0;; ++it) {
          if (tid == 0) { cq[it & 1] = (int)nxt; nxt = xb_add(qctr, 1u); }
          __syncthreads();
          const int c = cq[it & 1];
          if (c < NCH) { const int ch = NCH - 1 - c; convmix_task(a, 4 * ch + (wave >> 1), wave & 1, lane);
              if (16 * ch >= MP) signal_add_wt(srdy);
              else { asm volatile("s_waitcnt vmcnt(0)" ::: "memory"); if (lane == 0) (void)xb_add((unsigned*)a.ws + PMR_WORD0 + 64 * (ch >> 4), 1u); } }
          else if (c < NCH + DM / 8) { wait_ge_wt(srdy, 2u * MS + (unsigned)(MT - MP) / 16u); p4_item(a, lds, c - NCH, tid); }
          else break; } }
}

__global__ void __launch_bounds__(NWAVES * 64, 2) mk_fwd(Args a) {
    extern __shared__ __attribute__((aligned(16))) unsigned char lds_raw[];
    LAS unsigned char* lds = (LAS unsigned char*)lds_raw;
    const int tid = threadIdx.x, lane = tid & 63, wave = __builtin_amdgcn_readfirstlane(tid >> 6);
    const int G = gridDim.x; const int bx = blockIdx.x; const int vcu = (G % 8 == 0) ? (bx % 8) * (G / 8) + bx / 8 : bx;
    volatile LAS unsigned* MISC = (volatile LAS unsigned*)(lds + MISC_OFF);
    if (tid < 64) MISC[tid] = 0u;
    __syncthreads();
    XcdBarrier bar = xcd_barrier_post((unsigned*)a.ws, MISC + 8);
    int vcu2 = vcu;
    { int t_ = threadIdx.x; asm volatile("" : "+v"(t_)); const int lane = t_ & 63, wave = __builtin_amdgcn_readfirstlane(t_ >> 6); HOOK_0 p0_prologue(a, lds, vcu, G, wave, lane); HOOK_1 }
    xcd_barrier(bar);
    { pg8::Gemm g{(const f16*)(a.ws + WS_XNH), (const f16*)(a.ws + WS_WINT), DM};
      pg8::StaticOrder S; S.init(MPAD / 256, NPAD / 256, G, bx, 2);
      EpiIn E{a.out, a.ws, a.in[9], a.in[10], a.in[11], (LAS float*)(lds + SCR_OFF)};
      HOOK_2 pg8::gemm_phase<EpiIn, pg8::StaticOrder>(lds, g, S, E); HOOK_3 }
    { int t_ = threadIdx.x; asm volatile("" : "+v"(t_)); const int lane = t_ & 63, wave = __builtin_amdgcn_readfirstlane(t_ >> 6);
      signal_add((unsigned*)a.ws + RDYB_WORD); if (threadIdx.x == 0) MISC[44] = xb_add((unsigned*)a.ws + TICKET_WORD, 1u); __syncthreads(); vcu2 = (int)MISC[44]; wait_ge_wt((unsigned*)a.ws + RDYA_WORD, (unsigned)(MPAD / 256) * 5u * NWAVES);
      HOOK_4 p2_phase(a, lds, vcu2, G, wave, lane); HOOK_7 }
    { int t_ = threadIdx.x; asm volatile("" : "+v"(t_)); p3_phase(a, lds, vcu2, G, t_); HOOK_10 }
    { pg8::Gemm g{(const f16*)(a.ws + WS_MIX), (const f16*)(a.ws + WS_WOUTT), DM};
      pg8::StaticOrder S; S.init(MP / 256, DM / 256, G, bx);
      EpiOut E{a.out, a.in[0]};
      f32x4 accp[2][2][4][2]; { pg8::Unit u0; int t0_ = threadIdx.x; asm volatile("" : "+v"(t0_)); const int w0_ = __builtin_amdgcn_readfirstlane(t0_ >> 6), l0_ = t0_ & 63;
          if (S.next(0, u0)) E.init(accp, u0, w0_ >> 2, w0_ & 3, l0_ & 15, l0_ >> 4); }
      { pg8::Unit uw_; for (int i_ = 0; S.next(i_, uw_); ++i_) wait_ge_wt((unsigned*)a.ws + PMR_WORD0 + 64 * uw_.pm, 256u); }
      HOOK_11 pg8::gemm_phase<EpiOut, pg8::StaticOrder, true>(lds, g, S, E, accp); HOOK_12
      HOOK_13 }
}

#ifndef PROG
#define PROG 0x11111u
#endif
extern "C" void kernel_launch(void* const* d_in, const int* in_sizes, int n_in, void* d_out, int out_size, void* d_ws, size_t ws_size, hipStream_t stream) {
    static int grid = 0;
    if (grid == 0) {
        if (ws_size < WS_NEED2 || out_size != (int)O_END || n_in != 14) { fprintf(stderr, "kernel_launch: ws %zu (need %zu) out %d (want %zu) n_in %d\n", ws_size, (size_t)WS_NEED2, out_size, (size_t)O_END, n_in); grid = -1; return; }
        int dev = 0, cus = 0; hipGetDevice(&dev); hipDeviceGetAttribute(&cus, hipDeviceAttributeMultiprocessorCount, dev);
        if (hipFuncSetAttribute((const void*)mk_fwd, hipFuncAttributeMaxDynamicSharedMemorySize, LDS_BYTES) != hipSuccess) { fprintf(stderr, "kernel_launch: hipFuncSetAttribute failed\n"); grid = -1; return; }
        int per_cu = 0; hipOccupancyMaxActiveBlocksPerMultiprocessor(&per_cu, (const void*)mk_fwd, NWAVES * 64, LDS_BYTES); (void)hipGetLastError();
        if (per_cu < 1) fprintf(stderr, "kernel_launch: occupancy query says %d blocks per CU\n", per_cu);
        grid = cus > 0 ? cus : 256;
    }
    if (grid < 0) return;
    float* out = (float*)d_out; unsigned char* ws = (unsigned char*)d_ws;
    Args a{};
    for (int i = 0; i < 14; ++i) a.in[i] = (const float*)d_in[i];
    a.out = out; a.ws = ws;
    if (hipMemsetAsync(ws, 0, 131072, stream) != hipSuccess) { fprintf(stderr, "kernel_launch: memset of the control words failed\n"); return; }
    a.ph_lo = (int)PROG; a.ph_hi = 0; hipLaunchKernelGGL(mk_fwd, dim3(grid), dim3(NWAVES * 64), LDS_BYTES, stream, a);
}
```

```cpp
#include <hip/hip_runtime.h>
#include <cstdio>
#include <cstdint>
#include <cmath>

typedef _Float16 f16;
typedef unsigned short bf16_t;

constexpr int DM = 2048, NB = 4, S = 2048, NSB = 8, NST = 4, PAST = 16384, PAGE = 128, NPAGES = PAST / PAGE;
constexpr int MP = NB * S;
constexpr int MS = NSB * NST;
constexpr int MT = MP + MS;
constexpr int DIN = 7760;
constexpr int OQ = 0, OKK = 1024, OV = 1280, OZ = 1536, OQI = 2560, OKI = 3584, OWI = 3648, OH = 3664, OBB = 4688, OC = 5712, OZC = 6736;
constexpr int NH = 8, NKV = 2, HD = 128, NIH = 16, ID = 64, TOPK = 256, DC = 1024;
constexpr float EPS = 1e-6f;
constexpr size_t O_YP = 0, O_YS = 16777216, O_KP = 16842752, O_VP = 18939904, O_KIP = 21037056, O_CVP = 21561344,
                 O_KS = 21569536, O_VS = 21577728, O_KIS = 21585920, O_CVS = 21587968, O_END = 21604352;
constexpr size_t MiB = 1u << 20;
constexpr size_t WS_ROPE = 1 * MiB;
constexpr size_t WS_ROPE_I = WS_ROPE + 2052 * 32 * 4;
constexpr size_t WS_QB = 2 * MiB;
constexpr size_t WS_KB = 18 * MiB;
constexpr size_t WS_VB = 22 * MiB;
constexpr size_t WS_SZ = 26 * MiB;
constexpr size_t WS_QI = 43 * MiB;
constexpr size_t WS_KI = 60 * MiB;
constexpr size_t WS_WI = 61 * MiB;
constexpr size_t WS_U = 62 * MiB;
constexpr size_t WS_G = 79 * MiB;
constexpr size_t WS_MIX = 96 * MiB;
constexpr size_t WS_MASK = 130 * MiB;
constexpr size_t WS_SSC = 132 * MiB;
constexpr size_t WS_QS = 134 * MiB;
constexpr size_t WS_XN = 136 * MiB;
constexpr size_t WS_P = 202 * MiB;
constexpr size_t WS_NEED = 448 * MiB;

__device__ __forceinline__ bf16_t f2bf(float f) { unsigned u = __builtin_bit_cast(unsigned, f); return (bf16_t)((u + 0x7fffu + ((u >> 16) & 1u)) >> 16); }
__device__ __forceinline__ float bf2f(bf16_t h) { return __builtin_bit_cast(float, (unsigned)h << 16); }
__device__ __forceinline__ float silu(float z) { return z * __builtin_amdgcn_rcpf(1.f + __builtin_amdgcn_exp2f(-1.4426950408889634f * z)); }
__device__ __forceinline__ unsigned fkey(float f) { unsigned u = __builtin_bit_cast(unsigned, f); return (u & 0x80000000u) ? ~u : (u | 0x80000000u); }

#define P0_REP_T 1
#define P0_REP_X 1
#define P3_REP_S 1
#define P3_REP_A 1
#define P2_KT_REP 1
#define P2_SEL_REP 1
#define P2_REP_A 1
#define P2_REP_B 1
#define P2_REP_C 1
#define LAS __attribute__((address_space(3)))
#define GAS __attribute__((address_space(1)))
typedef _Float16 f16x8 __attribute__((ext_vector_type(8)));
typedef _Float16 f16x4 __attribute__((ext_vector_type(4)));
typedef _Float16 f16x2 __attribute__((ext_vector_type(2)));
typedef float f32x4 __attribute__((ext_vector_type(4)));
typedef float f32x2 __attribute__((ext_vector_type(2)));
typedef unsigned u32x4 __attribute__((ext_vector_type(4)));
typedef unsigned u32x2 __attribute__((ext_vector_type(2)));
typedef __bf16 bf16x2_t __attribute__((ext_vector_type(2)));
__device__ __forceinline__ void st16_wt(GAS void* p, u32x4 v) { asm volatile("global_store_dwordx4 %0, %1, off sc0 sc1\n\ts_nop 1" :: "v"(p), "v"(v) : "memory"); }
namespace pg8 {
constexpr int BM = 256, BK = 64, HALF = 128, HTB = HALF * BK * 2, STAGE_BYTES = 8 * HTB, NXCD = 8, WGM = 8;
__host__ __device__ __forceinline__ int lds_byte(int r, int c) { const int st = (r >> 4) * 2 + (c >> 5), rr = r & 15, cc = c & 31, ob = rr * 64 + cc * 2; return st * 1024 + (ob ^ (((ob >> 9) & 1) << 5)); }
__host__ __device__ __forceinline__ void stage_rc(int b, int& R, int& C) { const int st = b / 1024, sb = b % 1024, swz = sb ^ (((sb >> 9) & 1) << 5); R = (st >> 1) * 16 + swz / 64; C = (st & 1) * 32 + (swz % 64) / 2; }
struct Unit { int pm, pn; };
struct Gemm { const f16* A; const f16* Bt; int K; };
struct StaticOrder {
    int nM, nN, nwg, G, c;
    __device__ __forceinline__ void init(int nM_, int nN_, int G_, int c_) { nM = nM_; nN = nN_; nwg = nM * nN; G = G_; c = c_; }
    __device__ __forceinline__ bool next(int i, Unit& u) const {
        const long L = (long)i * G + c; if (L >= nwg) return false;
        int wgid = (int)L; { const int q = nwg / NXCD, r = nwg % NXCD, xcd = wgid % NXCD, off = wgid / NXCD; wgid = (xcd < r ? xcd * (q + 1) : r * (q + 1) + (xcd - r) * q) + off; }
        const int nig = WGM * nN, gid = wgid / nig, fm = gid * WGM, gsz = (nM - fm) < WGM ? (nM - fm) : WGM;
        u.pm = fm + ((wgid % nig) % gsz); u.pn = (wgid % nig) / gsz; return true;
    }
};
struct OneUnit { int pm, pn; __device__ __forceinline__ bool next(int i, Unit& u) const { if (i != 0) return false; u.pm = pm; u.pn = pn; return true; } };
template <class Epi, class Sched, bool PRE = false>
__device__ __forceinline__ void gemm_phase(LAS unsigned char* lds, const Gemm g, const Sched& S, const Epi& E, const f32x4 (*pre)[2][4][2] = nullptr) {
    int tid_ = threadIdx.x; asm volatile("" : "+v"(tid_));
    const int tid = tid_, wid = __builtin_amdgcn_readfirstlane(tid >> 6), lane = tid & 63, wr = wid >> 2, wc = wid & 3, fr = lane & 15, fq = lane >> 4;
    const int K = g.K, nt = K / BK;
    unsigned voffA[2];
#pragma unroll
    for (int i = 0; i < 2; ++i) { int R, C; stage_rc(tid * 16 + i * 8192, R, C); voffA[i] = (unsigned)(R * K + C) * 2u; }
    const size_t kstep = (size_t)(BK * 2);
    const size_t hstep = (size_t)HALF * K * 2;
    const size_t tstep = 2 * hstep;
    const unsigned ldsw = (unsigned)wid * 1024u;
    const int aoff = lds_byte(wr * 64 + fr, fq * 8), boff = lds_byte(wc * 32 + fr, fq * 8);
#define PG8_SA(b, h) (((b) * 2 + (h)) * HTB)
#define PG8_SB(b, h) ((4 + (b) * 2 + (h)) * HTB)
#define PG8_STAGE(bufoff, gbase) do { _Pragma("unroll") for (int _i = 0; _i < 2; ++_i) \
        __builtin_amdgcn_global_load_lds((const unsigned*)((const char*)(gbase) + voffA[_i]), (LAS unsigned*)(lds + (bufoff) + ldsw + _i * 8192), 16, 0, 0); } while (0)
#define PG8_LDA(dst, b, h) do { _Pragma("unroll") for (int m = 0; m < 4; ++m) _Pragma("unroll") for (int k = 0; k < 2; ++k) dst[m][k] = *(const LAS f16x8*)(lds + PG8_SA(b, h) + aoff + m * 2048 + k * 1024); } while (0)
#define PG8_LDB(dst, b, h) do { _Pragma("unroll") for (int n = 0; n < 2; ++n) _Pragma("unroll") for (int k = 0; k < 2; ++k) dst[n][k] = *(const LAS f16x8*)(lds + PG8_SB(b, h) + boff + n * 2048 + k * 1024); } while (0)
#define PG8_MMA(ai, bj, At, Bt) do { __builtin_amdgcn_s_setprio(1); _Pragma("unroll") for (int m = 0; m < 4; ++m) _Pragma("unroll") for (int n = 0; n < 2; ++n) _Pragma("unroll") for (int k = 0; k < 2; ++k) \
        acc[ai][bj][m][n] = __builtin_amdgcn_mfma_f32_16x16x32_f16(Bt[n][k], At[m][k], acc[ai][bj][m][n], 0, 0, 0); __builtin_amdgcn_s_setprio(0); } while (0)
#define PG8_WAIT_V(n) asm volatile("s_waitcnt vmcnt(" #n ")" ::: "memory")
#define PG8_WAIT_L(n) asm volatile("s_waitcnt lgkmcnt(" #n ")" ::: "memory")
#define PG8_BAR __builtin_amdgcn_s_barrier()
#define PG8_SCHED __builtin_amdgcn_sched_barrier(0)
    Unit cur, nxt; int ui = 0;
    if (!S.next(0, cur)) return;
    f32x4 acc[2][2][4][2];
    if constexpr (PRE) {
#pragma unroll
        for (int a = 0; a < 2; ++a)
#pragma unroll
            for (int b = 0; b < 2; ++b)
#pragma unroll
                for (int m = 0; m < 4; ++m)
#pragma unroll
                    for (int n = 0; n < 2; ++n) acc[a][b][m][n] = pre[a][b][m][n];
    } else E.init(acc, cur, wr, wc, fr, fq);
    f16x8 At[4][2], B0[2][2], B1[2][2];
    const char* cA = (const char*)g.A + (size_t)cur.pm * tstep; const char* cB = (const char*)g.Bt + (size_t)cur.pn * tstep;
    PG8_STAGE(PG8_SB(0, 0), cB); PG8_STAGE(PG8_SB(0, 1), cB + hstep); PG8_STAGE(PG8_SA(0, 0), cA); PG8_STAGE(PG8_SA(0, 1), cA + hstep);
    if (wr == 1) PG8_BAR;
    PG8_WAIT_V(2); PG8_BAR;
    PG8_STAGE(PG8_SB(1, 0), cB + kstep); PG8_STAGE(PG8_SA(1, 0), cA + kstep); PG8_STAGE(PG8_SB(1, 1), cB + hstep + kstep);
    PG8_WAIT_V(6); PG8_BAR;
    for (;;) {
        const bool has_next = S.next(ui + 1, nxt);
        const char* nA = has_next ? (const char*)g.A + (size_t)nxt.pm * tstep : cA; const char* nB = has_next ? (const char*)g.Bt + (size_t)nxt.pn * tstep : cB;
        for (int t = 0; t < nt; t += 2) {
            const bool last = (t == nt - 2);
            const char* a1 = cA + (size_t)(t + 1) * kstep;
            const char* a2 = last ? nA : cA + (size_t)(t + 2) * kstep; const char* b2 = last ? nB : cB + (size_t)(t + 2) * kstep;
            const char* a3 = a2 + kstep; const char* b3 = b2 + kstep;
            PG8_LDB(B0, 0, 0); PG8_LDB(B1, 0, 1); PG8_SCHED; PG8_LDA(At, 0, 0); PG8_STAGE(PG8_SA(1, 1), a1 + hstep);
            PG8_WAIT_V(8); PG8_WAIT_L(0); PG8_BAR; PG8_MMA(0, 0, At, B0); PG8_MMA(0, 1, At, B1); PG8_BAR; PG8_SCHED;
            PG8_LDA(At, 0, 1); PG8_STAGE(PG8_SB(0, 0), b2); PG8_STAGE(PG8_SB(0, 1), b2 + hstep); PG8_STAGE(PG8_SA(0, 0), a2);
            PG8_WAIT_V(8); PG8_WAIT_L(0); PG8_BAR; PG8_MMA(1, 0, At, B0); PG8_MMA(1, 1, At, B1); PG8_BAR; PG8_SCHED;
            PG8_LDB(B0, 1, 0); PG8_LDB(B1, 1, 1); PG8_SCHED; PG8_LDA(At, 1, 0); PG8_STAGE(PG8_SA(0, 1), a2 + hstep);
            PG8_WAIT_V(8); PG8_WAIT_L(0); PG8_BAR; PG8_MMA(0, 0, At, B0); PG8_MMA(0, 1, At, B1); PG8_BAR; PG8_SCHED;
            PG8_LDA(At, 1, 1); PG8_STAGE(PG8_SB(1, 0), b3); PG8_STAGE(PG8_SB(1, 1), b3 + hstep); PG8_STAGE(PG8_SA(1, 0), a3);
            PG8_WAIT_V(8); PG8_WAIT_L(0); PG8_BAR; PG8_MMA(1, 0, At, B0); PG8_MMA(1, 1, At, B1); PG8_BAR; PG8_SCHED;
        }
        const bool al = E.aligned(cur);
        if (al && wr == 0) PG8_BAR;
        E(acc, cur, wr, wc, fr, fq);
        if (!has_next) { if (!al && wr == 0) PG8_BAR; break; }
        cur = nxt; cA = nA; cB = nB; ++ui;
        E.init(acc, cur, wr, wc, fr, fq);
        if (al && wr == 1) PG8_BAR;
    }
    PG8_WAIT_V(0);
    PG8_BAR;
#undef PG8_SA
#undef PG8_SB
#undef PG8_STAGE
#undef PG8_LDA
#undef PG8_LDB
#undef PG8_MMA
#undef PG8_WAIT_V
#undef PG8_WAIT_L
#undef PG8_BAR
#undef PG8_SCHED
}
}
#ifndef P0_REP_T
#define P0_REP_T 1
#define P0_REP_X 1
#endif
constexpr int NWAVES = 8;
constexpr int MPAD = 8448, NPAD = 7936;
constexpr size_t WS_XNH = 450 * MiB;
constexpr size_t WS_WINT = 484 * MiB;
constexpr size_t WS_WOUTT = 516 * MiB;
constexpr size_t WS_PART = 524 * MiB;
constexpr size_t PART_STRIDE = 32768 + 256;
constexpr size_t WS_NEED2 = 536 * MiB;
constexpr int RING_BYTES = 131072, SCR_OFF = RING_BYTES, SCR_BYTES = 8192, MISC_OFF = 145408, LDS_BYTES = 147456;

__device__ __forceinline__ unsigned pk_bf16(float lo, float hi) { f32x2 v = {lo, hi}; bf16x2_t b = __builtin_convertvector(v, bf16x2_t); return __builtin_bit_cast(unsigned, b); }
__device__ __forceinline__ unsigned pk_f16(float lo, float hi) { f32x2 v = {lo, hi}; f16x2 b = __builtin_convertvector(v, f16x2); return __builtin_bit_cast(unsigned, b); }

struct Args { const float* in[14]; float* out; unsigned char* ws; int ph_lo, ph_hi; };

__device__ __forceinline__ int win_src(int np) {
    const int pn = np >> 8, c = np & 255;
    if (pn < 15) { const int rho = c & 31, nn = rho >> 4, ii = rho & 15; const int L = (np & ~31) | (8 * (ii >> 2) + 4 * nn + (ii & 3));
        if (pn < 14) return L;
        return (L & 255) < 80 ? L : -1; }
    const int T = pn - 15, bj = c >> 7, wc = (c >> 5) & 3, n = (c >> 4) & 1, fqi = c & 15;
    const int base = bj == 0 ? (n == 0 ? OH : OBB) : (n == 0 ? OC : OZC);
    return base + 64 * T + 16 * wc + fqi;
}
template <bool MAP>
__device__ __forceinline__ void p0_t_load(const float* W, int N, int item, int nblk, int lane, f32x4 (&va)[4], f32x4 (&vb)[4]) {
    const int kb = item / nblk, nb = item % nblk, k0 = 64 * kb, n0 = 32 * nb;
    const int q = lane & 7, kr = lane >> 3;
    const int src = MAP ? win_src(n0 + 4 * q) : n0 + 4 * q;
    const GAS float* wp = (const GAS float*)W + (size_t)(k0 + 2 * kr) * N + (src >= 0 ? src : 0);
#pragma unroll
    for (int p = 0; p < 4; ++p) { va[p] = *(const GAS f32x4*)(wp + (size_t)(16 * p) * N); vb[p] = *(const GAS f32x4*)(wp + (size_t)(16 * p + 1) * N); }
}
template <bool MAP>
__device__ __forceinline__ void p0_t_finish(f16* WT, LAS unsigned char* scr, int item, int nblk, int lane, f32x4 (&va)[4], f32x4 (&vb)[4]) {
    const int kb = item / nblk, nb = item % nblk, k0 = 64 * kb, n0 = 32 * nb;
    const int q = lane & 7, kr = lane >> 3;
    const int src = MAP ? win_src(n0 + 4 * q) : n0 + 4 * q;
#pragma unroll
    for (int p = 0; p < 4; ++p) { if (src < 0) { va[p] = (f32x4){0.f, 0.f, 0.f, 0.f}; vb[p] = va[p]; }
#pragma unroll
        for (int e = 0; e < 4; ++e) *(LAS unsigned*)(scr + (4 * q + e) * 144 + 2 * (16 * p + 2 * kr)) = pk_f16(va[p][e], vb[p][e]); }
    asm volatile("s_waitcnt lgkmcnt(0)" ::: "memory");
    const int ch = lane & 7;
#pragma unroll
    for (int j = 0; j < 4; ++j) { const int n = (lane >> 3) + 8 * j;
        *(GAS u32x4*)(WT + (size_t)(n0 + n) * 2048 + k0 + 8 * ch) = *(const LAS u32x4*)(scr + n * 144 + ch * 16); }
    asm volatile("s_waitcnt lgkmcnt(0)" ::: "memory");
}
template <bool MAP>
__device__ __forceinline__ void p0_transpose_all(const float* W, int N, f16* WT, LAS unsigned char* scr, int nitems, int nblk, int gw, int NGW, int lane) {
    f32x4 a0[4], b0[4], a1[4], b1[4]; const int last = nitems - 1;
    int it = gw; if (it >= nitems) return;
    p0_t_load<MAP>(W, N, it, nblk, lane, a0, b0);
    for (; it < nitems; it += 2 * NGW) {
        { const int nx = it + NGW; p0_t_load<MAP>(W, N, nx < last ? nx : last, nblk, lane, a1, b1); }
        p0_t_finish<MAP>(WT, scr, it, nblk, lane, a0, b0);
        { const int nx = it + 2 * NGW; p0_t_load<MAP>(W, N, nx < last ? nx : last, nblk, lane, a0, b0); }
        if (it + NGW < nitems) p0_t_finish<MAP>(WT, scr, it + NGW, nblk, lane, a1, b1);
    }
}
template <int CTRL, int RM, int BM> __device__ __forceinline__ float dppf(float old, float src) { return __builtin_bit_cast(float, __builtin_amdgcn_update_dpp(__builtin_bit_cast(int, old), __builtin_bit_cast(int, src), CTRL, RM, BM, false)); }
template <int CTRL, int RM, int BM> __device__ __forceinline__ unsigned dppu(unsigned old, unsigned src) { return (unsigned)__builtin_amdgcn_update_dpp((int)old, (int)src, CTRL, RM, BM, false); }
__device__ __forceinline__ float wave_max_dpp(float v) {
    v = fmaxf(v, dppf<0xB1, 0xF, 0xF>(v, v)); v = fmaxf(v, dppf<0x4E, 0xF, 0xF>(v, v)); v = fmaxf(v, dppf<0x141, 0xF, 0xF>(v, v)); v = fmaxf(v, dppf<0x140, 0xF, 0xF>(v, v));
    v = fmaxf(v, dppf<0x142, 0xA, 0xF>(v, v)); v = fmaxf(v, dppf<0x143, 0xC, 0xF>(v, v));
    return __builtin_bit_cast(float, __builtin_amdgcn_readlane(__builtin_bit_cast(int, v), 63));
}
__device__ __forceinline__ float wave_sum_dpp(float v) {
    v += dppf<0xB1, 0xF, 0xF>(0.f, v); v += dppf<0x4E, 0xF, 0xF>(0.f, v); v += dppf<0x141, 0xF, 0xF>(0.f, v); v += dppf<0x140, 0xF, 0xF>(0.f, v);
    v += dppf<0x142, 0xA, 0xF>(0.f, v); v += dppf<0x143, 0xC, 0xF>(0.f, v);
    return __builtin_bit_cast(float, __builtin_amdgcn_readlane(__builtin_bit_cast(int, v), 63));
}
__device__ __forceinline__ float half_sum_dpp(float v) {
    v += dppf<0xB1, 0xF, 0xF>(0.f, v); v += dppf<0x4E, 0xF, 0xF>(0.f, v); v += dppf<0x141, 0xF, 0xF>(0.f, v); v += dppf<0x140, 0xF, 0xF>(0.f, v);
    v += dppf<0x142, 0xA, 0xF>(0.f, v);
    return v;
}
__device__ __forceinline__ unsigned wave_scan_dpp(unsigned x) {
    x += dppu<0x111, 0xF, 0xF>(0u, x); x += dppu<0x112, 0xF, 0xF>(0u, x); x += dppu<0x114, 0xF, 0xF>(0u, x); x += dppu<0x118, 0xF, 0xF>(0u, x);
    x += dppu<0x142, 0xA, 0xF>(0u, x); x += dppu<0x143, 0xC, 0xF>(0u, x);
    return x;
}
__device__ __forceinline__ float wave_sum(float v) {
#pragma unroll
    for (int o = 1; o < 64; o <<= 1) v += __shfl_xor(v, o);
    return v;
}
__device__ __forceinline__ void p0_prologue(const Args& a, LAS unsigned char* lds, int vcu, int G, int wave, int lane) {
    LAS unsigned char* scr = lds + wave * 16384;
    const int gw = vcu * NWAVES + wave, NGW = G * NWAVES;
    const float* win = a.in[8]; const float* wout = a.in[13];
    f16* WinT = (f16*)(a.ws + WS_WINT); f16* WoutT = (f16*)(a.ws + WS_WOUTT); f16* XN = (f16*)(a.ws + WS_XNH);
    constexpr int I_IN = 32 * (NPAD / 32), I_OUT = 32 * (DM / 32);
    for (int rpt = 0; rpt < P0_REP_T; ++rpt) {
        p0_transpose_all<true>(win, DIN, WinT, scr, I_IN, NPAD / 32, gw, NGW, lane);
        p0_transpose_all<false>(wout, DM, WoutT, scr, I_OUT, DM / 32, gw, NGW, lane); }

    const float* gin = a.in[7];
    f32x4 gv[8];
#pragma unroll
    for (int j = 0; j < 8; ++j) gv[j] = ((const f32x4*)gin)[lane + 64 * j];
#define XLOAD(V, m_) do { const int mm_ = (m_) < MT - 1 ? (m_) : MT - 1; const float* xrow_ = mm_ < MP ? a.in[0] + (size_t)mm_ * DM : a.in[1] + (size_t)(mm_ - MP) * DM; \
        const f32x4* xr_ = (const f32x4*)xrow_ + lane; _Pragma("unroll") for (int j = 0; j < 8; ++j) V[j] = xr_[64 * j]; } while (0)
#define XPROC(V, m_) do { float s_ = 0.f; _Pragma("unroll") for (int j = 0; j < 8; ++j) s_ += (V[j].x * V[j].x + V[j].y * V[j].y) + (V[j].z * V[j].z + V[j].w * V[j].w); \
        const float rs_ = rsqrtf(wave_sum_dpp(s_) * (1.f / DM) + EPS); u32x2* o8_ = (u32x2*)(XN + (size_t)(m_) * DM) + lane; \
        _Pragma("unroll") for (int j = 0; j < 8; ++j) { u32x2 w_; w_.x = pk_f16(V[j].x * rs_ * gv[j].x, V[j].y * rs_ * gv[j].y); w_.y = pk_f16(V[j].z * rs_ * gv[j].z, V[j].w * rs_ * gv[j].w); o8_[64 * j] = w_; } } while (0)
    for (int rpx = 0; rpx < P0_REP_X; ++rpx) {
        f32x4 v0[8], v1[8]; int m = gw;
        if (m < MT) { XLOAD(v0, m);
            for (; m < MT; m += 2 * NGW) {
                XLOAD(v1, m + NGW); XPROC(v0, m);
                XLOAD(v0, m + 2 * NGW); if (m + NGW < MT) XPROC(v1, m + NGW); } } }
#undef XLOAD
#undef XPROC

    float* rqk = (float*)(a.ws + WS_ROPE); float* ri = (float*)(a.ws + WS_ROPE_I);
    for (int i = gw * 64 + lane; i < 2052 * 16; i += NGW * 64) {
        { int slot = i / 16, j = i % 16; int pos = slot < 2048 ? slot : PAST + (slot - 2048);
          float inv = (float)pow(500000.0, -(double)j / 16.0); float ang = (float)pos * inv;
          rqk[(slot * 16 + j) * 2] = (float)cos((double)ang); rqk[(slot * 16 + j) * 2 + 1] = (float)sin((double)ang); }
        if (i < 2052 * 8) { int slot = i / 8, j = i % 8; int pos = slot < 2048 ? slot : PAST + (slot - 2048);
          float inv = (float)pow(500000.0, -(double)j / 8.0); float ang = (float)pos * inv;
          ri[(slot * 8 + j) * 2] = (float)cos((double)ang); ri[(slot * 8 + j) * 2 + 1] = (float)sin((double)ang); }
    }
}

struct EpiIn {
    float* out; unsigned char* ws; const float* gq; const float* gk; const float* gki; LAS float* scr;
    __device__ __forceinline__ bool aligned(const pg8::Unit& u) const { return u.pn <= 4 || u.pn == 14; }
    __device__ __forceinline__ void init(f32x4 (&acc)[2][2][4][2], const pg8::Unit&, int, int, int, int) const {
#pragma unroll
        for (int a = 0; a < 2; ++a)
#pragma unroll
            for (int b = 0; b < 2; ++b)
#pragma unroll
                for (int m = 0; m < 4; ++m)
#pragma unroll
                    for (int n = 0; n < 2; ++n) acc[a][b][m][n] = (f32x4){0.f, 0.f, 0.f, 0.f};
    }
    __device__ __forceinline__ void operator()(f32x4 (&acc)[2][2][4][2], const pg8::Unit& u, int wr, int wc, int fr_, int fq_) const {
        int fr = fr_, fq = fq_; asm volatile("" : "+v"(fr), "+v"(fq));
        GAS unsigned char* ws = (GAS unsigned char*)this->ws; GAS float* out = (GAS float*)this->out; asm volatile("" : "+s"(ws), "+s"(out));
        const int pn = u.pn, pm = u.pm; const bool smp = pm == 32;
        const int rbase = 64 * wr + fr;
        const int bb = pm >> 3, t0 = (pm & 7) << 8;
        const GAS float* rqk = (const GAS float*)(ws + WS_ROPE); const GAS float* ri = (const GAS float*)(ws + WS_ROPE_I);
#define ROWLOOP _Pragma("unroll") for (int ai = 0; ai < 2; ++ai) _Pragma("unroll") for (int m = 0; m < 4; ++m)
#define ROWVARS const int r = rbase + 128 * ai + 16 * m; const bool valid = !smp || r < MS; const int grow = smp ? MP + r : pm * 256 + r; const int tt = smp ? (r & 3) : t0 + r; const int slot = smp ? 2048 + (r & 3) : tt; (void)grow; (void)tt; (void)slot; (void)valid;
        const int cl = 32 * wc + 8 * fq;
#define PK8B(x0_, x1_) ((u32x4){pk_bf16(x0_[0], x0_[1]), pk_bf16(x0_[2], x0_[3]), pk_bf16(x1_[0], x1_[1]), pk_bf16(x1_[2], x1_[3])})
#define PK8H(x0_, x1_) ((u32x4){pk_f16(x0_[0], x0_[1]), pk_f16(x0_[2], x0_[3]), pk_f16(x1_[0], x1_[1]), pk_f16(x1_[2], x1_[3])})
#define SHX4(dst_, src_, off_) do { dst_[0] = __shfl_xor(src_[0], off_); dst_[1] = __shfl_xor(src_[1], off_); dst_[2] = __shfl_xor(src_[2], off_); dst_[3] = __shfl_xor(src_[3], off_); } while (0)
        if (pn <= 4 || pn == 14) {
            const bool isk = pn == 14;
            ROWLOOP { asm volatile("" ::: "memory"); const int r = rbase + 128 * ai + 16 * m;
#pragma unroll
                for (int bj = 0; bj < 2; ++bj) { float s = 0.f;
#pragma unroll
                    for (int n = 0; n < 2; ++n) { const f32x4 x = acc[ai][bj][m][n]; s += (x[0] * x[0] + x[1] * x[1]) + (x[2] * x[2] + x[3] * x[3]); }
                    if (isk && (wc >= 2 || bj == 1)) s = 0.f;
                    s += __shfl_xor(s, 16); s += __shfl_xor(s, 32);
                    if (fq == 0) scr[(r * 2 + bj) * 4 + wc] = s; } }
            asm volatile("s_waitcnt lgkmcnt(0)" ::: "memory"); __builtin_amdgcn_s_barrier(); asm volatile("" ::: "memory");
            if (!isk) {
                const GAS float* g = (const GAS float*)(pn < 4 ? gq : gk);
                const f32x4 g0 = *(const GAS f32x4*)(g + cl), g1 = *(const GAS f32x4*)(g + cl + 4);
                GAS bf16_t* Qb = (GAS bf16_t*)(ws + WS_QB); GAS bf16_t* Kb = (GAS bf16_t*)(ws + WS_KB); GAS float* QS = (GAS float*)(ws + WS_QS);
                ROWLOOP { asm volatile("" ::: "memory"); ROWVARS
                    f32x4 c0 = {1.f, 1.f, 1.f, 1.f}, s0 = {0.f, 0.f, 0.f, 0.f}, c1 = c0, s1 = s0;
                    if (wc == 0) { const GAS f32x4* cp = (const GAS f32x4*)(rqk + (slot * 16 + 8 * (fq & 1)) * 2); const f32x4 t0_ = cp[0], t1_ = cp[1], t2_ = cp[2], t3_ = cp[3];
                        c0 = (f32x4){t0_[0], t0_[2], t1_[0], t1_[2]}; s0 = (f32x4){t0_[1], t0_[3], t1_[1], t1_[3]}; c1 = (f32x4){t2_[0], t2_[2], t3_[0], t3_[2]}; s1 = (f32x4){t2_[1], t2_[3], t3_[1], t3_[3]}; }
#pragma unroll
                    for (int bj = 0; bj < 2; ++bj) {
                        const f32x4 p = *(const LAS f32x4*)(scr + (r * 2 + bj) * 4);
                        const float rs = rsqrtf(((p[0] + p[1]) + (p[2] + p[3])) * (1.f / 128.f) + EPS);
                        f32x4 x0 = acc[ai][bj][m][0] * rs * g0, x1 = acc[ai][bj][m][1] * rs * g1;
                        if (wc == 0) { f32x4 o0, o1; SHX4(o0, x0, 32); SHX4(o1, x1, 32);
                            if (fq < 2) { x0 = x0 * c0 - o0 * s0; x1 = x1 * c1 - o1 * s1; } else { x0 = x0 * c0 + o0 * s0; x1 = x1 * c1 + o1 * s1; } }
                        const int hh = 2 * pn + bj;
                        if (pn < 4) {
                            if (smp) { if (valid) { GAS float* q = QS + (size_t)r * 1024 + hh * 128 + cl; *(GAS f32x4*)q = x0; *(GAS f32x4*)(q + 4) = x1; } }
                            else *(GAS u32x4*)(Qb + (((size_t)bb * NH + hh) * S + tt) * HD + cl) = PK8B(x0, x1);
                        } else {
                            if (smp) { if (valid) { GAS float* k = out + O_KS + (size_t)r * 256 + bj * 128 + cl; *(GAS f32x4*)k = x0; *(GAS f32x4*)(k + 4) = x1; } }
                            else { GAS float* k = out + O_KP + (size_t)grow * 256 + bj * 128 + cl; *(GAS f32x4*)k = x0; *(GAS f32x4*)(k + 4) = x1;
                                *(GAS u32x4*)(Kb + (((size_t)bb * NKV + bj) * S + tt) * HD + cl) = PK8B(x0, x1); }
                        } } }
            } else {
                const int dl = 32 * (wc & 1) + 8 * fq;
                const f32x4 g0 = *(const GAS f32x4*)((const GAS float*)gki + dl), g1 = *(const GAS f32x4*)((const GAS float*)gki + dl + 4);
                GAS f16* KI = (GAS f16*)(ws + WS_KI); GAS float* WI = (GAS float*)(ws + WS_WI);
                ROWLOOP { asm volatile("" ::: "memory"); ROWVARS
                    const f32x4 p = *(const LAS f32x4*)(scr + (r * 2) * 4);
                    const float rs = rsqrtf((p[0] + p[1]) * (1.f / 64.f) + EPS);
                    f32x4 x0 = acc[ai][0][m][0] * rs * g0, x1 = acc[ai][0][m][1] * rs * g1;
                    f32x4 o0, o1; SHX4(o0, x0, 16); SHX4(o1, x1, 16);
                    if (wc == 0 && fq < 2) { const GAS f32x4* cp = (const GAS f32x4*)(ri + (slot * 8) * 2); const f32x4 t0_ = cp[0], t1_ = cp[1], t2_ = cp[2], t3_ = cp[3];
                        const f32x4 c0 = {t0_[0], t0_[2], t1_[0], t1_[2]}, s0 = {t0_[1], t0_[3], t1_[1], t1_[3]}, c1 = {t2_[0], t2_[2], t3_[0], t3_[2]}, s1 = {t2_[1], t2_[3], t3_[1], t3_[3]};
                        if (fq == 0) { x0 = x0 * c0 - o0 * s0; x1 = x1 * c1 - o1 * s1; } else { x0 = x0 * c0 + o0 * s0; x1 = x1 * c1 + o1 * s1; } }
                    if (wc < 2 && valid) {
                        GAS float* ko = smp ? out + O_KIS + (size_t)r * 64 + dl : out + O_KIP + (size_t)grow * 64 + dl;
                        *(GAS f32x4*)ko = x0; *(GAS f32x4*)(ko + 4) = x1;
                        if (!smp) *(GAS u32x4*)(KI + (size_t)grow * 64 + dl) = PK8H(x0, x1); }
                    if (wc == 2 && fq < 2 && valid) { GAS float* wo = WI + (size_t)grow * 16 + 8 * fq; *(GAS f32x4*)wo = acc[ai][0][m][0] * (1.f / 32.f); *(GAS f32x4*)(wo + 4) = acc[ai][0][m][1] * (1.f / 32.f); }
                }
            }
        } else if (pn == 5) {
            GAS bf16_t* Vb = (GAS bf16_t*)(ws + WS_VB);
            ROWLOOP { asm volatile("" ::: "memory"); ROWVARS
#pragma unroll
                for (int bj = 0; bj < 2; ++bj) { const f32x4 x0 = acc[ai][bj][m][0], x1 = acc[ai][bj][m][1];
                    if (smp) { if (valid) { GAS float* v = out + O_VS + (size_t)r * 256 + bj * 128 + cl; *(GAS f32x4*)v = x0; *(GAS f32x4*)(v + 4) = x1; } }
                    else { GAS float* v = out + O_VP + (size_t)grow * 256 + bj * 128 + cl; *(GAS f32x4*)v = x0; *(GAS f32x4*)(v + 4) = x1;
                        *(GAS u32x4*)(Vb + (((size_t)bb * NKV + bj) * S + tt) * HD + cl) = PK8B(x0, x1); } } }
        } else if (pn <= 9) {
            GAS f16* SZ = (GAS f16*)(ws + WS_SZ); const int c0 = 256 * (pn - 6) + cl;
            ROWLOOP { asm volatile("" ::: "memory"); ROWVARS
                if (valid) {
#pragma unroll
                    for (int bj = 0; bj < 2; ++bj) { const f32x4 a0 = acc[ai][bj][m][0], a1 = acc[ai][bj][m][1];
                        f32x4 z0, z1; z0[0] = silu(a0[0]); z0[1] = silu(a0[1]); z0[2] = silu(a0[2]); z0[3] = silu(a0[3]); z1[0] = silu(a1[0]); z1[1] = silu(a1[1]); z1[2] = silu(a1[2]); z1[3] = silu(a1[3]);
                        *(GAS u32x4*)(SZ + (size_t)grow * 1024 + c0 + 128 * bj) = PK8H(z0, z1); } } }
        } else if (pn <= 13) {
            GAS f16* QI = (GAS f16*)(ws + WS_QI); const int c0 = 256 * (pn - 10) + cl;
            ROWLOOP { asm volatile("" ::: "memory"); ROWVARS
                f32x4 c0v = {1.f, 1.f, 1.f, 1.f}, s0v = {0.f, 0.f, 0.f, 0.f}, c1v = c0v, s1v = s0v;
                const bool rp = (wc & 1) == 0;
                if (rp) { const GAS f32x4* cp = (const GAS f32x4*)(ri + (slot * 8) * 2); const f32x4 t0_ = cp[0], t1_ = cp[1], t2_ = cp[2], t3_ = cp[3];
                    c0v = (f32x4){t0_[0], t0_[2], t1_[0], t1_[2]}; s0v = (f32x4){t0_[1], t0_[3], t1_[1], t1_[3]}; c1v = (f32x4){t2_[0], t2_[2], t3_[0], t3_[2]}; s1v = (f32x4){t2_[1], t2_[3], t3_[1], t3_[3]}; }
#pragma unroll
                for (int bj = 0; bj < 2; ++bj) { f32x4 x0 = acc[ai][bj][m][0], x1 = acc[ai][bj][m][1];
                    f32x4 o0, o1; SHX4(o0, x0, 16); SHX4(o1, x1, 16);
                    if (rp && fq < 2) { if (fq == 0) { x0 = x0 * c0v - o0 * s0v; x1 = x1 * c1v - o1 * s1v; } else { x0 = x0 * c0v + o0 * s0v; x1 = x1 * c1v + o1 * s1v; } }
                    if (valid) *(GAS u32x4*)(QI + (size_t)grow * 1024 + c0 + 128 * bj) = PK8H(x0, x1); } }
        } else {
            GAS f16* UG = (GAS f16*)(ws + WS_U); const int ch = 64 * (pn - 15) + 16 * wc + 4 * fq;
            ROWLOOP { asm volatile("" ::: "memory"); ROWVARS
                const f32x4 h = acc[ai][0][m][0], b = acc[ai][0][m][1], c = acc[ai][1][m][0], z = acc[ai][1][m][1];
                const f32x4 uu = c * h; f32x4 gg; gg[0] = b[0] * silu(z[0]); gg[1] = b[1] * silu(z[1]); gg[2] = b[2] * silu(z[2]); gg[3] = b[3] * silu(z[3]);
                if (valid) { u32x4 w = {pk_f16(uu[0], uu[1]), pk_f16(uu[2], uu[3]), pk_f16(gg[0], gg[1]), pk_f16(gg[2], gg[3])};
                    *(GAS u32x4*)(UG + (size_t)grow * 2048 + 2 * ch) = w;
                    if (!smp && tt >= S - 2) *(GAS f32x4*)(out + O_CVP + ((size_t)bb * 2 + (tt - (S - 2))) * 1024 + ch) = uu;
                    if (smp && tt >= 2) *(GAS f32x4*)(out + O_CVS + ((size_t)(r >> 2) * 2 + (tt - 2)) * 1024 + ch) = uu; } }
        }
#undef ROWLOOP
#undef ROWVARS
#undef PK8B
#undef PK8H
#undef SHX4
    }
};


struct EpiOut {
    float* out; const float* xp;
    __device__ __forceinline__ bool aligned(const pg8::Unit&) const { return false; }
    __device__ __forceinline__ void init(f32x4 (&acc)[2][2][4][2], const pg8::Unit& u, int wr, int wc, int fr, int fq) const {
        const GAS float* xp = (const GAS float*)this->xp;
        const size_t base = (size_t)(u.pm * 256 + 64 * wr + fr) * DM + u.pn * 256 + 32 * wc + 4 * fq;
#pragma unroll
        for (int ai = 0; ai < 2; ++ai)
#pragma unroll
            for (int m = 0; m < 4; ++m)
#pragma unroll
                for (int bj = 0; bj < 2; ++bj)
#pragma unroll
                    for (int n = 0; n < 2; ++n) acc[ai][bj][m][n] = *(const GAS f32x4*)(xp + base + (size_t)(128 * ai + 16 * m) * DM + 128 * bj + 16 * n);
    }
    __device__ __forceinline__ void operator()(f32x4 (&acc)[2][2][4][2], const pg8::Unit& u, int wr, int wc, int fr_, int fq_) const {
        int fr = fr_, fq = fq_; asm volatile("" : "+v"(fr), "+v"(fq));
        GAS float* out = (GAS float*)this->out; asm volatile("" : "+s"(out));
        const size_t base = (size_t)(u.pm * 256 + 64 * wr + fr) * DM + u.pn * 256 + 32 * wc + 4 * fq;
#pragma unroll
        for (int ai = 0; ai < 2; ++ai)
#pragma unroll
            for (int m = 0; m < 4; ++m) { const size_t off = base + (size_t)(128 * ai + 16 * m) * DM;
#pragma unroll
                for (int bj = 0; bj < 2; ++bj)
#pragma unroll
                    for (int n = 0; n < 2; ++n) *(GAS f32x4*)(out + off + 128 * bj + 16 * n) = acc[ai][bj][m][n]; }
    }
};
__device__ __forceinline__ void p4_item(const Args& a, LAS unsigned char* lds, int cg, int tid) {
    const GAS f16* WT = (const GAS f16*)(a.ws + WS_WOUTT);
    LAS float* part = (LAS float*)lds;
    const int lane = tid & 63, wave = __builtin_amdgcn_readfirstlane(tid >> 6), fr = lane & 15, fq = lane >> 4;
    const unsigned long long mu = (unsigned long long)(a.ws + WS_MIX + (size_t)MP * DM * 2);
    const unsigned mlo = __builtin_amdgcn_readfirstlane((unsigned)mu), mhi = __builtin_amdgcn_readfirstlane((unsigned)(mu >> 32));
    const __amdgpu_buffer_rsrc_t rm = __builtin_amdgcn_make_buffer_rsrc((void*)(((unsigned long long)mhi << 32) | mlo), (short)0, MS * DM * 2, 0x00020000);
    const unsigned mvo = (unsigned)(fr * DM + wave * 256 + 8 * fq) * 2u;
    float res = 0.f; const int rr = tid >> 3, cc = tid & 7;
    if (tid < 256) res = a.in[1][(size_t)rr * DM + cg * 8 + cc];
    const GAS f16* wp = WT + (size_t)(cg * 8 + (fr & 7)) * DM + wave * 256 + 8 * fq;
    f16x8 wf[8], m0[8], m1[8];
#pragma unroll
    for (int ks = 0; ks < 8; ++ks) { wf[ks] = *(const GAS f16x8*)(wp + 32 * ks);
        m0[ks] = __builtin_bit_cast(f16x8, __builtin_amdgcn_raw_buffer_load_b128(rm, mvo, 64 * ks, 16)); m1[ks] = __builtin_bit_cast(f16x8, __builtin_amdgcn_raw_buffer_load_b128(rm, mvo, 16 * DM * 2 + 64 * ks, 16)); }
    f32x4 c0 = {0.f, 0.f, 0.f, 0.f}, c1 = {0.f, 0.f, 0.f, 0.f};
#pragma unroll
    for (int ks = 0; ks < 8; ++ks) { c0 = __builtin_amdgcn_mfma_f32_16x16x32_f16(wf[ks], m0[ks], c0, 0, 0, 0); c1 = __builtin_amdgcn_mfma_f32_16x16x32_f16(wf[ks], m1[ks], c1, 0, 0, 0); }
    *(LAS f32x4*)(part + ((wave * 2 + 0) * 64 + lane) * 4) = c0; *(LAS f32x4*)(part + ((wave * 2 + 1) * 64 + lane) * 4) = c1;
    __syncthreads();
    if (tid < 256) { const int ln = (rr & 15) + 16 * (cc >> 2), tl = rr >> 4; float s = res;
#pragma unroll
        for (int w = 0; w < 8; ++w) s += part[((w * 2 + tl) * 64 + ln) * 4 + (cc & 3)];
        a.out[O_YS + (size_t)rr * DM + cg * 8 + cc] = s; }
    __syncthreads();
}
typedef GAS unsigned gu32;
#define XB_TMO      128
#define XB_XCNT(j)  (256  + 64 * (j))
#define XB_XSUB(j)  (1280 + 64 * (j))
#define XB_XGEN(j)  (2304 + 64 * (j))
#define XB_TOP      3328
#define XB_TOPGEN   3392
#define XCD_BAR_WORDS 3456
#define XB_SPIN_CAP (1u << 18)
__device__ __forceinline__ unsigned xb_ld(unsigned* p)              { return __hip_atomic_load(p, __ATOMIC_RELAXED, __HIP_MEMORY_SCOPE_AGENT); }
__device__ __forceinline__ unsigned xb_add(unsigned* p, unsigned v) { return __hip_atomic_fetch_add(p, v, __ATOMIC_RELAXED, __HIP_MEMORY_SCOPE_AGENT); }
__device__ __forceinline__ unsigned xb_xcc_id() { return (unsigned)__builtin_amdgcn_s_getreg((3 << 11) | 20) & 0xFu; }
#define XB_SPIN(cond, bar) do { unsigned _sp = 0; while (cond) { __builtin_amdgcn_s_sleep(1); \
    if ((++_sp & 255u) == 0u) { if (xb_ld(&(bar)[XB_TMO])) break; if (_sp > XB_SPIN_CAP) { atomicAdd(&(bar)[XB_TMO], 1u); break; } } } } while (0)
struct XcdBarrier { unsigned* bar; unsigned x; volatile LAS unsigned* st; };
__device__ __forceinline__ XcdBarrier xcd_barrier_post(unsigned* bar, volatile LAS unsigned* st) {
    XcdBarrier b; b.bar = bar; b.x = xb_xcc_id(); b.st = st;
    if (threadIdx.x == 0) (void)xb_add(&bar[XB_XCNT(b.x)], 1u);
    return b;
}
__device__ __forceinline__ void xcd_barrier_complete(unsigned* bar, unsigned x, unsigned& nloc, unsigned& nx) {
    const unsigned G = gridDim.x * gridDim.y * gridDim.z;
    unsigned sum, cnt, mine, sp = 0u;
    for (;;) {
        sum = 0u; cnt = 0u; mine = 0u;
#pragma unroll
        for (unsigned j = 0; j < 16; ++j) { const unsigned c = xb_ld(&bar[XB_XCNT(j)]); sum += c; cnt += (c > 0u) ? 1u : 0u; mine = (j == x) ? c : mine; }
        if (sum == G) break;
        __builtin_amdgcn_s_sleep(1);
        if ((++sp & 255u) == 0u) { if (xb_ld(&bar[XB_TMO])) break; if (sp > XB_SPIN_CAP) { atomicAdd(&bar[XB_TMO], 1u); break; } }
    }
    nloc = mine > 0u ? mine : 1u; nx = cnt > 0u ? cnt : 1u;
}
__device__ __forceinline__ void xcd_barrier(const XcdBarrier& b) {
    asm volatile("s_waitcnt vmcnt(0)" ::: "memory");
    __syncthreads();
    if (threadIdx.x == 0) {
        unsigned* bar = b.bar;
        __builtin_amdgcn_s_waitcnt(0);
        unsigned nloc = b.st[0], nx = b.st[1];
        if (nloc == 0u) { xcd_barrier_complete(bar, b.x, nloc, nx); b.st[0] = nloc; b.st[1] = nx; }
        const unsigned old = xb_add(&bar[XB_XSUB(b.x)], 1u);
        const unsigned gen = old / nloc;
        if (old + 1u == (gen + 1u) * nloc) {
            __builtin_amdgcn_fence(__ATOMIC_RELEASE, "agent");
            asm volatile("s_waitcnt vmcnt(0)" ::: "memory");
            const unsigned og = xb_add(&bar[XB_TOP], 1u);
            const unsigned tg = og / nx;
            if (og + 1u == (tg + 1u) * nx) xb_add(&bar[XB_TOPGEN], 1u);
            else XB_SPIN(xb_ld(&bar[XB_TOPGEN]) == tg, bar);
            __builtin_amdgcn_fence(__ATOMIC_ACQUIRE, "agent");
            xb_add(&bar[XB_XGEN(b.x)], 1u);
            asm volatile("s_waitcnt vmcnt(0)" ::: "memory");
        } else {
            XB_SPIN(xb_ld(&bar[XB_XGEN(b.x)]) == gen, bar);
            __builtin_amdgcn_fence(__ATOMIC_ACQUIRE, "agent");
            asm volatile("s_waitcnt vmcnt(0)" ::: "memory");
        }
    }
    __syncthreads();
}

constexpr int CMQ_WORD = 16064;
constexpr int RDY_WORD0 = 4096;
__device__ __forceinline__ void signal_add(unsigned* ctr) {
    asm volatile("s_waitcnt vmcnt(0)" ::: "memory");
    __syncthreads();
    if (threadIdx.x == 0) { __builtin_amdgcn_fence(__ATOMIC_RELEASE, "agent"); asm volatile("s_waitcnt vmcnt(0)" ::: "memory"); (void)xb_add(ctr, 1u); }
}
__device__ __forceinline__ void wait_ge(unsigned* ctr, unsigned need) {
    if (threadIdx.x == 0) { unsigned sp = 0; while (xb_ld(ctr) < need) { __builtin_amdgcn_s_sleep(2); if (++sp > (1u << 22)) break; }
        __builtin_amdgcn_fence(__ATOMIC_ACQUIRE, "agent"); asm volatile("s_waitcnt vmcnt(0)" ::: "memory"); }
    __syncthreads();
}

constexpr int PMR_WORD0 = 16384;
__device__ __forceinline__ void signal_add_wt(unsigned* ctr) {
    asm volatile("s_waitcnt vmcnt(0)" ::: "memory");
    __syncthreads();
    if (threadIdx.x == 0) (void)xb_add(ctr, 1u);
}
__device__ __forceinline__ void wait_ge_wt(unsigned* ctr, unsigned need) {
    if (threadIdx.x == 0) { unsigned sp = 0; while (xb_ld(ctr) < need) { __builtin_amdgcn_s_sleep(2); if (++sp > (1u << 22)) break; } }
    __syncthreads();
}

#ifndef P2_KT_REP
#define P2_KT_REP 1
#define P2_SEL_REP 1
#endif
#ifndef P2_REP_A
#define P2_REP_A 1
#define P2_REP_B 1
#define P2_REP_C 1
#endif
constexpr int SC_STRIDE = 2052;
constexpr int SC_BYTES = 16 * SC_STRIDE * 4;
constexpr int WSCR_OFF = 131584, WSCR_BYTES = 1536;
__device__ __forceinline__ f16x8 cvt8(f32x4 a, f32x4 b) { u32x4 w = {pk_f16(a[0], a[1]), pk_f16(a[2], a[3]), pk_f16(b[0], b[1]), pk_f16(b[2], b[3])}; return __builtin_bit_cast(f16x8, w); }

__device__ __forceinline__ void convmix_task(const Args& a, int ch, int half, int lane) {
    const GAS f16* UG = (const GAS f16*)(a.ws + WS_U); GAS f16* MIX = (GAS f16*)(a.ws + WS_MIX);
    const GAS float* wconv = (const GAS float*)a.in[12]; const GAS float* state = (const GAS float*)a.in[5];
    {
        const int row0 = 4 * ch; const bool smp = row0 >= MP; const int t0 = smp ? 0 : (row0 & (S - 1)); const int seq = (row0 - MP) >> 2;
        { const int cb = half * 512 + 8 * lane;
            float um2[8], um1[8], w0[8], w1[8], w2[8];
#pragma unroll
            for (int e = 0; e < 8; e += 4) { const f32x4 a0 = *(const GAS f32x4*)(wconv + cb + e), a1 = *(const GAS f32x4*)(wconv + 1024 + cb + e), a2 = *(const GAS f32x4*)(wconv + 2048 + cb + e);
#pragma unroll
                for (int i = 0; i < 4; ++i) { w0[e + i] = a0[i]; w1[e + i] = a1[i]; w2[e + i] = a2[i]; } }
            if (t0 == 0) {
                if (smp) {
#pragma unroll
                    for (int e = 0; e < 8; e += 4) { const f32x4 s0 = *(const GAS f32x4*)(state + ((size_t)seq * 2) * 1024 + cb + e), s1 = *(const GAS f32x4*)(state + ((size_t)seq * 2 + 1) * 1024 + cb + e);
#pragma unroll
                        for (int i = 0; i < 4; ++i) { um2[e + i] = s0[i]; um1[e + i] = s1[i]; } }
                } else {
#pragma unroll
                    for (int e = 0; e < 8; ++e) { um2[e] = 0.f; um1[e] = 0.f; } }
            } else {
#pragma unroll
                for (int gq = 0; gq < 2; ++gq) { const f16x4 p2 = *(const GAS f16x4*)(UG + (size_t)(row0 - 2) * 2048 + 2 * cb + 8 * gq), p1 = *(const GAS f16x4*)(UG + (size_t)(row0 - 1) * 2048 + 2 * cb + 8 * gq);
#pragma unroll
                    for (int e = 0; e < 4; ++e) { um2[4 * gq + e] = (float)p2[e]; um1[4 * gq + e] = (float)p1[e]; } } }
#pragma unroll
            for (int i = 0; i < 4; ++i) { const size_t row = row0 + i;
                const f16x8 x0 = *(const GAS f16x8*)(UG + row * 2048 + 2 * cb), x1 = *(const GAS f16x8*)(UG + row * 2048 + 2 * cb + 8); float o[8];
#pragma unroll
                for (int e = 0; e < 8; ++e) { const float u = (float)(e < 4 ? x0[e] : x1[e - 4]); const float g = (float)(e < 4 ? x0[4 + e] : x1[e]);
                    const float cv = w0[e] * um2[e] + w1[e] * um1[e] + w2[e] * u; o[e] = g * cv; um2[e] = um1[e]; um1[e] = u; }
                u32x4 w = {pk_f16(o[0], o[1]), pk_f16(o[2], o[3]), pk_f16(o[4], o[5]), pk_f16(o[6], o[7])};
                st16_wt((GAS void*)(MIX + row * 2048 + 1024 + cb), w); }
        }
    }
}

__device__ __forceinline__ void p2_sscore(const Args& a, int gw, int NGW, int lane) {
    const GAS float* cki = (const GAS float*)a.in[4]; const GAS int* ptab = (const GAS int*)a.in[6];
    const GAS f16* QI = (const GAS f16*)(a.ws + WS_QI); const GAS float* WI = (const GAS float*)(a.ws + WS_WI); GAS float* SSC = (GAS float*)(a.ws + WS_SSC);
    const int fr = lane & 15, fq = lane >> 4;
    for (int it = gw; it < NSB * 256; it += NGW) {
        const int sb = it >> 8, hp = it & 255, pg = hp >> 1, k0 = (hp & 1) * 64; const int phys = ptab[sb * NPAGES + pg];
        const GAS float* kbase = cki + ((size_t)phys * PAGE + k0) * 64;
        f16x8 qf[4][2]; f32x4 wv[4];
#pragma unroll
        for (int t = 0; t < 4; ++t) { const size_t row = MP + 4 * sb + t;
            qf[t][0] = *(const GAS f16x8*)(QI + row * 1024 + fr * 64 + 8 * fq); qf[t][1] = *(const GAS f16x8*)(QI + row * 1024 + fr * 64 + 32 + 8 * fq);
            wv[t] = *(const GAS f32x4*)(WI + row * 16 + 4 * fq); }
        f32x4 kraw[4][4];
#pragma unroll
        for (int tile = 0; tile < 4; ++tile) { const GAS float* kr = kbase + (size_t)(16 * tile + fr) * 64 + 8 * fq;
            kraw[tile][0] = *(const GAS f32x4*)kr; kraw[tile][1] = *(const GAS f32x4*)(kr + 4); kraw[tile][2] = *(const GAS f32x4*)(kr + 32); kraw[tile][3] = *(const GAS f32x4*)(kr + 36); }
#pragma unroll
        for (int tile = 0; tile < 4; ++tile) {
            const f16x8 kf0 = cvt8(kraw[tile][0], kraw[tile][1]), kf1 = cvt8(kraw[tile][2], kraw[tile][3]);
            float mine = 0.f;
#pragma unroll
            for (int t = 0; t < 4; ++t) { f32x4 c = {0.f, 0.f, 0.f, 0.f};
                c = __builtin_amdgcn_mfma_f32_16x16x32_f16(qf[t][0], kf0, c, 0, 0, 0); c = __builtin_amdgcn_mfma_f32_16x16x32_f16(qf[t][1], kf1, c, 0, 0, 0);
                float s = wv[t][0] * fmaxf(c[0], 0.f) + wv[t][1] * fmaxf(c[1], 0.f) + wv[t][2] * fmaxf(c[2], 0.f) + wv[t][3] * fmaxf(c[3], 0.f);
                s += __shfl_xor(s, 16); s += __shfl_xor(s, 32);
                mine = fq == t ? s : mine; }
            __hip_atomic_store((GAS unsigned*)SSC + ((size_t)(4 * sb + fq) * PAST + pg * PAGE + k0 + 16 * tile + fr), __builtin_bit_cast(unsigned, mine), __ATOMIC_RELAXED, __HIP_MEMORY_SCOPE_AGENT);
        }
    }
}

__device__ __forceinline__ void wave_topk_mask(const LAS float* row, int t, GAS unsigned long long* mrow, int lane, LAS unsigned* hist, LAS float* cand) {
    const float NINF = -__builtin_inff(), PINF = __builtin_inff();
    const int jmax = t >> 6;
    const int rem = t - lane;
    float v[32]; float mx = NINF, mn = PINF;
#pragma unroll
    for (int g = 0; g < 4; ++g) {
        if (8 * g <= jmax) {
#pragma unroll
            for (int jj = 0; jj < 8; ++jj) { const int j = 8 * g + jj; const float x = row[64 * j + lane]; const bool ok = 64 * j <= rem; v[j] = ok ? x : NINF; mx = fmaxf(mx, v[j]); mn = fminf(mn, ok ? x : PINF); }
        } else {
#pragma unroll
            for (int jj = 0; jj < 8; ++jj) v[8 * g + jj] = NINF; } }
    mx = wave_max_dpp(mx); mn = -wave_max_dpp(-mn);
    *(LAS u32x4*)(hist + 4 * lane) = (u32x4){0u, 0u, 0u, 0u};
    const float scale = 255.5f / (mx - mn), off = -mn * scale;
    float tau = 0.f; bool have = false;
    if (mx > mn) {
        asm volatile("s_waitcnt lgkmcnt(0)" ::: "memory");
        unsigned bins[32];
#pragma unroll
        for (int g = 0; g < 4; ++g) {
            if (8 * g <= jmax) {
#pragma unroll
                for (int jj = 0; jj < 8; ++jj) { const int j = 8 * g + jj; unsigned b = (unsigned)fmaf(v[j], scale, off); b = b > 255u ? 255u : b; bins[j] = b;
                    __hip_atomic_fetch_add(hist + b, 1u, __ATOMIC_RELAXED, __HIP_MEMORY_SCOPE_WORKGROUP); }
            } else {
#pragma unroll
                for (int jj = 0; jj < 8; ++jj) bins[8 * g + jj] = 0u; } }
        asm volatile("s_waitcnt lgkmcnt(0)" ::: "memory");
        const u32x4 h = *(const LAS u32x4*)(hist + 4 * lane);
        const unsigned sl = h[0] + h[1] + h[2] + h[3]; const unsigned pre = wave_scan_dpp(sl);
        const unsigned tot = __builtin_amdgcn_readlane(pre, 63); const unsigned suf = tot - pre + sl;
        const unsigned long long bm = __ballot(suf >= TOPK);
        const int Ls = 63 - __builtin_clzll(bm);
        unsigned c = __builtin_amdgcn_readlane(suf, Ls) - __builtin_amdgcn_readlane(sl, Ls);
        const unsigned h3 = __builtin_amdgcn_readlane(h[3], Ls), h2 = __builtin_amdgcn_readlane(h[2], Ls), h1 = __builtin_amdgcn_readlane(h[1], Ls);
        int Bs;
        if (c + h3 >= TOPK) Bs = 4 * Ls + 3; else { c += h3; if (c + h2 >= TOPK) Bs = 4 * Ls + 2; else { c += h2; if (c + h1 >= TOPK) Bs = 4 * Ls + 1; else { c += h1; Bs = 4 * Ls; } } }
        const int need = TOPK - (int)c;
        if (Bs > 0) {
            int base = 0;
#pragma unroll
            for (int g = 0; g < 4; ++g) {
                if (8 * g <= jmax) {
#pragma unroll
                    for (int jj = 0; jj < 8; ++jj) { const int j = 8 * g + jj; const bool isc = bins[j] == (unsigned)Bs;
                        const unsigned long long m = __ballot(isc);
                        if (m) { const int pos = base + (int)__builtin_amdgcn_mbcnt_hi((unsigned)(m >> 32), __builtin_amdgcn_mbcnt_lo((unsigned)m, 0u)); if (isc && pos < 64) cand[pos] = v[j]; base += __builtin_popcountll(m); } } } }
            if (base <= 64) {
                asm volatile("s_waitcnt lgkmcnt(0)" ::: "memory");
                const float x = lane < base ? cand[lane] : NINF; int rank = 0;
                for (int m = 0; m < base; ++m) { const float y = __builtin_bit_cast(float, __builtin_amdgcn_readlane(__builtin_bit_cast(int, x), m)); rank += y > x ? 1 : 0; }
                float tc = (lane < base && rank <= need - 1) ? x : PINF;
                tau = -wave_max_dpp(-tc); have = true;
            }
        }
    }
    if (!have) {
        unsigned tk = 0u;
        for (int bit = 31; bit >= 0; --bit) { const unsigned cd = tk | (1u << bit); int cnt = 0;
#pragma unroll
            for (int j = 0; j < 32; ++j) cnt += __builtin_popcountll(__ballot((64 * j + lane <= t) && fkey(v[j]) >= cd));
            if (cnt >= TOPK) tk = cd; }
        tau = __builtin_bit_cast(float, (tk & 0x80000000u) ? (tk ^ 0x80000000u) : ~tk);
    }
    unsigned wlo = 0u, whi = 0u;
#pragma unroll
    for (int g = 0; g < 4; ++g) {
        if (8 * g <= jmax) {
#pragma unroll
            for (int jj = 0; jj < 8; ++jj) { const int j = 8 * g + jj; const unsigned long long m = __ballot(v[j] >= tau);
                if (lane == j) { wlo = (unsigned)m; whi = (unsigned)(m >> 32); } } } }
    if (lane < 32) __hip_atomic_store(mrow + lane, ((unsigned long long)whi << 32) | wlo, __ATOMIC_RELAXED, __HIP_MEMORY_SCOPE_AGENT);
}

__device__ __forceinline__ void wave_topk_mask2(const LAS float* rowA, const LAS float* rowB, int tA, GAS unsigned long long* mrowA, GAS unsigned long long* mrowB, int lane, LAS unsigned* hist, LAS float* cand) {
    const float NINF = -__builtin_inff(), PINF = __builtin_inff();
    const int tB = tA + 1, jmax = tB >> 6;
    const int remA = tA - lane, remB = tB - lane;
    float vA[32], vB[32]; float mxA = NINF, mnA = PINF, mxB = NINF, mnB = PINF;
#pragma unroll
    for (int g = 0; g < 4; ++g) {
        if (8 * g <= jmax) {
#pragma unroll
            for (int jj = 0; jj < 8; ++jj) { const int j = 8 * g + jj; const float xA = rowA[64 * j + lane], xB = rowB[64 * j + lane]; const bool okA = 64 * j <= remA, okB = 64 * j <= remB;
                vA[j] = okA ? xA : NINF; mxA = fmaxf(mxA, vA[j]); mnA = fminf(mnA, okA ? xA : PINF);
                vB[j] = okB ? xB : NINF; mxB = fmaxf(mxB, vB[j]); mnB = fminf(mnB, okB ? xB : PINF); }
        } else {
#pragma unroll
            for (int jj = 0; jj < 8; ++jj) { vA[8 * g + jj] = NINF; vB[8 * g + jj] = NINF; } } }
    mxA = wave_max_dpp(mxA); mxB = wave_max_dpp(mxB); mnA = -wave_max_dpp(-mnA); mnB = -wave_max_dpp(-mnB);
    *(LAS u32x4*)(hist + 4 * lane) = (u32x4){0u, 0u, 0u, 0u};
    const float scA = 255.5f / (mxA - mnA), ofA = -mnA * scA, scB = 255.5f / (mxB - mnB), ofB = -mnB * scB;
    float tauA = 0.f, tauB = 0.f; bool haveA = false, haveB = false;
#define BIN_OF(x_, sc_, of_) ({ unsigned b_ = (unsigned)fmaf((x_), (sc_), (of_)); b_ > 255u ? 255u : b_; })
    if (mxA > mnA && mxB > mnB) {
        asm volatile("s_waitcnt lgkmcnt(0)" ::: "memory");
#pragma unroll
        for (int g = 0; g < 4; ++g) {
            if (8 * g <= jmax) {
#pragma unroll
                for (int jj = 0; jj < 8; ++jj) { const int j = 8 * g + jj;
                    __hip_atomic_fetch_add(hist + BIN_OF(vA[j], scA, ofA), 1u, __ATOMIC_RELAXED, __HIP_MEMORY_SCOPE_WORKGROUP);
                    __hip_atomic_fetch_add(hist + BIN_OF(vB[j], scB, ofB), 0x10000u, __ATOMIC_RELAXED, __HIP_MEMORY_SCOPE_WORKGROUP); } } }
        asm volatile("s_waitcnt lgkmcnt(0)" ::: "memory");
        const u32x4 h = *(const LAS u32x4*)(hist + 4 * lane);
        const unsigned a0 = h[0] & 0xffffu, a1 = h[1] & 0xffffu, a2 = h[2] & 0xffffu, a3 = h[3] & 0xffffu, b0 = h[0] >> 16, b1 = h[1] >> 16, b2 = h[2] >> 16, b3 = h[3] >> 16;
        const unsigned slA = a0 + a1 + a2 + a3, slB = b0 + b1 + b2 + b3; const unsigned preA = wave_scan_dpp(slA), preB = wave_scan_dpp(slB);
        const unsigned sufA = __builtin_amdgcn_readlane(preA, 63) - preA + slA, sufB = __builtin_amdgcn_readlane(preB, 63) - preB + slB;
        const unsigned long long bmA = __ballot(sufA >= TOPK), bmB = __ballot(sufB >= TOPK);
        const int LA = 63 - __builtin_clzll(bmA), LB = 63 - __builtin_clzll(bmB);
        int BsA, BsB, needA, needB;
        { unsigned c = __builtin_amdgcn_readlane(sufA, LA) - __builtin_amdgcn_readlane(slA, LA);
          const unsigned h3 = __builtin_amdgcn_readlane(a3, LA), h2 = __builtin_amdgcn_readlane(a2, LA), h1 = __builtin_amdgcn_readlane(a1, LA);
          if (c + h3 >= TOPK) BsA = 4 * LA + 3; else { c += h3; if (c + h2 >= TOPK) BsA = 4 * LA + 2; else { c += h2; if (c + h1 >= TOPK) BsA = 4 * LA + 1; else { c += h1; BsA = 4 * LA; } } }
          needA = TOPK - (int)c; }
        { unsigned c = __builtin_amdgcn_readlane(sufB, LB) - __builtin_amdgcn_readlane(slB, LB);
          const unsigned h3 = __builtin_amdgcn_readlane(b3, LB), h2 = __builtin_amdgcn_readlane(b2, LB), h1 = __builtin_amdgcn_readlane(b1, LB);
          if (c + h3 >= TOPK) BsB = 4 * LB + 3; else { c += h3; if (c + h2 >= TOPK) BsB = 4 * LB + 2; else { c += h2; if (c + h1 >= TOPK) BsB = 4 * LB + 1; else { c += h1; BsB = 4 * LB; } } }
          needB = TOPK - (int)c; }
        int baseA = 65, baseB = 65;
        if (BsA > 0) { baseA = 0;
#pragma unroll
            for (int g = 0; g < 4; ++g) {
                if (8 * g <= jmax) {
#pragma unroll
                    for (int jj = 0; jj < 8; ++jj) { const int j = 8 * g + jj; const bool isc = BIN_OF(vA[j], scA, ofA) == (unsigned)BsA;
                        const unsigned long long m = __ballot(isc);
                        if (m) { const int pos = baseA + (int)__builtin_amdgcn_mbcnt_hi((unsigned)(m >> 32), __builtin_amdgcn_mbcnt_lo((unsigned)m, 0u)); if (isc && pos < 64) cand[pos] = vA[j]; baseA += __builtin_popcountll(m); } } } } }
        if (BsB > 0) { baseB = 0;
#pragma unroll
            for (int g = 0; g < 4; ++g) {
                if (8 * g <= jmax) {
#pragma unroll
                    for (int jj = 0; jj < 8; ++jj) { const int j = 8 * g + jj; const bool isc = BIN_OF(vB[j], scB, ofB) == (unsigned)BsB;
                        const unsigned long long m = __ballot(isc);
                        if (m) { const int pos = baseB + (int)__builtin_amdgcn_mbcnt_hi((unsigned)(m >> 32), __builtin_amdgcn_mbcnt_lo((unsigned)m, 0u)); if (isc && pos < 64) cand[64 + pos] = vB[j]; baseB += __builtin_popcountll(m); } } } } }
        asm volatile("s_waitcnt lgkmcnt(0)" ::: "memory");
        if (baseA <= 64) { const float x = lane < baseA ? cand[lane] : NINF; int rank = 0;
            for (int m = 0; m < baseA; ++m) { const float y = __builtin_bit_cast(float, __builtin_amdgcn_readlane(__builtin_bit_cast(int, x), m)); rank += y > x ? 1 : 0; }
            const float tc = (lane < baseA && rank <= needA - 1) ? x : PINF; tauA = -wave_max_dpp(-tc); haveA = true; }
        if (baseB <= 64) { const float x = lane < baseB ? cand[64 + lane] : NINF; int rank = 0;
            for (int m = 0; m < baseB; ++m) { const float y = __builtin_bit_cast(float, __builtin_amdgcn_readlane(__builtin_bit_cast(int, x), m)); rank += y > x ? 1 : 0; }
            const float tc = (lane < baseB && rank <= needB - 1) ? x : PINF; tauB = -wave_max_dpp(-tc); haveB = true; }
    }
#undef BIN_OF
    if (haveA) { unsigned wlo = 0u, whi = 0u;
#pragma unroll
        for (int g = 0; g < 4; ++g) {
            if (8 * g <= jmax) {
#pragma unroll
                for (int jj = 0; jj < 8; ++jj) { const int j = 8 * g + jj; const unsigned long long m = __ballot(vA[j] >= tauA);
                    if (lane == j) { wlo = (unsigned)m; whi = (unsigned)(m >> 32); } } } }
        if (lane < 32) __hip_atomic_store(mrowA + lane, ((unsigned long long)whi << 32) | wlo, __ATOMIC_RELAXED, __HIP_MEMORY_SCOPE_AGENT); }
    if (haveB) { unsigned wlo = 0u, whi = 0u;
#pragma unroll
        for (int g = 0; g < 4; ++g) {
            if (8 * g <= jmax) {
#pragma unroll
                for (int jj = 0; jj < 8; ++jj) { const int j = 8 * g + jj; const unsigned long long m = __ballot(vB[j] >= tauB);
                    if (lane == j) { wlo = (unsigned)m; whi = (unsigned)(m >> 32); } } } }
        if (lane < 32) __hip_atomic_store(mrowB + lane, ((unsigned long long)whi << 32) | wlo, __ATOMIC_RELAXED, __HIP_MEMORY_SCOPE_AGENT); }
    if (!haveA) wave_topk_mask(rowA, tA, mrowA, lane, hist, cand);
    if (!haveB) wave_topk_mask(rowB, tB, mrowB, lane, hist, cand);
}

#define RELU_FMA(acc_, c_, w_) do { const float f_ = (c_); const int i_ = __builtin_bit_cast(int, f_); const float r_ = __builtin_bit_cast(float, i_ > 0 ? i_ : 0); asm("v_fmac_f32_e32 %0, %1, %2" : "+v"(acc_) : "v"(r_), "v"(w_)); } while (0)
__device__ __forceinline__ void p2_index_tile(const Args& a, LAS unsigned char* lds, int b, int t0, int wave, int lane) {
    const GAS f16* QI = (const GAS f16*)(a.ws + WS_QI); const GAS float* WI = (const GAS float*)(a.ws + WS_WI); const GAS f16* KI = (const GAS f16*)(a.ws + WS_KI);
    GAS unsigned long long* MASK = (GAS unsigned long long*)(a.ws + WS_MASK);
    LAS float* sc = (LAS float*)lds;
    const int fr = lane & 15, fq = lane >> 4; const size_t rowq = (size_t)b * S + t0 + fr;
    f16x8 qf[16][2]; float w[16];
#pragma unroll
    for (int h = 0; h < 16; ++h) { qf[h][0] = *(const GAS f16x8*)(QI + rowq * 1024 + h * 64 + 8 * fq); qf[h][1] = *(const GAS f16x8*)(QI + rowq * 1024 + h * 64 + 32 + 8 * fq); }
#pragma unroll
    for (int h = 0; h < 16; h += 4) { const f32x4 x = *(const GAS f32x4*)(WI + rowq * 16 + h); w[h] = x[0]; w[h + 1] = x[1]; w[h + 2] = x[2]; w[h + 3] = x[3]; }
    const int nkt = (t0 + 16) >> 4;
    const GAS f16* kp = KI + ((size_t)b * S + fr) * 64 + 8 * fq;
#define KLOAD(d0_, d1_, kt_) do { const int k_ = (kt_) < nkt ? (kt_) : wave; d0_ = *(const GAS f16x8*)(kp + (size_t)k_ * 1024); d1_ = *(const GAS f16x8*)(kp + (size_t)k_ * 1024 + 32); } while (0)
    f16x8 ka0, ka1, kb0, kb1, kc0, kc1;
#define KCOMP(kf0, kf1, kt_) do { float a0 = 0.f, a1 = 0.f, a2 = 0.f, a3 = 0.f; const f32x4 z4 = {0.f, 0.f, 0.f, 0.f}; \
        f32x4 cc = __builtin_amdgcn_mfma_f32_16x16x32_f16(kf0, qf[0][0], z4, 0, 0, 0); cc = __builtin_amdgcn_mfma_f32_16x16x32_f16(kf1, qf[0][1], cc, 0, 0, 0); \
        _Pragma("unroll") for (int h = 0; h < 16; ++h) { f32x4 cn = z4;        \
            if (h < 15) { cn = __builtin_amdgcn_mfma_f32_16x16x32_f16(kf0, qf[h + 1][0], z4, 0, 0, 0); cn = __builtin_amdgcn_mfma_f32_16x16x32_f16(kf1, qf[h + 1][1], cn, 0, 0, 0); } \
            RELU_FMA(a0, cc[0], w[h]); RELU_FMA(a1, cc[1], w[h]); RELU_FMA(a2, cc[2], w[h]); RELU_FMA(a3, cc[3], w[h]); \
            cc = cn; __builtin_amdgcn_sched_barrier(0); } \
        *(LAS f32x4*)(sc + fr * SC_STRIDE + 16 * (kt_) + 4 * fq) = (f32x4){a0, a1, a2, a3}; } while (0)
    for (int rpk = 0; rpk < P2_KT_REP; ++rpk) {
    KLOAD(ka0, ka1, wave); KLOAD(kb0, kb1, wave + NWAVES);
    for (int kt = wave; kt < nkt; kt += 3 * NWAVES) {
        KLOAD(kc0, kc1, kt + 2 * NWAVES); KCOMP(ka0, ka1, kt);
        if (kt + NWAVES < nkt) { KLOAD(ka0, ka1, kt + 3 * NWAVES); KCOMP(kb0, kb1, kt + NWAVES); }
        if (kt + 2 * NWAVES < nkt) { KLOAD(kb0, kb1, kt + 4 * NWAVES); KCOMP(kc0, kc1, kt + 2 * NWAVES); }
    } }
#undef KCOMP
#undef KLOAD
    __syncthreads();
#pragma unroll 1
    for (int qq = 0; qq < P2_SEL_REP; ++qq) { const int q = 2 * wave; const int t = t0 + q;
        wave_topk_mask2(sc + q * SC_STRIDE, sc + (q + 1) * SC_STRIDE, t, MASK + ((size_t)b * S + t) * 32, MASK + ((size_t)b * S + t + 1) * 32, lane,
                        (LAS unsigned*)(lds + WSCR_OFF + wave * WSCR_BYTES), (LAS float*)(lds + WSCR_OFF + wave * WSCR_BYTES + 1024)); }
    __syncthreads();
}

__device__ __forceinline__ void p2_phase(const Args& a, LAS unsigned char* lds, int vcu, int G, int wave, int lane) {
    unsigned* rdy = (unsigned*)a.ws + RDY_WORD0;
    const int skip = (G == 256) ? 32 : 0;
    if (vcu >= skip) { const int gw = (vcu - skip) * NWAVES + wave, NGW = (G - skip) * NWAVES;
      for (int rp = 0; rp < P2_REP_A; ++rp) p2_sscore(a, gw, NGW, lane);

      GAS unsigned long long* MASK = (GAS unsigned long long*)(a.ws + WS_MASK);
      for (int i = gw * 64 + lane; i < NB * TOPK * 32; i += NGW * 64) { const int wd = i & 31, t = (i >> 5) & (TOPK - 1), b = i >> 13; const int lo = 64 * wd;
          const unsigned long long m = lo + 63 <= t ? ~0ull : (lo > t ? 0ull : ((1ull << (t - lo + 1)) - 1ull));
          __hip_atomic_store(MASK + ((size_t)b * S + t) * 32 + wd, m, __ATOMIC_RELAXED, __HIP_MEMORY_SCOPE_AGENT); } }
    signal_add_wt(rdy + 64 * 32);

    constexpr int NT = NB * (S - TOPK) / 16;
    for (int rp = 0; rp < P2_REP_C; ++rp)
    for (int r = 0; r * G < NT; ++r) { const int k = (r & 1) ? (r + 1) * G - 1 - vcu : r * G + vcu;
        if (k < NT) { const int j = (NT / NB - 1) - (k >> 2), b = k & 3; p2_index_tile(a, lds, b, TOPK + 16 * j, wave, lane);
            if (rp == 0) signal_add_wt(rdy + 64 * (40 + b * 32 + ((TOPK + 16 * j) >> 6))); } }
}

#ifndef P3_REP_S
#define P3_REP_S 1
#define P3_REP_A 1
#endif
namespace att {
typedef short bf16x8 __attribute__((ext_vector_type(8)));
typedef short s16x4 __attribute__((ext_vector_type(4)));
typedef float f32x16 __attribute__((ext_vector_type(16)));
constexpr int QBLK = 32, KVBLK = 64, D = 128;
constexpr int SHM_V = KVBLK * D * 2, SHM_K = KVBLK * D * 2;
constexpr int WS_OFF = 2 * SHM_V + 2 * SHM_K;
constexpr float SCALE = 0.08838834764831845f;
#define KSWZ(row, colB) ((row) * 256 + ((colB) ^ (((row) & 7) << 4)))
#define SBAR() __builtin_amdgcn_sched_barrier(0)
__device__ __forceinline__ int v_st(int k, int c) { const int kk = (k & ~0xC) | ((k & 4) << 1) | ((k & 8) >> 1); return ((kk >> 3) * 4 + (c >> 5)) * 512 + ((kk & 7) * 32 + (c & 31)) * 2; }
__device__ __forceinline__ int v_rd_base(int lane) { return ((lane & 3) << 3) | (((lane >> 2) & 3) << 6) | (((lane >> 4) & 1) << 5) | (((lane >> 5) & 1) << 8); }
constexpr int v_rd_off(int d0, int ks, int half) { return d0 * 512 + ks * 4096 + half * 2048; }
__device__ __forceinline__ int crow(int r, int hi) { return (r & 3) + 8 * (r >> 2) + 4 * hi; }
__device__ __forceinline__ unsigned cvtpk(float lo, float hi) { return pk_bf16(lo, hi); }

template <int KB>
__device__ __forceinline__ void qkt(f32x16& p0, f32x16& p1, const LAS unsigned char* K_lds, int r32, int hi, const LAS unsigned char* qp) {
    p0 = f32x16{}; p1 = f32x16{};
    const LAS unsigned char* kb[4];
#pragma unroll
    for (int dd = 0; dd < 4; ++dd) kb[dd] = K_lds + KB * SHM_K + KSWZ(r32, (dd * 16 + hi * 8) * 2);
#pragma unroll
    for (int d0 = 0; d0 < 8; ++d0) { const LAS unsigned char* a = kb[d0 & 3] + (d0 >> 2) * 128;
        const bf16x8 b0 = *(const LAS bf16x8*)a;
        const bf16x8 b1 = *(const LAS bf16x8*)(a + 32 * 256);
        const bf16x8 qv = *(const LAS bf16x8*)(qp + d0 * 1024);
        p0 = __builtin_amdgcn_mfma_f32_32x32x16_bf16(b0, qv, p0, 0, 0, 0);
        p1 = __builtin_amdgcn_mfma_f32_32x32x16_bf16(b1, qv, p1, 0, 0, 0); }
}
template <int VB>
__device__ __forceinline__ void pv_tile(f32x16* o, int vb0, bf16x8 pa0, bf16x8 pa1, bf16x8 pa2, bf16x8 pa3) {
#define TRRD(dst, off) asm volatile("ds_read_b64_tr_b16 %0, %1 offset:%2" : "=&v"(dst) : "v"(vb0), "i"(off) : "memory")
#define PV_D0(d0) do { s16x4 l0, l1, l2, l3, h0, h1, h2, h3; constexpr int b_ = VB * SHM_V + v_rd_off(d0, 0, 0); \
        TRRD(l0, b_); TRRD(h0, b_ + 2048); TRRD(l1, b_ + 4096); TRRD(h1, b_ + 6144); TRRD(l2, b_ + 8192); TRRD(h2, b_ + 10240); TRRD(l3, b_ + 12288); TRRD(h3, b_ + 14336); \
        asm volatile("s_waitcnt lgkmcnt(0)" ::: "memory"); SBAR(); \
        o[d0] = __builtin_amdgcn_mfma_f32_32x32x16_bf16(pa0, (bf16x8){l0[0], l0[1], l0[2], l0[3], h0[0], h0[1], h0[2], h0[3]}, o[d0], 0, 0, 0); \
        o[d0] = __builtin_amdgcn_mfma_f32_32x32x16_bf16(pa1, (bf16x8){l1[0], l1[1], l1[2], l1[3], h1[0], h1[1], h1[2], h1[3]}, o[d0], 0, 0, 0); \
        o[d0] = __builtin_amdgcn_mfma_f32_32x32x16_bf16(pa2, (bf16x8){l2[0], l2[1], l2[2], l2[3], h2[0], h2[1], h2[2], h2[3]}, o[d0], 0, 0, 0); \
        o[d0] = __builtin_amdgcn_mfma_f32_32x32x16_bf16(pa3, (bf16x8){l3[0], l3[1], l3[2], l3[3], h3[0], h3[1], h3[2], h3[3]}, o[d0], 0, 0, 0); } while (0)
    PV_D0(0); PV_D0(1); PV_D0(2); PV_D0(3);
#undef PV_D0
#undef TRRD
}
__device__ __forceinline__ void partialSM(f32x16& p0, f32x16& p1, unsigned wl, unsigned wh, float sh2) {
    const float NEG = -__builtin_inff(); constexpr float C2 = 1.4426950408889634f * SCALE;
#pragma unroll
    for (int r = 0; r < 16; ++r) { const unsigned bit = 1u << ((r & 3) + 8 * (r >> 2));
        p0[r] = (wl & bit) ? fmaf(p0[r], C2, -sh2) : NEG; p1[r] = (wh & bit) ? fmaf(p1[r], C2, -sh2) : NEG; }
#pragma unroll
    for (int r = 0; r < 16; ++r) p0[r] = __builtin_amdgcn_exp2f(p0[r]);
}
__device__ __forceinline__ void finishSM(f32x16& p0, f32x16& p1, float& l_reg, bf16x8& pa0, bf16x8& pa1, bf16x8& pa2, bf16x8& pa3) {
#pragma unroll
    for (int r = 0; r < 16; ++r) p1[r] = __builtin_amdgcn_exp2f(p1[r]);
    float ps = 0;
#pragma unroll
    for (int r = 0; r < 16; ++r) ps += p0[r];
#pragma unroll
    for (int r = 0; r < 16; ++r) ps += p1[r];
    l_reg += ps;
#define PK4(P, B_, OUT) do { unsigned a0 = cvtpk(P[B_+0], P[B_+1]), a1 = cvtpk(P[B_+2], P[B_+3]); \
        unsigned b0 = cvtpk(P[B_+4], P[B_+5]), b1 = cvtpk(P[B_+6], P[B_+7]); \
        auto r0 = __builtin_amdgcn_permlane32_swap(a0, b0, false, false); auto r1 = __builtin_amdgcn_permlane32_swap(a1, b1, false, false); \
        u32x4 w = {r0[0], r1[0], r0[1], r1[1]}; OUT = __builtin_bit_cast(bf16x8, w); } while (0)
    PK4(p0, 0, pa0); PK4(p0, 8, pa1); PK4(p1, 0, pa2); PK4(p1, 8, pa3);
#undef PK4
}

__device__ __forceinline__ __amdgpu_buffer_rsrc_t mk_rsrc(const GAS void* p, unsigned bytes) {
    const unsigned long long u = (unsigned long long)p; const unsigned lo = __builtin_amdgcn_readfirstlane((unsigned)u), hi = __builtin_amdgcn_readfirstlane((unsigned)(u >> 32));
    return __builtin_amdgcn_make_buffer_rsrc((void*)(((unsigned long long)hi << 32) | lo), (short)0, (int)bytes, 0x00020000);
}
__device__ __forceinline__ void attn_block(const Args& a, LAS unsigned char* lds, int b, int kvh, int q0, float sh2) {
    int tid_ = threadIdx.x; asm volatile("" : "+v"(tid_));
    const int tid = tid_, wid = __builtin_amdgcn_readfirstlane(tid >> 6), lane = tid & 63, r32 = lane & 31, hi = lane >> 5;
    const int head = 4 * kvh + (wid >> 1), qw = q0 + 32 * (wid & 1);
    const GAS bf16_t* Qw = (const GAS bf16_t*)(a.ws + WS_QB) + (((size_t)b * NH + head) * S + qw) * D;
    const GAS bf16_t* Kh = (const GAS bf16_t*)(a.ws + WS_KB) + ((size_t)b * NKV + kvh) * S * D;
    const GAS bf16_t* Vh = (const GAS bf16_t*)(a.ws + WS_VB) + ((size_t)b * NKV + kvh) * S * D;
    const __amdgpu_buffer_rsrc_t rK = mk_rsrc(Kh, S * D * 2), rV = mk_rsrc(Vh, S * D * 2), rM = mk_rsrc((const GAS unsigned long long*)(a.ws + WS_MASK) + ((size_t)b * S + qw) * 32, 32 * 256);
    const unsigned moff = (unsigned)r32 * 256u;
    const int NT = q0 / KVBLK + 1;
    LAS unsigned char* V_lds = lds; LAS unsigned char* K_lds = lds + 2 * SHM_V;
    const int sr = tid >> 4, sc = (tid & 15) * 8, vst0 = v_st(sr, sc), vst1 = v_st(32 + sr, sc), kws = KSWZ(sr, sc * 2);
    const int vb0 = (int)(unsigned)(size_t)V_lds + v_rd_base(lane); const unsigned kvoff = (unsigned)(sr * D + sc) * 2u;
    bf16x8 sA_v0, sA_v1, sA_k0, sA_k1, sB_v0, sB_v1, sB_k0, sB_k1;
    LAS unsigned char* qp = lds + WS_OFF + 2048 + wid * 8192 + lane * 16;
#define VMW() asm volatile("s_waitcnt vmcnt(0)" ::: "memory")
#define BL128(r_, so_) __builtin_bit_cast(bf16x8, __builtin_amdgcn_raw_buffer_load_b128(r_, kvoff, (so_), 0))
#define SLOAD_S(S_, k0) do { const int so_ = (k0) * 256; S_##_v0 = BL128(rV, so_); S_##_v1 = BL128(rV, so_ + 8192); S_##_k0 = BL128(rK, so_); S_##_k1 = BL128(rK, so_ + 8192); } while (0)
#define SWRITE_S(S_, bf) do { *(LAS bf16x8*)(V_lds + (bf) * SHM_V + vst0) = S_##_v0; *(LAS bf16x8*)(V_lds + (bf) * SHM_V + vst1) = S_##_v1; \
        *(LAS bf16x8*)(K_lds + (bf) * SHM_K + kws) = S_##_k0; *(LAS bf16x8*)(K_lds + (bf) * SHM_K + kws + 32 * 256) = S_##_k1; } while (0)
#define MLOAD(t) __builtin_bit_cast(unsigned long long, __builtin_amdgcn_raw_buffer_load_b64(rM, moff, (t) * 8, 16))
#define MSPLIT(mw, wl, wh) do { wl = (unsigned)(mw) >> (4 * hi); wh = (unsigned)((mw) >> 32) >> (4 * hi); } while (0)
    { bf16x8 qt[8];
#pragma unroll
      for (int d0 = 0; d0 < 8; ++d0) qt[d0] = *(const GAS bf16x8*)(Qw + (unsigned)(r32 * D + d0 * 16 + hi * 8));
#pragma unroll
      for (int d0 = 0; d0 < 8; ++d0) *(LAS bf16x8*)(qp + d0 * 1024) = qt[d0]; }
    SLOAD_S(sA, 0); unsigned long long mwA = MLOAD(0), mwB = 0ull; VMW(); SWRITE_S(sA, 0);
    SLOAD_S(sB, KVBLK); mwB = MLOAD(1); SLOAD_S(sA, 2 * KVBLK);
    __syncthreads();
    float l_reg = 0.f; f32x16 o[4] = {};
    f32x16 p0, p1; bf16x8 pa0, pa1, pa2, pa3; unsigned wl, wh;
    SBAR(); qkt<0>(p0, p1, K_lds, r32, hi, qp);
    MSPLIT(mwA, wl, wh); partialSM(p0, p1, wl, wh, sh2);
    if (NT > 1) { SWRITE_S(sB, 1); }
    __syncthreads();
#define STEP(t, KB, VB, SW, SL) do { \
        finishSM(p0, p1, l_reg, pa0, pa1, pa2, pa3); SBAR(); \
        mwA = MLOAD((t) + 1); SLOAD_S(SL, ((t) + 2) * KVBLK); SBAR();        \
        pv_tile<VB>(o, vb0, pa0, pa1, pa2, pa3); SBAR(); \
        qkt<KB>(p0, p1, K_lds, r32, hi, qp); \
        MSPLIT(mwB, wl, wh); partialSM(p0, p1, wl, wh, sh2); mwB = mwA; \
        __syncthreads(); \
        if ((t) + 1 < NT) { SWRITE_S(SW, VB); } \
        __syncthreads(); } while (0)
    int t = 1;
    for (; t + 1 < NT; t += 2) { STEP(t, 1, 0, sA, sB); STEP(t + 1, 0, 1, sB, sA); }
    if (t < NT) { STEP(t, 1, 0, sA, sB); }
    finishSM(p0, p1, l_reg, pa0, pa1, pa2, pa3); SBAR();
    if ((NT - 1) & 1) pv_tile<1>(o, vb0, pa0, pa1, pa2, pa3); else pv_tile<0>(o, vb0, pa0, pa1, pa2, pa3);
    { auto rr = __builtin_amdgcn_permlane32_swap(__float_as_uint(l_reg), __float_as_uint(l_reg), false, false); l_reg = __uint_as_float(rr[0]) + __uint_as_float(rr[1]); }
    { int te = threadIdx.x; asm volatile("" : "+v"(te));
      const int le = te & 63, r32e = le & 31, hie = le >> 5;
      LAS float* wse = (LAS float*)(lds + WS_OFF) + wid * 64;
      if (hie == 0) wse[r32e] = l_reg;
      asm volatile("s_waitcnt lgkmcnt(0)" ::: "memory");
      __syncthreads();
      LAS f16* stg = (LAS f16*)(lds + wid * 8192);
#pragma unroll
      for (int r = 0; r < 16; ++r) { const int orow = crow(r, hie); const float rl = __builtin_amdgcn_rcpf(wse[orow]);
#pragma unroll
          for (int d0 = 0; d0 < 4; ++d0) stg[orow * 128 + d0 * 32 + r32e] = (f16)(o[d0][r] * rl); }
      asm volatile("s_waitcnt lgkmcnt(0)" ::: "memory");
      const GAS f16* SZ = (const GAS f16*)(a.ws + WS_SZ) + ((size_t)b * S + qw) * 1024 + head * 128; GAS f16* MIX = (GAS f16*)(a.ws + WS_MIX) + ((size_t)b * S + qw) * 2048 + head * 128;
#pragma unroll
      for (int i = 0; i < 8; ++i) { const int c = le + 64 * i, row = c >> 4, ch = c & 15;
          const f16x8 ov = *(const LAS f16x8*)(stg + row * 128 + ch * 8); const f16x8 zv = *(const GAS f16x8*)(SZ + (unsigned)(row * 1024 + ch * 8));
          const f16x8 mv_ = ov * zv; st16_wt((GAS void*)(MIX + (unsigned)(row * 2048 + ch * 8)), __builtin_bit_cast(u32x4, mv_)); } }
    asm volatile("s_waitcnt lgkmcnt(0)" ::: "memory");
    __syncthreads();
#undef BL128
#undef VMW
#undef SLOAD_S
#undef SWRITE_S
#undef MLOAD
#undef MSPLIT
#undef STEP
}
#undef KSWZ
#undef SBAR
}

__device__ __forceinline__ void p3_sample_item(const Args& a, LAS unsigned char* lds, int item, int tid) {
    const int qi = item >> 1, kvh = item & 1, sb = qi / NST, tl = qi % NST; constexpr int L = PAST + NST, PER = 33;
    const int lane = tid & 63, wave = __builtin_amdgcn_readfirstlane(tid >> 6);
    const GAS float* ck = (const GAS float*)a.in[2]; const GAS float* cv = (const GAS float*)a.in[3]; const GAS int* ptab = (const GAS int*)a.in[6]; const GAS float* out_ro = (const GAS float*)a.out;
    LAS float* q = (LAS float*)lds; LAS float* w = q + 1024; LAS float* newsc = w + 16; LAS float* ctl = newsc + 4; LAS float* red = ctl + 16;
    LAS unsigned* hist = (LAS unsigned*)(red + 32); LAS float* cand = (LAS float*)(hist + 256); LAS unsigned* cnt = (LAS unsigned*)(cand + 64);
    LAS unsigned* rid = cnt + 32; LAS float* qa = (LAS float*)(rid + 512); LAS float* sc = qa + 512; LAS float* inv = sc + 4 * 512; LAS float* part = inv + 4;
    LAS int* nsel = (LAS int*)(ctl + 8); LAS int* ncand = (LAS int*)(ctl + 9);
    const GAS f16* QI = (const GAS f16*)(a.ws + WS_QI) + (size_t)(MP + qi) * 1024; const GAS float* QS = (const GAS float*)(a.ws + WS_QS) + (size_t)qi * 1024 + kvh * 512;
    for (int i = tid; i < 1024; i += 512) q[i] = (float)QI[i];
    qa[tid] = QS[tid];
    if (tid < 16) w[tid] = ((const GAS float*)(a.ws + WS_WI))[(size_t)(MP + qi) * 16 + tid];
    if (tid < 32) cnt[tid] = 0u;
    if (tid < 256) hist[tid] = 0u;
    if (tid == 0) { *nsel = 0; *ncand = 0; }
    const GAS float* ssc = (const GAS float*)(a.ws + WS_SSC) + (size_t)qi * PAST;
    float v[PER];
#pragma unroll
    for (int j = 0; j < PER - 1; ++j) v[j] = __builtin_bit_cast(float, __hip_atomic_load((const GAS unsigned*)ssc + (j * 512 + tid), __ATOMIC_RELAXED, __HIP_MEMORY_SCOPE_AGENT));
    __syncthreads();
    if (tid < NST) { const GAS float* kr = out_ro + O_KIS + (size_t)(sb * NST + tid) * 64; float s = 0.f;
#pragma unroll 1
        for (int h = 0; h < 16; ++h) { float dsum = 0.f;
#pragma unroll 8
            for (int d = 0; d < 64; ++d) dsum += q[h * 64 + d] * kr[d];
            s += w[h] * fmaxf(dsum, 0.f); }
        newsc[tid] = s; }
    __syncthreads();
    const float NINF = -__builtin_inff(), PINF = __builtin_inff();
    { const int s = (PER - 1) * 512 + tid; v[PER - 1] = (s < L && (s - PAST) <= tl) ? newsc[s - PAST] : NINF; }
    float mx = NINF, mn = PINF;
#pragma unroll
    for (int j = 0; j < PER; ++j) { mx = fmaxf(mx, v[j]); mn = fminf(mn, v[j] == NINF ? PINF : v[j]); }
#pragma unroll
    for (int o = 1; o < 64; o <<= 1) { mx = fmaxf(mx, __shfl_xor(mx, o)); mn = fminf(mn, __shfl_xor(mn, o)); }
    if (lane == 0) { red[wave] = mx; red[8 + wave] = mn; }
    __syncthreads();
#pragma unroll
    for (int i = 0; i < 8; ++i) { mx = fmaxf(mx, red[i]); mn = fminf(mn, red[8 + i]); }
    const float scale = 255.5f / (mx - mn);
    float tau = 0.f; bool have = false;
    if (mx > mn) {
#pragma unroll
        for (int j = 0; j < PER; ++j) if (v[j] != NINF) { int bn = (int)((v[j] - mn) * scale); bn = bn > 255 ? 255 : bn; __hip_atomic_fetch_add(hist + bn, 1u, __ATOMIC_RELAXED, __HIP_MEMORY_SCOPE_WORKGROUP); }
        __syncthreads();
        if (wave == 0) {
            const u32x4 h = *(const LAS u32x4*)(hist + 4 * lane);
            const unsigned sl = h[0] + h[1] + h[2] + h[3]; unsigned pre = sl;
#pragma unroll
            for (int o = 1; o < 64; o <<= 1) { const unsigned y = __shfl_up(pre, o); if (lane >= o) pre += y; }
            const unsigned tot = __builtin_amdgcn_readlane(pre, 63); const unsigned suf = tot - pre + sl;
            const unsigned long long bm = __ballot(suf >= TOPK);
            const int Ls = 63 - __builtin_clzll(bm);
            unsigned c = __builtin_amdgcn_readlane(suf, Ls) - __builtin_amdgcn_readlane(sl, Ls);
            const unsigned h3 = __builtin_amdgcn_readlane(h[3], Ls), h2 = __builtin_amdgcn_readlane(h[2], Ls), h1 = __builtin_amdgcn_readlane(h[1], Ls);
            int Bs;
            if (c + h3 >= TOPK) Bs = 4 * Ls + 3; else { c += h3; if (c + h2 >= TOPK) Bs = 4 * Ls + 2; else { c += h2; if (c + h1 >= TOPK) Bs = 4 * Ls + 1; else { c += h1; Bs = 4 * Ls; } } }
            if (lane == 0) { ((LAS int*)ctl)[0] = Bs; ((LAS int*)ctl)[1] = TOPK - (int)c; }
        }
        __syncthreads();
        const int Bs = ((LAS int*)ctl)[0], need = ((LAS int*)ctl)[1];
#pragma unroll
        for (int j = 0; j < PER; ++j) if (v[j] != NINF) { int bn = (int)((v[j] - mn) * scale); bn = bn > 255 ? 255 : bn;
            if (bn == Bs) { const int p = __hip_atomic_fetch_add(ncand, 1, __ATOMIC_RELAXED, __HIP_MEMORY_SCOPE_WORKGROUP); if (p < 64) cand[p] = v[j]; } }
        __syncthreads();
        const int base = *ncand;
        if (base <= 64) {
            if (wave == 0) { const float x = lane < base ? cand[lane] : NINF; int rank = 0;
                for (int m = 0; m < base; ++m) { const float y = __builtin_bit_cast(float, __builtin_amdgcn_readlane(__builtin_bit_cast(int, x), m)); rank += y > x ? 1 : 0; }
                float tc = (lane < base && rank <= need - 1) ? x : PINF;
#pragma unroll
                for (int o = 1; o < 64; o <<= 1) tc = fminf(tc, __shfl_xor(tc, o));
                if (lane == 0) ctl[2] = tc; }
            __syncthreads();
            tau = ctl[2]; have = true;
        }
    }
    if (!have) {
        unsigned tk = 0u;
        for (int bit = 31; bit >= 0; --bit) { const unsigned cd = tk | (1u << bit); int c = 0;
#pragma unroll
            for (int j = 0; j < PER; ++j) c += __builtin_popcountll(__ballot(v[j] != NINF && fkey(v[j]) >= cd));
            if (lane == 0) __hip_atomic_fetch_add(cnt + bit, (unsigned)c, __ATOMIC_RELAXED, __HIP_MEMORY_SCOPE_WORKGROUP);
            __syncthreads();
            if (cnt[bit] >= TOPK) tk = cd; }
        tau = __builtin_bit_cast(float, (tk & 0x80000000u) ? (tk ^ 0x80000000u) : ~tk);
    }
#pragma unroll
    for (int j = 0; j < PER; ++j) { if (v[j] >= tau) { const int s = j * 512 + tid; const int p = __hip_atomic_fetch_add(nsel, 1, __ATOMIC_RELAXED, __HIP_MEMORY_SCOPE_WORKGROUP);
        if (p < 512) rid[p] = s < PAST ? (unsigned)(ptab[sb * NPAGES + (s >> 7)] * PAGE + (s & (PAGE - 1))) : (0x80000000u | (unsigned)(s - PAST)); } }
    __syncthreads();
    const int n = *nsel < 512 ? *nsel : 512;
    const int half = lane >> 5, l32 = lane & 31;
    { f32x4 qv[4];
#pragma unroll
      for (int h = 0; h < 4; ++h) qv[h] = *(const LAS f32x4*)(qa + h * 128 + 4 * l32);
      for (int j0 = 2 * wave; j0 < n; j0 += 128) { f32x4 kv[8]; int jj[8];
#pragma unroll
          for (int u = 0; u < 8; ++u) { jj[u] = j0 + 16 * u + half; const unsigned r = rid[jj[u] < n ? jj[u] : 0];
              const GAS float* kr = (r & 0x80000000u) ? out_ro + O_KS + ((size_t)(sb * NST + (r & 3u)) * NKV + kvh) * HD : ck + ((size_t)r * NKV + kvh) * HD;
              kv[u] = *(const GAS f32x4*)(kr + 4 * l32); }
#pragma unroll
          for (int u = 0; u < 8; ++u) { float d[4];
#pragma unroll
              for (int h = 0; h < 4; ++h) d[h] = half_sum_dpp((kv[u][0] * qv[h][0] + kv[u][1] * qv[h][1]) + (kv[u][2] * qv[h][2] + kv[u][3] * qv[h][3]));
              if (jj[u] < n && l32 >= 16 && l32 < 20) { const int hq = l32 & 3; sc[hq * 512 + jj[u]] = (hq == 0 ? d[0] : hq == 1 ? d[1] : hq == 2 ? d[2] : d[3]) * 0.08838834764831845f; } } } }
    __syncthreads();
    if (wave < 4) { LAS float* row = sc + wave * 512; float m2 = -1e30f;
      for (int j = lane; j < n; j += 64) m2 = fmaxf(m2, row[j]);
      m2 = wave_max_dpp(m2);
      float sm = 0.f;
      for (int j = lane; j < n; j += 64) { const float e = __expf(row[j] - m2); row[j] = e; sm += e; }
      sm = wave_sum_dpp(sm); if (lane == 0) inv[wave] = 1.f / sm; }
    __syncthreads();
    { f32x4 acc[4] = {};
      for (int j0 = 2 * wave; j0 < n; j0 += 128) { f32x4 vv[8]; int jj[8];
#pragma unroll
          for (int u = 0; u < 8; ++u) { jj[u] = j0 + 16 * u + half; const unsigned r = rid[jj[u] < n ? jj[u] : 0];
              const GAS float* vr = (r & 0x80000000u) ? out_ro + O_VS + ((size_t)(sb * NST + (r & 3u)) * NKV + kvh) * HD : cv + ((size_t)r * NKV + kvh) * HD;
              vv[u] = *(const GAS f32x4*)(vr + 4 * l32); }
#pragma unroll
          for (int u = 0; u < 8; ++u)
#pragma unroll
              for (int h = 0; h < 4; ++h) { const float p = jj[u] < n ? sc[h * 512 + jj[u]] : 0.f; acc[h] += vv[u] * p; } }
#pragma unroll
      for (int h = 0; h < 4; ++h) {
#pragma unroll
          for (int e = 0; e < 4; ++e) acc[h][e] += __shfl_xor(acc[h][e], 32);
          if (half == 0) *(LAS f32x4*)(part + (wave * 4 + h) * 128 + 4 * l32) = acc[h]; } }
    __syncthreads();
    { const GAS f16* SZ = (const GAS f16*)(a.ws + WS_SZ) + (size_t)(MP + qi) * 1024 + kvh * 512; GAS f16* MIX = (GAS f16*)(a.ws + WS_MIX) + (size_t)(MP + qi) * 2048 + kvh * 512;
      const int h = tid >> 7, d = tid & 127; float o = 0.f;
#pragma unroll
      for (int p = 0; p < 8; ++p) o += part[(p * 4 + h) * 128 + d];
      const float val = o * inv[h] * (float)SZ[tid]; const float nbv = __shfl_down(val, 1);
      if (!(tid & 1)) __hip_atomic_store((GAS unsigned*)(MIX + tid), pk_f16(val, nbv), __ATOMIC_RELAXED, __HIP_MEMORY_SCOPE_AGENT); }
    __syncthreads();
}

__device__ __forceinline__ void p3_phase(const Args& a, LAS unsigned char* lds, int vcu, int G, int tid) {
    float gm = 0.f, km = 0.f;
    for (int i = 0; i < HD; ++i) { gm = fmaxf(gm, fabsf(a.in[9][i])); km = fmaxf(km, fabsf(a.in[10][i])); }
    const float sh2 = fmaxf(0.f, 11.313708498984761f * gm * km - 20.f) * 1.4426950408889634f;
    for (int rp = 0; rp < P3_REP_S; ++rp)
    for (int sidx = G - 1 - vcu; sidx < 2 * MS; sidx += G) { wait_ge_wt((unsigned*)a.ws + RDY_WORD0 + 64 * 32, (unsigned)G); p3_sample_item(a, lds, sidx, tid); if (rp == 0) signal_add_wt((unsigned*)a.ws + RDY_WORD0 + 64 * 34); }


    for (int rp = 0; rp < P3_REP_A; ++rp)
    for (int k = vcu; k < 256; k += G) { const int i = 31 - (k >> 3), bk = k & 7;
        if (i >= 4) wait_ge_wt((unsigned*)a.ws + RDY_WORD0 + 64 * (40 + (bk >> 1) * 32 + i), 4u); else wait_ge_wt((unsigned*)a.ws + RDY_WORD0 + 64 * 32, (unsigned)G);
        att::attn_block(a, lds, bk >> 1, bk & 1, 64 * i, sh2);
        if (rp == 0) { asm volatile("s_waitcnt vmcnt(0)" ::: "memory"); __syncthreads(); if (tid == 0) (void)xb_add((unsigned*)a.ws + PMR_WORD0 + 64 * (8 * (bk >> 1) + (i >> 2)), 16u); } }
    { unsigned* qctr = (unsigned*)a.ws + CMQ_WORD; unsigned* srdy = (unsigned*)a.ws + RDY_WORD0 + 64 * 34; LAS int* cq = (LAS int*)(lds + MISC_OFF + 168); const int wave = tid >> 6, lane = tid & 63;
      constexpr int NCH = MT / 16;
      unsigned nxt = 0u; if (tid == 0) nxt = xb_add(qctr, 1u);
      for (int it = 0;; ++it) {
          if (tid == 0) { cq[it & 1] = (int)nxt; nxt = xb_add(qctr, 1u); }
          __syncthreads();
          const int c = cq[it & 1];
          if (c < NCH) { const int ch = NCH - 1 - c; convmix_task(a, 4 * ch + (wave >> 1), wave & 1, lane);
              if (16 * ch >= MP) signal_add_wt(srdy);
              else { asm volatile("s_waitcnt vmcnt(0)" ::: "memory"); if (lane == 0) (void)xb_add((unsigned*)a.ws + PMR_WORD0 + 64 * (ch >> 4), 1u); } }
          else if (c < NCH + DM / 8) { wait_ge_wt(srdy, 2u * MS + (unsigned)(MT - MP) / 16u); p4_item(a, lds, c - NCH, tid); }
          else break; } }
}

__global__ void __launch_bounds__(NWAVES * 64, 2) mk_fwd(Args a) {
    extern __shared__ __attribute__((aligned(16))) unsigned char lds_raw[];
    LAS unsigned char* lds = (LAS unsigned char*)lds_raw;
    const int tid = threadIdx.x, lane = tid & 63, wave = __builtin_amdgcn_readfirstlane(tid >> 6);
    const int G = gridDim.x; const int bx = blockIdx.x; const int vcu = (G % 8 == 0) ? (bx % 8) * (G / 8) + bx / 8 : bx;
    volatile LAS unsigned* MISC = (volatile LAS unsigned*)(lds + MISC_OFF);
    if (tid < 64) MISC[tid] = 0u;
    __syncthreads();
    XcdBarrier bar = xcd_barrier_post((unsigned*)a.ws, MISC + 8);
    { int t_ = threadIdx.x; asm volatile("" : "+v"(t_)); const int lane = t_ & 63, wave = __builtin_amdgcn_readfirstlane(t_ >> 6); p0_prologue(a, lds, vcu, G, wave, lane); }
    xcd_barrier(bar);
    { pg8::Gemm g{(const f16*)(a.ws + WS_XNH), (const f16*)(a.ws + WS_WINT), DM};
      pg8::StaticOrder S; S.init(MPAD / 256, NPAD / 256, G, bx);
      EpiIn E{a.out, a.ws, a.in[9], a.in[10], a.in[11], (LAS float*)(lds + SCR_OFF)};
      pg8::gemm_phase<EpiIn, pg8::StaticOrder>(lds, g, S, E); }
    { int t_ = threadIdx.x; asm volatile("" : "+v"(t_)); const int lane = t_ & 63, wave = __builtin_amdgcn_readfirstlane(t_ >> 6);
      xcd_barrier(bar);
      p2_phase(a, lds, vcu, G, wave, lane); }
    { int t_ = threadIdx.x; asm volatile("" : "+v"(t_)); p3_phase(a, lds, vcu, G, t_); }
    { pg8::Gemm g{(const f16*)(a.ws + WS_MIX), (const f16*)(a.ws + WS_WOUTT), DM};
      pg8::StaticOrder S; S.init(MP / 256, DM / 256, G, bx);
      EpiOut E{a.out, a.in[0]};
      f32x4 accp[2][2][4][2]; { pg8::Unit u0; int t0_ = threadIdx.x; asm volatile("" : "+v"(t0_)); const int w0_ = __builtin_amdgcn_readfirstlane(t0_ >> 6), l0_ = t0_ & 63;
          if (S.next(0, u0)) E.init(accp, u0, w0_ >> 2, w0_ & 3, l0_ & 15, l0_ >> 4); }
      { pg8::Unit uw_; for (int i_ = 0; S.next(i_, uw_); ++i_) wait_ge_wt((unsigned*)a.ws + PMR_WORD0 + 64 * uw_.pm, 256u); }
      pg8::gemm_phase<EpiOut, pg8::StaticOrder, true>(lds, g, S, E, accp);
      }
}

#ifndef PROG
#define PROG 0x11111u
#endif
extern "C" void kernel_launch(void* const* d_in, const int* in_sizes, int n_in, void* d_out, int out_size, void* d_ws, size_t ws_size, hipStream_t stream) {
    static int grid = 0;
    if (grid == 0) {
        if (ws_size < WS_NEED2 || out_size != (int)O_END || n_in != 14) { fprintf(stderr, "kernel_launch: ws %zu (need %zu) out %d (want %zu) n_in %d\n", ws_size, (size_t)WS_NEED2, out_size, (size_t)O_END, n_in); grid = -1; return; }
        int dev = 0, cus = 0; hipGetDevice(&dev); hipDeviceGetAttribute(&cus, hipDeviceAttributeMultiprocessorCount, dev);
        if (hipFuncSetAttribute((const void*)mk_fwd, hipFuncAttributeMaxDynamicSharedMemorySize, LDS_BYTES) != hipSuccess) { fprintf(stderr, "kernel_launch: hipFuncSetAttribute failed\n"); grid = -1; return; }
        int per_cu = 0; hipOccupancyMaxActiveBlocksPerMultiprocessor(&per_cu, (const void*)mk_fwd, NWAVES * 64, LDS_BYTES); (void)hipGetLastError();
        if (per_cu < 1) fprintf(stderr, "kernel_launch: occupancy query says %d blocks per CU\n", per_cu);
        grid = cus > 0 ? cus : 256;
    }
    if (grid < 0) return;
    float* out = (float*)d_out; unsigned char* ws = (unsigned char*)d_ws;
    Args a{};
    for (int i = 0; i < 14; ++i) a.in[i] = (const float*)d_in[i];
    a.out = out; a.ws = ws;
    if (hipMemsetAsync(ws, 0, 131072, stream) != hipSuccess) { fprintf(stderr, "kernel_launch: memset of the control words failed\n"); return; }
    a.ph_lo = (int)PROG; a.ph_hi = 0; hipLaunchKernelGGL(mk_fwd, dim3(grid), dim3(NWAVES * 64), LDS_BYTES, stream, a);
}
```
